# Optimizing an MI355X kernel written in HIP

```python
import jax, jax.numpy as jnp
from jax import lax
import numpy as np

D_MODEL = 1024
BATCH = 32
SEQ = 256
DEPTH = 4
DEC_BATCH = 2
DEC_SEQ = 1024
PAST_LEN = 256

GRID_W = 64
N_EVEN = (DEPTH + 1) // 2
N_ODD = DEPTH // 2
N_MOD = 9
D_FF = 2816
EPS = 1e-6
A_WIDTH = 512
A_GROUPS = 4
A_GROUP_DIM = A_WIDTH // A_GROUPS
A_CHUNK = 128
SSM_HEADS = 8
SSM_HEAD_DIM = 64
SSM_INNER = SSM_HEADS * SSM_HEAD_DIM
SSM_GROUPS = 2
SSM_STATE = 128
SSM_CONV = 3
SSM_CHUNK = 128
SSM_XBC = SSM_INNER + 2 * SSM_GROUPS * SSM_STATE
EVEN_IN = 2 * A_WIDTH + SSM_INNER + SSM_XBC + 2 * SSM_HEADS
EVEN_MIX = A_WIDTH + SSM_INNER
MLA_HEADS = 8
MLA_NOPE = 64
MLA_ROPE = 32
MLA_V = 64
MLA_Q_RANK = 384
MLA_KV_RANK = 256
ROPE_THETA = 10000.0
Q_BLOCK = 128
CONV_WIDTH = 512
CONV_K = 31
ODD_IN = MLA_Q_RANK + MLA_KV_RANK + MLA_ROPE + 2 * CONV_WIDTH
ODD_MIX = MLA_HEADS * MLA_V + CONV_WIDTH

kernel_name = 'hybrid_gmlp_ssd_mla_conformer_dit_step'


def rmsnorm(x, g):
    xf = x.astype(jnp.float32)
    y = xf * lax.rsqrt(jnp.mean(xf * xf, axis=-1, keepdims=True) + EPS)
    return (y * g.astype(jnp.float32)).astype(x.dtype)


def layernorm(x, g, b):
    xf = x.astype(jnp.float32)
    xc = xf - jnp.mean(xf, axis=-1, keepdims=True)
    var = jnp.mean(xc * xc, axis=-1, keepdims=True)
    return (xc * lax.rsqrt(var + EPS) * g.astype(jnp.float32) + b.astype(jnp.float32)).astype(x.dtype)


def modulate(x, shift, scale):
    return x * (1 + scale) + shift


def swiglu(x, w_gu, w_d):
    g, u = jnp.split(x @ w_gu, 2, axis=-1)
    return (jax.nn.silu(g) * u) @ w_d


def ffn_sublayer(x, g, shift, scale, gate, w_gu, w_d):
    return x + 0.5 * gate * swiglu(modulate(rmsnorm(x, g), shift, scale), w_gu, w_d)


def depthwise_conv(x, w, b):
    k = w.shape[0]
    y = lax.conv_general_dilated(x, w[:, None, :].astype(x.dtype), window_strides=(1,),
                                 padding=[(k // 2, k // 2)], dimension_numbers=('NWC', 'WIO', 'NWC'),
                                 feature_group_count=x.shape[-1])
    return y + b


def chunk_gmlp(uv, w_s, b_s, g_v):
    bsz, length, _ = uv.shape
    u, v = jnp.split(jax.nn.gelu(uv), 2, axis=-1)
    v = rmsnorm(v, g_v).reshape(bsz, length // A_CHUNK, A_CHUNK, A_GROUPS, A_GROUP_DIM)
    s = jnp.einsum('gij,bcjgd->bcigd', w_s, v) + b_s.T[None, None, :, :, None]
    return u * s.reshape(bsz, length, A_WIDTH)


def ssd_scan(x, dt, a, bm, cm, h0):
    bsz, length, n_h, p = x.shape
    nc = length // SSM_CHUNK
    rep = n_h // SSM_GROUPS
    bh = jnp.repeat(bm, rep, axis=2).reshape(bsz, nc, SSM_CHUNK, n_h, SSM_STATE)
    ch = jnp.repeat(cm, rep, axis=2).reshape(bsz, nc, SSM_CHUNK, n_h, SSM_STATE)
    xdt = (x * dt[..., None]).reshape(bsz, nc, SSM_CHUNK, n_h, p)
    cum = jnp.cumsum((dt.astype(jnp.float32) * a.astype(jnp.float32)).reshape(bsz, nc, SSM_CHUNK, n_h), axis=2)
    seg = cum[:, :, :, None, :] - cum[:, :, None, :, :]
    lower = jnp.tril(jnp.ones((SSM_CHUNK, SSM_CHUNK), dtype=bool))[None, None, :, :, None]
    lmat = jnp.exp(jnp.where(lower, seg, -jnp.inf)).astype(x.dtype)
    scores = jnp.einsum('bcihn,bcjhn->bcijh', ch, bh) * lmat
    y_diag = jnp.einsum('bcijh,bcjhp->bcihp', scores, xdt)
    decay_end = jnp.exp(cum[:, :, -1:, :] - cum).astype(x.dtype)
    chunk_states = jnp.einsum('bcjhn,bcjh,bcjhp->bchpn', bh, decay_end, xdt)
    chunk_decay = jnp.exp(cum[:, :, -1, :]).astype(x.dtype)

    def step(h, inp):
        dec, st = inp
        return h * dec[:, :, None, None] + st, h

    h_last, h_in = lax.scan(step, h0, (jnp.moveaxis(chunk_decay, 1, 0), jnp.moveaxis(chunk_states, 1, 0)))
    h_in = jnp.moveaxis(h_in, 0, 1)
    y_off = jnp.einsum('bcihn,bchpn->bcihp', ch, h_in) * jnp.exp(cum).astype(x.dtype)[..., None]
    return (y_diag + y_off).reshape(bsz, length, n_h, p), h_last


def ssd_gmlp_mixer(h, w_in, w_out, w_s, b_s, g_v, w_conv, b_conv, dt_bias, a_log, d_skip, g_out, h0_f, h0_b):
    bsz, length, _ = h.shape
    proj = h @ w_in
    o1 = 2 * A_WIDTH
    o2 = o1 + SSM_INNER
    o3 = o2 + SSM_XBC
    y_a = chunk_gmlp(proj[..., :o1], w_s, b_s, g_v)
    z = proj[..., o1:o2]
    xbc = jax.nn.silu(depthwise_conv(proj[..., o2:o3], w_conv, b_conv))
    dt_raw = proj[..., o3:]
    xs = xbc[..., :SSM_INNER].reshape(bsz, length, SSM_HEADS, SSM_HEAD_DIM)
    bm = xbc[..., SSM_INNER:SSM_INNER + SSM_GROUPS * SSM_STATE].reshape(bsz, length, SSM_GROUPS, SSM_STATE)
    cm = xbc[..., SSM_INNER + SSM_GROUPS * SSM_STATE:].reshape(bsz, length, SSM_GROUPS, SSM_STATE)
    dt_f = jax.nn.softplus(dt_raw[..., :SSM_HEADS] + dt_bias[0])
    dt_b = jax.nn.softplus(dt_raw[..., SSM_HEADS:] + dt_bias[1])
    y_f, h_f = ssd_scan(xs, dt_f, -jnp.exp(a_log[0]), bm, cm, h0_f)
    y_b, h_b = ssd_scan(jnp.flip(xs, 1), jnp.flip(dt_b, 1), -jnp.exp(a_log[1]),
                        jnp.flip(bm, 1), jnp.flip(cm, 1), h0_b)
    y = y_f + jnp.flip(y_b, 1) + xs * (d_skip[0] + d_skip[1])[:, None]
    y = rmsnorm(y.reshape(bsz, length, SSM_INNER) * jax.nn.silu(z), g_out)
    return jnp.concatenate([y_a, y], axis=-1) @ w_out, h_f, h_b


def rope_2d(length):
    n_rows = length // GRID_W
    row = jnp.repeat(jnp.arange(n_rows, dtype=jnp.float32), GRID_W)
    col = jnp.tile(jnp.arange(GRID_W, dtype=jnp.float32), n_rows)
    n_freq = MLA_ROPE // 4
    freqs = ROPE_THETA ** (-jnp.arange(n_freq, dtype=jnp.float32) / n_freq)
    ang = jnp.stack([row[:, None] * freqs, col[:, None] * freqs], axis=1)
    return jnp.cos(ang), jnp.sin(ang)


def apply_rope(x, cos, sin):
    xs = x.reshape(x.shape[:-1] + (2, 2, MLA_ROPE // 4))
    x1, x2 = xs[..., 0, :], xs[..., 1, :]
    cos = cos.astype(x.dtype)
    sin = sin.astype(x.dtype)
    out = jnp.stack([x1 * cos - x2 * sin, x1 * sin + x2 * cos], axis=-2)
    return out.reshape(x.shape)


def mla_attend(q_nope, q_rope, k_nope, k_rope, v):
    bsz, lq = q_nope.shape[:2]
    nb = lq // Q_BLOCK
    scale = (MLA_NOPE + MLA_ROPE) ** -0.5
    qn_b = jnp.moveaxis(q_nope.reshape(bsz, nb, Q_BLOCK, MLA_HEADS, MLA_NOPE), 1, 0)
    qr_b = jnp.moveaxis(q_rope.reshape(bsz, nb, Q_BLOCK, MLA_HEADS, MLA_ROPE), 1, 0)

    def block(args):
        qn, qr = args
        s = jnp.einsum('bqhd,bkhd->bhqk', qn, k_nope) + jnp.einsum('bqhd,bkd->bhqk', qr, k_rope)
        p = jax.nn.softmax(s.astype(jnp.float32) * scale, axis=-1).astype(v.dtype)
        return jnp.einsum('bhqk,bkhd->bqhd', p, v)

    o = lax.map(block, (qn_b, qr_b))
    return jnp.moveaxis(o, 0, 1).reshape(bsz, lq, MLA_HEADS * MLA_V)


def up_kv(ckv, w_ukv):
    kv = (ckv @ w_ukv).reshape(ckv.shape[:-1] + (MLA_HEADS, MLA_NOPE + MLA_V))
    return kv[..., :MLA_NOPE], kv[..., MLA_NOPE:]


def mla_conv_mixer(h, w_in, w_out, g_cq, w_uq, g_ckv, w_ukv, w_dw, b_dw, g_ln, b_ln, ctx):
    bsz, length, _ = h.shape
    proj = h @ w_in
    o1 = MLA_Q_RANK
    o2 = o1 + MLA_KV_RANK
    o3 = o2 + MLA_ROPE
    q = (rmsnorm(proj[..., :o1], g_cq) @ w_uq).reshape(bsz, length, MLA_HEADS, MLA_NOPE + MLA_ROPE)
    q_nope, q_rope = q[..., :MLA_NOPE], q[..., MLA_NOPE:]
    ckv = rmsnorm(proj[..., o1:o2], g_ckv)
    k_rope = proj[..., o2:o3]
    k_nope, v = up_kv(ckv, w_ukv)
    if ctx is None:
        attn = mla_attend(q_nope, q_rope, k_nope, k_rope, v)
    else:
        cache_ckv, cache_kr, cos, sin = ctx
        kc_nope, vc = up_kv(cache_ckv, w_ukv)
        attn = mla_attend(q_nope, apply_rope(q_rope, cos[:, None], sin[:, None]),
                          jnp.concatenate([kc_nope, k_nope], axis=1),
                          jnp.concatenate([cache_kr, apply_rope(k_rope, cos, sin)], axis=1),
                          jnp.concatenate([vc, v], axis=1))
    a_half, g_half = jnp.split(proj[..., o3:], 2, axis=-1)
    d = depthwise_conv(a_half * jax.nn.sigmoid(g_half), w_dw, b_dw)
    d = jax.nn.silu(layernorm(d, g_ln, b_ln))
    return jnp.concatenate([attn, d], axis=-1) @ w_out, ckv, k_rope


def setup_inputs(seed: int = 0) -> dict:
    key = jax.random.key(seed)
    ks = jax.random.split(key, 34)
    f32 = jnp.float32

    def nrm(k, shape, scale):
        return jax.random.normal(k, shape, f32) * scale

    dt0 = jnp.exp(jax.random.uniform(ks[19], (N_EVEN, 2, SSM_HEADS), f32,
                                     np.log(1e-3), np.log(1e-1)))
    return {
        'x_prompt': nrm(ks[0], (BATCH, SEQ, D_MODEL), 1.0),
        'x_sample': nrm(ks[1], (DEC_BATCH, DEC_SEQ, D_MODEL), 1.0),
        'state_ssd': nrm(ks[2], (DEC_BATCH, N_EVEN, 2, SSM_HEADS, SSM_HEAD_DIM, SSM_STATE), 0.5),
        'cache_mla_ckv': nrm(ks[3], (DEC_BATCH, N_ODD, PAST_LEN, MLA_KV_RANK), 1.0),
        'cache_mla_krope': nrm(ks[4], (DEC_BATCH, N_ODD, PAST_LEN, MLA_ROPE), 1.0),
        'c': nrm(ks[5], (DEC_BATCH, D_MODEL), 1.0),
        'c_ctx': nrm(ks[6], (D_MODEL,), 1.0),
        'w_mod': nrm(ks[7], (DEPTH, D_MODEL, N_MOD * D_MODEL), 0.5 * D_MODEL ** -0.5),
        'b_mod': nrm(ks[8], (DEPTH, N_MOD * D_MODEL), 0.02),
        'g_norm': 1.0 + nrm(ks[9], (DEPTH, 3, D_MODEL), 0.1),
        'w_ff_gu': nrm(ks[10], (DEPTH, 2, D_MODEL, 2 * D_FF), D_MODEL ** -0.5),
        'w_ff_down': nrm(ks[11], (DEPTH, 2, D_FF, D_MODEL), D_FF ** -0.5),
        'w_in_even': nrm(ks[12], (N_EVEN, D_MODEL, EVEN_IN), D_MODEL ** -0.5),
        'w_out_even': nrm(ks[13], (N_EVEN, EVEN_MIX, D_MODEL), EVEN_MIX ** -0.5),
        'w_spatial': nrm(ks[14], (N_EVEN, A_GROUPS, A_CHUNK, A_CHUNK), A_CHUNK ** -0.5),
        'b_spatial': 1.0 + nrm(ks[15], (N_EVEN, A_GROUPS, A_CHUNK), 0.1),
        'g_gmlp_v': 1.0 + nrm(ks[16], (N_EVEN, A_WIDTH), 0.1),
        'w_conv_ssm': nrm(ks[17], (N_EVEN, SSM_CONV, SSM_XBC), SSM_CONV ** -0.5),
        'b_conv_ssm': nrm(ks[18], (N_EVEN, SSM_XBC), 0.02),
        'dt_bias': dt0 + jnp.log(-jnp.expm1(-dt0)),
        'a_log': jnp.log(jax.random.uniform(ks[20], (N_EVEN, 2, SSM_HEADS), f32, 1.0, 16.0)),
        'd_skip': 1.0 + nrm(ks[21], (N_EVEN, 2, SSM_HEADS), 0.1),
        'g_ssm_out': 1.0 + nrm(ks[22], (N_EVEN, SSM_INNER), 0.1),
        'w_in_odd': nrm(ks[23], (N_ODD, D_MODEL, ODD_IN), D_MODEL ** -0.5),
        'w_out_odd': nrm(ks[24], (N_ODD, ODD_MIX, D_MODEL), ODD_MIX ** -0.5),
        'g_cq': 1.0 + nrm(ks[25], (N_ODD, MLA_Q_RANK), 0.1),
        'w_uq': nrm(ks[26], (N_ODD, MLA_Q_RANK, MLA_HEADS * (MLA_NOPE + MLA_ROPE)), MLA_Q_RANK ** -0.5),
        'g_ckv': 1.0 + nrm(ks[27], (N_ODD, MLA_KV_RANK), 0.1),
        'w_ukv': nrm(ks[28], (N_ODD, MLA_KV_RANK, MLA_HEADS * (MLA_NOPE + MLA_V)), MLA_KV_RANK ** -0.5),
        'w_dwconv': nrm(ks[29], (N_ODD, CONV_K, CONV_WIDTH), CONV_K ** -0.5),
        'b_dwconv': nrm(ks[30], (N_ODD, CONV_WIDTH), 0.02),
        'g_conv_ln': 1.0 + nrm(ks[31], (N_ODD, CONV_WIDTH), 0.1),
        'b_conv_ln': nrm(ks[32], (N_ODD, CONV_WIDTH), 0.02),
        'g_final': 1.0 + nrm(ks[33], (D_MODEL,), 0.1),
    }


def reference(x_prompt, x_sample, state_ssd, cache_mla_ckv, cache_mla_krope, c, c_ctx,
              w_mod, b_mod, g_norm, w_ff_gu, w_ff_down,
              w_in_even, w_out_even, w_spatial, b_spatial, g_gmlp_v, w_conv_ssm, b_conv_ssm,
              dt_bias, a_log, d_skip, g_ssm_out,
              w_in_odd, w_out_odd, g_cq, w_uq, g_ckv, w_ukv, w_dwconv, b_dwconv, g_conv_ln, b_conv_ln,
              g_final):
    bp = x_prompt.shape[0]
    xc, xs = x_prompt, x_sample
    rope_cos, rope_sin = rope_2d(x_sample.shape[1])
    silu_ctx = jax.nn.silu(c_ctx)
    silu_c = jax.nn.silu(c)
    new_ssd, new_ckv, new_kr = [], [], []
    for l in range(DEPTH):
        mc = jnp.split(silu_ctx @ w_mod[l] + b_mod[l], N_MOD, axis=-1)
        ms = jnp.split((silu_c @ w_mod[l] + b_mod[l])[:, None, :], N_MOD, axis=-1)
        xc = ffn_sublayer(xc, g_norm[l, 0], mc[0], mc[1], mc[2], w_ff_gu[l, 0], w_ff_down[l, 0])
        xs = ffn_sublayer(xs, g_norm[l, 0], ms[0], ms[1], ms[2], w_ff_gu[l, 0], w_ff_down[l, 0])
        hc = modulate(rmsnorm(xc, g_norm[l, 1]), mc[3], mc[4])
        hs = modulate(rmsnorm(xs, g_norm[l, 1]), ms[3], ms[4])
        i = l // 2
        if l % 2 == 0:
            ep = (w_in_even[i], w_out_even[i], w_spatial[i], b_spatial[i], g_gmlp_v[i],
                  w_conv_ssm[i], b_conv_ssm[i], dt_bias[i], a_log[i], d_skip[i], g_ssm_out[i])
            h0 = jnp.zeros((bp, SSM_HEADS, SSM_HEAD_DIM, SSM_STATE), hc.dtype)
            oc, hf, hb = ssd_gmlp_mixer(hc, *ep, h0, h0)
            os_, _, _ = ssd_gmlp_mixer(hs, *ep, state_ssd[:, i, 0].astype(hs.dtype),
                                       state_ssd[:, i, 1].astype(hs.dtype))
            new_ssd.append(jnp.stack([hf, hb], axis=1))
        else:
            op = (w_in_odd[i], w_out_odd[i], g_cq[i], w_uq[i], g_ckv[i], w_ukv[i],
                  w_dwconv[i], b_dwconv[i], g_conv_ln[i], b_conv_ln[i])
            oc, ckv, kr = mla_conv_mixer(hc, *op, None)
            os_, _, _ = mla_conv_mixer(hs, *op, (cache_mla_ckv[:, i].astype(hs.dtype),
                                                 cache_mla_krope[:, i].astype(hs.dtype),
                                                 rope_cos, rope_sin))
            new_ckv.append(ckv)
            new_kr.append(kr)
        xc = xc + mc[5] * oc
        xs = xs + ms[5] * os_
        xc = ffn_sublayer(xc, g_norm[l, 2], mc[6], mc[7], mc[8], w_ff_gu[l, 1], w_ff_down[l, 1])
        xs = ffn_sublayer(xs, g_norm[l, 2], ms[6], ms[7], ms[8], w_ff_gu[l, 1], w_ff_down[l, 1])
    y_prompt = rmsnorm(xc, g_final)
    y_sample = rmsnorm(xs, g_final)
    new_state_ssd = jnp.stack(new_ssd, axis=1)
    new_cache_mla_ckv = jnp.stack(new_ckv, axis=1)
    new_cache_mla_krope = jnp.stack(new_kr, axis=1)
    return (y_prompt, y_sample, new_state_ssd, new_cache_mla_ckv, new_cache_mla_krope)
```

```cpp
#include <hip/hip_runtime.h>
#include <cstdio>
#include <cstdint>
namespace pg8 {
#define PG8_LAS __attribute__((address_space(3)))
typedef unsigned short bf16_t;
typedef short bf16x8 __attribute__((ext_vector_type(8)));
typedef float f32x4 __attribute__((ext_vector_type(4)));
typedef unsigned u32x4 __attribute__((ext_vector_type(4)));
typedef unsigned u32x2 __attribute__((ext_vector_type(2)));
constexpr int BM = 256, BK = 64, HALF = 128, HTB = HALF * BK * 2  , STAGE_BYTES = 8 * HTB, NXCD = 8, WGM = 8;

__host__ __device__ __forceinline__ int lds_byte(int r, int c) { const int st = (r >> 4) * 2 + (c >> 5), rr = r & 15, cc = c & 31, ob = rr * 64 + cc * 2; return st * 1024 + (ob ^ (((ob >> 9) & 1) << 5)); }
__host__ __device__ __forceinline__ void stage_rc(int b, int& R, int& C) { const int st = b / 1024, sb = b % 1024, swz = sb ^ (((sb >> 9) & 1) << 5); R = (st >> 1) * 16 + swz / 64; C = (st & 1) * 32 + (swz % 64) / 2; }
__host__ __device__ __forceinline__ int perm32(int rho) { const int n = rho >> 4, i = rho & 15; return 8 * (i >> 2) + 4 * n + (i & 3); }

struct Unit { int pm, pn; };
struct Gemm { const bf16_t* A; const bf16_t* Bt; int M, N, K, lda, ldb; };

struct StaticOrder {
    int nM, nN, nwg, G, c;
    __host__ __device__ void init(int M, int N, int G_, int c_) { nM = M / BM; nN = N / BM; nwg = nM * nN; G = G_; c = c_; }
    __host__ __device__ bool next(int i, Unit& u) const {
        const long L = (long)i * G + c; if (L >= nwg) return false;
        int wgid = (int)L; { const int q = nwg / NXCD, r = nwg % NXCD, xcd = wgid % NXCD, off = wgid / NXCD; wgid = (xcd < r ? xcd * (q + 1) : r * (q + 1) + (xcd - r) * q) + off; }
        const int nig = WGM * nN, gid = wgid / nig, fm = gid * WGM, gsz = (nM - fm) < WGM ? (nM - fm) : WGM;
        u.pm = fm + ((wgid % nig) % gsz); u.pn = (wgid % nig) / gsz; return true;
    }
    __device__ __forceinline__ void a_ready(const Unit&) const {}
    __device__ __forceinline__ void done(const Unit&) const {}
};

__device__ __forceinline__ unsigned cvt_pk_bf16(float lo, float hi) { unsigned r; asm volatile("v_cvt_pk_bf16_f32 %0, %1, %2" : "=v"(r) : "v"(lo), "v"(hi)); return r; }

template <class Epi, class Sched, bool ALIGN_EPI>
__device__ __forceinline__ void gemm_phase(PG8_LAS unsigned char* lds, const int tid, const Gemm g, const Sched& S, const Epi& E) {
    const int wid = __builtin_amdgcn_readfirstlane(tid >> 6), lane = tid & 63, wr = wid >> 2, wc = wid & 3, fr = lane & 15, fq = lane >> 4;
    const int K = g.K, nt = K / BK;
    unsigned voffA[2], voffB[2];
#pragma unroll
    for (int i = 0; i < 2; ++i) { int R, C; stage_rc(tid * 16 + i * 8192, R, C); const int Rb = Epi::PERM ? ((R & ~31) + perm32(R & 31)) : R;
        voffA[i] = (unsigned)(R * g.lda + C) * 2u; voffB[i] = (unsigned)(Rb * g.ldb + C) * 2u; }
    const size_t kstep = (size_t)(BK * 2);
    const size_t hstepA = (size_t)HALF * g.lda * 2, hstepB = (size_t)HALF * g.ldb * 2;
    const size_t tstepA = 2 * hstepA, tstepB = 2 * hstepB;
    const unsigned ldsw = (unsigned)wid * 1024u;
    const int aoff = lds_byte(wr * 64 + fr, fq * 8), boff = lds_byte(wc * 32 + fr, fq * 8);
#define PG8_SA(b, h) (((b) * 2 + (h)) * HTB)
#define PG8_SB(b, h) ((4 + (b) * 2 + (h)) * HTB)
#define PG8_STAGE(bufoff, gbase, voff) do { _Pragma("unroll") for (int _i = 0; _i < 2; ++_i) \
        __builtin_amdgcn_global_load_lds((const unsigned*)((const char*)(gbase) + (voff)[_i]), (PG8_LAS unsigned*)(lds + (bufoff) + ldsw + _i * 8192), 16, 0, 0); } while (0)
#define PG8_LDA(dst, b, h) do { _Pragma("unroll") for (int m = 0; m < 4; ++m) _Pragma("unroll") for (int k = 0; k < 2; ++k) dst[m][k] = *(const PG8_LAS bf16x8*)(lds + PG8_SA(b, h) + aoff + m * 2048 + k * 1024); } while (0)
#define PG8_LDB(dst, b, h) do { _Pragma("unroll") for (int n = 0; n < 2; ++n) _Pragma("unroll") for (int k = 0; k < 2; ++k) dst[n][k] = *(const PG8_LAS bf16x8*)(lds + PG8_SB(b, h) + boff + n * 2048 + k * 1024); } while (0)
#define PG8_MMA(ai, bj, At, Bt) do { __builtin_amdgcn_s_setprio(1); _Pragma("unroll") for (int m = 0; m < 4; ++m) _Pragma("unroll") for (int n = 0; n < 2; ++n) _Pragma("unroll") for (int k = 0; k < 2; ++k) \
        acc[ai][bj][m][n] = __builtin_amdgcn_mfma_f32_16x16x32_bf16(Bt[n][k], At[m][k], acc[ai][bj][m][n], 0, 0, 0); __builtin_amdgcn_s_setprio(0); } while (0)
#define PG8_WAIT_V(n) asm volatile("s_waitcnt vmcnt(" #n ")" ::: "memory")
#define PG8_WAIT_L(n) asm volatile("s_waitcnt lgkmcnt(" #n ")" ::: "memory")
#define PG8_BAR __builtin_amdgcn_s_barrier()
#define PG8_SCHED __builtin_amdgcn_sched_barrier(0)
    Unit cur, nxt; int ui = 0;
    if (!S.next(0, cur)) return;
    f32x4 acc[2][2][4][2];
#pragma unroll
    for (int a = 0; a < 2; ++a)
#pragma unroll
        for (int b = 0; b < 2; ++b)
#pragma unroll
            for (int m = 0; m < 4; ++m)
#pragma unroll
                for (int n = 0; n < 2; ++n) acc[a][b][m][n] = (f32x4){0.f, 0.f, 0.f, 0.f};
    bf16x8 At[4][2], B0[2][2], B1[2][2];
    const char* cA = (const char*)g.A + (size_t)cur.pm * tstepA; const char* cB = (const char*)g.Bt + (size_t)cur.pn * tstepB;
    S.a_ready(cur);
    E.prefetch_sync(cur, tid, lds, 0); E.prefetch_dma(cur, wid, lane, lds, 0);
    PG8_STAGE(PG8_SB(0, 0), cB, voffB); PG8_STAGE(PG8_SB(0, 1), cB + hstepB, voffB); PG8_STAGE(PG8_SA(0, 0), cA, voffA); PG8_STAGE(PG8_SA(0, 1), cA + hstepA, voffA);
    if (wr == 1) PG8_BAR;
    PG8_WAIT_V(2); PG8_BAR;
    PG8_STAGE(PG8_SB(1, 0), cB + kstep, voffB); PG8_STAGE(PG8_SA(1, 0), cA + kstep, voffA); PG8_STAGE(PG8_SB(1, 1), cB + hstepB + kstep, voffB);
    PG8_WAIT_V(6); PG8_BAR;
    for (;;) {
        const bool has_next = S.next(ui + 1, nxt);
        const char* nA = has_next ? (const char*)g.A + (size_t)nxt.pm * tstepA : cA; const char* nB = has_next ? (const char*)g.Bt + (size_t)nxt.pn * tstepB : cB;
        for (int t = 0; t < nt; t += 2) {
            const bool last = (t == nt - 2);
            const char* a1 = cA + (size_t)(t + 1) * kstep;
            const char* a2 = last ? nA : cA + (size_t)(t + 2) * kstep; const char* b2 = last ? nB : cB + (size_t)(t + 2) * kstep;
            const char* a3 = a2 + kstep; const char* b3 = b2 + kstep;
            if (last && has_next) { S.a_ready(nxt); E.prefetch_dma(nxt, wid, lane, lds, (ui + 1) & 1); }
            PG8_LDB(B0, 0, 0); PG8_LDB(B1, 0, 1); PG8_SCHED; PG8_LDA(At, 0, 0); PG8_STAGE(PG8_SA(1, 1), a1 + hstepA, voffA);
            PG8_WAIT_V(8); PG8_WAIT_L(0); PG8_BAR; PG8_MMA(0, 0, At, B0); PG8_MMA(0, 1, At, B1); PG8_BAR; PG8_SCHED;
            PG8_LDA(At, 0, 1); PG8_STAGE(PG8_SB(0, 0), b2, voffB); PG8_STAGE(PG8_SB(0, 1), b2 + hstepB, voffB); PG8_STAGE(PG8_SA(0, 0), a2, voffA);
            PG8_WAIT_V(8); PG8_WAIT_L(0); PG8_BAR; PG8_MMA(1, 0, At, B0); PG8_MMA(1, 1, At, B1); PG8_BAR; PG8_SCHED;
            PG8_LDB(B0, 1, 0); PG8_LDB(B1, 1, 1); PG8_SCHED; PG8_LDA(At, 1, 0); PG8_STAGE(PG8_SA(0, 1), a2 + hstepA, voffA);
            PG8_WAIT_V(8); PG8_WAIT_L(0); PG8_BAR; PG8_MMA(0, 0, At, B0); PG8_MMA(0, 1, At, B1); PG8_BAR; PG8_SCHED;
            PG8_LDA(At, 1, 1); PG8_STAGE(PG8_SB(1, 0), b3, voffB); PG8_STAGE(PG8_SB(1, 1), b3 + hstepB, voffB); PG8_STAGE(PG8_SA(1, 0), a3, voffA);
            PG8_WAIT_V(8); PG8_WAIT_L(0); PG8_BAR; PG8_MMA(1, 0, At, B0); PG8_MMA(1, 1, At, B1); PG8_BAR; PG8_SCHED;
        }
        if constexpr (ALIGN_EPI) { if (wr == 0) PG8_BAR; }
        E(acc, cur, wr, wc, fr, fq, lds, ui & 1);
        if (!has_next) break;
#pragma unroll
        for (int a = 0; a < 2; ++a)
#pragma unroll
            for (int b = 0; b < 2; ++b)
#pragma unroll
                for (int m = 0; m < 4; ++m)
#pragma unroll
                    for (int n = 0; n < 2; ++n) acc[a][b][m][n] = (f32x4){0.f, 0.f, 0.f, 0.f};
        cur = nxt; cA = nA; cB = nB; ++ui;
        E.prefetch_sync(cur, tid, lds, ui & 1);
        if constexpr (ALIGN_EPI) { if (wr == 1) PG8_BAR; }
    }
    PG8_WAIT_V(0);
    if constexpr (!ALIGN_EPI) { if (wr == 0) PG8_BAR; }
    PG8_BAR;
#undef PG8_SA
#undef PG8_SB
#undef PG8_STAGE
#undef PG8_LDA
#undef PG8_LDB
#undef PG8_MMA
#undef PG8_WAIT_V
#undef PG8_WAIT_L
#undef PG8_BAR
#undef PG8_SCHED
}
}
constexpr int NWAVES = 8, NTHR = 512;
constexpr int D = 1024, TCTX = 8192, TSMP = 2048, T = 10240, TP = T + 512;
constexpr int DFF = 2816, NMODV = 9 * 1024;
constexpr int EVEN_NP = 2816, ODD_NP = 1792;
constexpr float EPS = 1e-6f;
constexpr int NCHUNK = 80;

constexpr size_t MiB = 1u << 20;
constexpr size_t WS_CTL = 0, CTL_ZERO_BYTES = 64 * 1024;
constexpr size_t WS_MOD = 1 * MiB;
constexpr size_t WS_ROPE = WS_MOD + 512 * 1024;
constexpr size_t WS_DEC = WS_ROPE + 160 * 1024;
constexpr size_t WS_SSQ = WS_MOD + 768 * 1024;
constexpr size_t WS_BIAS = 2 * MiB;
constexpr size_t BIAS_LD = 5632, BIAS_MS = 16 * BIAS_LD;
constexpr size_t WS_BIASF = 15 * MiB;
constexpr size_t WS_WGU = 16 * MiB;
constexpr size_t SZ_WGU = (size_t)5632 * 1024 * 2;
constexpr size_t WS_WD = WS_WGU + 8 * SZ_WGU;
constexpr size_t SZ_WD = (size_t)1024 * 2816 * 2;
constexpr size_t WS_WIE = WS_WD + 8 * SZ_WD;
constexpr size_t SZ_WIE = (size_t)EVEN_NP * 1024 * 2;
constexpr size_t WS_WOE = WS_WIE + 2 * SZ_WIE;
constexpr size_t SZ_WO = (size_t)1024 * 1024 * 2;
constexpr size_t WS_WIO = WS_WOE + 2 * SZ_WO;
constexpr size_t SZ_WIO = (size_t)ODD_NP * 1024 * 2;
constexpr size_t WS_WOO = WS_WIO + 2 * SZ_WIO;
constexpr size_t WS_WUQ = WS_WOO + 2 * SZ_WO;
constexpr size_t SZ_WUQ = (size_t)768 * 384 * 2;
constexpr size_t WS_WKV = WS_WUQ + 2 * SZ_WUQ;
constexpr size_t SZ_WKV = (size_t)1024 * 256 * 2;
constexpr size_t WS_WEND = WS_WKV + 2 * SZ_WKV;
constexpr size_t WS_X = (WS_WEND + MiB - 1) / MiB * MiB;
constexpr size_t WS_XA = WS_X + (size_t)T * D * 4;
constexpr size_t WS_PROJ = WS_XA + (size_t)T * D * 2;
constexpr size_t WS_YMIX = WS_PROJ + (size_t)T * EVEN_NP * 2;
constexpr size_t WS_H = WS_YMIX + (size_t)T * D * 2;
constexpr size_t WS_ST = WS_H;
constexpr size_t WS_QA = WS_H;
constexpr size_t WS_CKVA = WS_QA + (size_t)T * 384 * 2;
constexpr size_t WS_KR = WS_CKVA + (size_t)TP * 256 * 2;
constexpr size_t WS_Q = WS_KR + (size_t)TP * 32 * 2;
constexpr size_t WS_KN = WS_Q + (size_t)T * 768 * 2;
constexpr size_t WS_VT = WS_KN + (size_t)TP * 512 * 2;
constexpr size_t WS_HEND = WS_H + (size_t)T * DFF * 2;
static_assert(WS_VT + (size_t)512 * TP * 2 <= WS_HEND, "odd-layer scratch fits the H overlay");
static_assert(WS_ST + (size_t)NCHUNK * 8 * 2 * 8192 * 4 <= WS_HEND, "chunk states fit the H overlay");
constexpr size_t WS_XCT = WS_HEND;
constexpr size_t WS_CC = WS_XCT + (size_t)NCHUNK * 8 * 8192 * 2;
constexpr size_t WS_CBM = WS_CC + (size_t)T * 256 * 2;
constexpr size_t WS_HIN = WS_CBM + (size_t)NCHUNK * 2 * 16384 * 2;
constexpr size_t WS_END = WS_HIN + (size_t)NCHUNK * 8 * 2 * 8192 * 2;

constexpr size_t OUT_Y = 0, OUT_SSD = (size_t)T * D, OUT_CKV = OUT_SSD + (size_t)32 * 2 * 2 * 8 * 64 * 128, OUT_KR = OUT_CKV + (size_t)32 * 2 * 256 * 256, OUT_END = OUT_KR + (size_t)32 * 2 * 256 * 32;

constexpr int RING_BYTES = 131072;
constexpr int LDSCTL_OFF = 144 * 1024 - 512, MISC_OFF = LDSCTL_OFF + 320;
constexpr int LDS_BYTES = 147456;

#define GAS __attribute__((address_space(1)))
#define LAS __attribute__((address_space(3)))
typedef unsigned short bf16;
typedef unsigned v4u __attribute__((ext_vector_type(4)));
typedef unsigned v2u __attribute__((ext_vector_type(2)));
typedef float f32x4 __attribute__((ext_vector_type(4)));
typedef short bf16x8 __attribute__((ext_vector_type(8)));
typedef GAS unsigned gu32;
#define RLX_AGENT __ATOMIC_RELAXED, __HIP_MEMORY_SCOPE_AGENT
__device__ __forceinline__ unsigned f2bf(float f) { unsigned u = __builtin_bit_cast(unsigned, f); return (u + 0x7fffu + ((u >> 16) & 1u)) >> 16; }
typedef float f32x2_t __attribute__((ext_vector_type(2)));
typedef __bf16 bf16x2_t __attribute__((ext_vector_type(2)));
__device__ __forceinline__ unsigned pk2(float lo, float hi) { const f32x2_t v = {lo, hi}; const bf16x2_t b = __builtin_convertvector(v, bf16x2_t); return __builtin_bit_cast(unsigned, b); }
__device__ __forceinline__ unsigned f2bf1(float f) { return pk2(f, 0.f) & 0xffffu; }
__device__ __forceinline__ float bflo(unsigned w) { return __builtin_bit_cast(float, w << 16); }
__device__ __forceinline__ float bfhi(unsigned w) { return __builtin_bit_cast(float, w & 0xffff0000u); }
__device__ __forceinline__ float bf1(bf16 h) { return __builtin_bit_cast(float, ((unsigned)h) << 16); }
__device__ __forceinline__ void unpack8(const v4u v, float* o) { o[0] = bflo(v.x); o[1] = bfhi(v.x); o[2] = bflo(v.y); o[3] = bfhi(v.y); o[4] = bflo(v.z); o[5] = bfhi(v.z); o[6] = bflo(v.w); o[7] = bfhi(v.w); }
__device__ __forceinline__ v4u pack8(const float* o) { v4u v; v.x = pk2(o[0], o[1]); v.y = pk2(o[2], o[3]); v.z = pk2(o[4], o[5]); v.w = pk2(o[6], o[7]); return v; }
template <int K> __device__ __forceinline__ float xlane(float v) { static_assert(K >= 1 && K < 32, "xor mask inside a 32-lane half");
    return __builtin_bit_cast(float, __builtin_amdgcn_ds_swizzle(__builtin_bit_cast(int, v), (K << 10) | 0x1F)); }
__device__ __forceinline__ float sum_x32(float v) { const unsigned u = __builtin_bit_cast(unsigned, v); const auto r = __builtin_amdgcn_permlane32_swap(u, u, false, false);
    return __builtin_bit_cast(float, (unsigned)r[0]) + __builtin_bit_cast(float, (unsigned)r[1]); }
__device__ __forceinline__ float max_x32(float v) { const unsigned u = __builtin_bit_cast(unsigned, v); const auto r = __builtin_amdgcn_permlane32_swap(u, u, false, false);
    return fmaxf(__builtin_bit_cast(float, (unsigned)r[0]), __builtin_bit_cast(float, (unsigned)r[1])); }
__device__ __forceinline__ float wave_sum(float v) {
    v += xlane<1>(v); v += xlane<2>(v); v += xlane<4>(v); v += xlane<8>(v); v += xlane<16>(v);
    return sum_x32(v);
}
__device__ __forceinline__ float frcp(float x) { return __builtin_amdgcn_rcpf(x); }
__device__ __forceinline__ float frsq(float x) { return __builtin_amdgcn_rsqf(x); }
__device__ __forceinline__ float sigmoidf_(float x) { return frcp(1.0f + __expf(-x)); }
__device__ __forceinline__ float siluf_(float x) { return x * frcp(1.0f + __expf(-x)); }
__device__ __forceinline__ float gelu_tanh(float x) { const float y = 0.7978845608028654f * (x + 0.044715f * x * x * x); const float t = 1.0f - 2.0f * frcp(1.0f + __expf(2.0f * y)); return 0.5f * x * (1.0f + t); }
__device__ __forceinline__ float softplusf_(float x) { const float e = __expf(x); return x > 20.f ? x : (e < 1e-3f ? e * (1.0f - 0.5f * e) : __logf(1.0f + e)); }
__device__ __forceinline__ int modrow_of_tile(int pm) { return pm < 32 ? 0 : 1 + ((pm - 32) >> 2); }
__device__ __forceinline__ int modrow_of_tok(int t) { return t < TCTX ? 0 : 1 + ((t - TCTX) >> 10); }

#define XB_TMO      128
#define XB_XCNT(j)  (256  + 64 * (j))
#define XB_XSUB(j)  (1280 + 64 * (j))
#define XB_XGEN(j)  (2304 + 64 * (j))
#define XB_TOP      3328
#define XB_TOPGEN   3392
#define XCD_BAR_WORDS 3456
#define XB_SPIN_CAP (1u << 22)
__device__ __forceinline__ unsigned xb_ld(unsigned* p)              { return __hip_atomic_load(p, __ATOMIC_RELAXED, __HIP_MEMORY_SCOPE_AGENT); }
__device__ __forceinline__ unsigned xb_add(unsigned* p, unsigned v) { return __hip_atomic_fetch_add(p, v, __ATOMIC_RELAXED, __HIP_MEMORY_SCOPE_AGENT); }
__device__ __forceinline__ unsigned xb_xcc_id() { return (unsigned)__builtin_amdgcn_s_getreg((3 << 11) | 20) & 0xFu; }
#define XB_SPIN(cond, bar) do { unsigned _sp = 0; while (cond) { __builtin_amdgcn_s_sleep(1); \
    if ((++_sp & 255u) == 0u) { if (xb_ld(&(bar)[XB_TMO])) break; if (_sp > XB_SPIN_CAP) { atomicAdd(&(bar)[XB_TMO], 1u); break; } } } } while (0)
struct XcdBarrier { unsigned* bar; unsigned x; volatile LAS unsigned* st; };
__device__ __forceinline__ XcdBarrier xcd_barrier_post(unsigned* bar, volatile LAS unsigned* st) {
    XcdBarrier b; b.bar = bar; b.x = xb_xcc_id(); b.st = st;
    if (threadIdx.x == 0) (void)xb_add(&bar[XB_XCNT(b.x)], 1u);
    return b;
}
__device__ __forceinline__ void xcd_barrier_complete(unsigned* bar, unsigned x, unsigned& nloc, unsigned& nx) {
    const unsigned G = gridDim.x * gridDim.y * gridDim.z;
    unsigned sum, cnt, mine, sp = 0u;
    for (;;) {
        sum = 0u; cnt = 0u; mine = 0u;
#pragma unroll
        for (unsigned j = 0; j < 16; ++j) { const unsigned c = xb_ld(&bar[XB_XCNT(j)]); sum += c; cnt += (c > 0u) ? 1u : 0u; mine = (j == x) ? c : mine; }
        if (sum == G) break;
        __builtin_amdgcn_s_sleep(1);
        if ((++sp & 255u) == 0u) { if (xb_ld(&bar[XB_TMO])) break; if (sp > XB_SPIN_CAP) { atomicAdd(&bar[XB_TMO], 1u); break; } }
    }
    nloc = mine > 0u ? mine : 1u; nx = cnt > 0u ? cnt : 1u;
}
__device__ __forceinline__ void xcd_barrier(const XcdBarrier& b) {
    asm volatile("s_waitcnt vmcnt(0)" ::: "memory");
    __syncthreads();
    if (threadIdx.x == 0) {
        unsigned* bar = b.bar;
        __builtin_amdgcn_s_waitcnt(0);
        unsigned nloc = b.st[0], nx = b.st[1];
        if (nloc == 0u) { xcd_barrier_complete(bar, b.x, nloc, nx); b.st[0] = nloc; b.st[1] = nx; }
        const unsigned old = xb_add(&bar[XB_XSUB(b.x)], 1u);
        const unsigned gen = old / nloc;
        if (old + 1u == (gen + 1u) * nloc) {
            __builtin_amdgcn_fence(__ATOMIC_RELEASE, "agent");
            asm volatile("s_waitcnt vmcnt(0)" ::: "memory");
            const unsigned og = xb_add(&bar[XB_TOP], 1u);
            const unsigned tg = og / nx;
            if (og + 1u == (tg + 1u) * nx) xb_add(&bar[XB_TOPGEN], 1u);
            else XB_SPIN(xb_ld(&bar[XB_TOPGEN]) == tg, bar);
            __builtin_amdgcn_fence(__ATOMIC_ACQUIRE, "agent");
            xb_add(&bar[XB_XGEN(b.x)], 1u);
            asm volatile("s_waitcnt vmcnt(0)" ::: "memory");
        } else {
            XB_SPIN(xb_ld(&bar[XB_XGEN(b.x)]) == gen, bar);
            __builtin_amdgcn_fence(__ATOMIC_ACQUIRE, "agent");
            asm volatile("s_waitcnt vmcnt(0)" ::: "memory");
        }
    }
    __syncthreads();
}

struct Args { const float* in[34]; float* out; unsigned char* ws; int ph_lo, ph_hi, li, pad; };
typedef const __attribute__((address_space(4))) Args* CArgsP;
enum { I_XP = 0, I_XS, I_SSD, I_CCKV, I_CKR, I_C, I_CCTX, I_WMOD, I_BMOD, I_GNORM, I_WGU, I_WDN, I_WIE, I_WOE, I_WSP, I_BSP, I_GV, I_WCS, I_BCS, I_DTB, I_ALOG, I_DSK, I_GSO,
       I_WIO, I_WOO, I_GCQ, I_WUQ, I_GCKV, I_WUKV, I_WDW, I_BDW, I_GLN, I_BLN, I_GFIN };
using pg8::Unit;
constexpr int EP_PART = RING_BYTES, EP_S = RING_BYTES + 4096, EP_B = RING_BYTES + 4096 + 8192;
__device__ __forceinline__ void epi_prefetch_dma(GAS unsigned char* ws, int bias_off, const Unit& u, int wid, int lane, PG8_LAS unsigned char* ldsl, int par) {
    if (wid < 4) __builtin_amdgcn_global_load_lds((const GAS unsigned*)(ws + WS_SSQ + ((size_t)(u.pm * 256 + 64 * wid + lane) * 4) * 4), (PG8_LAS unsigned*)(ldsl + EP_S + par * 4096 + wid * 1024), 16, 0, 0);
    else if (wid == 4) __builtin_amdgcn_global_load_lds((const GAS unsigned*)(ws + WS_BIASF + ((size_t)bias_off / 16 + (size_t)modrow_of_tile(u.pm) * BIAS_LD + u.pn * 256 + 4 * lane) * 4), (PG8_LAS unsigned*)(ldsl + EP_B + par * 1024), 16, 0, 0);
}
__device__ __forceinline__ void epi_prefetch_sync16(GAS unsigned char* ws, int bias_off, const Unit& u, int tid, PG8_LAS unsigned char* ldsl, int par) {
    if (tid < 256) *(PG8_LAS pg8::f32x4*)(ldsl + EP_S + par * 4096 + tid * 16) = *(const GAS pg8::f32x4*)(ws + WS_SSQ + ((size_t)(u.pm * 256 + tid) * 4) * 4);
    else { const GAS float* bp = (const GAS float*)(ws + WS_BIAS) + (size_t)bias_off + (size_t)modrow_of_tile(u.pm) * BIAS_MS + u.pn * 256 + (tid - 256); float b = 0.f;
#pragma unroll
        for (int kb = 0; kb < 16; ++kb) b += bp[(size_t)kb * BIAS_LD];
        ((PG8_LAS float*)(ldsl + EP_B))[par * 256 + (tid - 256)] = b; }
}
__device__ __forceinline__ float epi_row_rstd(const PG8_LAS unsigned char* ldsl, int par, int rl) { const pg8::f32x4 s = *(const PG8_LAS pg8::f32x4*)(ldsl + EP_S + par * 4096 + rl * 16); return frsq(((s[0] + s[1]) + (s[2] + s[3])) * (1.f / D) + EPS); }
struct EpiSwiglu {
    static constexpr bool PERM = true;
    GAS unsigned char* ws; int bias_off, nparts;
    __device__ __forceinline__ void prefetch_dma(const Unit& u, int wid, int lane, PG8_LAS unsigned char* ldsl, int par) const { if (nparts == 1) epi_prefetch_dma(ws, bias_off, u, wid, lane, ldsl, par); }
    __device__ __forceinline__ void prefetch_sync(const Unit& u, int tid, PG8_LAS unsigned char* ldsl, int par) const { if (nparts != 1) epi_prefetch_sync16(ws, bias_off, u, tid, ldsl, par); }
    __device__ __forceinline__ void operator()(const pg8::f32x4 (&acc)[2][2][4][2], const Unit& u, int wr, int wc, int fr, int fq, PG8_LAS unsigned char* ldsl, int par) const {
        bf16* H = (bf16*)(GAS bf16*)(ws + WS_H);
        const PG8_LAS float* bb = (const PG8_LAS float*)(ldsl + EP_B) + par * 256 + wc * 32 + 8 * fq;
        const int row0 = u.pm * 256 + wr * 64 + fr, col0 = u.pn * 128 + wc * 32 + 8 * fq;
        const pg8::f32x4 bg0 = *(const PG8_LAS pg8::f32x4*)bb, bg1 = *(const PG8_LAS pg8::f32x4*)(bb + 4), bu0 = *(const PG8_LAS pg8::f32x4*)(bb + 128), bu1 = *(const PG8_LAS pg8::f32x4*)(bb + 132);
#pragma unroll
        for (int ai = 0; ai < 2; ++ai)
#pragma unroll
            for (int m = 0; m < 4; ++m) {
                const int rl = ai * 128 + wr * 64 + m * 16 + fr;
                const float rs = epi_row_rstd(ldsl, par, rl);
                bf16* rowp = H + (size_t)(u.pm * 256 + rl) * DFF + col0;
                const pg8::f32x4 g0 = acc[ai][0][m][0] * rs + bg0, g1 = acc[ai][0][m][1] * rs + bg1, u0 = acc[ai][1][m][0] * rs + bu0, u1 = acc[ai][1][m][1] * rs + bu1;
                float gg[8], uu[8], e[8], o[8];
#pragma unroll
                for (int j = 0; j < 4; ++j) { gg[j] = g0[j]; gg[4 + j] = g1[j]; uu[j] = u0[j]; uu[4 + j] = u1[j]; }
#pragma unroll
                for (int j = 0; j < 8; ++j) e[j] = __builtin_amdgcn_exp2f(gg[j] * -1.4426950408889634f);
#pragma unroll
                for (int j = 0; j < 8; ++j) e[j] = __builtin_amdgcn_rcpf(1.0f + e[j]);
#pragma unroll
                for (int j = 0; j < 8; ++j) o[j] = (gg[j] * uu[j]) * e[j];
                pg8::u32x4 w; w.x = pg8::cvt_pk_bf16(o[0], o[1]); w.y = pg8::cvt_pk_bf16(o[2], o[3]); w.z = pg8::cvt_pk_bf16(o[4], o[5]); w.w = pg8::cvt_pk_bf16(o[6], o[7]);
                *(pg8::u32x4*)rowp = w;
            }
        (void)row0;
    }
};
struct EpiResid {
    static constexpr bool PERM = true;
    GAS unsigned char* ws; const float* gn; int gate_off, scn_off; float coef;
    __device__ __forceinline__ void prefetch_dma(const Unit&, int, int, PG8_LAS unsigned char*, int) const {}
    __device__ __forceinline__ void prefetch_sync(const Unit&, int, PG8_LAS unsigned char*, int) const {}
    __device__ __forceinline__ void operator()(const pg8::f32x4 (&acc)[2][2][4][2], const Unit& u, int wr, int wc, int fr, int fq, PG8_LAS unsigned char* ldsl, int) const {
        bf16* X = (bf16*)(GAS bf16*)(ws + WS_X); const float* gate = (const float*)(const GAS float*)(ws + WS_MOD) + gate_off; const float* scn = (const float*)(const GAS float*)(ws + WS_MOD) + scn_off;
        bf16* XA = (bf16*)(GAS bf16*)(ws + WS_XA); float* SSQ = (float*)(GAS float*)(ws + WS_SSQ); PG8_LAS float* part = (PG8_LAS float*)(ldsl + EP_PART);
        const int row0 = u.pm * 256 + wr * 64 + fr, col0 = u.pn * 256 + wc * 32 + 8 * fq;
        const int mr = modrow_of_tile(u.pm);
        float ss[2][4];
#pragma unroll
        for (int ai = 0; ai < 2; ++ai)
#pragma unroll
            for (int m = 0; m < 4; ++m) ss[ai][m] = 0.f;
#pragma unroll
        for (int bj = 0; bj < 2; ++bj) {
            const int co = col0 + bj * 128;
            const float* gp = gate + (size_t)mr * NMODV + co; const float* sp = scn + (size_t)mr * NMODV + co;
            const pg8::f32x4 gv0 = *(const pg8::f32x4*)gp * coef, gv1 = *(const pg8::f32x4*)(gp + 4) * coef;
            const pg8::f32x4 gc0 = *(const pg8::f32x4*)(gn + co) * (*(const pg8::f32x4*)sp + 1.0f), gc1 = *(const pg8::f32x4*)(gn + co + 4) * (*(const pg8::f32x4*)(sp + 4) + 1.0f);
#pragma unroll
            for (int ai = 0; ai < 2; ++ai) {
                pg8::u32x4 xo[4];
#pragma unroll
                for (int m = 0; m < 4; ++m) xo[m] = *(const pg8::u32x4*)(X + (size_t)(row0 + ai * 128 + m * 16) * D + co);
#pragma unroll
                for (int m = 0; m < 4; ++m) {
                    const size_t off = (size_t)(row0 + ai * 128 + m * 16) * D + co;
                    const pg8::u32x4 xw = xo[m];
                    const pg8::f32x4 x0 = {bflo(xw.x), bfhi(xw.x), bflo(xw.y), bfhi(xw.y)}, x1 = {bflo(xw.z), bfhi(xw.z), bflo(xw.w), bfhi(xw.w)};
                    const pg8::f32x4 n0 = x0 + gv0 * acc[ai][bj][m][0], n1 = x1 + gv1 * acc[ai][bj][m][1];
                    ss[ai][m] += ((n0[0] * n0[0] + n0[1] * n0[1]) + (n0[2] * n0[2] + n0[3] * n0[3])) + ((n1[0] * n1[0] + n1[1] * n1[1]) + (n1[2] * n1[2] + n1[3] * n1[3]));
                    pg8::u32x4 w; w.x = pg8::cvt_pk_bf16(n0[0], n0[1]); w.y = pg8::cvt_pk_bf16(n0[2], n0[3]); w.z = pg8::cvt_pk_bf16(n1[0], n1[1]); w.w = pg8::cvt_pk_bf16(n1[2], n1[3]);
                    *(pg8::u32x4*)(X + off) = w;
                    const pg8::f32x4 a0 = n0 * gc0, a1 = n1 * gc1;
                    pg8::u32x4 v; v.x = pg8::cvt_pk_bf16(a0[0], a0[1]); v.y = pg8::cvt_pk_bf16(a0[2], a0[3]); v.z = pg8::cvt_pk_bf16(a1[0], a1[1]); v.w = pg8::cvt_pk_bf16(a1[2], a1[3]);
                    *(pg8::u32x4*)(XA + off) = v;
                }
            }
        }
#pragma unroll
        for (int ai = 0; ai < 2; ++ai)
#pragma unroll
            for (int m = 0; m < 4; ++m) { float s = ss[ai][m]; s += xlane<16>(s); s = sum_x32(s);
                if (fq == 0) part[wc * 256 + ai * 128 + wr * 64 + m * 16 + fr] = s; }
        asm volatile("s_waitcnt lgkmcnt(0)" ::: "memory"); __builtin_amdgcn_s_barrier(); asm volatile("" ::: "memory");
        const int t = (wr * 4 + wc) * 64 + fq * 16 + fr;
        if (t < 256) SSQ[(size_t)(u.pm * 256 + t) * 4 + u.pn] = (part[t] + part[256 + t]) + (part[512 + t] + part[768 + t]);
    }
};
struct EpiStore {
    static constexpr bool PERM = true;
    GAS unsigned char* ws; unsigned o_off; int ldc; int bias_off;
    __device__ __forceinline__ void prefetch_dma(const Unit& u, int wid, int lane, PG8_LAS unsigned char* ldsl, int par) const { if (bias_off >= 0) epi_prefetch_dma(ws, bias_off, u, wid, lane, ldsl, par); }
    __device__ __forceinline__ void prefetch_sync(const Unit&, int, PG8_LAS unsigned char*, int) const {}
    __device__ __forceinline__ void operator()(const pg8::f32x4 (&acc)[2][2][4][2], const Unit& u, int wr, int wc, int fr, int fq, PG8_LAS unsigned char* ldsl, int par) const {
        bf16* O = (bf16*)(GAS bf16*)(ws + o_off);
        const PG8_LAS float* bb = (const PG8_LAS float*)(ldsl + EP_B) + par * 256 + wc * 32 + 8 * fq;
        const int col0 = u.pn * 256 + wc * 32 + 8 * fq; const bool nrm = bias_off >= 0;
        pg8::f32x4 b[2][2];
#pragma unroll
        for (int bj = 0; bj < 2; ++bj)
#pragma unroll
            for (int n = 0; n < 2; ++n) { const pg8::f32x4 bv = *(const PG8_LAS pg8::f32x4*)(bb + bj * 128 + 4 * n); b[bj][n] = nrm ? bv : (pg8::f32x4){0.f, 0.f, 0.f, 0.f}; }
#pragma unroll
        for (int ai = 0; ai < 2; ++ai)
#pragma unroll
            for (int m = 0; m < 4; ++m) {
                const int rl = ai * 128 + wr * 64 + m * 16 + fr;
                const float rs0 = epi_row_rstd(ldsl, par, rl), rs = nrm ? rs0 : 1.0f;
                bf16* rowp = O + (size_t)(u.pm * 256 + rl) * ldc + col0;
#pragma unroll
                for (int bj = 0; bj < 2; ++bj) {
                    const pg8::f32x4 v0 = acc[ai][bj][m][0] * rs + b[bj][0], v1 = acc[ai][bj][m][1] * rs + b[bj][1];
                    pg8::u32x4 w; w.x = pg8::cvt_pk_bf16(v0[0], v0[1]); w.y = pg8::cvt_pk_bf16(v0[2], v0[3]); w.z = pg8::cvt_pk_bf16(v1[0], v1[1]); w.w = pg8::cvt_pk_bf16(v1[2], v1[3]);
                    *(pg8::u32x4*)(rowp + bj * 128) = w;
                }
            }
    }
};

struct Frame {
    unsigned char* lds;
    mutable int tid, lane; int wave, bid, G;
    __device__ __forceinline__ void relane() const { int ln; asm volatile("v_mbcnt_lo_u32_b32 %0, -1, 0\n\tv_mbcnt_hi_u32_b32 %0, -1, %0" : "=v"(ln)); lane = ln; tid = wave * 64 + ln; }
    CArgsP a;
    GAS unsigned char* ws;
};
#define WSP(type, off) ((type*)(GAS type*)(F.ws + (off)))
#define AIN(i) ((const float*)(const GAS float*)F.a->in[i])
#define AOUT ((float*)(GAS float*)F.a->out)

__device__ __forceinline__ void p0_transpose_item(const float* W, int N, bf16* WT, int ldt, int k0, int n0, int dst_row0, float* scr, int lane, const float* shift, float* bias_out) {
    const int n = n0 + (lane & 31); const bool ok = n < N;
#pragma unroll 8
    for (int i = 0; i < 32; ++i) { const int kk = 2 * i + (lane >> 5); scr[kk * 33 + (lane & 31)] = ok ? W[(size_t)(k0 + kk) * N + n] : 0.f; }
    if (bias_out) {
#pragma unroll
        for (int m = 0; m < 3; ++m) scr[64 * 33 + m * 64 + lane] = shift[(size_t)m * NMODV + lane];
    }
    asm volatile("s_waitcnt lgkmcnt(0)" ::: "memory");
    const int c = lane & 7;
#pragma unroll
    for (int j = 0; j < 4; ++j) { const int nn = (lane >> 3) + 8 * j; const float* s = scr + (8 * c) * 33 + nn;
        v4u o; o.x = pk2(s[0 * 33], s[1 * 33]); o.y = pk2(s[2 * 33], s[3 * 33]); o.z = pk2(s[4 * 33], s[5 * 33]); o.w = pk2(s[6 * 33], s[7 * 33]);
        *(v4u*)(WT + (size_t)(dst_row0 + nn) * ldt + k0 + 8 * c) = o; }
    if (bias_out) {
        const int kh = lane >> 5, nl = lane & 31; float a0 = 0.f, a1 = 0.f, a2 = 0.f;
#pragma unroll 8
        for (int i = 0; i < 32; ++i) { const int kk = kh * 32 + i; const float wv = scr[kk * 33 + nl];
            a0 += wv * scr[64 * 33 + kk]; a1 += wv * scr[64 * 33 + 64 + kk]; a2 += wv * scr[64 * 33 + 128 + kk]; }
        a0 = sum_x32(a0); a1 = sum_x32(a1); a2 = sum_x32(a2);
        if (lane < 32) { float* bo = bias_out + (size_t)(k0 >> 6) * BIAS_LD + dst_row0 + nl; bo[0] = a0; bo[BIAS_MS] = a1; bo[2 * BIAS_MS] = a2; }
    }
    asm volatile("s_waitcnt lgkmcnt(0)" ::: "memory");
}
constexpr int CI_DN = 44 * 32, CI_OE = 16 * 32, CI_UQ = 6 * 24, CI_KV = 4 * 32, CI_GU = 16 * 176, CI_IE = 16 * 88, CI_IO = 16 * 56;
__host__ __device__ constexpr int conv_na(int l) { return 2 * CI_DN + CI_OE + ((l & 1) ? CI_UQ + CI_KV : 0); }
__host__ __device__ constexpr int conv_nb(int l) { return 2 * CI_GU + ((l & 1) ? CI_IO : CI_IE); }
__device__ __forceinline__ void conv_item_a(const Frame& F, int l, int it, float* scr) {
    int r = it; const int hi = l >> 1;
    if (r < 2 * CI_DN) { const int w = l * 2 + r / CI_DN, q = r % CI_DN, kb = q / 32, nb = q % 32;
        p0_transpose_item(AIN(I_WDN) + (size_t)w * DFF * 1024, 1024, WSP(bf16, WS_WD + w * SZ_WD), DFF, kb * 64, nb * 32, nb * 32, scr, F.lane, nullptr, nullptr); return; } r -= 2 * CI_DN;
    if (r < CI_OE) { const int kb = r / 32, nb = r % 32;
        if (l & 1) p0_transpose_item(AIN(I_WOO) + (size_t)hi * 1024 * 1024, 1024, WSP(bf16, WS_WOO + hi * SZ_WO), 1024, kb * 64, nb * 32, nb * 32, scr, F.lane, nullptr, nullptr);
        else       p0_transpose_item(AIN(I_WOE) + (size_t)hi * 1024 * 1024, 1024, WSP(bf16, WS_WOE + hi * SZ_WO), 1024, kb * 64, nb * 32, nb * 32, scr, F.lane, nullptr, nullptr);
        return; } r -= CI_OE;
    if (r < CI_UQ) { const int kb = r / 24, nb = r % 24;
        p0_transpose_item(AIN(I_WUQ) + (size_t)hi * 384 * 768, 768, WSP(bf16, WS_WUQ + hi * SZ_WUQ), 384, kb * 64, nb * 32, nb * 32, scr, F.lane, nullptr, nullptr); return; } r -= CI_UQ;
    { const int kb = r / 32, nb = r % 32, n0 = nb * 32, h = n0 >> 7, rr = n0 & 127;
        const int dst = (rr < 64 ? 0 : 512) + h * 64 + (rr & 63);
        p0_transpose_item(AIN(I_WUKV) + (size_t)hi * 256 * 1024, 1024, WSP(bf16, WS_WKV + hi * SZ_WKV), 256, kb * 64, n0, dst, scr, F.lane, nullptr, nullptr); }
}
__device__ __forceinline__ void conv_item_b(const Frame& F, int l, int it, float* scr) {
    int r = it; const int hi = l >> 1; const float* MOD = WSP(float, WS_MOD) + (size_t)l * 3 * NMODV; float* BIAS = WSP(float, WS_BIAS) + (size_t)(l * 3) * 3 * BIAS_MS;
    if (r < 2 * CI_GU) { const int f = r / CI_GU, w = l * 2 + f, q = r % CI_GU, kb = q / 176, nb = q % 176, n0 = nb * 32;
        const int dst = (n0 < DFF) ? ((n0 >> 7) * 256 + (n0 & 127)) : (((n0 - DFF) >> 7) * 256 + 128 + ((n0 - DFF) & 127));
        p0_transpose_item(AIN(I_WGU) + (size_t)w * 1024 * 5632, 5632, WSP(bf16, WS_WGU + w * SZ_WGU), 1024, kb * 64, n0, dst, scr, F.lane,
                          MOD + (f == 0 ? 0 : 6) * 1024 + kb * 64, BIAS + (size_t)(f == 0 ? 0 : 2) * 3 * BIAS_MS); return; } r -= 2 * CI_GU;
    if (l & 1) { const int kb = r / 56, nb = r % 56;
        p0_transpose_item(AIN(I_WIO) + (size_t)hi * 1024 * 1696, 1696, WSP(bf16, WS_WIO + hi * SZ_WIO), 1024, kb * 64, nb * 32, nb * 32, scr, F.lane, MOD + 3 * 1024 + kb * 64, BIAS + (size_t)3 * BIAS_MS); }
    else { const int kb = r / 88, nb = r % 88;
        p0_transpose_item(AIN(I_WIE) + (size_t)hi * 1024 * 2576, 2576, WSP(bf16, WS_WIE + hi * SZ_WIE), 1024, kb * 64, nb * 32, nb * 32, scr, F.lane, MOD + 3 * 1024 + kb * 64, BIAS + (size_t)3 * BIAS_MS); }
}
template <int N4> __device__ __forceinline__ void mod_tile(const Frame& F, int l, int tile) {
    constexpr int KG = 504 / N4, NC = 4 * N4;
    float* sv = (float*)F.lds;
    float* red = (float*)(F.lds + 12288);
    __syncthreads();
    for (int i = F.tid; i < 3072; i += NTHR) { const int r = i >> 10, k = i & 1023; const float c = (r == 0) ? AIN(I_CCTX)[k] : AIN(I_C)[(r - 1) * 1024 + k]; sv[i] = siluf_(c); }
    __syncthreads();
    const int n0 = tile * NC, n4 = F.tid % N4, kg = F.tid / N4;
    if (F.tid < 504) {
        f32x4 a0 = {0.f, 0.f, 0.f, 0.f}, a1 = a0, a2 = a0;
        const float* wp = AIN(I_WMOD) + (size_t)l * 1024 * NMODV + n0 + 4 * n4;
#pragma unroll 4
        for (int k = kg; k < 1024; k += KG) { const f32x4 w = *(const f32x4*)(wp + (size_t)k * NMODV); a0 += w * sv[k]; a1 += w * sv[1024 + k]; a2 += w * sv[2048 + k]; }
        *(f32x4*)(red + (kg * 3 + 0) * NC + 4 * n4) = a0; *(f32x4*)(red + (kg * 3 + 1) * NC + 4 * n4) = a1; *(f32x4*)(red + (kg * 3 + 2) * NC + 4 * n4) = a2;
    }
    __syncthreads();
    for (int o = F.tid; o < 3 * NC; o += NTHR) { const int r = o / NC, n = o % NC; float s = AIN(I_BMOD)[l * NMODV + n0 + n];
        for (int g = 0; g < KG; ++g) s += red[(g * 3 + r) * NC + n];
        WSP(float, WS_MOD)[(size_t)(l * 3 + r) * NMODV + n0 + n] = s; }
    __syncthreads();
}
__device__ __forceinline__ void bias_reduce(const Frame& F, int l, int kmask, int bgi, int nbg) {
    const float* BP = WSP(float, WS_BIAS); float* BF = WSP(float, WS_BIASF);
    const int gt = bgi * NTHR + F.tid, NT = nbg * NTHR;
    for (int i = gt; i < 3 * 3 * (int)BIAS_LD; i += NT) { const int kind = i / (3 * (int)BIAS_LD), rem = i % (3 * (int)BIAS_LD), m = rem / (int)BIAS_LD, n = rem % (int)BIAS_LD;
        if (!((kmask >> kind) & 1)) continue;
        const float* p = BP + ((size_t)(l * 3 + kind) * 3 + m) * BIAS_MS + n; float b = 0.f;
#pragma unroll
        for (int kb = 0; kb < 16; ++kb) b += p[(size_t)kb * BIAS_LD];
        BF[((size_t)(l * 3 + kind) * 3 + m) * BIAS_LD + n] = b; }
}
__device__ __forceinline__ void background_work(const Frame& F, int l, int win, int bgi, int nbg) {
    F.relane();
    if (nbg <= 0) return;
    if (win == 0) bias_reduce(F, l, 6, bgi, nbg);
    if (l >= 3) return;
    const int ln = l + 1;
    if (win == 2) bias_reduce(F, ln, 1, bgi, nbg);
    float* scr = (float*)(F.lds + F.wave * 16384);
    const int gw = bgi * NWAVES + F.wave, NGW = nbg * NWAVES;
    if (win == 0) {
        for (int t = bgi; t < 64; t += nbg) mod_tile<36>(F, ln, t);
        const int na = conv_na(ln);
        for (int it = gw; it < na; it += NGW) conv_item_a(F, ln, it, scr);
    } else {
        const int nb = conv_nb(ln), cut = CI_GU;
        const int lo = win == 1 ? 0 : cut, hi_ = win == 1 ? cut : nb;
        for (int it = lo + gw; it < hi_; it += NGW) conv_item_b(F, ln, it, scr);
    }
}
__device__ __forceinline__ void p0_phase(const Frame& F) {
    F.relane();
    for (int t = F.bid; t < 256; t += F.G) mod_tile<9>(F, 0, t);
    {
        float* scr = (float*)(F.lds + F.wave * 16384);
        const int gw = F.bid * NWAVES + F.wave, NGW = F.G * NWAVES;
        for (int it = gw; it < conv_na(0); it += NGW) conv_item_a(F, 0, it, scr);
    }
    {
        const size_t gt = (size_t)F.bid * NTHR + F.tid, NT = (size_t)F.G * NTHR;
        for (size_t i = gt; i < 1024 * 16; i += NT) { const int pos = (int)(i >> 4), ax = (int)(i >> 3) & 1, f = (int)i & 7;
            const float freq = exp2f(-(float)f * (13.287712379549449f / 8.0f));
            const float ang = (float)(ax == 0 ? (pos >> 6) : (pos & 63)) * freq;
            float sn, cs; sincosf(ang, &sn, &cs);
            WSP(float, WS_ROPE)[2 * i] = cs; WSP(float, WS_ROPE)[2 * i + 1] = sn; }
    }
}
__device__ __forceinline__ void p1_copy_phase(const Frame& F) {
    F.relane();
    float* scr = (float*)(F.lds + F.wave * 16384);
    const int gw = F.bid * NWAVES + F.wave, NGW = F.G * NWAVES;
    for (int it = gw; it < conv_nb(0); it += NGW) conv_item_b(F, 0, it, scr);
}

__device__ __forceinline__ void norm0_phase(const Frame& F) {
    F.relane();
    const int gw = F.bid * NWAVES + F.wave, NGW = F.G * NWAVES;
    bf16* X = WSP(bf16, WS_X); bf16* XA = WSP(bf16, WS_XA); float* SSQ = WSP(float, WS_SSQ);
    const float* g = AIN(I_GNORM); const float* scale = WSP(float, WS_MOD) + 1024;
    for (int row = gw; row < T; row += NGW) {
        const int r = modrow_of_tok(row);
        const f32x4* xr = (const f32x4*)(row < TCTX ? AIN(I_XP) + (size_t)row * D : AIN(I_XS) + (size_t)(row - TCTX) * D) + F.lane;
        f32x4 v[4]; float s = 0.f;
#pragma unroll
        for (int j = 0; j < 4; ++j) { v[j] = xr[64 * j]; s += (v[j].x * v[j].x + v[j].y * v[j].y) + (v[j].z * v[j].z + v[j].w * v[j].w); }
        s = wave_sum(s);
        if (F.lane == 0) *(f32x4*)(SSQ + (size_t)row * 4) = (f32x4){s, 0.f, 0.f, 0.f};
        unsigned long long* o8 = (unsigned long long*)(XA + (size_t)row * D) + F.lane;
        unsigned long long* xo = (unsigned long long*)(X + (size_t)row * D) + F.lane;
#pragma unroll
        for (int j = 0; j < 4; ++j) {
            const f32x4 gg = *((const f32x4*)g + F.lane + 64 * j), sc = *((const f32x4*)(scale + (size_t)r * NMODV) + F.lane + 64 * j);
            const f32x4 o = v[j] * gg * (sc + 1.0f);
            xo[64 * j] = (unsigned long long)pk2(v[j].x, v[j].y) | ((unsigned long long)pk2(v[j].z, v[j].w) << 32);
            o8[64 * j] = (unsigned long long)pk2(o.x, o.y) | ((unsigned long long)pk2(o.z, o.w) << 32);
        }
    }
}
__device__ __forceinline__ void final_phase(const Frame& F) {
    F.relane();
    const int gw = F.bid * NWAVES + F.wave, NGW = F.G * NWAVES;
    const bf16* X = WSP(bf16, WS_X); const float* g = AIN(I_GFIN); float* out = AOUT + OUT_Y;
    for (int row = gw; row < T; row += NGW) {
        const v2u* xr = (const v2u*)(X + (size_t)row * D) + F.lane;
        f32x4 v[4]; float s = 0.f;
#pragma unroll
        for (int j = 0; j < 4; ++j) { const v2u w = xr[64 * j]; v[j] = (f32x4){bflo(w.x), bfhi(w.x), bflo(w.y), bfhi(w.y)}; s += (v[j].x * v[j].x + v[j].y * v[j].y) + (v[j].z * v[j].z + v[j].w * v[j].w); }
        const float rstd = frsq(wave_sum(s) * (1.f / D) + EPS);
        f32x4* o = (f32x4*)(out + (size_t)row * D) + F.lane;
#pragma unroll
        for (int j = 0; j < 4; ++j) o[64 * j] = v[j] * rstd * *((const f32x4*)g + F.lane + 64 * j);
    }
}
constexpr int LDT = 136;
__device__ __forceinline__ bf16x8 ld_frag16(const unsigned char* p) { return *(const bf16x8*)p; }
__device__ __forceinline__ bf16x8 ld_frag8x2(const unsigned char* p0, const unsigned char* p1) {
    const v2u a = *(const v2u*)p0, b = *(const v2u*)p1; v4u v; v.x = a.x; v.y = a.y; v.z = b.x; v.w = b.y; return __builtin_bit_cast(bf16x8, v); }
#define MFMA16(a, b, c) __builtin_amdgcn_mfma_f32_16x16x32_bf16((a), (b), (c), 0, 0, 0)

__device__ __forceinline__ void chunk_info(int c, int& cfirst, int& clast, bool& is_ctx, int& sb) {
    if (c < 64) { cfirst = c & ~1; clast = cfirst + 1; is_ctx = true; sb = c >> 1; }
    else { cfirst = 64 + ((c - 64) & ~7); clast = cfirst + 7; is_ctx = false; sb = (c - 64) >> 3; }
}
struct ConvW { f32x4 w0a, w0b, w1a, w1b, w2a, w2b, ba, bb; };
__device__ __forceinline__ ConvW conv_w(const float* wc, const float* bc, int ch) {
    ConvW W; W.w0a = *(const f32x4*)(wc + ch); W.w0b = *(const f32x4*)(wc + ch + 4); W.w1a = *(const f32x4*)(wc + 1024 + ch); W.w1b = *(const f32x4*)(wc + 1024 + ch + 4);
    W.w2a = *(const f32x4*)(wc + 2048 + ch); W.w2b = *(const f32x4*)(wc + 2048 + ch + 4); W.ba = *(const f32x4*)(bc + ch); W.bb = *(const f32x4*)(bc + ch + 4); return W;
}
__device__ __forceinline__ void conv8(const bf16* PROJ, int t, bool has_prev, bool has_next, int ch, const ConvW& W, float* out) {
    const bf16* p = PROJ + (size_t)t * EVEN_NP + 1536 + ch;
    const v4u z = {0u, 0u, 0u, 0u};
    const v4u c0 = *(const v4u*)p, cm = has_prev ? *(const v4u*)(p - EVEN_NP) : z, cp = has_next ? *(const v4u*)(p + EVEN_NP) : z;
    float x0[8], xm[8], xp[8]; unpack8(c0, x0); unpack8(cm, xm); unpack8(cp, xp);
#pragma unroll
    for (int i = 0; i < 4; ++i) { out[i] = siluf_(W.ba[i] + W.w0a[i] * xm[i] + W.w1a[i] * x0[i] + W.w2a[i] * xp[i]); out[4 + i] = siluf_(W.bb[i] + W.w0b[i] * xm[4 + i] + W.w1b[i] * x0[4 + i] + W.w2b[i] * xp[4 + i]); }
}
__device__ __forceinline__ void ssd_tables(const Frame& F, int ei, int t0, float* dtl, float* cml) {
    const bf16* PROJ = WSP(bf16, WS_PROJ);
    if (F.tid < 256) { const int j = F.tid >> 1, dir = F.tid & 1;
        const v4u raw = *(const v4u*)(PROJ + (size_t)(t0 + j) * EVEN_NP + 2560 + 8 * dir); float x[8]; unpack8(raw, x);
#pragma unroll
        for (int h = 0; h < 8; ++h) dtl[(dir * 8 + h) * 128 + j] = softplusf_(x[h] + AIN(I_DTB)[ei * 16 + dir * 8 + h]); }
    __syncthreads();
#pragma unroll
    for (int k = 0; k < 2; ++k) {
        const int row = 2 * F.wave + k, rev = row >> 3;
        const float a = -__expf(AIN(I_ALOG)[ei * 16 + row]);
        const int i0 = rev ? 127 - 2 * F.lane : 2 * F.lane, i1 = rev ? 126 - 2 * F.lane : 2 * F.lane + 1;
        const float v0 = dtl[row * 128 + i0] * a, v1 = dtl[row * 128 + i1] * a;
        float x = v0 + v1;
#pragma unroll
        for (int d = 1; d < 64; d <<= 1) { const float t = __builtin_bit_cast(float, __builtin_amdgcn_ds_bpermute((F.lane - d) * 4, __builtin_bit_cast(int, x))); x += (F.lane >= d) ? t : 0.f; }
        const float ex = x - (v0 + v1);
        cml[row * 128 + i0] = ex + v0; cml[row * 128 + i1] = ex + (v0 + v1);
    }
    __syncthreads();
}
constexpr int TILE128 = 34816, TILE64 = 17408;
constexpr int S1_BT = 0, S1_B = TILE128, S1_C = 2 * TILE128, S1_XT = TILE128  , S1_DT = 3 * TILE128, S1_CUM = S1_DT + 8192;
constexpr int S2_XT = 0  , S2_H = 2 * TILE64  , S2_DT = 6 * TILE64, S2_CUM = S2_DT + 8192, S2_SSQ = S2_CUM + 8192;

__device__ __forceinline__ void ssd_state_item(const Frame& F, int ei, int c, int g) {
    F.relane();
    const bf16* PROJ = WSP(bf16, WS_PROJ);
    const float* wc = AIN(I_WCS) + (size_t)ei * 3 * 1024; const float* bc = AIN(I_BCS) + (size_t)ei * 1024;
    int cfirst, clast, sb; bool is_ctx; chunk_info(c, cfirst, clast, is_ctx, sb);
    const int t0 = c * 128, len = is_ctx ? 256 : 1024, pos0 = (c - cfirst) * 128;
    bf16* BT = (bf16*)(F.lds + S1_BT); bf16* Bl = (bf16*)(F.lds + S1_B); bf16* Cl = (bf16*)(F.lds + S1_C); bf16* XT4 = (bf16*)(F.lds + S1_XT);
    float* dtl = (float*)(F.lds + S1_DT); float* cml = (float*)(F.lds + S1_CUM);
    bf16* ST = WSP(bf16, WS_ST); float* DEC = WSP(float, WS_DEC);
    bf16* CC = WSP(bf16, WS_CC); bf16* CBM = WSP(bf16, WS_CBM); bf16* XCT = WSP(bf16, WS_XCT);
    const int r = F.lane & 15, q = F.lane >> 4, w = F.wave;
    __syncthreads();
    ssd_tables(F, ei, t0, dtl, cml);
    { const ConvW W = conv_w(wc, bc, 512 + g * 128 + (F.tid & 15) * 8);
#pragma unroll 2
    for (int e = F.tid; e < 128 * 16; e += NTHR) { const int j = e >> 4, n8 = (e & 15) * 8; float o[8];
        conv8(PROJ, t0 + j, pos0 + j > 0, pos0 + j < len - 1, 512 + g * 128 + n8, W, o);
        const v4u pk = pack8(o);
        *(v4u*)((unsigned char*)Bl + (j * LDT + n8) * 2) = pk;
#pragma unroll
        for (int i = 0; i < 8; ++i) BT[(n8 + i) * LDT + j] = (bf16)f2bf1(o[i]); } }
    { const ConvW W = conv_w(wc, bc, 768 + g * 128 + (F.tid & 15) * 8);
#pragma unroll 2
    for (int e = F.tid; e < 128 * 16; e += NTHR) { const int j = e >> 4, n8 = (e & 15) * 8; float o[8];
        conv8(PROJ, t0 + j, pos0 + j > 0, pos0 + j < len - 1, 768 + g * 128 + n8, W, o);
        const v4u pk = pack8(o);
        *(v4u*)((unsigned char*)Cl + (j * LDT + n8) * 2) = pk;
        *(v4u*)(CC + (size_t)(t0 + j) * 256 + g * 128 + n8) = pk; } }
    __syncthreads();
    {
        bf16x8 cf[4];
#pragma unroll
        for (int ks = 0; ks < 4; ++ks) cf[ks] = ld_frag16((const unsigned char*)Cl + ((16 * w + r) * LDT + 32 * ks + 8 * q) * 2);
        bf16* dst = CBM + ((size_t)(c * 2 + g) * 128 + 16 * w + r) * 128 + 4 * q;
#pragma unroll
        for (int jt = 0; jt < 8; ++jt) { f32x4 a = {0.f, 0.f, 0.f, 0.f};
#pragma unroll
            for (int ks = 0; ks < 4; ++ks) a = MFMA16(ld_frag16((const unsigned char*)Bl + ((16 * jt + r) * LDT + 32 * ks + 8 * q) * 2), cf[ks], a);
            v2u o; o.x = pk2(a[0], a[1]); o.y = pk2(a[2], a[3]); *(v2u*)(dst + 16 * jt) = o; }
    }
    __syncthreads();
    { const ConvW W = conv_w(wc, bc, g * 256 + (F.tid & 31) * 8);
#pragma unroll 2
    for (int e = F.tid; e < 128 * 32; e += NTHR) { const int j = e >> 5, p8 = (e & 31) * 8; float o[8];
        conv8(PROJ, t0 + j, pos0 + j > 0, pos0 + j < len - 1, g * 256 + p8, W, o);
#pragma unroll
        for (int i = 0; i < 8; ++i) XT4[(p8 + i) * LDT + j] = (bf16)f2bf1(o[i]); } }
    __syncthreads();
#pragma unroll 1
    for (int e = F.tid; e < 256 * 16; e += NTHR) { const int row = e >> 4, ch = (e & 15) * 8;
        *(v4u*)(XCT + ((size_t)(c * 8 + 4 * g) * 64 + row) * 128 + ch) = *(const v4u*)((const unsigned char*)XT4 + (row * LDT + ch) * 2); }
#pragma unroll 1
    for (int hd = 0; hd < 8; ++hd) {
        const int hh = hd >> 1, dir = hd & 1, h = 4 * g + hh;
        const float* dth = dtl + (dir * 8 + h) * 128; const float* cmh = cml + (dir * 8 + h) * 128;
        const float cend = dir == 0 ? cmh[127] : cmh[0];
        const bf16* XT = XT4 + hh * 64 * LDT;
        f32x4 acc[4];
#pragma unroll
        for (int pt = 0; pt < 4; ++pt) acc[pt] = (f32x4){0.f, 0.f, 0.f, 0.f};
#pragma unroll
        for (int ks = 0; ks < 4; ++ks) {
            const int j0 = 32 * ks + 8 * q;
            const v4u braw = *(const v4u*)((const unsigned char*)BT + ((16 * w + r) * LDT + j0) * 2); float bv[8]; unpack8(braw, bv);
            const f32x4 d0 = *(const f32x4*)(dth + j0), d1 = *(const f32x4*)(dth + j0 + 4), c0 = *(const f32x4*)(cmh + j0), c1 = *(const f32x4*)(cmh + j0 + 4);
#pragma unroll
            for (int i = 0; i < 4; ++i) { bv[i] *= d0[i] * __expf(cend - c0[i]); bv[4 + i] *= d1[i] * __expf(cend - c1[i]); }
            const bf16x8 af = __builtin_bit_cast(bf16x8, pack8(bv));
#pragma unroll
            for (int pt = 0; pt < 4; ++pt) { const bf16x8 bf = ld_frag16((const unsigned char*)XT + ((16 * pt + r) * LDT + j0) * 2); acc[pt] = MFMA16(af, bf, acc[pt]); }
        }
        bf16* dst = ST + ((size_t)(c * 8 + h) * 2 + dir) * 8192;
#pragma unroll
        for (int pt = 0; pt < 4; ++pt) { v2u o; o.x = pk2(acc[pt][0], acc[pt][1]); o.y = pk2(acc[pt][2], acc[pt][3]); *(v2u*)(dst + (16 * pt + r) * 128 + 16 * w + 4 * q) = o; }
        if (F.tid == 0) DEC[(c * 8 + h) * 2 + dir] = __expf(cend);
    }
}

__device__ __forceinline__ void gmlp_item(const Frame& F, int ei, int c, int g) {
    F.relane();
    const bf16* PROJ = WSP(bf16, WS_PROJ); bf16* YMIX = WSP(bf16, WS_YMIX);
    const int t0 = c * 128;
    float* rs = (float*)F.lds; bf16* Vt = (bf16*)(F.lds + 1024); bf16* Wl = (bf16*)(F.lds + 1024 + 34816);
    const float* gv = AIN(I_GV) + ei * 512;
    __syncthreads();
#pragma unroll 1
    for (int kb = 0; kb < 16; kb += 8) {
        v4u raw[8];
#pragma unroll
        for (int k = 0; k < 8; ++k) raw[k] = *(const v4u*)(PROJ + (size_t)(t0 + F.wave * 16 + kb + k) * EVEN_NP + 512 + 8 * F.lane);
#pragma unroll
        for (int k = 0; k < 8; ++k) { float x[8]; unpack8(raw[k], x); float s = 0.f;
#pragma unroll
            for (int i = 0; i < 8; ++i) { const float y = gelu_tanh(x[i]); s += y * y; }
            s = wave_sum(s); if (F.lane == 0) rs[F.wave * 16 + kb + k] = frsq(s * (1.f / 512.f) + EPS); }
    }
    { const float* ws_ = AIN(I_WSP) + ((size_t)ei * 4 + g) * 16384;
#pragma unroll
      for (int e = F.tid; e < 4096; e += NTHR) { const int i = e >> 5, j4 = (e & 31) * 4; const f32x4 v = *(const f32x4*)(ws_ + i * 128 + j4);
          v2u o; o.x = pk2(v.x, v.y); o.y = pk2(v.z, v.w); *(v2u*)((unsigned char*)Wl + (i * LDT + j4) * 2) = o; } }
    __syncthreads();
    { const int d8 = (F.tid & 15) * 8; v4u raw[4];
#pragma unroll
      for (int k = 0; k < 4; ++k) raw[k] = *(const v4u*)(PROJ + (size_t)(t0 + (F.tid >> 4) + 32 * k) * EVEN_NP + 512 + g * 128 + d8);
#pragma unroll
      for (int k = 0; k < 4; ++k) { const int j = (F.tid >> 4) + 32 * k; float x[8]; unpack8(raw[k], x); const float rj = rs[j];
#pragma unroll
          for (int i = 0; i < 8; ++i) Vt[(d8 + i) * LDT + j] = (bf16)f2bf1(gelu_tanh(x[i]) * rj * gv[g * 128 + d8 + i]); } }
    __syncthreads();
    const int r = F.lane & 15, q = F.lane >> 4, w = F.wave;
    bf16x8 af[4];
#pragma unroll
    for (int ks = 0; ks < 4; ++ks) af[ks] = ld_frag16((const unsigned char*)Vt + ((16 * w + r) * LDT + 32 * ks + 8 * q) * 2);
    const float* bs = AIN(I_BSP) + ((size_t)ei * 4 + g) * 128;
    v2u uraw[8];
#pragma unroll
    for (int it = 0; it < 8; ++it) uraw[it] = *(const v2u*)(PROJ + (size_t)(t0 + 16 * it + r) * EVEN_NP + g * 128 + 16 * w + 4 * q);
#pragma unroll
    for (int it = 0; it < 8; ++it) {
        f32x4 acc = {0.f, 0.f, 0.f, 0.f};
#pragma unroll
        for (int ks = 0; ks < 4; ++ks) acc = MFMA16(af[ks], ld_frag16((const unsigned char*)Wl + ((16 * it + r) * LDT + 32 * ks + 8 * q) * 2), acc);
        const int i = 16 * it + r, col = g * 128 + 16 * w + 4 * q; const float b = bs[i];
        const float u0 = gelu_tanh(bflo(uraw[it].x)), u1 = gelu_tanh(bfhi(uraw[it].x)), u2 = gelu_tanh(bflo(uraw[it].y)), u3 = gelu_tanh(bfhi(uraw[it].y));
        v2u o; o.x = pk2(u0 * (acc[0] + b), u1 * (acc[1] + b)); o.y = pk2(u2 * (acc[2] + b), u3 * (acc[3] + b));
        *(v2u*)(YMIX + (size_t)(t0 + i) * D + col) = o;
    }
}

__device__ __forceinline__ f32x4 ld_bf4(const bf16* p) { const v2u w = *(const v2u*)p; return (f32x4){bflo(w.x), bfhi(w.x), bflo(w.y), bfhi(w.y)}; }
__device__ __forceinline__ void ssd_scan_phase(const Frame& F, int ei) {
    F.relane();
    const bf16* ST = WSP(bf16, WS_ST); const float* DEC = WSP(float, WS_DEC); bf16* HIN = WSP(bf16, WS_HIN);
    const size_t gt = (size_t)F.bid * NTHR + F.tid, NT = (size_t)F.G * NTHR;
    constexpr size_t N_SMP = (size_t)2 * 8 * 2 * 2048, N_CTX = (size_t)32 * 8 * 2 * 2048;
    for (size_t it = gt; it < N_SMP + N_CTX; it += NT) {
        if (it < N_SMP) {
            const int e = (int)(it & 2047) * 4, dir = (int)(it >> 11) & 1, h = (int)(it >> 12) & 7, b = (int)(it >> 15);
            const int c0 = 64 + 8 * b;
            f32x4 st[8]; float dc[8];
#pragma unroll
            for (int k = 0; k < 8; ++k) { const int cc = dir == 0 ? c0 + k : c0 + 7 - k; st[k] = ld_bf4(ST + ((size_t)(cc * 8 + h) * 2 + dir) * 8192 + e); dc[k] = DEC[(cc * 8 + h) * 2 + dir]; }
            f32x4 v = *(const f32x4*)(AIN(I_SSD) + ((size_t)((b * 2 + ei) * 2 + dir) * 8 + h) * 8192 + e);
#pragma unroll
            for (int k = 0; k < 8; ++k) { const int cc = dir == 0 ? c0 + k : c0 + 7 - k;
                v2u o; o.x = pk2(v.x, v.y); o.y = pk2(v.z, v.w); *(v2u*)(HIN + ((size_t)(cc * 8 + h) * 2 + dir) * 8192 + e) = o;
                v = v * dc[k] + st[k]; }
        } else {
            const size_t i2 = it - N_SMP;
            const int e = (int)(i2 & 2047) * 4, dir = (int)(i2 >> 11) & 1, h = (int)(i2 >> 12) & 7, s = (int)(i2 >> 15);
            const int ca = dir == 0 ? 2 * s : 2 * s + 1, cb = dir == 0 ? 2 * s + 1 : 2 * s;
            const f32x4 sa = ld_bf4(ST + ((size_t)(ca * 8 + h) * 2 + dir) * 8192 + e), sb_ = ld_bf4(ST + ((size_t)(cb * 8 + h) * 2 + dir) * 8192 + e);
            const float db = DEC[(cb * 8 + h) * 2 + dir];
            *(f32x4*)(AOUT + OUT_SSD + ((size_t)((s * 2 + ei) * 2 + dir) * 8 + h) * 8192 + e) = sa * db + sb_;
        }
    }
}

__device__ __forceinline__ void ssd_out_item(const Frame& F, int ei, int c, int th) {
    F.relane();
    const bf16* PROJ = WSP(bf16, WS_PROJ); bf16* YMIX = WSP(bf16, WS_YMIX);
    const bf16* CC = WSP(bf16, WS_CC); const bf16* CBM = WSP(bf16, WS_CBM); const bf16* XCT = WSP(bf16, WS_XCT); const bf16* HIN = WSP(bf16, WS_HIN); const bf16* ST = WSP(bf16, WS_ST);
    const int t0 = c * 128;
    float* dtl = (float*)(F.lds + S2_DT); float* cml = (float*)(F.lds + S2_CUM); float* ssqx = (float*)(F.lds + S2_SSQ);
    const int r = F.lane & 15, q = F.lane >> 4, w = F.wave, it = w & 3, g = w >> 2;
    const int irow = 64 * th + 16 * it + r;
    const bool hzero[2] = {c < 64 && (c & 1) == 0, c < 64 && (c & 1) == 1};
    __syncthreads();
    ssd_tables(F, ei, t0, dtl, cml);
    v2u cbp[8]; bf16x8 cf[4];
    {
        const bf16* cbr = CBM + ((size_t)(c * 2 + g) * 128 + irow) * 128 + 4 * q;
#pragma unroll
        for (int jt = 0; jt < 8; ++jt) cbp[jt] = *(const v2u*)(cbr + 16 * jt);
#pragma unroll
        for (int kn = 0; kn < 4; ++kn) cf[kn] = *(const bf16x8*)(CC + (size_t)(t0 + irow) * 256 + g * 128 + 32 * kn + 8 * q);
    }
    float ssq = 0.f;
    v4u pre[12];
    const int goff = (F.tid >> 4) * 128 + (F.tid & 15) * 8, loff = ((F.tid >> 4) * LDT + (F.tid & 15) * 8) * 2;
#define E2_SRC(m_, hh_) ((m_) < 2 ? XCT + (size_t)(c * 8 + 4 * (m_) + (hh_)) * 8192 : \
        (c < 64 ? ST + ((size_t)((((m_) - 2) & 1) == 0 ? c - 1 : c + 1) * 8 + 4 * (((m_) - 2) >> 1) + (hh_)) * 16384 + (((m_) - 2) & 1) * 8192 \
                : HIN + ((size_t)c * 8 + 4 * (((m_) - 2) >> 1) + (hh_)) * 16384 + (((m_) - 2) & 1) * 8192))
#define E2_FETCH(hh_) do { _Pragma("unroll") for (int m = 0; m < 6; ++m) { if (m >= 2 && hzero[(m - 2) & 1]) continue; const bf16* sp = E2_SRC(m, hh_) + goff; \
            pre[2 * m] = *(const v4u*)sp; pre[2 * m + 1] = *(const v4u*)(sp + 32 * 128); } } while (0)
    E2_FETCH(0);
#pragma unroll 1
    for (int hh = 0; hh < 4; ++hh) {
        __syncthreads();
#pragma unroll
        for (int m = 0; m < 6; ++m) { if (m >= 2 && hzero[(m - 2) & 1]) continue;
            unsigned char* dp = F.lds + (m < 2 ? S2_XT + m * TILE64 : S2_H + (m - 2) * TILE64) + loff;
            *(v4u*)dp = pre[2 * m]; *(v4u*)(dp + 32 * LDT * 2) = pre[2 * m + 1]; }
        __syncthreads();
        if (hh < 3) E2_FETCH(hh + 1);
        v2u zr4[4];
#pragma unroll
        for (int pt = 0; pt < 4; ++pt) zr4[pt] = *(const v2u*)(PROJ + (size_t)(t0 + irow) * EVEN_NP + 1024 + (4 * g + hh) * 64 + 16 * pt + 4 * q);
        const int h = 4 * g + hh;
        const bf16* XT = (const bf16*)(F.lds + S2_XT + g * TILE64);
        f32x4 yacc[4];
#pragma unroll
        for (int pt = 0; pt < 4; ++pt) yacc[pt] = (f32x4){0.f, 0.f, 0.f, 0.f};
        const float* dt0 = dtl + h * 128; const float* cm0 = cml + h * 128; const float* dt1 = dtl + (8 + h) * 128; const float* cm1 = cml + (8 + h) * 128;
        const float ci0 = cm0[irow], ci1 = cm1[irow];
#pragma unroll
        for (int ks = 0; ks < 4; ++ks) {
            float sl0[8], sl1[8];
#pragma unroll
            for (int hf = 0; hf < 2; ++hf) {
                const int j0 = 32 * ks + 16 * hf + 4 * q; const v2u cw = cbp[2 * ks + hf];
                const f32x4 c0v = *(const f32x4*)(cm0 + j0), d0v = *(const f32x4*)(dt0 + j0), c1v = *(const f32x4*)(cm1 + j0), d1v = *(const f32x4*)(dt1 + j0);
                const float cbv[4] = {bflo(cw.x), bfhi(cw.x), bflo(cw.y), bfhi(cw.y)};
#pragma unroll
                for (int e = 0; e < 4; ++e) { const int j = j0 + e;
                    const float e0 = __expf(ci0 - c0v[e]) * d0v[e] * cbv[e], e1 = __expf(ci1 - c1v[e]) * d1v[e] * cbv[e];
                    sl0[4 * hf + e] = (j <= irow) ? e0 : 0.f; sl1[4 * hf + e] = (j >= irow) ? e1 : 0.f; }
            }
            const bf16x8 sf0 = __builtin_bit_cast(bf16x8, pack8(sl0)), sf1 = __builtin_bit_cast(bf16x8, pack8(sl1));
#pragma unroll
            for (int pt = 0; pt < 4; ++pt) { const unsigned char* xr = (const unsigned char*)XT + ((16 * pt + r) * LDT + 32 * ks + 4 * q) * 2;
                const bf16x8 xf = ld_frag8x2(xr, xr + 32);
                yacc[pt] = MFMA16(xf, sf0, yacc[pt]); yacc[pt] = MFMA16(xf, sf1, yacc[pt]); }
        }
#pragma unroll
        for (int dir = 0; dir < 2; ++dir) {
            if (hzero[dir]) continue;
            const unsigned char* Hl = F.lds + S2_H + (g * 2 + dir) * TILE64;
            const float ei_ = __expf(dir == 0 ? ci0 : ci1);
#pragma unroll
            for (int pt = 0; pt < 4; ++pt) { f32x4 t = {0.f, 0.f, 0.f, 0.f};
#pragma unroll
                for (int kn = 0; kn < 4; ++kn) t = MFMA16(ld_frag16(Hl + ((16 * pt + r) * LDT + 32 * kn + 8 * q) * 2), cf[kn], t);
                yacc[pt] += t * ei_; }
        }
        const float dsk = AIN(I_DSK)[ei * 16 + h] + AIN(I_DSK)[ei * 16 + 8 + h];
#pragma unroll
        for (int pt = 0; pt < 4; ++pt) {
            const int p0 = 16 * pt + 4 * q;
            const v2u zr = zr4[pt];
            const float z0 = bflo(zr.x), z1 = bfhi(zr.x), z2 = bflo(zr.y), z3 = bfhi(zr.y);
            float y0 = yacc[pt][0] + dsk * bf1(XT[(p0 + 0) * LDT + irow]), y1 = yacc[pt][1] + dsk * bf1(XT[(p0 + 1) * LDT + irow]),
                  y2 = yacc[pt][2] + dsk * bf1(XT[(p0 + 2) * LDT + irow]), y3 = yacc[pt][3] + dsk * bf1(XT[(p0 + 3) * LDT + irow]);
            y0 *= siluf_(z0); y1 *= siluf_(z1); y2 *= siluf_(z2); y3 *= siluf_(z3);
            ssq += (y0 * y0 + y1 * y1) + (y2 * y2 + y3 * y3);
            v2u o; o.x = pk2(y0, y1); o.y = pk2(y2, y3);
            *(v2u*)(YMIX + (size_t)(t0 + irow) * D + 512 + h * 64 + p0) = o;
        }
    }
#undef E2_FETCH
#undef E2_SRC
    ssq += xlane<16>(ssq); ssq = sum_x32(ssq);
    if (q == 0) ssqx[w * 16 + r] = ssq;
    __syncthreads();
    ssq += ssqx[(w ^ 4) * 16 + r];
    const float rstd = frsq(ssq * (1.f / 512.f) + EPS);
    const float* go = AIN(I_GSO) + ei * 512;
#pragma unroll 1
    for (int hh = 0; hh < 4; ++hh)
#pragma unroll
        for (int pt = 0; pt < 4; ++pt) {
            const int col = (4 * g + hh) * 64 + 16 * pt + 4 * q;
            v2u* p = (v2u*)(YMIX + (size_t)(t0 + irow) * D + 512 + col); const v2u v = *p; const f32x4 gg = *(const f32x4*)(go + col);
            v2u o; o.x = pk2(bflo(v.x) * rstd * gg.x, bfhi(v.x) * rstd * gg.y); o.y = pk2(bflo(v.y) * rstd * gg.z, bfhi(v.y) * rstd * gg.w);
            *p = o;
        }
}

__device__ __forceinline__ void even_phase1(const Frame& F, int ei) {
    if (F.G >= 256) {
        if (F.bid < 160) ssd_state_item(F, ei, F.bid >> 1, F.bid & 1);
        else for (int it = F.bid - 160; it < 192; it += F.G - 160) gmlp_item(F, ei, it >> 2, it & 3);
        return;
    }
    for (int it = F.bid; it < 160 + 320; it += F.G) {
        if (it < 160) ssd_state_item(F, ei, it >> 1, it & 1);
        else gmlp_item(F, ei, (it - 160) >> 2, (it - 160) & 3);
    }
}
__device__ __forceinline__ void even_phase2(const Frame& F, int ei) {
    if (F.G >= 256) {
        if (F.bid < 160) ssd_out_item(F, ei, F.bid >> 1, F.bid & 1);
        else for (int it = 192 + F.bid - 160; it < 320; it += F.G - 160) gmlp_item(F, ei, it >> 2, it & 3);
        return;
    }
    for (int it = F.bid; it < 160; it += F.G) ssd_out_item(F, ei, it >> 1, it & 1);
}
constexpr int CV_T = 43, CV_W = CV_T + 30, CV_ITEMS = 32 * 6 + 2 * 24;
__device__ __forceinline__ void conv_item(const Frame& F, int oi, int item) {
    F.relane();
    const bf16* PROJ = WSP(bf16, WS_PROJ); bf16* YMIX = WSP(bf16, WS_YMIX);
    int sbeg, slen, tile; if (item < 192) { sbeg = (item / 6) * 256; slen = 256; tile = item % 6; } else { const int i2 = item - 192; sbeg = TCTX + (i2 / 24) * 1024; slen = 1024; tile = i2 % 24; }
    const int send = sbeg + slen, t0 = sbeg + tile * CV_T, nt = (slen - tile * CV_T) < CV_T ? (slen - tile * CV_T) : CV_T;
    float* Dl = (float*)F.lds;
    const int c = F.tid;
    float glu[CV_W];
#pragma unroll
    for (int w0 = 0; w0 < CV_W; w0 += 8) {
        bf16 av[8], gv[8];
#pragma unroll
        for (int i = 0; i < 8; ++i) if (w0 + i < CV_W) { int t = t0 - 15 + w0 + i; t = t < sbeg ? sbeg : (t >= send ? send - 1 : t);
            av[i] = PROJ[(size_t)t * ODD_NP + 672 + c]; gv[i] = PROJ[(size_t)t * ODD_NP + 1184 + c]; }
#pragma unroll
        for (int i = 0; i < 8; ++i) if (w0 + i < CV_W) { const int t = t0 - 15 + w0 + i; const float v = bf1(av[i]) * sigmoidf_(bf1(gv[i])); glu[w0 + i] = (t >= sbeg && t < send) ? v : 0.f; }
    }
    float wk[31];
#pragma unroll
    for (int k = 0; k < 31; ++k) wk[k] = AIN(I_WDW)[((size_t)oi * 31 + k) * 512 + c];
    const float bd = AIN(I_BDW)[oi * 512 + c];
    __syncthreads();
#pragma unroll
    for (int tt = 0; tt < CV_T; ++tt) { float s = bd;
#pragma unroll
        for (int k = 0; k < 31; ++k) s += wk[k] * glu[tt + k];
        Dl[tt * 512 + c] = s; }
    __syncthreads();
    const float* gl = AIN(I_GLN) + oi * 512; const float* bl = AIN(I_BLN) + oi * 512;
    const f32x4 g0 = *(const f32x4*)(gl + 8 * F.lane), g1 = *(const f32x4*)(gl + 8 * F.lane + 4), b0 = *(const f32x4*)(bl + 8 * F.lane), b1 = *(const f32x4*)(bl + 8 * F.lane + 4);
#pragma unroll 1
    for (int tt = F.wave; tt < nt; tt += NWAVES) {
        const f32x4 v0 = *(const f32x4*)(Dl + tt * 512 + 8 * F.lane), v1 = *(const f32x4*)(Dl + tt * 512 + 8 * F.lane + 4);
        float s = (v0.x + v0.y) + (v0.z + v0.w) + (v1.x + v1.y) + (v1.z + v1.w);
        const float mean = wave_sum(s) * (1.f / 512.f);
        const f32x4 d0 = v0 - mean, d1 = v1 - mean;
        float s2 = (d0.x * d0.x + d0.y * d0.y) + (d0.z * d0.z + d0.w * d0.w) + (d1.x * d1.x + d1.y * d1.y) + (d1.z * d1.z + d1.w * d1.w);
        const float rstd = frsq(wave_sum(s2) * (1.f / 512.f) + EPS);
        float o[8];
#pragma unroll
        for (int i = 0; i < 4; ++i) { o[i] = siluf_(d0[i] * rstd * g0[i] + b0[i]); o[4 + i] = siluf_(d1[i] * rstd * g1[i] + b1[i]); }
        *(v4u*)(YMIX + (size_t)(t0 + tt) * D + 512 + 8 * F.lane) = pack8(o);
    }
}
__device__ __forceinline__ void odd_rows(const Frame& F, int oi) {
    F.relane();
    const bf16* PROJ = WSP(bf16, WS_PROJ);
    bf16* QA = WSP(bf16, WS_QA); bf16* CKVA = WSP(bf16, WS_CKVA); bf16* KR = WSP(bf16, WS_KR); const float* ROPE = WSP(float, WS_ROPE);
    const int gw = F.bid * NWAVES + F.wave, NGW = F.G * NWAVES, lane = F.lane;
    for (int row = T + gw; row < TP; row += NGW) {
        const int b = (row - T) >> 8, j = (row - T) & 255;
        const f32x4 v = *(const f32x4*)(AIN(I_CCKV) + ((size_t)(b * 2 + oi) * 256 + j) * 256 + 4 * lane);
        v2u o; o.x = pk2(v.x, v.y); o.y = pk2(v.z, v.w); *(v2u*)(CKVA + (size_t)row * 256 + 4 * lane) = o;
        if (lane < 32) KR[(size_t)row * 32 + lane] = (bf16)f2bf1(AIN(I_CKR)[((size_t)(b * 2 + oi) * 256 + j) * 32 + lane]);
    }
    const f32x4 gkv = *(const f32x4*)(AIN(I_GCKV) + oi * 256 + 4 * lane);
    float gq[6];
#pragma unroll
    for (int k = 0; k < 3; ++k) { gq[2 * k] = AIN(I_GCQ)[oi * 384 + 128 * k + 2 * lane]; gq[2 * k + 1] = AIN(I_GCQ)[oi * 384 + 128 * k + 2 * lane + 1]; }
    unsigned qw[3], nqw[3]; v2u kw, nkw; bf16 krw, nkrw;
    int row = gw;
    if (row < T) { const bf16* pr = PROJ + (size_t)row * ODD_NP;
#pragma unroll
        for (int k = 0; k < 3; ++k) nqw[k] = *(const unsigned*)(pr + 128 * k + 2 * lane);
        nkw = *(const v2u*)(pr + 384 + 4 * lane); nkrw = pr[640 + (lane & 31)]; }
#pragma unroll 1
    for (; row < T; row += NGW) {
#pragma unroll
        for (int k = 0; k < 3; ++k) qw[k] = nqw[k];
        kw = nkw; krw = nkrw;
        if (row + NGW < T) { const bf16* pr = PROJ + (size_t)(row + NGW) * ODD_NP;
#pragma unroll
            for (int k = 0; k < 3; ++k) nqw[k] = *(const unsigned*)(pr + 128 * k + 2 * lane);
            nkw = *(const v2u*)(pr + 384 + 4 * lane); nkrw = pr[640 + (lane & 31)]; }
        float qv[6]; float s = 0.f;
#pragma unroll
        for (int k = 0; k < 3; ++k) { qv[2 * k] = bflo(qw[k]); qv[2 * k + 1] = bfhi(qw[k]); s += qv[2 * k] * qv[2 * k] + qv[2 * k + 1] * qv[2 * k + 1]; }
        f32x4 kv = {bflo(kw.x), bfhi(kw.x), bflo(kw.y), bfhi(kw.y)};
        float s2 = (kv.x * kv.x + kv.y * kv.y) + (kv.z * kv.z + kv.w * kv.w);
        s += xlane<1>(s); s2 += xlane<1>(s2); s += xlane<2>(s); s2 += xlane<2>(s2); s += xlane<4>(s); s2 += xlane<4>(s2); s += xlane<8>(s); s2 += xlane<8>(s2); s += xlane<16>(s); s2 += xlane<16>(s2);
        s = sum_x32(s); s2 = sum_x32(s2);
        const float rq = frsq(s * (1.f / 384.f) + EPS), rk = frsq(s2 * (1.f / 256.f) + EPS);
#pragma unroll
        for (int k = 0; k < 3; ++k) *(unsigned*)(QA + (size_t)row * 384 + 128 * k + 2 * lane) = pk2(qv[2 * k] * rq * gq[2 * k], qv[2 * k + 1] * rq * gq[2 * k + 1]);
        kv = kv * rk * gkv;
        { v2u o; o.x = pk2(kv.x, kv.y); o.y = pk2(kv.z, kv.w); *(v2u*)(CKVA + (size_t)row * 256 + 4 * lane) = o; }
        float kr = bf1(krw);
        if (row < TCTX) {
            const int b = row >> 8, pos = row & 255;
            *(f32x4*)(AOUT + OUT_CKV + ((size_t)(b * 2 + oi) * 256 + pos) * 256 + 4 * lane) = kv;
            if (lane < 32) AOUT[OUT_KR + ((size_t)(b * 2 + oi) * 256 + pos) * 32 + lane] = kr;
        } else {
            const int pos = (row - TCTX) & 1023, e = lane & 31, ax = e >> 4, half = (e >> 3) & 1, f = e & 7;
            const float other = xlane<8>(kr);
            const float cs = ROPE[((pos * 2 + ax) * 8 + f) * 2], sn = ROPE[((pos * 2 + ax) * 8 + f) * 2 + 1];
            kr = half == 0 ? (kr * cs - other * sn) : (other * sn + kr * cs);
        }
        if (lane < 32) KR[(size_t)row * 32 + lane] = (bf16)f2bf1(kr);
    }
}
__device__ __forceinline__ void odd_phase1(const Frame& F, int oi) {
    for (int it = F.bid; it < CV_ITEMS; it += F.G) conv_item(F, oi, it);
    odd_rows(F, oi);
}

constexpr int AT_KROW = 208, AT_VROW = 272, AT_KBYTES = 128 * AT_KROW, AT_BUF = 45056;
struct AttnPre { v4u k[3]; v4u v[2]; };
__device__ __forceinline__ void attn_load_tile(const Frame& F, int h, int krow0, AttnPre& P) {
    const bf16* KN = WSP(bf16, WS_KN); const bf16* KR = WSP(bf16, WS_KR); const bf16* VT = WSP(bf16, WS_VT);
#pragma unroll
    for (int i = 0; i < 3; ++i) { const int e = F.tid + NTHR * i, key = e / 12, c = e % 12; const size_t kr = (size_t)(krow0 + key);
        P.k[i] = c < 8 ? *(const v4u*)(KN + kr * 512 + h * 64 + c * 8) : *(const v4u*)(KR + kr * 32 + (c - 8) * 8); }
#pragma unroll
    for (int i = 0; i < 2; ++i) { const int e = F.tid + NTHR * i, row = e >> 4, c = e & 15;
        P.v[i] = *(const v4u*)(VT + (size_t)(h * 64 + row) * TP + krow0 + c * 8); }
}
__device__ __forceinline__ void attn_store_tile(const Frame& F, unsigned char* buf, const AttnPre& P) {
#pragma unroll
    for (int i = 0; i < 3; ++i) { const int e = F.tid + NTHR * i, key = e / 12, c = e % 12; *(v4u*)(buf + key * AT_KROW + c * 16) = P.k[i]; }
#pragma unroll
    for (int i = 0; i < 2; ++i) { const int e = F.tid + NTHR * i, row = e >> 4, c = e & 15; *(v4u*)(buf + AT_KBYTES + row * AT_VROW + c * 16) = P.v[i]; }
}
__device__ __forceinline__ int attn_tile_row(bool is_smp, int sb, int i) {
    if (!is_smp) return sb * 256 + 128 * i;
    return i < 2 ? T + sb * 256 + 128 * i : TCTX + sb * 1024 + 128 * (i - 2);
}
__device__ __forceinline__ void attn_item(const Frame& F, int q0, int h, bool is_smp, int spos0, int sb) {
    F.relane();
    const bf16* Q = WSP(bf16, WS_Q); bf16* YMIX = WSP(bf16, WS_YMIX); const float* ROPE = WSP(float, WS_ROPE);
    const int r = F.lane & 15, g = F.lane >> 4, w = F.wave;
    const int tq = q0 + 16 * w + r;
    const int ntile = is_smp ? 10 : 2;
    AttnPre P;
    attn_load_tile(F, h, attn_tile_row(is_smp, sb, 0), P);
    bf16x8 qf[3];
#pragma unroll
    for (int ks = 0; ks < 3; ++ks) qf[ks] = *(const bf16x8*)(Q + (size_t)tq * 768 + h * 96 + 32 * ks + 8 * g);
    if (is_smp) {
        float x[8], o[8]; unpack8(__builtin_bit_cast(v4u, qf[2]), x);
        const int pos = spos0 + 16 * w + r, ax = g >> 1, half = g & 1;
        const float* rp = ROPE + ((size_t)(pos * 2 + ax) * 8) * 2;
#pragma unroll
        for (int j = 0; j < 8; ++j) { const float other = xlane<16>(x[j]); const float cs = rp[2 * j], sn = rp[2 * j + 1];
            o[j] = half == 0 ? (x[j] * cs - other * sn) : (other * sn + x[j] * cs); }
        qf[2] = __builtin_bit_cast(bf16x8, pack8(o));
    }
    const float csc = 0.10206207261596577f * 1.4426950408889634f;
    float m = -1e30f, l = 0.f;
    f32x4 oacc[4];
#pragma unroll
    for (int dt = 0; dt < 4; ++dt) oacc[dt] = (f32x4){0.f, 0.f, 0.f, 0.f};
    __syncthreads();
    attn_store_tile(F, F.lds, P);
    AttnPre P2;
    if (ntile > 1) attn_load_tile(F, h, attn_tile_row(is_smp, sb, 1), P);
    __syncthreads();
#define ATTN_COMPUTE(buf) do { \
        f32x4 sacc[8]; \
        _Pragma("unroll") \
        for (int st = 0; st < 8; ++st) { \
            const unsigned char* kp = buf + (16 * st + r) * AT_KROW + 16 * g; \
            f32x4 a = {0.f, 0.f, 0.f, 0.f}; \
            a = MFMA16(ld_frag16(kp), qf[0], a); a = MFMA16(ld_frag16(kp + 64), qf[1], a); a = MFMA16(ld_frag16(kp + 128), qf[2], a); \
            sacc[st] = a; \
        } \
        float mx = -1e30f; \
        _Pragma("unroll") \
        for (int st = 0; st < 8; ++st) mx = fmaxf(fmaxf(fmaxf(sacc[st][0], sacc[st][1]), fmaxf(sacc[st][2], sacc[st][3])), mx); \
        mx = fmaxf(mx, xlane<16>(mx)); mx = max_x32(mx); \
        const float mn = fmaxf(m, mx), alpha = exp2f((m - mn) * csc); m = mn; \
        float ps = 0.f; float p[32]; \
        _Pragma("unroll") \
        for (int st = 0; st < 8; ++st) \
            _Pragma("unroll") \
            for (int j = 0; j < 4; ++j) { const float e = exp2f((sacc[st][j] - mn) * csc); p[4 * st + j] = e; ps += e; } \
        l = l * alpha + ps; \
        _Pragma("unroll") \
        for (int dt = 0; dt < 4; ++dt) oacc[dt] *= alpha; \
        _Pragma("unroll") \
        for (int ks2 = 0; ks2 < 4; ++ks2) { \
            const bf16x8 pf = __builtin_bit_cast(bf16x8, pack8(p + 8 * ks2)); \
            _Pragma("unroll") \
            for (int dt = 0; dt < 4; ++dt) { \
                const unsigned char* vp = buf + AT_KBYTES + (16 * dt + r) * AT_VROW + (32 * ks2 + 4 * g) * 2; \
                oacc[dt] = MFMA16(ld_frag8x2(vp, vp + 32), pf, oacc[dt]); \
            } \
        } } while (0)
#pragma unroll 1
    for (int ti = 0; ti < ntile; ti += 2) {
        if (ti + 2 < ntile) attn_load_tile(F, h, attn_tile_row(is_smp, sb, ti + 2), P2);
        { const unsigned char* buf = F.lds; ATTN_COMPUTE(buf); }
        if (ti + 1 < ntile) attn_store_tile(F, F.lds + AT_BUF, P);
        __syncthreads();
        if (ti + 1 >= ntile) break;
        if (ti + 3 < ntile) attn_load_tile(F, h, attn_tile_row(is_smp, sb, ti + 3), P);
        { const unsigned char* buf = F.lds + AT_BUF; ATTN_COMPUTE(buf); }
        if (ti + 2 < ntile) attn_store_tile(F, F.lds, P2);
        __syncthreads();
    }
#undef ATTN_COMPUTE
    l += xlane<16>(l); l = sum_x32(l);
    const float inv = 1.0f / l;
#pragma unroll
    for (int dt = 0; dt < 4; ++dt) { v2u o; o.x = pk2(oacc[dt][0] * inv, oacc[dt][1] * inv); o.y = pk2(oacc[dt][2] * inv, oacc[dt][3] * inv);
        *(v2u*)(YMIX + (size_t)tq * D + h * 64 + 16 * dt + 4 * g) = o; }
}
__device__ __forceinline__ void odd_phase3(const Frame& F) {
    if (F.G >= 256) {
        if (F.bid < 128) {
            const int bh = F.bid & 15, qt = F.bid >> 4, b = bh >> 3, h = bh & 7;
            attn_item(F, TCTX + b * 1024 + qt * 128, h, true, qt * 128, b);
        } else {
            for (int p = F.bid - 128; p < 256; p += F.G - 128) { const int s = p >> 3, h = p & 7;
                attn_item(F, s * 256, h, false, 0, s); attn_item(F, s * 256 + 128, h, false, 0, s); }
        }
        return;
    }
    for (int it = F.bid; it < 640; it += F.G) {
        if (it < 128) { const int b = it >> 6, h = (it >> 3) & 7, qt = it & 7; attn_item(F, TCTX + b * 1024 + qt * 128, h, true, qt * 128, b); }
        else { const int i2 = it - 128, s = i2 >> 4, h = (i2 >> 1) & 7, qt = i2 & 1; attn_item(F, s * 256 + qt * 128, h, false, 0, s); }
    }
}
constexpr int PH_PER_LAYER = 9, PH_L0 = 2, N_PHASES = PH_L0 + 4 * PH_PER_LAYER + 1;
#ifndef MK_ONE_LAUNCH
#define MK_ONE_LAUNCH 1
#endif
#ifndef PROBE_REP
#define PROBE_REP 1
#define PROBE_SLOT -2
#endif

__global__ void __launch_bounds__(NTHR, 2) fwd_kernel(Args args) {
    extern __shared__ __attribute__((aligned(16))) unsigned char lds[];
    Frame F; F.lds = lds; F.tid = threadIdx.x; F.lane = F.tid & 63; F.wave = __builtin_amdgcn_readfirstlane(F.tid >> 6); F.bid = blockIdx.x; F.G = gridDim.x;
    const int wave_id = F.wave;
    { CArgsP ap = (CArgsP)__builtin_amdgcn_kernarg_segment_ptr(); asm volatile("" : "+s"(ap)); F.a = ap; F.ws = (GAS unsigned char*)ap->ws; }
    LAS unsigned char* ldsl = (LAS unsigned char*)lds;
    for (int u = F.tid; u < (LDS_BYTES - LDSCTL_OFF) / 4; u += NTHR) ((LAS unsigned*)(ldsl + LDSCTL_OFF))[u] = 0u;
    __syncthreads();
    XcdBarrier bar; bar.bar = (unsigned*)(GAS unsigned*)(F.ws + WS_CTL) + 1024; bar.x = 0; bar.st = nullptr;
    const bool multi = (args.ph_hi - args.ph_lo) > 1;
    if (multi) bar = xcd_barrier_post((unsigned*)(GAS unsigned*)(F.ws + WS_CTL) + 1024, (volatile LAS unsigned*)(ldsl + MISC_OFF) + 8);

#define FRESH_F() do { int wv_ = wave_id; asm volatile("" : "+s"(wv_)); int ln_; asm volatile("v_mbcnt_lo_u32_b32 %0, -1, 0\n\tv_mbcnt_hi_u32_b32 %0, -1, %0" : "=v"(ln_)); F.tid = wv_ * 64 + ln_; F.lane = ln_; F.wave = wv_; } while (0)
    int rep = 0;
    for (int ph = args.ph_lo; ph < args.ph_hi; ) {
        { CArgsP ap = (CArgsP)__builtin_amdgcn_kernarg_segment_ptr(); asm volatile("" : "+s"(ap)); F.a = ap; F.ws = (GAS unsigned char*)ap->ws;
          int bid_ = blockIdx.x; asm volatile("" : "+s"(bid_)); F.bid = bid_; }
        if (ph == 0) { FRESH_F(); p0_phase(F); }
        else if (ph == 1) { FRESH_F(); p1_copy_phase(F); norm0_phase(F); }
        else if (ph == N_PHASES - 1) { FRESH_F(); final_phase(F); }
        else {
            const int l = (ph - PH_L0) / PH_PER_LAYER, s = (ph - PH_L0) % PH_PER_LAYER, hi = l >> 1; const bool odd = l & 1;
            if (s == 0 || s == 7) {
                FRESH_F();
                const int f = s == 0 ? 0 : 1;
                pg8::Gemm g{(const bf16*)(const GAS bf16*)(F.ws + WS_XA), (const bf16*)(const GAS bf16*)(F.ws + WS_WGU + (size_t)(l * 2 + f) * SZ_WGU), T, 2 * DFF, D, D, D};
                pg8::StaticOrder S; S.init(T, 2 * DFF, F.G, F.bid);
                EpiSwiglu E{F.ws, (int)(((l * 3) + (f == 0 ? 0 : 2)) * 3 * BIAS_MS), (l == 0 && f == 0) ? 16 : 1};
                pg8::gemm_phase<EpiSwiglu, pg8::StaticOrder, true>(ldsl, F.tid, g, S, E);
            } else if (s == 1 || s == 8 || s == 6) {
                FRESH_F();
                const int f = s == 1 ? 0 : 1;
                const bool mix = s == 6, lastg = (s == 8 && l == 3);
                const bf16* gA = mix ? (const bf16*)(const GAS bf16*)(F.ws + WS_YMIX) : (const bf16*)(const GAS bf16*)(F.ws + WS_H);
                const bf16* gB = mix ? (const bf16*)(const GAS bf16*)(F.ws + (odd ? WS_WOO : WS_WOE) + (size_t)hi * SZ_WO) : (const bf16*)(const GAS bf16*)(F.ws + WS_WD + (size_t)(l * 2 + f) * SZ_WD);
                const int gK = mix ? D : DFF;
                const int gate_off = l * 3 * NMODV + (mix ? 5 : (f == 0 ? 2 : 8)) * 1024;
                const float coef = rep ? 0.f : (mix ? 1.0f : 0.5f);
                const int nl = (s == 8) ? l + 1 : l, ni = mix ? 2 : (f == 0 ? 1 : 0), sci = mix ? 7 : (f == 0 ? 4 : 1);
                const float* gn = AIN(I_GNORM) + (size_t)((lastg ? 0 : nl) * 3 + ni) * D;
                const int scn_off = (lastg ? 0 : nl) * 3 * NMODV + sci * 1024;
                pg8::Gemm g{gA, gB, T, D, gK, gK, gK};
                EpiResid E{F.ws, gn, gate_off, scn_off, coef};
                pg8::StaticOrder S; S.init(T, D, F.G, F.bid);
                pg8::gemm_phase<EpiResid, pg8::StaticOrder, true>(ldsl, F.tid, g, S, E);
                FRESH_F();
                if (F.bid >= 160 && rep == 0) background_work(F, l, s == 1 ? 0 : (s == 6 ? 1 : 2), F.bid - 160, F.G - 160);
            } else if (s == 2 || (s == 4 && odd)) {
                const int ng = s == 2 ? 1 : 3;
                for (int gi = 0; gi < ng; ++gi) {
                    FRESH_F();
                    const bool inproj = s == 2;
                    const int kind = inproj ? 0 : 1 + gi;
                    const size_t offA = kind == 0 ? WS_XA : (kind == 1 ? WS_QA : (kind == 2 ? WS_CKVA : WS_WKV + (size_t)hi * SZ_WKV + (size_t)512 * 256 * 2));
                    const size_t offB = kind == 0 ? (odd ? WS_WIO + (size_t)hi * SZ_WIO : WS_WIE + (size_t)hi * SZ_WIE) : (kind == 1 ? WS_WUQ + (size_t)hi * SZ_WUQ : (kind == 2 ? WS_WKV + (size_t)hi * SZ_WKV : WS_CKVA));
                    const size_t offO = kind == 0 ? WS_PROJ : (kind == 1 ? WS_Q : (kind == 2 ? WS_KN : WS_VT));
                    const int gM = kind == 3 ? 512 : (kind == 2 ? TP : T);
                    const int gN = kind == 0 ? (odd ? ODD_NP : EVEN_NP) : (kind == 1 ? 768 : (kind == 2 ? 512 : TP));
                    const int gK = kind == 0 ? D : (kind == 1 ? 384 : 256);
                    const int ldc = kind == 3 ? TP : gN;
                    const int off = kind == 2 ? 136 : (kind == 3 ? 52 : 0);
                    pg8::Gemm g{(const bf16*)(const GAS bf16*)(F.ws + offA), (const bf16*)(const GAS bf16*)(F.ws + offB), gM, gN, gK, gK, gK};
                    EpiStore E{F.ws, (unsigned)offO, ldc, inproj ? (int)((l * 3 + 1) * 3 * BIAS_MS) : -1};
                    pg8::StaticOrder S; S.init(gM, gN, F.G, (F.bid + off) % F.G);
                    pg8::gemm_phase<EpiStore, pg8::StaticOrder, true>(ldsl, F.tid, g, S, E);
                }
            } else if (s == 3) { if (!odd) { FRESH_F(); even_phase1(F, hi); } else { FRESH_F(); odd_phase1(F, hi); } }
            else if (s == 4) { FRESH_F(); ssd_scan_phase(F, hi); }
            else if (s == 5) { if (odd) { FRESH_F(); odd_phase3(F); } else { FRESH_F(); even_phase2(F, hi); } }
        }
        {
            const int slot = ph < PH_L0 ? 100 + ph : (ph == N_PHASES - 1 ? 102 : ((ph - PH_L0) % PH_PER_LAYER) + 20 * (((ph - PH_L0) / PH_PER_LAYER) & 1));
            const int reps = ((PROBE_SLOT == 200 && slot < 100) || slot == PROBE_SLOT || (PROBE_SLOT < 20 && slot == PROBE_SLOT + 20 && (PROBE_SLOT < 2 || PROBE_SLOT > 5))) ? PROBE_REP : 1;
            if (++rep >= reps) { rep = 0; ++ph; }
            if (ph < args.ph_hi) xcd_barrier(bar);
        }
    }
}

extern "C" void kernel_launch(void* const* d_in, const int* in_sizes, int n_in, void* d_out, int out_size, void* d_ws, size_t ws_size, hipStream_t stream) {
    static int grid = 0;
    if (grid == 0) {
        if (n_in != 34 || (size_t)out_size != OUT_END || ws_size < WS_END) { fprintf(stderr, "kernel_launch: unexpected problem: n_in %d out %d ws %zu (need %zu)\n", n_in, out_size, ws_size, (size_t)WS_END); grid = -1; return; }
        int dev = 0, cus = 0, per_cu = 0;
        if (hipGetDevice(&dev) != hipSuccess || hipDeviceGetAttribute(&cus, hipDeviceAttributeMultiprocessorCount, dev) != hipSuccess) { grid = -1; return; }
        if (hipFuncSetAttribute((const void*)fwd_kernel, hipFuncAttributeMaxDynamicSharedMemorySize, LDS_BYTES) != hipSuccess) { fprintf(stderr, "kernel_launch: hipFuncSetAttribute failed\n"); grid = -1; return; }
        if (hipOccupancyMaxActiveBlocksPerMultiprocessor(&per_cu, (const void*)fwd_kernel, NTHR, LDS_BYTES) != hipSuccess || per_cu < 1) { fprintf(stderr, "kernel_launch: occupancy query says %d blocks per CU\n", per_cu); per_cu = 1; }
        (void)hipGetLastError();
        grid = cus;
        if (grid < 256) fprintf(stderr, "kernel_launch: %d CUs (tuned for 256)\n", grid);
    }
    if (grid < 0) return;
    (void)hipMemsetAsync((char*)d_ws + WS_CTL, 0, CTL_ZERO_BYTES, stream);
    Args a{};
    for (int i = 0; i < 34; ++i) a.in[i] = (const float*)d_in[i];
    a.out = (float*)d_out; a.ws = (unsigned char*)d_ws;
#if MK_ONE_LAUNCH
    a.ph_lo = 0; a.ph_hi = N_PHASES; a.li = 0;
    hipLaunchKernelGGL(fwd_kernel, dim3(grid), dim3(NTHR), LDS_BYTES, stream, a);
#else
    int li = 0;
    for (int ph = 0; ph < N_PHASES; ++ph) {
        a.ph_lo = ph; a.ph_hi = ph + 1; a.li = li++;
        hipLaunchKernelGGL(fwd_kernel, dim3(grid), dim3(NTHR), LDS_BYTES, stream, a);
    }
#endif
}
```

```cpp
#include <hip/hip_runtime.h>
#include <cstdio>
#include <cstdint>
namespace pg8 {
#define PG8_LAS __attribute__((address_space(3)))
typedef unsigned short bf16_t;
typedef short bf16x8 __attribute__((ext_vector_type(8)));
typedef float f32x4 __attribute__((ext_vector_type(4)));
typedef unsigned u32x4 __attribute__((ext_vector_type(4)));
typedef unsigned u32x2 __attribute__((ext_vector_type(2)));
constexpr int BM = 256, BK = 64, HALF = 128, HTB = HALF * BK * 2  , STAGE_BYTES = 8 * HTB, NXCD = 8, WGM = 8;

__host__ __device__ __forceinline__ int lds_byte(int r, int c) { const int st = (r >> 4) * 2 + (c >> 5), rr = r & 15, cc = c & 31, ob = rr * 64 + cc * 2; return st * 1024 + (ob ^ (((ob >> 9) & 1) << 5)); }
__host__ __device__ __forceinline__ void stage_rc(int b, int& R, int& C) { const int st = b / 1024, sb = b % 1024, swz = sb ^ (((sb >> 9) & 1) << 5); R = (st >> 1) * 16 + swz / 64; C = (st & 1) * 32 + (swz % 64) / 2; }
__host__ __device__ __forceinline__ int perm32(int rho) { const int n = rho >> 4, i = rho & 15; return 8 * (i >> 2) + 4 * n + (i & 3); }

struct Unit { int pm, pn; };
struct Gemm { const bf16_t* A; const bf16_t* Bt; int M, N, K, lda, ldb; };

struct StaticOrder {
    int nM, nN, nwg, G, c;
    __host__ __device__ void init(int M, int N, int G_, int c_) { nM = M / BM; nN = N / BM; nwg = nM * nN; G = G_; c = c_; }
    __host__ __device__ bool next(int i, Unit& u) const {
        const long L = (long)i * G + c; if (L >= nwg) return false;
        int wgid = (int)L; { const int q = nwg / NXCD, r = nwg % NXCD, xcd = wgid % NXCD, off = wgid / NXCD; wgid = (xcd < r ? xcd * (q + 1) : r * (q + 1) + (xcd - r) * q) + off; }
        const int nig = WGM * nN, gid = wgid / nig, fm = gid * WGM, gsz = (nM - fm) < WGM ? (nM - fm) : WGM;
        u.pm = fm + ((wgid % nig) % gsz); u.pn = (wgid % nig) / gsz; return true;
    }
    __device__ __forceinline__ void a_ready(const Unit&) const {}
    __device__ __forceinline__ void done(const Unit&) const {}
};

__device__ __forceinline__ unsigned cvt_pk_bf16(float lo, float hi) { unsigned r; asm volatile("v_cvt_pk_bf16_f32 %0, %1, %2" : "=v"(r) : "v"(lo), "v"(hi)); return r; }

template <class Epi, class Sched, bool ALIGN_EPI>
__device__ __forceinline__ void gemm_phase(PG8_LAS unsigned char* lds, const int tid, const Gemm g, const Sched& S, const Epi& E) {
    const int wid = __builtin_amdgcn_readfirstlane(tid >> 6), lane = tid & 63, wr = wid >> 2, wc = wid & 3, fr = lane & 15, fq = lane >> 4;
    const int K = g.K, nt = K / BK;
    unsigned voffA[2], voffB[2];
#pragma unroll
    for (int i = 0; i < 2; ++i) { int R, C; stage_rc(tid * 16 + i * 8192, R, C); const int Rb = Epi::PERM ? ((R & ~31) + perm32(R & 31)) : R;
        voffA[i] = (unsigned)(R * g.lda + C) * 2u; voffB[i] = (unsigned)(Rb * g.ldb + C) * 2u; }
    const size_t kstep = (size_t)(BK * 2);
    const size_t hstepA = (size_t)HALF * g.lda * 2, hstepB = (size_t)HALF * g.ldb * 2;
    const size_t tstepA = 2 * hstepA, tstepB = 2 * hstepB;
    const unsigned ldsw = (unsigned)wid * 1024u;
    const int aoff = lds_byte(wr * 64 + fr, fq * 8), boff = lds_byte(wc * 32 + fr, fq * 8);
#define PG8_SA(b, h) (((b) * 2 + (h)) * HTB)
#define PG8_SB(b, h) ((4 + (b) * 2 + (h)) * HTB)
#define PG8_STAGE(bufoff, gbase, voff) do { _Pragma("unroll") for (int _i = 0; _i < 2; ++_i) \
        __builtin_amdgcn_global_load_lds((const unsigned*)((const char*)(gbase) + (voff)[_i]), (PG8_LAS unsigned*)(lds + (bufoff) + ldsw + _i * 8192), 16, 0, 0); } while (0)
#define PG8_LDA(dst, b, h) do { _Pragma("unroll") for (int m = 0; m < 4; ++m) _Pragma("unroll") for (int k = 0; k < 2; ++k) dst[m][k] = *(const PG8_LAS bf16x8*)(lds + PG8_SA(b, h) + aoff + m * 2048 + k * 1024); } while (0)
#define PG8_LDB(dst, b, h) do { _Pragma("unroll") for (int n = 0; n < 2; ++n) _Pragma("unroll") for (int k = 0; k < 2; ++k) dst[n][k] = *(const PG8_LAS bf16x8*)(lds + PG8_SB(b, h) + boff + n * 2048 + k * 1024); } while (0)
#define PG8_MMA(ai, bj, At, Bt) do { __builtin_amdgcn_s_setprio(1); _Pragma("unroll") for (int m = 0; m < 4; ++m) _Pragma("unroll") for (int n = 0; n < 2; ++n) _Pragma("unroll") for (int k = 0; k < 2; ++k) \
        acc[ai][bj][m][n] = __builtin_amdgcn_mfma_f32_16x16x32_bf16(Bt[n][k], At[m][k], acc[ai][bj][m][n], 0, 0, 0); __builtin_amdgcn_s_setprio(0); } while (0)
#define PG8_WAIT_V(n) asm volatile("s_waitcnt vmcnt(" #n ")" ::: "memory")
#define PG8_WAIT_L(n) asm volatile("s_waitcnt lgkmcnt(" #n ")" ::: "memory")
#define PG8_BAR __builtin_amdgcn_s_barrier()
#define PG8_SCHED __builtin_amdgcn_sched_barrier(0)
    Unit cur, nxt; int ui = 0;
    if (!S.next(0, cur)) return;
    f32x4 acc[2][2][4][2];
#pragma unroll
    for (int a = 0; a < 2; ++a)
#pragma unroll
        for (int b = 0; b < 2; ++b)
#pragma unroll
            for (int m = 0; m < 4; ++m)
#pragma unroll
                for (int n = 0; n < 2; ++n) acc[a][b][m][n] = (f32x4){0.f, 0.f, 0.f, 0.f};
    bf16x8 At[4][2], B0[2][2], B1[2][2];
    const char* cA = (const char*)g.A + (size_t)cur.pm * tstepA; const char* cB = (const char*)g.Bt + (size_t)cur.pn * tstepB;
    S.a_ready(cur);
    E.prefetch_sync(cur, tid, lds, 0); E.prefetch_dma(cur, wid, lane, lds, 0);
    PG8_STAGE(PG8_SB(0, 0), cB, voffB); PG8_STAGE(PG8_SB(0, 1), cB + hstepB, voffB); PG8_STAGE(PG8_SA(0, 0), cA, voffA); PG8_STAGE(PG8_SA(0, 1), cA + hstepA, voffA);
    if (wr == 1) PG8_BAR;
    PG8_WAIT_V(2); PG8_BAR;
    PG8_STAGE(PG8_SB(1, 0), cB + kstep, voffB); PG8_STAGE(PG8_SA(1, 0), cA + kstep, voffA); PG8_STAGE(PG8_SB(1, 1), cB + hstepB + kstep, voffB);
    PG8_WAIT_V(6); PG8_BAR;
    for (;;) {
        const bool has_next = S.next(ui + 1, nxt);
        const char* nA = has_next ? (const char*)g.A + (size_t)nxt.pm * tstepA : cA; const char* nB = has_next ? (const char*)g.Bt + (size_t)nxt.pn * tstepB : cB;
        for (int t = 0; t < nt; t += 2) {
            const bool last = (t == nt - 2);
            const char* a1 = cA + (size_t)(t + 1) * kstep;
            const char* a2 = last ? nA : cA + (size_t)(t + 2) * kstep; const char* b2 = last ? nB : cB + (size_t)(t + 2) * kstep;
            const char* a3 = a2 + kstep; const char* b3 = b2 + kstep;
            if (last && has_next) { S.a_ready(nxt); E.prefetch_dma(nxt, wid, lane, lds, (ui + 1) & 1); }
            PG8_LDB(B0, 0, 0); PG8_LDB(B1, 0, 1); PG8_SCHED; PG8_LDA(At, 0, 0); PG8_STAGE(PG8_SA(1, 1), a1 + hstepA, voffA);
            PG8_WAIT_V(8); PG8_WAIT_L(0); PG8_BAR; PG8_MMA(0, 0, At, B0); PG8_MMA(0, 1, At, B1); PG8_BAR; PG8_SCHED;
            PG8_LDA(At, 0, 1); PG8_STAGE(PG8_SB(0, 0), b2, voffB); PG8_STAGE(PG8_SB(0, 1), b2 + hstepB, voffB); PG8_STAGE(PG8_SA(0, 0), a2, voffA);
            PG8_WAIT_V(8); PG8_WAIT_L(0); PG8_BAR; PG8_MMA(1, 0, At, B0); PG8_MMA(1, 1, At, B1); PG8_BAR; PG8_SCHED;
            PG8_LDB(B0, 1, 0); PG8_LDB(B1, 1, 1); PG8_SCHED; PG8_LDA(At, 1, 0); PG8_STAGE(PG8_SA(0, 1), a2 + hstepA, voffA);
            PG8_WAIT_V(8); PG8_WAIT_L(0); PG8_BAR; PG8_MMA(0, 0, At, B0); PG8_MMA(0, 1, At, B1); PG8_BAR; PG8_SCHED;
            PG8_LDA(At, 1, 1); PG8_STAGE(PG8_SB(1, 0), b3, voffB); PG8_STAGE(PG8_SB(1, 1), b3 + hstepB, voffB); PG8_STAGE(PG8_SA(1, 0), a3, voffA);
            PG8_WAIT_V(8); PG8_WAIT_L(0); PG8_BAR; PG8_MMA(1, 0, At, B0); PG8_MMA(1, 1, At, B1); PG8_BAR; PG8_SCHED;
        }
        if constexpr (ALIGN_EPI) { if (wr == 0) PG8_BAR; }
        E(acc, cur, wr, wc, fr, fq, lds, ui & 1);
        if (!has_next) break;
#pragma unroll
        for (int a = 0; a < 2; ++a)
#pragma unroll
            for (int b = 0; b < 2; ++b)
#pragma unroll
                for (int m = 0; m < 4; ++m)
#pragma unroll
                    for (int n = 0; n < 2; ++n) acc[a][b][m][n] = (f32x4){0.f, 0.f, 0.f, 0.f};
        cur = nxt; cA = nA; cB = nB; ++ui;
        E.prefetch_sync(cur, tid, lds, ui & 1);
        if constexpr (ALIGN_EPI) { if (wr == 1) PG8_BAR; }
    }
    PG8_WAIT_V(0);
    if constexpr (!ALIGN_EPI) { if (wr == 0) PG8_BAR; }
    PG8_BAR;
#undef PG8_SA
#undef PG8_SB
#undef PG8_STAGE
#undef PG8_LDA
#undef PG8_LDB
#undef PG8_MMA
#undef PG8_WAIT_V
#undef PG8_WAIT_L
#undef PG8_BAR
#undef PG8_SCHED
}
}
constexpr int NWAVES = 8, NTHR = 512;
constexpr int D = 1024, TCTX = 8192, TSMP = 2048, T = 10240, TP = T + 512;
constexpr int DFF = 2816, NMODV = 9 * 1024;
constexpr int EVEN_NP = 2816, ODD_NP = 1792;
constexpr float EPS = 1e-6f;
constexpr int NCHUNK = 80;

constexpr size_t MiB = 1u << 20;
constexpr size_t WS_CTL = 0, CTL_ZERO_BYTES = 64 * 1024;
constexpr size_t WS_MOD = 1 * MiB;
constexpr size_t WS_ROPE = WS_MOD + 512 * 1024;
constexpr size_t WS_DEC = WS_ROPE + 160 * 1024;
constexpr size_t WS_SSQ = WS_MOD + 768 * 1024;
constexpr size_t WS_BIAS = 2 * MiB;
constexpr size_t BIAS_LD = 5632, BIAS_MS = 16 * BIAS_LD;
constexpr size_t WS_BIASF = 15 * MiB;
constexpr size_t WS_WGU = 16 * MiB;
constexpr size_t SZ_WGU = (size_t)5632 * 1024 * 2;
constexpr size_t WS_WD = WS_WGU + 8 * SZ_WGU;
constexpr size_t SZ_WD = (size_t)1024 * 2816 * 2;
constexpr size_t WS_WIE = WS_WD + 8 * SZ_WD;
constexpr size_t SZ_WIE = (size_t)EVEN_NP * 1024 * 2;
constexpr size_t WS_WOE = WS_WIE + 2 * SZ_WIE;
constexpr size_t SZ_WO = (size_t)1024 * 1024 * 2;
constexpr size_t WS_WIO = WS_WOE + 2 * SZ_WO;
constexpr size_t SZ_WIO = (size_t)ODD_NP * 1024 * 2;
constexpr size_t WS_WOO = WS_WIO + 2 * SZ_WIO;
constexpr size_t WS_WUQ = WS_WOO + 2 * SZ_WO;
constexpr size_t SZ_WUQ = (size_t)768 * 384 * 2;
constexpr size_t WS_WKV = WS_WUQ + 2 * SZ_WUQ;
constexpr size_t SZ_WKV = (size_t)1024 * 256 * 2;
constexpr size_t WS_WEND = WS_WKV + 2 * SZ_WKV;
constexpr size_t WS_X = (WS_WEND + MiB - 1) / MiB * MiB;
constexpr size_t WS_XA = WS_X + (size_t)T * D * 4;
constexpr size_t WS_PROJ = WS_XA + (size_t)T * D * 2;
constexpr size_t WS_YMIX = WS_PROJ + (size_t)T * EVEN_NP * 2;
constexpr size_t WS_H = WS_YMIX + (size_t)T * D * 2;
constexpr size_t WS_ST = WS_H;
constexpr size_t WS_QA = WS_H;
constexpr size_t WS_CKVA = WS_QA + (size_t)T * 384 * 2;
constexpr size_t WS_KR = WS_CKVA + (size_t)TP * 256 * 2;
constexpr size_t WS_Q = WS_KR + (size_t)TP * 32 * 2;
constexpr size_t WS_KN = WS_Q + (size_t)T * 768 * 2;
constexpr size_t WS_VT = WS_KN + (size_t)TP * 512 * 2;
constexpr size_t WS_HEND = WS_H + (size_t)T * DFF * 2;
static_assert(WS_VT + (size_t)512 * TP * 2 <= WS_HEND, "odd-layer scratch fits the H overlay");
static_assert(WS_ST + (size_t)NCHUNK * 8 * 2 * 8192 * 4 <= WS_HEND, "chunk states fit the H overlay");
constexpr size_t WS_XCT = WS_HEND;
constexpr size_t WS_CC = WS_XCT + (size_t)NCHUNK * 8 * 8192 * 2;
constexpr size_t WS_CBM = WS_CC + (size_t)T * 256 * 2;
constexpr size_t WS_HIN = WS_CBM + (size_t)NCHUNK * 2 * 16384 * 2;
constexpr size_t WS_END = WS_HIN + (size_t)NCHUNK * 8 * 2 * 8192 * 2;

constexpr size_t OUT_Y = 0, OUT_SSD = (size_t)T * D, OUT_CKV = OUT_SSD + (size_t)32 * 2 * 2 * 8 * 64 * 128, OUT_KR = OUT_CKV + (size_t)32 * 2 * 256 * 256, OUT_END = OUT_KR + (size_t)32 * 2 * 256 * 32;

constexpr int RING_BYTES = 131072;
constexpr int LDSCTL_OFF = 144 * 1024 - 512, MISC_OFF = LDSCTL_OFF + 320;
constexpr int LDS_BYTES = 147456;

#define GAS __attribute__((address_space(1)))
#define LAS __attribute__((address_space(3)))
typedef unsigned short bf16;
typedef unsigned v4u __attribute__((ext_vector_type(4)));
typedef unsigned v2u __attribute__((ext_vector_type(2)));
typedef float f32x4 __attribute__((ext_vector_type(4)));
typedef short bf16x8 __attribute__((ext_vector_type(8)));
typedef GAS unsigned gu32;
#define RLX_AGENT __ATOMIC_RELAXED, __HIP_MEMORY_SCOPE_AGENT
__device__ __forceinline__ unsigned f2bf(float f) { unsigned u = __builtin_bit_cast(unsigned, f); return (u + 0x7fffu + ((u >> 16) & 1u)) >> 16; }
typedef float f32x2_t __attribute__((ext_vector_type(2)));
typedef __bf16 bf16x2_t __attribute__((ext_vector_type(2)));
__device__ __forceinline__ unsigned pk2(float lo, float hi) { const f32x2_t v = {lo, hi}; const bf16x2_t b = __builtin_convertvector(v, bf16x2_t); return __builtin_bit_cast(unsigned, b); }
__device__ __forceinline__ unsigned f2bf1(float f) { return pk2(f, 0.f) & 0xffffu; }
__device__ __forceinline__ float bflo(unsigned w) { return __builtin_bit_cast(float, w << 16); }
__device__ __forceinline__ float bfhi(unsigned w) { return __builtin_bit_cast(float, w & 0xffff0000u); }
__device__ __forceinline__ float bf1(bf16 h) { return __builtin_bit_cast(float, ((unsigned)h) << 16); }
__device__ __forceinline__ void unpack8(const v4u v, float* o) { o[0] = bflo(v.x); o[1] = bfhi(v.x); o[2] = bflo(v.y); o[3] = bfhi(v.y); o[4] = bflo(v.z); o[5] = bfhi(v.z); o[6] = bflo(v.w); o[7] = bfhi(v.w); }
__device__ __forceinline__ v4u pack8(const float* o) { v4u v; v.x = pk2(o[0], o[1]); v.y = pk2(o[2], o[3]); v.z = pk2(o[4], o[5]); v.w = pk2(o[6], o[7]); return v; }
template <int K> __device__ __forceinline__ float xlane(float v) { static_assert(K >= 1 && K < 32, "xor mask inside a 32-lane half");
    return __builtin_bit_cast(float, __builtin_amdgcn_ds_swizzle(__builtin_bit_cast(int, v), (K << 10) | 0x1F)); }
__device__ __forceinline__ float sum_x32(float v) { const unsigned u = __builtin_bit_cast(unsigned, v); const auto r = __builtin_amdgcn_permlane32_swap(u, u, false, false);
    return __builtin_bit_cast(float, (unsigned)r[0]) + __builtin_bit_cast(float, (unsigned)r[1]); }
__device__ __forceinline__ float max_x32(float v) { const unsigned u = __builtin_bit_cast(unsigned, v); const auto r = __builtin_amdgcn_permlane32_swap(u, u, false, false);
    return fmaxf(__builtin_bit_cast(float, (unsigned)r[0]), __builtin_bit_cast(float, (unsigned)r[1])); }
__device__ __forceinline__ float wave_sum(float v) {
    v += xlane<1>(v); v += xlane<2>(v); v += xlane<4>(v); v += xlane<8>(v); v += xlane<16>(v);
    return sum_x32(v);
}
__device__ __forceinline__ float frcp(float x) { return __builtin_amdgcn_rcpf(x); }
__device__ __forceinline__ float frsq(float x) { return __builtin_amdgcn_rsqf(x); }
__device__ __forceinline__ float sigmoidf_(float x) { return frcp(1.0f + __expf(-x)); }
__device__ __forceinline__ float siluf_(float x) { return x * frcp(1.0f + __expf(-x)); }
__device__ __forceinline__ float gelu_tanh(float x) { const float y = 0.7978845608028654f * (x + 0.044715f * x * x * x); const float t = 1.0f - 2.0f * frcp(1.0f + __expf(2.0f * y)); return 0.5f * x * (1.0f + t); }
__device__ __forceinline__ float softplusf_(float x) { const float e = __expf(x); return x > 20.f ? x : (e < 1e-3f ? e * (1.0f - 0.5f * e) : __logf(1.0f + e)); }
__device__ __forceinline__ int modrow_of_tile(int pm) { return pm < 32 ? 0 : 1 + ((pm - 32) >> 2); }
__device__ __forceinline__ int modrow_of_tok(int t) { return t < TCTX ? 0 : 1 + ((t - TCTX) >> 10); }

#define XB_TMO      128
#define XB_XCNT(j)  (256  + 64 * (j))
#define XB_XSUB(j)  (1280 + 64 * (j))
#define XB_XGEN(j)  (2304 + 64 * (j))
#define XB_TOP      3328
#define XB_TOPGEN   3392
#define XCD_BAR_WORDS 3456
#define XB_SPIN_CAP (1u << 22)
__device__ __forceinline__ unsigned xb_ld(unsigned* p)              { return __hip_atomic_load(p, __ATOMIC_RELAXED, __HIP_MEMORY_SCOPE_AGENT); }
__device__ __forceinline__ unsigned xb_add(unsigned* p, unsigned v) { return __hip_atomic_fetch_add(p, v, __ATOMIC_RELAXED, __HIP_MEMORY_SCOPE_AGENT); }
__device__ __forceinline__ unsigned xb_xcc_id() { return (unsigned)__builtin_amdgcn_s_getreg((3 << 11) | 20) & 0xFu; }
#define XB_SPIN(cond, bar) do { unsigned _sp = 0; while (cond) { __builtin_amdgcn_s_sleep(1); \
    if ((++_sp & 255u) == 0u) { if (xb_ld(&(bar)[XB_TMO])) break; if (_sp > XB_SPIN_CAP) { atomicAdd(&(bar)[XB_TMO], 1u); break; } } } } while (0)
struct XcdBarrier { unsigned* bar; unsigned x; volatile LAS unsigned* st; };
__device__ __forceinline__ XcdBarrier xcd_barrier_post(unsigned* bar, volatile LAS unsigned* st) {
    XcdBarrier b; b.bar = bar; b.x = xb_xcc_id(); b.st = st;
    if (threadIdx.x == 0) (void)xb_add(&bar[XB_XCNT(b.x)], 1u);
    return b;
}
__device__ __forceinline__ void xcd_barrier_complete(unsigned* bar, unsigned x, unsigned& nloc, unsigned& nx) {
    const unsigned G = gridDim.x * gridDim.y * gridDim.z;
    unsigned sum, cnt, mine, sp = 0u;
    for (;;) {
        sum = 0u; cnt = 0u; mine = 0u;
#pragma unroll
        for (unsigned j = 0; j < 16; ++j) { const unsigned c = xb_ld(&bar[XB_XCNT(j)]); sum += c; cnt += (c > 0u) ? 1u : 0u; mine = (j == x) ? c : mine; }
        if (sum == G) break;
        __builtin_amdgcn_s_sleep(1);
        if ((++sp & 255u) == 0u) { if (xb_ld(&bar[XB_TMO])) break; if (sp > XB_SPIN_CAP) { atomicAdd(&bar[XB_TMO], 1u); break; } }
    }
    nloc = mine > 0u ? mine : 1u; nx = cnt > 0u ? cnt : 1u;
}
__device__ __forceinline__ void xcd_barrier(const XcdBarrier& b) {
    asm volatile("s_waitcnt vmcnt(0)" ::: "memory");
    __syncthreads();
    if (threadIdx.x == 0) {
        unsigned* bar = b.bar;
        __builtin_amdgcn_s_waitcnt(0);
        unsigned nloc = b.st[0], nx = b.st[1];
        if (nloc == 0u) { xcd_barrier_complete(bar, b.x, nloc, nx); b.st[0] = nloc; b.st[1] = nx; }
        const unsigned old = xb_add(&bar[XB_XSUB(b.x)], 1u);
        const unsigned gen = old / nloc;
        if (old + 1u == (gen + 1u) * nloc) {
            __builtin_amdgcn_fence(__ATOMIC_RELEASE, "agent");
            asm volatile("s_waitcnt vmcnt(0)" ::: "memory");
            const unsigned og = xb_add(&bar[XB_TOP], 1u);
            const unsigned tg = og / nx;
            if (og + 1u == (tg + 1u) * nx) xb_add(&bar[XB_TOPGEN], 1u);
            else XB_SPIN(xb_ld(&bar[XB_TOPGEN]) == tg, bar);
            __builtin_amdgcn_fence(__ATOMIC_ACQUIRE, "agent");
            xb_add(&bar[XB_XGEN(b.x)], 1u);
            asm volatile("s_waitcnt vmcnt(0)" ::: "memory");
        } else {
            XB_SPIN(xb_ld(&bar[XB_XGEN(b.x)]) == gen, bar);
            __builtin_amdgcn_fence(__ATOMIC_ACQUIRE, "agent");
            asm volatile("s_waitcnt vmcnt(0)" ::: "memory");
        }
    }
    __syncthreads();
}

struct Args { const float* in[34]; float* out; unsigned char* ws; int ph_lo, ph_hi, li, pad; };
typedef const __attribute__((address_space(4))) Args* CArgsP;
enum { I_XP = 0, I_XS, I_SSD, I_CCKV, I_CKR, I_C, I_CCTX, I_WMOD, I_BMOD, I_GNORM, I_WGU, I_WDN, I_WIE, I_WOE, I_WSP, I_BSP, I_GV, I_WCS, I_BCS, I_DTB, I_ALOG, I_DSK, I_GSO,
       I_WIO, I_WOO, I_GCQ, I_WUQ, I_GCKV, I_WUKV, I_WDW, I_BDW, I_GLN, I_BLN, I_GFIN };
using pg8::Unit;
constexpr int EP_PART = RING_BYTES, EP_S = RING_BYTES + 4096, EP_B = RING_BYTES + 4096 + 8192;
__device__ __forceinline__ void epi_prefetch_dma(GAS unsigned char* ws, int bias_off, const Unit& u, int wid, int lane, PG8_LAS unsigned char* ldsl, int par) {
    if (wid < 4) __builtin_amdgcn_global_load_lds((const GAS unsigned*)(ws + WS_SSQ + ((size_t)(u.pm * 256 + 64 * wid + lane) * 4) * 4), (PG8_LAS unsigned*)(ldsl + EP_S + par * 4096 + wid * 1024), 16, 0, 0);
    else if (wid == 4) __builtin_amdgcn_global_load_lds((const GAS unsigned*)(ws + WS_BIASF + ((size_t)bias_off / 16 + (size_t)modrow_of_tile(u.pm) * BIAS_LD + u.pn * 256 + 4 * lane) * 4), (PG8_LAS unsigned*)(ldsl + EP_B + par * 1024), 16, 0, 0);
}
__device__ __forceinline__ void epi_prefetch_sync16(GAS unsigned char* ws, int bias_off, const Unit& u, int tid, PG8_LAS unsigned char* ldsl, int par) {
    if (tid < 256) *(PG8_LAS pg8::f32x4*)(ldsl + EP_S + par * 4096 + tid * 16) = *(const GAS pg8::f32x4*)(ws + WS_SSQ + ((size_t)(u.pm * 256 + tid) * 4) * 4);
    else { const GAS float* bp = (const GAS float*)(ws + WS_BIAS) + (size_t)bias_off + (size_t)modrow_of_tile(u.pm) * BIAS_MS + u.pn * 256 + (tid - 256); float b = 0.f;
#pragma unroll
        for (int kb = 0; kb < 16; ++kb) b += bp[(size_t)kb * BIAS_LD];
        ((PG8_LAS float*)(ldsl + EP_B))[par * 256 + (tid - 256)] = b; }
}
__device__ __forceinline__ float epi_row_rstd(const PG8_LAS unsigned char* ldsl, int par, int rl) { const pg8::f32x4 s = *(const PG8_LAS pg8::f32x4*)(ldsl + EP_S + par * 4096 + rl * 16); return frsq(((s[0] + s[1]) + (s[2] + s[3])) * (1.f / D) + EPS); }
struct EpiSwiglu {
    static constexpr bool PERM = true;
    GAS unsigned char* ws; int bias_off, nparts;
    __device__ __forceinline__ void prefetch_dma(const Unit& u, int wid, int lane, PG8_LAS unsigned char* ldsl, int par) const { if (nparts == 1) epi_prefetch_dma(ws, bias_off, u, wid, lane, ldsl, par); }
    __device__ __forceinline__ void prefetch_sync(const Unit& u, int tid, PG8_LAS unsigned char* ldsl, int par) const { if (nparts != 1) epi_prefetch_sync16(ws, bias_off, u, tid, ldsl, par); }
    __device__ __forceinline__ void operator()(const pg8::f32x4 (&acc)[2][2][4][2], const Unit& u, int wr, int wc, int fr, int fq, PG8_LAS unsigned char* ldsl, int par) const {
        bf16* H = (bf16*)(GAS bf16*)(ws + WS_H);
        const PG8_LAS float* bb = (const PG8_LAS float*)(ldsl + EP_B) + par * 256 + wc * 32 + 8 * fq;
        const int row0 = u.pm * 256 + wr * 64 + fr, col0 = u.pn * 128 + wc * 32 + 8 * fq;
        const pg8::f32x4 bg0 = *(const PG8_LAS pg8::f32x4*)bb, bg1 = *(const PG8_LAS pg8::f32x4*)(bb + 4), bu0 = *(const PG8_LAS pg8::f32x4*)(bb + 128), bu1 = *(const PG8_LAS pg8::f32x4*)(bb + 132);
#pragma unroll
        for (int ai = 0; ai < 2; ++ai)
#pragma unroll
            for (int m = 0; m < 4; ++m) {
                const int rl = ai * 128 + wr * 64 + m * 16 + fr;
                const float rs = epi_row_rstd(ldsl, par, rl);
                bf16* rowp = H + (size_t)(u.pm * 256 + rl) * DFF + col0;
                const pg8::f32x4 g0 = acc[ai][0][m][0] * rs + bg0, g1 = acc[ai][0][m][1] * rs + bg1, u0 = acc[ai][1][m][0] * rs + bu0, u1 = acc[ai][1][m][1] * rs + bu1;
                float gg[8], uu[8], e[8], o[8];
#pragma unroll
                for (int j = 0; j < 4; ++j) { gg[j] = g0[j]; gg[4 + j] = g1[j]; uu[j] = u0[j]; uu[4 + j] = u1[j]; }
#pragma unroll
                for (int j = 0; j < 8; ++j) e[j] = __builtin_amdgcn_exp2f(gg[j] * -1.4426950408889634f);
#pragma unroll
                for (int j = 0; j < 8; ++j) e[j] = __builtin_amdgcn_rcpf(1.0f + e[j]);
#pragma unroll
                for (int j = 0; j < 8; ++j) o[j] = (gg[j] * uu[j]) * e[j];
                pg8::u32x4 w; w.x = pg8::cvt_pk_bf16(o[0], o[1]); w.y = pg8::cvt_pk_bf16(o[2], o[3]); w.z = pg8::cvt_pk_bf16(o[4], o[5]); w.w = pg8::cvt_pk_bf16(o[6], o[7]);
                *(pg8::u32x4*)rowp = w;
            }
        (void)row0;
    }
};
struct EpiResid {
    static constexpr bool PERM = true;
    GAS unsigned char* ws; const float* gn; int gate_off, scn_off; float coef;
    __device__ __forceinline__ void prefetch_dma(const Unit&, int, int, PG8_LAS unsigned char*, int) const {}
    __device__ __forceinline__ void prefetch_sync(const Unit&, int, PG8_LAS unsigned char*, int) const {}
    __device__ __forceinline__ void operator()(const pg8::f32x4 (&acc)[2][2][4][2], const Unit& u, int wr, int wc, int fr, int fq, PG8_LAS unsigned char* ldsl, int) const {
        bf16* X = (bf16*)(GAS bf16*)(ws + WS_X); const float* gate = (const float*)(const GAS float*)(ws + WS_MOD) + gate_off; const float* scn = (const float*)(const GAS float*)(ws + WS_MOD) + scn_off;
        bf16* XA = (bf16*)(GAS bf16*)(ws + WS_XA); float* SSQ = (float*)(GAS float*)(ws + WS_SSQ); PG8_LAS float* part = (PG8_LAS float*)(ldsl + EP_PART);
        const int row0 = u.pm * 256 + wr * 64 + fr, col0 = u.pn * 256 + wc * 32 + 8 * fq;
        const int mr = modrow_of_tile(u.pm);
        float ss[2][4];
#pragma unroll
        for (int ai = 0; ai < 2; ++ai)
#pragma unroll
            for (int m = 0; m < 4; ++m) ss[ai][m] = 0.f;
#pragma unroll
        for (int bj = 0; bj < 2; ++bj) {
            const int co = col0 + bj * 128;
            const float* gp = gate + (size_t)mr * NMODV + co; const float* sp = scn + (size_t)mr * NMODV + co;
            const pg8::f32x4 gv0 = *(const pg8::f32x4*)gp * coef, gv1 = *(const pg8::f32x4*)(gp + 4) * coef;
            const pg8::f32x4 gc0 = *(const pg8::f32x4*)(gn + co) * (*(const pg8::f32x4*)sp + 1.0f), gc1 = *(const pg8::f32x4*)(gn + co + 4) * (*(const pg8::f32x4*)(sp + 4) + 1.0f);
#pragma unroll
            for (int ai = 0; ai < 2; ++ai) {
                pg8::u32x4 xo[4];
#pragma unroll
                for (int m = 0; m < 4; ++m) xo[m] = *(const pg8::u32x4*)(X + (size_t)(row0 + ai * 128 + m * 16) * D + co);
#pragma unroll
                for (int m = 0; m < 4; ++m) {
                    const size_t off = (size_t)(row0 + ai * 128 + m * 16) * D + co;
                    const pg8::u32x4 xw = xo[m];
                    const pg8::f32x4 x0 = {bflo(xw.x), bfhi(xw.x), bflo(xw.y), bfhi(xw.y)}, x1 = {bflo(xw.z), bfhi(xw.z), bflo(xw.w), bfhi(xw.w)};
                    const pg8::f32x4 n0 = x0 + gv0 * acc[ai][bj][m][0], n1 = x1 + gv1 * acc[ai][bj][m][1];
                    ss[ai][m] += ((n0[0] * n0[0] + n0[1] * n0[1]) + (n0[2] * n0[2] + n0[3] * n0[3])) + ((n1[0] * n1[0] + n1[1] * n1[1]) + (n1[2] * n1[2] + n1[3] * n1[3]));
                    pg8::u32x4 w; w.x = pg8::cvt_pk_bf16(n0[0], n0[1]); w.y = pg8::cvt_pk_bf16(n0[2], n0[3]); w.z = pg8::cvt_pk_bf16(n1[0], n1[1]); w.w = pg8::cvt_pk_bf16(n1[2], n1[3]);
                    *(pg8::u32x4*)(X + off) = w;
                    const pg8::f32x4 a0 = n0 * gc0, a1 = n1 * gc1;
                    pg8::u32x4 v; v.x = pg8::cvt_pk_bf16(a0[0], a0[1]); v.y = pg8::cvt_pk_bf16(a0[2], a0[3]); v.z = pg8::cvt_pk_bf16(a1[0], a1[1]); v.w = pg8::cvt_pk_bf16(a1[2], a1[3]);
                    *(pg8::u32x4*)(XA + off) = v;
                }
            }
        }
#pragma unroll
        for (int ai = 0; ai < 2; ++ai)
#pragma unroll
            for (int m = 0; m < 4; ++m) { float s = ss[ai][m]; s += xlane<16>(s); s = sum_x32(s);
                if (fq == 0) part[wc * 256 + ai * 128 + wr * 64 + m * 16 + fr] = s; }
        asm volatile("s_waitcnt lgkmcnt(0)" ::: "memory"); __builtin_amdgcn_s_barrier(); asm volatile("" ::: "memory");
        const int t = (wr * 4 + wc) * 64 + fq * 16 + fr;
        if (t < 256) SSQ[(size_t)(u.pm * 256 + t) * 4 + u.pn] = (part[t] + part[256 + t]) + (part[512 + t] + part[768 + t]);
    }
};
struct EpiStore {
    static constexpr bool PERM = true;
    GAS unsigned char* ws; unsigned o_off; int ldc; int bias_off;
    __device__ __forceinline__ void prefetch_dma(const Unit& u, int wid, int lane, PG8_LAS unsigned char* ldsl, int par) const { if (bias_off >= 0) epi_prefetch_dma(ws, bias_off, u, wid, lane, ldsl, par); }
    __device__ __forceinline__ void prefetch_sync(const Unit&, int, PG8_LAS unsigned char*, int) const {}
    __device__ __forceinline__ void operator()(const pg8::f32x4 (&acc)[2][2][4][2], const Unit& u, int wr, int wc, int fr, int fq, PG8_LAS unsigned char* ldsl, int par) const {
        bf16* O = (bf16*)(GAS bf16*)(ws + o_off);
        const PG8_LAS float* bb = (const PG8_LAS float*)(ldsl + EP_B) + par * 256 + wc * 32 + 8 * fq;
        const int col0 = u.pn * 256 + wc * 32 + 8 * fq; const bool nrm = bias_off >= 0;
        pg8::f32x4 b[2][2];
#pragma unroll
        for (int bj = 0; bj < 2; ++bj)
#pragma unroll
            for (int n = 0; n < 2; ++n) { const pg8::f32x4 bv = *(const PG8_LAS pg8::f32x4*)(bb + bj * 128 + 4 * n); b[bj][n] = nrm ? bv : (pg8::f32x4){0.f, 0.f, 0.f, 0.f}; }
#pragma unroll
        for (int ai = 0; ai < 2; ++ai)
#pragma unroll
            for (int m = 0; m < 4; ++m) {
                const int rl = ai * 128 + wr * 64 + m * 16 + fr;
                const float rs0 = epi_row_rstd(ldsl, par, rl), rs = nrm ? rs0 : 1.0f;
                bf16* rowp = O + (size_t)(u.pm * 256 + rl) * ldc + col0;
#pragma unroll
                for (int bj = 0; bj < 2; ++bj) {
                    const pg8::f32x4 v0 = acc[ai][bj][m][0] * rs + b[bj][0], v1 = acc[ai][bj][m][1] * rs + b[bj][1];
                    pg8::u32x4 w; w.x = pg8::cvt_pk_bf16(v0[0], v0[1]); w.y = pg8::cvt_pk_bf16(v0[2], v0[3]); w.z = pg8::cvt_pk_bf16(v1[0], v1[1]); w.w = pg8::cvt_pk_bf16(v1[2], v1[3]);
                    *(pg8::u32x4*)(rowp + bj * 128) = w;
                }
            }
    }
};

struct Frame {
    unsigned char* lds;
    mutable int tid, lane; int wave, bid, G;
    __device__ __forceinline__ void relane() const { int ln; asm volatile("v_mbcnt_lo_u32_b32 %0, -1, 0\n\tv_mbcnt_hi_u32_b32 %0, -1, %0" : "=v"(ln)); lane = ln; tid = wave * 64 + ln; }
    CArgsP a;
    GAS unsigned char* ws;
};
#define WSP(type, off) ((type*)(GAS type*)(F.ws + (off)))
#define AIN(i) ((const float*)(const GAS float*)F.a->in[i])
#define AOUT ((float*)(GAS float*)F.a->out)

__device__ __forceinline__ void p0_transpose_item(const float* W, int N, bf16* WT, int ldt, int k0, int n0, int dst_row0, float* scr, int lane, const float* shift, float* bias_out) {
    const int n = n0 + (lane & 31); const bool ok = n < N;
#pragma unroll 8
    for (int i = 0; i < 32; ++i) { const int kk = 2 * i + (lane >> 5); scr[kk * 33 + (lane & 31)] = ok ? W[(size_t)(k0 + kk) * N + n] : 0.f; }
    if (bias_out) {
#pragma unroll
        for (int m = 0; m < 3; ++m) scr[64 * 33 + m * 64 + lane] = shift[(size_t)m * NMODV + lane];
    }
    asm volatile("s_waitcnt lgkmcnt(0)" ::: "memory");
    const int c = lane & 7;
#pragma unroll
    for (int j = 0; j < 4; ++j) { const int nn = (lane >> 3) + 8 * j; const float* s = scr + (8 * c) * 33 + nn;
        v4u o; o.x = pk2(s[0 * 33], s[1 * 33]); o.y = pk2(s[2 * 33], s[3 * 33]); o.z = pk2(s[4 * 33], s[5 * 33]); o.w = pk2(s[6 * 33], s[7 * 33]);
        *(v4u*)(WT + (size_t)(dst_row0 + nn) * ldt + k0 + 8 * c) = o; }
    if (bias_out) {
        const int kh = lane >> 5, nl = lane & 31; float a0 = 0.f, a1 = 0.f, a2 = 0.f;
#pragma unroll 8
        for (int i = 0; i < 32; ++i) { const int kk = kh * 32 + i; const float wv = scr[kk * 33 + nl];
            a0 += wv * scr[64 * 33 + kk]; a1 += wv * scr[64 * 33 + 64 + kk]; a2 += wv * scr[64 * 33 + 128 + kk]; }
        a0 = sum_x32(a0); a1 = sum_x32(a1); a2 = sum_x32(a2);
        if (lane < 32) { float* bo = bias_out + (size_t)(k0 >> 6) * BIAS_LD + dst_row0 + nl; bo[0] = a0; bo[BIAS_MS] = a1; bo[2 * BIAS_MS] = a2; }
    }
    asm volatile("s_waitcnt lgkmcnt(0)" ::: "memory");
}
constexpr int CI_DN = 44 * 32, CI_OE = 16 * 32, CI_UQ = 6 * 24, CI_KV = 4 * 32, CI_GU = 16 * 176, CI_IE = 16 * 88, CI_IO = 16 * 56;
__host__ __device__ constexpr int conv_na(int l) { return 2 * CI_DN + CI_OE + ((l & 1) ? CI_UQ + CI_KV : 0); }
__host__ __device__ constexpr int conv_nb(int l) { return 2 * CI_GU + ((l & 1) ? CI_IO : CI_IE); }
__device__ __forceinline__ void conv_item_a(const Frame& F, int l, int it, float* scr) {
    int r = it; const int hi = l >> 1;
    if (r < 2 * CI_DN) { const int w = l * 2 + r / CI_DN, q = r % CI_DN, kb = q / 32, nb = q % 32;
        p0_transpose_item(AIN(I_WDN) + (size_t)w * DFF * 1024, 1024, WSP(bf16, WS_WD + w * SZ_WD), DFF, kb * 64, nb * 32, nb * 32, scr, F.lane, nullptr, nullptr); return; } r -= 2 * CI_DN;
    if (r < CI_OE) { const int kb = r / 32, nb = r % 32;
        if (l & 1) p0_transpose_item(AIN(I_WOO) + (size_t)hi * 1024 * 1024, 1024, WSP(bf16, WS_WOO + hi * SZ_WO), 1024, kb * 64, nb * 32, nb * 32, scr, F.lane, nullptr, nullptr);
        else       p0_transpose_item(AIN(I_WOE) + (size_t)hi * 1024 * 1024, 1024, WSP(bf16, WS_WOE + hi * SZ_WO), 1024, kb * 64, nb * 32, nb * 32, scr, F.lane, nullptr, nullptr);
        return; } r -= CI_OE;
    if (r < CI_UQ) { const int kb = r / 24, nb = r % 24;
        p0_transpose_item(AIN(I_WUQ) + (size_t)hi * 384 * 768, 768, WSP(bf16, WS_WUQ + hi * SZ_WUQ), 384, kb * 64, nb * 32, nb * 32, scr, F.lane, nullptr, nullptr); return; } r -= CI_UQ;
    { const int kb = r / 32, nb = r % 32, n0 = nb * 32, h = n0 >> 7, rr = n0 & 127;
        const int dst = (rr < 64 ? 0 : 512) + h * 64 + (rr & 63);
        p0_transpose_item(AIN(I_WUKV) + (size_t)hi * 256 * 1024, 1024, WSP(bf16, WS_WKV + hi * SZ_WKV), 256, kb * 64, n0, dst, scr, F.lane, nullptr, nullptr); }
}
__device__ __forceinline__ void conv_item_b(const Frame& F, int l, int it, float* scr) {
    int r = it; const int hi = l >> 1; const float* MOD = WSP(float, WS_MOD) + (size_t)l * 3 * NMODV; float* BIAS = WSP(float, WS_BIAS) + (size_t)(l * 3) * 3 * BIAS_MS;
    if (r < 2 * CI_GU) { const int f = r / CI_GU, w = l * 2 + f, q = r % CI_GU, kb = q / 176, nb = q % 176, n0 = nb * 32;
        const int dst = (n0 < DFF) ? ((n0 >> 7) * 256 + (n0 & 127)) : (((n0 - DFF) >> 7) * 256 + 128 + ((n0 - DFF) & 127));
        p0_transpose_item(AIN(I_WGU) + (size_t)w * 1024 * 5632, 5632, WSP(bf16, WS_WGU + w * SZ_WGU), 1024, kb * 64, n0, dst, scr, F.lane,
                          MOD + (f == 0 ? 0 : 6) * 1024 + kb * 64, BIAS + (size_t)(f == 0 ? 0 : 2) * 3 * BIAS_MS); return; } r -= 2 * CI_GU;
    if (l & 1) { const int kb = r / 56, nb = r % 56;
        p0_transpose_item(AIN(I_WIO) + (size_t)hi * 1024 * 1696, 1696, WSP(bf16, WS_WIO + hi * SZ_WIO), 1024, kb * 64, nb * 32, nb * 32, scr, F.lane, MOD + 3 * 1024 + kb * 64, BIAS + (size_t)3 * BIAS_MS); }
    else { const int kb = r / 88, nb = r % 88;
        p0_transpose_item(AIN(I_WIE) + (size_t)hi * 1024 * 2576, 2576, WSP(bf16, WS_WIE + hi * SZ_WIE), 1024, kb * 64, nb * 32, nb * 32, scr, F.lane, MOD + 3 * 1024 + kb * 64, BIAS + (size_t)3 * BIAS_MS); }
}
template <int N4> __device__ __forceinline__ void mod_tile(const Frame& F, int l, int tile) {
    constexpr int KG = 504 / N4, NC = 4 * N4;
    float* sv = (float*)F.lds;
    float* red = (float*)(F.lds + 12288);
    __syncthreads();
    for (int i = F.tid; i < 3072; i += NTHR) { const int r = i >> 10, k = i & 1023; const float c = (r == 0) ? AIN(I_CCTX)[k] : AIN(I_C)[(r - 1) * 1024 + k]; sv[i] = siluf_(c); }
    __syncthreads();
    const int n0 = tile * NC, n4 = F.tid % N4, kg = F.tid / N4;
    if (F.tid < 504) {
        f32x4 a0 = {0.f, 0.f, 0.f, 0.f}, a1 = a0, a2 = a0;
        const float* wp = AIN(I_WMOD) + (size_t)l * 1024 * NMODV + n0 + 4 * n4;
#pragma unroll 4
        for (int k = kg; k < 1024; k += KG) { const f32x4 w = *(const f32x4*)(wp + (size_t)k * NMODV); a0 += w * sv[k]; a1 += w * sv[1024 + k]; a2 += w * sv[2048 + k]; }
        *(f32x4*)(red + (kg * 3 + 0) * NC + 4 * n4) = a0; *(f32x4*)(red + (kg * 3 + 1) * NC + 4 * n4) = a1; *(f32x4*)(red + (kg * 3 + 2) * NC + 4 * n4) = a2;
    }
    __syncthreads();
    for (int o = F.tid; o < 3 * NC; o += NTHR) { const int r = o / NC, n = o % NC; float s = AIN(I_BMOD)[l * NMODV + n0 + n];
        for (int g = 0; g < KG; ++g) s += red[(g * 3 + r) * NC + n];
        WSP(float, WS_MOD)[(size_t)(l * 3 + r) * NMODV + n0 + n] = s; }
    __syncthreads();
}
__device__ __forceinline__ void bias_reduce(const Frame& F, int l, int kmask, int bgi, int nbg) {
    const float* BP = WSP(float, WS_BIAS); float* BF = WSP(float, WS_BIASF);
    const int gt = bgi * NTHR + F.tid, NT = nbg * NTHR;
    for (int i = gt; i < 3 * 3 * (int)BIAS_LD; i += NT) { const int kind = i / (3 * (int)BIAS_LD), rem = i % (3 * (int)BIAS_LD), m = rem / (int)BIAS_LD, n = rem % (int)BIAS_LD;
        if (!((kmask >> kind) & 1)) continue;
        const float* p = BP + ((size_t)(l * 3 + kind) * 3 + m) * BIAS_MS + n; float b = 0.f;
#pragma unroll
        for (int kb = 0; kb < 16; ++kb) b += p[(size_t)kb * BIAS_LD];
        BF[((size_t)(l * 3 + kind) * 3 + m) * BIAS_LD + n] = b; }
}
__device__ __forceinline__ void background_work(const Frame& F, int l, int win, int bgi, int nbg) {
    F.relane();
    if (nbg <= 0) return;
    if (win == 0) bias_reduce(F, l, 6, bgi, nbg);
    if (l >= 3) return;
    const int ln = l + 1;
    if (win == 2) bias_reduce(F, ln, 1, bgi, nbg);
    float* scr = (float*)(F.lds + F.wave * 16384);
    const int gw = bgi * NWAVES + F.wave, NGW = nbg * NWAVES;
    if (win == 0) {
        for (int t = bgi; t < 64; t += nbg) mod_tile<36>(F, ln, t);
        const int na = conv_na(ln);
        for (int it = gw; it < na; it += NGW) conv_item_a(F, ln, it, scr);
    } else {
        const int nb = conv_nb(ln), cut = CI_GU;
        const int lo = win == 1 ? 0 : cut, hi_ = win == 1 ? cut : nb;
        for (int it = lo + gw; it < hi_; it += NGW) conv_item_b(F, ln, it, scr);
    }
}
__device__ __forceinline__ void p0_phase(const Frame& F) {
    F.relane();
    for (int t = F.bid; t < 256; t += F.G) mod_tile<9>(F, 0, t);
    {
        float* scr = (float*)(F.lds + F.wave * 16384);
        const int gw = F.bid * NWAVES + F.wave, NGW = F.G * NWAVES;
        for (int it = gw; it < conv_na(0); it += NGW) conv_item_a(F, 0, it, scr);
    }
    {
        const size_t gt = (size_t)F.bid * NTHR + F.tid, NT = (size_t)F.G * NTHR;
        for (size_t i = gt; i < 1024 * 16; i += NT) { const int pos = (int)(i >> 4), ax = (int)(i >> 3) & 1, f = (int)i & 7;
            const float freq = exp2f(-(float)f * (13.287712379549449f / 8.0f));
            const float ang = (float)(ax == 0 ? (pos >> 6) : (pos & 63)) * freq;
            float sn, cs; sincosf(ang, &sn, &cs);
            WSP(float, WS_ROPE)[2 * i] = cs; WSP(float, WS_ROPE)[2 * i + 1] = sn; }
    }
}
__device__ __forceinline__ void p1_copy_phase(const Frame& F) {
    F.relane();
    float* scr = (float*)(F.lds + F.wave * 16384);
    const int gw = F.bid * NWAVES + F.wave, NGW = F.G * NWAVES;
    for (int it = gw; it < conv_nb(0); it += NGW) conv_item_b(F, 0, it, scr);
}

__device__ __forceinline__ void norm0_phase(const Frame& F) {
    F.relane();
    const int gw = F.bid * NWAVES + F.wave, NGW = F.G * NWAVES;
    bf16* X = WSP(bf16, WS_X); bf16* XA = WSP(bf16, WS_XA); float* SSQ = WSP(float, WS_SSQ);
    const float* g = AIN(I_GNORM); const float* scale = WSP(float, WS_MOD) + 1024;
    for (int row = gw; row < T; row += NGW) {
        const int r = modrow_of_tok(row);
        const f32x4* xr = (const f32x4*)(row < TCTX ? AIN(I_XP) + (size_t)row * D : AIN(I_XS) + (size_t)(row - TCTX) * D) + F.lane;
        f32x4 v[4]; float s = 0.f;
#pragma unroll
        for (int j = 0; j < 4; ++j) { v[j] = xr[64 * j]; s += (v[j].x * v[j].x + v[j].y * v[j].y) + (v[j].z * v[j].z + v[j].w * v[j].w); }
        s = wave_sum(s);
        if (F.lane == 0) *(f32x4*)(SSQ + (size_t)row * 4) = (f32x4){s, 0.f, 0.f, 0.f};
        unsigned long long* o8 = (unsigned long long*)(XA + (size_t)row * D) + F.lane;
        unsigned long long* xo = (unsigned long long*)(X + (size_t)row * D) + F.lane;
#pragma unroll
        for (int j = 0; j < 4; ++j) {
            const f32x4 gg = *((const f32x4*)g + F.lane + 64 * j), sc = *((const f32x4*)(scale + (size_t)r * NMODV) + F.lane + 64 * j);
            const f32x4 o = v[j] * gg * (sc + 1.0f);
            xo[64 * j] = (unsigned long long)pk2(v[j].x, v[j].y) | ((unsigned long long)pk2(v[j].z, v[j].w) << 32);
            o8[64 * j] = (unsigned long long)pk2(o.x, o.y) | ((unsigned long long)pk2(o.z, o.w) << 32);
        }
    }
}
__device__ __forceinline__ void final_phase(const Frame& F) {
    F.relane();
    const int gw = F.bid * NWAVES + F.wave, NGW = F.G * NWAVES;
    const bf16* X = WSP(bf16, WS_X); const float* g = AIN(I_GFIN); float* out = AOUT + OUT_Y;
    for (int row = gw; row < T; row += NGW) {
        const v2u* xr = (const v2u*)(X + (size_t)row * D) + F.lane;
        f32x4 v[4]; float s = 0.f;
#pragma unroll
        for (int j = 0; j < 4; ++j) { const v2u w = xr[64 * j]; v[j] = (f32x4){bflo(w.x), bfhi(w.x), bflo(w.y), bfhi(w.y)}; s += (v[j].x * v[j].x + v[j].y * v[j].y) + (v[j].z * v[j].z + v[j].w * v[j].w); }
        const float rstd = frsq(wave_sum(s) * (1.f / D) + EPS);
        f32x4* o = (f32x4*)(out + (size_t)row * D) + F.lane;
#pragma unroll
        for (int j = 0; j < 4; ++j) o[64 * j] = v[j] * rstd * *((const f32x4*)g + F.lane + 64 * j);
    }
}
constexpr int LDT = 136;
__device__ __forceinline__ bf16x8 ld_frag16(const unsigned char* p) { return *(const bf16x8*)p; }
__device__ __forceinline__ bf16x8 ld_frag8x2(const unsigned char* p0, const unsigned char* p1) {
    const v2u a = *(const v2u*)p0, b = *(const v2u*)p1; v4u v; v.x = a.x; v.y = a.y; v.z = b.x; v.w = b.y; return __builtin_bit_cast(bf16x8, v); }
#define MFMA16(a, b, c) __builtin_amdgcn_mfma_f32_16x16x32_bf16((a), (b), (c), 0, 0, 0)

__device__ __forceinline__ void chunk_info(int c, int& cfirst, int& clast, bool& is_ctx, int& sb) {
    if (c < 64) { cfirst = c & ~1; clast = cfirst + 1; is_ctx = true; sb = c >> 1; }
    else { cfirst = 64 + ((c - 64) & ~7); clast = cfirst + 7; is_ctx = false; sb = (c - 64) >> 3; }
}
struct ConvW { f32x4 w0a, w0b, w1a, w1b, w2a, w2b, ba, bb; };
__device__ __forceinline__ ConvW conv_w(const float* wc, const float* bc, int ch) {
    ConvW W; W.w0a = *(const f32x4*)(wc + ch); W.w0b = *(const f32x4*)(wc + ch + 4); W.w1a = *(const f32x4*)(wc + 1024 + ch); W.w1b = *(const f32x4*)(wc + 1024 + ch + 4);
    W.w2a = *(const f32x4*)(wc + 2048 + ch); W.w2b = *(const f32x4*)(wc + 2048 + ch + 4); W.ba = *(const f32x4*)(bc + ch); W.bb = *(const f32x4*)(bc + ch + 4); return W;
}
__device__ __forceinline__ void conv8(const bf16* PROJ, int t, bool has_prev, bool has_next, int ch, const ConvW& W, float* out) {
    const bf16* p = PROJ + (size_t)t * EVEN_NP + 1536 + ch;
    const v4u z = {0u, 0u, 0u, 0u};
    const v4u c0 = *(const v4u*)p, cm = has_prev ? *(const v4u*)(p - EVEN_NP) : z, cp = has_next ? *(const v4u*)(p + EVEN_NP) : z;
    float x0[8], xm[8], xp[8]; unpack8(c0, x0); unpack8(cm, xm); unpack8(cp, xp);
#pragma unroll
    for (int i = 0; i < 4; ++i) { out[i] = siluf_(W.ba[i] + W.w0a[i] * xm[i] + W.w1a[i] * x0[i] + W.w2a[i] * xp[i]); out[4 + i] = siluf_(W.bb[i] + W.w0b[i] * xm[4 + i] + W.w1b[i] * x0[4 + i] + W.w2b[i] * xp[4 + i]); }
}
__device__ __forceinline__ void ssd_tables(const Frame& F, int ei, int t0, float* dtl, float* cml) {
    const bf16* PROJ = WSP(bf16, WS_PROJ);
    if (F.tid < 256) { const int j = F.tid >> 1, dir = F.tid & 1;
        const v4u raw = *(const v4u*)(PROJ + (size_t)(t0 + j) * EVEN_NP + 2560 + 8 * dir); float x[8]; unpack8(raw, x);
#pragma unroll
        for (int h = 0; h < 8; ++h) dtl[(dir * 8 + h) * 128 + j] = softplusf_(x[h] + AIN(I_DTB)[ei * 16 + dir * 8 + h]); }
    __syncthreads();
#pragma unroll
    for (int k = 0; k < 2; ++k) {
        const int row = 2 * F.wave + k, rev = row >> 3;
        const float a = -__expf(AIN(I_ALOG)[ei * 16 + row]);
        const int i0 = rev ? 127 - 2 * F.lane : 2 * F.lane, i1 = rev ? 126 - 2 * F.lane : 2 * F.lane + 1;
        const float v0 = dtl[row * 128 + i0] * a, v1 = dtl[row * 128 + i1] * a;
        float x = v0 + v1;
#pragma unroll
        for (int d = 1; d < 64; d <<= 1) { const float t = __builtin_bit_cast(float, __builtin_amdgcn_ds_bpermute((F.lane - d) * 4, __builtin_bit_cast(int, x))); x += (F.lane >= d) ? t : 0.f; }
        const float ex = x - (v0 + v1);
        cml[row * 128 + i0] = ex + v0; cml[row * 128 + i1] = ex + (v0 + v1);
    }
    __syncthreads();
}
constexpr int TILE128 = 34816, TILE64 = 17408;
constexpr int S1_BT = 0, S1_B = TILE128, S1_C = 2 * TILE128, S1_XT = TILE128  , S1_DT = 3 * TILE128, S1_CUM = S1_DT + 8192;
constexpr int S2_XT = 0  , S2_H = 2 * TILE64  , S2_DT = 6 * TILE64, S2_CUM = S2_DT + 8192, S2_SSQ = S2_CUM + 8192;

__device__ __forceinline__ void ssd_state_item(const Frame& F, int ei, int c, int g) {
    F.relane();
    const bf16* PROJ = WSP(bf16, WS_PROJ);
    const float* wc = AIN(I_WCS) + (size_t)ei * 3 * 1024; const float* bc = AIN(I_BCS) + (size_t)ei * 1024;
    int cfirst, clast, sb; bool is_ctx; chunk_info(c, cfirst, clast, is_ctx, sb);
    const int t0 = c * 128, len = is_ctx ? 256 : 1024, pos0 = (c - cfirst) * 128;
    bf16* BT = (bf16*)(F.lds + S1_BT); bf16* Bl = (bf16*)(F.lds + S1_B); bf16* Cl = (bf16*)(F.lds + S1_C); bf16* XT4 = (bf16*)(F.lds + S1_XT);
    float* dtl = (float*)(F.lds + S1_DT); float* cml = (float*)(F.lds + S1_CUM);
    bf16* ST = WSP(bf16, WS_ST); float* DEC = WSP(float, WS_DEC);
    bf16* CC = WSP(bf16, WS_CC); bf16* CBM = WSP(bf16, WS_CBM); bf16* XCT = WSP(bf16, WS_XCT);
    const int r = F.lane & 15, q = F.lane >> 4, w = F.wave;
    __syncthreads();
    ssd_tables(F, ei, t0, dtl, cml);
    { const ConvW W = conv_w(wc, bc, 512 + g * 128 + (F.tid & 15) * 8);
#pragma unroll 4
    for (int e = F.tid; e < 128 * 16; e += NTHR) { const int j = e >> 4, n8 = (e & 15) * 8; float o[8];
        conv8(PROJ, t0 + j, pos0 + j > 0, pos0 + j < len - 1, 512 + g * 128 + n8, W, o);
        const v4u pk = pack8(o);
        *(v4u*)((unsigned char*)Bl + (j * LDT + n8) * 2) = pk;
#pragma unroll
        for (int i = 0; i < 8; ++i) BT[(n8 + i) * LDT + j] = (bf16)f2bf1(o[i]); } }
    { const ConvW W = conv_w(wc, bc, 768 + g * 128 + (F.tid & 15) * 8);
#pragma unroll 4
    for (int e = F.tid; e < 128 * 16; e += NTHR) { const int j = e >> 4, n8 = (e & 15) * 8; float o[8];
        conv8(PROJ, t0 + j, pos0 + j > 0, pos0 + j < len - 1, 768 + g * 128 + n8, W, o);
        const v4u pk = pack8(o);
        *(v4u*)((unsigned char*)Cl + (j * LDT + n8) * 2) = pk;
        *(v4u*)(CC + (size_t)(t0 + j) * 256 + g * 128 + n8) = pk; } }
    __syncthreads();
    {
        bf16x8 cf[4];
#pragma unroll
        for (int ks = 0; ks < 4; ++ks) cf[ks] = ld_frag16((const unsigned char*)Cl + ((16 * w + r) * LDT + 32 * ks + 8 * q) * 2);
        bf16* dst = CBM + ((size_t)(c * 2 + g) * 128 + 16 * w + r) * 128 + 4 * q;
#pragma unroll
        for (int jt = 0; jt < 8; ++jt) { f32x4 a = {0.f, 0.f, 0.f, 0.f};
#pragma unroll
            for (int ks = 0; ks < 4; ++ks) a = MFMA16(ld_frag16((const unsigned char*)Bl + ((16 * jt + r) * LDT + 32 * ks + 8 * q) * 2), cf[ks], a);
            v2u o; o.x = pk2(a[0], a[1]); o.y = pk2(a[2], a[3]); *(v2u*)(dst + 16 * jt) = o; }
    }
    __syncthreads();
    { const ConvW W = conv_w(wc, bc, g * 256 + (F.tid & 31) * 8);
#pragma unroll 4
    for (int e = F.tid; e < 128 * 32; e += NTHR) { const int j = e >> 5, p8 = (e & 31) * 8; float o[8];
        conv8(PROJ, t0 + j, pos0 + j > 0, pos0 + j < len - 1, g * 256 + p8, W, o);
#pragma unroll
        for (int i = 0; i < 8; ++i) XT4[(p8 + i) * LDT + j] = (bf16)f2bf1(o[i]); } }
    __syncthreads();
#pragma unroll 4
    for (int e = F.tid; e < 256 * 16; e += NTHR) { const int row = e >> 4, ch = (e & 15) * 8;
        *(v4u*)(XCT + ((size_t)(c * 8 + 4 * g) * 64 + row) * 128 + ch) = *(const v4u*)((const unsigned char*)XT4 + (row * LDT + ch) * 2); }
#pragma unroll 2
    for (int hd = 0; hd < 8; ++hd) {
        const int hh = hd >> 1, dir = hd & 1, h = 4 * g + hh;
        const float* dth = dtl + (dir * 8 + h) * 128; const float* cmh = cml + (dir * 8 + h) * 128;
        const float cend = dir == 0 ? cmh[127] : cmh[0];
        const bf16* XT = XT4 + hh * 64 * LDT;
        f32x4 acc[4];
#pragma unroll
        for (int pt = 0; pt < 4; ++pt) acc[pt] = (f32x4){0.f, 0.f, 0.f, 0.f};
#pragma unroll
        for (int ks = 0; ks < 4; ++ks) {
            const int j0 = 32 * ks + 8 * q;
            const v4u braw = *(const v4u*)((const unsigned char*)BT + ((16 * w + r) * LDT + j0) * 2); float bv[8]; unpack8(braw, bv);
            const f32x4 d0 = *(const f32x4*)(dth + j0), d1 = *(const f32x4*)(dth + j0 + 4), c0 = *(const f32x4*)(cmh + j0), c1 = *(const f32x4*)(cmh + j0 + 4);
#pragma unroll
            for (int i = 0; i < 4; ++i) { bv[i] *= d0[i] * __expf(cend - c0[i]); bv[4 + i] *= d1[i] * __expf(cend - c1[i]); }
            const bf16x8 af = __builtin_bit_cast(bf16x8, pack8(bv));
#pragma unroll
            for (int pt = 0; pt < 4; ++pt) { const bf16x8 bf = ld_frag16((const unsigned char*)XT + ((16 * pt + r) * LDT + j0) * 2); acc[pt] = MFMA16(af, bf, acc[pt]); }
        }
        bf16* dst = ST + ((size_t)(c * 8 + h) * 2 + dir) * 8192;
#pragma unroll
        for (int pt = 0; pt < 4; ++pt) { v2u o; o.x = pk2(acc[pt][0], acc[pt][1]); o.y = pk2(acc[pt][2], acc[pt][3]); *(v2u*)(dst + (16 * pt + r) * 128 + 16 * w + 4 * q) = o; }
        if (F.tid == 0) DEC[(c * 8 + h) * 2 + dir] = __expf(cend);
    }
}

__device__ __forceinline__ void gmlp_item(const Frame& F, int ei, int c, int g) {
    F.relane();
    const bf16* PROJ = WSP(bf16, WS_PROJ); bf16* YMIX = WSP(bf16, WS_YMIX);
    const int t0 = c * 128;
    float* rs = (float*)F.lds; bf16* Vt = (bf16*)(F.lds + 1024); bf16* Wl = (bf16*)(F.lds + 1024 + 34816);
    const float* gv = AIN(I_GV) + ei * 512;
    __syncthreads();
#pragma unroll 1
    for (int kb = 0; kb < 16; kb += 8) {
        v4u raw[8];
#pragma unroll
        for (int k = 0; k < 8; ++k) raw[k] = *(const v4u*)(PROJ + (size_t)(t0 + F.wave * 16 + kb + k) * EVEN_NP + 512 + 8 * F.lane);
#pragma unroll
        for (int k = 0; k < 8; ++k) { float x[8]; unpack8(raw[k], x); float s = 0.f;
#pragma unroll
            for (int i = 0; i < 8; ++i) { const float y = gelu_tanh(x[i]); s += y * y; }
            s = wave_sum(s); if (F.lane == 0) rs[F.wave * 16 + kb + k] = frsq(s * (1.f / 512.f) + EPS); }
    }
    { const float* ws_ = AIN(I_WSP) + ((size_t)ei * 4 + g) * 16384;
#pragma unroll
      for (int e = F.tid; e < 4096; e += NTHR) { const int i = e >> 5, j4 = (e & 31) * 4; const f32x4 v = *(const f32x4*)(ws_ + i * 128 + j4);
          v2u o; o.x = pk2(v.x, v.y); o.y = pk2(v.z, v.w); *(v2u*)((unsigned char*)Wl + (i * LDT + j4) * 2) = o; } }
    __syncthreads();
    { const int d8 = (F.tid & 15) * 8; v4u raw[4];
#pragma unroll
      for (int k = 0; k < 4; ++k) raw[k] = *(const v4u*)(PROJ + (size_t)(t0 + (F.tid >> 4) + 32 * k) * EVEN_NP + 512 + g * 128 + d8);
#pragma unroll
      for (int k = 0; k < 4; ++k) { const int j = (F.tid >> 4) + 32 * k; float x[8]; unpack8(raw[k], x); const float rj = rs[j];
#pragma unroll
          for (int i = 0; i < 8; ++i) Vt[(d8 + i) * LDT + j] = (bf16)f2bf1(gelu_tanh(x[i]) * rj * gv[g * 128 + d8 + i]); } }
    __syncthreads();
    const int r = F.lane & 15, q = F.lane >> 4, w = F.wave;
    bf16x8 af[4];
#pragma unroll
    for (int ks = 0; ks < 4; ++ks) af[ks] = ld_frag16((const unsigned char*)Vt + ((16 * w + r) * LDT + 32 * ks + 8 * q) * 2);
    const float* bs = AIN(I_BSP) + ((size_t)ei * 4 + g) * 128;
    v2u uraw[8];
#pragma unroll
    for (int it = 0; it < 8; ++it) uraw[it] = *(const v2u*)(PROJ + (size_t)(t0 + 16 * it + r) * EVEN_NP + g * 128 + 16 * w + 4 * q);
#pragma unroll
    for (int it = 0; it < 8; ++it) {
        f32x4 acc = {0.f, 0.f, 0.f, 0.f};
#pragma unroll
        for (int ks = 0; ks < 4; ++ks) acc = MFMA16(af[ks], ld_frag16((const unsigned char*)Wl + ((16 * it + r) * LDT + 32 * ks + 8 * q) * 2), acc);
        const int i = 16 * it + r, col = g * 128 + 16 * w + 4 * q; const float b = bs[i];
        const float u0 = gelu_tanh(bflo(uraw[it].x)), u1 = gelu_tanh(bfhi(uraw[it].x)), u2 = gelu_tanh(bflo(uraw[it].y)), u3 = gelu_tanh(bfhi(uraw[it].y));
        v2u o; o.x = pk2(u0 * (acc[0] + b), u1 * (acc[1] + b)); o.y = pk2(u2 * (acc[2] + b), u3 * (acc[3] + b));
        *(v2u*)(YMIX + (size_t)(t0 + i) * D + col) = o;
    }
}

__device__ __forceinline__ f32x4 ld_bf4(const bf16* p) { const v2u w = *(const v2u*)p; return (f32x4){bflo(w.x), bfhi(w.x), bflo(w.y), bfhi(w.y)}; }
__device__ __forceinline__ void ssd_scan_phase(const Frame& F, int ei) {
    F.relane();
    const bf16* ST = WSP(bf16, WS_ST); const float* DEC = WSP(float, WS_DEC); bf16* HIN = WSP(bf16, WS_HIN);
    const size_t gt = (size_t)F.bid * NTHR + F.tid, NT = (size_t)F.G * NTHR;
    constexpr size_t N_SMP = (size_t)2 * 8 * 2 * 2048, N_CTX = (size_t)32 * 8 * 2 * 2048;
    for (size_t it = gt; it < N_SMP + N_CTX; it += NT) {
        if (it < N_SMP) {
            const int e = (int)(it & 2047) * 4, dir = (int)(it >> 11) & 1, h = (int)(it >> 12) & 7, b = (int)(it >> 15);
            const int c0 = 64 + 8 * b;
            f32x4 st[8]; float dc[8];
#pragma unroll
            for (int k = 0; k < 8; ++k) { const int cc = dir == 0 ? c0 + k : c0 + 7 - k; st[k] = ld_bf4(ST + ((size_t)(cc * 8 + h) * 2 + dir) * 8192 + e); dc[k] = DEC[(cc * 8 + h) * 2 + dir]; }
            f32x4 v = *(const f32x4*)(AIN(I_SSD) + ((size_t)((b * 2 + ei) * 2 + dir) * 8 + h) * 8192 + e);
#pragma unroll
            for (int k = 0; k < 8; ++k) { const int cc = dir == 0 ? c0 + k : c0 + 7 - k;
                v2u o; o.x = pk2(v.x, v.y); o.y = pk2(v.z, v.w); *(v2u*)(HIN + ((size_t)(cc * 8 + h) * 2 + dir) * 8192 + e) = o;
                v = v * dc[k] + st[k]; }
        } else {
            const size_t i2 = it - N_SMP;
            const int e = (int)(i2 & 2047) * 4, dir = (int)(i2 >> 11) & 1, h = (int)(i2 >> 12) & 7, s = (int)(i2 >> 15);
            const int ca = dir == 0 ? 2 * s : 2 * s + 1, cb = dir == 0 ? 2 * s + 1 : 2 * s;
            const f32x4 sa = ld_bf4(ST + ((size_t)(ca * 8 + h) * 2 + dir) * 8192 + e), sb_ = ld_bf4(ST + ((size_t)(cb * 8 + h) * 2 + dir) * 8192 + e);
            const float db = DEC[(cb * 8 + h) * 2 + dir];
            *(f32x4*)(AOUT + OUT_SSD + ((size_t)((s * 2 + ei) * 2 + dir) * 8 + h) * 8192 + e) = sa * db + sb_;
        }
    }
}

__device__ __forceinline__ void ssd_out_item(const Frame& F, int ei, int c, int th) {
    F.relane();
    const bf16* PROJ = WSP(bf16, WS_PROJ); bf16* YMIX = WSP(bf16, WS_YMIX);
    const bf16* CC = WSP(bf16, WS_CC); const bf16* CBM = WSP(bf16, WS_CBM); const bf16* XCT = WSP(bf16, WS_XCT); const bf16* HIN = WSP(bf16, WS_HIN); const bf16* ST = WSP(bf16, WS_ST);
    const int t0 = c * 128;
    float* dtl = (float*)(F.lds + S2_DT); float* cml = (float*)(F.lds + S2_CUM); float* ssqx = (float*)(F.lds + S2_SSQ);
    const int r = F.lane & 15, q = F.lane >> 4, w = F.wave, it = w & 3, g = w >> 2;
    const int irow = 64 * th + 16 * it + r;
    const bool hzero[2] = {c < 64 && (c & 1) == 0, c < 64 && (c & 1) == 1};
    __syncthreads();
    ssd_tables(F, ei, t0, dtl, cml);
    v2u cbp[8]; bf16x8 cf[4];
    {
        const bf16* cbr = CBM + ((size_t)(c * 2 + g) * 128 + irow) * 128 + 4 * q;
#pragma unroll
        for (int jt = 0; jt < 8; ++jt) cbp[jt] = *(const v2u*)(cbr + 16 * jt);
#pragma unroll
        for (int kn = 0; kn < 4; ++kn) cf[kn] = *(const bf16x8*)(CC + (size_t)(t0 + irow) * 256 + g * 128 + 32 * kn + 8 * q);
    }
    float ssq = 0.f;
    v4u pre[12];
    const int goff = (F.tid >> 4) * 128 + (F.tid & 15) * 8, loff = ((F.tid >> 4) * LDT + (F.tid & 15) * 8) * 2;
#define E2_SRC(m_, hh_) ((m_) < 2 ? XCT + (size_t)(c * 8 + 4 * (m_) + (hh_)) * 8192 : \
        (c < 64 ? ST + ((size_t)((((m_) - 2) & 1) == 0 ? c - 1 : c + 1) * 8 + 4 * (((m_) - 2) >> 1) + (hh_)) * 16384 + (((m_) - 2) & 1) * 8192 \
                : HIN + ((size_t)c * 8 + 4 * (((m_) - 2) >> 1) + (hh_)) * 16384 + (((m_) - 2) & 1) * 8192))
#define E2_FETCH(hh_) do { _Pragma("unroll") for (int m = 0; m < 6; ++m) { if (m >= 2 && hzero[(m - 2) & 1]) continue; const bf16* sp = E2_SRC(m, hh_) + goff; \
            pre[2 * m] = *(const v4u*)sp; pre[2 * m + 1] = *(const v4u*)(sp + 32 * 128); } } while (0)
    E2_FETCH(0);
#pragma unroll 1
    for (int hh = 0; hh < 4; ++hh) {
        __syncthreads();
#pragma unroll
        for (int m = 0; m < 6; ++m) { if (m >= 2 && hzero[(m - 2) & 1]) continue;
            unsigned char* dp = F.lds + (m < 2 ? S2_XT + m * TILE64 : S2_H + (m - 2) * TILE64) + loff;
            *(v4u*)dp = pre[2 * m]; *(v4u*)(dp + 32 * LDT * 2) = pre[2 * m + 1]; }
        __syncthreads();
        if (hh < 3) E2_FETCH(hh + 1);
        v2u zr4[4];
#pragma unroll
        for (int pt = 0; pt < 4; ++pt) zr4[pt] = *(const v2u*)(PROJ + (size_t)(t0 + irow) * EVEN_NP + 1024 + (4 * g + hh) * 64 + 16 * pt + 4 * q);
        const int h = 4 * g + hh;
        const bf16* XT = (const bf16*)(F.lds + S2_XT + g * TILE64);
        f32x4 yacc[4];
#pragma unroll
        for (int pt = 0; pt < 4; ++pt) yacc[pt] = (f32x4){0.f, 0.f, 0.f, 0.f};
        const float* dt0 = dtl + h * 128; const float* cm0 = cml + h * 128; const float* dt1 = dtl + (8 + h) * 128; const float* cm1 = cml + (8 + h) * 128;
        const float ci0 = cm0[irow], ci1 = cm1[irow];
#pragma unroll
        for (int ks = 0; ks < 4; ++ks) {
            float sl0[8], sl1[8];
#pragma unroll
            for (int hf = 0; hf < 2; ++hf) {
                const int j0 = 32 * ks + 16 * hf + 4 * q; const v2u cw = cbp[2 * ks + hf];
                const f32x4 c0v = *(const f32x4*)(cm0 + j0), d0v = *(const f32x4*)(dt0 + j0), c1v = *(const f32x4*)(cm1 + j0), d1v = *(const f32x4*)(dt1 + j0);
                const float cbv[4] = {bflo(cw.x), bfhi(cw.x), bflo(cw.y), bfhi(cw.y)};
#pragma unroll
                for (int e = 0; e < 4; ++e) { const int j = j0 + e;
                    const float e0 = __expf(ci0 - c0v[e]) * d0v[e] * cbv[e], e1 = __expf(ci1 - c1v[e]) * d1v[e] * cbv[e];
                    sl0[4 * hf + e] = (j <= irow) ? e0 : 0.f; sl1[4 * hf + e] = (j >= irow) ? e1 : 0.f; }
            }
            const bf16x8 sf0 = __builtin_bit_cast(bf16x8, pack8(sl0)), sf1 = __builtin_bit_cast(bf16x8, pack8(sl1));
#pragma unroll
            for (int pt = 0; pt < 4; ++pt) { const unsigned char* xr = (const unsigned char*)XT + ((16 * pt + r) * LDT + 32 * ks + 4 * q) * 2;
                const bf16x8 xf = ld_frag8x2(xr, xr + 32);
                yacc[pt] = MFMA16(xf, sf0, yacc[pt]); yacc[pt] = MFMA16(xf, sf1, yacc[pt]); }
        }
#pragma unroll
        for (int dir = 0; dir < 2; ++dir) {
            if (hzero[dir]) continue;
            const unsigned char* Hl = F.lds + S2_H + (g * 2 + dir) * TILE64;
            const float ei_ = __expf(dir == 0 ? ci0 : ci1);
#pragma unroll
            for (int pt = 0; pt < 4; ++pt) { f32x4 t = {0.f, 0.f, 0.f, 0.f};
#pragma unroll
                for (int kn = 0; kn < 4; ++kn) t = MFMA16(ld_frag16(Hl + ((16 * pt + r) * LDT + 32 * kn + 8 * q) * 2), cf[kn], t);
                yacc[pt] += t * ei_; }
        }
        const float dsk = AIN(I_DSK)[ei * 16 + h] + AIN(I_DSK)[ei * 16 + 8 + h];
#pragma unroll
        for (int pt = 0; pt < 4; ++pt) {
            const int p0 = 16 * pt + 4 * q;
            const v2u zr = zr4[pt];
            const float z0 = bflo(zr.x), z1 = bfhi(zr.x), z2 = bflo(zr.y), z3 = bfhi(zr.y);
            float y0 = yacc[pt][0] + dsk * bf1(XT[(p0 + 0) * LDT + irow]), y1 = yacc[pt][1] + dsk * bf1(XT[(p0 + 1) * LDT + irow]),
                  y2 = yacc[pt][2] + dsk * bf1(XT[(p0 + 2) * LDT + irow]), y3 = yacc[pt][3] + dsk * bf1(XT[(p0 + 3) * LDT + irow]);
            y0 *= siluf_(z0); y1 *= siluf_(z1); y2 *= siluf_(z2); y3 *= siluf_(z3);
            ssq += (y0 * y0 + y1 * y1) + (y2 * y2 + y3 * y3);
            v2u o; o.x = pk2(y0, y1); o.y = pk2(y2, y3);
            *(v2u*)(YMIX + (size_t)(t0 + irow) * D + 512 + h * 64 + p0) = o;
        }
    }
#undef E2_FETCH
#undef E2_SRC
    ssq += xlane<16>(ssq); ssq = sum_x32(ssq);
    if (q == 0) ssqx[w * 16 + r] = ssq;
    __syncthreads();
    ssq += ssqx[(w ^ 4) * 16 + r];
    const float rstd = frsq(ssq * (1.f / 512.f) + EPS);
    const float* go = AIN(I_GSO) + ei * 512;
#pragma unroll 1
    for (int hh = 0; hh < 4; ++hh)
#pragma unroll
        for (int pt = 0; pt < 4; ++pt) {
            const int col = (4 * g + hh) * 64 + 16 * pt + 4 * q;
            v2u* p = (v2u*)(YMIX + (size_t)(t0 + irow) * D + 512 + col); const v2u v = *p; const f32x4 gg = *(const f32x4*)(go + col);
            v2u o; o.x = pk2(bflo(v.x) * rstd * gg.x, bfhi(v.x) * rstd * gg.y); o.y = pk2(bflo(v.y) * rstd * gg.z, bfhi(v.y) * rstd * gg.w);
            *p = o;
        }
}

__device__ __forceinline__ void even_phase1(const Frame& F, int ei) {
    if (F.G >= 256) {
        if (F.bid < 160) ssd_state_item(F, ei, F.bid >> 1, F.bid & 1);
        else for (int it = F.bid - 160; it < 192; it += F.G - 160) gmlp_item(F, ei, it >> 2, it & 3);
        return;
    }
    for (int it = F.bid; it < 160 + 320; it += F.G) {
        if (it < 160) ssd_state_item(F, ei, it >> 1, it & 1);
        else gmlp_item(F, ei, (it - 160) >> 2, (it - 160) & 3);
    }
}
__device__ __forceinline__ void even_phase2(const Frame& F, int ei) {
    if (F.G >= 256) {
        if (F.bid < 160) ssd_out_item(F, ei, F.bid >> 1, F.bid & 1);
        else for (int it = 192 + F.bid - 160; it < 320; it += F.G - 160) gmlp_item(F, ei, it >> 2, it & 3);
        return;
    }
    for (int it = F.bid; it < 160; it += F.G) ssd_out_item(F, ei, it >> 1, it & 1);
}
constexpr int CV_T = 43, CV_W = CV_T + 30, CV_ITEMS = 32 * 6 + 2 * 24;
__device__ __forceinline__ void conv_item(const Frame& F, int oi, int item) {
    F.relane();
    const bf16* PROJ = WSP(bf16, WS_PROJ); bf16* YMIX = WSP(bf16, WS_YMIX);
    int sbeg, slen, tile; if (item < 192) { sbeg = (item / 6) * 256; slen = 256; tile = item % 6; } else { const int i2 = item - 192; sbeg = TCTX + (i2 / 24) * 1024; slen = 1024; tile = i2 % 24; }
    const int send = sbeg + slen, t0 = sbeg + tile * CV_T, nt = (slen - tile * CV_T) < CV_T ? (slen - tile * CV_T) : CV_T;
    float* Dl = (float*)F.lds;
    const int c = F.tid;
    float glu[CV_W];
#pragma unroll
    for (int w0 = 0; w0 < CV_W; w0 += 8) {
        bf16 av[8], gv[8];
#pragma unroll
        for (int i = 0; i < 8; ++i) if (w0 + i < CV_W) { int t = t0 - 15 + w0 + i; t = t < sbeg ? sbeg : (t >= send ? send - 1 : t);
            av[i] = PROJ[(size_t)t * ODD_NP + 672 + c]; gv[i] = PROJ[(size_t)t * ODD_NP + 1184 + c]; }
#pragma unroll
        for (int i = 0; i < 8; ++i) if (w0 + i < CV_W) { const int t = t0 - 15 + w0 + i; const float v = bf1(av[i]) * sigmoidf_(bf1(gv[i])); glu[w0 + i] = (t >= sbeg && t < send) ? v : 0.f; }
    }
    float wk[31];
#pragma unroll
    for (int k = 0; k < 31; ++k) wk[k] = AIN(I_WDW)[((size_t)oi * 31 + k) * 512 + c];
    const float bd = AIN(I_BDW)[oi * 512 + c];
    __syncthreads();
#pragma unroll
    for (int tt = 0; tt < CV_T; ++tt) { float s = bd;
#pragma unroll
        for (int k = 0; k < 31; ++k) s += wk[k] * glu[tt + k];
        Dl[tt * 512 + c] = s; }
    __syncthreads();
    const float* gl = AIN(I_GLN) + oi * 512; const float* bl = AIN(I_BLN) + oi * 512;
    const f32x4 g0 = *(const f32x4*)(gl + 8 * F.lane), g1 = *(const f32x4*)(gl + 8 * F.lane + 4), b0 = *(const f32x4*)(bl + 8 * F.lane), b1 = *(const f32x4*)(bl + 8 * F.lane + 4);
#pragma unroll 1
    for (int tt = F.wave; tt < nt; tt += NWAVES) {
        const f32x4 v0 = *(const f32x4*)(Dl + tt * 512 + 8 * F.lane), v1 = *(const f32x4*)(Dl + tt * 512 + 8 * F.lane + 4);
        float s = (v0.x + v0.y) + (v0.z + v0.w) + (v1.x + v1.y) + (v1.z + v1.w);
        const float mean = wave_sum(s) * (1.f / 512.f);
        const f32x4 d0 = v0 - mean, d1 = v1 - mean;
        float s2 = (d0.x * d0.x + d0.y * d0.y) + (d0.z * d0.z + d0.w * d0.w) + (d1.x * d1.x + d1.y * d1.y) + (d1.z * d1.z + d1.w * d1.w);
        const float rstd = frsq(wave_sum(s2) * (1.f / 512.f) + EPS);
        float o[8];
#pragma unroll
        for (int i = 0; i < 4; ++i) { o[i] = siluf_(d0[i] * rstd * g0[i] + b0[i]); o[4 + i] = siluf_(d1[i] * rstd * g1[i] + b1[i]); }
        *(v4u*)(YMIX + (size_t)(t0 + tt) * D + 512 + 8 * F.lane) = pack8(o);
    }
}
__device__ __forceinline__ void odd_rows(const Frame& F, int oi) {
    F.relane();
    const bf16* PROJ = WSP(bf16, WS_PROJ);
    bf16* QA = WSP(bf16, WS_QA); bf16* CKVA = WSP(bf16, WS_CKVA); bf16* KR = WSP(bf16, WS_KR); const float* ROPE = WSP(float, WS_ROPE);
    const int gw = F.bid * NWAVES + F.wave, NGW = F.G * NWAVES, lane = F.lane;
    for (int row = T + gw; row < TP; row += NGW) {
        const int b = (row - T) >> 8, j = (row - T) & 255;
        const f32x4 v = *(const f32x4*)(AIN(I_CCKV) + ((size_t)(b * 2 + oi) * 256 + j) * 256 + 4 * lane);
        v2u o; o.x = pk2(v.x, v.y); o.y = pk2(v.z, v.w); *(v2u*)(CKVA + (size_t)row * 256 + 4 * lane) = o;
        if (lane < 32) KR[(size_t)row * 32 + lane] = (bf16)f2bf1(AIN(I_CKR)[((size_t)(b * 2 + oi) * 256 + j) * 32 + lane]);
    }
    const f32x4 gkv = *(const f32x4*)(AIN(I_GCKV) + oi * 256 + 4 * lane);
    float gq[6];
#pragma unroll
    for (int k = 0; k < 3; ++k) { gq[2 * k] = AIN(I_GCQ)[oi * 384 + 128 * k + 2 * lane]; gq[2 * k + 1] = AIN(I_GCQ)[oi * 384 + 128 * k + 2 * lane + 1]; }
    unsigned qw[3], nqw[3]; v2u kw, nkw; bf16 krw, nkrw;
    int row = gw;
    if (row < T) { const bf16* pr = PROJ + (size_t)row * ODD_NP;
#pragma unroll
        for (int k = 0; k < 3; ++k) nqw[k] = *(const unsigned*)(pr + 128 * k + 2 * lane);
        nkw = *(const v2u*)(pr + 384 + 4 * lane); nkrw = pr[640 + (lane & 31)]; }
#pragma unroll 1
    for (; row < T; row += NGW) {
#pragma unroll
        for (int k = 0; k < 3; ++k) qw[k] = nqw[k];
        kw = nkw; krw = nkrw;
        if (row + NGW < T) { const bf16* pr = PROJ + (size_t)(row + NGW) * ODD_NP;
#pragma unroll
            for (int k = 0; k < 3; ++k) nqw[k] = *(const unsigned*)(pr + 128 * k + 2 * lane);
            nkw = *(const v2u*)(pr + 384 + 4 * lane); nkrw = pr[640 + (lane & 31)]; }
        float qv[6]; float s = 0.f;
#pragma unroll
        for (int k = 0; k < 3; ++k) { qv[2 * k] = bflo(qw[k]); qv[2 * k + 1] = bfhi(qw[k]); s += qv[2 * k] * qv[2 * k] + qv[2 * k + 1] * qv[2 * k + 1]; }
        f32x4 kv = {bflo(kw.x), bfhi(kw.x), bflo(kw.y), bfhi(kw.y)};
        float s2 = (kv.x * kv.x + kv.y * kv.y) + (kv.z * kv.z + kv.w * kv.w);
        s += xlane<1>(s); s2 += xlane<1>(s2); s += xlane<2>(s); s2 += xlane<2>(s2); s += xlane<4>(s); s2 += xlane<4>(s2); s += xlane<8>(s); s2 += xlane<8>(s2); s += xlane<16>(s); s2 += xlane<16>(s2);
        s = sum_x32(s); s2 = sum_x32(s2);
        const float rq = frsq(s * (1.f / 384.f) + EPS), rk = frsq(s2 * (1.f / 256.f) + EPS);
#pragma unroll
        for (int k = 0; k < 3; ++k) *(unsigned*)(QA + (size_t)row * 384 + 128 * k + 2 * lane) = pk2(qv[2 * k] * rq * gq[2 * k], qv[2 * k + 1] * rq * gq[2 * k + 1]);
        kv = kv * rk * gkv;
        { v2u o; o.x = pk2(kv.x, kv.y); o.y = pk2(kv.z, kv.w); *(v2u*)(CKVA + (size_t)row * 256 + 4 * lane) = o; }
        float kr = bf1(krw);
        if (row < TCTX) {
            const int b = row >> 8, pos = row & 255;
            *(f32x4*)(AOUT + OUT_CKV + ((size_t)(b * 2 + oi) * 256 + pos) * 256 + 4 * lane) = kv;
            if (lane < 32) AOUT[OUT_KR + ((size_t)(b * 2 + oi) * 256 + pos) * 32 + lane] = kr;
        } else {
            const int pos = (row - TCTX) & 1023, e = lane & 31, ax = e >> 4, half = (e >> 3) & 1, f = e & 7;
            const float other = xlane<8>(kr);
            const float cs = ROPE[((pos * 2 + ax) * 8 + f) * 2], sn = ROPE[((pos * 2 + ax) * 8 + f) * 2 + 1];
            kr = half == 0 ? (kr * cs - other * sn) : (other * sn + kr * cs);
        }
        if (lane < 32) KR[(size_t)row * 32 + lane] = (bf16)f2bf1(kr);
    }
}
__device__ __forceinline__ void odd_phase1(const Frame& F, int oi) {
    for (int it = F.bid; it < CV_ITEMS; it += F.G) conv_item(F, oi, it);
    odd_rows(F, oi);
}

constexpr int AT_KROW = 208, AT_VROW = 272, AT_KBYTES = 128 * AT_KROW, AT_BUF = 45056;
struct AttnPre { v4u k[3]; v4u v[2]; };
__device__ __forceinline__ void attn_load_tile(const Frame& F, int h, int krow0, AttnPre& P) {
    const bf16* KN = WSP(bf16, WS_KN); const bf16* KR = WSP(bf16, WS_KR); const bf16* VT = WSP(bf16, WS_VT);
#pragma unroll
    for (int i = 0; i < 3; ++i) { const int e = F.tid + NTHR * i, key = e / 12, c = e % 12; const size_t kr = (size_t)(krow0 + key);
        P.k[i] = c < 8 ? *(const v4u*)(KN + kr * 512 + h * 64 + c * 8) : *(const v4u*)(KR + kr * 32 + (c - 8) * 8); }
#pragma unroll
    for (int i = 0; i < 2; ++i) { const int e = F.tid + NTHR * i, row = e >> 4, c = e & 15;
        P.v[i] = *(const v4u*)(VT + (size_t)(h * 64 + row) * TP + krow0 + c * 8); }
}
__device__ __forceinline__ void attn_store_tile(const Frame& F, unsigned char* buf, const AttnPre& P) {
#pragma unroll
    for (int i = 0; i < 3; ++i) { const int e = F.tid + NTHR * i, key = e / 12, c = e % 12; *(v4u*)(buf + key * AT_KROW + c * 16) = P.k[i]; }
#pragma unroll
    for (int i = 0; i < 2; ++i) { const int e = F.tid + NTHR * i, row = e >> 4, c = e & 15; *(v4u*)(buf + AT_KBYTES + row * AT_VROW + c * 16) = P.v[i]; }
}
__device__ __forceinline__ int attn_tile_row(bool is_smp, int sb, int i) {
    if (!is_smp) return sb * 256 + 128 * i;
    return i < 2 ? T + sb * 256 + 128 * i : TCTX + sb * 1024 + 128 * (i - 2);
}
__device__ __forceinline__ void attn_item(const Frame& F, int q0, int h, bool is_smp, int spos0, int sb) {
    F.relane();
    const bf16* Q = WSP(bf16, WS_Q); bf16* YMIX = WSP(bf16, WS_YMIX); const float* ROPE = WSP(float, WS_ROPE);
    const int r = F.lane & 15, g = F.lane >> 4, w = F.wave;
    const int tq = q0 + 16 * w + r;
    const int ntile = is_smp ? 10 : 2;
    AttnPre P;
    attn_load_tile(F, h, attn_tile_row(is_smp, sb, 0), P);
    bf16x8 qf[3];
#pragma unroll
    for (int ks = 0; ks < 3; ++ks) qf[ks] = *(const bf16x8*)(Q + (size_t)tq * 768 + h * 96 + 32 * ks + 8 * g);
    if (is_smp) {
        float x[8], o[8]; unpack8(__builtin_bit_cast(v4u, qf[2]), x);
        const int pos = spos0 + 16 * w + r, ax = g >> 1, half = g & 1;
        const float* rp = ROPE + ((size_t)(pos * 2 + ax) * 8) * 2;
#pragma unroll
        for (int j = 0; j < 8; ++j) { const float other = xlane<16>(x[j]); const float cs = rp[2 * j], sn = rp[2 * j + 1];
            o[j] = half == 0 ? (x[j] * cs - other * sn) : (other * sn + x[j] * cs); }
        qf[2] = __builtin_bit_cast(bf16x8, pack8(o));
    }
    const float csc = 0.10206207261596577f * 1.4426950408889634f;
    float m = -1e30f, l = 0.f;
    f32x4 oacc[4];
#pragma unroll
    for (int dt = 0; dt < 4; ++dt) oacc[dt] = (f32x4){0.f, 0.f, 0.f, 0.f};
    __syncthreads();
    attn_store_tile(F, F.lds, P);
    AttnPre P2;
    if (ntile > 1) attn_load_tile(F, h, attn_tile_row(is_smp, sb, 1), P);
    __syncthreads();
#define ATTN_COMPUTE(buf) do { \
        f32x4 sacc[8]; \
        _Pragma("unroll") \
        for (int st = 0; st < 8; ++st) { \
            const unsigned char* kp = buf + (16 * st + r) * AT_KROW + 16 * g; \
            f32x4 a = {0.f, 0.f, 0.f, 0.f}; \
            a = MFMA16(ld_frag16(kp), qf[0], a); a = MFMA16(ld_frag16(kp + 64), qf[1], a); a = MFMA16(ld_frag16(kp + 128), qf[2], a); \
            sacc[st] = a; \
        } \
        float mx = -1e30f; \
        _Pragma("unroll") \
        for (int st = 0; st < 8; ++st) mx = fmaxf(fmaxf(fmaxf(sacc[st][0], sacc[st][1]), fmaxf(sacc[st][2], sacc[st][3])), mx); \
        mx = fmaxf(mx, xlane<16>(mx)); mx = max_x32(mx); \
        const float mn = fmaxf(m, mx), alpha = exp2f((m - mn) * csc); m = mn; \
        float ps = 0.f; float p[32]; \
        _Pragma("unroll") \
        for (int st = 0; st < 8; ++st) \
            _Pragma("unroll") \
            for (int j = 0; j < 4; ++j) { const float e = exp2f((sacc[st][j] - mn) * csc); p[4 * st + j] = e; ps += e; } \
        l = l * alpha + ps; \
        _Pragma("unroll") \
        for (int dt = 0; dt < 4; ++dt) oacc[dt] *= alpha; \
        _Pragma("unroll") \
        for (int ks2 = 0; ks2 < 4; ++ks2) { \
            const bf16x8 pf = __builtin_bit_cast(bf16x8, pack8(p + 8 * ks2)); \
            _Pragma("unroll") \
            for (int dt = 0; dt < 4; ++dt) { \
                const unsigned char* vp = buf + AT_KBYTES + (16 * dt + r) * AT_VROW + (32 * ks2 + 4 * g) * 2; \
                oacc[dt] = MFMA16(ld_frag8x2(vp, vp + 32), pf, oacc[dt]); \
            } \
        } } while (0)
#pragma unroll 1
    for (int ti = 0; ti < ntile; ti += 2) {
        if (ti + 2 < ntile) attn_load_tile(F, h, attn_tile_row(is_smp, sb, ti + 2), P2);
        { const unsigned char* buf = F.lds; ATTN_COMPUTE(buf); }
        if (ti + 1 < ntile) attn_store_tile(F, F.lds + AT_BUF, P);
        __syncthreads();
        if (ti + 1 >= ntile) break;
        if (ti + 3 < ntile) attn_load_tile(F, h, attn_tile_row(is_smp, sb, ti + 3), P);
        { const unsigned char* buf = F.lds + AT_BUF; ATTN_COMPUTE(buf); }
        if (ti + 2 < ntile) attn_store_tile(F, F.lds, P2);
        __syncthreads();
    }
#undef ATTN_COMPUTE
    l += xlane<16>(l); l = sum_x32(l);
    const float inv = 1.0f / l;
#pragma unroll
    for (int dt = 0; dt < 4; ++dt) { v2u o; o.x = pk2(oacc[dt][0] * inv, oacc[dt][1] * inv); o.y = pk2(oacc[dt][2] * inv, oacc[dt][3] * inv);
        *(v2u*)(YMIX + (size_t)tq * D + h * 64 + 16 * dt + 4 * g) = o; }
}
__device__ __forceinline__ void odd_phase3(const Frame& F) {
    if (F.G >= 256) {
        if (F.bid < 128) {
            const int bh = F.bid & 15, qt = F.bid >> 4, b = bh >> 3, h = bh & 7;
            attn_item(F, TCTX + b * 1024 + qt * 128, h, true, qt * 128, b);
        } else {
            for (int p = F.bid - 128; p < 256; p += F.G - 128) { const int s = p >> 3, h = p & 7;
                attn_item(F, s * 256, h, false, 0, s); attn_item(F, s * 256 + 128, h, false, 0, s); }
        }
        return;
    }
    for (int it = F.bid; it < 640; it += F.G) {
        if (it < 128) { const int b = it >> 6, h = (it >> 3) & 7, qt = it & 7; attn_item(F, TCTX + b * 1024 + qt * 128, h, true, qt * 128, b); }
        else { const int i2 = it - 128, s = i2 >> 4, h = (i2 >> 1) & 7, qt = i2 & 1; attn_item(F, s * 256 + qt * 128, h, false, 0, s); }
    }
}
constexpr int PH_PER_LAYER = 9, PH_L0 = 2, N_PHASES = PH_L0 + 4 * PH_PER_LAYER + 1;
#ifndef MK_ONE_LAUNCH
#define MK_ONE_LAUNCH 1
#endif
#ifndef PROBE_REP
#define PROBE_REP 1
#define PROBE_SLOT -2
#endif

__global__ void __launch_bounds__(NTHR, 2) fwd_kernel(Args args) {
    extern __shared__ __attribute__((aligned(16))) unsigned char lds[];
    Frame F; F.lds = lds; F.tid = threadIdx.x; F.lane = F.tid & 63; F.wave = __builtin_amdgcn_readfirstlane(F.tid >> 6); F.bid = blockIdx.x; F.G = gridDim.x;
    const int wave_id = F.wave;
    { CArgsP ap = (CArgsP)__builtin_amdgcn_kernarg_segment_ptr(); asm volatile("" : "+s"(ap)); F.a = ap; F.ws = (GAS unsigned char*)ap->ws; }
    LAS unsigned char* ldsl = (LAS unsigned char*)lds;
    for (int u = F.tid; u < (LDS_BYTES - LDSCTL_OFF) / 4; u += NTHR) ((LAS unsigned*)(ldsl + LDSCTL_OFF))[u] = 0u;
    __syncthreads();
    XcdBarrier bar; bar.bar = (unsigned*)(GAS unsigned*)(F.ws + WS_CTL) + 1024; bar.x = 0; bar.st = nullptr;
    const bool multi = (args.ph_hi - args.ph_lo) > 1;
    if (multi) bar = xcd_barrier_post((unsigned*)(GAS unsigned*)(F.ws + WS_CTL) + 1024, (volatile LAS unsigned*)(ldsl + MISC_OFF) + 8);

#define FRESH_F() do { int wv_ = wave_id; asm volatile("" : "+s"(wv_)); int ln_; asm volatile("v_mbcnt_lo_u32_b32 %0, -1, 0\n\tv_mbcnt_hi_u32_b32 %0, -1, %0" : "=v"(ln_)); F.tid = wv_ * 64 + ln_; F.lane = ln_; F.wave = wv_; } while (0)
    int rep = 0;
    for (int ph = args.ph_lo; ph < args.ph_hi; ) {
        { CArgsP ap = (CArgsP)__builtin_amdgcn_kernarg_segment_ptr(); asm volatile("" : "+s"(ap)); F.a = ap; F.ws = (GAS unsigned char*)ap->ws;
          int bid_ = blockIdx.x; asm volatile("" : "+s"(bid_)); F.bid = bid_; }
        if (ph == 0) { FRESH_F(); p0_phase(F); }
        else if (ph == 1) { FRESH_F(); p1_copy_phase(F); norm0_phase(F); }
        else if (ph == N_PHASES - 1) { FRESH_F(); final_phase(F); }
        else {
            const int l = (ph - PH_L0) / PH_PER_LAYER, s = (ph - PH_L0) % PH_PER_LAYER, hi = l >> 1; const bool odd = l & 1;
            if (s == 0 || s == 7) {
                FRESH_F();
                const int f = s == 0 ? 0 : 1;
                pg8::Gemm g{(const bf16*)(const GAS bf16*)(F.ws + WS_XA), (const bf16*)(const GAS bf16*)(F.ws + WS_WGU + (size_t)(l * 2 + f) * SZ_WGU), T, 2 * DFF, D, D, D};
                pg8::StaticOrder S; S.init(T, 2 * DFF, F.G, F.bid);
                EpiSwiglu E{F.ws, (int)(((l * 3) + (f == 0 ? 0 : 2)) * 3 * BIAS_MS), (l == 0 && f == 0) ? 16 : 1};
                pg8::gemm_phase<EpiSwiglu, pg8::StaticOrder, true>(ldsl, F.tid, g, S, E);
            } else if (s == 1 || s == 8 || s == 6) {
                FRESH_F();
                const int f = s == 1 ? 0 : 1;
                const bool mix = s == 6, lastg = (s == 8 && l == 3);
                const bf16* gA = mix ? (const bf16*)(const GAS bf16*)(F.ws + WS_YMIX) : (const bf16*)(const GAS bf16*)(F.ws + WS_H);
                const bf16* gB = mix ? (const bf16*)(const GAS bf16*)(F.ws + (odd ? WS_WOO : WS_WOE) + (size_t)hi * SZ_WO) : (const bf16*)(const GAS bf16*)(F.ws + WS_WD + (size_t)(l * 2 + f) * SZ_WD);
                const int gK = mix ? D : DFF;
                const int gate_off = l * 3 * NMODV + (mix ? 5 : (f == 0 ? 2 : 8)) * 1024;
                const float coef = rep ? 0.f : (mix ? 1.0f : 0.5f);
                const int nl = (s == 8) ? l + 1 : l, ni = mix ? 2 : (f == 0 ? 1 : 0), sci = mix ? 7 : (f == 0 ? 4 : 1);
                const float* gn = AIN(I_GNORM) + (size_t)((lastg ? 0 : nl) * 3 + ni) * D;
                const int scn_off = (lastg ? 0 : nl) * 3 * NMODV + sci * 1024;
                pg8::Gemm g{gA, gB, T, D, gK, gK, gK};
                EpiResid E{F.ws, gn, gate_off, scn_off, coef};
                pg8::StaticOrder S; S.init(T, D, F.G, F.bid);
                pg8::gemm_phase<EpiResid, pg8::StaticOrder, true>(ldsl, F.tid, g, S, E);
                FRESH_F();
                if (F.bid >= 160 && rep == 0) background_work(F, l, s == 1 ? 0 : (s == 6 ? 1 : 2), F.bid - 160, F.G - 160);
            } else if (s == 2 || (s == 4 && odd)) {
                const int ng = s == 2 ? 1 : 3;
                for (int gi = 0; gi < ng; ++gi) {
                    FRESH_F();
                    const bool inproj = s == 2;
                    const int kind = inproj ? 0 : 1 + gi;
                    const size_t offA = kind == 0 ? WS_XA : (kind == 1 ? WS_QA : (kind == 2 ? WS_CKVA : WS_WKV + (size_t)hi * SZ_WKV + (size_t)512 * 256 * 2));
                    const size_t offB = kind == 0 ? (odd ? WS_WIO + (size_t)hi * SZ_WIO : WS_WIE + (size_t)hi * SZ_WIE) : (kind == 1 ? WS_WUQ + (size_t)hi * SZ_WUQ : (kind == 2 ? WS_WKV + (size_t)hi * SZ_WKV : WS_CKVA));
                    const size_t offO = kind == 0 ? WS_PROJ : (kind == 1 ? WS_Q : (kind == 2 ? WS_KN : WS_VT));
                    const int gM = kind == 3 ? 512 : (kind == 2 ? TP : T);
                    const int gN = kind == 0 ? (odd ? ODD_NP : EVEN_NP) : (kind == 1 ? 768 : (kind == 2 ? 512 : TP));
                    const int gK = kind == 0 ? D : (kind == 1 ? 384 : 256);
                    const int ldc = kind == 3 ? TP : gN;
                    const int off = kind == 2 ? 136 : (kind == 3 ? 52 : 0);
                    pg8::Gemm g{(const bf16*)(const GAS bf16*)(F.ws + offA), (const bf16*)(const GAS bf16*)(F.ws + offB), gM, gN, gK, gK, gK};
                    EpiStore E{F.ws, (unsigned)offO, ldc, inproj ? (int)((l * 3 + 1) * 3 * BIAS_MS) : -1};
                    pg8::StaticOrder S; S.init(gM, gN, F.G, (F.bid + off) % F.G);
                    pg8::gemm_phase<EpiStore, pg8::StaticOrder, true>(ldsl, F.tid, g, S, E);
                }
            } else if (s == 3) { if (!odd) { FRESH_F(); even_phase1(F, hi); } else { FRESH_F(); odd_phase1(F, hi); } }
            else if (s == 4) { FRESH_F(); ssd_scan_phase(F, hi); }
            else if (s == 5) { if (odd) { FRESH_F(); odd_phase3(F); } else { FRESH_F(); even_phase2(F, hi); } }
        }
        {
            const int slot = ph < PH_L0 ? 100 + ph : (ph == N_PHASES - 1 ? 102 : ((ph - PH_L0) % PH_PER_LAYER) + 20 * (((ph - PH_L0) / PH_PER_LAYER) & 1));
            const int reps = ((PROBE_SLOT == 200 && slot < 100) || slot == PROBE_SLOT || (PROBE_SLOT < 20 && slot == PROBE_SLOT + 20 && (PROBE_SLOT < 2 || PROBE_SLOT > 5))) ? PROBE_REP : 1;
            if (++rep >= reps) { rep = 0; ++ph; }
            if (ph < args.ph_hi) xcd_barrier(bar);
        }
    }
}

extern "C" void kernel_launch(void* const* d_in, const int* in_sizes, int n_in, void* d_out, int out_size, void* d_ws, size_t ws_size, hipStream_t stream) {
    static int grid = 0;
    if (grid == 0) {
        if (n_in != 34 || (size_t)out_size != OUT_END || ws_size < WS_END) { fprintf(stderr, "kernel_launch: unexpected problem: n_in %d out %d ws %zu (need %zu)\n", n_in, out_size, ws_size, (size_t)WS_END); grid = -1; return; }
        int dev = 0, cus = 0, per_cu = 0;
        if (hipGetDevice(&dev) != hipSuccess || hipDeviceGetAttribute(&cus, hipDeviceAttributeMultiprocessorCount, dev) != hipSuccess) { grid = -1; return; }
        if (hipFuncSetAttribute((const void*)fwd_kernel, hipFuncAttributeMaxDynamicSharedMemorySize, LDS_BYTES) != hipSuccess) { fprintf(stderr, "kernel_launch: hipFuncSetAttribute failed\n"); grid = -1; return; }
        if (hipOccupancyMaxActiveBlocksPerMultiprocessor(&per_cu, (const void*)fwd_kernel, NTHR, LDS_BYTES) != hipSuccess || per_cu < 1) { fprintf(stderr, "kernel_launch: occupancy query says %d blocks per CU\n", per_cu); per_cu = 1; }
        (void)hipGetLastError();
        grid = cus;
        if (grid < 256) fprintf(stderr, "kernel_launch: %d CUs (tuned for 256)\n", grid);
    }
    if (grid < 0) return;
    (void)hipMemsetAsync((char*)d_ws + WS_CTL, 0, CTL_ZERO_BYTES, stream);
    Args a{};
    for (int i = 0; i < 34; ++i) a.in[i] = (const float*)d_in[i];
    a.out = (float*)d_out; a.ws = (unsigned char*)d_ws;
#if MK_ONE_LAUNCH
    a.ph_lo = 0; a.ph_hi = N_PHASES; a.li = 0;
    hipLaunchKernelGGL(fwd_kernel, dim3(grid), dim3(NTHR), LDS_BYTES, stream, a);
#else
    int li = 0;
    for (int ph = 0; ph < N_PHASES; ++ph) {
        a.ph_lo = ph; a.ph_hi = ph + 1; a.li = li++;
        hipLaunchKernelGGL(fwd_kernel, dim3(grid), dim3(NTHR), LDS_BYTES, stream, a);
    }
#endif
}
```

```cpp
#include <hip/hip_runtime.h>
#include <cstdio>
#include <cstdint>
namespace pg8 {
#define PG8_LAS __attribute__((address_space(3)))
typedef unsigned short bf16_t;
typedef short bf16x8 __attribute__((ext_vector_type(8)));
typedef float f32x4 __attribute__((ext_vector_type(4)));
typedef unsigned u32x4 __attribute__((ext_vector_type(4)));
typedef unsigned u32x2 __attribute__((ext_vector_type(2)));
constexpr int BM = 256, BK = 64, HALF = 128, HTB = HALF * BK * 2  , STAGE_BYTES = 8 * HTB, NXCD = 8, WGM = 8;

__host__ __device__ __forceinline__ int lds_byte(int r, int c) { const int st = (r >> 4) * 2 + (c >> 5), rr = r & 15, cc = c & 31, ob = rr * 64 + cc * 2; return st * 1024 + (ob ^ (((ob >> 9) & 1) << 5)); }
__host__ __device__ __forceinline__ void stage_rc(int b, int& R, int& C) { const int st = b / 1024, sb = b % 1024, swz = sb ^ (((sb >> 9) & 1) << 5); R = (st >> 1) * 16 + swz / 64; C = (st & 1) * 32 + (swz % 64) / 2; }
__host__ __device__ __forceinline__ int perm32(int rho) { const int n = rho >> 4, i = rho & 15; return 8 * (i >> 2) + 4 * n + (i & 3); }

struct Unit { int pm, pn; };
struct Gemm { const bf16_t* A; const bf16_t* Bt; int M, N, K, lda, ldb; };

struct StaticOrder {
    int nM, nN, nwg, G, c;
    __host__ __device__ void init(int M, int N, int G_, int c_) { nM = M / BM; nN = N / BM; nwg = nM * nN; G = G_; c = c_; }
    __host__ __device__ bool next(int i, Unit& u) const {
        const long L = (long)i * G + c; if (L >= nwg) return false;
        int wgid = (int)L; { const int q = nwg / NXCD, r = nwg % NXCD, xcd = wgid % NXCD, off = wgid / NXCD; wgid = (xcd < r ? xcd * (q + 1) : r * (q + 1) + (xcd - r) * q) + off; }
        const int nig = WGM * nN, gid = wgid / nig, fm = gid * WGM, gsz = (nM - fm) < WGM ? (nM - fm) : WGM;
        u.pm = fm + ((wgid % nig) % gsz); u.pn = (wgid % nig) / gsz; return true;
    }
    __device__ __forceinline__ void a_ready(const Unit&) const {}
    __device__ __forceinline__ void done(const Unit&) const {}
};

__device__ __forceinline__ unsigned cvt_pk_bf16(float lo, float hi) { unsigned r; asm volatile("v_cvt_pk_bf16_f32 %0, %1, %2" : "=v"(r) : "v"(lo), "v"(hi)); return r; }

template <class Epi, class Sched, bool ALIGN_EPI>
__device__ __forceinline__ void gemm_phase(PG8_LAS unsigned char* lds, const int tid, const Gemm g, const Sched& S, const Epi& E) {
    const int wid = __builtin_amdgcn_readfirstlane(tid >> 6), lane = tid & 63, wr = wid >> 2, wc = wid & 3, fr = lane & 15, fq = lane >> 4;
    const int K = g.K, nt = K / BK;
    unsigned voffA[2], voffB[2];
#pragma unroll
    for (int i = 0; i < 2; ++i) { int R, C; stage_rc(tid * 16 + i * 8192, R, C); const int Rb = Epi::PERM ? ((R & ~31) + perm32(R & 31)) : R;
        voffA[i] = (unsigned)(R * g.lda + C) * 2u; voffB[i] = (unsigned)(Rb * g.ldb + C) * 2u; }
    const size_t kstep = (size_t)(BK * 2);
    const size_t hstepA = (size_t)HALF * g.lda * 2, hstepB = (size_t)HALF * g.ldb * 2;
    const size_t tstepA = 2 * hstepA, tstepB = 2 * hstepB;
    const unsigned ldsw = (unsigned)wid * 1024u;
    const int aoff = lds_byte(wr * 64 + fr, fq * 8), boff = lds_byte(wc * 32 + fr, fq * 8);
#define PG8_SA(b, h) (((b) * 2 + (h)) * HTB)
#define PG8_SB(b, h) ((4 + (b) * 2 + (h)) * HTB)
#define PG8_STAGE(bufoff, gbase, voff) do { _Pragma("unroll") for (int _i = 0; _i < 2; ++_i) \
        __builtin_amdgcn_global_load_lds((const unsigned*)((const char*)(gbase) + (voff)[_i]), (PG8_LAS unsigned*)(lds + (bufoff) + ldsw + _i * 8192), 16, 0, 0); } while (0)
#define PG8_LDA(dst, b, h) do { _Pragma("unroll") for (int m = 0; m < 4; ++m) _Pragma("unroll") for (int k = 0; k < 2; ++k) dst[m][k] = *(const PG8_LAS bf16x8*)(lds + PG8_SA(b, h) + aoff + m * 2048 + k * 1024); } while (0)
#define PG8_LDB(dst, b, h) do { _Pragma("unroll") for (int n = 0; n < 2; ++n) _Pragma("unroll") for (int k = 0; k < 2; ++k) dst[n][k] = *(const PG8_LAS bf16x8*)(lds + PG8_SB(b, h) + boff + n * 2048 + k * 1024); } while (0)
#define PG8_MMA(ai, bj, At, Bt) do { __builtin_amdgcn_s_setprio(1); _Pragma("unroll") for (int m = 0; m < 4; ++m) _Pragma("unroll") for (int n = 0; n < 2; ++n) _Pragma("unroll") for (int k = 0; k < 2; ++k) \
        acc[ai][bj][m][n] = __builtin_amdgcn_mfma_f32_16x16x32_bf16(Bt[n][k], At[m][k], acc[ai][bj][m][n], 0, 0, 0); __builtin_amdgcn_s_setprio(0); } while (0)
#define PG8_WAIT_V(n) asm volatile("s_waitcnt vmcnt(" #n ")" ::: "memory")
#define PG8_WAIT_L(n) asm volatile("s_waitcnt lgkmcnt(" #n ")" ::: "memory")
#define PG8_BAR __builtin_amdgcn_s_barrier()
#define PG8_SCHED __builtin_amdgcn_sched_barrier(0)
    Unit cur, nxt; int ui = 0;
    if (!S.next(0, cur)) return;
    f32x4 acc[2][2][4][2];
#pragma unroll
    for (int a = 0; a < 2; ++a)
#pragma unroll
        for (int b = 0; b < 2; ++b)
#pragma unroll
            for (int m = 0; m < 4; ++m)
#pragma unroll
                for (int n = 0; n < 2; ++n) acc[a][b][m][n] = (f32x4){0.f, 0.f, 0.f, 0.f};
    bf16x8 At[4][2], B0[2][2], B1[2][2];
    const char* cA = (const char*)g.A + (size_t)cur.pm * tstepA; const char* cB = (const char*)g.Bt + (size_t)cur.pn * tstepB;
    S.a_ready(cur);
    E.prefetch_sync(cur, tid, lds, 0); E.prefetch_dma(cur, wid, lane, lds, 0);
    PG8_STAGE(PG8_SB(0, 0), cB, voffB); PG8_STAGE(PG8_SB(0, 1), cB + hstepB, voffB); PG8_STAGE(PG8_SA(0, 0), cA, voffA); PG8_STAGE(PG8_SA(0, 1), cA + hstepA, voffA);
    if (wr == 1) PG8_BAR;
    PG8_WAIT_V(2); PG8_BAR;
    PG8_STAGE(PG8_SB(1, 0), cB + kstep, voffB); PG8_STAGE(PG8_SA(1, 0), cA + kstep, voffA); PG8_STAGE(PG8_SB(1, 1), cB + hstepB + kstep, voffB);
    PG8_WAIT_V(6); PG8_BAR;
    for (;;) {
        const bool has_next = S.next(ui + 1, nxt);
        const char* nA = has_next ? (const char*)g.A + (size_t)nxt.pm * tstepA : cA; const char* nB = has_next ? (const char*)g.Bt + (size_t)nxt.pn * tstepB : cB;
        for (int t = 0; t < nt; t += 2) {
            const bool last = (t == nt - 2);
            const char* a1 = cA + (size_t)(t + 1) * kstep;
            const char* a2 = last ? nA : cA + (size_t)(t + 2) * kstep; const char* b2 = last ? nB : cB + (size_t)(t + 2) * kstep;
            const char* a3 = a2 + kstep; const char* b3 = b2 + kstep;
            if (last && has_next) { S.a_ready(nxt); E.prefetch_dma(nxt, wid, lane, lds, (ui + 1) & 1); }
            PG8_LDB(B0, 0, 0); PG8_LDB(B1, 0, 1); PG8_SCHED; PG8_LDA(At, 0, 0); PG8_STAGE(PG8_SA(1, 1), a1 + hstepA, voffA);
            PG8_WAIT_V(8); PG8_WAIT_L(0); PG8_BAR; PG8_MMA(0, 0, At, B0); PG8_MMA(0, 1, At, B1); PG8_BAR; PG8_SCHED;
            PG8_LDA(At, 0, 1); PG8_STAGE(PG8_SB(0, 0), b2, voffB); PG8_STAGE(PG8_SB(0, 1), b2 + hstepB, voffB); PG8_STAGE(PG8_SA(0, 0), a2, voffA);
            PG8_WAIT_V(8); PG8_WAIT_L(0); PG8_BAR; PG8_MMA(1, 0, At, B0); PG8_MMA(1, 1, At, B1); PG8_BAR; PG8_SCHED;
            PG8_LDB(B0, 1, 0); PG8_LDB(B1, 1, 1); PG8_SCHED; PG8_LDA(At, 1, 0); PG8_STAGE(PG8_SA(0, 1), a2 + hstepA, voffA);
            PG8_WAIT_V(8); PG8_WAIT_L(0); PG8_BAR; PG8_MMA(0, 0, At, B0); PG8_MMA(0, 1, At, B1); PG8_BAR; PG8_SCHED;
            PG8_LDA(At, 1, 1); PG8_STAGE(PG8_SB(1, 0), b3, voffB); PG8_STAGE(PG8_SB(1, 1), b3 + hstepB, voffB); PG8_STAGE(PG8_SA(1, 0), a3, voffA);
            PG8_WAIT_V(8); PG8_WAIT_L(0); PG8_BAR; PG8_MMA(1, 0, At, B0); PG8_MMA(1, 1, At, B1); PG8_BAR; PG8_SCHED;
        }
        if constexpr (ALIGN_EPI) { if (wr == 0) PG8_BAR; }
        E(acc, cur, wr, wc, fr, fq, lds, ui & 1);
        if (!has_next) break;
#pragma unroll
        for (int a = 0; a < 2; ++a)
#pragma unroll
            for (int b = 0; b < 2; ++b)
#pragma unroll
                for (int m = 0; m < 4; ++m)
#pragma unroll
                    for (int n = 0; n < 2; ++n) acc[a][b][m][n] = (f32x4){0.f, 0.f, 0.f, 0.f};
        cur = nxt; cA = nA; cB = nB; ++ui;
        E.prefetch_sync(cur, tid, lds, ui & 1);
        if constexpr (ALIGN_EPI) { if (wr == 1) PG8_BAR; }
    }
    PG8_WAIT_V(0);
    if constexpr (!ALIGN_EPI) { if (wr == 0) PG8_BAR; }
    PG8_BAR;
#undef PG8_SA
#undef PG8_SB
#undef PG8_STAGE
#undef PG8_LDA
#undef PG8_LDB
#undef PG8_MMA
#undef PG8_WAIT_V
#undef PG8_WAIT_L
#undef PG8_BAR
#undef PG8_SCHED
}
}
constexpr int NWAVES = 8, NTHR = 512;
constexpr int D = 1024, TCTX = 8192, TSMP = 2048, T = 10240, TP = T + 512;
constexpr int DFF = 2816, NMODV = 9 * 1024;
constexpr int EVEN_NP = 2816, ODD_NP = 1792;
constexpr float EPS = 1e-6f;
constexpr int NCHUNK = 80;

constexpr size_t MiB = 1u << 20;
constexpr size_t WS_CTL = 0, CTL_ZERO_BYTES = 64 * 1024;
constexpr size_t WS_MOD = 1 * MiB;
constexpr size_t WS_ROPE = WS_MOD + 512 * 1024;
constexpr size_t WS_DEC = WS_ROPE + 160 * 1024;
constexpr size_t WS_SSQ = WS_MOD + 768 * 1024;
constexpr size_t WS_BIAS = 2 * MiB;
constexpr size_t BIAS_LD = 5632, BIAS_MS = 16 * BIAS_LD;
constexpr size_t WS_BIASF = 15 * MiB;
constexpr size_t WS_WGU = 16 * MiB;
constexpr size_t SZ_WGU = (size_t)5632 * 1024 * 2;
constexpr size_t WS_WD = WS_WGU + 8 * SZ_WGU;
constexpr size_t SZ_WD = (size_t)1024 * 2816 * 2;
constexpr size_t WS_WIE = WS_WD + 8 * SZ_WD;
constexpr size_t SZ_WIE = (size_t)EVEN_NP * 1024 * 2;
constexpr size_t WS_WOE = WS_WIE + 2 * SZ_WIE;
constexpr size_t SZ_WO = (size_t)1024 * 1024 * 2;
constexpr size_t WS_WIO = WS_WOE + 2 * SZ_WO;
constexpr size_t SZ_WIO = (size_t)ODD_NP * 1024 * 2;
constexpr size_t WS_WOO = WS_WIO + 2 * SZ_WIO;
constexpr size_t WS_WUQ = WS_WOO + 2 * SZ_WO;
constexpr size_t SZ_WUQ = (size_t)768 * 384 * 2;
constexpr size_t WS_WKV = WS_WUQ + 2 * SZ_WUQ;
constexpr size_t SZ_WKV = (size_t)1024 * 256 * 2;
constexpr size_t WS_WEND = WS_WKV + 2 * SZ_WKV;
constexpr size_t WS_X = (WS_WEND + MiB - 1) / MiB * MiB;
constexpr size_t WS_XA = WS_X + (size_t)T * D * 4;
constexpr size_t WS_PROJ = WS_XA + (size_t)T * D * 2;
constexpr size_t WS_YMIX = WS_PROJ + (size_t)T * EVEN_NP * 2;
constexpr size_t WS_H = WS_YMIX + (size_t)T * D * 2;
constexpr size_t WS_ST = WS_H;
constexpr size_t WS_QA = WS_H;
constexpr size_t WS_CKVA = WS_QA + (size_t)T * 384 * 2;
constexpr size_t WS_KR = WS_CKVA + (size_t)TP * 256 * 2;
constexpr size_t WS_Q = WS_KR + (size_t)TP * 32 * 2;
constexpr size_t WS_KN = WS_Q + (size_t)T * 768 * 2;
constexpr size_t WS_VT = WS_KN + (size_t)TP * 512 * 2;
constexpr size_t WS_HEND = WS_H + (size_t)T * DFF * 2;
static_assert(WS_VT + (size_t)512 * TP * 2 <= WS_HEND, "odd-layer scratch fits the H overlay");
static_assert(WS_ST + (size_t)NCHUNK * 8 * 2 * 8192 * 4 <= WS_HEND, "chunk states fit the H overlay");
constexpr size_t WS_XCT = WS_HEND;
constexpr size_t WS_CC = WS_XCT + (size_t)NCHUNK * 8 * 8192 * 2;
constexpr size_t WS_CBM = WS_CC + (size_t)T * 256 * 2;
constexpr size_t WS_HIN = WS_CBM + (size_t)NCHUNK * 2 * 16384 * 2;
constexpr size_t WS_END = WS_HIN + (size_t)NCHUNK * 8 * 2 * 8192 * 2;

constexpr size_t OUT_Y = 0, OUT_SSD = (size_t)T * D, OUT_CKV = OUT_SSD + (size_t)32 * 2 * 2 * 8 * 64 * 128, OUT_KR = OUT_CKV + (size_t)32 * 2 * 256 * 256, OUT_END = OUT_KR + (size_t)32 * 2 * 256 * 32;

constexpr int RING_BYTES = 131072;
constexpr int LDSCTL_OFF = 144 * 1024 - 512, MISC_OFF = LDSCTL_OFF + 320;
constexpr int LDS_BYTES = 147456;

#define GAS __attribute__((address_space(1)))
#define LAS __attribute__((address_space(3)))
typedef unsigned short bf16;
typedef unsigned v4u __attribute__((ext_vector_type(4)));
typedef unsigned v2u __attribute__((ext_vector_type(2)));
typedef float f32x4 __attribute__((ext_vector_type(4)));
typedef short bf16x8 __attribute__((ext_vector_type(8)));
typedef GAS unsigned gu32;
#define RLX_AGENT __ATOMIC_RELAXED, __HIP_MEMORY_SCOPE_AGENT
__device__ __forceinline__ unsigned f2bf(float f) { unsigned u = __builtin_bit_cast(unsigned, f); return (u + 0x7fffu + ((u >> 16) & 1u)) >> 16; }
typedef float f32x2_t __attribute__((ext_vector_type(2)));
typedef __bf16 bf16x2_t __attribute__((ext_vector_type(2)));
__device__ __forceinline__ unsigned pk2(float lo, float hi) { const f32x2_t v = {lo, hi}; const bf16x2_t b = __builtin_convertvector(v, bf16x2_t); return __builtin_bit_cast(unsigned, b); }
__device__ __forceinline__ unsigned f2bf1(float f) { return pk2(f, 0.f) & 0xffffu; }
__device__ __forceinline__ float bflo(unsigned w) { return __builtin_bit_cast(float, w << 16); }
__device__ __forceinline__ float bfhi(unsigned w) { return __builtin_bit_cast(float, w & 0xffff0000u); }
__device__ __forceinline__ float bf1(bf16 h) { return __builtin_bit_cast(float, ((unsigned)h) << 16); }
__device__ __forceinline__ void unpack8(const v4u v, float* o) { o[0] = bflo(v.x); o[1] = bfhi(v.x); o[2] = bflo(v.y); o[3] = bfhi(v.y); o[4] = bflo(v.z); o[5] = bfhi(v.z); o[6] = bflo(v.w); o[7] = bfhi(v.w); }
__device__ __forceinline__ v4u pack8(const float* o) { v4u v; v.x = pk2(o[0], o[1]); v.y = pk2(o[2], o[3]); v.z = pk2(o[4], o[5]); v.w = pk2(o[6], o[7]); return v; }
template <int K> __device__ __forceinline__ float xlane(float v) { static_assert(K >= 1 && K < 32, "xor mask inside a 32-lane half");
    return __builtin_bit_cast(float, __builtin_amdgcn_ds_swizzle(__builtin_bit_cast(int, v), (K << 10) | 0x1F)); }
__device__ __forceinline__ float sum_x32(float v) { const unsigned u = __builtin_bit_cast(unsigned, v); const auto r = __builtin_amdgcn_permlane32_swap(u, u, false, false);
    return __builtin_bit_cast(float, (unsigned)r[0]) + __builtin_bit_cast(float, (unsigned)r[1]); }
__device__ __forceinline__ float max_x32(float v) { const unsigned u = __builtin_bit_cast(unsigned, v); const auto r = __builtin_amdgcn_permlane32_swap(u, u, false, false);
    return fmaxf(__builtin_bit_cast(float, (unsigned)r[0]), __builtin_bit_cast(float, (unsigned)r[1])); }
__device__ __forceinline__ float wave_sum(float v) {
    v += xlane<1>(v); v += xlane<2>(v); v += xlane<4>(v); v += xlane<8>(v); v += xlane<16>(v);
    return sum_x32(v);
}
__device__ __forceinline__ float frcp(float x) { return __builtin_amdgcn_rcpf(x); }
__device__ __forceinline__ float frsq(float x) { return __builtin_amdgcn_rsqf(x); }
__device__ __forceinline__ float sigmoidf_(float x) { return frcp(1.0f + __expf(-x)); }
__device__ __forceinline__ float siluf_(float x) { return x * frcp(1.0f + __expf(-x)); }
__device__ __forceinline__ float gelu_tanh(float x) { const float y = 0.7978845608028654f * (x + 0.044715f * x * x * x); const float t = 1.0f - 2.0f * frcp(1.0f + __expf(2.0f * y)); return 0.5f * x * (1.0f + t); }
__device__ __forceinline__ float softplusf_(float x) { const float e = __expf(x); return x > 20.f ? x : (e < 1e-3f ? e * (1.0f - 0.5f * e) : __logf(1.0f + e)); }
__device__ __forceinline__ int modrow_of_tile(int pm) { return pm < 32 ? 0 : 1 + ((pm - 32) >> 2); }
__device__ __forceinline__ int modrow_of_tok(int t) { return t < TCTX ? 0 : 1 + ((t - TCTX) >> 10); }

#define XB_TMO      128
#define XB_XCNT(j)  (256  + 64 * (j))
#define XB_XSUB(j)  (1280 + 64 * (j))
#define XB_XGEN(j)  (2304 + 64 * (j))
#define XB_TOP      3328
#define XB_TOPGEN   3392
#define XCD_BAR_WORDS 3456
#define XB_SPIN_CAP (1u << 22)
__device__ __forceinline__ unsigned xb_ld(unsigned* p)              { return __hip_atomic_load(p, __ATOMIC_RELAXED, __HIP_MEMORY_SCOPE_AGENT); }
__device__ __forceinline__ unsigned xb_add(unsigned* p, unsigned v) { return __hip_atomic_fetch_add(p, v, __ATOMIC_RELAXED, __HIP_MEMORY_SCOPE_AGENT); }
__device__ __forceinline__ unsigned xb_xcc_id() { return (unsigned)__builtin_amdgcn_s_getreg((3 << 11) | 20) & 0xFu; }
#define XB_SPIN(cond, bar) do { unsigned _sp = 0; while (cond) { __builtin_amdgcn_s_sleep(1); \
    if ((++_sp & 255u) == 0u) { if (xb_ld(&(bar)[XB_TMO])) break; if (_sp > XB_SPIN_CAP) { atomicAdd(&(bar)[XB_TMO], 1u); break; } } } } while (0)
struct XcdBarrier { unsigned* bar; unsigned x; volatile LAS unsigned* st; };
__device__ __forceinline__ XcdBarrier xcd_barrier_post(unsigned* bar, volatile LAS unsigned* st) {
    XcdBarrier b; b.bar = bar; b.x = xb_xcc_id(); b.st = st;
    if (threadIdx.x == 0) (void)xb_add(&bar[XB_XCNT(b.x)], 1u);
    return b;
}
__device__ __forceinline__ void xcd_barrier_complete(unsigned* bar, unsigned x, unsigned& nloc, unsigned& nx) {
    const unsigned G = gridDim.x * gridDim.y * gridDim.z;
    unsigned sum, cnt, mine, sp = 0u;
    for (;;) {
        sum = 0u; cnt = 0u; mine = 0u;
#pragma unroll
        for (unsigned j = 0; j < 16; ++j) { const unsigned c = xb_ld(&bar[XB_XCNT(j)]); sum += c; cnt += (c > 0u) ? 1u : 0u; mine = (j == x) ? c : mine; }
        if (sum == G) break;
        __builtin_amdgcn_s_sleep(1);
        if ((++sp & 255u) == 0u) { if (xb_ld(&bar[XB_TMO])) break; if (sp > XB_SPIN_CAP) { atomicAdd(&bar[XB_TMO], 1u); break; } }
    }
    nloc = mine > 0u ? mine : 1u; nx = cnt > 0u ? cnt : 1u;
}
__device__ __forceinline__ void xcd_barrier(const XcdBarrier& b) {
    asm volatile("s_waitcnt vmcnt(0)" ::: "memory");
    __syncthreads();
    if (threadIdx.x == 0) {
        unsigned* bar = b.bar;
        __builtin_amdgcn_s_waitcnt(0);
        unsigned nloc = b.st[0], nx = b.st[1];
        if (nloc == 0u) { xcd_barrier_complete(bar, b.x, nloc, nx); b.st[0] = nloc; b.st[1] = nx; }
        const unsigned old = xb_add(&bar[XB_XSUB(b.x)], 1u);
        const unsigned gen = old / nloc;
        if (old + 1u == (gen + 1u) * nloc) {
            __builtin_amdgcn_fence(__ATOMIC_RELEASE, "agent");
            asm volatile("s_waitcnt vmcnt(0)" ::: "memory");
            const unsigned og = xb_add(&bar[XB_TOP], 1u);
            const unsigned tg = og / nx;
            if (og + 1u == (tg + 1u) * nx) xb_add(&bar[XB_TOPGEN], 1u);
            else XB_SPIN(xb_ld(&bar[XB_TOPGEN]) == tg, bar);
            __builtin_amdgcn_fence(__ATOMIC_ACQUIRE, "agent");
            xb_add(&bar[XB_XGEN(b.x)], 1u);
            asm volatile("s_waitcnt vmcnt(0)" ::: "memory");
        } else {
            XB_SPIN(xb_ld(&bar[XB_XGEN(b.x)]) == gen, bar);
            __builtin_amdgcn_fence(__ATOMIC_ACQUIRE, "agent");
            asm volatile("s_waitcnt vmcnt(0)" ::: "memory");
        }
    }
    __syncthreads();
}

struct Args { const float* in[34]; float* out; unsigned char* ws; int ph_lo, ph_hi, li, pad; };
typedef const __attribute__((address_space(4))) Args* CArgsP;
enum { I_XP = 0, I_XS, I_SSD, I_CCKV, I_CKR, I_C, I_CCTX, I_WMOD, I_BMOD, I_GNORM, I_WGU, I_WDN, I_WIE, I_WOE, I_WSP, I_BSP, I_GV, I_WCS, I_BCS, I_DTB, I_ALOG, I_DSK, I_GSO,
       I_WIO, I_WOO, I_GCQ, I_WUQ, I_GCKV, I_WUKV, I_WDW, I_BDW, I_GLN, I_BLN, I_GFIN };
using pg8::Unit;
constexpr int EP_PART = RING_BYTES, EP_S = RING_BYTES + 4096, EP_B = RING_BYTES + 4096 + 8192;
__device__ __forceinline__ void epi_prefetch_dma(GAS unsigned char* ws, int bias_off, const Unit& u, int wid, int lane, PG8_LAS unsigned char* ldsl, int par) {
    if (wid < 4) __builtin_amdgcn_global_load_lds((const GAS unsigned*)(ws + WS_SSQ + ((size_t)(u.pm * 256 + 64 * wid + lane) * 4) * 4), (PG8_LAS unsigned*)(ldsl + EP_S + par * 4096 + wid * 1024), 16, 0, 0);
    else if (wid == 4) __builtin_amdgcn_global_load_lds((const GAS unsigned*)(ws + WS_BIASF + ((size_t)bias_off / 16 + (size_t)modrow_of_tile(u.pm) * BIAS_LD + u.pn * 256 + 4 * lane) * 4), (PG8_LAS unsigned*)(ldsl + EP_B + par * 1024), 16, 0, 0);
}
__device__ __forceinline__ void epi_prefetch_sync16(GAS unsigned char* ws, int bias_off, const Unit& u, int tid, PG8_LAS unsigned char* ldsl, int par) {
    if (tid < 256) *(PG8_LAS pg8::f32x4*)(ldsl + EP_S + par * 4096 + tid * 16) = *(const GAS pg8::f32x4*)(ws + WS_SSQ + ((size_t)(u.pm * 256 + tid) * 4) * 4);
    else { const GAS float* bp = (const GAS float*)(ws + WS_BIAS) + (size_t)bias_off + (size_t)modrow_of_tile(u.pm) * BIAS_MS + u.pn * 256 + (tid - 256); float b = 0.f;
#pragma unroll
        for (int kb = 0; kb < 16; ++kb) b += bp[(size_t)kb * BIAS_LD];
        ((PG8_LAS float*)(ldsl + EP_B))[par * 256 + (tid - 256)] = b; }
}
__device__ __forceinline__ float epi_row_rstd(const PG8_LAS unsigned char* ldsl, int par, int rl) { const pg8::f32x4 s = *(const PG8_LAS pg8::f32x4*)(ldsl + EP_S + par * 4096 + rl * 16); return frsq(((s[0] + s[1]) + (s[2] + s[3])) * (1.f / D) + EPS); }
struct EpiSwiglu {
    static constexpr bool PERM = true;
    GAS unsigned char* ws; int bias_off, nparts;
    __device__ __forceinline__ void prefetch_dma(const Unit& u, int wid, int lane, PG8_LAS unsigned char* ldsl, int par) const { if (nparts == 1) epi_prefetch_dma(ws, bias_off, u, wid, lane, ldsl, par); }
    __device__ __forceinline__ void prefetch_sync(const Unit& u, int tid, PG8_LAS unsigned char* ldsl, int par) const { if (nparts != 1) epi_prefetch_sync16(ws, bias_off, u, tid, ldsl, par); }
    __device__ __forceinline__ void operator()(const pg8::f32x4 (&acc)[2][2][4][2], const Unit& u, int wr, int wc, int fr, int fq, PG8_LAS unsigned char* ldsl, int par) const {
        bf16* H = (bf16*)(GAS bf16*)(ws + WS_H);
        const PG8_LAS float* bb = (const PG8_LAS float*)(ldsl + EP_B) + par * 256 + wc * 32 + 8 * fq;
        const int row0 = u.pm * 256 + wr * 64 + fr, col0 = u.pn * 128 + wc * 32 + 8 * fq;
        const pg8::f32x4 bg0 = *(const PG8_LAS pg8::f32x4*)bb, bg1 = *(const PG8_LAS pg8::f32x4*)(bb + 4), bu0 = *(const PG8_LAS pg8::f32x4*)(bb + 128), bu1 = *(const PG8_LAS pg8::f32x4*)(bb + 132);
#pragma unroll
        for (int ai = 0; ai < 2; ++ai)
#pragma unroll
            for (int m = 0; m < 4; ++m) {
                const int rl = ai * 128 + wr * 64 + m * 16 + fr;
                const float rs = epi_row_rstd(ldsl, par, rl);
                bf16* rowp = H + (size_t)(u.pm * 256 + rl) * DFF + col0;
                const pg8::f32x4 g0 = acc[ai][0][m][0] * rs + bg0, g1 = acc[ai][0][m][1] * rs + bg1, u0 = acc[ai][1][m][0] * rs + bu0, u1 = acc[ai][1][m][1] * rs + bu1;
                float gg[8], uu[8], e[8], o[8];
#pragma unroll
                for (int j = 0; j < 4; ++j) { gg[j] = g0[j]; gg[4 + j] = g1[j]; uu[j] = u0[j]; uu[4 + j] = u1[j]; }
#pragma unroll
                for (int j = 0; j < 8; ++j) e[j] = __builtin_amdgcn_exp2f(gg[j] * -1.4426950408889634f);
#pragma unroll
                for (int j = 0; j < 8; ++j) e[j] = __builtin_amdgcn_rcpf(1.0f + e[j]);
#pragma unroll
                for (int j = 0; j < 8; ++j) o[j] = (gg[j] * uu[j]) * e[j];
                pg8::u32x4 w; w.x = pg8::cvt_pk_bf16(o[0], o[1]); w.y = pg8::cvt_pk_bf16(o[2], o[3]); w.z = pg8::cvt_pk_bf16(o[4], o[5]); w.w = pg8::cvt_pk_bf16(o[6], o[7]);
                *(pg8::u32x4*)rowp = w;
            }
        (void)row0;
    }
};
struct EpiResid {
    static constexpr bool PERM = true;
    GAS unsigned char* ws; const float* gn; int gate_off, scn_off; float coef;
    __device__ __forceinline__ void prefetch_dma(const Unit&, int, int, PG8_LAS unsigned char*, int) const {}
    __device__ __forceinline__ void prefetch_sync(const Unit&, int, PG8_LAS unsigned char*, int) const {}
    __device__ __forceinline__ void operator()(const pg8::f32x4 (&acc)[2][2][4][2], const Unit& u, int wr, int wc, int fr, int fq, PG8_LAS unsigned char* ldsl, int) const {
        bf16* X = (bf16*)(GAS bf16*)(ws + WS_X); const float* gate = (const float*)(const GAS float*)(ws + WS_MOD) + gate_off; const float* scn = (const float*)(const GAS float*)(ws + WS_MOD) + scn_off;
        bf16* XA = (bf16*)(GAS bf16*)(ws + WS_XA); float* SSQ = (float*)(GAS float*)(ws + WS_SSQ); PG8_LAS float* part = (PG8_LAS float*)(ldsl + EP_PART);
        const int row0 = u.pm * 256 + wr * 64 + fr, col0 = u.pn * 256 + wc * 32 + 8 * fq;
        const int mr = modrow_of_tile(u.pm);
        float ss[2][4];
#pragma unroll
        for (int ai = 0; ai < 2; ++ai)
#pragma unroll
            for (int m = 0; m < 4; ++m) ss[ai][m] = 0.f;
#pragma unroll
        for (int bj = 0; bj < 2; ++bj) {
            const int co = col0 + bj * 128;
            const float* gp = gate + (size_t)mr * NMODV + co; const float* sp = scn + (size_t)mr * NMODV + co;
            const pg8::f32x4 gv0 = *(const pg8::f32x4*)gp * coef, gv1 = *(const pg8::f32x4*)(gp + 4) * coef;
            const pg8::f32x4 gc0 = *(const pg8::f32x4*)(gn + co) * (*(const pg8::f32x4*)sp + 1.0f), gc1 = *(const pg8::f32x4*)(gn + co + 4) * (*(const pg8::f32x4*)(sp + 4) + 1.0f);
#pragma unroll
            for (int ai = 0; ai < 2; ++ai) {
                pg8::u32x4 xo[4];
#pragma unroll
                for (int m = 0; m < 4; ++m) xo[m] = *(const pg8::u32x4*)(X + (size_t)(row0 + ai * 128 + m * 16) * D + co);
#pragma unroll
                for (int m = 0; m < 4; ++m) {
                    const size_t off = (size_t)(row0 + ai * 128 + m * 16) * D + co;
                    const pg8::u32x4 xw = xo[m];
                    const pg8::f32x4 x0 = {bflo(xw.x), bfhi(xw.x), bflo(xw.y), bfhi(xw.y)}, x1 = {bflo(xw.z), bfhi(xw.z), bflo(xw.w), bfhi(xw.w)};
                    const pg8::f32x4 n0 = x0 + gv0 * acc[ai][bj][m][0], n1 = x1 + gv1 * acc[ai][bj][m][1];
                    ss[ai][m] += ((n0[0] * n0[0] + n0[1] * n0[1]) + (n0[2] * n0[2] + n0[3] * n0[3])) + ((n1[0] * n1[0] + n1[1] * n1[1]) + (n1[2] * n1[2] + n1[3] * n1[3]));
                    pg8::u32x4 w; w.x = pg8::cvt_pk_bf16(n0[0], n0[1]); w.y = pg8::cvt_pk_bf16(n0[2], n0[3]); w.z = pg8::cvt_pk_bf16(n1[0], n1[1]); w.w = pg8::cvt_pk_bf16(n1[2], n1[3]);
                    *(pg8::u32x4*)(X + off) = w;
                    const pg8::f32x4 a0 = n0 * gc0, a1 = n1 * gc1;
                    pg8::u32x4 v; v.x = pg8::cvt_pk_bf16(a0[0], a0[1]); v.y = pg8::cvt_pk_bf16(a0[2], a0[3]); v.z = pg8::cvt_pk_bf16(a1[0], a1[1]); v.w = pg8::cvt_pk_bf16(a1[2], a1[3]);
                    *(pg8::u32x4*)(XA + off) = v;
                }
            }
        }
#pragma unroll
        for (int ai = 0; ai < 2; ++ai)
#pragma unroll
            for (int m = 0; m < 4; ++m) { float s = ss[ai][m]; s += xlane<16>(s); s = sum_x32(s);
                if (fq == 0) part[wc * 256 + ai * 128 + wr * 64 + m * 16 + fr] = s; }
        asm volatile("s_waitcnt lgkmcnt(0)" ::: "memory"); __builtin_amdgcn_s_barrier(); asm volatile("" ::: "memory");
        const int t = (wr * 4 + wc) * 64 + fq * 16 + fr;
        if (t < 256) SSQ[(size_t)(u.pm * 256 + t) * 4 + u.pn] = (part[t] + part[256 + t]) + (part[512 + t] + part[768 + t]);
    }
};
struct EpiStore {
    static constexpr bool PERM = true;
    GAS unsigned char* ws; unsigned o_off; int ldc; int bias_off;
    __device__ __forceinline__ void prefetch_dma(const Unit& u, int wid, int lane, PG8_LAS unsigned char* ldsl, int par) const { if (bias_off >= 0) epi_prefetch_dma(ws, bias_off, u, wid, lane, ldsl, par); }
    __device__ __forceinline__ void prefetch_sync(const Unit&, int, PG8_LAS unsigned char*, int) const {}
    __device__ __forceinline__ void operator()(const pg8::f32x4 (&acc)[2][2][4][2], const Unit& u, int wr, int wc, int fr, int fq, PG8_LAS unsigned char* ldsl, int par) const {
        bf16* O = (bf16*)(GAS bf16*)(ws + o_off);
        const PG8_LAS float* bb = (const PG8_LAS float*)(ldsl + EP_B) + par * 256 + wc * 32 + 8 * fq;
        const int col0 = u.pn * 256 + wc * 32 + 8 * fq; const bool nrm = bias_off >= 0;
        pg8::f32x4 b[2][2];
#pragma unroll
        for (int bj = 0; bj < 2; ++bj)
#pragma unroll
            for (int n = 0; n < 2; ++n) { const pg8::f32x4 bv = *(const PG8_LAS pg8::f32x4*)(bb + bj * 128 + 4 * n); b[bj][n] = nrm ? bv : (pg8::f32x4){0.f, 0.f, 0.f, 0.f}; }
#pragma unroll
        for (int ai = 0; ai < 2; ++ai)
#pragma unroll
            for (int m = 0; m < 4; ++m) {
                const int rl = ai * 128 + wr * 64 + m * 16 + fr;
                const float rs0 = epi_row_rstd(ldsl, par, rl), rs = nrm ? rs0 : 1.0f;
                bf16* rowp = O + (size_t)(u.pm * 256 + rl) * ldc + col0;
#pragma unroll
                for (int bj = 0; bj < 2; ++bj) {
                    const pg8::f32x4 v0 = acc[ai][bj][m][0] * rs + b[bj][0], v1 = acc[ai][bj][m][1] * rs + b[bj][1];
                    pg8::u32x4 w; w.x = pg8::cvt_pk_bf16(v0[0], v0[1]); w.y = pg8::cvt_pk_bf16(v0[2], v0[3]); w.z = pg8::cvt_pk_bf16(v1[0], v1[1]); w.w = pg8::cvt_pk_bf16(v1[2], v1[3]);
                    *(pg8::u32x4*)(rowp + bj * 128) = w;
                }
            }
    }
};

struct Frame {
    unsigned char* lds;
    mutable int tid, lane; int wave, bid, G;
    __device__ __forceinline__ void relane() const { int ln; asm volatile("v_mbcnt_lo_u32_b32 %0, -1, 0\n\tv_mbcnt_hi_u32_b32 %0, -1, %0" : "=v"(ln)); lane = ln; tid = wave * 64 + ln; }
    CArgsP a;
    GAS unsigned char* ws;
};
#define WSP(type, off) ((type*)(GAS type*)(F.ws + (off)))
#define AIN(i) ((const float*)(const GAS float*)F.a->in[i])
#define AOUT ((float*)(GAS float*)F.a->out)

__device__ __forceinline__ void p0_transpose_item(const float* W, int N, bf16* WT, int ldt, int k0, int n0, int dst_row0, float* scr, int lane, const float* shift, float* bias_out) {
    const int n = n0 + (lane & 31); const bool ok = n < N;
#pragma unroll 8
    for (int i = 0; i < 32; ++i) { const int kk = 2 * i + (lane >> 5); scr[kk * 33 + (lane & 31)] = ok ? W[(size_t)(k0 + kk) * N + n] : 0.f; }
    if (bias_out) {
#pragma unroll
        for (int m = 0; m < 3; ++m) scr[64 * 33 + m * 64 + lane] = shift[(size_t)m * NMODV + lane];
    }
    asm volatile("s_waitcnt lgkmcnt(0)" ::: "memory");
    const int c = lane & 7;
#pragma unroll
    for (int j = 0; j < 4; ++j) { const int nn = (lane >> 3) + 8 * j; const float* s = scr + (8 * c) * 33 + nn;
        v4u o; o.x = pk2(s[0 * 33], s[1 * 33]); o.y = pk2(s[2 * 33], s[3 * 33]); o.z = pk2(s[4 * 33], s[5 * 33]); o.w = pk2(s[6 * 33], s[7 * 33]);
        *(v4u*)(WT + (size_t)(dst_row0 + nn) * ldt + k0 + 8 * c) = o; }
    if (bias_out) {
        const int kh = lane >> 5, nl = lane & 31; float a0 = 0.f, a1 = 0.f, a2 = 0.f;
#pragma unroll 8
        for (int i = 0; i < 32; ++i) { const int kk = kh * 32 + i; const float wv = scr[kk * 33 + nl];
            a0 += wv * scr[64 * 33 + kk]; a1 += wv * scr[64 * 33 + 64 + kk]; a2 += wv * scr[64 * 33 + 128 + kk]; }
        a0 = sum_x32(a0); a1 = sum_x32(a1); a2 = sum_x32(a2);
        if (lane < 32) { float* bo = bias_out + (size_t)(k0 >> 6) * BIAS_LD + dst_row0 + nl; bo[0] = a0; bo[BIAS_MS] = a1; bo[2 * BIAS_MS] = a2; }
    }
    asm volatile("s_waitcnt lgkmcnt(0)" ::: "memory");
}
constexpr int CI_DN = 44 * 32, CI_OE = 16 * 32, CI_UQ = 6 * 24, CI_KV = 4 * 32, CI_GU = 16 * 176, CI_IE = 16 * 88, CI_IO = 16 * 56;
__host__ __device__ constexpr int conv_na(int l) { return 2 * CI_DN + CI_OE + ((l & 1) ? CI_UQ + CI_KV : 0); }
__host__ __device__ constexpr int conv_nb(int l) { return 2 * CI_GU + ((l & 1) ? CI_IO : CI_IE); }
__device__ __forceinline__ void conv_item_a(const Frame& F, int l, int it, float* scr) {
    int r = it; const int hi = l >> 1;
    if (r < 2 * CI_DN) { const int w = l * 2 + r / CI_DN, q = r % CI_DN, kb = q / 32, nb = q % 32;
        p0_transpose_item(AIN(I_WDN) + (size_t)w * DFF * 1024, 1024, WSP(bf16, WS_WD + w * SZ_WD), DFF, kb * 64, nb * 32, nb * 32, scr, F.lane, nullptr, nullptr); return; } r -= 2 * CI_DN;
    if (r < CI_OE) { const int kb = r / 32, nb = r % 32;
        if (l & 1) p0_transpose_item(AIN(I_WOO) + (size_t)hi * 1024 * 1024, 1024, WSP(bf16, WS_WOO + hi * SZ_WO), 1024, kb * 64, nb * 32, nb * 32, scr, F.lane, nullptr, nullptr);
        else       p0_transpose_item(AIN(I_WOE) + (size_t)hi * 1024 * 1024, 1024, WSP(bf16, WS_WOE + hi * SZ_WO), 1024, kb * 64, nb * 32, nb * 32, scr, F.lane, nullptr, nullptr);
        return; } r -= CI_OE;
    if (r < CI_UQ) { const int kb = r / 24, nb = r % 24;
        p0_transpose_item(AIN(I_WUQ) + (size_t)hi * 384 * 768, 768, WSP(bf16, WS_WUQ + hi * SZ_WUQ), 384, kb * 64, nb * 32, nb * 32, scr, F.lane, nullptr, nullptr); return; } r -= CI_UQ;
    { const int kb = r / 32, nb = r % 32, n0 = nb * 32, h = n0 >> 7, rr = n0 & 127;
        const int dst = (rr < 64 ? 0 : 512) + h * 64 + (rr & 63);
        p0_transpose_item(AIN(I_WUKV) + (size_t)hi * 256 * 1024, 1024, WSP(bf16, WS_WKV + hi * SZ_WKV), 256, kb * 64, n0, dst, scr, F.lane, nullptr, nullptr); }
}
__device__ __forceinline__ void conv_item_b(const Frame& F, int l, int it, float* scr) {
    int r = it; const int hi = l >> 1; const float* MOD = WSP(float, WS_MOD) + (size_t)l * 3 * NMODV; float* BIAS = WSP(float, WS_BIAS) + (size_t)(l * 3) * 3 * BIAS_MS;
    if (r < 2 * CI_GU) { const int f = r / CI_GU, w = l * 2 + f, q = r % CI_GU, kb = q / 176, nb = q % 176, n0 = nb * 32;
        const int dst = (n0 < DFF) ? ((n0 >> 7) * 256 + (n0 & 127)) : (((n0 - DFF) >> 7) * 256 + 128 + ((n0 - DFF) & 127));
        p0_transpose_item(AIN(I_WGU) + (size_t)w * 1024 * 5632, 5632, WSP(bf16, WS_WGU + w * SZ_WGU), 1024, kb * 64, n0, dst, scr, F.lane,
                          MOD + (f == 0 ? 0 : 6) * 1024 + kb * 64, BIAS + (size_t)(f == 0 ? 0 : 2) * 3 * BIAS_MS); return; } r -= 2 * CI_GU;
    if (l & 1) { const int kb = r / 56, nb = r % 56;
        p0_transpose_item(AIN(I_WIO) + (size_t)hi * 1024 * 1696, 1696, WSP(bf16, WS_WIO + hi * SZ_WIO), 1024, kb * 64, nb * 32, nb * 32, scr, F.lane, MOD + 3 * 1024 + kb * 64, BIAS + (size_t)3 * BIAS_MS); }
    else { const int kb = r / 88, nb = r % 88;
        p0_transpose_item(AIN(I_WIE) + (size_t)hi * 1024 * 2576, 2576, WSP(bf16, WS_WIE + hi * SZ_WIE), 1024, kb * 64, nb * 32, nb * 32, scr, F.lane, MOD + 3 * 1024 + kb * 64, BIAS + (size_t)3 * BIAS_MS); }
}
template <int N4> __device__ __forceinline__ void mod_tile(const Frame& F, int l, int tile) {
    constexpr int KG = 504 / N4, NC = 4 * N4;
    float* sv = (float*)F.lds;
    float* red = (float*)(F.lds + 12288);
    __syncthreads();
    for (int i = F.tid; i < 3072; i += NTHR) { const int r = i >> 10, k = i & 1023; const float c = (r == 0) ? AIN(I_CCTX)[k] : AIN(I_C)[(r - 1) * 1024 + k]; sv[i] = siluf_(c); }
    __syncthreads();
    const int n0 = tile * NC, n4 = F.tid % N4, kg = F.tid / N4;
    if (F.tid < 504) {
        f32x4 a0 = {0.f, 0.f, 0.f, 0.f}, a1 = a0, a2 = a0;
        const float* wp = AIN(I_WMOD) + (size_t)l * 1024 * NMODV + n0 + 4 * n4;
#pragma unroll 4
        for (int k = kg; k < 1024; k += KG) { const f32x4 w = *(const f32x4*)(wp + (size_t)k * NMODV); a0 += w * sv[k]; a1 += w * sv[1024 + k]; a2 += w * sv[2048 + k]; }
        *(f32x4*)(red + (kg * 3 + 0) * NC + 4 * n4) = a0; *(f32x4*)(red + (kg * 3 + 1) * NC + 4 * n4) = a1; *(f32x4*)(red + (kg * 3 + 2) * NC + 4 * n4) = a2;
    }
    __syncthreads();
    for (int o = F.tid; o < 3 * NC; o += NTHR) { const int r = o / NC, n = o % NC; float s = AIN(I_BMOD)[l * NMODV + n0 + n];
        for (int g = 0; g < KG; ++g) s += red[(g * 3 + r) * NC + n];
        WSP(float, WS_MOD)[(size_t)(l * 3 + r) * NMODV + n0 + n] = s; }
    __syncthreads();
}
__device__ __forceinline__ void bias_reduce(const Frame& F, int l, int kmask, int bgi, int nbg) {
    const float* BP = WSP(float, WS_BIAS); float* BF = WSP(float, WS_BIASF);
    const int gt = bgi * NTHR + F.tid, NT = nbg * NTHR;
    for (int i = gt; i < 3 * 3 * (int)BIAS_LD; i += NT) { const int kind = i / (3 * (int)BIAS_LD), rem = i % (3 * (int)BIAS_LD), m = rem / (int)BIAS_LD, n = rem % (int)BIAS_LD;
        if (!((kmask >> kind) & 1)) continue;
        const float* p = BP + ((size_t)(l * 3 + kind) * 3 + m) * BIAS_MS + n; float b = 0.f;
#pragma unroll
        for (int kb = 0; kb < 16; ++kb) b += p[(size_t)kb * BIAS_LD];
        BF[((size_t)(l * 3 + kind) * 3 + m) * BIAS_LD + n] = b; }
}
__device__ __forceinline__ void background_work(const Frame& F, int l, int win, int bgi, int nbg) {
    F.relane();
    if (nbg <= 0) return;
    if (win == 0) bias_reduce(F, l, 6, bgi, nbg);
    if (l >= 3) return;
    const int ln = l + 1;
    if (win == 2) bias_reduce(F, ln, 1, bgi, nbg);
    float* scr = (float*)(F.lds + F.wave * 16384);
    const int gw = bgi * NWAVES + F.wave, NGW = nbg * NWAVES;
    if (win == 0) {
        for (int t = bgi; t < 64; t += nbg) mod_tile<36>(F, ln, t);
        const int na = conv_na(ln);
        for (int it = gw; it < na; it += NGW) conv_item_a(F, ln, it, scr);
    } else {
        const int nb = conv_nb(ln), cut = CI_GU;
        const int lo = win == 1 ? 0 : cut, hi_ = win == 1 ? cut : nb;
        for (int it = lo + gw; it < hi_; it += NGW) conv_item_b(F, ln, it, scr);
    }
}
__device__ __forceinline__ void p0_phase(const Frame& F) {
    F.relane();
    for (int t = F.bid; t < 256; t += F.G) mod_tile<9>(F, 0, t);
    {
        float* scr = (float*)(F.lds + F.wave * 16384);
        const int gw = F.bid * NWAVES + F.wave, NGW = F.G * NWAVES;
        for (int it = gw; it < conv_na(0); it += NGW) conv_item_a(F, 0, it, scr);
    }
    {
        const size_t gt = (size_t)F.bid * NTHR + F.tid, NT = (size_t)F.G * NTHR;
        for (size_t i = gt; i < 1024 * 16; i += NT) { const int pos = (int)(i >> 4), ax = (int)(i >> 3) & 1, f = (int)i & 7;
            const float freq = exp2f(-(float)f * (13.287712379549449f / 8.0f));
            const float ang = (float)(ax == 0 ? (pos >> 6) : (pos & 63)) * freq;
            float sn, cs; sincosf(ang, &sn, &cs);
            WSP(float, WS_ROPE)[2 * i] = cs; WSP(float, WS_ROPE)[2 * i + 1] = sn; }
    }
}
__device__ __forceinline__ void p1_copy_phase(const Frame& F) {
    F.relane();
    float* scr = (float*)(F.lds + F.wave * 16384);
    const int gw = F.bid * NWAVES + F.wave, NGW = F.G * NWAVES;
    for (int it = gw; it < conv_nb(0); it += NGW) conv_item_b(F, 0, it, scr);
}

__device__ __forceinline__ void norm0_phase(const Frame& F) {
    F.relane();
    const int gw = F.bid * NWAVES + F.wave, NGW = F.G * NWAVES;
    bf16* X = WSP(bf16, WS_X); bf16* XA = WSP(bf16, WS_XA); float* SSQ = WSP(float, WS_SSQ);
    const float* g = AIN(I_GNORM); const float* scale = WSP(float, WS_MOD) + 1024;
    for (int row = gw; row < T; row += NGW) {
        const int r = modrow_of_tok(row);
        const f32x4* xr = (const f32x4*)(row < TCTX ? AIN(I_XP) + (size_t)row * D : AIN(I_XS) + (size_t)(row - TCTX) * D) + F.lane;
        f32x4 v[4]; float s = 0.f;
#pragma unroll
        for (int j = 0; j < 4; ++j) { v[j] = xr[64 * j]; s += (v[j].x * v[j].x + v[j].y * v[j].y) + (v[j].z * v[j].z + v[j].w * v[j].w); }
        s = wave_sum(s);
        if (F.lane == 0) *(f32x4*)(SSQ + (size_t)row * 4) = (f32x4){s, 0.f, 0.f, 0.f};
        unsigned long long* o8 = (unsigned long long*)(XA + (size_t)row * D) + F.lane;
        unsigned long long* xo = (unsigned long long*)(X + (size_t)row * D) + F.lane;
#pragma unroll
        for (int j = 0; j < 4; ++j) {
            const f32x4 gg = *((const f32x4*)g + F.lane + 64 * j), sc = *((const f32x4*)(scale + (size_t)r * NMODV) + F.lane + 64 * j);
            const f32x4 o = v[j] * gg * (sc + 1.0f);
            xo[64 * j] = (unsigned long long)pk2(v[j].x, v[j].y) | ((unsigned long long)pk2(v[j].z, v[j].w) << 32);
            o8[64 * j] = (unsigned long long)pk2(o.x, o.y) | ((unsigned long long)pk2(o.z, o.w) << 32);
        }
    }
}
__device__ __forceinline__ void final_phase(const Frame& F) {
    F.relane();
    const int gw = F.bid * NWAVES + F.wave, NGW = F.G * NWAVES;
    const bf16* X = WSP(bf16, WS_X); const float* g = AIN(I_GFIN); float* out = AOUT + OUT_Y;
    for (int row = gw; row < T; row += NGW) {
        const v2u* xr = (const v2u*)(X + (size_t)row * D) + F.lane;
        f32x4 v[4]; float s = 0.f;
#pragma unroll
        for (int j = 0; j < 4; ++j) { const v2u w = xr[64 * j]; v[j] = (f32x4){bflo(w.x), bfhi(w.x), bflo(w.y), bfhi(w.y)}; s += (v[j].x * v[j].x + v[j].y * v[j].y) + (v[j].z * v[j].z + v[j].w * v[j].w); }
        const float rstd = frsq(wave_sum(s) * (1.f / D) + EPS);
        f32x4* o = (f32x4*)(out + (size_t)row * D) + F.lane;
#pragma unroll
        for (int j = 0; j < 4; ++j) o[64 * j] = v[j] * rstd * *((const f32x4*)g + F.lane + 64 * j);
    }
}
constexpr int LDT = 136;
__device__ __forceinline__ bf16x8 ld_frag16(const unsigned char* p) { return *(const bf16x8*)p; }
__device__ __forceinline__ bf16x8 ld_frag8x2(const unsigned char* p0, const unsigned char* p1) {
    const v2u a = *(const v2u*)p0, b = *(const v2u*)p1; v4u v; v.x = a.x; v.y = a.y; v.z = b.x; v.w = b.y; return __builtin_bit_cast(bf16x8, v); }
#define MFMA16(a, b, c) __builtin_amdgcn_mfma_f32_16x16x32_bf16((a), (b), (c), 0, 0, 0)

__device__ __forceinline__ void chunk_info(int c, int& cfirst, int& clast, bool& is_ctx, int& sb) {
    if (c < 64) { cfirst = c & ~1; clast = cfirst + 1; is_ctx = true; sb = c >> 1; }
    else { cfirst = 64 + ((c - 64) & ~7); clast = cfirst + 7; is_ctx = false; sb = (c - 64) >> 3; }
}
struct ConvW { f32x4 w0a, w0b, w1a, w1b, w2a, w2b, ba, bb; };
__device__ __forceinline__ ConvW conv_w(const float* wc, const float* bc, int ch) {
    ConvW W; W.w0a = *(const f32x4*)(wc + ch); W.w0b = *(const f32x4*)(wc + ch + 4); W.w1a = *(const f32x4*)(wc + 1024 + ch); W.w1b = *(const f32x4*)(wc + 1024 + ch + 4);
    W.w2a = *(const f32x4*)(wc + 2048 + ch); W.w2b = *(const f32x4*)(wc + 2048 + ch + 4); W.ba = *(const f32x4*)(bc + ch); W.bb = *(const f32x4*)(bc + ch + 4); return W;
}
__device__ __forceinline__ void conv8(const bf16* PROJ, int t, bool has_prev, bool has_next, int ch, const ConvW& W, float* out) {
    const bf16* p = PROJ + (size_t)t * EVEN_NP + 1536 + ch;
    const v4u z = {0u, 0u, 0u, 0u};
    const v4u c0 = *(const v4u*)p, cm = has_prev ? *(const v4u*)(p - EVEN_NP) : z, cp = has_next ? *(const v4u*)(p + EVEN_NP) : z;
    float x0[8], xm[8], xp[8]; unpack8(c0, x0); unpack8(cm, xm); unpack8(cp, xp);
#pragma unroll
    for (int i = 0; i < 4; ++i) { out[i] = siluf_(W.ba[i] + W.w0a[i] * xm[i] + W.w1a[i] * x0[i] + W.w2a[i] * xp[i]); out[4 + i] = siluf_(W.bb[i] + W.w0b[i] * xm[4 + i] + W.w1b[i] * x0[4 + i] + W.w2b[i] * xp[4 + i]); }
}
__device__ __forceinline__ void ssd_tables(const Frame& F, int ei, int t0, float* dtl, float* cml) {
    const bf16* PROJ = WSP(bf16, WS_PROJ);
    if (F.tid < 256) { const int j = F.tid >> 1, dir = F.tid & 1;
        const v4u raw = *(const v4u*)(PROJ + (size_t)(t0 + j) * EVEN_NP + 2560 + 8 * dir); float x[8]; unpack8(raw, x);
#pragma unroll
        for (int h = 0; h < 8; ++h) dtl[(dir * 8 + h) * 128 + j] = softplusf_(x[h] + AIN(I_DTB)[ei * 16 + dir * 8 + h]); }
    __syncthreads();
#pragma unroll
    for (int k = 0; k < 2; ++k) {
        const int row = 2 * F.wave + k, rev = row >> 3;
        const float a = -__expf(AIN(I_ALOG)[ei * 16 + row]);
        const int i0 = rev ? 127 - 2 * F.lane : 2 * F.lane, i1 = rev ? 126 - 2 * F.lane : 2 * F.lane + 1;
        const float v0 = dtl[row * 128 + i0] * a, v1 = dtl[row * 128 + i1] * a;
        float x = v0 + v1;
#pragma unroll
        for (int d = 1; d < 64; d <<= 1) { const float t = __builtin_bit_cast(float, __builtin_amdgcn_ds_bpermute((F.lane - d) * 4, __builtin_bit_cast(int, x))); x += (F.lane >= d) ? t : 0.f; }
        const float ex = x - (v0 + v1);
        cml[row * 128 + i0] = ex + v0; cml[row * 128 + i1] = ex + (v0 + v1);
    }
    __syncthreads();
}
constexpr int TILE128 = 34816, TILE64 = 17408;
constexpr int S1_BT = 0, S1_B = TILE128, S1_C = 2 * TILE128, S1_XT = TILE128  , S1_DT = 3 * TILE128, S1_CUM = S1_DT + 8192;
constexpr int S2_XT = 0  , S2_H = 2 * TILE64  , S2_DT = 6 * TILE64, S2_CUM = S2_DT + 8192, S2_SSQ = S2_CUM + 8192;

__device__ __forceinline__ void ssd_state_item(const Frame& F, int ei, int c, int g) {
    F.relane();
    const bf16* PROJ = WSP(bf16, WS_PROJ);
    const float* wc = AIN(I_WCS) + (size_t)ei * 3 * 1024; const float* bc = AIN(I_BCS) + (size_t)ei * 1024;
    int cfirst, clast, sb; bool is_ctx; chunk_info(c, cfirst, clast, is_ctx, sb);
    const int t0 = c * 128, len = is_ctx ? 256 : 1024, pos0 = (c - cfirst) * 128;
    bf16* BT = (bf16*)(F.lds + S1_BT); bf16* Bl = (bf16*)(F.lds + S1_B); bf16* Cl = (bf16*)(F.lds + S1_C); bf16* XT4 = (bf16*)(F.lds + S1_XT);
    float* dtl = (float*)(F.lds + S1_DT); float* cml = (float*)(F.lds + S1_CUM);
    bf16* ST = WSP(bf16, WS_ST); float* DEC = WSP(float, WS_DEC);
    bf16* CC = WSP(bf16, WS_CC); bf16* CBM = WSP(bf16, WS_CBM); bf16* XCT = WSP(bf16, WS_XCT);
    const int r = F.lane & 15, q = F.lane >> 4, w = F.wave;
    __syncthreads();
    ssd_tables(F, ei, t0, dtl, cml);
    { const ConvW W = conv_w(wc, bc, 512 + g * 128 + (F.tid & 15) * 8);
#pragma unroll 4
    for (int e = F.tid; e < 128 * 16; e += NTHR) { const int j = e >> 4, n8 = (e & 15) * 8; float o[8];
        conv8(PROJ, t0 + j, pos0 + j > 0, pos0 + j < len - 1, 512 + g * 128 + n8, W, o);
        const v4u pk = pack8(o);
        *(v4u*)((unsigned char*)Bl + (j * LDT + n8) * 2) = pk;
#pragma unroll
        for (int i = 0; i < 8; ++i) BT[(n8 + i) * LDT + j] = (bf16)f2bf1(o[i]); } }
    { const ConvW W = conv_w(wc, bc, 768 + g * 128 + (F.tid & 15) * 8);
#pragma unroll 4
    for (int e = F.tid; e < 128 * 16; e += NTHR) { const int j = e >> 4, n8 = (e & 15) * 8; float o[8];
        conv8(PROJ, t0 + j, pos0 + j > 0, pos0 + j < len - 1, 768 + g * 128 + n8, W, o);
        const v4u pk = pack8(o);
        *(v4u*)((unsigned char*)Cl + (j * LDT + n8) * 2) = pk;
        *(v4u*)(CC + (size_t)(t0 + j) * 256 + g * 128 + n8) = pk; } }
    __syncthreads();
    {
        bf16x8 cf[4];
#pragma unroll
        for (int ks = 0; ks < 4; ++ks) cf[ks] = ld_frag16((const unsigned char*)Cl + ((16 * w + r) * LDT + 32 * ks + 8 * q) * 2);
        bf16* dst = CBM + ((size_t)(c * 2 + g) * 128 + 16 * w + r) * 128 + 4 * q;
#pragma unroll
        for (int jt = 0; jt < 8; ++jt) { f32x4 a = {0.f, 0.f, 0.f, 0.f};
#pragma unroll
            for (int ks = 0; ks < 4; ++ks) a = MFMA16(ld_frag16((const unsigned char*)Bl + ((16 * jt + r) * LDT + 32 * ks + 8 * q) * 2), cf[ks], a);
            v2u o; o.x = pk2(a[0], a[1]); o.y = pk2(a[2], a[3]); *(v2u*)(dst + 16 * jt) = o; }
    }
    __syncthreads();
    { const ConvW W = conv_w(wc, bc, g * 256 + (F.tid & 31) * 8);
#pragma unroll 4
    for (int e = F.tid; e < 128 * 32; e += NTHR) { const int j = e >> 5, p8 = (e & 31) * 8; float o[8];
        conv8(PROJ, t0 + j, pos0 + j > 0, pos0 + j < len - 1, g * 256 + p8, W, o);
#pragma unroll
        for (int i = 0; i < 8; ++i) XT4[(p8 + i) * LDT + j] = (bf16)f2bf1(o[i]); } }
    __syncthreads();
#pragma unroll 4
    for (int e = F.tid; e < 256 * 16; e += NTHR) { const int row = e >> 4, ch = (e & 15) * 8;
        *(v4u*)(XCT + ((size_t)(c * 8 + 4 * g) * 64 + row) * 128 + ch) = *(const v4u*)((const unsigned char*)XT4 + (row * LDT + ch) * 2); }
#pragma unroll 2
    for (int hd = 0; hd < 8; ++hd) {
        const int hh = hd >> 1, dir = hd & 1, h = 4 * g + hh;
        const float* dth = dtl + (dir * 8 + h) * 128; const float* cmh = cml + (dir * 8 + h) * 128;
        const float cend = dir == 0 ? cmh[127] : cmh[0];
        const bf16* XT = XT4 + hh * 64 * LDT;
        f32x4 acc[4];
#pragma unroll
        for (int pt = 0; pt < 4; ++pt) acc[pt] = (f32x4){0.f, 0.f, 0.f, 0.f};
#pragma unroll
        for (int ks = 0; ks < 4; ++ks) {
            const int j0 = 32 * ks + 8 * q;
            const v4u braw = *(const v4u*)((const unsigned char*)BT + ((16 * w + r) * LDT + j0) * 2); float bv[8]; unpack8(braw, bv);
            const f32x4 d0 = *(const f32x4*)(dth + j0), d1 = *(const f32x4*)(dth + j0 + 4), c0 = *(const f32x4*)(cmh + j0), c1 = *(const f32x4*)(cmh + j0 + 4);
#pragma unroll
            for (int i = 0; i < 4; ++i) { bv[i] *= d0[i] * __expf(cend - c0[i]); bv[4 + i] *= d1[i] * __expf(cend - c1[i]); }
            const bf16x8 af = __builtin_bit_cast(bf16x8, pack8(bv));
#pragma unroll
            for (int pt = 0; pt < 4; ++pt) { const bf16x8 bf = ld_frag16((const unsigned char*)XT + ((16 * pt + r) * LDT + j0) * 2); acc[pt] = MFMA16(af, bf, acc[pt]); }
        }
        bf16* dst = ST + ((size_t)(c * 8 + h) * 2 + dir) * 8192;
#pragma unroll
        for (int pt = 0; pt < 4; ++pt) { v2u o; o.x = pk2(acc[pt][0], acc[pt][1]); o.y = pk2(acc[pt][2], acc[pt][3]); *(v2u*)(dst + (16 * pt + r) * 128 + 16 * w + 4 * q) = o; }
        if (F.tid == 0) DEC[(c * 8 + h) * 2 + dir] = __expf(cend);
    }
}

__device__ __forceinline__ void gmlp_item(const Frame& F, int ei, int c, int g) {
    F.relane();
    const bf16* PROJ = WSP(bf16, WS_PROJ); bf16* YMIX = WSP(bf16, WS_YMIX);
    const int t0 = c * 128;
    float* rs = (float*)F.lds; bf16* Vt = (bf16*)(F.lds + 1024); bf16* Wl = (bf16*)(F.lds + 1024 + 34816);
    const float* gv = AIN(I_GV) + ei * 512;
    __syncthreads();
#pragma unroll 1
    for (int kb = 0; kb < 16; kb += 8) {
        v4u raw[8];
#pragma unroll
        for (int k = 0; k < 8; ++k) raw[k] = *(const v4u*)(PROJ + (size_t)(t0 + F.wave * 16 + kb + k) * EVEN_NP + 512 + 8 * F.lane);
#pragma unroll
        for (int k = 0; k < 8; ++k) { float x[8]; unpack8(raw[k], x); float s = 0.f;
#pragma unroll
            for (int i = 0; i < 8; ++i) { const float y = gelu_tanh(x[i]); s += y * y; }
            s = wave_sum(s); if (F.lane == 0) rs[F.wave * 16 + kb + k] = frsq(s * (1.f / 512.f) + EPS); }
    }
    { const float* ws_ = AIN(I_WSP) + ((size_t)ei * 4 + g) * 16384;
#pragma unroll
      for (int e = F.tid; e < 4096; e += NTHR) { const int i = e >> 5, j4 = (e & 31) * 4; const f32x4 v = *(const f32x4*)(ws_ + i * 128 + j4);
          v2u o; o.x = pk2(v.x, v.y); o.y = pk2(v.z, v.w); *(v2u*)((unsigned char*)Wl + (i * LDT + j4) * 2) = o; } }
    __syncthreads();
    { const int d8 = (F.tid & 15) * 8; v4u raw[4];
#pragma unroll
      for (int k = 0; k < 4; ++k) raw[k] = *(const v4u*)(PROJ + (size_t)(t0 + (F.tid >> 4) + 32 * k) * EVEN_NP + 512 + g * 128 + d8);
#pragma unroll
      for (int k = 0; k < 4; ++k) { const int j = (F.tid >> 4) + 32 * k; float x[8]; unpack8(raw[k], x); const float rj = rs[j];
#pragma unroll
          for (int i = 0; i < 8; ++i) Vt[(d8 + i) * LDT + j] = (bf16)f2bf1(gelu_tanh(x[i]) * rj * gv[g * 128 + d8 + i]); } }
    __syncthreads();
    const int r = F.lane & 15, q = F.lane >> 4, w = F.wave;
    bf16x8 af[4];
#pragma unroll
    for (int ks = 0; ks < 4; ++ks) af[ks] = ld_frag16((const unsigned char*)Vt + ((16 * w + r) * LDT + 32 * ks + 8 * q) * 2);
    const float* bs = AIN(I_BSP) + ((size_t)ei * 4 + g) * 128;
    v2u uraw[8];
#pragma unroll
    for (int it = 0; it < 8; ++it) uraw[it] = *(const v2u*)(PROJ + (size_t)(t0 + 16 * it + r) * EVEN_NP + g * 128 + 16 * w + 4 * q);
#pragma unroll
    for (int it = 0; it < 8; ++it) {
        f32x4 acc = {0.f, 0.f, 0.f, 0.f};
#pragma unroll
        for (int ks = 0; ks < 4; ++ks) acc = MFMA16(af[ks], ld_frag16((const unsigned char*)Wl + ((16 * it + r) * LDT + 32 * ks + 8 * q) * 2), acc);
        const int i = 16 * it + r, col = g * 128 + 16 * w + 4 * q; const float b = bs[i];
        const float u0 = gelu_tanh(bflo(uraw[it].x)), u1 = gelu_tanh(bfhi(uraw[it].x)), u2 = gelu_tanh(bflo(uraw[it].y)), u3 = gelu_tanh(bfhi(uraw[it].y));
        v2u o; o.x = pk2(u0 * (acc[0] + b), u1 * (acc[1] + b)); o.y = pk2(u2 * (acc[2] + b), u3 * (acc[3] + b));
        *(v2u*)(YMIX + (size_t)(t0 + i) * D + col) = o;
    }
}

__device__ __forceinline__ f32x4 ld_bf4(const bf16* p) { const v2u w = *(const v2u*)p; return (f32x4){bflo(w.x), bfhi(w.x), bflo(w.y), bfhi(w.y)}; }
__device__ __forceinline__ void ssd_scan_phase(const Frame& F, int ei) {
    F.relane();
    const bf16* ST = WSP(bf16, WS_ST); const float* DEC = WSP(float, WS_DEC); bf16* HIN = WSP(bf16, WS_HIN);
    const size_t gt = (size_t)F.bid * NTHR + F.tid, NT = (size_t)F.G * NTHR;
    constexpr size_t N_SMP = (size_t)2 * 8 * 2 * 2048, N_CTX = (size_t)32 * 8 * 2 * 2048;
    for (size_t it = gt; it < N_SMP + N_CTX; it += NT) {
        if (it < N_SMP) {
            const int e = (int)(it & 2047) * 4, dir = (int)(it >> 11) & 1, h = (int)(it >> 12) & 7, b = (int)(it >> 15);
            const int c0 = 64 + 8 * b;
            f32x4 st[8]; float dc[8];
#pragma unroll
            for (int k = 0; k < 8; ++k) { const int cc = dir == 0 ? c0 + k : c0 + 7 - k; st[k] = ld_bf4(ST + ((size_t)(cc * 8 + h) * 2 + dir) * 8192 + e); dc[k] = DEC[(cc * 8 + h) * 2 + dir]; }
            f32x4 v = *(const f32x4*)(AIN(I_SSD) + ((size_t)((b * 2 + ei) * 2 + dir) * 8 + h) * 8192 + e);
#pragma unroll
            for (int k = 0; k < 8; ++k) { const int cc = dir == 0 ? c0 + k : c0 + 7 - k;
                v2u o; o.x = pk2(v.x, v.y); o.y = pk2(v.z, v.w); *(v2u*)(HIN + ((size_t)(cc * 8 + h) * 2 + dir) * 8192 + e) = o;
                v = v * dc[k] + st[k]; }
        } else {
            const size_t i2 = it - N_SMP;
            const int e = (int)(i2 & 2047) * 4, dir = (int)(i2 >> 11) & 1, h = (int)(i2 >> 12) & 7, s = (int)(i2 >> 15);
            const int ca = dir == 0 ? 2 * s : 2 * s + 1, cb = dir == 0 ? 2 * s + 1 : 2 * s;
            const f32x4 sa = ld_bf4(ST + ((size_t)(ca * 8 + h) * 2 + dir) * 8192 + e), sb_ = ld_bf4(ST + ((size_t)(cb * 8 + h) * 2 + dir) * 8192 + e);
            const float db = DEC[(cb * 8 + h) * 2 + dir];
            *(f32x4*)(AOUT + OUT_SSD + ((size_t)((s * 2 + ei) * 2 + dir) * 8 + h) * 8192 + e) = sa * db + sb_;
        }
    }
}

__device__ __forceinline__ void ssd_out_item(const Frame& F, int ei, int c, int th) {
    F.relane();
    const bf16* PROJ = WSP(bf16, WS_PROJ); bf16* YMIX = WSP(bf16, WS_YMIX);
    const bf16* CC = WSP(bf16, WS_CC); const bf16* CBM = WSP(bf16, WS_CBM); const bf16* XCT = WSP(bf16, WS_XCT); const bf16* HIN = WSP(bf16, WS_HIN); const bf16* ST = WSP(bf16, WS_ST);
    const int t0 = c * 128;
    float* dtl = (float*)(F.lds + S2_DT); float* cml = (float*)(F.lds + S2_CUM); float* ssqx = (float*)(F.lds + S2_SSQ);
    const int r = F.lane & 15, q = F.lane >> 4, w = F.wave, it = w & 3, g = w >> 2;
    const int irow = 64 * th + 16 * it + r;
    const bool hzero[2] = {c < 64 && (c & 1) == 0, c < 64 && (c & 1) == 1};
    __syncthreads();
    ssd_tables(F, ei, t0, dtl, cml);
    v2u cbp[8]; bf16x8 cf[4];
    {
        const bf16* cbr = CBM + ((size_t)(c * 2 + g) * 128 + irow) * 128 + 4 * q;
#pragma unroll
        for (int jt = 0; jt < 8; ++jt) cbp[jt] = *(const v2u*)(cbr + 16 * jt);
#pragma unroll
        for (int kn = 0; kn < 4; ++kn) cf[kn] = *(const bf16x8*)(CC + (size_t)(t0 + irow) * 256 + g * 128 + 32 * kn + 8 * q);
    }
    float ssq = 0.f;
    v4u pre[12];
    const int goff = (F.tid >> 4) * 128 + (F.tid & 15) * 8, loff = ((F.tid >> 4) * LDT + (F.tid & 15) * 8) * 2;
#define E2_SRC(m_, hh_) ((m_) < 2 ? XCT + (size_t)(c * 8 + 4 * (m_) + (hh_)) * 8192 : \
        (c < 64 ? ST + ((size_t)((((m_) - 2) & 1) == 0 ? c - 1 : c + 1) * 8 + 4 * (((m_) - 2) >> 1) + (hh_)) * 16384 + (((m_) - 2) & 1) * 8192 \
                : HIN + ((size_t)c * 8 + 4 * (((m_) - 2) >> 1) + (hh_)) * 16384 + (((m_) - 2) & 1) * 8192))
#define E2_FETCH(hh_) do { _Pragma("unroll") for (int m = 0; m < 6; ++m) { if (m >= 2 && hzero[(m - 2) & 1]) continue; const bf16* sp = E2_SRC(m, hh_) + goff; \
            pre[2 * m] = *(const v4u*)sp; pre[2 * m + 1] = *(const v4u*)(sp + 32 * 128); } } while (0)
    E2_FETCH(0);
#pragma unroll 1
    for (int hh = 0; hh < 4; ++hh) {
        __syncthreads();
#pragma unroll
        for (int m = 0; m < 6; ++m) { if (m >= 2 && hzero[(m - 2) & 1]) continue;
            unsigned char* dp = F.lds + (m < 2 ? S2_XT + m * TILE64 : S2_H + (m - 2) * TILE64) + loff;
            *(v4u*)dp = pre[2 * m]; *(v4u*)(dp + 32 * LDT * 2) = pre[2 * m + 1]; }
        __syncthreads();
        if (hh < 3) E2_FETCH(hh + 1);
        v2u zr4[4];
#pragma unroll
        for (int pt = 0; pt < 4; ++pt) zr4[pt] = *(const v2u*)(PROJ + (size_t)(t0 + irow) * EVEN_NP + 1024 + (4 * g + hh) * 64 + 16 * pt + 4 * q);
        const int h = 4 * g + hh;
        const bf16* XT = (const bf16*)(F.lds + S2_XT + g * TILE64);
        f32x4 yacc[4];
#pragma unroll
        for (int pt = 0; pt < 4; ++pt) yacc[pt] = (f32x4){0.f, 0.f, 0.f, 0.f};
        const float* dt0 = dtl + h * 128; const float* cm0 = cml + h * 128; const float* dt1 = dtl + (8 + h) * 128; const float* cm1 = cml + (8 + h) * 128;
        const float ci0 = cm0[irow], ci1 = cm1[irow];
#pragma unroll
        for (int ks = 0; ks < 4; ++ks) {
            float sl0[8], sl1[8];
#pragma unroll
            for (int hf = 0; hf < 2; ++hf) {
                const int j0 = 32 * ks + 16 * hf + 4 * q; const v2u cw = cbp[2 * ks + hf];
                const f32x4 c0v = *(const f32x4*)(cm0 + j0), d0v = *(const f32x4*)(dt0 + j0), c1v = *(const f32x4*)(cm1 + j0), d1v = *(const f32x4*)(dt1 + j0);
                const float cbv[4] = {bflo(cw.x), bfhi(cw.x), bflo(cw.y), bfhi(cw.y)};
#pragma unroll
                for (int e = 0; e < 4; ++e) { const int j = j0 + e;
                    const float e0 = __expf(ci0 - c0v[e]) * d0v[e] * cbv[e], e1 = __expf(ci1 - c1v[e]) * d1v[e] * cbv[e];
                    sl0[4 * hf + e] = (j <= irow) ? e0 : 0.f; sl1[4 * hf + e] = (j >= irow) ? e1 : 0.f; }
            }
            const bf16x8 sf0 = __builtin_bit_cast(bf16x8, pack8(sl0)), sf1 = __builtin_bit_cast(bf16x8, pack8(sl1));
#pragma unroll
            for (int pt = 0; pt < 4; ++pt) { const unsigned char* xr = (const unsigned char*)XT + ((16 * pt + r) * LDT + 32 * ks + 4 * q) * 2;
                const bf16x8 xf = ld_frag8x2(xr, xr + 32);
                yacc[pt] = MFMA16(xf, sf0, yacc[pt]); yacc[pt] = MFMA16(xf, sf1, yacc[pt]); }
        }
#pragma unroll
        for (int dir = 0; dir < 2; ++dir) {
            if (hzero[dir]) continue;
            const unsigned char* Hl = F.lds + S2_H + (g * 2 + dir) * TILE64;
            const float ei_ = __expf(dir == 0 ? ci0 : ci1);
#pragma unroll
            for (int pt = 0; pt < 4; ++pt) { f32x4 t = {0.f, 0.f, 0.f, 0.f};
#pragma unroll
                for (int kn = 0; kn < 4; ++kn) t = MFMA16(ld_frag16(Hl + ((16 * pt + r) * LDT + 32 * kn + 8 * q) * 2), cf[kn], t);
                yacc[pt] += t * ei_; }
        }
        const float dsk = AIN(I_DSK)[ei * 16 + h] + AIN(I_DSK)[ei * 16 + 8 + h];
#pragma unroll
        for (int pt = 0; pt < 4; ++pt) {
            const int p0 = 16 * pt + 4 * q;
            const v2u zr = zr4[pt];
            const float z0 = bflo(zr.x), z1 = bfhi(zr.x), z2 = bflo(zr.y), z3 = bfhi(zr.y);
            float y0 = yacc[pt][0] + dsk * bf1(XT[(p0 + 0) * LDT + irow]), y1 = yacc[pt][1] + dsk * bf1(XT[(p0 + 1) * LDT + irow]),
                  y2 = yacc[pt][2] + dsk * bf1(XT[(p0 + 2) * LDT + irow]), y3 = yacc[pt][3] + dsk * bf1(XT[(p0 + 3) * LDT + irow]);
            y0 *= siluf_(z0); y1 *= siluf_(z1); y2 *= siluf_(z2); y3 *= siluf_(z3);
            ssq += (y0 * y0 + y1 * y1) + (y2 * y2 + y3 * y3);
            v2u o; o.x = pk2(y0, y1); o.y = pk2(y2, y3);
            *(v2u*)(YMIX + (size_t)(t0 + irow) * D + 512 + h * 64 + p0) = o;
        }
    }
#undef E2_FETCH
#undef E2_SRC
    ssq += xlane<16>(ssq); ssq = sum_x32(ssq);
    if (q == 0) ssqx[w * 16 + r] = ssq;
    __syncthreads();
    ssq += ssqx[(w ^ 4) * 16 + r];
    const float rstd = frsq(ssq * (1.f / 512.f) + EPS);
    const float* go = AIN(I_GSO) + ei * 512;
#pragma unroll 1
    for (int hh = 0; hh < 4; ++hh)
#pragma unroll
        for (int pt = 0; pt < 4; ++pt) {
            const int col = (4 * g + hh) * 64 + 16 * pt + 4 * q;
            v2u* p = (v2u*)(YMIX + (size_t)(t0 + irow) * D + 512 + col); const v2u v = *p; const f32x4 gg = *(const f32x4*)(go + col);
            v2u o; o.x = pk2(bflo(v.x) * rstd * gg.x, bfhi(v.x) * rstd * gg.y); o.y = pk2(bflo(v.y) * rstd * gg.z, bfhi(v.y) * rstd * gg.w);
            *p = o;
        }
}

__device__ __forceinline__ void even_phase1(const Frame& F, int ei) {
    if (F.G >= 256) {
        if (F.bid < 160) ssd_state_item(F, ei, F.bid >> 1, F.bid & 1);
        else for (int it = F.bid - 160; it < 192; it += F.G - 160) gmlp_item(F, ei, it >> 2, it & 3);
        return;
    }
    for (int it = F.bid; it < 160 + 320; it += F.G) {
        if (it < 160) ssd_state_item(F, ei, it >> 1, it & 1);
        else gmlp_item(F, ei, (it - 160) >> 2, (it - 160) & 3);
    }
}
__device__ __forceinline__ void even_phase2(const Frame& F, int ei) {
    if (F.G >= 256) {
        if (F.bid < 160) ssd_out_item(F, ei, F.bid >> 1, F.bid & 1);
        else for (int it = 192 + F.bid - 160; it < 320; it += F.G - 160) gmlp_item(F, ei, it >> 2, it & 3);
        return;
    }
    for (int it = F.bid; it < 160; it += F.G) ssd_out_item(F, ei, it >> 1, it & 1);
}
constexpr int CV_T = 43, CV_W = CV_T + 30, CV_ITEMS = 32 * 6 + 2 * 24;
__device__ __forceinline__ void conv_item(const Frame& F, int oi, int item) {
    F.relane();
    const bf16* PROJ = WSP(bf16, WS_PROJ); bf16* YMIX = WSP(bf16, WS_YMIX);
    int sbeg, slen, tile; if (item < 192) { sbeg = (item / 6) * 256; slen = 256; tile = item % 6; } else { const int i2 = item - 192; sbeg = TCTX + (i2 / 24) * 1024; slen = 1024; tile = i2 % 24; }
    const int send = sbeg + slen, t0 = sbeg + tile * CV_T, nt = (slen - tile * CV_T) < CV_T ? (slen - tile * CV_T) : CV_T;
    float* Dl = (float*)F.lds;
    const int c = F.tid;
    float glu[CV_W];
#pragma unroll
    for (int w0 = 0; w0 < CV_W; w0 += 8) {
        bf16 av[8], gv[8];
#pragma unroll
        for (int i = 0; i < 8; ++i) if (w0 + i < CV_W) { int t = t0 - 15 + w0 + i; t = t < sbeg ? sbeg : (t >= send ? send - 1 : t);
            av[i] = PROJ[(size_t)t * ODD_NP + 672 + c]; gv[i] = PROJ[(size_t)t * ODD_NP + 1184 + c]; }
#pragma unroll
        for (int i = 0; i < 8; ++i) if (w0 + i < CV_W) { const int t = t0 - 15 + w0 + i; const float v = bf1(av[i]) * sigmoidf_(bf1(gv[i])); glu[w0 + i] = (t >= sbeg && t < send) ? v : 0.f; }
    }
    float wk[31];
#pragma unroll
    for (int k = 0; k < 31; ++k) wk[k] = AIN(I_WDW)[((size_t)oi * 31 + k) * 512 + c];
    const float bd = AIN(I_BDW)[oi * 512 + c];
    __syncthreads();
#pragma unroll
    for (int tt = 0; tt < CV_T; ++tt) { float s = bd;
#pragma unroll
        for (int k = 0; k < 31; ++k) s += wk[k] * glu[tt + k];
        Dl[tt * 512 + c] = s; }
    __syncthreads();
    const float* gl = AIN(I_GLN) + oi * 512; const float* bl = AIN(I_BLN) + oi * 512;
    const f32x4 g0 = *(const f32x4*)(gl + 8 * F.lane), g1 = *(const f32x4*)(gl + 8 * F.lane + 4), b0 = *(const f32x4*)(bl + 8 * F.lane), b1 = *(const f32x4*)(bl + 8 * F.lane + 4);
#pragma unroll 1
    for (int tt = F.wave; tt < nt; tt += NWAVES) {
        const f32x4 v0 = *(const f32x4*)(Dl + tt * 512 + 8 * F.lane), v1 = *(const f32x4*)(Dl + tt * 512 + 8 * F.lane + 4);
        float s = (v0.x + v0.y) + (v0.z + v0.w) + (v1.x + v1.y) + (v1.z + v1.w);
        const float mean = wave_sum(s) * (1.f / 512.f);
        const f32x4 d0 = v0 - mean, d1 = v1 - mean;
        float s2 = (d0.x * d0.x + d0.y * d0.y) + (d0.z * d0.z + d0.w * d0.w) + (d1.x * d1.x + d1.y * d1.y) + (d1.z * d1.z + d1.w * d1.w);
        const float rstd = frsq(wave_sum(s2) * (1.f / 512.f) + EPS);
        float o[8];
#pragma unroll
        for (int i = 0; i < 4; ++i) { o[i] = siluf_(d0[i] * rstd * g0[i] + b0[i]); o[4 + i] = siluf_(d1[i] * rstd * g1[i] + b1[i]); }
        *(v4u*)(YMIX + (size_t)(t0 + tt) * D + 512 + 8 * F.lane) = pack8(o);
    }
}
__device__ __forceinline__ void odd_rows(const Frame& F, int oi) {
    F.relane();
    const bf16* PROJ = WSP(bf16, WS_PROJ);
    bf16* QA = WSP(bf16, WS_QA); bf16* CKVA = WSP(bf16, WS_CKVA); bf16* KR = WSP(bf16, WS_KR); const float* ROPE = WSP(float, WS_ROPE);
    const int gw = F.bid * NWAVES + F.wave, NGW = F.G * NWAVES, lane = F.lane;
    for (int row = T + gw; row < TP; row += NGW) {
        const int b = (row - T) >> 8, j = (row - T) & 255;
        const f32x4 v = *(const f32x4*)(AIN(I_CCKV) + ((size_t)(b * 2 + oi) * 256 + j) * 256 + 4 * lane);
        v2u o; o.x = pk2(v.x, v.y); o.y = pk2(v.z, v.w); *(v2u*)(CKVA + (size_t)row * 256 + 4 * lane) = o;
        if (lane < 32) KR[(size_t)row * 32 + lane] = (bf16)f2bf1(AIN(I_CKR)[((size_t)(b * 2 + oi) * 256 + j) * 32 + lane]);
    }
    const f32x4 gkv = *(const f32x4*)(AIN(I_GCKV) + oi * 256 + 4 * lane);
    float gq[6];
#pragma unroll
    for (int k = 0; k < 3; ++k) { gq[2 * k] = AIN(I_GCQ)[oi * 384 + 128 * k + 2 * lane]; gq[2 * k + 1] = AIN(I_GCQ)[oi * 384 + 128 * k + 2 * lane + 1]; }
    unsigned qw[3], nqw[3]; v2u kw, nkw; bf16 krw, nkrw;
    int row = gw;
    if (row < T) { const bf16* pr = PROJ + (size_t)row * ODD_NP;
#pragma unroll
        for (int k = 0; k < 3; ++k) nqw[k] = *(const unsigned*)(pr + 128 * k + 2 * lane);
        nkw = *(const v2u*)(pr + 384 + 4 * lane); nkrw = pr[640 + (lane & 31)]; }
#pragma unroll 1
    for (; row < T; row += NGW) {
#pragma unroll
        for (int k = 0; k < 3; ++k) qw[k] = nqw[k];
        kw = nkw; krw = nkrw;
        if (row + NGW < T) { const bf16* pr = PROJ + (size_t)(row + NGW) * ODD_NP;
#pragma unroll
            for (int k = 0; k < 3; ++k) nqw[k] = *(const unsigned*)(pr + 128 * k + 2 * lane);
            nkw = *(const v2u*)(pr + 384 + 4 * lane); nkrw = pr[640 + (lane & 31)]; }
        float qv[6]; float s = 0.f;
#pragma unroll
        for (int k = 0; k < 3; ++k) { qv[2 * k] = bflo(qw[k]); qv[2 * k + 1] = bfhi(qw[k]); s += qv[2 * k] * qv[2 * k] + qv[2 * k + 1] * qv[2 * k + 1]; }
        f32x4 kv = {bflo(kw.x), bfhi(kw.x), bflo(kw.y), bfhi(kw.y)};
        float s2 = (kv.x * kv.x + kv.y * kv.y) + (kv.z * kv.z + kv.w * kv.w);
        s += xlane<1>(s); s2 += xlane<1>(s2); s += xlane<2>(s); s2 += xlane<2>(s2); s += xlane<4>(s); s2 += xlane<4>(s2); s += xlane<8>(s); s2 += xlane<8>(s2); s += xlane<16>(s); s2 += xlane<16>(s2);
        s = sum_x32(s); s2 = sum_x32(s2);
        const float rq = frsq(s * (1.f / 384.f) + EPS), rk = frsq(s2 * (1.f / 256.f) + EPS);
#pragma unroll
        for (int k = 0; k < 3; ++k) *(unsigned*)(QA + (size_t)row * 384 + 128 * k + 2 * lane) = pk2(qv[2 * k] * rq * gq[2 * k], qv[2 * k + 1] * rq * gq[2 * k + 1]);
        kv = kv * rk * gkv;
        { v2u o; o.x = pk2(kv.x, kv.y); o.y = pk2(kv.z, kv.w); *(v2u*)(CKVA + (size_t)row * 256 + 4 * lane) = o; }
        float kr = bf1(krw);
        if (row < TCTX) {
            const int b = row >> 8, pos = row & 255;
            *(f32x4*)(AOUT + OUT_CKV + ((size_t)(b * 2 + oi) * 256 + pos) * 256 + 4 * lane) = kv;
            if (lane < 32) AOUT[OUT_KR + ((size_t)(b * 2 + oi) * 256 + pos) * 32 + lane] = kr;
        } else {
            const int pos = (row - TCTX) & 1023, e = lane & 31, ax = e >> 4, half = (e >> 3) & 1, f = e & 7;
            const float other = xlane<8>(kr);
            const float cs = ROPE[((pos * 2 + ax) * 8 + f) * 2], sn = ROPE[((pos * 2 + ax) * 8 + f) * 2 + 1];
            kr = half == 0 ? (kr * cs - other * sn) : (other * sn + kr * cs);
        }
        if (lane < 32) KR[(size_t)row * 32 + lane] = (bf16)f2bf1(kr);
    }
}
__device__ __forceinline__ void odd_phase1(const Frame& F, int oi) {
    for (int it = F.bid; it < CV_ITEMS; it += F.G) conv_item(F, oi, it);
    odd_rows(F, oi);
}

constexpr int AT_KROW = 208, AT_VROW = 272, AT_KBYTES = 128 * AT_KROW, AT_BUF = 45056;
struct AttnPre { v4u k[3]; v4u v[2]; };
__device__ __forceinline__ void attn_load_tile(const Frame& F, int h, int krow0, AttnPre& P) {
    const bf16* KN = WSP(bf16, WS_KN); const bf16* KR = WSP(bf16, WS_KR); const bf16* VT = WSP(bf16, WS_VT);
#pragma unroll
    for (int i = 0; i < 3; ++i) { const int e = F.tid + NTHR * i, key = e / 12, c = e % 12; const size_t kr = (size_t)(krow0 + key);
        P.k[i] = c < 8 ? *(const v4u*)(KN + kr * 512 + h * 64 + c * 8) : *(const v4u*)(KR + kr * 32 + (c - 8) * 8); }
#pragma unroll
    for (int i = 0; i < 2; ++i) { const int e = F.tid + NTHR * i, row = e >> 4, c = e & 15;
        P.v[i] = *(const v4u*)(VT + (size_t)(h * 64 + row) * TP + krow0 + c * 8); }
}
__device__ __forceinline__ void attn_store_tile(const Frame& F, unsigned char* buf, const AttnPre& P) {
#pragma unroll
    for (int i = 0; i < 3; ++i) { const int e = F.tid + NTHR * i, key = e / 12, c = e % 12; *(v4u*)(buf + key * AT_KROW + c * 16) = P.k[i]; }
#pragma unroll
    for (int i = 0; i < 2; ++i) { const int e = F.tid + NTHR * i, row = e >> 4, c = e & 15; *(v4u*)(buf + AT_KBYTES + row * AT_VROW + c * 16) = P.v[i]; }
}
__device__ __forceinline__ int attn_tile_row(bool is_smp, int sb, int i) {
    if (!is_smp) return sb * 256 + 128 * i;
    return i < 2 ? T + sb * 256 + 128 * i : TCTX + sb * 1024 + 128 * (i - 2);
}
__device__ __forceinline__ void attn_item(const Frame& F, int q0, int h, bool is_smp, int spos0, int sb) {
    F.relane();
    const bf16* Q = WSP(bf16, WS_Q); bf16* YMIX = WSP(bf16, WS_YMIX); const float* ROPE = WSP(float, WS_ROPE);
    const int r = F.lane & 15, g = F.lane >> 4, w = F.wave;
    const int tq = q0 + 16 * w + r;
    const int ntile = is_smp ? 10 : 2;
    AttnPre P;
    attn_load_tile(F, h, attn_tile_row(is_smp, sb, 0), P);
    bf16x8 qf[3];
#pragma unroll
    for (int ks = 0; ks < 3; ++ks) qf[ks] = *(const bf16x8*)(Q + (size_t)tq * 768 + h * 96 + 32 * ks + 8 * g);
    if (is_smp) {
        float x[8], o[8]; unpack8(__builtin_bit_cast(v4u, qf[2]), x);
        const int pos = spos0 + 16 * w + r, ax = g >> 1, half = g & 1;
        const float* rp = ROPE + ((size_t)(pos * 2 + ax) * 8) * 2;
#pragma unroll
        for (int j = 0; j < 8; ++j) { const float other = xlane<16>(x[j]); const float cs = rp[2 * j], sn = rp[2 * j + 1];
            o[j] = half == 0 ? (x[j] * cs - other * sn) : (other * sn + x[j] * cs); }
        qf[2] = __builtin_bit_cast(bf16x8, pack8(o));
    }
    const float csc = 0.10206207261596577f * 1.4426950408889634f;
    float m = -1e30f, l = 0.f;
    f32x4 oacc[4];
#pragma unroll
    for (int dt = 0; dt < 4; ++dt) oacc[dt] = (f32x4){0.f, 0.f, 0.f, 0.f};
    __syncthreads();
    attn_store_tile(F, F.lds, P);
    AttnPre P2;
    if (ntile > 1) attn_load_tile(F, h, attn_tile_row(is_smp, sb, 1), P);
    __syncthreads();
#define ATTN_COMPUTE(buf) do { \
        f32x4 sacc[8]; \
        _Pragma("unroll") \
        for (int st = 0; st < 8; ++st) { \
            const unsigned char* kp = buf + (16 * st + r) * AT_KROW + 16 * g; \
            f32x4 a = {0.f, 0.f, 0.f, 0.f}; \
            a = MFMA16(ld_frag16(kp), qf[0], a); a = MFMA16(ld_frag16(kp + 64), qf[1], a); a = MFMA16(ld_frag16(kp + 128), qf[2], a); \
            sacc[st] = a; \
        } \
        float mx = -1e30f; \
        _Pragma("unroll") \
        for (int st = 0; st < 8; ++st) mx = fmaxf(fmaxf(fmaxf(sacc[st][0], sacc[st][1]), fmaxf(sacc[st][2], sacc[st][3])), mx); \
        mx = fmaxf(mx, xlane<16>(mx)); mx = max_x32(mx); \
        const float mn = fmaxf(m, mx), alpha = __builtin_amdgcn_exp2f((m - mn) * csc); m = mn; \
        float ps = 0.f; float p[32]; \
        _Pragma("unroll") \
        for (int st = 0; st < 8; ++st) \
            _Pragma("unroll") \
            for (int j = 0; j < 4; ++j) { const float e = __builtin_amdgcn_exp2f((sacc[st][j] - mn) * csc); p[4 * st + j] = e; ps += e; } \
        l = l * alpha + ps; \
        _Pragma("unroll") \
        for (int dt = 0; dt < 4; ++dt) oacc[dt] *= alpha; \
        _Pragma("unroll") \
        for (int ks2 = 0; ks2 < 4; ++ks2) { \
            const bf16x8 pf = __builtin_bit_cast(bf16x8, pack8(p + 8 * ks2)); \
            _Pragma("unroll") \
            for (int dt = 0; dt < 4; ++dt) { \
                const unsigned char* vp = buf + AT_KBYTES + (16 * dt + r) * AT_VROW + (32 * ks2 + 4 * g) * 2; \
                oacc[dt] = MFMA16(ld_frag8x2(vp, vp + 32), pf, oacc[dt]); \
            } \
        } } while (0)
#pragma unroll 1
    for (int ti = 0; ti < ntile; ti += 2) {
        if (ti + 2 < ntile) attn_load_tile(F, h, attn_tile_row(is_smp, sb, ti + 2), P2);
        { const unsigned char* buf = F.lds; ATTN_COMPUTE(buf); }
        if (ti + 1 < ntile) attn_store_tile(F, F.lds + AT_BUF, P);
        __syncthreads();
        if (ti + 1 >= ntile) break;
        if (ti + 3 < ntile) attn_load_tile(F, h, attn_tile_row(is_smp, sb, ti + 3), P);
        { const unsigned char* buf = F.lds + AT_BUF; ATTN_COMPUTE(buf); }
        if (ti + 2 < ntile) attn_store_tile(F, F.lds, P2);
        __syncthreads();
    }
#undef ATTN_COMPUTE
    l += xlane<16>(l); l = sum_x32(l);
    const float inv = 1.0f / l;
#pragma unroll
    for (int dt = 0; dt < 4; ++dt) { v2u o; o.x = pk2(oacc[dt][0] * inv, oacc[dt][1] * inv); o.y = pk2(oacc[dt][2] * inv, oacc[dt][3] * inv);
        *(v2u*)(YMIX + (size_t)tq * D + h * 64 + 16 * dt + 4 * g) = o; }
}
__device__ __forceinline__ void odd_phase3(const Frame& F) {
    if (F.G >= 256) {
        if (F.bid < 128) {
            const int bh = F.bid & 15, qt = F.bid >> 4, b = bh >> 3, h = bh & 7;
            attn_item(F, TCTX + b * 1024 + qt * 128, h, true, qt * 128, b);
        } else {
            for (int p = F.bid - 128; p < 256; p += F.G - 128) { const int s = p >> 3, h = p & 7;
                attn_item(F, s * 256, h, false, 0, s); attn_item(F, s * 256 + 128, h, false, 0, s); }
        }
        return;
    }
    for (int it = F.bid; it < 640; it += F.G) {
        if (it < 128) { const int b = it >> 6, h = (it >> 3) & 7, qt = it & 7; attn_item(F, TCTX + b * 1024 + qt * 128, h, true, qt * 128, b); }
        else { const int i2 = it - 128, s = i2 >> 4, h = (i2 >> 1) & 7, qt = i2 & 1; attn_item(F, s * 256 + qt * 128, h, false, 0, s); }
    }
}
constexpr int PH_PER_LAYER = 9, PH_L0 = 2, N_PHASES = PH_L0 + 4 * PH_PER_LAYER + 1;
#ifndef MK_ONE_LAUNCH
#define MK_ONE_LAUNCH 1
#endif
#ifndef PROBE_REP
#define PROBE_REP 1
#define PROBE_SLOT -2
#endif

__global__ void __launch_bounds__(NTHR, 2) fwd_kernel(Args args) {
    extern __shared__ __attribute__((aligned(16))) unsigned char lds[];
    Frame F; F.lds = lds; F.tid = threadIdx.x; F.lane = F.tid & 63; F.wave = __builtin_amdgcn_readfirstlane(F.tid >> 6); F.bid = blockIdx.x; F.G = gridDim.x;
    const int wave_id = F.wave;
    { CArgsP ap = (CArgsP)__builtin_amdgcn_kernarg_segment_ptr(); asm volatile("" : "+s"(ap)); F.a = ap; F.ws = (GAS unsigned char*)ap->ws; }
    LAS unsigned char* ldsl = (LAS unsigned char*)lds;
    for (int u = F.tid; u < (LDS_BYTES - LDSCTL_OFF) / 4; u += NTHR) ((LAS unsigned*)(ldsl + LDSCTL_OFF))[u] = 0u;
    __syncthreads();
    XcdBarrier bar; bar.bar = (unsigned*)(GAS unsigned*)(F.ws + WS_CTL) + 1024; bar.x = 0; bar.st = nullptr;
    const bool multi = (args.ph_hi - args.ph_lo) > 1;
    if (multi) bar = xcd_barrier_post((unsigned*)(GAS unsigned*)(F.ws + WS_CTL) + 1024, (volatile LAS unsigned*)(ldsl + MISC_OFF) + 8);

#define FRESH_F() do { int wv_ = wave_id; asm volatile("" : "+s"(wv_)); int ln_; asm volatile("v_mbcnt_lo_u32_b32 %0, -1, 0\n\tv_mbcnt_hi_u32_b32 %0, -1, %0" : "=v"(ln_)); F.tid = wv_ * 64 + ln_; F.lane = ln_; F.wave = wv_; } while (0)
    int rep = 0;
    for (int ph = args.ph_lo; ph < args.ph_hi; ) {
        { CArgsP ap = (CArgsP)__builtin_amdgcn_kernarg_segment_ptr(); asm volatile("" : "+s"(ap)); F.a = ap; F.ws = (GAS unsigned char*)ap->ws;
          int bid_ = blockIdx.x; asm volatile("" : "+s"(bid_)); F.bid = bid_; }
        if (ph == 0) { FRESH_F(); p0_phase(F); }
        else if (ph == 1) { FRESH_F(); p1_copy_phase(F); norm0_phase(F); }
        else if (ph == N_PHASES - 1) { FRESH_F(); final_phase(F); }
        else {
            const int l = (ph - PH_L0) / PH_PER_LAYER, s = (ph - PH_L0) % PH_PER_LAYER, hi = l >> 1; const bool odd = l & 1;
            if (s == 0 || s == 7) {
                FRESH_F();
                const int f = s == 0 ? 0 : 1;
                pg8::Gemm g{(const bf16*)(const GAS bf16*)(F.ws + WS_XA), (const bf16*)(const GAS bf16*)(F.ws + WS_WGU + (size_t)(l * 2 + f) * SZ_WGU), T, 2 * DFF, D, D, D};
                pg8::StaticOrder S; S.init(T, 2 * DFF, F.G, F.bid);
                EpiSwiglu E{F.ws, (int)(((l * 3) + (f == 0 ? 0 : 2)) * 3 * BIAS_MS), (l == 0 && f == 0) ? 16 : 1};
                pg8::gemm_phase<EpiSwiglu, pg8::StaticOrder, true>(ldsl, F.tid, g, S, E);
            } else if (s == 1 || s == 8 || s == 6) {
                FRESH_F();
                const int f = s == 1 ? 0 : 1;
                const bool mix = s == 6, lastg = (s == 8 && l == 3);
                const bf16* gA = mix ? (const bf16*)(const GAS bf16*)(F.ws + WS_YMIX) : (const bf16*)(const GAS bf16*)(F.ws + WS_H);
                const bf16* gB = mix ? (const bf16*)(const GAS bf16*)(F.ws + (odd ? WS_WOO : WS_WOE) + (size_t)hi * SZ_WO) : (const bf16*)(const GAS bf16*)(F.ws + WS_WD + (size_t)(l * 2 + f) * SZ_WD);
                const int gK = mix ? D : DFF;
                const int gate_off = l * 3 * NMODV + (mix ? 5 : (f == 0 ? 2 : 8)) * 1024;
                const float coef = rep ? 0.f : (mix ? 1.0f : 0.5f);
                const int nl = (s == 8) ? l + 1 : l, ni = mix ? 2 : (f == 0 ? 1 : 0), sci = mix ? 7 : (f == 0 ? 4 : 1);
                const float* gn = AIN(I_GNORM) + (size_t)((lastg ? 0 : nl) * 3 + ni) * D;
                const int scn_off = (lastg ? 0 : nl) * 3 * NMODV + sci * 1024;
                pg8::Gemm g{gA, gB, T, D, gK, gK, gK};
                EpiResid E{F.ws, gn, gate_off, scn_off, coef};
                pg8::StaticOrder S; S.init(T, D, F.G, F.bid);
                pg8::gemm_phase<EpiResid, pg8::StaticOrder, true>(ldsl, F.tid, g, S, E);
                FRESH_F();
                if (F.bid >= 160 && rep == 0) background_work(F, l, s == 1 ? 0 : (s == 6 ? 1 : 2), F.bid - 160, F.G - 160);
            } else if (s == 2 || (s == 4 && odd)) {
                const int ng = s == 2 ? 1 : 3;
                for (int gi = 0; gi < ng; ++gi) {
                    FRESH_F();
                    const bool inproj = s == 2;
                    const int kind = inproj ? 0 : 1 + gi;
                    const size_t offA = kind == 0 ? WS_XA : (kind == 1 ? WS_QA : (kind == 2 ? WS_CKVA : WS_WKV + (size_t)hi * SZ_WKV + (size_t)512 * 256 * 2));
                    const size_t offB = kind == 0 ? (odd ? WS_WIO + (size_t)hi * SZ_WIO : WS_WIE + (size_t)hi * SZ_WIE) : (kind == 1 ? WS_WUQ + (size_t)hi * SZ_WUQ : (kind == 2 ? WS_WKV + (size_t)hi * SZ_WKV : WS_CKVA));
                    const size_t offO = kind == 0 ? WS_PROJ : (kind == 1 ? WS_Q : (kind == 2 ? WS_KN : WS_VT));
                    const int gM = kind == 3 ? 512 : (kind == 2 ? TP : T);
                    const int gN = kind == 0 ? (odd ? ODD_NP : EVEN_NP) : (kind == 1 ? 768 : (kind == 2 ? 512 : TP));
                    const int gK = kind == 0 ? D : (kind == 1 ? 384 : 256);
                    const int ldc = kind == 3 ? TP : gN;
                    const int off = kind == 2 ? 136 : (kind == 3 ? 52 : 0);
                    pg8::Gemm g{(const bf16*)(const GAS bf16*)(F.ws + offA), (const bf16*)(const GAS bf16*)(F.ws + offB), gM, gN, gK, gK, gK};
                    EpiStore E{F.ws, (unsigned)offO, ldc, inproj ? (int)((l * 3 + 1) * 3 * BIAS_MS) : -1};
                    pg8::StaticOrder S; S.init(gM, gN, F.G, (F.bid + off) % F.G);
                    pg8::gemm_phase<EpiStore, pg8::StaticOrder, true>(ldsl, F.tid, g, S, E);
                }
            } else if (s == 3) { if (!odd) { FRESH_F(); even_phase1(F, hi); } else { FRESH_F(); odd_phase1(F, hi); } }
            else if (s == 4) { FRESH_F(); ssd_scan_phase(F, hi); }
            else if (s == 5) { if (odd) { FRESH_F(); odd_phase3(F); } else { FRESH_F(); even_phase2(F, hi); } }
        }
        {
            const int slot = ph < PH_L0 ? 100 + ph : (ph == N_PHASES - 1 ? 102 : ((ph - PH_L0) % PH_PER_LAYER) + 20 * (((ph - PH_L0) / PH_PER_LAYER) & 1));
            const int reps = ((PROBE_SLOT == 200 && slot < 100) || slot == PROBE_SLOT || (PROBE_SLOT < 20 && slot == PROBE_SLOT + 20 && (PROBE_SLOT < 2 || PROBE_SLOT > 5))) ? PROBE_REP : 1;
            if (++rep >= reps) { rep = 0; ++ph; }
            if (ph < args.ph_hi) xcd_barrier(bar);
        }
    }
}

extern "C" void kernel_launch(void* const* d_in, const int* in_sizes, int n_in, void* d_out, int out_size, void* d_ws, size_t ws_size, hipStream_t stream) {
    static int grid = 0;
    if (grid == 0) {
        if (n_in != 34 || (size_t)out_size != OUT_END || ws_size < WS_END) { fprintf(stderr, "kernel_launch: unexpected problem: n_in %d out %d ws %zu (need %zu)\n", n_in, out_size, ws_size, (size_t)WS_END); grid = -1; return; }
        int dev = 0, cus = 0, per_cu = 0;
        if (hipGetDevice(&dev) != hipSuccess || hipDeviceGetAttribute(&cus, hipDeviceAttributeMultiprocessorCount, dev) != hipSuccess) { grid = -1; return; }
        if (hipFuncSetAttribute((const void*)fwd_kernel, hipFuncAttributeMaxDynamicSharedMemorySize, LDS_BYTES) != hipSuccess) { fprintf(stderr, "kernel_launch: hipFuncSetAttribute failed\n"); grid = -1; return; }
        if (hipOccupancyMaxActiveBlocksPerMultiprocessor(&per_cu, (const void*)fwd_kernel, NTHR, LDS_BYTES) != hipSuccess || per_cu < 1) { fprintf(stderr, "kernel_launch: occupancy query says %d blocks per CU\n", per_cu); per_cu = 1; }
        (void)hipGetLastError();
        grid = cus;
        if (grid < 256) fprintf(stderr, "kernel_launch: %d CUs (tuned for 256)\n", grid);
    }
    if (grid < 0) return;
    (void)hipMemsetAsync((char*)d_ws + WS_CTL, 0, CTL_ZERO_BYTES, stream);
    Args a{};
    for (int i = 0; i < 34; ++i) a.in[i] = (const float*)d_in[i];
    a.out = (float*)d_out; a.ws = (unsigned char*)d_ws;
#if MK_ONE_LAUNCH
    a.ph_lo = 0; a.ph_hi = N_PHASES; a.li = 0;
    hipLaunchKernelGGL(fwd_kernel, dim3(grid), dim3(NTHR), LDS_BYTES, stream, a);
#else
    int li = 0;
    for (int ph = 0; ph < N_PHASES; ++ph) {
        a.ph_lo = ph; a.ph_hi = ph + 1; a.li = li++;
        hipLaunchKernelGGL(fwd_kernel, dim3(grid), dim3(NTHR), LDS_BYTES, stream, a);
    }
#endif
}
```

```cpp
#include <hip/hip_runtime.h>
#include <cstdio>
#include <cstdint>
#ifndef GEMM_SP2
#define GEMM_SP2 1
#endif
namespace pg8 {
#define PG8_LAS __attribute__((address_space(3)))
typedef unsigned short bf16_t;
typedef short bf16x8 __attribute__((ext_vector_type(8)));
typedef float f32x4 __attribute__((ext_vector_type(4)));
typedef unsigned u32x4 __attribute__((ext_vector_type(4)));
typedef unsigned u32x2 __attribute__((ext_vector_type(2)));
constexpr int BM = 256, BK = 64, HALF = 128, HTB = HALF * BK * 2  , STAGE_BYTES = 8 * HTB, NXCD = 8, WGM = 8;

__host__ __device__ __forceinline__ int lds_byte(int r, int c) { const int st = (r >> 4) * 2 + (c >> 5), rr = r & 15, cc = c & 31, ob = rr * 64 + cc * 2; return st * 1024 + (ob ^ (((ob >> 9) & 1) << 5)); }
__host__ __device__ __forceinline__ void stage_rc(int b, int& R, int& C) { const int st = b / 1024, sb = b % 1024, swz = sb ^ (((sb >> 9) & 1) << 5); R = (st >> 1) * 16 + swz / 64; C = (st & 1) * 32 + (swz % 64) / 2; }
__host__ __device__ __forceinline__ int perm32(int rho) { const int n = rho >> 4, i = rho & 15; return 8 * (i >> 2) + 4 * n + (i & 3); }

struct Unit { int pm, pn; };
struct Gemm { const bf16_t* A; const bf16_t* Bt; int M, N, K, lda, ldb; };

struct StaticOrder {
    int nM, nN, nwg, G, c;
    __host__ __device__ void init(int M, int N, int G_, int c_) { nM = M / BM; nN = N / BM; nwg = nM * nN; G = G_; c = c_; }
    __host__ __device__ bool next(int i, Unit& u) const {
        const long L = (long)i * G + c; if (L >= nwg) return false;
        int wgid = (int)L; { const int q = nwg / NXCD, r = nwg % NXCD, xcd = wgid % NXCD, off = wgid / NXCD; wgid = (xcd < r ? xcd * (q + 1) : r * (q + 1) + (xcd - r) * q) + off; }
        const int nig = WGM * nN, gid = wgid / nig, fm = gid * WGM, gsz = (nM - fm) < WGM ? (nM - fm) : WGM;
        u.pm = fm + ((wgid % nig) % gsz); u.pn = (wgid % nig) / gsz; return true;
    }
    __device__ __forceinline__ void a_ready(const Unit&) const {}
    __device__ __forceinline__ void done(const Unit&) const {}
};

__device__ __forceinline__ unsigned cvt_pk_bf16(float lo, float hi) { unsigned r; asm volatile("v_cvt_pk_bf16_f32 %0, %1, %2" : "=v"(r) : "v"(lo), "v"(hi)); return r; }

template <class Epi, class Sched, bool ALIGN_EPI>
__device__ __forceinline__ void gemm_phase(PG8_LAS unsigned char* lds, const int tid, const Gemm g, const Sched& S, const Epi& E) {
    const int wid = __builtin_amdgcn_readfirstlane(tid >> 6), lane = tid & 63, wr = wid >> 2, wc = wid & 3, fr = lane & 15, fq = lane >> 4;
    const int K = g.K, nt = K / BK;
    unsigned voffA[2], voffB[2];
#pragma unroll
    for (int i = 0; i < 2; ++i) { int R, C; stage_rc(tid * 16 + i * 8192, R, C); const int Rb = Epi::PERM ? ((R & ~31) + perm32(R & 31)) : R;
        voffA[i] = (unsigned)(R * g.lda + C) * 2u; voffB[i] = (unsigned)(Rb * g.ldb + C) * 2u; }
    const size_t kstep = (size_t)(BK * 2);
    const size_t hstepA = (size_t)HALF * g.lda * 2, hstepB = (size_t)HALF * g.ldb * 2;
    const size_t tstepA = 2 * hstepA, tstepB = 2 * hstepB;
    const unsigned ldsw = (unsigned)wid * 1024u;
    const int aoff = lds_byte(wr * 64 + fr, fq * 8), boff = lds_byte(wc * 32 + fr, fq * 8);
#define PG8_SA(b, h) (((b) * 2 + (h)) * HTB)
#define PG8_SB(b, h) ((4 + (b) * 2 + (h)) * HTB)
#define PG8_STAGE(bufoff, gbase, voff) do { _Pragma("unroll") for (int _i = 0; _i < 2; ++_i) \
        __builtin_amdgcn_global_load_lds((const unsigned*)((const char*)(gbase) + (voff)[_i]), (PG8_LAS unsigned*)(lds + (bufoff) + ldsw + _i * 8192), 16, 0, 0); } while (0)
#define PG8_LDA(dst, b, h) do { _Pragma("unroll") for (int m = 0; m < 4; ++m) _Pragma("unroll") for (int k = 0; k < 2; ++k) dst[m][k] = *(const PG8_LAS bf16x8*)(lds + PG8_SA(b, h) + aoff + m * 2048 + k * 1024); } while (0)
#define PG8_LDB(dst, b, h) do { _Pragma("unroll") for (int n = 0; n < 2; ++n) _Pragma("unroll") for (int k = 0; k < 2; ++k) dst[n][k] = *(const PG8_LAS bf16x8*)(lds + PG8_SB(b, h) + boff + n * 2048 + k * 1024); } while (0)
#define PG8_MMA(ai, bj, At, Bt) do { __builtin_amdgcn_s_setprio(1); _Pragma("unroll") for (int m = 0; m < 4; ++m) _Pragma("unroll") for (int n = 0; n < 2; ++n) _Pragma("unroll") for (int k = 0; k < 2; ++k) \
        acc[ai][bj][m][n] = __builtin_amdgcn_mfma_f32_16x16x32_bf16(Bt[n][k], At[m][k], acc[ai][bj][m][n], 0, 0, 0); __builtin_amdgcn_s_setprio(0); } while (0)
#define PG8_WAIT_V(n) asm volatile("s_waitcnt vmcnt(" #n ")" ::: "memory")
#define PG8_WAIT_L(n) asm volatile("s_waitcnt lgkmcnt(" #n ")" ::: "memory")
#define PG8_BAR __builtin_amdgcn_s_barrier()
#define PG8_SCHED __builtin_amdgcn_sched_barrier(0)
    Unit cur, nxt; int ui = 0;
    if (!S.next(0, cur)) return;
    f32x4 acc[2][2][4][2];
#pragma unroll
    for (int a = 0; a < 2; ++a)
#pragma unroll
        for (int b = 0; b < 2; ++b)
#pragma unroll
            for (int m = 0; m < 4; ++m)
#pragma unroll
                for (int n = 0; n < 2; ++n) acc[a][b][m][n] = (f32x4){0.f, 0.f, 0.f, 0.f};
    bf16x8 At[4][2], B0[2][2], B1[2][2];
    const char* cA = (const char*)g.A + (size_t)cur.pm * tstepA; const char* cB = (const char*)g.Bt + (size_t)cur.pn * tstepB;
    S.a_ready(cur);
    E.prefetch_sync(cur, tid, lds, 0); E.prefetch_dma(cur, wid, lane, lds, 0);
#if GEMM_SP2
    PG8_STAGE(PG8_SB(0, 0), cB, voffB); PG8_STAGE(PG8_SB(0, 1), cB + hstepB, voffB); PG8_STAGE(PG8_SA(0, 0), cA, voffA); PG8_STAGE(PG8_SA(0, 1), cA + hstepA, voffA);
    if (wr == 1) PG8_BAR;
    PG8_WAIT_V(2); PG8_BAR;
    PG8_STAGE(PG8_SB(1, 0), cB + kstep, voffB); PG8_STAGE(PG8_SA(1, 0), cA + kstep, voffA); PG8_STAGE(PG8_SB(1, 1), cB + hstepB + kstep, voffB);
    PG8_WAIT_V(6); PG8_BAR;
#else
    PG8_STAGE(PG8_SB(0, 0), cB, voffB); PG8_STAGE(PG8_SA(0, 0), cA, voffA); PG8_STAGE(PG8_SB(0, 1), cB + hstepB, voffB); PG8_STAGE(PG8_SA(0, 1), cA + hstepA, voffA);
    if (wr == 1) PG8_BAR;
    PG8_WAIT_V(4); PG8_BAR;
    PG8_STAGE(PG8_SB(1, 0), cB + kstep, voffB); PG8_STAGE(PG8_SA(1, 0), cA + kstep, voffA); PG8_STAGE(PG8_SB(1, 1), cB + hstepB + kstep, voffB);
    PG8_WAIT_V(6); PG8_BAR;
#endif
    for (;;) {
        const bool has_next = S.next(ui + 1, nxt);
        const char* nA = has_next ? (const char*)g.A + (size_t)nxt.pm * tstepA : cA; const char* nB = has_next ? (const char*)g.Bt + (size_t)nxt.pn * tstepB : cB;
        for (int t = 0; t < nt; t += 2) {
            const bool last = (t == nt - 2);
            const char* a1 = cA + (size_t)(t + 1) * kstep;
            const char* a2 = last ? nA : cA + (size_t)(t + 2) * kstep; const char* b2 = last ? nB : cB + (size_t)(t + 2) * kstep;
            const char* a3 = a2 + kstep; const char* b3 = b2 + kstep;
            if (last && has_next) { S.a_ready(nxt); E.prefetch_dma(nxt, wid, lane, lds, (ui + 1) & 1); }
#if GEMM_SP2
            PG8_LDB(B0, 0, 0); PG8_LDB(B1, 0, 1); PG8_SCHED; PG8_LDA(At, 0, 0); PG8_STAGE(PG8_SA(1, 1), a1 + hstepA, voffA);
            PG8_WAIT_V(8); PG8_WAIT_L(0); PG8_BAR; PG8_MMA(0, 0, At, B0); PG8_MMA(0, 1, At, B1); PG8_BAR; PG8_SCHED;
            PG8_LDA(At, 0, 1); PG8_STAGE(PG8_SB(0, 0), b2, voffB); PG8_STAGE(PG8_SB(0, 1), b2 + hstepB, voffB); PG8_STAGE(PG8_SA(0, 0), a2, voffA);
            PG8_WAIT_V(8); PG8_WAIT_L(0); PG8_BAR; PG8_MMA(1, 0, At, B0); PG8_MMA(1, 1, At, B1); PG8_BAR; PG8_SCHED;
            PG8_LDB(B0, 1, 0); PG8_LDB(B1, 1, 1); PG8_SCHED; PG8_LDA(At, 1, 0); PG8_STAGE(PG8_SA(0, 1), a2 + hstepA, voffA);
            PG8_WAIT_V(8); PG8_WAIT_L(0); PG8_BAR; PG8_MMA(0, 0, At, B0); PG8_MMA(0, 1, At, B1); PG8_BAR; PG8_SCHED;
            PG8_LDA(At, 1, 1); PG8_STAGE(PG8_SB(1, 0), b3, voffB); PG8_STAGE(PG8_SB(1, 1), b3 + hstepB, voffB); PG8_STAGE(PG8_SA(1, 0), a3, voffA);
            PG8_WAIT_V(8); PG8_WAIT_L(0); PG8_BAR; PG8_MMA(1, 0, At, B0); PG8_MMA(1, 1, At, B1); PG8_BAR; PG8_SCHED;
#else
            PG8_LDB(B0, 0, 0); PG8_SCHED; PG8_LDA(At, 0, 0); PG8_STAGE(PG8_SA(1, 1), a1 + hstepA, voffA);
            PG8_WAIT_L(8); PG8_BAR; PG8_WAIT_L(0); PG8_MMA(0, 0, At, B0); PG8_BAR; PG8_SCHED;
            PG8_LDB(B1, 0, 1); PG8_STAGE(PG8_SB(0, 0), b2, voffB);
            PG8_BAR; PG8_WAIT_L(0); PG8_MMA(0, 1, At, B1); PG8_BAR;
            PG8_LDA(At, 0, 1); PG8_STAGE(PG8_SA(0, 0), a2, voffA);
            PG8_BAR; PG8_WAIT_L(0); PG8_MMA(1, 0, At, B0); PG8_BAR; PG8_SCHED;
            PG8_STAGE(PG8_SB(0, 1), b2 + hstepB, voffB);
            PG8_WAIT_V(6); PG8_BAR; PG8_MMA(1, 1, At, B1); PG8_BAR;
            PG8_LDB(B0, 1, 0); PG8_SCHED; PG8_LDA(At, 1, 0); PG8_STAGE(PG8_SA(0, 1), a2 + hstepA, voffA);
            PG8_WAIT_L(8); PG8_BAR; PG8_WAIT_L(0); PG8_MMA(0, 0, At, B0); PG8_BAR; PG8_SCHED;
            PG8_LDB(B1, 1, 1); PG8_STAGE(PG8_SB(1, 0), b3, voffB);
            PG8_BAR; PG8_WAIT_L(0); PG8_MMA(0, 1, At, B1); PG8_BAR;
            PG8_LDA(At, 1, 1); PG8_STAGE(PG8_SA(1, 0), a3, voffA);
            PG8_BAR; PG8_WAIT_L(0); PG8_MMA(1, 0, At, B0); PG8_BAR; PG8_SCHED;
            PG8_STAGE(PG8_SB(1, 1), b3 + hstepB, voffB);
            PG8_WAIT_V(6); PG8_BAR; PG8_MMA(1, 1, At, B1); PG8_BAR;
#endif
        }
        if constexpr (ALIGN_EPI) { if (wr == 0) PG8_BAR; }
        E(acc, cur, wr, wc, fr, fq, lds, ui & 1);
#if defined(PROBE_EPI)
        if constexpr ((Epi::KIND & PROBE_EPI) != 0) { for (int er_ = 1; er_ < PROBE_EPI_REP; ++er_) E(acc, cur, wr, wc, fr, fq, lds, ui & 1); }
#endif
        if (!has_next) break;
#pragma unroll
        for (int a = 0; a < 2; ++a)
#pragma unroll
            for (int b = 0; b < 2; ++b)
#pragma unroll
                for (int m = 0; m < 4; ++m)
#pragma unroll
                    for (int n = 0; n < 2; ++n) acc[a][b][m][n] = (f32x4){0.f, 0.f, 0.f, 0.f};
        cur = nxt; cA = nA; cB = nB; ++ui;
        E.prefetch_sync(cur, tid, lds, ui & 1);
        if constexpr (ALIGN_EPI) { if (wr == 1) PG8_BAR; }
    }
    PG8_WAIT_V(0);
    if constexpr (!ALIGN_EPI) { if (wr == 0) PG8_BAR; }
    PG8_BAR;
#undef PG8_SA
#undef PG8_SB
#undef PG8_STAGE
#undef PG8_LDA
#undef PG8_LDB
#undef PG8_MMA
#undef PG8_WAIT_V
#undef PG8_WAIT_L
#undef PG8_BAR
#undef PG8_SCHED
}
}
constexpr int NWAVES = 8, NTHR = 512;
constexpr int D = 1024, TCTX = 8192, TSMP = 2048, T = 10240, TP = T + 512;
constexpr int DFF = 2816, NMODV = 9 * 1024;
constexpr int EVEN_NP = 2816, ODD_NP = 1792;
constexpr float EPS = 1e-6f;
constexpr int NCHUNK = 80;

constexpr size_t MiB = 1u << 20;
constexpr size_t WS_CTL = 0, CTL_ZERO_BYTES = 64 * 1024;
constexpr size_t WS_MOD = 1 * MiB;
constexpr size_t WS_ROPE = WS_MOD + 512 * 1024;
constexpr size_t WS_DEC = WS_ROPE + 160 * 1024;
constexpr size_t WS_SSQ = WS_MOD + 768 * 1024;
constexpr size_t WS_BIAS = 2 * MiB;
constexpr size_t BIAS_LD = 5632, BIAS_MS = 16 * BIAS_LD;
constexpr size_t WS_BIASF = 15 * MiB;
constexpr size_t WS_WGU = 16 * MiB;
constexpr size_t SZ_WGU = (size_t)5632 * 1024 * 2;
constexpr size_t WS_WD = WS_WGU + 8 * SZ_WGU;
constexpr size_t SZ_WD = (size_t)1024 * 2816 * 2;
constexpr size_t WS_WIE = WS_WD + 8 * SZ_WD;
constexpr size_t SZ_WIE = (size_t)EVEN_NP * 1024 * 2;
constexpr size_t WS_WOE = WS_WIE + 2 * SZ_WIE;
constexpr size_t SZ_WO = (size_t)1024 * 1024 * 2;
constexpr size_t WS_WIO = WS_WOE + 2 * SZ_WO;
constexpr size_t SZ_WIO = (size_t)ODD_NP * 1024 * 2;
constexpr size_t WS_WOO = WS_WIO + 2 * SZ_WIO;
constexpr size_t WS_WUQ = WS_WOO + 2 * SZ_WO;
constexpr size_t SZ_WUQ = (size_t)768 * 384 * 2;
constexpr size_t WS_WKV = WS_WUQ + 2 * SZ_WUQ;
constexpr size_t SZ_WKV = (size_t)1024 * 256 * 2;
constexpr size_t WS_WEND = WS_WKV + 2 * SZ_WKV;
constexpr size_t WS_X = (WS_WEND + MiB - 1) / MiB * MiB;
constexpr size_t WS_XA = WS_X + (size_t)T * D * 4;
constexpr size_t WS_PROJ = WS_XA + (size_t)T * D * 2;
constexpr size_t WS_YMIX = WS_PROJ + (size_t)T * EVEN_NP * 2;
constexpr size_t WS_H = WS_YMIX + (size_t)T * D * 2;
constexpr size_t WS_ST = WS_H;
constexpr size_t WS_QA = WS_H;
constexpr size_t WS_CKVA = WS_QA + (size_t)T * 384 * 2;
constexpr size_t WS_KR = WS_CKVA + (size_t)TP * 256 * 2;
constexpr size_t WS_Q = WS_KR + (size_t)TP * 32 * 2;
constexpr size_t WS_KN = WS_Q + (size_t)T * 768 * 2;
constexpr size_t WS_VT = WS_KN + (size_t)TP * 512 * 2;
constexpr size_t WS_HEND = WS_H + (size_t)T * DFF * 2;
static_assert(WS_VT + (size_t)512 * TP * 2 <= WS_HEND, "odd-layer scratch fits the H overlay");
static_assert(WS_ST + (size_t)NCHUNK * 8 * 2 * 8192 * 4 <= WS_HEND, "chunk states fit the H overlay");
constexpr size_t WS_XCT = WS_HEND;
constexpr size_t WS_CC = WS_XCT + (size_t)NCHUNK * 8 * 8192 * 2;
constexpr size_t WS_CBM = WS_CC + (size_t)T * 256 * 2;
constexpr size_t WS_HIN = WS_CBM + (size_t)NCHUNK * 2 * 16384 * 2;
constexpr size_t WS_END = WS_HIN + (size_t)NCHUNK * 8 * 2 * 8192 * 2;

constexpr size_t OUT_Y = 0, OUT_SSD = (size_t)T * D, OUT_CKV = OUT_SSD + (size_t)32 * 2 * 2 * 8 * 64 * 128, OUT_KR = OUT_CKV + (size_t)32 * 2 * 256 * 256, OUT_END = OUT_KR + (size_t)32 * 2 * 256 * 32;

constexpr int RING_BYTES = 131072;
constexpr int LDSCTL_OFF = 144 * 1024 - 512, MISC_OFF = LDSCTL_OFF + 320;
constexpr int LDS_BYTES = 147456;

#define GAS __attribute__((address_space(1)))
#define LAS __attribute__((address_space(3)))
typedef unsigned short bf16;
typedef unsigned v4u __attribute__((ext_vector_type(4)));
typedef unsigned v2u __attribute__((ext_vector_type(2)));
typedef float f32x4 __attribute__((ext_vector_type(4)));
typedef short bf16x8 __attribute__((ext_vector_type(8)));
typedef GAS unsigned gu32;
#define RLX_AGENT __ATOMIC_RELAXED, __HIP_MEMORY_SCOPE_AGENT
__device__ __forceinline__ unsigned f2bf(float f) { unsigned u = __builtin_bit_cast(unsigned, f); return (u + 0x7fffu + ((u >> 16) & 1u)) >> 16; }
typedef float f32x2_t __attribute__((ext_vector_type(2)));
typedef __bf16 bf16x2_t __attribute__((ext_vector_type(2)));
__device__ __forceinline__ unsigned pk2(float lo, float hi) { const f32x2_t v = {lo, hi}; const bf16x2_t b = __builtin_convertvector(v, bf16x2_t); return __builtin_bit_cast(unsigned, b); }
__device__ __forceinline__ unsigned f2bf1(float f) { return pk2(f, 0.f) & 0xffffu; }
__device__ __forceinline__ float bflo(unsigned w) { return __builtin_bit_cast(float, w << 16); }
__device__ __forceinline__ float bfhi(unsigned w) { return __builtin_bit_cast(float, w & 0xffff0000u); }
__device__ __forceinline__ float bf1(bf16 h) { return __builtin_bit_cast(float, ((unsigned)h) << 16); }
__device__ __forceinline__ void unpack8(const v4u v, float* o) { o[0] = bflo(v.x); o[1] = bfhi(v.x); o[2] = bflo(v.y); o[3] = bfhi(v.y); o[4] = bflo(v.z); o[5] = bfhi(v.z); o[6] = bflo(v.w); o[7] = bfhi(v.w); }
__device__ __forceinline__ v4u pack8(const float* o) { v4u v; v.x = pk2(o[0], o[1]); v.y = pk2(o[2], o[3]); v.z = pk2(o[4], o[5]); v.w = pk2(o[6], o[7]); return v; }
template <int K> __device__ __forceinline__ float xlane(float v) { static_assert(K >= 1 && K < 32, "xor mask inside a 32-lane half");
    return __builtin_bit_cast(float, __builtin_amdgcn_ds_swizzle(__builtin_bit_cast(int, v), (K << 10) | 0x1F)); }
__device__ __forceinline__ float sum_x32(float v) { const unsigned u = __builtin_bit_cast(unsigned, v); const auto r = __builtin_amdgcn_permlane32_swap(u, u, false, false);
    return __builtin_bit_cast(float, (unsigned)r[0]) + __builtin_bit_cast(float, (unsigned)r[1]); }
__device__ __forceinline__ float max_x32(float v) { const unsigned u = __builtin_bit_cast(unsigned, v); const auto r = __builtin_amdgcn_permlane32_swap(u, u, false, false);
    return fmaxf(__builtin_bit_cast(float, (unsigned)r[0]), __builtin_bit_cast(float, (unsigned)r[1])); }
__device__ __forceinline__ float wave_sum(float v) {
    v += xlane<1>(v); v += xlane<2>(v); v += xlane<4>(v); v += xlane<8>(v); v += xlane<16>(v);
    return sum_x32(v);
}
__device__ __forceinline__ float frcp(float x) { return __builtin_amdgcn_rcpf(x); }
__device__ __forceinline__ float frsq(float x) { return __builtin_amdgcn_rsqf(x); }
__device__ __forceinline__ float sigmoidf_(float x) { return frcp(1.0f + __expf(-x)); }
__device__ __forceinline__ float siluf_(float x) { return x * frcp(1.0f + __expf(-x)); }
__device__ __forceinline__ float gelu_tanh(float x) { const float y = 0.7978845608028654f * (x + 0.044715f * x * x * x); const float t = 1.0f - 2.0f * frcp(1.0f + __expf(2.0f * y)); return 0.5f * x * (1.0f + t); }
__device__ __forceinline__ float softplusf_(float x) { const float e = __expf(x); return x > 20.f ? x : (e < 1e-3f ? e * (1.0f - 0.5f * e) : __logf(1.0f + e)); }
__device__ __forceinline__ int modrow_of_tile(int pm) { return pm < 32 ? 0 : 1 + ((pm - 32) >> 2); }
__device__ __forceinline__ int modrow_of_tok(int t) { return t < TCTX ? 0 : 1 + ((t - TCTX) >> 10); }

#define XB_TMO      128
#define XB_XCNT(j)  (256  + 64 * (j))
#define XB_XSUB(j)  (1280 + 64 * (j))
#define XB_XGEN(j)  (2304 + 64 * (j))
#define XB_TOP      3328
#define XB_TOPGEN   3392
#define XCD_BAR_WORDS 3456
#define XB_SPIN_CAP (1u << 22)
__device__ __forceinline__ unsigned xb_ld(unsigned* p)              { return __hip_atomic_load(p, __ATOMIC_RELAXED, __HIP_MEMORY_SCOPE_AGENT); }
__device__ __forceinline__ unsigned xb_add(unsigned* p, unsigned v) { return __hip_atomic_fetch_add(p, v, __ATOMIC_RELAXED, __HIP_MEMORY_SCOPE_AGENT); }
__device__ __forceinline__ unsigned xb_xcc_id() { return (unsigned)__builtin_amdgcn_s_getreg((3 << 11) | 20) & 0xFu; }
#define XB_SPIN(cond, bar) do { unsigned _sp = 0; while (cond) { __builtin_amdgcn_s_sleep(1); \
    if ((++_sp & 255u) == 0u) { if (xb_ld(&(bar)[XB_TMO])) break; if (_sp > XB_SPIN_CAP) { atomicAdd(&(bar)[XB_TMO], 1u); break; } } } } while (0)
struct XcdBarrier { unsigned* bar; unsigned x; volatile LAS unsigned* st; };
__device__ __forceinline__ XcdBarrier xcd_barrier_post(unsigned* bar, volatile LAS unsigned* st) {
    XcdBarrier b; b.bar = bar; b.x = xb_xcc_id(); b.st = st;
    if (threadIdx.x == 0) (void)xb_add(&bar[XB_XCNT(b.x)], 1u);
    return b;
}
__device__ __forceinline__ void xcd_barrier_complete(unsigned* bar, unsigned x, unsigned& nloc, unsigned& nx) {
    const unsigned G = gridDim.x * gridDim.y * gridDim.z;
    unsigned sum, cnt, mine, sp = 0u;
    for (;;) {
        sum = 0u; cnt = 0u; mine = 0u;
#pragma unroll
        for (unsigned j = 0; j < 16; ++j) { const unsigned c = xb_ld(&bar[XB_XCNT(j)]); sum += c; cnt += (c > 0u) ? 1u : 0u; mine = (j == x) ? c : mine; }
        if (sum == G) break;
        __builtin_amdgcn_s_sleep(1);
        if ((++sp & 255u) == 0u) { if (xb_ld(&bar[XB_TMO])) break; if (sp > XB_SPIN_CAP) { atomicAdd(&bar[XB_TMO], 1u); break; } }
    }
    nloc = mine > 0u ? mine : 1u; nx = cnt > 0u ? cnt : 1u;
}
__device__ __forceinline__ void xcd_barrier(const XcdBarrier& b) {
    asm volatile("s_waitcnt vmcnt(0)" ::: "memory");
    __syncthreads();
    if (threadIdx.x == 0) {
        unsigned* bar = b.bar;
        __builtin_amdgcn_s_waitcnt(0);
        unsigned nloc = b.st[0], nx = b.st[1];
        if (nloc == 0u) { xcd_barrier_complete(bar, b.x, nloc, nx); b.st[0] = nloc; b.st[1] = nx; }
        const unsigned k = b.st[2] + 1u; b.st[2] = k;
        const unsigned old = xb_add(&bar[XB_XSUB(b.x)], 1u);
        if (old + 1u == k * nloc) {
            __builtin_amdgcn_fence(__ATOMIC_RELEASE, "agent");
            asm volatile("s_waitcnt vmcnt(0)" ::: "memory");
            const unsigned og = xb_add(&bar[XB_TOP], 1u);
            if (og + 1u == k * nx) xb_add(&bar[XB_TOPGEN], 1u);
        }
        XB_SPIN(xb_ld(&bar[XB_TOPGEN]) < k, bar);
        __builtin_amdgcn_fence(__ATOMIC_ACQUIRE, "agent");
        asm volatile("s_waitcnt vmcnt(0)" ::: "memory");
    }
    __syncthreads();
}

struct Args { const float* in[34]; float* out; unsigned char* ws; int ph_lo, ph_hi, li, pad; };
typedef const __attribute__((address_space(4))) Args* CArgsP;
enum { I_XP = 0, I_XS, I_SSD, I_CCKV, I_CKR, I_C, I_CCTX, I_WMOD, I_BMOD, I_GNORM, I_WGU, I_WDN, I_WIE, I_WOE, I_WSP, I_BSP, I_GV, I_WCS, I_BCS, I_DTB, I_ALOG, I_DSK, I_GSO,
       I_WIO, I_WOO, I_GCQ, I_WUQ, I_GCKV, I_WUKV, I_WDW, I_BDW, I_GLN, I_BLN, I_GFIN };
using pg8::Unit;
constexpr int EP_PART = RING_BYTES, EP_S = RING_BYTES + 4096, EP_B = RING_BYTES + 4096 + 8192;
__device__ __forceinline__ void epi_prefetch_dma(GAS unsigned char* ws, int bias_off, const Unit& u, int wid, int lane, PG8_LAS unsigned char* ldsl, int par) {
    if (wid < 4) __builtin_amdgcn_global_load_lds((const GAS unsigned*)(ws + WS_SSQ + ((size_t)(u.pm * 256 + 64 * wid + lane) * 4) * 4), (PG8_LAS unsigned*)(ldsl + EP_S + par * 4096 + wid * 1024), 16, 0, 0);
    else if (wid == 4) __builtin_amdgcn_global_load_lds((const GAS unsigned*)(ws + WS_BIASF + ((size_t)bias_off / 16 + (size_t)modrow_of_tile(u.pm) * BIAS_LD + u.pn * 256 + 4 * lane) * 4), (PG8_LAS unsigned*)(ldsl + EP_B + par * 1024), 16, 0, 0);
}
__device__ __forceinline__ void epi_prefetch_sync16(GAS unsigned char* ws, int bias_off, const Unit& u, int tid, PG8_LAS unsigned char* ldsl, int par) {
    if (tid < 256) *(PG8_LAS pg8::f32x4*)(ldsl + EP_S + par * 4096 + tid * 16) = *(const GAS pg8::f32x4*)(ws + WS_SSQ + ((size_t)(u.pm * 256 + tid) * 4) * 4);
    else { const GAS float* bp = (const GAS float*)(ws + WS_BIAS) + (size_t)bias_off + (size_t)modrow_of_tile(u.pm) * BIAS_MS + u.pn * 256 + (tid - 256); float b = 0.f;
#pragma unroll
        for (int kb = 0; kb < 16; ++kb) b += bp[(size_t)kb * BIAS_LD];
        ((PG8_LAS float*)(ldsl + EP_B))[par * 256 + (tid - 256)] = b; }
}
__device__ __forceinline__ float epi_row_rstd(const PG8_LAS unsigned char* ldsl, int par, int rl) { const pg8::f32x4 s = *(const PG8_LAS pg8::f32x4*)(ldsl + EP_S + par * 4096 + rl * 16); return frsq(((s[0] + s[1]) + (s[2] + s[3])) * (1.f / D) + EPS); }
struct EpiSwiglu {
    static constexpr bool PERM = true; static constexpr int KIND = 1;
    GAS unsigned char* ws; int bias_off, nparts;
    __device__ __forceinline__ void prefetch_dma(const Unit& u, int wid, int lane, PG8_LAS unsigned char* ldsl, int par) const { if (nparts == 1) epi_prefetch_dma(ws, bias_off, u, wid, lane, ldsl, par); }
    __device__ __forceinline__ void prefetch_sync(const Unit& u, int tid, PG8_LAS unsigned char* ldsl, int par) const { if (nparts != 1) epi_prefetch_sync16(ws, bias_off, u, tid, ldsl, par); }
    __device__ __forceinline__ void operator()(const pg8::f32x4 (&acc)[2][2][4][2], const Unit& u, int wr, int wc, int fr, int fq, PG8_LAS unsigned char* ldsl, int par) const {
        bf16* H = (bf16*)(GAS bf16*)(ws + WS_H);
        const PG8_LAS float* bb = (const PG8_LAS float*)(ldsl + EP_B) + par * 256 + wc * 32 + 8 * fq;
        const int row0 = u.pm * 256 + wr * 64 + fr, col0 = u.pn * 128 + wc * 32 + 8 * fq;
        const pg8::f32x4 bg0 = *(const PG8_LAS pg8::f32x4*)bb, bg1 = *(const PG8_LAS pg8::f32x4*)(bb + 4), bu0 = *(const PG8_LAS pg8::f32x4*)(bb + 128), bu1 = *(const PG8_LAS pg8::f32x4*)(bb + 132);
#pragma unroll
        for (int ai = 0; ai < 2; ++ai)
#pragma unroll
            for (int m = 0; m < 4; ++m) {
                const int rl = ai * 128 + wr * 64 + m * 16 + fr;
                const float rs = epi_row_rstd(ldsl, par, rl);
                bf16* rowp = H + (size_t)(u.pm * 256 + rl) * DFF + col0;
                const pg8::f32x4 g0 = acc[ai][0][m][0] * rs + bg0, g1 = acc[ai][0][m][1] * rs + bg1, u0 = acc[ai][1][m][0] * rs + bu0, u1 = acc[ai][1][m][1] * rs + bu1;
                float gg[8], uu[8], e[8], o[8];
#pragma unroll
                for (int j = 0; j < 4; ++j) { gg[j] = g0[j]; gg[4 + j] = g1[j]; uu[j] = u0[j]; uu[4 + j] = u1[j]; }
#pragma unroll
                for (int j = 0; j < 8; ++j) e[j] = __builtin_amdgcn_exp2f(gg[j] * -1.4426950408889634f);
#pragma unroll
                for (int j = 0; j < 8; ++j) e[j] = __builtin_amdgcn_rcpf(1.0f + e[j]);
#pragma unroll
                for (int j = 0; j < 8; ++j) o[j] = (gg[j] * uu[j]) * e[j];
                pg8::u32x4 w; w.x = pg8::cvt_pk_bf16(o[0], o[1]); w.y = pg8::cvt_pk_bf16(o[2], o[3]); w.z = pg8::cvt_pk_bf16(o[4], o[5]); w.w = pg8::cvt_pk_bf16(o[6], o[7]);
                *(pg8::u32x4*)rowp = w;
            }
        (void)row0;
    }
};
struct EpiResid {
    static constexpr bool PERM = true; static constexpr int KIND = 4;
    GAS unsigned char* ws; const float* gn; int gate_off, scn_off; float coef;
    __device__ __forceinline__ void prefetch_dma(const Unit&, int, int, PG8_LAS unsigned char*, int) const {}
    __device__ __forceinline__ void prefetch_sync(const Unit&, int, PG8_LAS unsigned char*, int) const {}
    __device__ __forceinline__ void operator()(const pg8::f32x4 (&acc)[2][2][4][2], const Unit& u, int wr, int wc, int fr, int fq, PG8_LAS unsigned char* ldsl, int) const {
        bf16* X = (bf16*)(GAS bf16*)(ws + WS_X); const float* gate = (const float*)(const GAS float*)(ws + WS_MOD) + gate_off; const float* scn = (const float*)(const GAS float*)(ws + WS_MOD) + scn_off;
        bf16* XA = (bf16*)(GAS bf16*)(ws + WS_XA); float* SSQ = (float*)(GAS float*)(ws + WS_SSQ); PG8_LAS float* part = (PG8_LAS float*)(ldsl + EP_PART);
        const int row0 = u.pm * 256 + wr * 64 + fr, col0 = u.pn * 256 + wc * 32 + 8 * fq;
        const int mr = modrow_of_tile(u.pm);
        float ss[2][4];
#pragma unroll
        for (int ai = 0; ai < 2; ++ai)
#pragma unroll
            for (int m = 0; m < 4; ++m) ss[ai][m] = 0.f;
#pragma unroll
        for (int bj = 0; bj < 2; ++bj) {
            const int co = col0 + bj * 128;
            const float* gp = gate + (size_t)mr * NMODV + co; const float* sp = scn + (size_t)mr * NMODV + co;
            const pg8::f32x4 gv0 = *(const pg8::f32x4*)gp * coef, gv1 = *(const pg8::f32x4*)(gp + 4) * coef;
            const pg8::f32x4 gc0 = *(const pg8::f32x4*)(gn + co) * (*(const pg8::f32x4*)sp + 1.0f), gc1 = *(const pg8::f32x4*)(gn + co + 4) * (*(const pg8::f32x4*)(sp + 4) + 1.0f);
#pragma unroll
            for (int ai = 0; ai < 2; ++ai) {
                pg8::u32x4 xo[4];
#pragma unroll
                for (int m = 0; m < 4; ++m) xo[m] = *(const pg8::u32x4*)(X + (size_t)(row0 + ai * 128 + m * 16) * D + co);
#pragma unroll
                for (int m = 0; m < 4; ++m) {
                    const size_t off = (size_t)(row0 + ai * 128 + m * 16) * D + co;
                    const pg8::u32x4 xw = xo[m];
                    const pg8::f32x4 x0 = {bflo(xw.x), bfhi(xw.x), bflo(xw.y), bfhi(xw.y)}, x1 = {bflo(xw.z), bfhi(xw.z), bflo(xw.w), bfhi(xw.w)};
                    const pg8::f32x4 n0 = x0 + gv0 * acc[ai][bj][m][0], n1 = x1 + gv1 * acc[ai][bj][m][1];
                    ss[ai][m] += ((n0[0] * n0[0] + n0[1] * n0[1]) + (n0[2] * n0[2] + n0[3] * n0[3])) + ((n1[0] * n1[0] + n1[1] * n1[1]) + (n1[2] * n1[2] + n1[3] * n1[3]));
                    pg8::u32x4 w; w.x = pg8::cvt_pk_bf16(n0[0], n0[1]); w.y = pg8::cvt_pk_bf16(n0[2], n0[3]); w.z = pg8::cvt_pk_bf16(n1[0], n1[1]); w.w = pg8::cvt_pk_bf16(n1[2], n1[3]);
                    *(pg8::u32x4*)(X + off) = w;
                    const pg8::f32x4 a0 = n0 * gc0, a1 = n1 * gc1;
                    pg8::u32x4 v; v.x = pg8::cvt_pk_bf16(a0[0], a0[1]); v.y = pg8::cvt_pk_bf16(a0[2], a0[3]); v.z = pg8::cvt_pk_bf16(a1[0], a1[1]); v.w = pg8::cvt_pk_bf16(a1[2], a1[3]);
                    *(pg8::u32x4*)(XA + off) = v;
                }
            }
        }
#pragma unroll
        for (int ai = 0; ai < 2; ++ai)
#pragma unroll
            for (int m = 0; m < 4; ++m) { float s = ss[ai][m]; s += xlane<16>(s); s = sum_x32(s);
                if (fq == 0) part[wc * 256 + ai * 128 + wr * 64 + m * 16 + fr] = s; }
        asm volatile("s_waitcnt lgkmcnt(0)" ::: "memory"); __builtin_amdgcn_s_barrier(); asm volatile("" ::: "memory");
        const int t = (wr * 4 + wc) * 64 + fq * 16 + fr;
        if (t < 256) SSQ[(size_t)(u.pm * 256 + t) * 4 + u.pn] = (part[t] + part[256 + t]) + (part[512 + t] + part[768 + t]);
    }
};
struct EpiStore {
    static constexpr bool PERM = true; static constexpr int KIND = 2;
    GAS unsigned char* ws; unsigned o_off; int ldc; int bias_off;
    __device__ __forceinline__ void prefetch_dma(const Unit& u, int wid, int lane, PG8_LAS unsigned char* ldsl, int par) const { if (bias_off >= 0) epi_prefetch_dma(ws, bias_off, u, wid, lane, ldsl, par); }
    __device__ __forceinline__ void prefetch_sync(const Unit&, int, PG8_LAS unsigned char*, int) const {}
    __device__ __forceinline__ void operator()(const pg8::f32x4 (&acc)[2][2][4][2], const Unit& u, int wr, int wc, int fr, int fq, PG8_LAS unsigned char* ldsl, int par) const {
        bf16* O = (bf16*)(GAS bf16*)(ws + o_off);
        const PG8_LAS float* bb = (const PG8_LAS float*)(ldsl + EP_B) + par * 256 + wc * 32 + 8 * fq;
        const int col0 = u.pn * 256 + wc * 32 + 8 * fq; const bool nrm = bias_off >= 0;
        pg8::f32x4 b[2][2];
#pragma unroll
        for (int bj = 0; bj < 2; ++bj)
#pragma unroll
            for (int n = 0; n < 2; ++n) { const pg8::f32x4 bv = *(const PG8_LAS pg8::f32x4*)(bb + bj * 128 + 4 * n); b[bj][n] = nrm ? bv : (pg8::f32x4){0.f, 0.f, 0.f, 0.f}; }
#pragma unroll
        for (int ai = 0; ai < 2; ++ai)
#pragma unroll
            for (int m = 0; m < 4; ++m) {
                const int rl = ai * 128 + wr * 64 + m * 16 + fr;
                const float rs0 = epi_row_rstd(ldsl, par, rl), rs = nrm ? rs0 : 1.0f;
                bf16* rowp = O + (size_t)(u.pm * 256 + rl) * ldc + col0;
#pragma unroll
                for (int bj = 0; bj < 2; ++bj) {
                    const pg8::f32x4 v0 = acc[ai][bj][m][0] * rs + b[bj][0], v1 = acc[ai][bj][m][1] * rs + b[bj][1];
                    pg8::u32x4 w; w.x = pg8::cvt_pk_bf16(v0[0], v0[1]); w.y = pg8::cvt_pk_bf16(v0[2], v0[3]); w.z = pg8::cvt_pk_bf16(v1[0], v1[1]); w.w = pg8::cvt_pk_bf16(v1[2], v1[3]);
                    *(pg8::u32x4*)(rowp + bj * 128) = w;
                }
            }
    }
};

struct Frame {
    unsigned char* lds;
    mutable int tid, lane; int wave, bid, G;
    __device__ __forceinline__ void relane() const { int ln; asm volatile("v_mbcnt_lo_u32_b32 %0, -1, 0\n\tv_mbcnt_hi_u32_b32 %0, -1, %0" : "=v"(ln)); lane = ln; tid = wave * 64 + ln; }
    CArgsP a;
    GAS unsigned char* ws;
};
#define WSP(type, off) ((type*)(GAS type*)(F.ws + (off)))
#define AIN(i) ((const float*)(const GAS float*)F.a->in[i])
#define AOUT ((float*)(GAS float*)F.a->out)

__device__ __forceinline__ void p0_transpose_item(const float* W, int N, bf16* WT, int ldt, int k0, int n0, int dst_row0, float* scr, int lane, const float* shift, float* bias_out) {
    const int n = n0 + (lane & 31); const bool ok = n < N;
#pragma unroll 8
    for (int i = 0; i < 32; ++i) { const int kk = 2 * i + (lane >> 5); scr[kk * 33 + (lane & 31)] = ok ? W[(size_t)(k0 + kk) * N + n] : 0.f; }
    if (bias_out) {
#pragma unroll
        for (int m = 0; m < 3; ++m) scr[64 * 33 + m * 64 + lane] = shift[(size_t)m * NMODV + lane];
    }
    asm volatile("s_waitcnt lgkmcnt(0)" ::: "memory");
    const int c = lane & 7;
#pragma unroll
    for (int j = 0; j < 4; ++j) { const int nn = (lane >> 3) + 8 * j; const float* s = scr + (8 * c) * 33 + nn;
        v4u o; o.x = pk2(s[0 * 33], s[1 * 33]); o.y = pk2(s[2 * 33], s[3 * 33]); o.z = pk2(s[4 * 33], s[5 * 33]); o.w = pk2(s[6 * 33], s[7 * 33]);
        *(v4u*)(WT + (size_t)(dst_row0 + nn) * ldt + k0 + 8 * c) = o; }
    if (bias_out) {
        const int kh = lane >> 5, nl = lane & 31; float a0 = 0.f, a1 = 0.f, a2 = 0.f;
#pragma unroll 8
        for (int i = 0; i < 32; ++i) { const int kk = kh * 32 + i; const float wv = scr[kk * 33 + nl];
            a0 += wv * scr[64 * 33 + kk]; a1 += wv * scr[64 * 33 + 64 + kk]; a2 += wv * scr[64 * 33 + 128 + kk]; }
        a0 = sum_x32(a0); a1 = sum_x32(a1); a2 = sum_x32(a2);
        if (lane < 32) { float* bo = bias_out + (size_t)(k0 >> 6) * BIAS_LD + dst_row0 + nl; bo[0] = a0; bo[BIAS_MS] = a1; bo[2 * BIAS_MS] = a2; }
    }
    asm volatile("s_waitcnt lgkmcnt(0)" ::: "memory");
}
constexpr int CI_DN = 44 * 32, CI_OE = 16 * 32, CI_UQ = 6 * 24, CI_KV = 4 * 32, CI_GU = 16 * 176, CI_IE = 16 * 88, CI_IO = 16 * 56;
__host__ __device__ constexpr int conv_na(int l) { return 2 * CI_DN + CI_OE + ((l & 1) ? CI_UQ + CI_KV : 0); }
__host__ __device__ constexpr int conv_nb(int l) { return 2 * CI_GU + ((l & 1) ? CI_IO : CI_IE); }
__device__ __forceinline__ void conv_item_a(const Frame& F, int l, int it, float* scr) {
    int r = it; const int hi = l >> 1;
    if (r < 2 * CI_DN) { const int w = l * 2 + r / CI_DN, q = r % CI_DN, kb = q / 32, nb = q % 32;
        p0_transpose_item(AIN(I_WDN) + (size_t)w * DFF * 1024, 1024, WSP(bf16, WS_WD + w * SZ_WD), DFF, kb * 64, nb * 32, nb * 32, scr, F.lane, nullptr, nullptr); return; } r -= 2 * CI_DN;
    if (r < CI_OE) { const int kb = r / 32, nb = r % 32;
        if (l & 1) p0_transpose_item(AIN(I_WOO) + (size_t)hi * 1024 * 1024, 1024, WSP(bf16, WS_WOO + hi * SZ_WO), 1024, kb * 64, nb * 32, nb * 32, scr, F.lane, nullptr, nullptr);
        else       p0_transpose_item(AIN(I_WOE) + (size_t)hi * 1024 * 1024, 1024, WSP(bf16, WS_WOE + hi * SZ_WO), 1024, kb * 64, nb * 32, nb * 32, scr, F.lane, nullptr, nullptr);
        return; } r -= CI_OE;
    if (r < CI_UQ) { const int kb = r / 24, nb = r % 24;
        p0_transpose_item(AIN(I_WUQ) + (size_t)hi * 384 * 768, 768, WSP(bf16, WS_WUQ + hi * SZ_WUQ), 384, kb * 64, nb * 32, nb * 32, scr, F.lane, nullptr, nullptr); return; } r -= CI_UQ;
    { const int kb = r / 32, nb = r % 32, n0 = nb * 32, h = n0 >> 7, rr = n0 & 127;
        const int dst = (rr < 64 ? 0 : 512) + h * 64 + (rr & 63);
        p0_transpose_item(AIN(I_WUKV) + (size_t)hi * 256 * 1024, 1024, WSP(bf16, WS_WKV + hi * SZ_WKV), 256, kb * 64, n0, dst, scr, F.lane, nullptr, nullptr); }
}
__device__ __forceinline__ void conv_item_b(const Frame& F, int l, int it, float* scr) {
    int r = it; const int hi = l >> 1; const float* MOD = WSP(float, WS_MOD) + (size_t)l * 3 * NMODV; float* BIAS = WSP(float, WS_BIAS) + (size_t)(l * 3) * 3 * BIAS_MS;
    if (r < 2 * CI_GU) { const int f = r / CI_GU, w = l * 2 + f, q = r % CI_GU, kb = q / 176, nb = q % 176, n0 = nb * 32;
        const int dst = (n0 < DFF) ? ((n0 >> 7) * 256 + (n0 & 127)) : (((n0 - DFF) >> 7) * 256 + 128 + ((n0 - DFF) & 127));
        p0_transpose_item(AIN(I_WGU) + (size_t)w * 1024 * 5632, 5632, WSP(bf16, WS_WGU + w * SZ_WGU), 1024, kb * 64, n0, dst, scr, F.lane,
                          MOD + (f == 0 ? 0 : 6) * 1024 + kb * 64, BIAS + (size_t)(f == 0 ? 0 : 2) * 3 * BIAS_MS); return; } r -= 2 * CI_GU;
    if (l & 1) { const int kb = r / 56, nb = r % 56;
        p0_transpose_item(AIN(I_WIO) + (size_t)hi * 1024 * 1696, 1696, WSP(bf16, WS_WIO + hi * SZ_WIO), 1024, kb * 64, nb * 32, nb * 32, scr, F.lane, MOD + 3 * 1024 + kb * 64, BIAS + (size_t)3 * BIAS_MS); }
    else { const int kb = r / 88, nb = r % 88;
        p0_transpose_item(AIN(I_WIE) + (size_t)hi * 1024 * 2576, 2576, WSP(bf16, WS_WIE + hi * SZ_WIE), 1024, kb * 64, nb * 32, nb * 32, scr, F.lane, MOD + 3 * 1024 + kb * 64, BIAS + (size_t)3 * BIAS_MS); }
}
template <int N4> __device__ __forceinline__ void mod_tile(const Frame& F, int l, int tile) {
    constexpr int KG = 504 / N4, NC = 4 * N4;
    float* sv = (float*)F.lds;
    float* red = (float*)(F.lds + 12288);
    __syncthreads();
    for (int i = F.tid; i < 3072; i += NTHR) { const int r = i >> 10, k = i & 1023; const float c = (r == 0) ? AIN(I_CCTX)[k] : AIN(I_C)[(r - 1) * 1024 + k]; sv[i] = siluf_(c); }
    __syncthreads();
    const int n0 = tile * NC, n4 = F.tid % N4, kg = F.tid / N4;
    if (F.tid < 504) {
        f32x4 a0 = {0.f, 0.f, 0.f, 0.f}, a1 = a0, a2 = a0;
        const float* wp = AIN(I_WMOD) + (size_t)l * 1024 * NMODV + n0 + 4 * n4;
#pragma unroll 4
        for (int k = kg; k < 1024; k += KG) { const f32x4 w = *(const f32x4*)(wp + (size_t)k * NMODV); a0 += w * sv[k]; a1 += w * sv[1024 + k]; a2 += w * sv[2048 + k]; }
        *(f32x4*)(red + (kg * 3 + 0) * NC + 4 * n4) = a0; *(f32x4*)(red + (kg * 3 + 1) * NC + 4 * n4) = a1; *(f32x4*)(red + (kg * 3 + 2) * NC + 4 * n4) = a2;
    }
    __syncthreads();
    for (int o = F.tid; o < 3 * NC; o += NTHR) { const int r = o / NC, n = o % NC; float s = AIN(I_BMOD)[l * NMODV + n0 + n];
        for (int g = 0; g < KG; ++g) s += red[(g * 3 + r) * NC + n];
        WSP(float, WS_MOD)[(size_t)(l * 3 + r) * NMODV + n0 + n] = s; }
    __syncthreads();
}
__device__ __forceinline__ void bias_reduce(const Frame& F, int l, int kmask, int bgi, int nbg) {
    const float* BP = WSP(float, WS_BIAS); float* BF = WSP(float, WS_BIASF);
    const int gt = bgi * NTHR + F.tid, NT = nbg * NTHR;
    for (int i = gt; i < 3 * 3 * (int)BIAS_LD; i += NT) { const int kind = i / (3 * (int)BIAS_LD), rem = i % (3 * (int)BIAS_LD), m = rem / (int)BIAS_LD, n = rem % (int)BIAS_LD;
        if (!((kmask >> kind) & 1)) continue;
        const float* p = BP + ((size_t)(l * 3 + kind) * 3 + m) * BIAS_MS + n; float b = 0.f;
#pragma unroll
        for (int kb = 0; kb < 16; ++kb) b += p[(size_t)kb * BIAS_LD];
        BF[((size_t)(l * 3 + kind) * 3 + m) * BIAS_LD + n] = b; }
}
__device__ __forceinline__ void background_work(const Frame& F, int l, int win, int bgi, int nbg) {
    F.relane();
    if (nbg <= 0) return;
    if (win == 0) bias_reduce(F, l, 6, bgi, nbg);
    if (l >= 3) return;
    const int ln = l + 1;
    if (win == 2) bias_reduce(F, ln, 1, bgi, nbg);
    float* scr = (float*)(F.lds + F.wave * 16384);
    const int gw = bgi * NWAVES + F.wave, NGW = nbg * NWAVES;
    if (win == 0) {
        for (int t = bgi; t < 64; t += nbg) mod_tile<36>(F, ln, t);
        const int na = conv_na(ln);
        for (int it = gw; it < na; it += NGW) conv_item_a(F, ln, it, scr);
    } else {
        const int nb = conv_nb(ln), cut = CI_GU;
        const int lo = win == 1 ? 0 : cut, hi_ = win == 1 ? cut : nb;
        for (int it = lo + gw; it < hi_; it += NGW) conv_item_b(F, ln, it, scr);
    }
}
__device__ __forceinline__ void p0_phase(const Frame& F) {
    F.relane();
    for (int t = F.bid; t < 256; t += F.G) mod_tile<9>(F, 0, t);
    {
        float* scr = (float*)(F.lds + F.wave * 16384);
        const int gw = F.bid * NWAVES + F.wave, NGW = F.G * NWAVES;
        for (int it = gw; it < conv_na(0); it += NGW) conv_item_a(F, 0, it, scr);
    }
    {
        const size_t gt = (size_t)F.bid * NTHR + F.tid, NT = (size_t)F.G * NTHR;
        for (size_t i = gt; i < 1024 * 16; i += NT) { const int pos = (int)(i >> 4), ax = (int)(i >> 3) & 1, f = (int)i & 7;
            const float freq = exp2f(-(float)f * (13.287712379549449f / 8.0f));
            const float ang = (float)(ax == 0 ? (pos >> 6) : (pos & 63)) * freq;
            float sn, cs; sincosf(ang, &sn, &cs);
            WSP(float, WS_ROPE)[2 * i] = cs; WSP(float, WS_ROPE)[2 * i + 1] = sn; }
    }
}
__device__ __forceinline__ void p1_copy_phase(const Frame& F) {
    F.relane();
    float* scr = (float*)(F.lds + F.wave * 16384);
    const int gw = F.bid * NWAVES + F.wave, NGW = F.G * NWAVES;
    for (int it = gw; it < conv_nb(0); it += NGW) conv_item_b(F, 0, it, scr);
}

__device__ __forceinline__ void norm0_phase(const Frame& F) {
    F.relane();
    const int gw = F.bid * NWAVES + F.wave, NGW = F.G * NWAVES;
    bf16* X = WSP(bf16, WS_X); bf16* XA = WSP(bf16, WS_XA); float* SSQ = WSP(float, WS_SSQ);
    const float* g = AIN(I_GNORM); const float* scale = WSP(float, WS_MOD) + 1024;
    for (int row = gw; row < T; row += NGW) {
        const int r = modrow_of_tok(row);
        const f32x4* xr = (const f32x4*)(row < TCTX ? AIN(I_XP) + (size_t)row * D : AIN(I_XS) + (size_t)(row - TCTX) * D) + F.lane;
        f32x4 v[4]; float s = 0.f;
#pragma unroll
        for (int j = 0; j < 4; ++j) { v[j] = xr[64 * j]; s += (v[j].x * v[j].x + v[j].y * v[j].y) + (v[j].z * v[j].z + v[j].w * v[j].w); }
        s = wave_sum(s);
        if (F.lane == 0) *(f32x4*)(SSQ + (size_t)row * 4) = (f32x4){s, 0.f, 0.f, 0.f};
        unsigned long long* o8 = (unsigned long long*)(XA + (size_t)row * D) + F.lane;
        unsigned long long* xo = (unsigned long long*)(X + (size_t)row * D) + F.lane;
#pragma unroll
        for (int j = 0; j < 4; ++j) {
            const f32x4 gg = *((const f32x4*)g + F.lane + 64 * j), sc = *((const f32x4*)(scale + (size_t)r * NMODV) + F.lane + 64 * j);
            const f32x4 o = v[j] * gg * (sc + 1.0f);
            xo[64 * j] = (unsigned long long)pk2(v[j].x, v[j].y) | ((unsigned long long)pk2(v[j].z, v[j].w) << 32);
            o8[64 * j] = (unsigned long long)pk2(o.x, o.y) | ((unsigned long long)pk2(o.z, o.w) << 32);
        }
    }
}
__device__ __forceinline__ void final_phase(const Frame& F) {
    F.relane();
    const int gw = F.bid * NWAVES + F.wave, NGW = F.G * NWAVES;
    const bf16* X = WSP(bf16, WS_X); const float* g = AIN(I_GFIN); float* out = AOUT + OUT_Y;
    for (int row = gw; row < T; row += NGW) {
        const v2u* xr = (const v2u*)(X + (size_t)row * D) + F.lane;
        f32x4 v[4]; float s = 0.f;
#pragma unroll
        for (int j = 0; j < 4; ++j) { const v2u w = xr[64 * j]; v[j] = (f32x4){bflo(w.x), bfhi(w.x), bflo(w.y), bfhi(w.y)}; s += (v[j].x * v[j].x + v[j].y * v[j].y) + (v[j].z * v[j].z + v[j].w * v[j].w); }
        const float rstd = frsq(wave_sum(s) * (1.f / D) + EPS);
        f32x4* o = (f32x4*)(out + (size_t)row * D) + F.lane;
#pragma unroll
        for (int j = 0; j < 4; ++j) o[64 * j] = v[j] * rstd * *((const f32x4*)g + F.lane + 64 * j);
    }
}
constexpr int LDT = 136;
__device__ __forceinline__ bf16x8 ld_frag16(const unsigned char* p) { return *(const bf16x8*)p; }
__device__ __forceinline__ bf16x8 ld_frag8x2(const unsigned char* p0, const unsigned char* p1) {
    const v2u a = *(const v2u*)p0, b = *(const v2u*)p1; v4u v; v.x = a.x; v.y = a.y; v.z = b.x; v.w = b.y; return __builtin_bit_cast(bf16x8, v); }
#define MFMA16(a, b, c) __builtin_amdgcn_mfma_f32_16x16x32_bf16((a), (b), (c), 0, 0, 0)

__device__ __forceinline__ void chunk_info(int c, int& cfirst, int& clast, bool& is_ctx, int& sb) {
    if (c < 64) { cfirst = c & ~1; clast = cfirst + 1; is_ctx = true; sb = c >> 1; }
    else { cfirst = 64 + ((c - 64) & ~7); clast = cfirst + 7; is_ctx = false; sb = (c - 64) >> 3; }
}
struct ConvW { f32x4 w0a, w0b, w1a, w1b, w2a, w2b, ba, bb; };
__device__ __forceinline__ ConvW conv_w(const float* wc, const float* bc, int ch) {
    ConvW W; W.w0a = *(const f32x4*)(wc + ch); W.w0b = *(const f32x4*)(wc + ch + 4); W.w1a = *(const f32x4*)(wc + 1024 + ch); W.w1b = *(const f32x4*)(wc + 1024 + ch + 4);
    W.w2a = *(const f32x4*)(wc + 2048 + ch); W.w2b = *(const f32x4*)(wc + 2048 + ch + 4); W.ba = *(const f32x4*)(bc + ch); W.bb = *(const f32x4*)(bc + ch + 4); return W;
}
__device__ __forceinline__ void conv8(const bf16* PROJ, int t, bool has_prev, bool has_next, int ch, const ConvW& W, float* out) {
    const bf16* p = PROJ + (size_t)t * EVEN_NP + 1536 + ch;
    const v4u z = {0u, 0u, 0u, 0u};
    const v4u c0 = *(const v4u*)p, cm = has_prev ? *(const v4u*)(p - EVEN_NP) : z, cp = has_next ? *(const v4u*)(p + EVEN_NP) : z;
    float x0[8], xm[8], xp[8]; unpack8(c0, x0); unpack8(cm, xm); unpack8(cp, xp);
#pragma unroll
    for (int i = 0; i < 4; ++i) { out[i] = siluf_(W.ba[i] + W.w0a[i] * xm[i] + W.w1a[i] * x0[i] + W.w2a[i] * xp[i]); out[4 + i] = siluf_(W.bb[i] + W.w0b[i] * xm[4 + i] + W.w1b[i] * x0[4 + i] + W.w2b[i] * xp[4 + i]); }
}
__device__ __forceinline__ void ssd_tables(const Frame& F, int ei, int t0, float* dtl, float* cml) {
    const bf16* PROJ = WSP(bf16, WS_PROJ);
    if (F.tid < 256) { const int j = F.tid >> 1, dir = F.tid & 1;
        const v4u raw = *(const v4u*)(PROJ + (size_t)(t0 + j) * EVEN_NP + 2560 + 8 * dir); float x[8]; unpack8(raw, x);
#pragma unroll
        for (int h = 0; h < 8; ++h) dtl[(dir * 8 + h) * 128 + j] = softplusf_(x[h] + AIN(I_DTB)[ei * 16 + dir * 8 + h]); }
    __syncthreads();
#pragma unroll
    for (int k = 0; k < 2; ++k) {
        const int row = 2 * F.wave + k, rev = row >> 3;
        const float a = -__expf(AIN(I_ALOG)[ei * 16 + row]);
        const int i0 = rev ? 127 - 2 * F.lane : 2 * F.lane, i1 = rev ? 126 - 2 * F.lane : 2 * F.lane + 1;
        const float v0 = dtl[row * 128 + i0] * a, v1 = dtl[row * 128 + i1] * a;
        float x = v0 + v1;
#pragma unroll
        for (int d = 1; d < 64; d <<= 1) { const float t = __builtin_bit_cast(float, __builtin_amdgcn_ds_bpermute((F.lane - d) * 4, __builtin_bit_cast(int, x))); x += (F.lane >= d) ? t : 0.f; }
        const float ex = x - (v0 + v1);
        cml[row * 128 + i0] = ex + v0; cml[row * 128 + i1] = ex + (v0 + v1);
    }
    __syncthreads();
}
constexpr int TILE128 = 34816, TILE64 = 17408;
constexpr int S1_BT = 0, S1_B = TILE128, S1_C = 2 * TILE128, S1_XT = TILE128  , S1_DT = 3 * TILE128, S1_CUM = S1_DT + 8192;
constexpr int S2_XT = 0  , S2_H = 2 * TILE64  , S2_DT = 6 * TILE64, S2_CUM = S2_DT + 8192, S2_SSQ = S2_CUM + 8192;

__device__ __forceinline__ void ssd_state_item(const Frame& F, int ei, int c, int g) {
    F.relane();
    const bf16* PROJ = WSP(bf16, WS_PROJ);
    const float* wc = AIN(I_WCS) + (size_t)ei * 3 * 1024; const float* bc = AIN(I_BCS) + (size_t)ei * 1024;
    int cfirst, clast, sb; bool is_ctx; chunk_info(c, cfirst, clast, is_ctx, sb);
    const int t0 = c * 128, len = is_ctx ? 256 : 1024, pos0 = (c - cfirst) * 128;
    bf16* BT = (bf16*)(F.lds + S1_BT); bf16* Bl = (bf16*)(F.lds + S1_B); bf16* Cl = (bf16*)(F.lds + S1_C); bf16* XT4 = (bf16*)(F.lds + S1_XT);
    float* dtl = (float*)(F.lds + S1_DT); float* cml = (float*)(F.lds + S1_CUM);
    bf16* ST = WSP(bf16, WS_ST); float* DEC = WSP(float, WS_DEC);
    bf16* CC = WSP(bf16, WS_CC); bf16* CBM = WSP(bf16, WS_CBM); bf16* XCT = WSP(bf16, WS_XCT);
    const int r = F.lane & 15, q = F.lane >> 4, w = F.wave;
    __syncthreads();
    ssd_tables(F, ei, t0, dtl, cml);
    { const ConvW W = conv_w(wc, bc, 512 + g * 128 + (F.tid & 15) * 8);
#pragma unroll 4
    for (int e = F.tid; e < 128 * 16; e += NTHR) { const int j = e >> 4, n8 = (e & 15) * 8; float o[8];
        conv8(PROJ, t0 + j, pos0 + j > 0, pos0 + j < len - 1, 512 + g * 128 + n8, W, o);
        const v4u pk = pack8(o);
        *(v4u*)((unsigned char*)Bl + (j * LDT + n8) * 2) = pk;
#pragma unroll
        for (int i = 0; i < 8; ++i) BT[(n8 + i) * LDT + j] = (bf16)f2bf1(o[i]); } }
    { const ConvW W = conv_w(wc, bc, 768 + g * 128 + (F.tid & 15) * 8);
#pragma unroll 4
    for (int e = F.tid; e < 128 * 16; e += NTHR) { const int j = e >> 4, n8 = (e & 15) * 8; float o[8];
        conv8(PROJ, t0 + j, pos0 + j > 0, pos0 + j < len - 1, 768 + g * 128 + n8, W, o);
        const v4u pk = pack8(o);
        *(v4u*)((unsigned char*)Cl + (j * LDT + n8) * 2) = pk;
        *(v4u*)(CC + (size_t)(t0 + j) * 256 + g * 128 + n8) = pk; } }
    __syncthreads();
    {
        bf16x8 cf[4];
#pragma unroll
        for (int ks = 0; ks < 4; ++ks) cf[ks] = ld_frag16((const unsigned char*)Cl + ((16 * w + r) * LDT + 32 * ks + 8 * q) * 2);
        bf16* dst = CBM + ((size_t)(c * 2 + g) * 128 + 16 * w + r) * 128 + 4 * q;
#pragma unroll
        for (int jt = 0; jt < 8; ++jt) { f32x4 a = {0.f, 0.f, 0.f, 0.f};
#pragma unroll
            for (int ks = 0; ks < 4; ++ks) a = MFMA16(ld_frag16((const unsigned char*)Bl + ((16 * jt + r) * LDT + 32 * ks + 8 * q) * 2), cf[ks], a);
            v2u o; o.x = pk2(a[0], a[1]); o.y = pk2(a[2], a[3]); *(v2u*)(dst + 16 * jt) = o; }
    }
    __syncthreads();
    { const ConvW W = conv_w(wc, bc, g * 256 + (F.tid & 31) * 8);
#pragma unroll 4
    for (int e = F.tid; e < 128 * 32; e += NTHR) { const int j = e >> 5, p8 = (e & 31) * 8; float o[8];
        conv8(PROJ, t0 + j, pos0 + j > 0, pos0 + j < len - 1, g * 256 + p8, W, o);
#pragma unroll
        for (int i = 0; i < 8; ++i) XT4[(p8 + i) * LDT + j] = (bf16)f2bf1(o[i]); } }
    __syncthreads();
#pragma unroll 4
    for (int e = F.tid; e < 256 * 16; e += NTHR) { const int row = e >> 4, ch = (e & 15) * 8;
        *(v4u*)(XCT + ((size_t)(c * 8 + 4 * g) * 64 + row) * 128 + ch) = *(const v4u*)((const unsigned char*)XT4 + (row * LDT + ch) * 2); }
#pragma unroll 2
    for (int hd = 0; hd < 8; ++hd) {
        const int hh = hd >> 1, dir = hd & 1, h = 4 * g + hh;
        const float* dth = dtl + (dir * 8 + h) * 128; const float* cmh = cml + (dir * 8 + h) * 128;
        const float cend = dir == 0 ? cmh[127] : cmh[0];
        const bf16* XT = XT4 + hh * 64 * LDT;
        f32x4 acc[4];
#pragma unroll
        for (int pt = 0; pt < 4; ++pt) acc[pt] = (f32x4){0.f, 0.f, 0.f, 0.f};
#pragma unroll
        for (int ks = 0; ks < 4; ++ks) {
            const int j0 = 32 * ks + 8 * q;
            const v4u braw = *(const v4u*)((const unsigned char*)BT + ((16 * w + r) * LDT + j0) * 2); float bv[8]; unpack8(braw, bv);
            const f32x4 d0 = *(const f32x4*)(dth + j0), d1 = *(const f32x4*)(dth + j0 + 4), c0 = *(const f32x4*)(cmh + j0), c1 = *(const f32x4*)(cmh + j0 + 4);
#pragma unroll
            for (int i = 0; i < 4; ++i) { bv[i] *= d0[i] * __expf(cend - c0[i]); bv[4 + i] *= d1[i] * __expf(cend - c1[i]); }
            const bf16x8 af = __builtin_bit_cast(bf16x8, pack8(bv));
#pragma unroll
            for (int pt = 0; pt < 4; ++pt) { const bf16x8 bf = ld_frag16((const unsigned char*)XT + ((16 * pt + r) * LDT + j0) * 2); acc[pt] = MFMA16(af, bf, acc[pt]); }
        }
        bf16* dst = ST + ((size_t)(c * 8 + h) * 2 + dir) * 8192;
#pragma unroll
        for (int pt = 0; pt < 4; ++pt) { v2u o; o.x = pk2(acc[pt][0], acc[pt][1]); o.y = pk2(acc[pt][2], acc[pt][3]); *(v2u*)(dst + (16 * pt + r) * 128 + 16 * w + 4 * q) = o; }
        if (F.tid == 0) DEC[(c * 8 + h) * 2 + dir] = __expf(cend);
    }
}

__device__ __forceinline__ void gmlp_item(const Frame& F, int ei, int c, int g) {
    F.relane();
    const bf16* PROJ = WSP(bf16, WS_PROJ); bf16* YMIX = WSP(bf16, WS_YMIX);
    const int t0 = c * 128;
    float* rs = (float*)F.lds; bf16* Vt = (bf16*)(F.lds + 1024); bf16* Wl = (bf16*)(F.lds + 1024 + 34816);
    const float* gv = AIN(I_GV) + ei * 512;
    __syncthreads();
#pragma unroll 1
    for (int kb = 0; kb < 16; kb += 8) {
        v4u raw[8];
#pragma unroll
        for (int k = 0; k < 8; ++k) raw[k] = *(const v4u*)(PROJ + (size_t)(t0 + F.wave * 16 + kb + k) * EVEN_NP + 512 + 8 * F.lane);
#pragma unroll
        for (int k = 0; k < 8; ++k) { float x[8]; unpack8(raw[k], x); float s = 0.f;
#pragma unroll
            for (int i = 0; i < 8; ++i) { const float y = gelu_tanh(x[i]); s += y * y; }
            s = wave_sum(s); if (F.lane == 0) rs[F.wave * 16 + kb + k] = frsq(s * (1.f / 512.f) + EPS); }
    }
    { const float* ws_ = AIN(I_WSP) + ((size_t)ei * 4 + g) * 16384;
#pragma unroll
      for (int e = F.tid; e < 4096; e += NTHR) { const int i = e >> 5, j4 = (e & 31) * 4; const f32x4 v = *(const f32x4*)(ws_ + i * 128 + j4);
          v2u o; o.x = pk2(v.x, v.y); o.y = pk2(v.z, v.w); *(v2u*)((unsigned char*)Wl + (i * LDT + j4) * 2) = o; } }
    __syncthreads();
    { const int d8 = (F.tid & 15) * 8; v4u raw[4];
#pragma unroll
      for (int k = 0; k < 4; ++k) raw[k] = *(const v4u*)(PROJ + (size_t)(t0 + (F.tid >> 4) + 32 * k) * EVEN_NP + 512 + g * 128 + d8);
#pragma unroll
      for (int k = 0; k < 4; ++k) { const int j = (F.tid >> 4) + 32 * k; float x[8]; unpack8(raw[k], x); const float rj = rs[j];
#pragma unroll
          for (int i = 0; i < 8; ++i) Vt[(d8 + i) * LDT + j] = (bf16)f2bf1(gelu_tanh(x[i]) * rj * gv[g * 128 + d8 + i]); } }
    __syncthreads();
    const int r = F.lane & 15, q = F.lane >> 4, w = F.wave;
    bf16x8 af[4];
#pragma unroll
    for (int ks = 0; ks < 4; ++ks) af[ks] = ld_frag16((const unsigned char*)Vt + ((16 * w + r) * LDT + 32 * ks + 8 * q) * 2);
    const float* bs = AIN(I_BSP) + ((size_t)ei * 4 + g) * 128;
    v2u uraw[8];
#pragma unroll
    for (int it = 0; it < 8; ++it) uraw[it] = *(const v2u*)(PROJ + (size_t)(t0 + 16 * it + r) * EVEN_NP + g * 128 + 16 * w + 4 * q);
#pragma unroll
    for (int it = 0; it < 8; ++it) {
        f32x4 acc = {0.f, 0.f, 0.f, 0.f};
#pragma unroll
        for (int ks = 0; ks < 4; ++ks) acc = MFMA16(af[ks], ld_frag16((const unsigned char*)Wl + ((16 * it + r) * LDT + 32 * ks + 8 * q) * 2), acc);
        const int i = 16 * it + r, col = g * 128 + 16 * w + 4 * q; const float b = bs[i];
        const float u0 = gelu_tanh(bflo(uraw[it].x)), u1 = gelu_tanh(bfhi(uraw[it].x)), u2 = gelu_tanh(bflo(uraw[it].y)), u3 = gelu_tanh(bfhi(uraw[it].y));
        v2u o; o.x = pk2(u0 * (acc[0] + b), u1 * (acc[1] + b)); o.y = pk2(u2 * (acc[2] + b), u3 * (acc[3] + b));
        *(v2u*)(YMIX + (size_t)(t0 + i) * D + col) = o;
    }
}

__device__ __forceinline__ f32x4 ld_bf4(const bf16* p) { const v2u w = *(const v2u*)p; return (f32x4){bflo(w.x), bfhi(w.x), bflo(w.y), bfhi(w.y)}; }
__device__ __forceinline__ void ssd_scan_phase(const Frame& F, int ei) {
    F.relane();
    const bf16* ST = WSP(bf16, WS_ST); const float* DEC = WSP(float, WS_DEC); bf16* HIN = WSP(bf16, WS_HIN);
    const size_t gt = (size_t)F.bid * NTHR + F.tid, NT = (size_t)F.G * NTHR;
    constexpr size_t N_SMP = (size_t)2 * 8 * 2 * 2048, N_CTX = (size_t)32 * 8 * 2 * 2048;
    for (size_t it = gt; it < N_SMP + N_CTX; it += NT) {
        if (it < N_SMP) {
            const int e = (int)(it & 2047) * 4, dir = (int)(it >> 11) & 1, h = (int)(it >> 12) & 7, b = (int)(it >> 15);
            const int c0 = 64 + 8 * b;
            f32x4 st[8]; float dc[8];
#pragma unroll
            for (int k = 0; k < 8; ++k) { const int cc = dir == 0 ? c0 + k : c0 + 7 - k; st[k] = ld_bf4(ST + ((size_t)(cc * 8 + h) * 2 + dir) * 8192 + e); dc[k] = DEC[(cc * 8 + h) * 2 + dir]; }
            f32x4 v = *(const f32x4*)(AIN(I_SSD) + ((size_t)((b * 2 + ei) * 2 + dir) * 8 + h) * 8192 + e);
#pragma unroll
            for (int k = 0; k < 8; ++k) { const int cc = dir == 0 ? c0 + k : c0 + 7 - k;
                v2u o; o.x = pk2(v.x, v.y); o.y = pk2(v.z, v.w); *(v2u*)(HIN + ((size_t)(cc * 8 + h) * 2 + dir) * 8192 + e) = o;
                v = v * dc[k] + st[k]; }
        } else {
            const size_t i2 = it - N_SMP;
            const int e = (int)(i2 & 2047) * 4, dir = (int)(i2 >> 11) & 1, h = (int)(i2 >> 12) & 7, s = (int)(i2 >> 15);
            const int ca = dir == 0 ? 2 * s : 2 * s + 1, cb = dir == 0 ? 2 * s + 1 : 2 * s;
            const f32x4 sa = ld_bf4(ST + ((size_t)(ca * 8 + h) * 2 + dir) * 8192 + e), sb_ = ld_bf4(ST + ((size_t)(cb * 8 + h) * 2 + dir) * 8192 + e);
            const float db = DEC[(cb * 8 + h) * 2 + dir];
            *(f32x4*)(AOUT + OUT_SSD + ((size_t)((s * 2 + ei) * 2 + dir) * 8 + h) * 8192 + e) = sa * db + sb_;
        }
    }
}

__device__ __forceinline__ void ssd_out_item(const Frame& F, int ei, int c, int th) {
    F.relane();
    const bf16* PROJ = WSP(bf16, WS_PROJ); bf16* YMIX = WSP(bf16, WS_YMIX);
    const bf16* CC = WSP(bf16, WS_CC); const bf16* CBM = WSP(bf16, WS_CBM); const bf16* XCT = WSP(bf16, WS_XCT); const bf16* HIN = WSP(bf16, WS_HIN); const bf16* ST = WSP(bf16, WS_ST);
    const int t0 = c * 128;
    float* dtl = (float*)(F.lds + S2_DT); float* cml = (float*)(F.lds + S2_CUM); float* ssqx = (float*)(F.lds + S2_SSQ);
    const int r = F.lane & 15, q = F.lane >> 4, w = F.wave, it = w & 3, g = w >> 2;
    const int irow = 64 * th + 16 * it + r;
    const bool hzero[2] = {c < 64 && (c & 1) == 0, c < 64 && (c & 1) == 1};
    __syncthreads();
    ssd_tables(F, ei, t0, dtl, cml);
    v2u cbp[8]; bf16x8 cf[4];
    {
        const bf16* cbr = CBM + ((size_t)(c * 2 + g) * 128 + irow) * 128 + 4 * q;
#pragma unroll
        for (int jt = 0; jt < 8; ++jt) cbp[jt] = *(const v2u*)(cbr + 16 * jt);
#pragma unroll
        for (int kn = 0; kn < 4; ++kn) cf[kn] = *(const bf16x8*)(CC + (size_t)(t0 + irow) * 256 + g * 128 + 32 * kn + 8 * q);
    }
    float ssq = 0.f;
    v4u pre[12];
    const int goff = (F.tid >> 4) * 128 + (F.tid & 15) * 8, loff = ((F.tid >> 4) * LDT + (F.tid & 15) * 8) * 2;
#define E2_SRC(m_, hh_) ((m_) < 2 ? XCT + (size_t)(c * 8 + 4 * (m_) + (hh_)) * 8192 : \
        (c < 64 ? ST + ((size_t)((((m_) - 2) & 1) == 0 ? c - 1 : c + 1) * 8 + 4 * (((m_) - 2) >> 1) + (hh_)) * 16384 + (((m_) - 2) & 1) * 8192 \
                : HIN + ((size_t)c * 8 + 4 * (((m_) - 2) >> 1) + (hh_)) * 16384 + (((m_) - 2) & 1) * 8192))
#define E2_FETCH(hh_) do { _Pragma("unroll") for (int m = 0; m < 6; ++m) { if (m >= 2 && hzero[(m - 2) & 1]) continue; const bf16* sp = E2_SRC(m, hh_) + goff; \
            pre[2 * m] = *(const v4u*)sp; pre[2 * m + 1] = *(const v4u*)(sp + 32 * 128); } } while (0)
    E2_FETCH(0);
#pragma unroll 1
    for (int hh = 0; hh < 4; ++hh) {
        __syncthreads();
#pragma unroll
        for (int m = 0; m < 6; ++m) { if (m >= 2 && hzero[(m - 2) & 1]) continue;
            unsigned char* dp = F.lds + (m < 2 ? S2_XT + m * TILE64 : S2_H + (m - 2) * TILE64) + loff;
            *(v4u*)dp = pre[2 * m]; *(v4u*)(dp + 32 * LDT * 2) = pre[2 * m + 1]; }
        __syncthreads();
        if (hh < 3) E2_FETCH(hh + 1);
        v2u zr4[4];
#pragma unroll
        for (int pt = 0; pt < 4; ++pt) zr4[pt] = *(const v2u*)(PROJ + (size_t)(t0 + irow) * EVEN_NP + 1024 + (4 * g + hh) * 64 + 16 * pt + 4 * q);
        const int h = 4 * g + hh;
        const bf16* XT = (const bf16*)(F.lds + S2_XT + g * TILE64);
        f32x4 yacc[4];
#pragma unroll
        for (int pt = 0; pt < 4; ++pt) yacc[pt] = (f32x4){0.f, 0.f, 0.f, 0.f};
        const float* dt0 = dtl + h * 128; const float* cm0 = cml + h * 128; const float* dt1 = dtl + (8 + h) * 128; const float* cm1 = cml + (8 + h) * 128;
        const float ci0 = cm0[irow], ci1 = cm1[irow];
#pragma unroll
        for (int ks = 0; ks < 4; ++ks) {
            float sl0[8], sl1[8];
#pragma unroll
            for (int hf = 0; hf < 2; ++hf) {
                const int j0 = 32 * ks + 16 * hf + 4 * q; const v2u cw = cbp[2 * ks + hf];
                const f32x4 c0v = *(const f32x4*)(cm0 + j0), d0v = *(const f32x4*)(dt0 + j0), c1v = *(const f32x4*)(cm1 + j0), d1v = *(const f32x4*)(dt1 + j0);
                const float cbv[4] = {bflo(cw.x), bfhi(cw.x), bflo(cw.y), bfhi(cw.y)};
#pragma unroll
                for (int e = 0; e < 4; ++e) { const int j = j0 + e;
                    const float e0 = __expf(ci0 - c0v[e]) * d0v[e] * cbv[e], e1 = __expf(ci1 - c1v[e]) * d1v[e] * cbv[e];
                    sl0[4 * hf + e] = (j <= irow) ? e0 : 0.f; sl1[4 * hf + e] = (j >= irow) ? e1 : 0.f; }
            }
            const bf16x8 sf0 = __builtin_bit_cast(bf16x8, pack8(sl0)), sf1 = __builtin_bit_cast(bf16x8, pack8(sl1));
#pragma unroll
            for (int pt = 0; pt < 4; ++pt) { const unsigned char* xr = (const unsigned char*)XT + ((16 * pt + r) * LDT + 32 * ks + 4 * q) * 2;
                const bf16x8 xf = ld_frag8x2(xr, xr + 32);
                yacc[pt] = MFMA16(xf, sf0, yacc[pt]); yacc[pt] = MFMA16(xf, sf1, yacc[pt]); }
        }
#pragma unroll
        for (int dir = 0; dir < 2; ++dir) {
            if (hzero[dir]) continue;
            const unsigned char* Hl = F.lds + S2_H + (g * 2 + dir) * TILE64;
            const float ei_ = __expf(dir == 0 ? ci0 : ci1);
#pragma unroll
            for (int pt = 0; pt < 4; ++pt) { f32x4 t = {0.f, 0.f, 0.f, 0.f};
#pragma unroll
                for (int kn = 0; kn < 4; ++kn) t = MFMA16(ld_frag16(Hl + ((16 * pt + r) * LDT + 32 * kn + 8 * q) * 2), cf[kn], t);
                yacc[pt] += t * ei_; }
        }
        const float dsk = AIN(I_DSK)[ei * 16 + h] + AIN(I_DSK)[ei * 16 + 8 + h];
#pragma unroll
        for (int pt = 0; pt < 4; ++pt) {
            const int p0 = 16 * pt + 4 * q;
            const v2u zr = zr4[pt];
            const float z0 = bflo(zr.x), z1 = bfhi(zr.x), z2 = bflo(zr.y), z3 = bfhi(zr.y);
            float y0 = yacc[pt][0] + dsk * bf1(XT[(p0 + 0) * LDT + irow]), y1 = yacc[pt][1] + dsk * bf1(XT[(p0 + 1) * LDT + irow]),
                  y2 = yacc[pt][2] + dsk * bf1(XT[(p0 + 2) * LDT + irow]), y3 = yacc[pt][3] + dsk * bf1(XT[(p0 + 3) * LDT + irow]);
            y0 *= siluf_(z0); y1 *= siluf_(z1); y2 *= siluf_(z2); y3 *= siluf_(z3);
            ssq += (y0 * y0 + y1 * y1) + (y2 * y2 + y3 * y3);
            v2u o; o.x = pk2(y0, y1); o.y = pk2(y2, y3);
            *(v2u*)(YMIX + (size_t)(t0 + irow) * D + 512 + h * 64 + p0) = o;
        }
    }
#undef E2_FETCH
#undef E2_SRC
    ssq += xlane<16>(ssq); ssq = sum_x32(ssq);
    if (q == 0) ssqx[w * 16 + r] = ssq;
    __syncthreads();
    ssq += ssqx[(w ^ 4) * 16 + r];
    const float rstd = frsq(ssq * (1.f / 512.f) + EPS);
    const float* go = AIN(I_GSO) + ei * 512;
#pragma unroll 1
    for (int hh = 0; hh < 4; ++hh)
#pragma unroll
        for (int pt = 0; pt < 4; ++pt) {
            const int col = (4 * g + hh) * 64 + 16 * pt + 4 * q;
            v2u* p = (v2u*)(YMIX + (size_t)(t0 + irow) * D + 512 + col); const v2u v = *p; const f32x4 gg = *(const f32x4*)(go + col);
            v2u o; o.x = pk2(bflo(v.x) * rstd * gg.x, bfhi(v.x) * rstd * gg.y); o.y = pk2(bflo(v.y) * rstd * gg.z, bfhi(v.y) * rstd * gg.w);
            *p = o;
        }
}

__device__ __forceinline__ void even_phase1(const Frame& F, int ei) {
    if (F.G >= 256) {
        if (F.bid < 160) ssd_state_item(F, ei, F.bid >> 1, F.bid & 1);
        else for (int it = F.bid - 160; it < 192; it += F.G - 160) gmlp_item(F, ei, it >> 2, it & 3);
        return;
    }
    for (int it = F.bid; it < 160 + 320; it += F.G) {
        if (it < 160) ssd_state_item(F, ei, it >> 1, it & 1);
        else gmlp_item(F, ei, (it - 160) >> 2, (it - 160) & 3);
    }
}
__device__ __forceinline__ void even_phase2(const Frame& F, int ei) {
    if (F.G >= 256) {
        if (F.bid < 160) ssd_out_item(F, ei, F.bid >> 1, F.bid & 1);
        else for (int it = 192 + F.bid - 160; it < 320; it += F.G - 160) gmlp_item(F, ei, it >> 2, it & 3);
        return;
    }
    for (int it = F.bid; it < 160; it += F.G) ssd_out_item(F, ei, it >> 1, it & 1);
}
constexpr int CV_T = 43, CV_W = CV_T + 30, CV_ITEMS = 32 * 6 + 2 * 24;
__device__ __forceinline__ void conv_item(const Frame& F, int oi, int item) {
    F.relane();
    const bf16* PROJ = WSP(bf16, WS_PROJ); bf16* YMIX = WSP(bf16, WS_YMIX);
    int sbeg, slen, tile; if (item < 192) { sbeg = (item / 6) * 256; slen = 256; tile = item % 6; } else { const int i2 = item - 192; sbeg = TCTX + (i2 / 24) * 1024; slen = 1024; tile = i2 % 24; }
    const int send = sbeg + slen, t0 = sbeg + tile * CV_T, nt = (slen - tile * CV_T) < CV_T ? (slen - tile * CV_T) : CV_T;
    float* Dl = (float*)F.lds;
    const int c = F.tid;
    float glu[CV_W];
#pragma unroll
    for (int w0 = 0; w0 < CV_W; w0 += 8) {
        bf16 av[8], gv[8];
#pragma unroll
        for (int i = 0; i < 8; ++i) if (w0 + i < CV_W) { int t = t0 - 15 + w0 + i; t = t < sbeg ? sbeg : (t >= send ? send - 1 : t);
            av[i] = PROJ[(size_t)t * ODD_NP + 672 + c]; gv[i] = PROJ[(size_t)t * ODD_NP + 1184 + c]; }
#pragma unroll
        for (int i = 0; i < 8; ++i) if (w0 + i < CV_W) { const int t = t0 - 15 + w0 + i; const float v = bf1(av[i]) * sigmoidf_(bf1(gv[i])); glu[w0 + i] = (t >= sbeg && t < send) ? v : 0.f; }
    }
    float wk[31];
#pragma unroll
    for (int k = 0; k < 31; ++k) wk[k] = AIN(I_WDW)[((size_t)oi * 31 + k) * 512 + c];
    const float bd = AIN(I_BDW)[oi * 512 + c];
    __syncthreads();
#pragma unroll
    for (int tt = 0; tt < CV_T; ++tt) { float s = bd;
#pragma unroll
        for (int k = 0; k < 31; ++k) s += wk[k] * glu[tt + k];
        Dl[tt * 512 + c] = s; }
    __syncthreads();
    const float* gl = AIN(I_GLN) + oi * 512; const float* bl = AIN(I_BLN) + oi * 512;
    const f32x4 g0 = *(const f32x4*)(gl + 8 * F.lane), g1 = *(const f32x4*)(gl + 8 * F.lane + 4), b0 = *(const f32x4*)(bl + 8 * F.lane), b1 = *(const f32x4*)(bl + 8 * F.lane + 4);
#pragma unroll 1
    for (int tt = F.wave; tt < nt; tt += NWAVES) {
        const f32x4 v0 = *(const f32x4*)(Dl + tt * 512 + 8 * F.lane), v1 = *(const f32x4*)(Dl + tt * 512 + 8 * F.lane + 4);
        float s = (v0.x + v0.y) + (v0.z + v0.w) + (v1.x + v1.y) + (v1.z + v1.w);
        const float mean = wave_sum(s) * (1.f / 512.f);
        const f32x4 d0 = v0 - mean, d1 = v1 - mean;
        float s2 = (d0.x * d0.x + d0.y * d0.y) + (d0.z * d0.z + d0.w * d0.w) + (d1.x * d1.x + d1.y * d1.y) + (d1.z * d1.z + d1.w * d1.w);
        const float rstd = frsq(wave_sum(s2) * (1.f / 512.f) + EPS);
        float o[8];
#pragma unroll
        for (int i = 0; i < 4; ++i) { o[i] = siluf_(d0[i] * rstd * g0[i] + b0[i]); o[4 + i] = siluf_(d1[i] * rstd * g1[i] + b1[i]); }
        *(v4u*)(YMIX + (size_t)(t0 + tt) * D + 512 + 8 * F.lane) = pack8(o);
    }
}
__device__ __forceinline__ void odd_rows(const Frame& F, int oi) {
    F.relane();
    const bf16* PROJ = WSP(bf16, WS_PROJ);
    bf16* QA = WSP(bf16, WS_QA); bf16* CKVA = WSP(bf16, WS_CKVA); bf16* KR = WSP(bf16, WS_KR); const float* ROPE = WSP(float, WS_ROPE);
    const int gw = F.bid * NWAVES + F.wave, NGW = F.G * NWAVES, lane = F.lane;
    for (int row = T + gw; row < TP; row += NGW) {
        const int b = (row - T) >> 8, j = (row - T) & 255;
        const f32x4 v = *(const f32x4*)(AIN(I_CCKV) + ((size_t)(b * 2 + oi) * 256 + j) * 256 + 4 * lane);
        v2u o; o.x = pk2(v.x, v.y); o.y = pk2(v.z, v.w); *(v2u*)(CKVA + (size_t)row * 256 + 4 * lane) = o;
        if (lane < 32) KR[(size_t)row * 32 + lane] = (bf16)f2bf1(AIN(I_CKR)[((size_t)(b * 2 + oi) * 256 + j) * 32 + lane]);
    }
    const f32x4 gkv = *(const f32x4*)(AIN(I_GCKV) + oi * 256 + 4 * lane);
    float gq[6];
#pragma unroll
    for (int k = 0; k < 3; ++k) { gq[2 * k] = AIN(I_GCQ)[oi * 384 + 128 * k + 2 * lane]; gq[2 * k + 1] = AIN(I_GCQ)[oi * 384 + 128 * k + 2 * lane + 1]; }
    unsigned qw[3], nqw[3]; v2u kw, nkw; bf16 krw, nkrw;
    int row = gw;
    if (row < T) { const bf16* pr = PROJ + (size_t)row * ODD_NP;
#pragma unroll
        for (int k = 0; k < 3; ++k) nqw[k] = *(const unsigned*)(pr + 128 * k + 2 * lane);
        nkw = *(const v2u*)(pr + 384 + 4 * lane); nkrw = pr[640 + (lane & 31)]; }
#pragma unroll 1
    for (; row < T; row += NGW) {
#pragma unroll
        for (int k = 0; k < 3; ++k) qw[k] = nqw[k];
        kw = nkw; krw = nkrw;
        if (row + NGW < T) { const bf16* pr = PROJ + (size_t)(row + NGW) * ODD_NP;
#pragma unroll
            for (int k = 0; k < 3; ++k) nqw[k] = *(const unsigned*)(pr + 128 * k + 2 * lane);
            nkw = *(const v2u*)(pr + 384 + 4 * lane); nkrw = pr[640 + (lane & 31)]; }
        float qv[6]; float s = 0.f;
#pragma unroll
        for (int k = 0; k < 3; ++k) { qv[2 * k] = bflo(qw[k]); qv[2 * k + 1] = bfhi(qw[k]); s += qv[2 * k] * qv[2 * k] + qv[2 * k + 1] * qv[2 * k + 1]; }
        f32x4 kv = {bflo(kw.x), bfhi(kw.x), bflo(kw.y), bfhi(kw.y)};
        float s2 = (kv.x * kv.x + kv.y * kv.y) + (kv.z * kv.z + kv.w * kv.w);
        s += xlane<1>(s); s2 += xlane<1>(s2); s += xlane<2>(s); s2 += xlane<2>(s2); s += xlane<4>(s); s2 += xlane<4>(s2); s += xlane<8>(s); s2 += xlane<8>(s2); s += xlane<16>(s); s2 += xlane<16>(s2);
        s = sum_x32(s); s2 = sum_x32(s2);
        const float rq = frsq(s * (1.f / 384.f) + EPS), rk = frsq(s2 * (1.f / 256.f) + EPS);
#pragma unroll
        for (int k = 0; k < 3; ++k) *(unsigned*)(QA + (size_t)row * 384 + 128 * k + 2 * lane) = pk2(qv[2 * k] * rq * gq[2 * k], qv[2 * k + 1] * rq * gq[2 * k + 1]);
        kv = kv * rk * gkv;
        { v2u o; o.x = pk2(kv.x, kv.y); o.y = pk2(kv.z, kv.w); *(v2u*)(CKVA + (size_t)row * 256 + 4 * lane) = o; }
        float kr = bf1(krw);
        if (row < TCTX) {
            const int b = row >> 8, pos = row & 255;
            *(f32x4*)(AOUT + OUT_CKV + ((size_t)(b * 2 + oi) * 256 + pos) * 256 + 4 * lane) = kv;
            if (lane < 32) AOUT[OUT_KR + ((size_t)(b * 2 + oi) * 256 + pos) * 32 + lane] = kr;
        } else {
            const int pos = (row - TCTX) & 1023, e = lane & 31, ax = e >> 4, half = (e >> 3) & 1, f = e & 7;
            const float other = xlane<8>(kr);
            const float cs = ROPE[((pos * 2 + ax) * 8 + f) * 2], sn = ROPE[((pos * 2 + ax) * 8 + f) * 2 + 1];
            kr = half == 0 ? (kr * cs - other * sn) : (other * sn + kr * cs);
        }
        if (lane < 32) KR[(size_t)row * 32 + lane] = (bf16)f2bf1(kr);
    }
}
__device__ __forceinline__ void odd_phase1(const Frame& F, int oi) {
    for (int it = F.bid; it < CV_ITEMS; it += F.G) conv_item(F, oi, it);
    odd_rows(F, oi);
}

constexpr int AT_KROW = 208, AT_VROW = 272, AT_KBYTES = 128 * AT_KROW, AT_BUF = 45056;
struct AttnPre { v4u k[3]; v4u v[2]; };
__device__ __forceinline__ void attn_load_tile(const Frame& F, int h, int krow0, AttnPre& P) {
    const bf16* KN = WSP(bf16, WS_KN); const bf16* KR = WSP(bf16, WS_KR); const bf16* VT = WSP(bf16, WS_VT);
#pragma unroll
    for (int i = 0; i < 3; ++i) { const int e = F.tid + NTHR * i, key = e / 12, c = e % 12; const size_t kr = (size_t)(krow0 + key);
        P.k[i] = c < 8 ? *(const v4u*)(KN + kr * 512 + h * 64 + c * 8) : *(const v4u*)(KR + kr * 32 + (c - 8) * 8); }
#pragma unroll
    for (int i = 0; i < 2; ++i) { const int e = F.tid + NTHR * i, row = e >> 4, c = e & 15;
        P.v[i] = *(const v4u*)(VT + (size_t)(h * 64 + row) * TP + krow0 + c * 8); }
}
__device__ __forceinline__ void attn_store_tile(const Frame& F, unsigned char* buf, const AttnPre& P) {
#pragma unroll
    for (int i = 0; i < 3; ++i) { const int e = F.tid + NTHR * i, key = e / 12, c = e % 12; *(v4u*)(buf + key * AT_KROW + c * 16) = P.k[i]; }
#pragma unroll
    for (int i = 0; i < 2; ++i) { const int e = F.tid + NTHR * i, row = e >> 4, c = e & 15; *(v4u*)(buf + AT_KBYTES + row * AT_VROW + c * 16) = P.v[i]; }
}
__device__ __forceinline__ int attn_tile_row(bool is_smp, int sb, int i) {
    if (!is_smp) return sb * 256 + 128 * i;
    return i < 2 ? T + sb * 256 + 128 * i : TCTX + sb * 1024 + 128 * (i - 2);
}
__device__ __forceinline__ void attn_item(const Frame& F, int q0, int h, bool is_smp, int spos0, int sb) {
    F.relane();
    const bf16* Q = WSP(bf16, WS_Q); bf16* YMIX = WSP(bf16, WS_YMIX); const float* ROPE = WSP(float, WS_ROPE);
    const int r = F.lane & 15, g = F.lane >> 4, w = F.wave;
    const int tq = q0 + 16 * w + r;
    const int ntile = is_smp ? 10 : 2;
    AttnPre P;
    attn_load_tile(F, h, attn_tile_row(is_smp, sb, 0), P);
    bf16x8 qf[3];
#pragma unroll
    for (int ks = 0; ks < 3; ++ks) qf[ks] = *(const bf16x8*)(Q + (size_t)tq * 768 + h * 96 + 32 * ks + 8 * g);
    if (is_smp) {
        float x[8], o[8]; unpack8(__builtin_bit_cast(v4u, qf[2]), x);
        const int pos = spos0 + 16 * w + r, ax = g >> 1, half = g & 1;
        const float* rp = ROPE + ((size_t)(pos * 2 + ax) * 8) * 2;
#pragma unroll
        for (int j = 0; j < 8; ++j) { const float other = xlane<16>(x[j]); const float cs = rp[2 * j], sn = rp[2 * j + 1];
            o[j] = half == 0 ? (x[j] * cs - other * sn) : (other * sn + x[j] * cs); }
        qf[2] = __builtin_bit_cast(bf16x8, pack8(o));
    }
    const float csc = 0.10206207261596577f * 1.4426950408889634f;
    float m = -1e30f, l = 0.f;
    f32x4 oacc[4];
#pragma unroll
    for (int dt = 0; dt < 4; ++dt) oacc[dt] = (f32x4){0.f, 0.f, 0.f, 0.f};
    __syncthreads();
    attn_store_tile(F, F.lds, P);
    AttnPre P2;
    if (ntile > 1) attn_load_tile(F, h, attn_tile_row(is_smp, sb, 1), P);
    __syncthreads();
#define ATTN_COMPUTE(buf) do { \
        f32x4 sacc[8]; \
        _Pragma("unroll") \
        for (int st = 0; st < 8; ++st) { \
            const unsigned char* kp = buf + (16 * st + r) * AT_KROW + 16 * g; \
            f32x4 a = {0.f, 0.f, 0.f, 0.f}; \
            a = MFMA16(ld_frag16(kp), qf[0], a); a = MFMA16(ld_frag16(kp + 64), qf[1], a); a = MFMA16(ld_frag16(kp + 128), qf[2], a); \
            sacc[st] = a; \
        } \
        float mx = -1e30f; \
        _Pragma("unroll") \
        for (int st = 0; st < 8; ++st) mx = fmaxf(fmaxf(fmaxf(sacc[st][0], sacc[st][1]), fmaxf(sacc[st][2], sacc[st][3])), mx); \
        mx = fmaxf(mx, xlane<16>(mx)); mx = max_x32(mx); \
        const float mn = fmaxf(m, mx), alpha = __builtin_amdgcn_exp2f((m - mn) * csc); m = mn; \
        float ps = 0.f; float p[32]; \
        _Pragma("unroll") \
        for (int st = 0; st < 8; ++st) \
            _Pragma("unroll") \
            for (int j = 0; j < 4; ++j) { const float e = __builtin_amdgcn_exp2f((sacc[st][j] - mn) * csc); p[4 * st + j] = e; ps += e; } \
        l = l * alpha + ps; \
        _Pragma("unroll") \
        for (int dt = 0; dt < 4; ++dt) oacc[dt] *= alpha; \
        _Pragma("unroll") \
        for (int ks2 = 0; ks2 < 4; ++ks2) { \
            const bf16x8 pf = __builtin_bit_cast(bf16x8, pack8(p + 8 * ks2)); \
            _Pragma("unroll") \
            for (int dt = 0; dt < 4; ++dt) { \
                const unsigned char* vp = buf + AT_KBYTES + (16 * dt + r) * AT_VROW + (32 * ks2 + 4 * g) * 2; \
                oacc[dt] = MFMA16(ld_frag8x2(vp, vp + 32), pf, oacc[dt]); \
            } \
        } } while (0)
#pragma unroll 1
    for (int ti = 0; ti < ntile; ti += 2) {
        if (ti + 2 < ntile) attn_load_tile(F, h, attn_tile_row(is_smp, sb, ti + 2), P2);
        { const unsigned char* buf = F.lds; ATTN_COMPUTE(buf); }
        if (ti + 1 < ntile) attn_store_tile(F, F.lds + AT_BUF, P);
        __syncthreads();
        if (ti + 1 >= ntile) break;
        if (ti + 3 < ntile) attn_load_tile(F, h, attn_tile_row(is_smp, sb, ti + 3), P);
        { const unsigned char* buf = F.lds + AT_BUF; ATTN_COMPUTE(buf); }
        if (ti + 2 < ntile) attn_store_tile(F, F.lds, P2);
        __syncthreads();
    }
#undef ATTN_COMPUTE
    l += xlane<16>(l); l = sum_x32(l);
    const float inv = 1.0f / l;
#pragma unroll
    for (int dt = 0; dt < 4; ++dt) { v2u o; o.x = pk2(oacc[dt][0] * inv, oacc[dt][1] * inv); o.y = pk2(oacc[dt][2] * inv, oacc[dt][3] * inv);
        *(v2u*)(YMIX + (size_t)tq * D + h * 64 + 16 * dt + 4 * g) = o; }
}
__device__ __forceinline__ void odd_phase3(const Frame& F) {
    if (F.G >= 256) {
        if (F.bid < 128) {
            const int bh = F.bid & 15, qt = F.bid >> 4, b = bh >> 3, h = bh & 7;
            attn_item(F, TCTX + b * 1024 + qt * 128, h, true, qt * 128, b);
        } else {
            for (int p = F.bid - 128; p < 256; p += F.G - 128) { const int s = p >> 3, h = p & 7;
                attn_item(F, s * 256, h, false, 0, s); attn_item(F, s * 256 + 128, h, false, 0, s); }
        }
        return;
    }
    for (int it = F.bid; it < 640; it += F.G) {
        if (it < 128) { const int b = it >> 6, h = (it >> 3) & 7, qt = it & 7; attn_item(F, TCTX + b * 1024 + qt * 128, h, true, qt * 128, b); }
        else { const int i2 = it - 128, s = i2 >> 4, h = (i2 >> 1) & 7, qt = i2 & 1; attn_item(F, s * 256 + qt * 128, h, false, 0, s); }
    }
}
constexpr int PH_PER_LAYER = 9, PH_L0 = 2, N_PHASES = PH_L0 + 4 * PH_PER_LAYER + 1;
#ifndef MK_ONE_LAUNCH
#define MK_ONE_LAUNCH 1
#endif
#ifndef PROBE_REP
#define PROBE_REP 1
#define PROBE_SLOT -2
#endif

__global__ void __launch_bounds__(NTHR, 2) fwd_kernel(Args args) {
    extern __shared__ __attribute__((aligned(16))) unsigned char lds[];
    Frame F; F.lds = lds; F.tid = threadIdx.x; F.lane = F.tid & 63; F.wave = __builtin_amdgcn_readfirstlane(F.tid >> 6); F.bid = blockIdx.x; F.G = gridDim.x;
    const int wave_id = F.wave;
    { CArgsP ap = (CArgsP)__builtin_amdgcn_kernarg_segment_ptr(); asm volatile("" : "+s"(ap)); F.a = ap; F.ws = (GAS unsigned char*)ap->ws; }
    LAS unsigned char* ldsl = (LAS unsigned char*)lds;
    for (int u = F.tid; u < (LDS_BYTES - LDSCTL_OFF) / 4; u += NTHR) ((LAS unsigned*)(ldsl + LDSCTL_OFF))[u] = 0u;
    __syncthreads();
    XcdBarrier bar; bar.bar = (unsigned*)(GAS unsigned*)(F.ws + WS_CTL) + 1024; bar.x = 0; bar.st = nullptr;
    const bool multi = (args.ph_hi - args.ph_lo) > 1;
    if (multi) bar = xcd_barrier_post((unsigned*)(GAS unsigned*)(F.ws + WS_CTL) + 1024, (volatile LAS unsigned*)(ldsl + MISC_OFF) + 8);

#define FRESH_F() do { int wv_ = wave_id; asm volatile("" : "+s"(wv_)); int ln_; asm volatile("v_mbcnt_lo_u32_b32 %0, -1, 0\n\tv_mbcnt_hi_u32_b32 %0, -1, %0" : "=v"(ln_)); F.tid = wv_ * 64 + ln_; F.lane = ln_; F.wave = wv_; } while (0)
    int rep = 0;
    for (int ph = args.ph_lo; ph < args.ph_hi; ) {
        { CArgsP ap = (CArgsP)__builtin_amdgcn_kernarg_segment_ptr(); asm volatile("" : "+s"(ap)); F.a = ap; F.ws = (GAS unsigned char*)ap->ws;
          int bid_ = blockIdx.x; asm volatile("" : "+s"(bid_)); F.bid = bid_; }
        if (ph == 0) { FRESH_F(); p0_phase(F); }
        else if (ph == 1) { FRESH_F(); p1_copy_phase(F); norm0_phase(F); }
        else if (ph == N_PHASES - 1) { FRESH_F(); final_phase(F); }
        else {
            const int l = (ph - PH_L0) / PH_PER_LAYER, s = (ph - PH_L0) % PH_PER_LAYER, hi = l >> 1; const bool odd = l & 1;
            if (s == 0 || s == 7) {
                FRESH_F();
                const int f = s == 0 ? 0 : 1;
                pg8::Gemm g{(const bf16*)(const GAS bf16*)(F.ws + WS_XA), (const bf16*)(const GAS bf16*)(F.ws + WS_WGU + (size_t)(l * 2 + f) * SZ_WGU), T, 2 * DFF, D, D, D};
                pg8::StaticOrder S; S.init(T, 2 * DFF, F.G, F.bid);
                EpiSwiglu E{F.ws, (int)(((l * 3) + (f == 0 ? 0 : 2)) * 3 * BIAS_MS), (l == 0 && f == 0) ? 16 : 1};
                pg8::gemm_phase<EpiSwiglu, pg8::StaticOrder, true>(ldsl, F.tid, g, S, E);
            } else if (s == 1 || s == 8 || s == 6) {
                FRESH_F();
                const int f = s == 1 ? 0 : 1;
                const bool mix = s == 6, lastg = (s == 8 && l == 3);
                const bf16* gA = mix ? (const bf16*)(const GAS bf16*)(F.ws + WS_YMIX) : (const bf16*)(const GAS bf16*)(F.ws + WS_H);
                const bf16* gB = mix ? (const bf16*)(const GAS bf16*)(F.ws + (odd ? WS_WOO : WS_WOE) + (size_t)hi * SZ_WO) : (const bf16*)(const GAS bf16*)(F.ws + WS_WD + (size_t)(l * 2 + f) * SZ_WD);
                const int gK = mix ? D : DFF;
                const int gate_off = l * 3 * NMODV + (mix ? 5 : (f == 0 ? 2 : 8)) * 1024;
                const float coef = rep ? 0.f : (mix ? 1.0f : 0.5f);
                const int nl = (s == 8) ? l + 1 : l, ni = mix ? 2 : (f == 0 ? 1 : 0), sci = mix ? 7 : (f == 0 ? 4 : 1);
                const float* gn = AIN(I_GNORM) + (size_t)((lastg ? 0 : nl) * 3 + ni) * D;
                const int scn_off = (lastg ? 0 : nl) * 3 * NMODV + sci * 1024;
                pg8::Gemm g{gA, gB, T, D, gK, gK, gK};
                EpiResid E{F.ws, gn, gate_off, scn_off, coef};
                pg8::StaticOrder S; S.init(T, D, F.G, F.bid);
                pg8::gemm_phase<EpiResid, pg8::StaticOrder, true>(ldsl, F.tid, g, S, E);
                FRESH_F();
                if (F.bid >= 160 && rep == 0) background_work(F, l, s == 1 ? 0 : (s == 6 ? 1 : 2), F.bid - 160, F.G - 160);
            } else if (s == 2 || (s == 4 && odd)) {
                const int ng = s == 2 ? 1 : 3;
                for (int gi = 0; gi < ng; ++gi) {
                    FRESH_F();
                    const bool inproj = s == 2;
                    const int kind = inproj ? 0 : 1 + gi;
                    const size_t offA = kind == 0 ? WS_XA : (kind == 1 ? WS_QA : (kind == 2 ? WS_CKVA : WS_WKV + (size_t)hi * SZ_WKV + (size_t)512 * 256 * 2));
                    const size_t offB = kind == 0 ? (odd ? WS_WIO + (size_t)hi * SZ_WIO : WS_WIE + (size_t)hi * SZ_WIE) : (kind == 1 ? WS_WUQ + (size_t)hi * SZ_WUQ : (kind == 2 ? WS_WKV + (size_t)hi * SZ_WKV : WS_CKVA));
                    const size_t offO = kind == 0 ? WS_PROJ : (kind == 1 ? WS_Q : (kind == 2 ? WS_KN : WS_VT));
                    const int gM = kind == 3 ? 512 : (kind == 2 ? TP : T);
                    const int gN = kind == 0 ? (odd ? ODD_NP : EVEN_NP) : (kind == 1 ? 768 : (kind == 2 ? 512 : TP));
                    const int gK = kind == 0 ? D : (kind == 1 ? 384 : 256);
                    const int ldc = kind == 3 ? TP : gN;
                    const int off = kind == 2 ? 136 : (kind == 3 ? 52 : 0);
                    pg8::Gemm g{(const bf16*)(const GAS bf16*)(F.ws + offA), (const bf16*)(const GAS bf16*)(F.ws + offB), gM, gN, gK, gK, gK};
                    EpiStore E{F.ws, (unsigned)offO, ldc, inproj ? (int)((l * 3 + 1) * 3 * BIAS_MS) : -1};
                    pg8::StaticOrder S; S.init(gM, gN, F.G, (F.bid + off) % F.G);
                    pg8::gemm_phase<EpiStore, pg8::StaticOrder, true>(ldsl, F.tid, g, S, E);
                }
            } else if (s == 3) { if (!odd) { FRESH_F(); even_phase1(F, hi); } else { FRESH_F(); odd_phase1(F, hi); } }
            else if (s == 4) { FRESH_F(); ssd_scan_phase(F, hi); }
            else if (s == 5) { if (odd) { FRESH_F(); odd_phase3(F); } else { FRESH_F(); even_phase2(F, hi); } }
        }
        {
            const int slot = ph < PH_L0 ? 100 + ph : (ph == N_PHASES - 1 ? 102 : ((ph - PH_L0) % PH_PER_LAYER) + 20 * (((ph - PH_L0) / PH_PER_LAYER) & 1));
            const int reps = ((PROBE_SLOT == 200 && slot < 100) || slot == PROBE_SLOT || (PROBE_SLOT < 20 && slot == PROBE_SLOT + 20 && (PROBE_SLOT < 2 || PROBE_SLOT > 5))) ? PROBE_REP : 1;
            if (++rep >= reps) { rep = 0; ++ph; }
            if (ph < args.ph_hi) xcd_barrier(bar);
#if defined(PROBE_BAR)
            if (ph < args.ph_hi) { for (int pb_ = 1; pb_ < PROBE_BAR; ++pb_) xcd_barrier(bar); }
#endif
        }
    }
}

extern "C" void kernel_launch(void* const* d_in, const int* in_sizes, int n_in, void* d_out, int out_size, void* d_ws, size_t ws_size, hipStream_t stream) {
    static int grid = 0;
    if (grid == 0) {
        if (n_in != 34 || (size_t)out_size != OUT_END || ws_size < WS_END) { fprintf(stderr, "kernel_launch: unexpected problem: n_in %d out %d ws %zu (need %zu)\n", n_in, out_size, ws_size, (size_t)WS_END); grid = -1; return; }
        int dev = 0, cus = 0, per_cu = 0;
        if (hipGetDevice(&dev) != hipSuccess || hipDeviceGetAttribute(&cus, hipDeviceAttributeMultiprocessorCount, dev) != hipSuccess) { grid = -1; return; }
        if (hipFuncSetAttribute((const void*)fwd_kernel, hipFuncAttributeMaxDynamicSharedMemorySize, LDS_BYTES) != hipSuccess) { fprintf(stderr, "kernel_launch: hipFuncSetAttribute failed\n"); grid = -1; return; }
        if (hipOccupancyMaxActiveBlocksPerMultiprocessor(&per_cu, (const void*)fwd_kernel, NTHR, LDS_BYTES) != hipSuccess || per_cu < 1) { fprintf(stderr, "kernel_launch: occupancy query says %d blocks per CU\n", per_cu); per_cu = 1; }
        (void)hipGetLastError();
        grid = cus;
        if (grid < 256) fprintf(stderr, "kernel_launch: %d CUs (tuned for 256)\n", grid);
    }
    if (grid < 0) return;
    (void)hipMemsetAsync((char*)d_ws + WS_CTL, 0, CTL_ZERO_BYTES, stream);
    Args a{};
    for (int i = 0; i < 34; ++i) a.in[i] = (const float*)d_in[i];
    a.out = (float*)d_out; a.ws = (unsigned char*)d_ws;
#if MK_ONE_LAUNCH
    a.ph_lo = 0; a.ph_hi = N_PHASES; a.li = 0;
    hipLaunchKernelGGL(fwd_kernel, dim3(grid), dim3(NTHR), LDS_BYTES, stream, a);
#else
    int li = 0;
    for (int ph = 0; ph < N_PHASES; ++ph) {
        a.ph_lo = ph; a.ph_hi = ph + 1; a.li = li++;
        hipLaunchKernelGGL(fwd_kernel, dim3(grid), dim3(NTHR), LDS_BYTES, stream, a);
    }
#endif
}
```

```cpp
#include <hip/hip_runtime.h>
#include <cstdio>
#include <cstdint>
#ifndef GEMM_SP2
#define GEMM_SP2 1
#endif
namespace pg8 {
#define PG8_LAS __attribute__((address_space(3)))
typedef unsigned short bf16_t;
typedef short bf16x8 __attribute__((ext_vector_type(8)));
typedef float f32x4 __attribute__((ext_vector_type(4)));
typedef unsigned u32x4 __attribute__((ext_vector_type(4)));
typedef unsigned u32x2 __attribute__((ext_vector_type(2)));
constexpr int BM = 256, BK = 64, HALF = 128, HTB = HALF * BK * 2  , STAGE_BYTES = 8 * HTB, NXCD = 8, WGM = 8;

__host__ __device__ __forceinline__ int lds_byte(int r, int c) { const int st = (r >> 4) * 2 + (c >> 5), rr = r & 15, cc = c & 31, ob = rr * 64 + cc * 2; return st * 1024 + (ob ^ (((ob >> 9) & 1) << 5)); }
__host__ __device__ __forceinline__ void stage_rc(int b, int& R, int& C) { const int st = b / 1024, sb = b % 1024, swz = sb ^ (((sb >> 9) & 1) << 5); R = (st >> 1) * 16 + swz / 64; C = (st & 1) * 32 + (swz % 64) / 2; }
__host__ __device__ __forceinline__ int perm32(int rho) { const int n = rho >> 4, i = rho & 15; return 8 * (i >> 2) + 4 * n + (i & 3); }

struct Unit { int pm, pn; };
struct Gemm { const bf16_t* A; const bf16_t* Bt; int M, N, K, lda, ldb; };

struct StaticOrder {
    int nM, nN, nwg, G, c;
    __host__ __device__ void init(int M, int N, int G_, int c_) { nM = M / BM; nN = N / BM; nwg = nM * nN; G = G_; c = c_; }
    __host__ __device__ bool next(int i, Unit& u) const {
        const long L = (long)i * G + c; if (L >= nwg) return false;
        int wgid = (int)L; { const int q = nwg / NXCD, r = nwg % NXCD, xcd = wgid % NXCD, off = wgid / NXCD; wgid = (xcd < r ? xcd * (q + 1) : r * (q + 1) + (xcd - r) * q) + off; }
        const int nig = WGM * nN, gid = wgid / nig, fm = gid * WGM, gsz = (nM - fm) < WGM ? (nM - fm) : WGM;
        u.pm = fm + ((wgid % nig) % gsz); u.pn = (wgid % nig) / gsz; return true;
    }
    __device__ __forceinline__ void a_ready(const Unit&) const {}
    __device__ __forceinline__ void done(const Unit&) const {}
};

__device__ __forceinline__ unsigned cvt_pk_bf16(float lo, float hi) { unsigned r; asm volatile("v_cvt_pk_bf16_f32 %0, %1, %2" : "=v"(r) : "v"(lo), "v"(hi)); return r; }

template <class Epi, class Sched, bool ALIGN_EPI>
__device__ __forceinline__ void gemm_phase(PG8_LAS unsigned char* lds, const int tid, const Gemm g, const Sched& S, const Epi& E) {
    const int wid = __builtin_amdgcn_readfirstlane(tid >> 6), lane = tid & 63, wr = wid >> 2, wc = wid & 3, fr = lane & 15, fq = lane >> 4;
    const int K = g.K, nt = K / BK;
    unsigned voffA[2], voffB[2];
#pragma unroll
    for (int i = 0; i < 2; ++i) { int R, C; stage_rc(tid * 16 + i * 8192, R, C); const int Rb = Epi::PERM ? ((R & ~31) + perm32(R & 31)) : R;
        voffA[i] = (unsigned)(R * g.lda + C) * 2u; voffB[i] = (unsigned)(Rb * g.ldb + C) * 2u; }
    const size_t kstep = (size_t)(BK * 2);
    const size_t hstepA = (size_t)HALF * g.lda * 2, hstepB = (size_t)HALF * g.ldb * 2;
    const size_t tstepA = 2 * hstepA, tstepB = 2 * hstepB;
    const unsigned ldsw = (unsigned)wid * 1024u;
    const int aoff = lds_byte(wr * 64 + fr, fq * 8), boff = lds_byte(wc * 32 + fr, fq * 8);
#define PG8_SA(b, h) (((b) * 2 + (h)) * HTB)
#define PG8_SB(b, h) ((4 + (b) * 2 + (h)) * HTB)
#define PG8_STAGE(bufoff, gbase, voff) do { _Pragma("unroll") for (int _i = 0; _i < 2; ++_i) \
        __builtin_amdgcn_global_load_lds((const unsigned*)((const char*)(gbase) + (voff)[_i]), (PG8_LAS unsigned*)(lds + (bufoff) + ldsw + _i * 8192), 16, 0, 0); } while (0)
#define PG8_LDA(dst, b, h) do { _Pragma("unroll") for (int m = 0; m < 4; ++m) _Pragma("unroll") for (int k = 0; k < 2; ++k) dst[m][k] = *(const PG8_LAS bf16x8*)(lds + PG8_SA(b, h) + aoff + m * 2048 + k * 1024); } while (0)
#define PG8_LDB(dst, b, h) do { _Pragma("unroll") for (int n = 0; n < 2; ++n) _Pragma("unroll") for (int k = 0; k < 2; ++k) dst[n][k] = *(const PG8_LAS bf16x8*)(lds + PG8_SB(b, h) + boff + n * 2048 + k * 1024); } while (0)
#define PG8_MMA(ai, bj, At, Bt) do { __builtin_amdgcn_s_setprio(1); _Pragma("unroll") for (int m = 0; m < 4; ++m) _Pragma("unroll") for (int n = 0; n < 2; ++n) _Pragma("unroll") for (int k = 0; k < 2; ++k) \
        acc[ai][bj][m][n] = __builtin_amdgcn_mfma_f32_16x16x32_bf16(Bt[n][k], At[m][k], acc[ai][bj][m][n], 0, 0, 0); __builtin_amdgcn_s_setprio(0); } while (0)
#define PG8_WAIT_V(n) asm volatile("s_waitcnt vmcnt(" #n ")" ::: "memory")
#define PG8_WAIT_L(n) asm volatile("s_waitcnt lgkmcnt(" #n ")" ::: "memory")
#define PG8_BAR __builtin_amdgcn_s_barrier()
#define PG8_SCHED __builtin_amdgcn_sched_barrier(0)
    Unit cur, nxt; int ui = 0;
    if (!S.next(0, cur)) return;
    f32x4 acc[2][2][4][2];
#pragma unroll
    for (int a = 0; a < 2; ++a)
#pragma unroll
        for (int b = 0; b < 2; ++b)
#pragma unroll
            for (int m = 0; m < 4; ++m)
#pragma unroll
                for (int n = 0; n < 2; ++n) acc[a][b][m][n] = (f32x4){0.f, 0.f, 0.f, 0.f};
    bf16x8 At[4][2], B0[2][2], B1[2][2];
    const char* cA = (const char*)g.A + (size_t)cur.pm * tstepA; const char* cB = (const char*)g.Bt + (size_t)cur.pn * tstepB;
    S.a_ready(cur);
    E.prefetch_sync(cur, tid, lds, 0); E.prefetch_dma(cur, wid, lane, lds, 0);
#if GEMM_SP2
    PG8_STAGE(PG8_SB(0, 0), cB, voffB); PG8_STAGE(PG8_SB(0, 1), cB + hstepB, voffB); PG8_STAGE(PG8_SA(0, 0), cA, voffA); PG8_STAGE(PG8_SA(0, 1), cA + hstepA, voffA);
    if (wr == 1) PG8_BAR;
    PG8_WAIT_V(2); PG8_BAR;
    PG8_STAGE(PG8_SB(1, 0), cB + kstep, voffB); PG8_STAGE(PG8_SA(1, 0), cA + kstep, voffA); PG8_STAGE(PG8_SB(1, 1), cB + hstepB + kstep, voffB);
    PG8_WAIT_V(6); PG8_BAR;
#else
    PG8_STAGE(PG8_SB(0, 0), cB, voffB); PG8_STAGE(PG8_SA(0, 0), cA, voffA); PG8_STAGE(PG8_SB(0, 1), cB + hstepB, voffB); PG8_STAGE(PG8_SA(0, 1), cA + hstepA, voffA);
    if (wr == 1) PG8_BAR;
    PG8_WAIT_V(4); PG8_BAR;
    PG8_STAGE(PG8_SB(1, 0), cB + kstep, voffB); PG8_STAGE(PG8_SA(1, 0), cA + kstep, voffA); PG8_STAGE(PG8_SB(1, 1), cB + hstepB + kstep, voffB);
    PG8_WAIT_V(6); PG8_BAR;
#endif
    for (;;) {
        const bool has_next = S.next(ui + 1, nxt);
        const char* nA = has_next ? (const char*)g.A + (size_t)nxt.pm * tstepA : cA; const char* nB = has_next ? (const char*)g.Bt + (size_t)nxt.pn * tstepB : cB;
        for (int t = 0; t < nt; t += 2) {
            const bool last = (t == nt - 2);
            const char* a1 = cA + (size_t)(t + 1) * kstep;
            const char* a2 = last ? nA : cA + (size_t)(t + 2) * kstep; const char* b2 = last ? nB : cB + (size_t)(t + 2) * kstep;
            const char* a3 = a2 + kstep; const char* b3 = b2 + kstep;
            if (last && has_next) { S.a_ready(nxt); E.prefetch_dma(nxt, wid, lane, lds, (ui + 1) & 1); }
#if GEMM_SP2
            PG8_LDB(B0, 0, 0); PG8_LDB(B1, 0, 1); PG8_SCHED; PG8_LDA(At, 0, 0); PG8_STAGE(PG8_SA(1, 1), a1 + hstepA, voffA);
            PG8_WAIT_V(8); PG8_WAIT_L(0); PG8_BAR; PG8_MMA(0, 0, At, B0); PG8_MMA(0, 1, At, B1); PG8_BAR; PG8_SCHED;
            PG8_LDA(At, 0, 1); PG8_STAGE(PG8_SB(0, 0), b2, voffB); PG8_STAGE(PG8_SB(0, 1), b2 + hstepB, voffB); PG8_STAGE(PG8_SA(0, 0), a2, voffA);
            PG8_WAIT_V(8); PG8_WAIT_L(0); PG8_BAR; PG8_MMA(1, 0, At, B0); PG8_MMA(1, 1, At, B1); PG8_BAR; PG8_SCHED;
            PG8_LDB(B0, 1, 0); PG8_LDB(B1, 1, 1); PG8_SCHED; PG8_LDA(At, 1, 0); PG8_STAGE(PG8_SA(0, 1), a2 + hstepA, voffA);
            PG8_WAIT_V(8); PG8_WAIT_L(0); PG8_BAR; PG8_MMA(0, 0, At, B0); PG8_MMA(0, 1, At, B1); PG8_BAR; PG8_SCHED;
            PG8_LDA(At, 1, 1); PG8_STAGE(PG8_SB(1, 0), b3, voffB); PG8_STAGE(PG8_SB(1, 1), b3 + hstepB, voffB); PG8_STAGE(PG8_SA(1, 0), a3, voffA);
            PG8_WAIT_V(8); PG8_WAIT_L(0); PG8_BAR; PG8_MMA(1, 0, At, B0); PG8_MMA(1, 1, At, B1); PG8_BAR; PG8_SCHED;
#else
            PG8_LDB(B0, 0, 0); PG8_SCHED; PG8_LDA(At, 0, 0); PG8_STAGE(PG8_SA(1, 1), a1 + hstepA, voffA);
            PG8_WAIT_L(8); PG8_BAR; PG8_WAIT_L(0); PG8_MMA(0, 0, At, B0); PG8_BAR; PG8_SCHED;
            PG8_LDB(B1, 0, 1); PG8_STAGE(PG8_SB(0, 0), b2, voffB);
            PG8_BAR; PG8_WAIT_L(0); PG8_MMA(0, 1, At, B1); PG8_BAR;
            PG8_LDA(At, 0, 1); PG8_STAGE(PG8_SA(0, 0), a2, voffA);
            PG8_BAR; PG8_WAIT_L(0); PG8_MMA(1, 0, At, B0); PG8_BAR; PG8_SCHED;
            PG8_STAGE(PG8_SB(0, 1), b2 + hstepB, voffB);
            PG8_WAIT_V(6); PG8_BAR; PG8_MMA(1, 1, At, B1); PG8_BAR;
            PG8_LDB(B0, 1, 0); PG8_SCHED; PG8_LDA(At, 1, 0); PG8_STAGE(PG8_SA(0, 1), a2 + hstepA, voffA);
            PG8_WAIT_L(8); PG8_BAR; PG8_WAIT_L(0); PG8_MMA(0, 0, At, B0); PG8_BAR; PG8_SCHED;
            PG8_LDB(B1, 1, 1); PG8_STAGE(PG8_SB(1, 0), b3, voffB);
            PG8_BAR; PG8_WAIT_L(0); PG8_MMA(0, 1, At, B1); PG8_BAR;
            PG8_LDA(At, 1, 1); PG8_STAGE(PG8_SA(1, 0), a3, voffA);
            PG8_BAR; PG8_WAIT_L(0); PG8_MMA(1, 0, At, B0); PG8_BAR; PG8_SCHED;
            PG8_STAGE(PG8_SB(1, 1), b3 + hstepB, voffB);
            PG8_WAIT_V(6); PG8_BAR; PG8_MMA(1, 1, At, B1); PG8_BAR;
#endif
        }
        if constexpr (ALIGN_EPI) { if (wr == 0) PG8_BAR; }
        E(acc, cur, wr, wc, fr, fq, lds, ui & 1);
#if defined(PROBE_EPI)
        if constexpr ((Epi::KIND & PROBE_EPI) != 0) { for (int er_ = 1; er_ < PROBE_EPI_REP; ++er_) E(acc, cur, wr, wc, fr, fq, lds, ui & 1); }
#endif
        if (!has_next) break;
#pragma unroll
        for (int a = 0; a < 2; ++a)
#pragma unroll
            for (int b = 0; b < 2; ++b)
#pragma unroll
                for (int m = 0; m < 4; ++m)
#pragma unroll
                    for (int n = 0; n < 2; ++n) acc[a][b][m][n] = (f32x4){0.f, 0.f, 0.f, 0.f};
        cur = nxt; cA = nA; cB = nB; ++ui;
        E.prefetch_sync(cur, tid, lds, ui & 1);
        if constexpr (ALIGN_EPI) { if (wr == 1) PG8_BAR; }
    }
    PG8_WAIT_V(0);
    if constexpr (!ALIGN_EPI) { if (wr == 0) PG8_BAR; }
    PG8_BAR;
#undef PG8_SA
#undef PG8_SB
#undef PG8_STAGE
#undef PG8_LDA
#undef PG8_LDB
#undef PG8_MMA
#undef PG8_WAIT_V
#undef PG8_WAIT_L
#undef PG8_BAR
#undef PG8_SCHED
}
}
constexpr int NWAVES = 8, NTHR = 512;
constexpr int D = 1024, TCTX = 8192, TSMP = 2048, T = 10240, TP = T + 512;
constexpr int DFF = 2816, NMODV = 9 * 1024;
constexpr int EVEN_NP = 2816, ODD_NP = 1792;
constexpr float EPS = 1e-6f;
constexpr int NCHUNK = 80;

constexpr size_t MiB = 1u << 20;
constexpr size_t WS_CTL = 0, CTL_ZERO_BYTES = 64 * 1024;
constexpr size_t WS_MOD = 1 * MiB;
constexpr size_t WS_ROPE = WS_MOD + 512 * 1024;
constexpr size_t WS_DEC = WS_ROPE + 160 * 1024;
constexpr size_t WS_SSQ = WS_MOD + 768 * 1024;
constexpr size_t WS_BIAS = 2 * MiB;
constexpr size_t BIAS_LD = 5632, BIAS_MS = 16 * BIAS_LD;
constexpr size_t WS_BIASF = 15 * MiB;
constexpr size_t WS_WGU = 16 * MiB;
constexpr size_t SZ_WGU = (size_t)5632 * 1024 * 2;
constexpr size_t WS_WD = WS_WGU + 8 * SZ_WGU;
constexpr size_t SZ_WD = (size_t)1024 * 2816 * 2;
constexpr size_t WS_WIE = WS_WD + 8 * SZ_WD;
constexpr size_t SZ_WIE = (size_t)EVEN_NP * 1024 * 2;
constexpr size_t WS_WOE = WS_WIE + 2 * SZ_WIE;
constexpr size_t SZ_WO = (size_t)1024 * 1024 * 2;
constexpr size_t WS_WIO = WS_WOE + 2 * SZ_WO;
constexpr size_t SZ_WIO = (size_t)ODD_NP * 1024 * 2;
constexpr size_t WS_WOO = WS_WIO + 2 * SZ_WIO;
constexpr size_t WS_WUQ = WS_WOO + 2 * SZ_WO;
constexpr size_t SZ_WUQ = (size_t)768 * 384 * 2;
constexpr size_t WS_WKV = WS_WUQ + 2 * SZ_WUQ;
constexpr size_t SZ_WKV = (size_t)1024 * 256 * 2;
constexpr size_t WS_WEND = WS_WKV + 2 * SZ_WKV;
constexpr size_t WS_X = (WS_WEND + MiB - 1) / MiB * MiB;
constexpr size_t WS_XA = WS_X + (size_t)T * D * 4;
constexpr size_t WS_PROJ = WS_XA + (size_t)T * D * 2;
constexpr size_t WS_YMIX = WS_PROJ + (size_t)T * EVEN_NP * 2;
constexpr size_t WS_H = WS_YMIX + (size_t)T * D * 2;
constexpr size_t WS_ST = WS_H;
constexpr size_t WS_QA = WS_H;
constexpr size_t WS_CKVA = WS_QA + (size_t)T * 384 * 2;
constexpr size_t WS_KR = WS_CKVA + (size_t)TP * 256 * 2;
constexpr size_t WS_Q = WS_KR + (size_t)TP * 32 * 2;
constexpr size_t WS_KN = WS_Q + (size_t)T * 768 * 2;
constexpr size_t WS_VT = WS_KN + (size_t)TP * 512 * 2;
constexpr size_t WS_HEND = WS_H + (size_t)T * DFF * 2;
static_assert(WS_VT + (size_t)512 * TP * 2 <= WS_HEND, "odd-layer scratch fits the H overlay");
static_assert(WS_ST + (size_t)NCHUNK * 8 * 2 * 8192 * 4 <= WS_HEND, "chunk states fit the H overlay");
constexpr size_t WS_XCT = WS_HEND;
constexpr size_t WS_CC = WS_XCT + (size_t)NCHUNK * 8 * 8192 * 2;
constexpr size_t WS_CBM = WS_CC + (size_t)T * 256 * 2;
constexpr size_t WS_HIN = WS_CBM + (size_t)NCHUNK * 2 * 16384 * 2;
constexpr size_t WS_END = WS_HIN + (size_t)NCHUNK * 8 * 2 * 8192 * 2;

constexpr size_t OUT_Y = 0, OUT_SSD = (size_t)T * D, OUT_CKV = OUT_SSD + (size_t)32 * 2 * 2 * 8 * 64 * 128, OUT_KR = OUT_CKV + (size_t)32 * 2 * 256 * 256, OUT_END = OUT_KR + (size_t)32 * 2 * 256 * 32;

constexpr int RING_BYTES = 131072;
constexpr int LDSCTL_OFF = 144 * 1024 - 512, MISC_OFF = LDSCTL_OFF + 320;
constexpr int LDS_BYTES = 147456;

#define GAS __attribute__((address_space(1)))
#define LAS __attribute__((address_space(3)))
typedef unsigned short bf16;
typedef unsigned v4u __attribute__((ext_vector_type(4)));
typedef unsigned v2u __attribute__((ext_vector_type(2)));
typedef float f32x4 __attribute__((ext_vector_type(4)));
typedef short bf16x8 __attribute__((ext_vector_type(8)));
typedef GAS unsigned gu32;
#define RLX_AGENT __ATOMIC_RELAXED, __HIP_MEMORY_SCOPE_AGENT
__device__ __forceinline__ unsigned f2bf(float f) { unsigned u = __builtin_bit_cast(unsigned, f); return (u + 0x7fffu + ((u >> 16) & 1u)) >> 16; }
typedef float f32x2_t __attribute__((ext_vector_type(2)));
typedef __bf16 bf16x2_t __attribute__((ext_vector_type(2)));
__device__ __forceinline__ unsigned pk2(float lo, float hi) { const f32x2_t v = {lo, hi}; const bf16x2_t b = __builtin_convertvector(v, bf16x2_t); return __builtin_bit_cast(unsigned, b); }
__device__ __forceinline__ unsigned f2bf1(float f) { return pk2(f, 0.f) & 0xffffu; }
__device__ __forceinline__ float bflo(unsigned w) { return __builtin_bit_cast(float, w << 16); }
__device__ __forceinline__ float bfhi(unsigned w) { return __builtin_bit_cast(float, w & 0xffff0000u); }
__device__ __forceinline__ float bf1(bf16 h) { return __builtin_bit_cast(float, ((unsigned)h) << 16); }
__device__ __forceinline__ void unpack8(const v4u v, float* o) { o[0] = bflo(v.x); o[1] = bfhi(v.x); o[2] = bflo(v.y); o[3] = bfhi(v.y); o[4] = bflo(v.z); o[5] = bfhi(v.z); o[6] = bflo(v.w); o[7] = bfhi(v.w); }
__device__ __forceinline__ v4u pack8(const float* o) { v4u v; v.x = pk2(o[0], o[1]); v.y = pk2(o[2], o[3]); v.z = pk2(o[4], o[5]); v.w = pk2(o[6], o[7]); return v; }
template <int K> __device__ __forceinline__ float xlane(float v) { static_assert(K >= 1 && K < 32, "xor mask inside a 32-lane half");
    return __builtin_bit_cast(float, __builtin_amdgcn_ds_swizzle(__builtin_bit_cast(int, v), (K << 10) | 0x1F)); }
__device__ __forceinline__ float sum_x32(float v) { const unsigned u = __builtin_bit_cast(unsigned, v); const auto r = __builtin_amdgcn_permlane32_swap(u, u, false, false);
    return __builtin_bit_cast(float, (unsigned)r[0]) + __builtin_bit_cast(float, (unsigned)r[1]); }
__device__ __forceinline__ float max_x32(float v) { const unsigned u = __builtin_bit_cast(unsigned, v); const auto r = __builtin_amdgcn_permlane32_swap(u, u, false, false);
    return fmaxf(__builtin_bit_cast(float, (unsigned)r[0]), __builtin_bit_cast(float, (unsigned)r[1])); }
__device__ __forceinline__ float wave_sum(float v) {
    v += xlane<1>(v); v += xlane<2>(v); v += xlane<4>(v); v += xlane<8>(v); v += xlane<16>(v);
    return sum_x32(v);
}
__device__ __forceinline__ float frcp(float x) { return __builtin_amdgcn_rcpf(x); }
__device__ __forceinline__ float frsq(float x) { return __builtin_amdgcn_rsqf(x); }
__device__ __forceinline__ float sigmoidf_(float x) { return frcp(1.0f + __expf(-x)); }
__device__ __forceinline__ float siluf_(float x) { return x * frcp(1.0f + __expf(-x)); }
__device__ __forceinline__ float gelu_tanh(float x) { const float y = 0.7978845608028654f * (x + 0.044715f * x * x * x); const float t = 1.0f - 2.0f * frcp(1.0f + __expf(2.0f * y)); return 0.5f * x * (1.0f + t); }
__device__ __forceinline__ float softplusf_(float x) { const float e = __expf(x); return x > 20.f ? x : (e < 1e-3f ? e * (1.0f - 0.5f * e) : __logf(1.0f + e)); }
__device__ __forceinline__ int modrow_of_tile(int pm) { return pm < 32 ? 0 : 1 + ((pm - 32) >> 2); }
__device__ __forceinline__ int modrow_of_tok(int t) { return t < TCTX ? 0 : 1 + ((t - TCTX) >> 10); }

#define XB_TMO      128
#define XB_XCNT(j)  (256  + 64 * (j))
#define XB_XSUB(j)  (1280 + 64 * (j))
#define XB_XGEN(j)  (2304 + 64 * (j))
#define XB_TOP      3328
#define XB_TOPGEN   3392
#define XCD_BAR_WORDS 3456
#define XB_SPIN_CAP (1u << 22)
__device__ __forceinline__ unsigned xb_ld(unsigned* p)              { return __hip_atomic_load(p, __ATOMIC_RELAXED, __HIP_MEMORY_SCOPE_AGENT); }
__device__ __forceinline__ unsigned xb_add(unsigned* p, unsigned v) { return __hip_atomic_fetch_add(p, v, __ATOMIC_RELAXED, __HIP_MEMORY_SCOPE_AGENT); }
__device__ __forceinline__ unsigned xb_xcc_id() { return (unsigned)__builtin_amdgcn_s_getreg((3 << 11) | 20) & 0xFu; }
#define XB_SPIN(cond, bar) do { unsigned _sp = 0; while (cond) { __builtin_amdgcn_s_sleep(1); \
    if ((++_sp & 255u) == 0u) { if (xb_ld(&(bar)[XB_TMO])) break; if (_sp > XB_SPIN_CAP) { atomicAdd(&(bar)[XB_TMO], 1u); break; } } } } while (0)
struct XcdBarrier { unsigned* bar; unsigned x; volatile LAS unsigned* st; };
__device__ __forceinline__ XcdBarrier xcd_barrier_post(unsigned* bar, volatile LAS unsigned* st) {
    XcdBarrier b; b.bar = bar; b.x = xb_xcc_id(); b.st = st;
    if (threadIdx.x == 0) (void)xb_add(&bar[XB_XCNT(b.x)], 1u);
    return b;
}
__device__ __forceinline__ void xcd_barrier_complete(unsigned* bar, unsigned x, unsigned& nloc, unsigned& nx) {
    const unsigned G = gridDim.x * gridDim.y * gridDim.z;
    unsigned sum, cnt, mine, sp = 0u;
    for (;;) {
        sum = 0u; cnt = 0u; mine = 0u;
#pragma unroll
        for (unsigned j = 0; j < 16; ++j) { const unsigned c = xb_ld(&bar[XB_XCNT(j)]); sum += c; cnt += (c > 0u) ? 1u : 0u; mine = (j == x) ? c : mine; }
        if (sum == G) break;
        __builtin_amdgcn_s_sleep(1);
        if ((++sp & 255u) == 0u) { if (xb_ld(&bar[XB_TMO])) break; if (sp > XB_SPIN_CAP) { atomicAdd(&bar[XB_TMO], 1u); break; } }
    }
    nloc = mine > 0u ? mine : 1u; nx = cnt > 0u ? cnt : 1u;
}
__device__ __forceinline__ void xcd_barrier(const XcdBarrier& b) {
    asm volatile("s_waitcnt vmcnt(0)" ::: "memory");
    __syncthreads();
    if (threadIdx.x == 0) {
        unsigned* bar = b.bar;
        __builtin_amdgcn_s_waitcnt(0);
        unsigned nloc = b.st[0], nx = b.st[1];
        if (nloc == 0u) { xcd_barrier_complete(bar, b.x, nloc, nx); b.st[0] = nloc; b.st[1] = nx; }
        const unsigned k = b.st[2] + 1u; b.st[2] = k;
        const unsigned old = xb_add(&bar[XB_XSUB(b.x)], 1u);
        if (old + 1u == k * nloc) {
            __builtin_amdgcn_fence(__ATOMIC_RELEASE, "agent");
            asm volatile("s_waitcnt vmcnt(0)" ::: "memory");
            const unsigned og = xb_add(&bar[XB_TOP], 1u);
            if (og + 1u == k * nx) xb_add(&bar[XB_TOPGEN], 1u);
        }
        XB_SPIN(xb_ld(&bar[XB_TOPGEN]) < k, bar);
        __builtin_amdgcn_fence(__ATOMIC_ACQUIRE, "agent");
        asm volatile("s_waitcnt vmcnt(0)" ::: "memory");
    }
    __syncthreads();
}

struct Args { const float* in[34]; float* out; unsigned char* ws; int ph_lo, ph_hi, li, pad; };
typedef const __attribute__((address_space(4))) Args* CArgsP;
enum { I_XP = 0, I_XS, I_SSD, I_CCKV, I_CKR, I_C, I_CCTX, I_WMOD, I_BMOD, I_GNORM, I_WGU, I_WDN, I_WIE, I_WOE, I_WSP, I_BSP, I_GV, I_WCS, I_BCS, I_DTB, I_ALOG, I_DSK, I_GSO,
       I_WIO, I_WOO, I_GCQ, I_WUQ, I_GCKV, I_WUKV, I_WDW, I_BDW, I_GLN, I_BLN, I_GFIN };
using pg8::Unit;
constexpr int EP_PART = RING_BYTES, EP_S = RING_BYTES + 4096, EP_B = RING_BYTES + 4096 + 8192;
__device__ __forceinline__ void epi_prefetch_dma(GAS unsigned char* ws, int bias_off, const Unit& u, int wid, int lane, PG8_LAS unsigned char* ldsl, int par) {
    if (wid < 4) __builtin_amdgcn_global_load_lds((const GAS unsigned*)(ws + WS_SSQ + ((size_t)(u.pm * 256 + 64 * wid + lane) * 4) * 4), (PG8_LAS unsigned*)(ldsl + EP_S + par * 4096 + wid * 1024), 16, 0, 0);
    else if (wid == 4) __builtin_amdgcn_global_load_lds((const GAS unsigned*)(ws + WS_BIASF + ((size_t)bias_off / 16 + (size_t)modrow_of_tile(u.pm) * BIAS_LD + u.pn * 256 + 4 * lane) * 4), (PG8_LAS unsigned*)(ldsl + EP_B + par * 1024), 16, 0, 0);
}
__device__ __forceinline__ void epi_prefetch_sync16(GAS unsigned char* ws, int bias_off, const Unit& u, int tid, PG8_LAS unsigned char* ldsl, int par) {
    if (tid < 256) *(PG8_LAS pg8::f32x4*)(ldsl + EP_S + par * 4096 + tid * 16) = *(const GAS pg8::f32x4*)(ws + WS_SSQ + ((size_t)(u.pm * 256 + tid) * 4) * 4);
    else { const GAS float* bp = (const GAS float*)(ws + WS_BIAS) + (size_t)bias_off + (size_t)modrow_of_tile(u.pm) * BIAS_MS + u.pn * 256 + (tid - 256); float b = 0.f;
#pragma unroll
        for (int kb = 0; kb < 16; ++kb) b += bp[(size_t)kb * BIAS_LD];
        ((PG8_LAS float*)(ldsl + EP_B))[par * 256 + (tid - 256)] = b; }
}
__device__ __forceinline__ float epi_row_rstd(const PG8_LAS unsigned char* ldsl, int par, int rl) { const pg8::f32x4 s = *(const PG8_LAS pg8::f32x4*)(ldsl + EP_S + par * 4096 + rl * 16); return frsq(((s[0] + s[1]) + (s[2] + s[3])) * (1.f / D) + EPS); }
struct EpiSwiglu {
    static constexpr bool PERM = true; static constexpr int KIND = 1;
    GAS unsigned char* ws; int bias_off, nparts;
    __device__ __forceinline__ void prefetch_dma(const Unit& u, int wid, int lane, PG8_LAS unsigned char* ldsl, int par) const { if (nparts == 1) epi_prefetch_dma(ws, bias_off, u, wid, lane, ldsl, par); }
    __device__ __forceinline__ void prefetch_sync(const Unit& u, int tid, PG8_LAS unsigned char* ldsl, int par) const { if (nparts != 1) epi_prefetch_sync16(ws, bias_off, u, tid, ldsl, par); }
    __device__ __forceinline__ void operator()(const pg8::f32x4 (&acc)[2][2][4][2], const Unit& u, int wr, int wc, int fr, int fq, PG8_LAS unsigned char* ldsl, int par) const {
        bf16* H = (bf16*)(GAS bf16*)(ws + WS_H);
        const PG8_LAS float* bb = (const PG8_LAS float*)(ldsl + EP_B) + par * 256 + wc * 32 + 8 * fq;
        const int row0 = u.pm * 256 + wr * 64 + fr, col0 = u.pn * 128 + wc * 32 + 8 * fq;
        const pg8::f32x4 bg0 = *(const PG8_LAS pg8::f32x4*)bb, bg1 = *(const PG8_LAS pg8::f32x4*)(bb + 4), bu0 = *(const PG8_LAS pg8::f32x4*)(bb + 128), bu1 = *(const PG8_LAS pg8::f32x4*)(bb + 132);
#pragma unroll
        for (int ai = 0; ai < 2; ++ai)
#pragma unroll
            for (int m = 0; m < 4; ++m) {
                const int rl = ai * 128 + wr * 64 + m * 16 + fr;
                const float rs = epi_row_rstd(ldsl, par, rl);
                bf16* rowp = H + (size_t)(u.pm * 256 + rl) * DFF + col0;
                const pg8::f32x4 g0 = acc[ai][0][m][0] * rs + bg0, g1 = acc[ai][0][m][1] * rs + bg1, u0 = acc[ai][1][m][0] * rs + bu0, u1 = acc[ai][1][m][1] * rs + bu1;
                float gg[8], uu[8], e[8], o[8];
#pragma unroll
                for (int j = 0; j < 4; ++j) { gg[j] = g0[j]; gg[4 + j] = g1[j]; uu[j] = u0[j]; uu[4 + j] = u1[j]; }
#pragma unroll
                for (int j = 0; j < 8; ++j) e[j] = __builtin_amdgcn_exp2f(gg[j] * -1.4426950408889634f);
#pragma unroll
                for (int j = 0; j < 8; ++j) e[j] = __builtin_amdgcn_rcpf(1.0f + e[j]);
#pragma unroll
                for (int j = 0; j < 8; ++j) o[j] = (gg[j] * uu[j]) * e[j];
                pg8::u32x4 w; w.x = pg8::cvt_pk_bf16(o[0], o[1]); w.y = pg8::cvt_pk_bf16(o[2], o[3]); w.z = pg8::cvt_pk_bf16(o[4], o[5]); w.w = pg8::cvt_pk_bf16(o[6], o[7]);
                *(pg8::u32x4*)rowp = w;
            }
        (void)row0;
    }
};
struct EpiResid {
    static constexpr bool PERM = true; static constexpr int KIND = 4;
    GAS unsigned char* ws; const float* gn; int gate_off, scn_off; float coef;
    __device__ __forceinline__ void prefetch_dma(const Unit&, int, int, PG8_LAS unsigned char*, int) const {}
    __device__ __forceinline__ void prefetch_sync(const Unit&, int, PG8_LAS unsigned char*, int) const {}
    __device__ __forceinline__ void operator()(const pg8::f32x4 (&acc)[2][2][4][2], const Unit& u, int wr, int wc, int fr, int fq, PG8_LAS unsigned char* ldsl, int) const {
        bf16* X = (bf16*)(GAS bf16*)(ws + WS_X); const float* gate = (const float*)(const GAS float*)(ws + WS_MOD) + gate_off; const float* scn = (const float*)(const GAS float*)(ws + WS_MOD) + scn_off;
        bf16* XA = (bf16*)(GAS bf16*)(ws + WS_XA); float* SSQ = (float*)(GAS float*)(ws + WS_SSQ); PG8_LAS float* part = (PG8_LAS float*)(ldsl + EP_PART);
        const int row0 = u.pm * 256 + wr * 64 + fr, col0 = u.pn * 256 + wc * 32 + 8 * fq;
        const int mr = modrow_of_tile(u.pm);
        float ss[2][4];
#pragma unroll
        for (int ai = 0; ai < 2; ++ai)
#pragma unroll
            for (int m = 0; m < 4; ++m) ss[ai][m] = 0.f;
#pragma unroll
        for (int bj = 0; bj < 2; ++bj) {
            const int co = col0 + bj * 128;
            const float* gp = gate + (size_t)mr * NMODV + co; const float* sp = scn + (size_t)mr * NMODV + co;
            const pg8::f32x4 gv0 = *(const pg8::f32x4*)gp * coef, gv1 = *(const pg8::f32x4*)(gp + 4) * coef;
            const pg8::f32x4 gc0 = *(const pg8::f32x4*)(gn + co) * (*(const pg8::f32x4*)sp + 1.0f), gc1 = *(const pg8::f32x4*)(gn + co + 4) * (*(const pg8::f32x4*)(sp + 4) + 1.0f);
#pragma unroll
            for (int ai = 0; ai < 2; ++ai) {
                pg8::u32x4 xo[4];
#pragma unroll
                for (int m = 0; m < 4; ++m) xo[m] = *(const pg8::u32x4*)(X + (size_t)(row0 + ai * 128 + m * 16) * D + co);
#pragma unroll
                for (int m = 0; m < 4; ++m) {
                    const size_t off = (size_t)(row0 + ai * 128 + m * 16) * D + co;
                    const pg8::u32x4 xw = xo[m];
                    const pg8::f32x4 x0 = {bflo(xw.x), bfhi(xw.x), bflo(xw.y), bfhi(xw.y)}, x1 = {bflo(xw.z), bfhi(xw.z), bflo(xw.w), bfhi(xw.w)};
                    const pg8::f32x4 n0 = x0 + gv0 * acc[ai][bj][m][0], n1 = x1 + gv1 * acc[ai][bj][m][1];
                    ss[ai][m] += ((n0[0] * n0[0] + n0[1] * n0[1]) + (n0[2] * n0[2] + n0[3] * n0[3])) + ((n1[0] * n1[0] + n1[1] * n1[1]) + (n1[2] * n1[2] + n1[3] * n1[3]));
                    pg8::u32x4 w; w.x = pg8::cvt_pk_bf16(n0[0], n0[1]); w.y = pg8::cvt_pk_bf16(n0[2], n0[3]); w.z = pg8::cvt_pk_bf16(n1[0], n1[1]); w.w = pg8::cvt_pk_bf16(n1[2], n1[3]);
                    *(pg8::u32x4*)(X + off) = w;
                    const pg8::f32x4 a0 = n0 * gc0, a1 = n1 * gc1;
                    pg8::u32x4 v; v.x = pg8::cvt_pk_bf16(a0[0], a0[1]); v.y = pg8::cvt_pk_bf16(a0[2], a0[3]); v.z = pg8::cvt_pk_bf16(a1[0], a1[1]); v.w = pg8::cvt_pk_bf16(a1[2], a1[3]);
                    *(pg8::u32x4*)(XA + off) = v;
                }
            }
        }
#pragma unroll
        for (int ai = 0; ai < 2; ++ai)
#pragma unroll
            for (int m = 0; m < 4; ++m) { float s = ss[ai][m]; s += xlane<16>(s); s = sum_x32(s);
                if (fq == 0) part[wc * 256 + ai * 128 + wr * 64 + m * 16 + fr] = s; }
        asm volatile("s_waitcnt lgkmcnt(0)" ::: "memory"); __builtin_amdgcn_s_barrier(); asm volatile("" ::: "memory");
        const int t = (wr * 4 + wc) * 64 + fq * 16 + fr;
        if (t < 256) SSQ[(size_t)(u.pm * 256 + t) * 4 + u.pn] = (part[t] + part[256 + t]) + (part[512 + t] + part[768 + t]);
    }
};
struct EpiStore {
    static constexpr bool PERM = true; static constexpr int KIND = 2;
    GAS unsigned char* ws; unsigned o_off; int ldc; int bias_off;
    __device__ __forceinline__ void prefetch_dma(const Unit& u, int wid, int lane, PG8_LAS unsigned char* ldsl, int par) const { if (bias_off >= 0) epi_prefetch_dma(ws, bias_off, u, wid, lane, ldsl, par); }
    __device__ __forceinline__ void prefetch_sync(const Unit&, int, PG8_LAS unsigned char*, int) const {}
    __device__ __forceinline__ void operator()(const pg8::f32x4 (&acc)[2][2][4][2], const Unit& u, int wr, int wc, int fr, int fq, PG8_LAS unsigned char* ldsl, int par) const {
        bf16* O = (bf16*)(GAS bf16*)(ws + o_off);
        const PG8_LAS float* bb = (const PG8_LAS float*)(ldsl + EP_B) + par * 256 + wc * 32 + 8 * fq;
        const int col0 = u.pn * 256 + wc * 32 + 8 * fq; const bool nrm = bias_off >= 0;
        pg8::f32x4 b[2][2];
#pragma unroll
        for (int bj = 0; bj < 2; ++bj)
#pragma unroll
            for (int n = 0; n < 2; ++n) { const pg8::f32x4 bv = *(const PG8_LAS pg8::f32x4*)(bb + bj * 128 + 4 * n); b[bj][n] = nrm ? bv : (pg8::f32x4){0.f, 0.f, 0.f, 0.f}; }
#pragma unroll
        for (int ai = 0; ai < 2; ++ai)
#pragma unroll
            for (int m = 0; m < 4; ++m) {
                const int rl = ai * 128 + wr * 64 + m * 16 + fr;
                const float rs0 = epi_row_rstd(ldsl, par, rl), rs = nrm ? rs0 : 1.0f;
                bf16* rowp = O + (size_t)(u.pm * 256 + rl) * ldc + col0;
#pragma unroll
                for (int bj = 0; bj < 2; ++bj) {
                    const pg8::f32x4 v0 = acc[ai][bj][m][0] * rs + b[bj][0], v1 = acc[ai][bj][m][1] * rs + b[bj][1];
                    pg8::u32x4 w; w.x = pg8::cvt_pk_bf16(v0[0], v0[1]); w.y = pg8::cvt_pk_bf16(v0[2], v0[3]); w.z = pg8::cvt_pk_bf16(v1[0], v1[1]); w.w = pg8::cvt_pk_bf16(v1[2], v1[3]);
                    *(pg8::u32x4*)(rowp + bj * 128) = w;
                }
            }
    }
};

struct Frame {
    unsigned char* lds;
    mutable int tid, lane; int wave, bid, G;
    __device__ __forceinline__ void relane() const { int ln; asm volatile("v_mbcnt_lo_u32_b32 %0, -1, 0\n\tv_mbcnt_hi_u32_b32 %0, -1, %0" : "=v"(ln)); lane = ln; tid = wave * 64 + ln; }
    CArgsP a;
    GAS unsigned char* ws;
};
#define WSP(type, off) ((type*)(GAS type*)(F.ws + (off)))
#define AIN(i) ((const float*)(const GAS float*)F.a->in[i])
#define AOUT ((float*)(GAS float*)F.a->out)

__device__ __forceinline__ void p0_transpose_item(const float* W, int N, bf16* WT, int ldt, int k0, int n0, int dst_row0, float* scr, int lane, const float* shift, float* bias_out) {
    const int n4 = (lane & 7) * 4; const bool ok4 = n0 + n4 < N;
#pragma unroll
    for (int i = 0; i < 8; ++i) { const int kk = 8 * i + (lane >> 3);
        const f32x4 v = ok4 ? *(const f32x4*)(W + (size_t)(k0 + kk) * N + n0 + n4) : (f32x4){0.f, 0.f, 0.f, 0.f};
        scr[kk * 33 + n4] = v.x; scr[kk * 33 + n4 + 1] = v.y; scr[kk * 33 + n4 + 2] = v.z; scr[kk * 33 + n4 + 3] = v.w; }
    if (bias_out) {
#pragma unroll
        for (int m = 0; m < 3; ++m) scr[64 * 33 + m * 64 + lane] = shift[(size_t)m * NMODV + lane];
    }
    asm volatile("s_waitcnt lgkmcnt(0)" ::: "memory");
    const int c = lane & 7;
#pragma unroll
    for (int j = 0; j < 4; ++j) { const int nn = (lane >> 3) + 8 * j; const float* s = scr + (8 * c) * 33 + nn;
        v4u o; o.x = pk2(s[0 * 33], s[1 * 33]); o.y = pk2(s[2 * 33], s[3 * 33]); o.z = pk2(s[4 * 33], s[5 * 33]); o.w = pk2(s[6 * 33], s[7 * 33]);
        *(v4u*)(WT + (size_t)(dst_row0 + nn) * ldt + k0 + 8 * c) = o; }
    if (bias_out) {
        const int kh = lane >> 5, nl = lane & 31; float a0 = 0.f, a1 = 0.f, a2 = 0.f;
#pragma unroll 8
        for (int i = 0; i < 32; ++i) { const int kk = kh * 32 + i; const float wv = scr[kk * 33 + nl];
            a0 += wv * scr[64 * 33 + kk]; a1 += wv * scr[64 * 33 + 64 + kk]; a2 += wv * scr[64 * 33 + 128 + kk]; }
        a0 = sum_x32(a0); a1 = sum_x32(a1); a2 = sum_x32(a2);
        if (lane < 32) { float* bo = bias_out + (size_t)(k0 >> 6) * BIAS_LD + dst_row0 + nl; bo[0] = a0; bo[BIAS_MS] = a1; bo[2 * BIAS_MS] = a2; }
    }
    asm volatile("s_waitcnt lgkmcnt(0)" ::: "memory");
}
constexpr int CI_DN = 44 * 32, CI_OE = 16 * 32, CI_UQ = 6 * 24, CI_KV = 4 * 32, CI_GU = 16 * 176, CI_IE = 16 * 88, CI_IO = 16 * 56;
__host__ __device__ constexpr int conv_na(int l) { return 2 * CI_DN + CI_OE + ((l & 1) ? CI_UQ + CI_KV : 0); }
__host__ __device__ constexpr int conv_nb(int l) { return 2 * CI_GU + ((l & 1) ? CI_IO : CI_IE); }
__device__ __forceinline__ void conv_item_a(const Frame& F, int l, int it, float* scr) {
    int r = it; const int hi = l >> 1;
    if (r < 2 * CI_DN) { const int w = l * 2 + r / CI_DN, q = r % CI_DN, kb = q / 32, nb = q % 32;
        p0_transpose_item(AIN(I_WDN) + (size_t)w * DFF * 1024, 1024, WSP(bf16, WS_WD + w * SZ_WD), DFF, kb * 64, nb * 32, nb * 32, scr, F.lane, nullptr, nullptr); return; } r -= 2 * CI_DN;
    if (r < CI_OE) { const int kb = r / 32, nb = r % 32;
        if (l & 1) p0_transpose_item(AIN(I_WOO) + (size_t)hi * 1024 * 1024, 1024, WSP(bf16, WS_WOO + hi * SZ_WO), 1024, kb * 64, nb * 32, nb * 32, scr, F.lane, nullptr, nullptr);
        else       p0_transpose_item(AIN(I_WOE) + (size_t)hi * 1024 * 1024, 1024, WSP(bf16, WS_WOE + hi * SZ_WO), 1024, kb * 64, nb * 32, nb * 32, scr, F.lane, nullptr, nullptr);
        return; } r -= CI_OE;
    if (r < CI_UQ) { const int kb = r / 24, nb = r % 24;
        p0_transpose_item(AIN(I_WUQ) + (size_t)hi * 384 * 768, 768, WSP(bf16, WS_WUQ + hi * SZ_WUQ), 384, kb * 64, nb * 32, nb * 32, scr, F.lane, nullptr, nullptr); return; } r -= CI_UQ;
    { const int kb = r / 32, nb = r % 32, n0 = nb * 32, h = n0 >> 7, rr = n0 & 127;
        const int dst = (rr < 64 ? 0 : 512) + h * 64 + (rr & 63);
        p0_transpose_item(AIN(I_WUKV) + (size_t)hi * 256 * 1024, 1024, WSP(bf16, WS_WKV + hi * SZ_WKV), 256, kb * 64, n0, dst, scr, F.lane, nullptr, nullptr); }
}
__device__ __forceinline__ void conv_item_b(const Frame& F, int l, int it, float* scr) {
    int r = it; const int hi = l >> 1; const float* MOD = WSP(float, WS_MOD) + (size_t)l * 3 * NMODV; float* BIAS = WSP(float, WS_BIAS) + (size_t)(l * 3) * 3 * BIAS_MS;
    if (r < 2 * CI_GU) { const int f = r / CI_GU, w = l * 2 + f, q = r % CI_GU, kb = q / 176, nb = q % 176, n0 = nb * 32;
        const int dst = (n0 < DFF) ? ((n0 >> 7) * 256 + (n0 & 127)) : (((n0 - DFF) >> 7) * 256 + 128 + ((n0 - DFF) & 127));
        p0_transpose_item(AIN(I_WGU) + (size_t)w * 1024 * 5632, 5632, WSP(bf16, WS_WGU + w * SZ_WGU), 1024, kb * 64, n0, dst, scr, F.lane,
                          MOD + (f == 0 ? 0 : 6) * 1024 + kb * 64, BIAS + (size_t)(f == 0 ? 0 : 2) * 3 * BIAS_MS); return; } r -= 2 * CI_GU;
    if (l & 1) { const int kb = r / 56, nb = r % 56;
        p0_transpose_item(AIN(I_WIO) + (size_t)hi * 1024 * 1696, 1696, WSP(bf16, WS_WIO + hi * SZ_WIO), 1024, kb * 64, nb * 32, nb * 32, scr, F.lane, MOD + 3 * 1024 + kb * 64, BIAS + (size_t)3 * BIAS_MS); }
    else { const int kb = r / 88, nb = r % 88;
        p0_transpose_item(AIN(I_WIE) + (size_t)hi * 1024 * 2576, 2576, WSP(bf16, WS_WIE + hi * SZ_WIE), 1024, kb * 64, nb * 32, nb * 32, scr, F.lane, MOD + 3 * 1024 + kb * 64, BIAS + (size_t)3 * BIAS_MS); }
}
template <int N4> __device__ __forceinline__ void mod_tile(const Frame& F, int l, int tile) {
    constexpr int KG = 504 / N4, NC = 4 * N4;
    float* sv = (float*)F.lds;
    float* red = (float*)(F.lds + 12288);
    __syncthreads();
    for (int i = F.tid; i < 3072; i += NTHR) { const int r = i >> 10, k = i & 1023; const float c = (r == 0) ? AIN(I_CCTX)[k] : AIN(I_C)[(r - 1) * 1024 + k]; sv[i] = siluf_(c); }
    __syncthreads();
    const int n0 = tile * NC, n4 = F.tid % N4, kg = F.tid / N4;
    if (F.tid < 504) {
        f32x4 a0 = {0.f, 0.f, 0.f, 0.f}, a1 = a0, a2 = a0;
        const float* wp = AIN(I_WMOD) + (size_t)l * 1024 * NMODV + n0 + 4 * n4;
#pragma unroll 4
        for (int k = kg; k < 1024; k += KG) { const f32x4 w = *(const f32x4*)(wp + (size_t)k * NMODV); a0 += w * sv[k]; a1 += w * sv[1024 + k]; a2 += w * sv[2048 + k]; }
        *(f32x4*)(red + (kg * 3 + 0) * NC + 4 * n4) = a0; *(f32x4*)(red + (kg * 3 + 1) * NC + 4 * n4) = a1; *(f32x4*)(red + (kg * 3 + 2) * NC + 4 * n4) = a2;
    }
    __syncthreads();
    for (int o = F.tid; o < 3 * NC; o += NTHR) { const int r = o / NC, n = o % NC; float s = AIN(I_BMOD)[l * NMODV + n0 + n];
        for (int g = 0; g < KG; ++g) s += red[(g * 3 + r) * NC + n];
        WSP(float, WS_MOD)[(size_t)(l * 3 + r) * NMODV + n0 + n] = s; }
    __syncthreads();
}
__device__ __forceinline__ void bias_reduce(const Frame& F, int l, int kmask, int bgi, int nbg) {
    const float* BP = WSP(float, WS_BIAS); float* BF = WSP(float, WS_BIASF);
    const int gt = bgi * NTHR + F.tid, NT = nbg * NTHR;
    for (int i = gt; i < 3 * 3 * (int)BIAS_LD; i += NT) { const int kind = i / (3 * (int)BIAS_LD), rem = i % (3 * (int)BIAS_LD), m = rem / (int)BIAS_LD, n = rem % (int)BIAS_LD;
        if (!((kmask >> kind) & 1)) continue;
        const float* p = BP + ((size_t)(l * 3 + kind) * 3 + m) * BIAS_MS + n; float b = 0.f;
#pragma unroll
        for (int kb = 0; kb < 16; ++kb) b += p[(size_t)kb * BIAS_LD];
        BF[((size_t)(l * 3 + kind) * 3 + m) * BIAS_LD + n] = b; }
}
__device__ __forceinline__ void background_work(const Frame& F, int l, int win, int bgi, int nbg) {
    F.relane();
    if (nbg <= 0) return;
    if (win == 0) bias_reduce(F, l, 6, bgi, nbg);
    if (l >= 3) return;
    const int ln = l + 1;
    if (win == 2) bias_reduce(F, ln, 1, bgi, nbg);
    float* scr = (float*)(F.lds + F.wave * 16384);
    const int gw = bgi * NWAVES + F.wave, NGW = nbg * NWAVES;
    if (win == 0) {
        for (int t = bgi; t < 64; t += nbg) mod_tile<36>(F, ln, t);
        const int na = conv_na(ln);
        for (int it = gw; it < na; it += NGW) conv_item_a(F, ln, it, scr);
    } else {
        const int nb = conv_nb(ln), cut = CI_GU;
        const int lo = win == 1 ? 0 : cut, hi_ = win == 1 ? cut : nb;
        for (int it = lo + gw; it < hi_; it += NGW) conv_item_b(F, ln, it, scr);
    }
}
__device__ __forceinline__ void p0_phase(const Frame& F) {
    F.relane();
    for (int t = F.bid; t < 256; t += F.G) mod_tile<9>(F, 0, t);
    {
        float* scr = (float*)(F.lds + F.wave * 16384);
        const int gw = F.bid * NWAVES + F.wave, NGW = F.G * NWAVES;
        for (int it = gw; it < conv_na(0); it += NGW) conv_item_a(F, 0, it, scr);
    }
    {
        const size_t gt = (size_t)F.bid * NTHR + F.tid, NT = (size_t)F.G * NTHR;
        for (size_t i = gt; i < 1024 * 16; i += NT) { const int pos = (int)(i >> 4), ax = (int)(i >> 3) & 1, f = (int)i & 7;
            const float freq = exp2f(-(float)f * (13.287712379549449f / 8.0f));
            const float ang = (float)(ax == 0 ? (pos >> 6) : (pos & 63)) * freq;
            float sn, cs; sincosf(ang, &sn, &cs);
            WSP(float, WS_ROPE)[2 * i] = cs; WSP(float, WS_ROPE)[2 * i + 1] = sn; }
    }
}
__device__ __forceinline__ void p1_copy_phase(const Frame& F) {
    F.relane();
    float* scr = (float*)(F.lds + F.wave * 16384);
    const int gw = F.bid * NWAVES + F.wave, NGW = F.G * NWAVES;
    for (int it = gw; it < conv_nb(0); it += NGW) conv_item_b(F, 0, it, scr);
}

__device__ __forceinline__ void norm0_phase(const Frame& F) {
    F.relane();
    const int gw = F.bid * NWAVES + F.wave, NGW = F.G * NWAVES;
    bf16* X = WSP(bf16, WS_X); bf16* XA = WSP(bf16, WS_XA); float* SSQ = WSP(float, WS_SSQ);
    const float* g = AIN(I_GNORM); const float* scale = WSP(float, WS_MOD) + 1024;
    for (int row = gw; row < T; row += NGW) {
        const int r = modrow_of_tok(row);
        const f32x4* xr = (const f32x4*)(row < TCTX ? AIN(I_XP) + (size_t)row * D : AIN(I_XS) + (size_t)(row - TCTX) * D) + F.lane;
        f32x4 v[4]; float s = 0.f;
#pragma unroll
        for (int j = 0; j < 4; ++j) { v[j] = xr[64 * j]; s += (v[j].x * v[j].x + v[j].y * v[j].y) + (v[j].z * v[j].z + v[j].w * v[j].w); }
        s = wave_sum(s);
        if (F.lane == 0) *(f32x4*)(SSQ + (size_t)row * 4) = (f32x4){s, 0.f, 0.f, 0.f};
        unsigned long long* o8 = (unsigned long long*)(XA + (size_t)row * D) + F.lane;
        unsigned long long* xo = (unsigned long long*)(X + (size_t)row * D) + F.lane;
#pragma unroll
        for (int j = 0; j < 4; ++j) {
            const f32x4 gg = *((const f32x4*)g + F.lane + 64 * j), sc = *((const f32x4*)(scale + (size_t)r * NMODV) + F.lane + 64 * j);
            const f32x4 o = v[j] * gg * (sc + 1.0f);
            xo[64 * j] = (unsigned long long)pk2(v[j].x, v[j].y) | ((unsigned long long)pk2(v[j].z, v[j].w) << 32);
            o8[64 * j] = (unsigned long long)pk2(o.x, o.y) | ((unsigned long long)pk2(o.z, o.w) << 32);
        }
    }
}
__device__ __forceinline__ void final_phase(const Frame& F) {
    F.relane();
    const int gw = F.bid * NWAVES + F.wave, NGW = F.G * NWAVES;
    const bf16* X = WSP(bf16, WS_X); const float* g = AIN(I_GFIN); float* out = AOUT + OUT_Y;
    for (int row = gw; row < T; row += NGW) {
        const v2u* xr = (const v2u*)(X + (size_t)row * D) + F.lane;
        f32x4 v[4]; float s = 0.f;
#pragma unroll
        for (int j = 0; j < 4; ++j) { const v2u w = xr[64 * j]; v[j] = (f32x4){bflo(w.x), bfhi(w.x), bflo(w.y), bfhi(w.y)}; s += (v[j].x * v[j].x + v[j].y * v[j].y) + (v[j].z * v[j].z + v[j].w * v[j].w); }
        const float rstd = frsq(wave_sum(s) * (1.f / D) + EPS);
        f32x4* o = (f32x4*)(out + (size_t)row * D) + F.lane;
#pragma unroll
        for (int j = 0; j < 4; ++j) o[64 * j] = v[j] * rstd * *((const f32x4*)g + F.lane + 64 * j);
    }
}
constexpr int LDT = 136;
__device__ __forceinline__ bf16x8 ld_frag16(const unsigned char* p) { return *(const bf16x8*)p; }
__device__ __forceinline__ bf16x8 ld_frag8x2(const unsigned char* p0, const unsigned char* p1) {
    const v2u a = *(const v2u*)p0, b = *(const v2u*)p1; v4u v; v.x = a.x; v.y = a.y; v.z = b.x; v.w = b.y; return __builtin_bit_cast(bf16x8, v); }
#define MFMA16(a, b, c) __builtin_amdgcn_mfma_f32_16x16x32_bf16((a), (b), (c), 0, 0, 0)

__device__ __forceinline__ void chunk_info(int c, int& cfirst, int& clast, bool& is_ctx, int& sb) {
    if (c < 64) { cfirst = c & ~1; clast = cfirst + 1; is_ctx = true; sb = c >> 1; }
    else { cfirst = 64 + ((c - 64) & ~7); clast = cfirst + 7; is_ctx = false; sb = (c - 64) >> 3; }
}
struct ConvW { f32x4 w0a, w0b, w1a, w1b, w2a, w2b, ba, bb; };
__device__ __forceinline__ ConvW conv_w(const float* wc, const float* bc, int ch) {
    ConvW W; W.w0a = *(const f32x4*)(wc + ch); W.w0b = *(const f32x4*)(wc + ch + 4); W.w1a = *(const f32x4*)(wc + 1024 + ch); W.w1b = *(const f32x4*)(wc + 1024 + ch + 4);
    W.w2a = *(const f32x4*)(wc + 2048 + ch); W.w2b = *(const f32x4*)(wc + 2048 + ch + 4); W.ba = *(const f32x4*)(bc + ch); W.bb = *(const f32x4*)(bc + ch + 4); return W;
}
__device__ __forceinline__ void conv8(const bf16* PROJ, int t, bool has_prev, bool has_next, int ch, const ConvW& W, float* out) {
    const bf16* p = PROJ + (size_t)t * EVEN_NP + 1536 + ch;
    const v4u z = {0u, 0u, 0u, 0u};
    const v4u c0 = *(const v4u*)p, cm = has_prev ? *(const v4u*)(p - EVEN_NP) : z, cp = has_next ? *(const v4u*)(p + EVEN_NP) : z;
    float x0[8], xm[8], xp[8]; unpack8(c0, x0); unpack8(cm, xm); unpack8(cp, xp);
#pragma unroll
    for (int i = 0; i < 4; ++i) { out[i] = siluf_(W.ba[i] + W.w0a[i] * xm[i] + W.w1a[i] * x0[i] + W.w2a[i] * xp[i]); out[4 + i] = siluf_(W.bb[i] + W.w0b[i] * xm[4 + i] + W.w1b[i] * x0[4 + i] + W.w2b[i] * xp[4 + i]); }
}
__device__ __forceinline__ void ssd_tables(const Frame& F, int ei, int t0, float* dtl, float* cml) {
    const bf16* PROJ = WSP(bf16, WS_PROJ);
    if (F.tid < 256) { const int j = F.tid >> 1, dir = F.tid & 1;
        const v4u raw = *(const v4u*)(PROJ + (size_t)(t0 + j) * EVEN_NP + 2560 + 8 * dir); float x[8]; unpack8(raw, x);
#pragma unroll
        for (int h = 0; h < 8; ++h) dtl[(dir * 8 + h) * 128 + j] = softplusf_(x[h] + AIN(I_DTB)[ei * 16 + dir * 8 + h]); }
    __syncthreads();
#pragma unroll
    for (int k = 0; k < 2; ++k) {
        const int row = 2 * F.wave + k, rev = row >> 3;
        const float a = -__expf(AIN(I_ALOG)[ei * 16 + row]);
        const int i0 = rev ? 127 - 2 * F.lane : 2 * F.lane, i1 = rev ? 126 - 2 * F.lane : 2 * F.lane + 1;
        const float v0 = dtl[row * 128 + i0] * a, v1 = dtl[row * 128 + i1] * a;
        float x = v0 + v1;
#pragma unroll
        for (int d = 1; d < 64; d <<= 1) { const float t = __builtin_bit_cast(float, __builtin_amdgcn_ds_bpermute((F.lane - d) * 4, __builtin_bit_cast(int, x))); x += (F.lane >= d) ? t : 0.f; }
        const float ex = x - (v0 + v1);
        cml[row * 128 + i0] = ex + v0; cml[row * 128 + i1] = ex + (v0 + v1);
    }
    __syncthreads();
}
constexpr int TILE128 = 34816, TILE64 = 17408;
constexpr int S1_BT = 0, S1_B = TILE128, S1_C = 2 * TILE128, S1_XT = TILE128  , S1_DT = 3 * TILE128, S1_CUM = S1_DT + 8192;
constexpr int S2_XT = 0  , S2_H = 2 * TILE64  , S2_DT = 6 * TILE64, S2_CUM = S2_DT + 8192, S2_SSQ = S2_CUM + 8192;

__device__ __forceinline__ void ssd_state_item(const Frame& F, int ei, int c, int g) {
    F.relane();
    const bf16* PROJ = WSP(bf16, WS_PROJ);
    const float* wc = AIN(I_WCS) + (size_t)ei * 3 * 1024; const float* bc = AIN(I_BCS) + (size_t)ei * 1024;
    int cfirst, clast, sb; bool is_ctx; chunk_info(c, cfirst, clast, is_ctx, sb);
    const int t0 = c * 128, len = is_ctx ? 256 : 1024, pos0 = (c - cfirst) * 128;
    bf16* BT = (bf16*)(F.lds + S1_BT); bf16* Bl = (bf16*)(F.lds + S1_B); bf16* Cl = (bf16*)(F.lds + S1_C); bf16* XT4 = (bf16*)(F.lds + S1_XT);
    float* dtl = (float*)(F.lds + S1_DT); float* cml = (float*)(F.lds + S1_CUM);
    bf16* ST = WSP(bf16, WS_ST); float* DEC = WSP(float, WS_DEC);
    bf16* CC = WSP(bf16, WS_CC); bf16* CBM = WSP(bf16, WS_CBM); bf16* XCT = WSP(bf16, WS_XCT);
    const int r = F.lane & 15, q = F.lane >> 4, w = F.wave;
    __syncthreads();
    ssd_tables(F, ei, t0, dtl, cml);
    { const ConvW W = conv_w(wc, bc, 512 + g * 128 + (F.tid & 15) * 8);
#pragma unroll 4
    for (int e = F.tid; e < 128 * 16; e += NTHR) { const int j = e >> 4, n8 = (e & 15) * 8; float o[8];
        conv8(PROJ, t0 + j, pos0 + j > 0, pos0 + j < len - 1, 512 + g * 128 + n8, W, o);
        const v4u pk = pack8(o);
        *(v4u*)((unsigned char*)Bl + (j * LDT + n8) * 2) = pk;
#pragma unroll
        for (int i = 0; i < 8; ++i) BT[(n8 + i) * LDT + j] = (bf16)f2bf1(o[i]); } }
    { const ConvW W = conv_w(wc, bc, 768 + g * 128 + (F.tid & 15) * 8);
#pragma unroll 4
    for (int e = F.tid; e < 128 * 16; e += NTHR) { const int j = e >> 4, n8 = (e & 15) * 8; float o[8];
        conv8(PROJ, t0 + j, pos0 + j > 0, pos0 + j < len - 1, 768 + g * 128 + n8, W, o);
        const v4u pk = pack8(o);
        *(v4u*)((unsigned char*)Cl + (j * LDT + n8) * 2) = pk;
        *(v4u*)(CC + (size_t)(t0 + j) * 256 + g * 128 + n8) = pk; } }
    __syncthreads();
    {
        bf16x8 cf[4];
#pragma unroll
        for (int ks = 0; ks < 4; ++ks) cf[ks] = ld_frag16((const unsigned char*)Cl + ((16 * w + r) * LDT + 32 * ks + 8 * q) * 2);
        bf16* dst = CBM + ((size_t)(c * 2 + g) * 128 + 16 * w + r) * 128 + 4 * q;
#pragma unroll
        for (int jt = 0; jt < 8; ++jt) { f32x4 a = {0.f, 0.f, 0.f, 0.f};
#pragma unroll
            for (int ks = 0; ks < 4; ++ks) a = MFMA16(ld_frag16((const unsigned char*)Bl + ((16 * jt + r) * LDT + 32 * ks + 8 * q) * 2), cf[ks], a);
            v2u o; o.x = pk2(a[0], a[1]); o.y = pk2(a[2], a[3]); *(v2u*)(dst + 16 * jt) = o; }
    }
    __syncthreads();
    { const ConvW W = conv_w(wc, bc, g * 256 + (F.tid & 31) * 8);
#pragma unroll 4
    for (int e = F.tid; e < 128 * 32; e += NTHR) { const int j = e >> 5, p8 = (e & 31) * 8; float o[8];
        conv8(PROJ, t0 + j, pos0 + j > 0, pos0 + j < len - 1, g * 256 + p8, W, o);
#pragma unroll
        for (int i = 0; i < 8; ++i) XT4[(p8 + i) * LDT + j] = (bf16)f2bf1(o[i]); } }
    __syncthreads();
#pragma unroll 4
    for (int e = F.tid; e < 256 * 16; e += NTHR) { const int row = e >> 4, ch = (e & 15) * 8;
        *(v4u*)(XCT + ((size_t)(c * 8 + 4 * g) * 64 + row) * 128 + ch) = *(const v4u*)((const unsigned char*)XT4 + (row * LDT + ch) * 2); }
#pragma unroll 2
    for (int hd = 0; hd < 8; ++hd) {
        const int hh = hd >> 1, dir = hd & 1, h = 4 * g + hh;
        const float* dth = dtl + (dir * 8 + h) * 128; const float* cmh = cml + (dir * 8 + h) * 128;
        const float cend = dir == 0 ? cmh[127] : cmh[0];
        const bf16* XT = XT4 + hh * 64 * LDT;
        f32x4 acc[4];
#pragma unroll
        for (int pt = 0; pt < 4; ++pt) acc[pt] = (f32x4){0.f, 0.f, 0.f, 0.f};
#pragma unroll
        for (int ks = 0; ks < 4; ++ks) {
            const int j0 = 32 * ks + 8 * q;
            const v4u braw = *(const v4u*)((const unsigned char*)BT + ((16 * w + r) * LDT + j0) * 2); float bv[8]; unpack8(braw, bv);
            const f32x4 d0 = *(const f32x4*)(dth + j0), d1 = *(const f32x4*)(dth + j0 + 4), c0 = *(const f32x4*)(cmh + j0), c1 = *(const f32x4*)(cmh + j0 + 4);
#pragma unroll
            for (int i = 0; i < 4; ++i) { bv[i] *= d0[i] * __expf(cend - c0[i]); bv[4 + i] *= d1[i] * __expf(cend - c1[i]); }
            const bf16x8 af = __builtin_bit_cast(bf16x8, pack8(bv));
#pragma unroll
            for (int pt = 0; pt < 4; ++pt) { const bf16x8 bf = ld_frag16((const unsigned char*)XT + ((16 * pt + r) * LDT + j0) * 2); acc[pt] = MFMA16(af, bf, acc[pt]); }
        }
        bf16* dst = ST + ((size_t)(c * 8 + h) * 2 + dir) * 8192;
#pragma unroll
        for (int pt = 0; pt < 4; ++pt) { v2u o; o.x = pk2(acc[pt][0], acc[pt][1]); o.y = pk2(acc[pt][2], acc[pt][3]); *(v2u*)(dst + (16 * pt + r) * 128 + 16 * w + 4 * q) = o; }
        if (F.tid == 0) DEC[(c * 8 + h) * 2 + dir] = __expf(cend);
    }
}

__device__ __forceinline__ void gmlp_item(const Frame& F, int ei, int c, int g) {
    F.relane();
    const bf16* PROJ = WSP(bf16, WS_PROJ); bf16* YMIX = WSP(bf16, WS_YMIX);
    const int t0 = c * 128;
    float* rs = (float*)F.lds; bf16* Vt = (bf16*)(F.lds + 1024); bf16* Wl = (bf16*)(F.lds + 1024 + 34816);
    const float* gv = AIN(I_GV) + ei * 512;
    __syncthreads();
#pragma unroll 1
    for (int kb = 0; kb < 16; kb += 8) {
        v4u raw[8];
#pragma unroll
        for (int k = 0; k < 8; ++k) raw[k] = *(const v4u*)(PROJ + (size_t)(t0 + F.wave * 16 + kb + k) * EVEN_NP + 512 + 8 * F.lane);
#pragma unroll
        for (int k = 0; k < 8; ++k) { float x[8]; unpack8(raw[k], x); float s = 0.f;
#pragma unroll
            for (int i = 0; i < 8; ++i) { const float y = gelu_tanh(x[i]); s += y * y; }
            s = wave_sum(s); if (F.lane == 0) rs[F.wave * 16 + kb + k] = frsq(s * (1.f / 512.f) + EPS); }
    }
    { const float* ws_ = AIN(I_WSP) + ((size_t)ei * 4 + g) * 16384;
#pragma unroll
      for (int e = F.tid; e < 4096; e += NTHR) { const int i = e >> 5, j4 = (e & 31) * 4; const f32x4 v = *(const f32x4*)(ws_ + i * 128 + j4);
          v2u o; o.x = pk2(v.x, v.y); o.y = pk2(v.z, v.w); *(v2u*)((unsigned char*)Wl + (i * LDT + j4) * 2) = o; } }
    __syncthreads();
    { const int d8 = (F.tid & 15) * 8; v4u raw[4];
#pragma unroll
      for (int k = 0; k < 4; ++k) raw[k] = *(const v4u*)(PROJ + (size_t)(t0 + (F.tid >> 4) + 32 * k) * EVEN_NP + 512 + g * 128 + d8);
#pragma unroll
      for (int k = 0; k < 4; ++k) { const int j = (F.tid >> 4) + 32 * k; float x[8]; unpack8(raw[k], x); const float rj = rs[j];
#pragma unroll
          for (int i = 0; i < 8; ++i) Vt[(d8 + i) * LDT + j] = (bf16)f2bf1(gelu_tanh(x[i]) * rj * gv[g * 128 + d8 + i]); } }
    __syncthreads();
    const int r = F.lane & 15, q = F.lane >> 4, w = F.wave;
    bf16x8 af[4];
#pragma unroll
    for (int ks = 0; ks < 4; ++ks) af[ks] = ld_frag16((const unsigned char*)Vt + ((16 * w + r) * LDT + 32 * ks + 8 * q) * 2);
    const float* bs = AIN(I_BSP) + ((size_t)ei * 4 + g) * 128;
    v2u uraw[8];
#pragma unroll
    for (int it = 0; it < 8; ++it) uraw[it] = *(const v2u*)(PROJ + (size_t)(t0 + 16 * it + r) * EVEN_NP + g * 128 + 16 * w + 4 * q);
#pragma unroll
    for (int it = 0; it < 8; ++it) {
        f32x4 acc = {0.f, 0.f, 0.f, 0.f};
#pragma unroll
        for (int ks = 0; ks < 4; ++ks) acc = MFMA16(af[ks], ld_frag16((const unsigned char*)Wl + ((16 * it + r) * LDT + 32 * ks + 8 * q) * 2), acc);
        const int i = 16 * it + r, col = g * 128 + 16 * w + 4 * q; const float b = bs[i];
        const float u0 = gelu_tanh(bflo(uraw[it].x)), u1 = gelu_tanh(bfhi(uraw[it].x)), u2 = gelu_tanh(bflo(uraw[it].y)), u3 = gelu_tanh(bfhi(uraw[it].y));
        v2u o; o.x = pk2(u0 * (acc[0] + b), u1 * (acc[1] + b)); o.y = pk2(u2 * (acc[2] + b), u3 * (acc[3] + b));
        *(v2u*)(YMIX + (size_t)(t0 + i) * D + col) = o;
    }
}

__device__ __forceinline__ f32x4 ld_bf4(const bf16* p) { const v2u w = *(const v2u*)p; return (f32x4){bflo(w.x), bfhi(w.x), bflo(w.y), bfhi(w.y)}; }
__device__ __forceinline__ void ssd_scan_phase(const Frame& F, int ei) {
    F.relane();
    const bf16* ST = WSP(bf16, WS_ST); const float* DEC = WSP(float, WS_DEC); bf16* HIN = WSP(bf16, WS_HIN);
    const size_t gt = (size_t)F.bid * NTHR + F.tid, NT = (size_t)F.G * NTHR;
    constexpr size_t N_SMP = (size_t)2 * 8 * 2 * 2048, N_CTX = (size_t)32 * 8 * 2 * 2048;
    for (size_t it = gt; it < N_SMP + N_CTX; it += NT) {
        if (it < N_SMP) {
            const int e = (int)(it & 2047) * 4, dir = (int)(it >> 11) & 1, h = (int)(it >> 12) & 7, b = (int)(it >> 15);
            const int c0 = 64 + 8 * b;
            f32x4 st[8]; float dc[8];
#pragma unroll
            for (int k = 0; k < 8; ++k) { const int cc = dir == 0 ? c0 + k : c0 + 7 - k; st[k] = ld_bf4(ST + ((size_t)(cc * 8 + h) * 2 + dir) * 8192 + e); dc[k] = DEC[(cc * 8 + h) * 2 + dir]; }
            f32x4 v = *(const f32x4*)(AIN(I_SSD) + ((size_t)((b * 2 + ei) * 2 + dir) * 8 + h) * 8192 + e);
#pragma unroll
            for (int k = 0; k < 8; ++k) { const int cc = dir == 0 ? c0 + k : c0 + 7 - k;
                v2u o; o.x = pk2(v.x, v.y); o.y = pk2(v.z, v.w); *(v2u*)(HIN + ((size_t)(cc * 8 + h) * 2 + dir) * 8192 + e) = o;
                v = v * dc[k] + st[k]; }
        } else {
            const size_t i2 = it - N_SMP;
            const int e = (int)(i2 & 2047) * 4, dir = (int)(i2 >> 11) & 1, h = (int)(i2 >> 12) & 7, s = (int)(i2 >> 15);
            const int ca = dir == 0 ? 2 * s : 2 * s + 1, cb = dir == 0 ? 2 * s + 1 : 2 * s;
            const f32x4 sa = ld_bf4(ST + ((size_t)(ca * 8 + h) * 2 + dir) * 8192 + e), sb_ = ld_bf4(ST + ((size_t)(cb * 8 + h) * 2 + dir) * 8192 + e);
            const float db = DEC[(cb * 8 + h) * 2 + dir];
            *(f32x4*)(AOUT + OUT_SSD + ((size_t)((s * 2 + ei) * 2 + dir) * 8 + h) * 8192 + e) = sa * db + sb_;
        }
    }
}

__device__ __forceinline__ void ssd_out_item(const Frame& F, int ei, int c, int th) {
    F.relane();
    const bf16* PROJ = WSP(bf16, WS_PROJ); bf16* YMIX = WSP(bf16, WS_YMIX);
    const bf16* CC = WSP(bf16, WS_CC); const bf16* CBM = WSP(bf16, WS_CBM); const bf16* XCT = WSP(bf16, WS_XCT); const bf16* HIN = WSP(bf16, WS_HIN); const bf16* ST = WSP(bf16, WS_ST);
    const int t0 = c * 128;
    float* dtl = (float*)(F.lds + S2_DT); float* cml = (float*)(F.lds + S2_CUM); float* ssqx = (float*)(F.lds + S2_SSQ);
    const int r = F.lane & 15, q = F.lane >> 4, w = F.wave, it = w & 3, g = w >> 2;
    const int irow = 64 * th + 16 * it + r;
    const bool hzero[2] = {c < 64 && (c & 1) == 0, c < 64 && (c & 1) == 1};
    __syncthreads();
    ssd_tables(F, ei, t0, dtl, cml);
    v2u cbp[8]; bf16x8 cf[4];
    {
        const bf16* cbr = CBM + ((size_t)(c * 2 + g) * 128 + irow) * 128 + 4 * q;
#pragma unroll
        for (int jt = 0; jt < 8; ++jt) cbp[jt] = *(const v2u*)(cbr + 16 * jt);
#pragma unroll
        for (int kn = 0; kn < 4; ++kn) cf[kn] = *(const bf16x8*)(CC + (size_t)(t0 + irow) * 256 + g * 128 + 32 * kn + 8 * q);
    }
    float ssq = 0.f;
    v4u pre[12];
    const int goff = (F.tid >> 4) * 128 + (F.tid & 15) * 8, loff = ((F.tid >> 4) * LDT + (F.tid & 15) * 8) * 2;
#define E2_SRC(m_, hh_) ((m_) < 2 ? XCT + (size_t)(c * 8 + 4 * (m_) + (hh_)) * 8192 : \
        (c < 64 ? ST + ((size_t)((((m_) - 2) & 1) == 0 ? c - 1 : c + 1) * 8 + 4 * (((m_) - 2) >> 1) + (hh_)) * 16384 + (((m_) - 2) & 1) * 8192 \
                : HIN + ((size_t)c * 8 + 4 * (((m_) - 2) >> 1) + (hh_)) * 16384 + (((m_) - 2) & 1) * 8192))
#define E2_FETCH(hh_) do { _Pragma("unroll") for (int m = 0; m < 6; ++m) { if (m >= 2 && hzero[(m - 2) & 1]) continue; const bf16* sp = E2_SRC(m, hh_) + goff; \
            pre[2 * m] = *(const v4u*)sp; pre[2 * m + 1] = *(const v4u*)(sp + 32 * 128); } } while (0)
    E2_FETCH(0);
#pragma unroll 1
    for (int hh = 0; hh < 4; ++hh) {
        __syncthreads();
#pragma unroll
        for (int m = 0; m < 6; ++m) { if (m >= 2 && hzero[(m - 2) & 1]) continue;
            unsigned char* dp = F.lds + (m < 2 ? S2_XT + m * TILE64 : S2_H + (m - 2) * TILE64) + loff;
            *(v4u*)dp = pre[2 * m]; *(v4u*)(dp + 32 * LDT * 2) = pre[2 * m + 1]; }
        __syncthreads();
        if (hh < 3) E2_FETCH(hh + 1);
        v2u zr4[4];
#pragma unroll
        for (int pt = 0; pt < 4; ++pt) zr4[pt] = *(const v2u*)(PROJ + (size_t)(t0 + irow) * EVEN_NP + 1024 + (4 * g + hh) * 64 + 16 * pt + 4 * q);
        const int h = 4 * g + hh;
        const bf16* XT = (const bf16*)(F.lds + S2_XT + g * TILE64);
        f32x4 yacc[4];
#pragma unroll
        for (int pt = 0; pt < 4; ++pt) yacc[pt] = (f32x4){0.f, 0.f, 0.f, 0.f};
        const float* dt0 = dtl + h * 128; const float* cm0 = cml + h * 128; const float* dt1 = dtl + (8 + h) * 128; const float* cm1 = cml + (8 + h) * 128;
        const float ci0 = cm0[irow], ci1 = cm1[irow];
#pragma unroll
        for (int ks = 0; ks < 4; ++ks) {
            float sl0[8], sl1[8];
#pragma unroll
            for (int hf = 0; hf < 2; ++hf) {
                const int j0 = 32 * ks + 16 * hf + 4 * q; const v2u cw = cbp[2 * ks + hf];
                const f32x4 c0v = *(const f32x4*)(cm0 + j0), d0v = *(const f32x4*)(dt0 + j0), c1v = *(const f32x4*)(cm1 + j0), d1v = *(const f32x4*)(dt1 + j0);
                const float cbv[4] = {bflo(cw.x), bfhi(cw.x), bflo(cw.y), bfhi(cw.y)};
#pragma unroll
                for (int e = 0; e < 4; ++e) { const int j = j0 + e;
                    const float e0 = __expf(ci0 - c0v[e]) * d0v[e] * cbv[e], e1 = __expf(ci1 - c1v[e]) * d1v[e] * cbv[e];
                    sl0[4 * hf + e] = (j <= irow) ? e0 : 0.f; sl1[4 * hf + e] = (j >= irow) ? e1 : 0.f; }
            }
            const bf16x8 sf0 = __builtin_bit_cast(bf16x8, pack8(sl0)), sf1 = __builtin_bit_cast(bf16x8, pack8(sl1));
#pragma unroll
            for (int pt = 0; pt < 4; ++pt) { const unsigned char* xr = (const unsigned char*)XT + ((16 * pt + r) * LDT + 32 * ks + 4 * q) * 2;
                const bf16x8 xf = ld_frag8x2(xr, xr + 32);
                yacc[pt] = MFMA16(xf, sf0, yacc[pt]); yacc[pt] = MFMA16(xf, sf1, yacc[pt]); }
        }
#pragma unroll
        for (int dir = 0; dir < 2; ++dir) {
            if (hzero[dir]) continue;
            const unsigned char* Hl = F.lds + S2_H + (g * 2 + dir) * TILE64;
            const float ei_ = __expf(dir == 0 ? ci0 : ci1);
#pragma unroll
            for (int pt = 0; pt < 4; ++pt) { f32x4 t = {0.f, 0.f, 0.f, 0.f};
#pragma unroll
                for (int kn = 0; kn < 4; ++kn) t = MFMA16(ld_frag16(Hl + ((16 * pt + r) * LDT + 32 * kn + 8 * q) * 2), cf[kn], t);
                yacc[pt] += t * ei_; }
        }
        const float dsk = AIN(I_DSK)[ei * 16 + h] + AIN(I_DSK)[ei * 16 + 8 + h];
#pragma unroll
        for (int pt = 0; pt < 4; ++pt) {
            const int p0 = 16 * pt + 4 * q;
            const v2u zr = zr4[pt];
            const float z0 = bflo(zr.x), z1 = bfhi(zr.x), z2 = bflo(zr.y), z3 = bfhi(zr.y);
            float y0 = yacc[pt][0] + dsk * bf1(XT[(p0 + 0) * LDT + irow]), y1 = yacc[pt][1] + dsk * bf1(XT[(p0 + 1) * LDT + irow]),
                  y2 = yacc[pt][2] + dsk * bf1(XT[(p0 + 2) * LDT + irow]), y3 = yacc[pt][3] + dsk * bf1(XT[(p0 + 3) * LDT + irow]);
            y0 *= siluf_(z0); y1 *= siluf_(z1); y2 *= siluf_(z2); y3 *= siluf_(z3);
            ssq += (y0 * y0 + y1 * y1) + (y2 * y2 + y3 * y3);
            v2u o; o.x = pk2(y0, y1); o.y = pk2(y2, y3);
            *(v2u*)(YMIX + (size_t)(t0 + irow) * D + 512 + h * 64 + p0) = o;
        }
    }
#undef E2_FETCH
#undef E2_SRC
    ssq += xlane<16>(ssq); ssq = sum_x32(ssq);
    if (q == 0) ssqx[w * 16 + r] = ssq;
    __syncthreads();
    ssq += ssqx[(w ^ 4) * 16 + r];
    const float rstd = frsq(ssq * (1.f / 512.f) + EPS);
    const float* go = AIN(I_GSO) + ei * 512;
#pragma unroll 1
    for (int hh = 0; hh < 4; ++hh)
#pragma unroll
        for (int pt = 0; pt < 4; ++pt) {
            const int col = (4 * g + hh) * 64 + 16 * pt + 4 * q;
            v2u* p = (v2u*)(YMIX + (size_t)(t0 + irow) * D + 512 + col); const v2u v = *p; const f32x4 gg = *(const f32x4*)(go + col);
            v2u o; o.x = pk2(bflo(v.x) * rstd * gg.x, bfhi(v.x) * rstd * gg.y); o.y = pk2(bflo(v.y) * rstd * gg.z, bfhi(v.y) * rstd * gg.w);
            *p = o;
        }
}

__device__ __forceinline__ void even_phase1(const Frame& F, int ei) {
    if (F.G >= 256) {
        if (F.bid < 160) ssd_state_item(F, ei, F.bid >> 1, F.bid & 1);
        else for (int it = F.bid - 160; it < 192; it += F.G - 160) gmlp_item(F, ei, it >> 2, it & 3);
        return;
    }
    for (int it = F.bid; it < 160 + 320; it += F.G) {
        if (it < 160) ssd_state_item(F, ei, it >> 1, it & 1);
        else gmlp_item(F, ei, (it - 160) >> 2, (it - 160) & 3);
    }
}
__device__ __forceinline__ void even_phase2(const Frame& F, int ei) {
    if (F.G >= 256) {
        if (F.bid < 160) ssd_out_item(F, ei, F.bid >> 1, F.bid & 1);
        else for (int it = 192 + F.bid - 160; it < 320; it += F.G - 160) gmlp_item(F, ei, it >> 2, it & 3);
        return;
    }
    for (int it = F.bid; it < 160; it += F.G) ssd_out_item(F, ei, it >> 1, it & 1);
}
constexpr int CV_T = 43, CV_W = CV_T + 30, CV_ITEMS = 32 * 6 + 2 * 24;
__device__ __forceinline__ void conv_item(const Frame& F, int oi, int item) {
    F.relane();
    const bf16* PROJ = WSP(bf16, WS_PROJ); bf16* YMIX = WSP(bf16, WS_YMIX);
    int sbeg, slen, tile; if (item < 192) { sbeg = (item / 6) * 256; slen = 256; tile = item % 6; } else { const int i2 = item - 192; sbeg = TCTX + (i2 / 24) * 1024; slen = 1024; tile = i2 % 24; }
    const int send = sbeg + slen, t0 = sbeg + tile * CV_T, nt = (slen - tile * CV_T) < CV_T ? (slen - tile * CV_T) : CV_T;
    float* Dl = (float*)F.lds;
    const int c = F.tid;
    float glu[CV_W];
#pragma unroll
    for (int w0 = 0; w0 < CV_W; w0 += 8) {
        bf16 av[8], gv[8];
#pragma unroll
        for (int i = 0; i < 8; ++i) if (w0 + i < CV_W) { int t = t0 - 15 + w0 + i; t = t < sbeg ? sbeg : (t >= send ? send - 1 : t);
            av[i] = PROJ[(size_t)t * ODD_NP + 672 + c]; gv[i] = PROJ[(size_t)t * ODD_NP + 1184 + c]; }
#pragma unroll
        for (int i = 0; i < 8; ++i) if (w0 + i < CV_W) { const int t = t0 - 15 + w0 + i; const float v = bf1(av[i]) * sigmoidf_(bf1(gv[i])); glu[w0 + i] = (t >= sbeg && t < send) ? v : 0.f; }
    }
    float wk[31];
#pragma unroll
    for (int k = 0; k < 31; ++k) wk[k] = AIN(I_WDW)[((size_t)oi * 31 + k) * 512 + c];
    const float bd = AIN(I_BDW)[oi * 512 + c];
    __syncthreads();
#pragma unroll
    for (int tt = 0; tt < CV_T; ++tt) { float s = bd;
#pragma unroll
        for (int k = 0; k < 31; ++k) s += wk[k] * glu[tt + k];
        Dl[tt * 512 + c] = s; }
    __syncthreads();
    const float* gl = AIN(I_GLN) + oi * 512; const float* bl = AIN(I_BLN) + oi * 512;
    const f32x4 g0 = *(const f32x4*)(gl + 8 * F.lane), g1 = *(const f32x4*)(gl + 8 * F.lane + 4), b0 = *(const f32x4*)(bl + 8 * F.lane), b1 = *(const f32x4*)(bl + 8 * F.lane + 4);
#pragma unroll 1
    for (int tt = F.wave; tt < nt; tt += NWAVES) {
        const f32x4 v0 = *(const f32x4*)(Dl + tt * 512 + 8 * F.lane), v1 = *(const f32x4*)(Dl + tt * 512 + 8 * F.lane + 4);
        float s = (v0.x + v0.y) + (v0.z + v0.w) + (v1.x + v1.y) + (v1.z + v1.w);
        const float mean = wave_sum(s) * (1.f / 512.f);
        const f32x4 d0 = v0 - mean, d1 = v1 - mean;
        float s2 = (d0.x * d0.x + d0.y * d0.y) + (d0.z * d0.z + d0.w * d0.w) + (d1.x * d1.x + d1.y * d1.y) + (d1.z * d1.z + d1.w * d1.w);
        const float rstd = frsq(wave_sum(s2) * (1.f / 512.f) + EPS);
        float o[8];
#pragma unroll
        for (int i = 0; i < 4; ++i) { o[i] = siluf_(d0[i] * rstd * g0[i] + b0[i]); o[4 + i] = siluf_(d1[i] * rstd * g1[i] + b1[i]); }
        *(v4u*)(YMIX + (size_t)(t0 + tt) * D + 512 + 8 * F.lane) = pack8(o);
    }
}
__device__ __forceinline__ void odd_rows(const Frame& F, int oi) {
    F.relane();
    const bf16* PROJ = WSP(bf16, WS_PROJ);
    bf16* QA = WSP(bf16, WS_QA); bf16* CKVA = WSP(bf16, WS_CKVA); bf16* KR = WSP(bf16, WS_KR); const float* ROPE = WSP(float, WS_ROPE);
    const int gw = F.bid * NWAVES + F.wave, NGW = F.G * NWAVES, lane = F.lane;
    for (int row = T + gw; row < TP; row += NGW) {
        const int b = (row - T) >> 8, j = (row - T) & 255;
        const f32x4 v = *(const f32x4*)(AIN(I_CCKV) + ((size_t)(b * 2 + oi) * 256 + j) * 256 + 4 * lane);
        v2u o; o.x = pk2(v.x, v.y); o.y = pk2(v.z, v.w); *(v2u*)(CKVA + (size_t)row * 256 + 4 * lane) = o;
        if (lane < 32) KR[(size_t)row * 32 + lane] = (bf16)f2bf1(AIN(I_CKR)[((size_t)(b * 2 + oi) * 256 + j) * 32 + lane]);
    }
    const f32x4 gkv = *(const f32x4*)(AIN(I_GCKV) + oi * 256 + 4 * lane);
    float gq[6];
#pragma unroll
    for (int k = 0; k < 3; ++k) { gq[2 * k] = AIN(I_GCQ)[oi * 384 + 128 * k + 2 * lane]; gq[2 * k + 1] = AIN(I_GCQ)[oi * 384 + 128 * k + 2 * lane + 1]; }
    unsigned qw[3], nqw[3]; v2u kw, nkw; bf16 krw, nkrw;
    int row = gw;
    if (row < T) { const bf16* pr = PROJ + (size_t)row * ODD_NP;
#pragma unroll
        for (int k = 0; k < 3; ++k) nqw[k] = *(const unsigned*)(pr + 128 * k + 2 * lane);
        nkw = *(const v2u*)(pr + 384 + 4 * lane); nkrw = pr[640 + (lane & 31)]; }
#pragma unroll 1
    for (; row < T; row += NGW) {
#pragma unroll
        for (int k = 0; k < 3; ++k) qw[k] = nqw[k];
        kw = nkw; krw = nkrw;
        if (row + NGW < T) { const bf16* pr = PROJ + (size_t)(row + NGW) * ODD_NP;
#pragma unroll
            for (int k = 0; k < 3; ++k) nqw[k] = *(const unsigned*)(pr + 128 * k + 2 * lane);
            nkw = *(const v2u*)(pr + 384 + 4 * lane); nkrw = pr[640 + (lane & 31)]; }
        float qv[6]; float s = 0.f;
#pragma unroll
        for (int k = 0; k < 3; ++k) { qv[2 * k] = bflo(qw[k]); qv[2 * k + 1] = bfhi(qw[k]); s += qv[2 * k] * qv[2 * k] + qv[2 * k + 1] * qv[2 * k + 1]; }
        f32x4 kv = {bflo(kw.x), bfhi(kw.x), bflo(kw.y), bfhi(kw.y)};
        float s2 = (kv.x * kv.x + kv.y * kv.y) + (kv.z * kv.z + kv.w * kv.w);
        s += xlane<1>(s); s2 += xlane<1>(s2); s += xlane<2>(s); s2 += xlane<2>(s2); s += xlane<4>(s); s2 += xlane<4>(s2); s += xlane<8>(s); s2 += xlane<8>(s2); s += xlane<16>(s); s2 += xlane<16>(s2);
        s = sum_x32(s); s2 = sum_x32(s2);
        const float rq = frsq(s * (1.f / 384.f) + EPS), rk = frsq(s2 * (1.f / 256.f) + EPS);
#pragma unroll
        for (int k = 0; k < 3; ++k) *(unsigned*)(QA + (size_t)row * 384 + 128 * k + 2 * lane) = pk2(qv[2 * k] * rq * gq[2 * k], qv[2 * k + 1] * rq * gq[2 * k + 1]);
        kv = kv * rk * gkv;
        { v2u o; o.x = pk2(kv.x, kv.y); o.y = pk2(kv.z, kv.w); *(v2u*)(CKVA + (size_t)row * 256 + 4 * lane) = o; }
        float kr = bf1(krw);
        if (row < TCTX) {
            const int b = row >> 8, pos = row & 255;
            *(f32x4*)(AOUT + OUT_CKV + ((size_t)(b * 2 + oi) * 256 + pos) * 256 + 4 * lane) = kv;
            if (lane < 32) AOUT[OUT_KR + ((size_t)(b * 2 + oi) * 256 + pos) * 32 + lane] = kr;
        } else {
            const int pos = (row - TCTX) & 1023, e = lane & 31, ax = e >> 4, half = (e >> 3) & 1, f = e & 7;
            const float other = xlane<8>(kr);
            const float cs = ROPE[((pos * 2 + ax) * 8 + f) * 2], sn = ROPE[((pos * 2 + ax) * 8 + f) * 2 + 1];
            kr = half == 0 ? (kr * cs - other * sn) : (other * sn + kr * cs);
        }
        if (lane < 32) KR[(size_t)row * 32 + lane] = (bf16)f2bf1(kr);
    }
}
__device__ __forceinline__ void odd_phase1(const Frame& F, int oi) {
    for (int it = F.bid; it < CV_ITEMS; it += F.G) conv_item(F, oi, it);
    odd_rows(F, oi);
}

constexpr int AT_KROW = 208, AT_VROW = 272, AT_KBYTES = 128 * AT_KROW, AT_BUF = 45056;
struct AttnPre { v4u k[3]; v4u v[2]; };
__device__ __forceinline__ void attn_load_tile(const Frame& F, int h, int krow0, AttnPre& P) {
    const bf16* KN = WSP(bf16, WS_KN); const bf16* KR = WSP(bf16, WS_KR); const bf16* VT = WSP(bf16, WS_VT);
#pragma unroll
    for (int i = 0; i < 3; ++i) { const int e = F.tid + NTHR * i, key = e / 12, c = e % 12; const size_t kr = (size_t)(krow0 + key);
        P.k[i] = c < 8 ? *(const v4u*)(KN + kr * 512 + h * 64 + c * 8) : *(const v4u*)(KR + kr * 32 + (c - 8) * 8); }
#pragma unroll
    for (int i = 0; i < 2; ++i) { const int e = F.tid + NTHR * i, row = e >> 4, c = e & 15;
        P.v[i] = *(const v4u*)(VT + (size_t)(h * 64 + row) * TP + krow0 + c * 8); }
}
__device__ __forceinline__ void attn_store_tile(const Frame& F, unsigned char* buf, const AttnPre& P) {
#pragma unroll
    for (int i = 0; i < 3; ++i) { const int e = F.tid + NTHR * i, key = e / 12, c = e % 12; *(v4u*)(buf + key * AT_KROW + c * 16) = P.k[i]; }
#pragma unroll
    for (int i = 0; i < 2; ++i) { const int e = F.tid + NTHR * i, row = e >> 4, c = e & 15; *(v4u*)(buf + AT_KBYTES + row * AT_VROW + c * 16) = P.v[i]; }
}
__device__ __forceinline__ int attn_tile_row(bool is_smp, int sb, int i) {
    if (!is_smp) return sb * 256 + 128 * i;
    return i < 2 ? T + sb * 256 + 128 * i : TCTX + sb * 1024 + 128 * (i - 2);
}
__device__ __forceinline__ void attn_item(const Frame& F, int q0, int h, bool is_smp, int spos0, int sb) {
    F.relane();
    const bf16* Q = WSP(bf16, WS_Q); bf16* YMIX = WSP(bf16, WS_YMIX); const float* ROPE = WSP(float, WS_ROPE);
    const int r = F.lane & 15, g = F.lane >> 4, w = F.wave;
    const int tq = q0 + 16 * w + r;
    const int ntile = is_smp ? 10 : 2;
    AttnPre P;
    attn_load_tile(F, h, attn_tile_row(is_smp, sb, 0), P);
    bf16x8 qf[3];
#pragma unroll
    for (int ks = 0; ks < 3; ++ks) qf[ks] = *(const bf16x8*)(Q + (size_t)tq * 768 + h * 96 + 32 * ks + 8 * g);
    if (is_smp) {
        float x[8], o[8]; unpack8(__builtin_bit_cast(v4u, qf[2]), x);
        const int pos = spos0 + 16 * w + r, ax = g >> 1, half = g & 1;
        const float* rp = ROPE + ((size_t)(pos * 2 + ax) * 8) * 2;
#pragma unroll
        for (int j = 0; j < 8; ++j) { const float other = xlane<16>(x[j]); const float cs = rp[2 * j], sn = rp[2 * j + 1];
            o[j] = half == 0 ? (x[j] * cs - other * sn) : (other * sn + x[j] * cs); }
        qf[2] = __builtin_bit_cast(bf16x8, pack8(o));
    }
    const float csc = 0.10206207261596577f * 1.4426950408889634f;
    float m = -1e30f, l = 0.f;
    f32x4 oacc[4];
#pragma unroll
    for (int dt = 0; dt < 4; ++dt) oacc[dt] = (f32x4){0.f, 0.f, 0.f, 0.f};
    __syncthreads();
    attn_store_tile(F, F.lds, P);
    AttnPre P2;
    if (ntile > 1) attn_load_tile(F, h, attn_tile_row(is_smp, sb, 1), P);
    __syncthreads();
#define ATTN_COMPUTE(buf) do { \
        f32x4 sacc[8]; \
        _Pragma("unroll") \
        for (int st = 0; st < 8; ++st) { \
            const unsigned char* kp = buf + (16 * st + r) * AT_KROW + 16 * g; \
            f32x4 a = {0.f, 0.f, 0.f, 0.f}; \
            a = MFMA16(ld_frag16(kp), qf[0], a); a = MFMA16(ld_frag16(kp + 64), qf[1], a); a = MFMA16(ld_frag16(kp + 128), qf[2], a); \
            sacc[st] = a; \
        } \
        float mx = -1e30f; \
        _Pragma("unroll") \
        for (int st = 0; st < 8; ++st) mx = fmaxf(fmaxf(fmaxf(sacc[st][0], sacc[st][1]), fmaxf(sacc[st][2], sacc[st][3])), mx); \
        mx = fmaxf(mx, xlane<16>(mx)); mx = max_x32(mx); \
        const float mn = fmaxf(m, mx), alpha = __builtin_amdgcn_exp2f((m - mn) * csc); m = mn; \
        float ps = 0.f; float p[32]; \
        _Pragma("unroll") \
        for (int st = 0; st < 8; ++st) \
            _Pragma("unroll") \
            for (int j = 0; j < 4; ++j) { const float e = __builtin_amdgcn_exp2f((sacc[st][j] - mn) * csc); p[4 * st + j] = e; ps += e; } \
        l = l * alpha + ps; \
        _Pragma("unroll") \
        for (int dt = 0; dt < 4; ++dt) oacc[dt] *= alpha; \
        _Pragma("unroll") \
        for (int ks2 = 0; ks2 < 4; ++ks2) { \
            const bf16x8 pf = __builtin_bit_cast(bf16x8, pack8(p + 8 * ks2)); \
            _Pragma("unroll") \
            for (int dt = 0; dt < 4; ++dt) { \
                const unsigned char* vp = buf + AT_KBYTES + (16 * dt + r) * AT_VROW + (32 * ks2 + 4 * g) * 2; \
                oacc[dt] = MFMA16(ld_frag8x2(vp, vp + 32), pf, oacc[dt]); \
            } \
        } } while (0)
#pragma unroll 1
    for (int ti = 0; ti < ntile; ti += 2) {
        if (ti + 2 < ntile) attn_load_tile(F, h, attn_tile_row(is_smp, sb, ti + 2), P2);
        { const unsigned char* buf = F.lds; ATTN_COMPUTE(buf); }
        if (ti + 1 < ntile) attn_store_tile(F, F.lds + AT_BUF, P);
        __syncthreads();
        if (ti + 1 >= ntile) break;
        if (ti + 3 < ntile) attn_load_tile(F, h, attn_tile_row(is_smp, sb, ti + 3), P);
        { const unsigned char* buf = F.lds + AT_BUF; ATTN_COMPUTE(buf); }
        if (ti + 2 < ntile) attn_store_tile(F, F.lds, P2);
        __syncthreads();
    }
#undef ATTN_COMPUTE
    l += xlane<16>(l); l = sum_x32(l);
    const float inv = 1.0f / l;
#pragma unroll
    for (int dt = 0; dt < 4; ++dt) { v2u o; o.x = pk2(oacc[dt][0] * inv, oacc[dt][1] * inv); o.y = pk2(oacc[dt][2] * inv, oacc[dt][3] * inv);
        *(v2u*)(YMIX + (size_t)tq * D + h * 64 + 16 * dt + 4 * g) = o; }
}
__device__ __forceinline__ void odd_phase3(const Frame& F) {
    if (F.G >= 256) {
        if (F.bid < 128) {
            const int bh = F.bid & 15, qt = F.bid >> 4, b = bh >> 3, h = bh & 7;
            attn_item(F, TCTX + b * 1024 + qt * 128, h, true, qt * 128, b);
        } else {
            for (int p = F.bid - 128; p < 256; p += F.G - 128) { const int s = p >> 3, h = p & 7;
                attn_item(F, s * 256, h, false, 0, s); attn_item(F, s * 256 + 128, h, false, 0, s); }
        }
        return;
    }
    for (int it = F.bid; it < 640; it += F.G) {
        if (it < 128) { const int b = it >> 6, h = (it >> 3) & 7, qt = it & 7; attn_item(F, TCTX + b * 1024 + qt * 128, h, true, qt * 128, b); }
        else { const int i2 = it - 128, s = i2 >> 4, h = (i2 >> 1) & 7, qt = i2 & 1; attn_item(F, s * 256 + qt * 128, h, false, 0, s); }
    }
}
constexpr int PH_PER_LAYER = 9, PH_L0 = 2, N_PHASES = PH_L0 + 4 * PH_PER_LAYER + 1;
#ifndef MK_ONE_LAUNCH
#define MK_ONE_LAUNCH 1
#endif
#ifndef PROBE_REP
#define PROBE_REP 1
#define PROBE_SLOT -2
#endif

__global__ void __launch_bounds__(NTHR, 2) fwd_kernel(Args args) {
    extern __shared__ __attribute__((aligned(16))) unsigned char lds[];
    Frame F; F.lds = lds; F.tid = threadIdx.x; F.lane = F.tid & 63; F.wave = __builtin_amdgcn_readfirstlane(F.tid >> 6); F.bid = blockIdx.x; F.G = gridDim.x;
    const int wave_id = F.wave;
    { CArgsP ap = (CArgsP)__builtin_amdgcn_kernarg_segment_ptr(); asm volatile("" : "+s"(ap)); F.a = ap; F.ws = (GAS unsigned char*)ap->ws; }
    LAS unsigned char* ldsl = (LAS unsigned char*)lds;
    for (int u = F.tid; u < (LDS_BYTES - LDSCTL_OFF) / 4; u += NTHR) ((LAS unsigned*)(ldsl + LDSCTL_OFF))[u] = 0u;
    __syncthreads();
    XcdBarrier bar; bar.bar = (unsigned*)(GAS unsigned*)(F.ws + WS_CTL) + 1024; bar.x = 0; bar.st = nullptr;
    const bool multi = (args.ph_hi - args.ph_lo) > 1;
    if (multi) bar = xcd_barrier_post((unsigned*)(GAS unsigned*)(F.ws + WS_CTL) + 1024, (volatile LAS unsigned*)(ldsl + MISC_OFF) + 8);

#define FRESH_F() do { int wv_ = wave_id; asm volatile("" : "+s"(wv_)); int ln_; asm volatile("v_mbcnt_lo_u32_b32 %0, -1, 0\n\tv_mbcnt_hi_u32_b32 %0, -1, %0" : "=v"(ln_)); F.tid = wv_ * 64 + ln_; F.lane = ln_; F.wave = wv_; } while (0)
    int rep = 0;
    for (int ph = args.ph_lo; ph < args.ph_hi; ) {
        { CArgsP ap = (CArgsP)__builtin_amdgcn_kernarg_segment_ptr(); asm volatile("" : "+s"(ap)); F.a = ap; F.ws = (GAS unsigned char*)ap->ws;
          int bid_ = blockIdx.x; asm volatile("" : "+s"(bid_)); F.bid = bid_; }
        if (ph == 0) { FRESH_F(); p0_phase(F); }
        else if (ph == 1) { FRESH_F(); p1_copy_phase(F); norm0_phase(F); }
        else if (ph == N_PHASES - 1) { FRESH_F(); final_phase(F); }
        else {
            const int l = (ph - PH_L0) / PH_PER_LAYER, s = (ph - PH_L0) % PH_PER_LAYER, hi = l >> 1; const bool odd = l & 1;
            if (s == 0 || s == 7) {
                FRESH_F();
                const int f = s == 0 ? 0 : 1;
                pg8::Gemm g{(const bf16*)(const GAS bf16*)(F.ws + WS_XA), (const bf16*)(const GAS bf16*)(F.ws + WS_WGU + (size_t)(l * 2 + f) * SZ_WGU), T, 2 * DFF, D, D, D};
                pg8::StaticOrder S; S.init(T, 2 * DFF, F.G, F.bid);
                EpiSwiglu E{F.ws, (int)(((l * 3) + (f == 0 ? 0 : 2)) * 3 * BIAS_MS), (l == 0 && f == 0) ? 16 : 1};
                pg8::gemm_phase<EpiSwiglu, pg8::StaticOrder, true>(ldsl, F.tid, g, S, E);
            } else if (s == 1 || s == 8 || s == 6) {
                FRESH_F();
                const int f = s == 1 ? 0 : 1;
                const bool mix = s == 6, lastg = (s == 8 && l == 3);
                const bf16* gA = mix ? (const bf16*)(const GAS bf16*)(F.ws + WS_YMIX) : (const bf16*)(const GAS bf16*)(F.ws + WS_H);
                const bf16* gB = mix ? (const bf16*)(const GAS bf16*)(F.ws + (odd ? WS_WOO : WS_WOE) + (size_t)hi * SZ_WO) : (const bf16*)(const GAS bf16*)(F.ws + WS_WD + (size_t)(l * 2 + f) * SZ_WD);
                const int gK = mix ? D : DFF;
                const int gate_off = l * 3 * NMODV + (mix ? 5 : (f == 0 ? 2 : 8)) * 1024;
                const float coef = rep ? 0.f : (mix ? 1.0f : 0.5f);
                const int nl = (s == 8) ? l + 1 : l, ni = mix ? 2 : (f == 0 ? 1 : 0), sci = mix ? 7 : (f == 0 ? 4 : 1);
                const float* gn = AIN(I_GNORM) + (size_t)((lastg ? 0 : nl) * 3 + ni) * D;
                const int scn_off = (lastg ? 0 : nl) * 3 * NMODV + sci * 1024;
                pg8::Gemm g{gA, gB, T, D, gK, gK, gK};
                EpiResid E{F.ws, gn, gate_off, scn_off, coef};
                pg8::StaticOrder S; S.init(T, D, F.G, F.bid);
                pg8::gemm_phase<EpiResid, pg8::StaticOrder, true>(ldsl, F.tid, g, S, E);
                FRESH_F();
                if (F.bid >= 160 && rep == 0) background_work(F, l, s == 1 ? 0 : (s == 6 ? 1 : 2), F.bid - 160, F.G - 160);
            } else if (s == 2 || (s == 4 && odd)) {
                const int ng = s == 2 ? 1 : 3;
                for (int gi = 0; gi < ng; ++gi) {
                    FRESH_F();
                    const bool inproj = s == 2;
                    const int kind = inproj ? 0 : 1 + gi;
                    const size_t offA = kind == 0 ? WS_XA : (kind == 1 ? WS_QA : (kind == 2 ? WS_CKVA : WS_WKV + (size_t)hi * SZ_WKV + (size_t)512 * 256 * 2));
                    const size_t offB = kind == 0 ? (odd ? WS_WIO + (size_t)hi * SZ_WIO : WS_WIE + (size_t)hi * SZ_WIE) : (kind == 1 ? WS_WUQ + (size_t)hi * SZ_WUQ : (kind == 2 ? WS_WKV + (size_t)hi * SZ_WKV : WS_CKVA));
                    const size_t offO = kind == 0 ? WS_PROJ : (kind == 1 ? WS_Q : (kind == 2 ? WS_KN : WS_VT));
                    const int gM = kind == 3 ? 512 : (kind == 2 ? TP : T);
                    const int gN = kind == 0 ? (odd ? ODD_NP : EVEN_NP) : (kind == 1 ? 768 : (kind == 2 ? 512 : TP));
                    const int gK = kind == 0 ? D : (kind == 1 ? 384 : 256);
                    const int ldc = kind == 3 ? TP : gN;
                    const int off = kind == 2 ? 136 : (kind == 3 ? 52 : 0);
                    pg8::Gemm g{(const bf16*)(const GAS bf16*)(F.ws + offA), (const bf16*)(const GAS bf16*)(F.ws + offB), gM, gN, gK, gK, gK};
                    EpiStore E{F.ws, (unsigned)offO, ldc, inproj ? (int)((l * 3 + 1) * 3 * BIAS_MS) : -1};
                    pg8::StaticOrder S; S.init(gM, gN, F.G, (F.bid + off) % F.G);
                    pg8::gemm_phase<EpiStore, pg8::StaticOrder, true>(ldsl, F.tid, g, S, E);
                }
            } else if (s == 3) { if (!odd) { FRESH_F(); even_phase1(F, hi); } else { FRESH_F(); odd_phase1(F, hi); } }
            else if (s == 4) { FRESH_F(); ssd_scan_phase(F, hi); }
            else if (s == 5) { if (odd) { FRESH_F(); odd_phase3(F); } else { FRESH_F(); even_phase2(F, hi); } }
        }
        {
            const int slot = ph < PH_L0 ? 100 + ph : (ph == N_PHASES - 1 ? 102 : ((ph - PH_L0) % PH_PER_LAYER) + 20 * (((ph - PH_L0) / PH_PER_LAYER) & 1));
            const int reps = ((PROBE_SLOT == 200 && slot < 100) || slot == PROBE_SLOT || (PROBE_SLOT < 20 && slot == PROBE_SLOT + 20 && (PROBE_SLOT < 2 || PROBE_SLOT > 5))) ? PROBE_REP : 1;
            if (++rep >= reps) { rep = 0; ++ph; }
            if (ph < args.ph_hi) xcd_barrier(bar);
#if defined(PROBE_BAR)
            if (ph < args.ph_hi) { for (int pb_ = 1; pb_ < PROBE_BAR; ++pb_) xcd_barrier(bar); }
#endif
        }
    }
}

extern "C" void kernel_launch(void* const* d_in, const int* in_sizes, int n_in, void* d_out, int out_size, void* d_ws, size_t ws_size, hipStream_t stream) {
    static int grid = 0;
    if (grid == 0) {
        if (n_in != 34 || (size_t)out_size != OUT_END || ws_size < WS_END) { fprintf(stderr, "kernel_launch: unexpected problem: n_in %d out %d ws %zu (need %zu)\n", n_in, out_size, ws_size, (size_t)WS_END); grid = -1; return; }
        int dev = 0, cus = 0, per_cu = 0;
        if (hipGetDevice(&dev) != hipSuccess || hipDeviceGetAttribute(&cus, hipDeviceAttributeMultiprocessorCount, dev) != hipSuccess) { grid = -1; return; }
        if (hipFuncSetAttribute((const void*)fwd_kernel, hipFuncAttributeMaxDynamicSharedMemorySize, LDS_BYTES) != hipSuccess) { fprintf(stderr, "kernel_launch: hipFuncSetAttribute failed\n"); grid = -1; return; }
        if (hipOccupancyMaxActiveBlocksPerMultiprocessor(&per_cu, (const void*)fwd_kernel, NTHR, LDS_BYTES) != hipSuccess || per_cu < 1) { fprintf(stderr, "kernel_launch: occupancy query says %d blocks per CU\n", per_cu); per_cu = 1; }
        (void)hipGetLastError();
        grid = cus;
        if (grid < 256) fprintf(stderr, "kernel_launch: %d CUs (tuned for 256)\n", grid);
    }
    if (grid < 0) return;
    (void)hipMemsetAsync((char*)d_ws + WS_CTL, 0, CTL_ZERO_BYTES, stream);
    Args a{};
    for (int i = 0; i < 34; ++i) a.in[i] = (const float*)d_in[i];
    a.out = (float*)d_out; a.ws = (unsigned char*)d_ws;
#if MK_ONE_LAUNCH
    a.ph_lo = 0; a.ph_hi = N_PHASES; a.li = 0;
    hipLaunchKernelGGL(fwd_kernel, dim3(grid), dim3(NTHR), LDS_BYTES, stream, a);
#else
    int li = 0;
    for (int ph = 0; ph < N_PHASES; ++ph) {
        a.ph_lo = ph; a.ph_hi = ph + 1; a.li = li++;
        hipLaunchKernelGGL(fwd_kernel, dim3(grid), dim3(NTHR), LDS_BYTES, stream, a);
    }
#endif
}
```

```cpp
#include <hip/hip_runtime.h>
#include <cstdio>
#include <cstdint>
#ifndef GEMM_SP2
#define GEMM_SP2 1
#endif
namespace pg8 {
#define PG8_LAS __attribute__((address_space(3)))
typedef unsigned short bf16_t;
typedef short bf16x8 __attribute__((ext_vector_type(8)));
typedef float f32x4 __attribute__((ext_vector_type(4)));
typedef unsigned u32x4 __attribute__((ext_vector_type(4)));
typedef unsigned u32x2 __attribute__((ext_vector_type(2)));
constexpr int BM = 256, BK = 64, HALF = 128, HTB = HALF * BK * 2  , STAGE_BYTES = 8 * HTB, NXCD = 8, WGM = 8;

__host__ __device__ __forceinline__ int lds_byte(int r, int c) { const int st = (r >> 4) * 2 + (c >> 5), rr = r & 15, cc = c & 31, ob = rr * 64 + cc * 2; return st * 1024 + (ob ^ (((ob >> 9) & 1) << 5)); }
__host__ __device__ __forceinline__ void stage_rc(int b, int& R, int& C) { const int st = b / 1024, sb = b % 1024, swz = sb ^ (((sb >> 9) & 1) << 5); R = (st >> 1) * 16 + swz / 64; C = (st & 1) * 32 + (swz % 64) / 2; }
__host__ __device__ __forceinline__ int perm32(int rho) { const int n = rho >> 4, i = rho & 15; return 8 * (i >> 2) + 4 * n + (i & 3); }

struct Unit { int pm, pn; };
struct Gemm { const bf16_t* A; const bf16_t* Bt; int M, N, K, lda, ldb; };

struct StaticOrder {
    int nM, nN, nwg, G, c;
    __host__ __device__ void init(int M, int N, int G_, int c_) { nM = M / BM; nN = N / BM; nwg = nM * nN; G = G_; c = c_; }
    __host__ __device__ bool next(int i, Unit& u) const {
        const long L = (long)i * G + c; if (L >= nwg) return false;
        int wgid = (int)L; { const int q = nwg / NXCD, r = nwg % NXCD, xcd = wgid % NXCD, off = wgid / NXCD; wgid = (xcd < r ? xcd * (q + 1) : r * (q + 1) + (xcd - r) * q) + off; }
        const int nig = WGM * nN, gid = wgid / nig, fm = gid * WGM, gsz = (nM - fm) < WGM ? (nM - fm) : WGM;
        u.pm = fm + ((wgid % nig) % gsz); u.pn = (wgid % nig) / gsz; return true;
    }
    __device__ __forceinline__ void a_ready(const Unit&) const {}
    __device__ __forceinline__ void done(const Unit&) const {}
};

__device__ __forceinline__ unsigned cvt_pk_bf16(float lo, float hi) { unsigned r; asm volatile("v_cvt_pk_bf16_f32 %0, %1, %2" : "=v"(r) : "v"(lo), "v"(hi)); return r; }

template <class Epi, class Sched, bool ALIGN_EPI>
__device__ __forceinline__ void gemm_phase(PG8_LAS unsigned char* lds, const int tid, const Gemm g, const Sched& S, const Epi& E) {
    const int wid = __builtin_amdgcn_readfirstlane(tid >> 6), lane = tid & 63, wr = wid >> 2, wc = wid & 3, fr = lane & 15, fq = lane >> 4;
    const int K = g.K, nt = K / BK;
    unsigned voffA[2], voffB[2];
#pragma unroll
    for (int i = 0; i < 2; ++i) { int R, C; stage_rc(tid * 16 + i * 8192, R, C); const int Rb = Epi::PERM ? ((R & ~31) + perm32(R & 31)) : R;
        voffA[i] = (unsigned)(R * g.lda + C) * 2u; voffB[i] = (unsigned)(Rb * g.ldb + C) * 2u; }
    const size_t kstep = (size_t)(BK * 2);
    const size_t hstepA = (size_t)HALF * g.lda * 2, hstepB = (size_t)HALF * g.ldb * 2;
    const size_t tstepA = 2 * hstepA, tstepB = 2 * hstepB;
    const unsigned ldsw = (unsigned)wid * 1024u;
    const int aoff = lds_byte(wr * 64 + fr, fq * 8), boff = lds_byte(wc * 32 + fr, fq * 8);
#define PG8_SA(b, h) (((b) * 2 + (h)) * HTB)
#define PG8_SB(b, h) ((4 + (b) * 2 + (h)) * HTB)
#define PG8_STAGE(bufoff, gbase, voff) do { _Pragma("unroll") for (int _i = 0; _i < 2; ++_i) \
        __builtin_amdgcn_global_load_lds((const unsigned*)((const char*)(gbase) + (voff)[_i]), (PG8_LAS unsigned*)(lds + (bufoff) + ldsw + _i * 8192), 16, 0, 0); } while (0)
#define PG8_LDA(dst, b, h) do { _Pragma("unroll") for (int m = 0; m < 4; ++m) _Pragma("unroll") for (int k = 0; k < 2; ++k) dst[m][k] = *(const PG8_LAS bf16x8*)(lds + PG8_SA(b, h) + aoff + m * 2048 + k * 1024); } while (0)
#define PG8_LDB(dst, b, h) do { _Pragma("unroll") for (int n = 0; n < 2; ++n) _Pragma("unroll") for (int k = 0; k < 2; ++k) dst[n][k] = *(const PG8_LAS bf16x8*)(lds + PG8_SB(b, h) + boff + n * 2048 + k * 1024); } while (0)
#define PG8_MMA(ai, bj, At, Bt) do { __builtin_amdgcn_s_setprio(1); _Pragma("unroll") for (int m = 0; m < 4; ++m) _Pragma("unroll") for (int n = 0; n < 2; ++n) _Pragma("unroll") for (int k = 0; k < 2; ++k) \
        acc[ai][bj][m][n] = __builtin_amdgcn_mfma_f32_16x16x32_bf16(Bt[n][k], At[m][k], acc[ai][bj][m][n], 0, 0, 0); __builtin_amdgcn_s_setprio(0); } while (0)
#define PG8_WAIT_V(n) asm volatile("s_waitcnt vmcnt(" #n ")" ::: "memory")
#define PG8_WAIT_L(n) asm volatile("s_waitcnt lgkmcnt(" #n ")" ::: "memory")
#define PG8_BAR __builtin_amdgcn_s_barrier()
#define PG8_SCHED __builtin_amdgcn_sched_barrier(0)
    Unit cur, nxt; int ui = 0;
    if (!S.next(0, cur)) return;
    f32x4 acc[2][2][4][2];
#pragma unroll
    for (int a = 0; a < 2; ++a)
#pragma unroll
        for (int b = 0; b < 2; ++b)
#pragma unroll
            for (int m = 0; m < 4; ++m)
#pragma unroll
                for (int n = 0; n < 2; ++n) acc[a][b][m][n] = (f32x4){0.f, 0.f, 0.f, 0.f};
    bf16x8 At[4][2], B0[2][2], B1[2][2];
    const char* cA = (const char*)g.A + (size_t)cur.pm * tstepA; const char* cB = (const char*)g.Bt + (size_t)cur.pn * tstepB;
    S.a_ready(cur);
    E.prefetch_sync(cur, tid, lds, 0); E.prefetch_dma(cur, wid, lane, lds, 0);
#if GEMM_SP2
    PG8_STAGE(PG8_SB(0, 0), cB, voffB); PG8_STAGE(PG8_SB(0, 1), cB + hstepB, voffB); PG8_STAGE(PG8_SA(0, 0), cA, voffA); PG8_STAGE(PG8_SA(0, 1), cA + hstepA, voffA);
    if (wr == 1) PG8_BAR;
    PG8_WAIT_V(2); PG8_BAR;
    PG8_STAGE(PG8_SB(1, 0), cB + kstep, voffB); PG8_STAGE(PG8_SA(1, 0), cA + kstep, voffA); PG8_STAGE(PG8_SB(1, 1), cB + hstepB + kstep, voffB);
    PG8_WAIT_V(6); PG8_BAR;
#else
    PG8_STAGE(PG8_SB(0, 0), cB, voffB); PG8_STAGE(PG8_SA(0, 0), cA, voffA); PG8_STAGE(PG8_SB(0, 1), cB + hstepB, voffB); PG8_STAGE(PG8_SA(0, 1), cA + hstepA, voffA);
    if (wr == 1) PG8_BAR;
    PG8_WAIT_V(4); PG8_BAR;
    PG8_STAGE(PG8_SB(1, 0), cB + kstep, voffB); PG8_STAGE(PG8_SA(1, 0), cA + kstep, voffA); PG8_STAGE(PG8_SB(1, 1), cB + hstepB + kstep, voffB);
    PG8_WAIT_V(6); PG8_BAR;
#endif
    for (;;) {
        const bool has_next = S.next(ui + 1, nxt);
        const char* nA = has_next ? (const char*)g.A + (size_t)nxt.pm * tstepA : cA; const char* nB = has_next ? (const char*)g.Bt + (size_t)nxt.pn * tstepB : cB;
        for (int t = 0; t < nt; t += 2) {
            const bool last = (t == nt - 2);
            const char* a1 = cA + (size_t)(t + 1) * kstep;
            const char* a2 = last ? nA : cA + (size_t)(t + 2) * kstep; const char* b2 = last ? nB : cB + (size_t)(t + 2) * kstep;
            const char* a3 = a2 + kstep; const char* b3 = b2 + kstep;
            if (last && has_next) { S.a_ready(nxt); E.prefetch_dma(nxt, wid, lane, lds, (ui + 1) & 1); }
#if GEMM_SP2
            PG8_LDB(B0, 0, 0); PG8_LDB(B1, 0, 1); PG8_SCHED; PG8_LDA(At, 0, 0); PG8_STAGE(PG8_SA(1, 1), a1 + hstepA, voffA);
            PG8_WAIT_V(8); PG8_WAIT_L(0); PG8_BAR; PG8_MMA(0, 0, At, B0); PG8_MMA(0, 1, At, B1); PG8_BAR; PG8_SCHED;
            PG8_LDA(At, 0, 1); PG8_STAGE(PG8_SB(0, 0), b2, voffB); PG8_STAGE(PG8_SB(0, 1), b2 + hstepB, voffB); PG8_STAGE(PG8_SA(0, 0), a2, voffA);
            PG8_WAIT_V(8); PG8_WAIT_L(0); PG8_BAR; PG8_MMA(1, 0, At, B0); PG8_MMA(1, 1, At, B1); PG8_BAR; PG8_SCHED;
            PG8_LDB(B0, 1, 0); PG8_LDB(B1, 1, 1); PG8_SCHED; PG8_LDA(At, 1, 0); PG8_STAGE(PG8_SA(0, 1), a2 + hstepA, voffA);
            PG8_WAIT_V(8); PG8_WAIT_L(0); PG8_BAR; PG8_MMA(0, 0, At, B0); PG8_MMA(0, 1, At, B1); PG8_BAR; PG8_SCHED;
            PG8_LDA(At, 1, 1); PG8_STAGE(PG8_SB(1, 0), b3, voffB); PG8_STAGE(PG8_SB(1, 1), b3 + hstepB, voffB); PG8_STAGE(PG8_SA(1, 0), a3, voffA);
            PG8_WAIT_V(8); PG8_WAIT_L(0); PG8_BAR; PG8_MMA(1, 0, At, B0); PG8_MMA(1, 1, At, B1); PG8_BAR; PG8_SCHED;
#else
            PG8_LDB(B0, 0, 0); PG8_SCHED; PG8_LDA(At, 0, 0); PG8_STAGE(PG8_SA(1, 1), a1 + hstepA, voffA);
            PG8_WAIT_L(8); PG8_BAR; PG8_WAIT_L(0); PG8_MMA(0, 0, At, B0); PG8_BAR; PG8_SCHED;
            PG8_LDB(B1, 0, 1); PG8_STAGE(PG8_SB(0, 0), b2, voffB);
            PG8_BAR; PG8_WAIT_L(0); PG8_MMA(0, 1, At, B1); PG8_BAR;
            PG8_LDA(At, 0, 1); PG8_STAGE(PG8_SA(0, 0), a2, voffA);
            PG8_BAR; PG8_WAIT_L(0); PG8_MMA(1, 0, At, B0); PG8_BAR; PG8_SCHED;
            PG8_STAGE(PG8_SB(0, 1), b2 + hstepB, voffB);
            PG8_WAIT_V(6); PG8_BAR; PG8_MMA(1, 1, At, B1); PG8_BAR;
            PG8_LDB(B0, 1, 0); PG8_SCHED; PG8_LDA(At, 1, 0); PG8_STAGE(PG8_SA(0, 1), a2 + hstepA, voffA);
            PG8_WAIT_L(8); PG8_BAR; PG8_WAIT_L(0); PG8_MMA(0, 0, At, B0); PG8_BAR; PG8_SCHED;
            PG8_LDB(B1, 1, 1); PG8_STAGE(PG8_SB(1, 0), b3, voffB);
            PG8_BAR; PG8_WAIT_L(0); PG8_MMA(0, 1, At, B1); PG8_BAR;
            PG8_LDA(At, 1, 1); PG8_STAGE(PG8_SA(1, 0), a3, voffA);
            PG8_BAR; PG8_WAIT_L(0); PG8_MMA(1, 0, At, B0); PG8_BAR; PG8_SCHED;
            PG8_STAGE(PG8_SB(1, 1), b3 + hstepB, voffB);
            PG8_WAIT_V(6); PG8_BAR; PG8_MMA(1, 1, At, B1); PG8_BAR;
#endif
        }
        if constexpr (ALIGN_EPI) { if (wr == 0) PG8_BAR; }
        E(acc, cur, wr, wc, fr, fq, lds, ui & 1);
#if defined(PROBE_EPI)
        if constexpr ((Epi::KIND & PROBE_EPI) != 0) { for (int er_ = 1; er_ < PROBE_EPI_REP; ++er_) E(acc, cur, wr, wc, fr, fq, lds, ui & 1); }
#endif
        if (!has_next) break;
#pragma unroll
        for (int a = 0; a < 2; ++a)
#pragma unroll
            for (int b = 0; b < 2; ++b)
#pragma unroll
                for (int m = 0; m < 4; ++m)
#pragma unroll
                    for (int n = 0; n < 2; ++n) acc[a][b][m][n] = (f32x4){0.f, 0.f, 0.f, 0.f};
        cur = nxt; cA = nA; cB = nB; ++ui;
        E.prefetch_sync(cur, tid, lds, ui & 1);
        if constexpr (ALIGN_EPI) { if (wr == 1) PG8_BAR; }
    }
    PG8_WAIT_V(0);
    if constexpr (!ALIGN_EPI) { if (wr == 0) PG8_BAR; }
    PG8_BAR;
#undef PG8_SA
#undef PG8_SB
#undef PG8_STAGE
#undef PG8_LDA
#undef PG8_LDB
#undef PG8_MMA
#undef PG8_WAIT_V
#undef PG8_WAIT_L
#undef PG8_BAR
#undef PG8_SCHED
}
}
constexpr int NWAVES = 8, NTHR = 512;
constexpr int D = 1024, TCTX = 8192, TSMP = 2048, T = 10240, TP = T + 512;
constexpr int DFF = 2816, NMODV = 9 * 1024;
constexpr int EVEN_NP = 2816, ODD_NP = 1792;
constexpr float EPS = 1e-6f;
constexpr int NCHUNK = 80;

constexpr size_t MiB = 1u << 20;
constexpr size_t WS_CTL = 0, CTL_ZERO_BYTES = 64 * 1024;
constexpr size_t WS_MOD = 1 * MiB;
constexpr size_t WS_ROPE = WS_MOD + 512 * 1024;
constexpr size_t WS_DEC = WS_ROPE + 160 * 1024;
constexpr size_t WS_SSQ = WS_MOD + 768 * 1024;
constexpr size_t WS_BIAS = 2 * MiB;
constexpr size_t BIAS_LD = 5632, BIAS_MS = 16 * BIAS_LD;
constexpr size_t WS_BIASF = 15 * MiB;
constexpr size_t WS_WGU = 16 * MiB;
constexpr size_t SZ_WGU = (size_t)5632 * 1024 * 2;
constexpr size_t WS_WD = WS_WGU + 8 * SZ_WGU;
constexpr size_t SZ_WD = (size_t)1024 * 2816 * 2;
constexpr size_t WS_WIE = WS_WD + 8 * SZ_WD;
constexpr size_t SZ_WIE = (size_t)EVEN_NP * 1024 * 2;
constexpr size_t WS_WOE = WS_WIE + 2 * SZ_WIE;
constexpr size_t SZ_WO = (size_t)1024 * 1024 * 2;
constexpr size_t WS_WIO = WS_WOE + 2 * SZ_WO;
constexpr size_t SZ_WIO = (size_t)ODD_NP * 1024 * 2;
constexpr size_t WS_WOO = WS_WIO + 2 * SZ_WIO;
constexpr size_t WS_WUQ = WS_WOO + 2 * SZ_WO;
constexpr size_t SZ_WUQ = (size_t)768 * 384 * 2;
constexpr size_t WS_WKV = WS_WUQ + 2 * SZ_WUQ;
constexpr size_t SZ_WKV = (size_t)1024 * 256 * 2;
constexpr size_t WS_WEND = WS_WKV + 2 * SZ_WKV;
constexpr size_t WS_X = (WS_WEND + MiB - 1) / MiB * MiB;
constexpr size_t WS_XA = WS_X + (size_t)T * D * 4;
constexpr size_t WS_PROJ = WS_XA + (size_t)T * D * 2;
constexpr size_t WS_YMIX = WS_PROJ + (size_t)T * EVEN_NP * 2;
constexpr size_t WS_H = WS_YMIX + (size_t)T * D * 2;
constexpr size_t WS_ST = WS_H;
constexpr size_t WS_QA = WS_H;
constexpr size_t WS_CKVA = WS_QA + (size_t)T * 384 * 2;
constexpr size_t WS_KR = WS_CKVA + (size_t)TP * 256 * 2;
constexpr size_t WS_Q = WS_KR + (size_t)TP * 32 * 2;
constexpr size_t WS_KN = WS_Q + (size_t)T * 768 * 2;
constexpr size_t WS_VT = WS_KN + (size_t)TP * 512 * 2;
constexpr size_t WS_HEND = WS_H + (size_t)T * DFF * 2;
static_assert(WS_VT + (size_t)512 * TP * 2 <= WS_HEND, "odd-layer scratch fits the H overlay");
static_assert(WS_ST + (size_t)NCHUNK * 8 * 2 * 8192 * 4 <= WS_HEND, "chunk states fit the H overlay");
constexpr size_t WS_XCT = WS_HEND;
constexpr size_t WS_CC = WS_XCT + (size_t)NCHUNK * 8 * 8192 * 2;
constexpr size_t WS_CBM = WS_CC + (size_t)T * 256 * 2;
constexpr size_t WS_HIN = WS_CBM + (size_t)NCHUNK * 2 * 16384 * 2;
constexpr size_t WS_END = WS_HIN + (size_t)NCHUNK * 8 * 2 * 8192 * 2;

constexpr size_t OUT_Y = 0, OUT_SSD = (size_t)T * D, OUT_CKV = OUT_SSD + (size_t)32 * 2 * 2 * 8 * 64 * 128, OUT_KR = OUT_CKV + (size_t)32 * 2 * 256 * 256, OUT_END = OUT_KR + (size_t)32 * 2 * 256 * 32;

constexpr int RING_BYTES = 131072;
constexpr int LDSCTL_OFF = 144 * 1024 - 512, MISC_OFF = LDSCTL_OFF + 320;
constexpr int LDS_BYTES = 147456;

#define GAS __attribute__((address_space(1)))
#define LAS __attribute__((address_space(3)))
typedef unsigned short bf16;
typedef unsigned v4u __attribute__((ext_vector_type(4)));
typedef unsigned v2u __attribute__((ext_vector_type(2)));
typedef float f32x4 __attribute__((ext_vector_type(4)));
typedef short bf16x8 __attribute__((ext_vector_type(8)));
typedef GAS unsigned gu32;
#define RLX_AGENT __ATOMIC_RELAXED, __HIP_MEMORY_SCOPE_AGENT
__device__ __forceinline__ unsigned f2bf(float f) { unsigned u = __builtin_bit_cast(unsigned, f); return (u + 0x7fffu + ((u >> 16) & 1u)) >> 16; }
typedef float f32x2_t __attribute__((ext_vector_type(2)));
typedef __bf16 bf16x2_t __attribute__((ext_vector_type(2)));
__device__ __forceinline__ unsigned pk2(float lo, float hi) { const f32x2_t v = {lo, hi}; const bf16x2_t b = __builtin_convertvector(v, bf16x2_t); return __builtin_bit_cast(unsigned, b); }
__device__ __forceinline__ unsigned f2bf1(float f) { return pk2(f, 0.f) & 0xffffu; }
__device__ __forceinline__ float bflo(unsigned w) { return __builtin_bit_cast(float, w << 16); }
__device__ __forceinline__ float bfhi(unsigned w) { return __builtin_bit_cast(float, w & 0xffff0000u); }
__device__ __forceinline__ float bf1(bf16 h) { return __builtin_bit_cast(float, ((unsigned)h) << 16); }
__device__ __forceinline__ void unpack8(const v4u v, float* o) { o[0] = bflo(v.x); o[1] = bfhi(v.x); o[2] = bflo(v.y); o[3] = bfhi(v.y); o[4] = bflo(v.z); o[5] = bfhi(v.z); o[6] = bflo(v.w); o[7] = bfhi(v.w); }
__device__ __forceinline__ v4u pack8(const float* o) { v4u v; v.x = pk2(o[0], o[1]); v.y = pk2(o[2], o[3]); v.z = pk2(o[4], o[5]); v.w = pk2(o[6], o[7]); return v; }
template <int K> __device__ __forceinline__ float xlane(float v) { static_assert(K >= 1 && K < 32, "xor mask inside a 32-lane half");
    return __builtin_bit_cast(float, __builtin_amdgcn_ds_swizzle(__builtin_bit_cast(int, v), (K << 10) | 0x1F)); }
__device__ __forceinline__ float sum_x32(float v) { const unsigned u = __builtin_bit_cast(unsigned, v); const auto r = __builtin_amdgcn_permlane32_swap(u, u, false, false);
    return __builtin_bit_cast(float, (unsigned)r[0]) + __builtin_bit_cast(float, (unsigned)r[1]); }
__device__ __forceinline__ float max_x32(float v) { const unsigned u = __builtin_bit_cast(unsigned, v); const auto r = __builtin_amdgcn_permlane32_swap(u, u, false, false);
    return fmaxf(__builtin_bit_cast(float, (unsigned)r[0]), __builtin_bit_cast(float, (unsigned)r[1])); }
__device__ __forceinline__ float wave_sum(float v) {
    v += xlane<1>(v); v += xlane<2>(v); v += xlane<4>(v); v += xlane<8>(v); v += xlane<16>(v);
    return sum_x32(v);
}
__device__ __forceinline__ float frcp(float x) { return __builtin_amdgcn_rcpf(x); }
__device__ __forceinline__ float frsq(float x) { return __builtin_amdgcn_rsqf(x); }
__device__ __forceinline__ float sigmoidf_(float x) { return frcp(1.0f + __expf(-x)); }
__device__ __forceinline__ float siluf_(float x) { return x * frcp(1.0f + __expf(-x)); }
__device__ __forceinline__ float gelu_tanh(float x) { const float y = 0.7978845608028654f * (x + 0.044715f * x * x * x); const float t = 1.0f - 2.0f * frcp(1.0f + __expf(2.0f * y)); return 0.5f * x * (1.0f + t); }
__device__ __forceinline__ float softplusf_(float x) { const float e = __expf(x); return x > 20.f ? x : (e < 1e-3f ? e * (1.0f - 0.5f * e) : __logf(1.0f + e)); }
__device__ __forceinline__ int modrow_of_tile(int pm) { return pm < 32 ? 0 : 1 + ((pm - 32) >> 2); }
__device__ __forceinline__ int modrow_of_tok(int t) { return t < TCTX ? 0 : 1 + ((t - TCTX) >> 10); }

#define XB_TMO      128
#define XB_XCNT(j)  (256  + 64 * (j))
#define XB_XSUB(j)  (1280 + 64 * (j))
#define XB_XGEN(j)  (2304 + 64 * (j))
#define XB_TOP      3328
#define XB_TOPGEN   3392
#define XCD_BAR_WORDS 3456
#define XB_SPIN_CAP (1u << 22)
__device__ __forceinline__ unsigned xb_ld(unsigned* p)              { return __hip_atomic_load(p, __ATOMIC_RELAXED, __HIP_MEMORY_SCOPE_AGENT); }
__device__ __forceinline__ unsigned xb_add(unsigned* p, unsigned v) { return __hip_atomic_fetch_add(p, v, __ATOMIC_RELAXED, __HIP_MEMORY_SCOPE_AGENT); }
__device__ __forceinline__ unsigned xb_xcc_id() { return (unsigned)__builtin_amdgcn_s_getreg((3 << 11) | 20) & 0xFu; }
#define XB_SPIN(cond, bar) do { unsigned _sp = 0; while (cond) { __builtin_amdgcn_s_sleep(1); \
    if ((++_sp & 255u) == 0u) { if (xb_ld(&(bar)[XB_TMO])) break; if (_sp > XB_SPIN_CAP) { atomicAdd(&(bar)[XB_TMO], 1u); break; } } } } while (0)
struct XcdBarrier { unsigned* bar; unsigned x; volatile LAS unsigned* st; };
__device__ __forceinline__ XcdBarrier xcd_barrier_post(unsigned* bar, volatile LAS unsigned* st) {
    XcdBarrier b; b.bar = bar; b.x = xb_xcc_id(); b.st = st;
    if (threadIdx.x == 0) (void)xb_add(&bar[XB_XCNT(b.x)], 1u);
    return b;
}
__device__ __forceinline__ void xcd_barrier_complete(unsigned* bar, unsigned x, unsigned& nloc, unsigned& nx) {
    const unsigned G = gridDim.x * gridDim.y * gridDim.z;
    unsigned sum, cnt, mine, sp = 0u;
    for (;;) {
        sum = 0u; cnt = 0u; mine = 0u;
#pragma unroll
        for (unsigned j = 0; j < 16; ++j) { const unsigned c = xb_ld(&bar[XB_XCNT(j)]); sum += c; cnt += (c > 0u) ? 1u : 0u; mine = (j == x) ? c : mine; }
        if (sum == G) break;
        __builtin_amdgcn_s_sleep(1);
        if ((++sp & 255u) == 0u) { if (xb_ld(&bar[XB_TMO])) break; if (sp > XB_SPIN_CAP) { atomicAdd(&bar[XB_TMO], 1u); break; } }
    }
    nloc = mine > 0u ? mine : 1u; nx = cnt > 0u ? cnt : 1u;
}
__device__ __forceinline__ void xcd_barrier(const XcdBarrier& b) {
    asm volatile("s_waitcnt vmcnt(0)" ::: "memory");
    __syncthreads();
    if (threadIdx.x == 0) {
        unsigned* bar = b.bar;
        __builtin_amdgcn_s_waitcnt(0);
        unsigned nloc = b.st[0], nx = b.st[1];
        if (nloc == 0u) { xcd_barrier_complete(bar, b.x, nloc, nx); b.st[0] = nloc; b.st[1] = nx; }
        const unsigned k = b.st[2] + 1u; b.st[2] = k;
        const unsigned old = xb_add(&bar[XB_XSUB(b.x)], 1u);
        if (old + 1u == k * nloc) {
            __builtin_amdgcn_fence(__ATOMIC_RELEASE, "agent");
            asm volatile("s_waitcnt vmcnt(0)" ::: "memory");
            const unsigned og = xb_add(&bar[XB_TOP], 1u);
            if (og + 1u == k * nx) xb_add(&bar[XB_TOPGEN], 1u);
        }
        XB_SPIN(xb_ld(&bar[XB_TOPGEN]) < k, bar);
        __builtin_amdgcn_fence(__ATOMIC_ACQUIRE, "agent");
        asm volatile("s_waitcnt vmcnt(0)" ::: "memory");
    }
    __syncthreads();
}

struct Args { const float* in[34]; float* out; unsigned char* ws; int ph_lo, ph_hi, li, pad; };
typedef const __attribute__((address_space(4))) Args* CArgsP;
enum { I_XP = 0, I_XS, I_SSD, I_CCKV, I_CKR, I_C, I_CCTX, I_WMOD, I_BMOD, I_GNORM, I_WGU, I_WDN, I_WIE, I_WOE, I_WSP, I_BSP, I_GV, I_WCS, I_BCS, I_DTB, I_ALOG, I_DSK, I_GSO,
       I_WIO, I_WOO, I_GCQ, I_WUQ, I_GCKV, I_WUKV, I_WDW, I_BDW, I_GLN, I_BLN, I_GFIN };
using pg8::Unit;
constexpr int EP_PART = RING_BYTES, EP_S = RING_BYTES + 4096, EP_B = RING_BYTES + 4096 + 8192;
__device__ __forceinline__ void epi_prefetch_dma(GAS unsigned char* ws, int bias_off, const Unit& u, int wid, int lane, PG8_LAS unsigned char* ldsl, int par) {
    if (wid < 4) __builtin_amdgcn_global_load_lds((const GAS unsigned*)(ws + WS_SSQ + ((size_t)(u.pm * 256 + 64 * wid + lane) * 4) * 4), (PG8_LAS unsigned*)(ldsl + EP_S + par * 4096 + wid * 1024), 16, 0, 0);
    else if (wid == 4) __builtin_amdgcn_global_load_lds((const GAS unsigned*)(ws + WS_BIASF + ((size_t)bias_off / 16 + (size_t)modrow_of_tile(u.pm) * BIAS_LD + u.pn * 256 + 4 * lane) * 4), (PG8_LAS unsigned*)(ldsl + EP_B + par * 1024), 16, 0, 0);
}
__device__ __forceinline__ void epi_prefetch_sync16(GAS unsigned char* ws, int bias_off, const Unit& u, int tid, PG8_LAS unsigned char* ldsl, int par) {
    if (tid < 256) *(PG8_LAS pg8::f32x4*)(ldsl + EP_S + par * 4096 + tid * 16) = *(const GAS pg8::f32x4*)(ws + WS_SSQ + ((size_t)(u.pm * 256 + tid) * 4) * 4);
    else { const GAS float* bp = (const GAS float*)(ws + WS_BIAS) + (size_t)bias_off + (size_t)modrow_of_tile(u.pm) * BIAS_MS + u.pn * 256 + (tid - 256); float b = 0.f;
#pragma unroll
        for (int kb = 0; kb < 16; ++kb) b += bp[(size_t)kb * BIAS_LD];
        ((PG8_LAS float*)(ldsl + EP_B))[par * 256 + (tid - 256)] = b; }
}
__device__ __forceinline__ float epi_row_rstd(const PG8_LAS unsigned char* ldsl, int par, int rl) { const pg8::f32x4 s = *(const PG8_LAS pg8::f32x4*)(ldsl + EP_S + par * 4096 + rl * 16); return frsq(((s[0] + s[1]) + (s[2] + s[3])) * (1.f / D) + EPS); }
struct EpiSwiglu {
    static constexpr bool PERM = true; static constexpr int KIND = 1;
    GAS unsigned char* ws; int bias_off, nparts;
    __device__ __forceinline__ void prefetch_dma(const Unit& u, int wid, int lane, PG8_LAS unsigned char* ldsl, int par) const { if (nparts == 1) epi_prefetch_dma(ws, bias_off, u, wid, lane, ldsl, par); }
    __device__ __forceinline__ void prefetch_sync(const Unit& u, int tid, PG8_LAS unsigned char* ldsl, int par) const { if (nparts != 1) epi_prefetch_sync16(ws, bias_off, u, tid, ldsl, par); }
    __device__ __forceinline__ void operator()(const pg8::f32x4 (&acc)[2][2][4][2], const Unit& u, int wr, int wc, int fr, int fq, PG8_LAS unsigned char* ldsl, int par) const {
        bf16* H = (bf16*)(GAS bf16*)(ws + WS_H);
        const PG8_LAS float* bb = (const PG8_LAS float*)(ldsl + EP_B) + par * 256 + wc * 32 + 8 * fq;
        const int row0 = u.pm * 256 + wr * 64 + fr, col0 = u.pn * 128 + wc * 32 + 8 * fq;
        const pg8::f32x4 bg0 = *(const PG8_LAS pg8::f32x4*)bb, bg1 = *(const PG8_LAS pg8::f32x4*)(bb + 4), bu0 = *(const PG8_LAS pg8::f32x4*)(bb + 128), bu1 = *(const PG8_LAS pg8::f32x4*)(bb + 132);
#pragma unroll
        for (int ai = 0; ai < 2; ++ai)
#pragma unroll
            for (int m = 0; m < 4; ++m) {
                const int rl = ai * 128 + wr * 64 + m * 16 + fr;
                const float rs = epi_row_rstd(ldsl, par, rl);
                bf16* rowp = H + (size_t)(u.pm * 256 + rl) * DFF + col0;
                const pg8::f32x4 g0 = acc[ai][0][m][0] * rs + bg0, g1 = acc[ai][0][m][1] * rs + bg1, u0 = acc[ai][1][m][0] * rs + bu0, u1 = acc[ai][1][m][1] * rs + bu1;
                float gg[8], uu[8], e[8], o[8];
#pragma unroll
                for (int j = 0; j < 4; ++j) { gg[j] = g0[j]; gg[4 + j] = g1[j]; uu[j] = u0[j]; uu[4 + j] = u1[j]; }
#pragma unroll
                for (int j = 0; j < 8; ++j) e[j] = __builtin_amdgcn_exp2f(gg[j] * -1.4426950408889634f);
#pragma unroll
                for (int j = 0; j < 8; ++j) e[j] = __builtin_amdgcn_rcpf(1.0f + e[j]);
#pragma unroll
                for (int j = 0; j < 8; ++j) o[j] = (gg[j] * uu[j]) * e[j];
                pg8::u32x4 w; w.x = pg8::cvt_pk_bf16(o[0], o[1]); w.y = pg8::cvt_pk_bf16(o[2], o[3]); w.z = pg8::cvt_pk_bf16(o[4], o[5]); w.w = pg8::cvt_pk_bf16(o[6], o[7]);
                *(pg8::u32x4*)rowp = w;
            }
        (void)row0;
    }
};
struct EpiResid {
    static constexpr bool PERM = true; static constexpr int KIND = 4;
    GAS unsigned char* ws; const float* gn; int gate_off, scn_off; float coef;
    __device__ __forceinline__ void prefetch_dma(const Unit&, int, int, PG8_LAS unsigned char*, int) const {}
    __device__ __forceinline__ void prefetch_sync(const Unit&, int, PG8_LAS unsigned char*, int) const {}
    __device__ __forceinline__ void operator()(const pg8::f32x4 (&acc)[2][2][4][2], const Unit& u, int wr, int wc, int fr, int fq, PG8_LAS unsigned char* ldsl, int) const {
        bf16* X = (bf16*)(GAS bf16*)(ws + WS_X); const float* gate = (const float*)(const GAS float*)(ws + WS_MOD) + gate_off; const float* scn = (const float*)(const GAS float*)(ws + WS_MOD) + scn_off;
        bf16* XA = (bf16*)(GAS bf16*)(ws + WS_XA); float* SSQ = (float*)(GAS float*)(ws + WS_SSQ); PG8_LAS float* part = (PG8_LAS float*)(ldsl + EP_PART);
        const int row0 = u.pm * 256 + wr * 64 + fr, col0 = u.pn * 256 + wc * 32 + 8 * fq;
        const int mr = modrow_of_tile(u.pm);
        float ss[2][4];
#pragma unroll
        for (int ai = 0; ai < 2; ++ai)
#pragma unroll
            for (int m = 0; m < 4; ++m) ss[ai][m] = 0.f;
#pragma unroll
        for (int bj = 0; bj < 2; ++bj) {
            const int co = col0 + bj * 128;
            const float* gp = gate + (size_t)mr * NMODV + co; const float* sp = scn + (size_t)mr * NMODV + co;
            const pg8::f32x4 gv0 = *(const pg8::f32x4*)gp * coef, gv1 = *(const pg8::f32x4*)(gp + 4) * coef;
            const pg8::f32x4 gc0 = *(const pg8::f32x4*)(gn + co) * (*(const pg8::f32x4*)sp + 1.0f), gc1 = *(const pg8::f32x4*)(gn + co + 4) * (*(const pg8::f32x4*)(sp + 4) + 1.0f);
#pragma unroll
            for (int ai = 0; ai < 2; ++ai) {
                pg8::u32x4 xo[4];
#pragma unroll
                for (int m = 0; m < 4; ++m) xo[m] = *(const pg8::u32x4*)(X + (size_t)(row0 + ai * 128 + m * 16) * D + co);
#pragma unroll
                for (int m = 0; m < 4; ++m) {
                    const size_t off = (size_t)(row0 + ai * 128 + m * 16) * D + co;
                    const pg8::u32x4 xw = xo[m];
                    const pg8::f32x4 x0 = {bflo(xw.x), bfhi(xw.x), bflo(xw.y), bfhi(xw.y)}, x1 = {bflo(xw.z), bfhi(xw.z), bflo(xw.w), bfhi(xw.w)};
                    const pg8::f32x4 n0 = x0 + gv0 * acc[ai][bj][m][0], n1 = x1 + gv1 * acc[ai][bj][m][1];
                    ss[ai][m] += ((n0[0] * n0[0] + n0[1] * n0[1]) + (n0[2] * n0[2] + n0[3] * n0[3])) + ((n1[0] * n1[0] + n1[1] * n1[1]) + (n1[2] * n1[2] + n1[3] * n1[3]));
                    pg8::u32x4 w; w.x = pg8::cvt_pk_bf16(n0[0], n0[1]); w.y = pg8::cvt_pk_bf16(n0[2], n0[3]); w.z = pg8::cvt_pk_bf16(n1[0], n1[1]); w.w = pg8::cvt_pk_bf16(n1[2], n1[3]);
                    *(pg8::u32x4*)(X + off) = w;
                    const pg8::f32x4 a0 = n0 * gc0, a1 = n1 * gc1;
                    pg8::u32x4 v; v.x = pg8::cvt_pk_bf16(a0[0], a0[1]); v.y = pg8::cvt_pk_bf16(a0[2], a0[3]); v.z = pg8::cvt_pk_bf16(a1[0], a1[1]); v.w = pg8::cvt_pk_bf16(a1[2], a1[3]);
                    *(pg8::u32x4*)(XA + off) = v;
                }
            }
        }
#pragma unroll
        for (int ai = 0; ai < 2; ++ai)
#pragma unroll
            for (int m = 0; m < 4; ++m) { float s = ss[ai][m]; s += xlane<16>(s); s = sum_x32(s);
                if (fq == 0) part[wc * 256 + ai * 128 + wr * 64 + m * 16 + fr] = s; }
        asm volatile("s_waitcnt lgkmcnt(0)" ::: "memory"); __builtin_amdgcn_s_barrier(); asm volatile("" ::: "memory");
        const int t = (wr * 4 + wc) * 64 + fq * 16 + fr;
        if (t < 256) SSQ[(size_t)(u.pm * 256 + t) * 4 + u.pn] = (part[t] + part[256 + t]) + (part[512 + t] + part[768 + t]);
    }
};
struct EpiStore {
    static constexpr bool PERM = true; static constexpr int KIND = 2;
    GAS unsigned char* ws; unsigned o_off; int ldc; int bias_off;
    __device__ __forceinline__ void prefetch_dma(const Unit& u, int wid, int lane, PG8_LAS unsigned char* ldsl, int par) const { if (bias_off >= 0) epi_prefetch_dma(ws, bias_off, u, wid, lane, ldsl, par); }
    __device__ __forceinline__ void prefetch_sync(const Unit&, int, PG8_LAS unsigned char*, int) const {}
    __device__ __forceinline__ void operator()(const pg8::f32x4 (&acc)[2][2][4][2], const Unit& u, int wr, int wc, int fr, int fq, PG8_LAS unsigned char* ldsl, int par) const {
        bf16* O = (bf16*)(GAS bf16*)(ws + o_off);
        const PG8_LAS float* bb = (const PG8_LAS float*)(ldsl + EP_B) + par * 256 + wc * 32 + 8 * fq;
        const int col0 = u.pn * 256 + wc * 32 + 8 * fq; const bool nrm = bias_off >= 0;
        pg8::f32x4 b[2][2];
#pragma unroll
        for (int bj = 0; bj < 2; ++bj)
#pragma unroll
            for (int n = 0; n < 2; ++n) { const pg8::f32x4 bv = *(const PG8_LAS pg8::f32x4*)(bb + bj * 128 + 4 * n); b[bj][n] = nrm ? bv : (pg8::f32x4){0.f, 0.f, 0.f, 0.f}; }
#pragma unroll
        for (int ai = 0; ai < 2; ++ai)
#pragma unroll
            for (int m = 0; m < 4; ++m) {
                const int rl = ai * 128 + wr * 64 + m * 16 + fr;
                const float rs0 = epi_row_rstd(ldsl, par, rl), rs = nrm ? rs0 : 1.0f;
                bf16* rowp = O + (size_t)(u.pm * 256 + rl) * ldc + col0;
#pragma unroll
                for (int bj = 0; bj < 2; ++bj) {
                    const pg8::f32x4 v0 = acc[ai][bj][m][0] * rs + b[bj][0], v1 = acc[ai][bj][m][1] * rs + b[bj][1];
                    pg8::u32x4 w; w.x = pg8::cvt_pk_bf16(v0[0], v0[1]); w.y = pg8::cvt_pk_bf16(v0[2], v0[3]); w.z = pg8::cvt_pk_bf16(v1[0], v1[1]); w.w = pg8::cvt_pk_bf16(v1[2], v1[3]);
                    *(pg8::u32x4*)(rowp + bj * 128) = w;
                }
            }
    }
};

struct Frame {
    unsigned char* lds;
    mutable int tid, lane; int wave, bid, G;
    __device__ __forceinline__ void relane() const { int ln; asm volatile("v_mbcnt_lo_u32_b32 %0, -1, 0\n\tv_mbcnt_hi_u32_b32 %0, -1, %0" : "=v"(ln)); lane = ln; tid = wave * 64 + ln; }
    CArgsP a;
    GAS unsigned char* ws;
};
#define WSP(type, off) ((type*)(GAS type*)(F.ws + (off)))
#define AIN(i) ((const float*)(const GAS float*)F.a->in[i])
#define AOUT ((float*)(GAS float*)F.a->out)

struct ConvD { const float* W; bf16* WT; const float* shift; float* bias_out; int N, ldt, k0, n0, dst; };
__device__ __forceinline__ void conv_load(const ConvD& d, int lane, f32x4 (&v)[8]) {
    const int n4 = (lane & 7) * 4; const bool ok4 = d.n0 + n4 < d.N;
#pragma unroll
    for (int i = 0; i < 8; ++i) { const int kk = 8 * i + (lane >> 3);
        v[i] = ok4 ? *(const f32x4*)(d.W + (size_t)(d.k0 + kk) * d.N + d.n0 + n4) : (f32x4){0.f, 0.f, 0.f, 0.f}; }
}
__device__ __forceinline__ void conv_proc(const ConvD& d, const f32x4 (&v)[8], float* scr, int lane) {
    const int n4 = (lane & 7) * 4;
#pragma unroll
    for (int i = 0; i < 8; ++i) { const int kk = 8 * i + (lane >> 3);
        scr[kk * 33 + n4] = v[i].x; scr[kk * 33 + n4 + 1] = v[i].y; scr[kk * 33 + n4 + 2] = v[i].z; scr[kk * 33 + n4 + 3] = v[i].w; }
    if (d.bias_out) {
#pragma unroll
        for (int m = 0; m < 3; ++m) scr[64 * 33 + m * 64 + lane] = d.shift[(size_t)m * NMODV + lane];
    }
    asm volatile("s_waitcnt lgkmcnt(0)" ::: "memory");
    const int c = lane & 7;
#pragma unroll
    for (int j = 0; j < 4; ++j) { const int nn = (lane >> 3) + 8 * j; const float* s = scr + (8 * c) * 33 + nn;
        v4u o; o.x = pk2(s[0 * 33], s[1 * 33]); o.y = pk2(s[2 * 33], s[3 * 33]); o.z = pk2(s[4 * 33], s[5 * 33]); o.w = pk2(s[6 * 33], s[7 * 33]);
        *(v4u*)(d.WT + (size_t)(d.dst + nn) * d.ldt + d.k0 + 8 * c) = o; }
    if (d.bias_out) {
        const int kh = lane >> 5, nl = lane & 31; float a0 = 0.f, a1 = 0.f, a2 = 0.f;
#pragma unroll 8
        for (int i = 0; i < 32; ++i) { const int kk = kh * 32 + i; const float wv = scr[kk * 33 + nl];
            a0 += wv * scr[64 * 33 + kk]; a1 += wv * scr[64 * 33 + 64 + kk]; a2 += wv * scr[64 * 33 + 128 + kk]; }
        a0 = sum_x32(a0); a1 = sum_x32(a1); a2 = sum_x32(a2);
        if (lane < 32) { float* bo = d.bias_out + (size_t)(d.k0 >> 6) * BIAS_LD + d.dst + nl; bo[0] = a0; bo[BIAS_MS] = a1; bo[2 * BIAS_MS] = a2; }
    }
    asm volatile("s_waitcnt lgkmcnt(0)" ::: "memory");
}
constexpr int CI_DN = 44 * 32, CI_OE = 16 * 32, CI_UQ = 6 * 24, CI_KV = 4 * 32, CI_GU = 16 * 176, CI_IE = 16 * 88, CI_IO = 16 * 56;
__host__ __device__ constexpr int conv_na(int l) { return 2 * CI_DN + CI_OE + ((l & 1) ? CI_UQ + CI_KV : 0); }
__host__ __device__ constexpr int conv_nb(int l) { return 2 * CI_GU + ((l & 1) ? CI_IO : CI_IE); }
__device__ __forceinline__ ConvD conv_desc_a(const Frame& F, int l, int it) {
    int r = it; const int hi = l >> 1;
    if (r < 2 * CI_DN) { const int w = l * 2 + r / CI_DN, q = r % CI_DN, kb = q / 32, nb = q % 32;
        return ConvD{AIN(I_WDN) + (size_t)w * DFF * 1024, WSP(bf16, WS_WD + w * SZ_WD), nullptr, nullptr, 1024, DFF, kb * 64, nb * 32, nb * 32}; } r -= 2 * CI_DN;
    if (r < CI_OE) { const int kb = r / 32, nb = r % 32;
        if (l & 1) return ConvD{AIN(I_WOO) + (size_t)hi * 1024 * 1024, WSP(bf16, WS_WOO + hi * SZ_WO), nullptr, nullptr, 1024, 1024, kb * 64, nb * 32, nb * 32};
        return ConvD{AIN(I_WOE) + (size_t)hi * 1024 * 1024, WSP(bf16, WS_WOE + hi * SZ_WO), nullptr, nullptr, 1024, 1024, kb * 64, nb * 32, nb * 32}; } r -= CI_OE;
    if (r < CI_UQ) { const int kb = r / 24, nb = r % 24;
        return ConvD{AIN(I_WUQ) + (size_t)hi * 384 * 768, WSP(bf16, WS_WUQ + hi * SZ_WUQ), nullptr, nullptr, 768, 384, kb * 64, nb * 32, nb * 32}; } r -= CI_UQ;
    { const int kb = r / 32, nb = r % 32, n0 = nb * 32, h = n0 >> 7, rr = n0 & 127;
        const int dst = (rr < 64 ? 0 : 512) + h * 64 + (rr & 63);
        return ConvD{AIN(I_WUKV) + (size_t)hi * 256 * 1024, WSP(bf16, WS_WKV + hi * SZ_WKV), nullptr, nullptr, 1024, 256, kb * 64, n0, dst}; }
}
__device__ __forceinline__ ConvD conv_desc_b(const Frame& F, int l, int it) {
    int r = it; const int hi = l >> 1; const float* MOD = WSP(float, WS_MOD) + (size_t)l * 3 * NMODV; float* BIAS = WSP(float, WS_BIAS) + (size_t)(l * 3) * 3 * BIAS_MS;
    if (r < 2 * CI_GU) { const int f = r / CI_GU, w = l * 2 + f, q = r % CI_GU, kb = q / 176, nb = q % 176, n0 = nb * 32;
        const int dst = (n0 < DFF) ? ((n0 >> 7) * 256 + (n0 & 127)) : (((n0 - DFF) >> 7) * 256 + 128 + ((n0 - DFF) & 127));
        return ConvD{AIN(I_WGU) + (size_t)w * 1024 * 5632, WSP(bf16, WS_WGU + w * SZ_WGU), MOD + (f == 0 ? 0 : 6) * 1024 + kb * 64, BIAS + (size_t)(f == 0 ? 0 : 2) * 3 * BIAS_MS, 5632, 1024, kb * 64, n0, dst}; } r -= 2 * CI_GU;
    if (l & 1) { const int kb = r / 56, nb = r % 56;
        return ConvD{AIN(I_WIO) + (size_t)hi * 1024 * 1696, WSP(bf16, WS_WIO + hi * SZ_WIO), MOD + 3 * 1024 + kb * 64, BIAS + (size_t)3 * BIAS_MS, 1696, 1024, kb * 64, nb * 32, nb * 32}; }
    { const int kb = r / 88, nb = r % 88;
        return ConvD{AIN(I_WIE) + (size_t)hi * 1024 * 2576, WSP(bf16, WS_WIE + hi * SZ_WIE), MOD + 3 * 1024 + kb * 64, BIAS + (size_t)3 * BIAS_MS, 2576, 1024, kb * 64, nb * 32, nb * 32}; }
}
template <bool LB> __device__ __forceinline__ void conv_run(const Frame& F, int l, int lo, int hi, int gw, int NGW, float* scr) {
    int it = lo + gw; if (it >= hi) return;
    ConvD d = LB ? conv_desc_b(F, l, it) : conv_desc_a(F, l, it);
    f32x4 v[8]; conv_load(d, F.lane, v);
    for (;;) {
        const int itn = it + NGW; const bool more = itn < hi;
        ConvD dn = d; f32x4 vn[8];
        if (more) { dn = LB ? conv_desc_b(F, l, itn) : conv_desc_a(F, l, itn); conv_load(dn, F.lane, vn); }
        conv_proc(d, v, scr, F.lane);
        if (!more) break;
        d = dn; it = itn;
#pragma unroll
        for (int i = 0; i < 8; ++i) v[i] = vn[i];
    }
}
template <int N4> __device__ __forceinline__ void mod_tile(const Frame& F, int l, int tile) {
    constexpr int KG = 504 / N4, NC = 4 * N4;
    float* sv = (float*)F.lds;
    float* red = (float*)(F.lds + 12288);
    __syncthreads();
    for (int i = F.tid; i < 3072; i += NTHR) { const int r = i >> 10, k = i & 1023; const float c = (r == 0) ? AIN(I_CCTX)[k] : AIN(I_C)[(r - 1) * 1024 + k]; sv[i] = siluf_(c); }
    __syncthreads();
    const int n0 = tile * NC, n4 = F.tid % N4, kg = F.tid / N4;
    if (F.tid < 504) {
        f32x4 a0 = {0.f, 0.f, 0.f, 0.f}, a1 = a0, a2 = a0;
        const float* wp = AIN(I_WMOD) + (size_t)l * 1024 * NMODV + n0 + 4 * n4;
#pragma unroll 8
        for (int k = kg; k < 1024; k += KG) { const f32x4 w = *(const f32x4*)(wp + (size_t)k * NMODV); a0 += w * sv[k]; a1 += w * sv[1024 + k]; a2 += w * sv[2048 + k]; }
        *(f32x4*)(red + (kg * 3 + 0) * NC + 4 * n4) = a0; *(f32x4*)(red + (kg * 3 + 1) * NC + 4 * n4) = a1; *(f32x4*)(red + (kg * 3 + 2) * NC + 4 * n4) = a2;
    }
    __syncthreads();
    for (int o = F.tid; o < 3 * NC; o += NTHR) { const int r = o / NC, n = o % NC; float s = AIN(I_BMOD)[l * NMODV + n0 + n];
        for (int g = 0; g < KG; ++g) s += red[(g * 3 + r) * NC + n];
        WSP(float, WS_MOD)[(size_t)(l * 3 + r) * NMODV + n0 + n] = s; }
    __syncthreads();
}
__device__ __forceinline__ void bias_reduce(const Frame& F, int l, int kmask, int bgi, int nbg) {
    const float* BP = WSP(float, WS_BIAS); float* BF = WSP(float, WS_BIASF);
    const int gt = bgi * NTHR + F.tid, NT = nbg * NTHR;
    for (int i = gt; i < 3 * 3 * (int)BIAS_LD; i += NT) { const int kind = i / (3 * (int)BIAS_LD), rem = i % (3 * (int)BIAS_LD), m = rem / (int)BIAS_LD, n = rem % (int)BIAS_LD;
        if (!((kmask >> kind) & 1)) continue;
        const float* p = BP + ((size_t)(l * 3 + kind) * 3 + m) * BIAS_MS + n; float b = 0.f;
#pragma unroll
        for (int kb = 0; kb < 16; ++kb) b += p[(size_t)kb * BIAS_LD];
        BF[((size_t)(l * 3 + kind) * 3 + m) * BIAS_LD + n] = b; }
}
__device__ __forceinline__ void background_work(const Frame& F, int l, int win, int bgi, int nbg) {
    F.relane();
    if (nbg <= 0) return;
    if (win == 0) bias_reduce(F, l, 6, bgi, nbg);
    if (l >= 3) return;
    const int ln = l + 1;
    if (win == 2) bias_reduce(F, ln, 1, bgi, nbg);
    float* scr = (float*)(F.lds + F.wave * 16384);
    const int gw = bgi * NWAVES + F.wave, NGW = nbg * NWAVES;
    if (win == 0) {
        for (int t = bgi; t < 96; t += nbg) mod_tile<24>(F, ln, t);
        const int na = conv_na(ln);
        conv_run<false>(F, ln, 0, na, gw, NGW, scr);
    } else {
        const int nb = conv_nb(ln), cut = CI_GU;
        const int lo = win == 1 ? 0 : cut, hi_ = win == 1 ? cut : nb;
        conv_run<true>(F, ln, lo, hi_, gw, NGW, scr);
    }
}
__device__ __forceinline__ void p0_phase(const Frame& F) {
    F.relane();
    for (int t = F.bid; t < 256; t += F.G) mod_tile<9>(F, 0, t);
    {
        float* scr = (float*)(F.lds + F.wave * 16384);
        const int gw = F.bid * NWAVES + F.wave, NGW = F.G * NWAVES;
        conv_run<false>(F, 0, 0, conv_na(0), gw, NGW, scr);
    }
    {
        const size_t gt = (size_t)F.bid * NTHR + F.tid, NT = (size_t)F.G * NTHR;
        for (size_t i = gt; i < 1024 * 16; i += NT) { const int pos = (int)(i >> 4), ax = (int)(i >> 3) & 1, f = (int)i & 7;
            const float freq = exp2f(-(float)f * (13.287712379549449f / 8.0f));
            const float ang = (float)(ax == 0 ? (pos >> 6) : (pos & 63)) * freq;
            float sn, cs; sincosf(ang, &sn, &cs);
            WSP(float, WS_ROPE)[2 * i] = cs; WSP(float, WS_ROPE)[2 * i + 1] = sn; }
    }
}
__device__ __forceinline__ void p1_copy_phase(const Frame& F) {
    F.relane();
    float* scr = (float*)(F.lds + F.wave * 16384);
    const int gw = F.bid * NWAVES + F.wave, NGW = F.G * NWAVES;
    conv_run<true>(F, 0, 0, conv_nb(0), gw, NGW, scr);
}

__device__ __forceinline__ void norm0_phase(const Frame& F) {
    F.relane();
    const int gw = F.bid * NWAVES + F.wave, NGW = F.G * NWAVES;
    bf16* X = WSP(bf16, WS_X); bf16* XA = WSP(bf16, WS_XA); float* SSQ = WSP(float, WS_SSQ);
    const float* g = AIN(I_GNORM); const float* scale = WSP(float, WS_MOD) + 1024;
    for (int row = gw; row < T; row += NGW) {
        const int r = modrow_of_tok(row);
        const f32x4* xr = (const f32x4*)(row < TCTX ? AIN(I_XP) + (size_t)row * D : AIN(I_XS) + (size_t)(row - TCTX) * D) + F.lane;
        f32x4 v[4]; float s = 0.f;
#pragma unroll
        for (int j = 0; j < 4; ++j) { v[j] = xr[64 * j]; s += (v[j].x * v[j].x + v[j].y * v[j].y) + (v[j].z * v[j].z + v[j].w * v[j].w); }
        s = wave_sum(s);
        if (F.lane == 0) *(f32x4*)(SSQ + (size_t)row * 4) = (f32x4){s, 0.f, 0.f, 0.f};
        unsigned long long* o8 = (unsigned long long*)(XA + (size_t)row * D) + F.lane;
        unsigned long long* xo = (unsigned long long*)(X + (size_t)row * D) + F.lane;
#pragma unroll
        for (int j = 0; j < 4; ++j) {
            const f32x4 gg = *((const f32x4*)g + F.lane + 64 * j), sc = *((const f32x4*)(scale + (size_t)r * NMODV) + F.lane + 64 * j);
            const f32x4 o = v[j] * gg * (sc + 1.0f);
            xo[64 * j] = (unsigned long long)pk2(v[j].x, v[j].y) | ((unsigned long long)pk2(v[j].z, v[j].w) << 32);
            o8[64 * j] = (unsigned long long)pk2(o.x, o.y) | ((unsigned long long)pk2(o.z, o.w) << 32);
        }
    }
}
__device__ __forceinline__ void final_phase(const Frame& F) {
    F.relane();
    const int gw = F.bid * NWAVES + F.wave, NGW = F.G * NWAVES;
    const bf16* X = WSP(bf16, WS_X); const float* g = AIN(I_GFIN); float* out = AOUT + OUT_Y;
    for (int row = gw; row < T; row += NGW) {
        const v2u* xr = (const v2u*)(X + (size_t)row * D) + F.lane;
        f32x4 v[4]; float s = 0.f;
#pragma unroll
        for (int j = 0; j < 4; ++j) { const v2u w = xr[64 * j]; v[j] = (f32x4){bflo(w.x), bfhi(w.x), bflo(w.y), bfhi(w.y)}; s += (v[j].x * v[j].x + v[j].y * v[j].y) + (v[j].z * v[j].z + v[j].w * v[j].w); }
        const float rstd = frsq(wave_sum(s) * (1.f / D) + EPS);
        f32x4* o = (f32x4*)(out + (size_t)row * D) + F.lane;
#pragma unroll
        for (int j = 0; j < 4; ++j) o[64 * j] = v[j] * rstd * *((const f32x4*)g + F.lane + 64 * j);
    }
}
constexpr int LDT = 136;
__device__ __forceinline__ bf16x8 ld_frag16(const unsigned char* p) { return *(const bf16x8*)p; }
__device__ __forceinline__ bf16x8 ld_frag8x2(const unsigned char* p0, const unsigned char* p1) {
    const v2u a = *(const v2u*)p0, b = *(const v2u*)p1; v4u v; v.x = a.x; v.y = a.y; v.z = b.x; v.w = b.y; return __builtin_bit_cast(bf16x8, v); }
#define MFMA16(a, b, c) __builtin_amdgcn_mfma_f32_16x16x32_bf16((a), (b), (c), 0, 0, 0)

__device__ __forceinline__ void chunk_info(int c, int& cfirst, int& clast, bool& is_ctx, int& sb) {
    if (c < 64) { cfirst = c & ~1; clast = cfirst + 1; is_ctx = true; sb = c >> 1; }
    else { cfirst = 64 + ((c - 64) & ~7); clast = cfirst + 7; is_ctx = false; sb = (c - 64) >> 3; }
}
struct ConvW { f32x4 w0a, w0b, w1a, w1b, w2a, w2b, ba, bb; };
__device__ __forceinline__ ConvW conv_w(const float* wc, const float* bc, int ch) {
    ConvW W; W.w0a = *(const f32x4*)(wc + ch); W.w0b = *(const f32x4*)(wc + ch + 4); W.w1a = *(const f32x4*)(wc + 1024 + ch); W.w1b = *(const f32x4*)(wc + 1024 + ch + 4);
    W.w2a = *(const f32x4*)(wc + 2048 + ch); W.w2b = *(const f32x4*)(wc + 2048 + ch + 4); W.ba = *(const f32x4*)(bc + ch); W.bb = *(const f32x4*)(bc + ch + 4); return W;
}
__device__ __forceinline__ void conv8(const bf16* PROJ, int t, bool has_prev, bool has_next, int ch, const ConvW& W, float* out) {
    const bf16* p = PROJ + (size_t)t * EVEN_NP + 1536 + ch;
    const v4u z = {0u, 0u, 0u, 0u};
    const v4u c0 = *(const v4u*)p, cm = has_prev ? *(const v4u*)(p - EVEN_NP) : z, cp = has_next ? *(const v4u*)(p + EVEN_NP) : z;
    float x0[8], xm[8], xp[8]; unpack8(c0, x0); unpack8(cm, xm); unpack8(cp, xp);
#pragma unroll
    for (int i = 0; i < 4; ++i) { out[i] = siluf_(W.ba[i] + W.w0a[i] * xm[i] + W.w1a[i] * x0[i] + W.w2a[i] * xp[i]); out[4 + i] = siluf_(W.bb[i] + W.w0b[i] * xm[4 + i] + W.w1b[i] * x0[4 + i] + W.w2b[i] * xp[4 + i]); }
}
__device__ __forceinline__ void ssd_tables(const Frame& F, int ei, int t0, float* dtl, float* cml) {
    const bf16* PROJ = WSP(bf16, WS_PROJ);
    if (F.tid < 256) { const int j = F.tid >> 1, dir = F.tid & 1;
        const v4u raw = *(const v4u*)(PROJ + (size_t)(t0 + j) * EVEN_NP + 2560 + 8 * dir); float x[8]; unpack8(raw, x);
#pragma unroll
        for (int h = 0; h < 8; ++h) dtl[(dir * 8 + h) * 128 + j] = softplusf_(x[h] + AIN(I_DTB)[ei * 16 + dir * 8 + h]); }
    __syncthreads();
#pragma unroll
    for (int k = 0; k < 2; ++k) {
        const int row = 2 * F.wave + k, rev = row >> 3;
        const float a = -__expf(AIN(I_ALOG)[ei * 16 + row]);
        const int i0 = rev ? 127 - 2 * F.lane : 2 * F.lane, i1 = rev ? 126 - 2 * F.lane : 2 * F.lane + 1;
        const float v0 = dtl[row * 128 + i0] * a, v1 = dtl[row * 128 + i1] * a;
        float x = v0 + v1;
#pragma unroll
        for (int d = 1; d < 64; d <<= 1) { const float t = __builtin_bit_cast(float, __builtin_amdgcn_ds_bpermute((F.lane - d) * 4, __builtin_bit_cast(int, x))); x += (F.lane >= d) ? t : 0.f; }
        const float ex = x - (v0 + v1);
        cml[row * 128 + i0] = ex + v0; cml[row * 128 + i1] = ex + (v0 + v1);
    }
    __syncthreads();
}
constexpr int TILE128 = 34816, TILE64 = 17408;
constexpr int S1_BT = 0, S1_B = TILE128, S1_C = 2 * TILE128, S1_XT = TILE128  , S1_DT = 3 * TILE128, S1_CUM = S1_DT + 8192;
constexpr int S2_XT = 0  , S2_H = 2 * TILE64  , S2_DT = 6 * TILE64, S2_CUM = S2_DT + 8192, S2_SSQ = S2_CUM + 8192;

__device__ __forceinline__ void ssd_state_item(const Frame& F, int ei, int c, int g) {
    F.relane();
    const bf16* PROJ = WSP(bf16, WS_PROJ);
    const float* wc = AIN(I_WCS) + (size_t)ei * 3 * 1024; const float* bc = AIN(I_BCS) + (size_t)ei * 1024;
    int cfirst, clast, sb; bool is_ctx; chunk_info(c, cfirst, clast, is_ctx, sb);
    const int t0 = c * 128, len = is_ctx ? 256 : 1024, pos0 = (c - cfirst) * 128;
    bf16* BT = (bf16*)(F.lds + S1_BT); bf16* Bl = (bf16*)(F.lds + S1_B); bf16* Cl = (bf16*)(F.lds + S1_C); bf16* XT4 = (bf16*)(F.lds + S1_XT);
    float* dtl = (float*)(F.lds + S1_DT); float* cml = (float*)(F.lds + S1_CUM);
    bf16* ST = WSP(bf16, WS_ST); float* DEC = WSP(float, WS_DEC);
    bf16* CC = WSP(bf16, WS_CC); bf16* CBM = WSP(bf16, WS_CBM); bf16* XCT = WSP(bf16, WS_XCT);
    const int r = F.lane & 15, q = F.lane >> 4, w = F.wave;
    __syncthreads();
    ssd_tables(F, ei, t0, dtl, cml);
    { const ConvW W = conv_w(wc, bc, 512 + g * 128 + (F.tid & 15) * 8);
#pragma unroll 4
    for (int e = F.tid; e < 128 * 16; e += NTHR) { const int j = e >> 4, n8 = (e & 15) * 8; float o[8];
        conv8(PROJ, t0 + j, pos0 + j > 0, pos0 + j < len - 1, 512 + g * 128 + n8, W, o);
        const v4u pk = pack8(o);
        *(v4u*)((unsigned char*)Bl + (j * LDT + n8) * 2) = pk;
#pragma unroll
        for (int i = 0; i < 8; ++i) BT[(n8 + i) * LDT + j] = (bf16)f2bf1(o[i]); } }
    { const ConvW W = conv_w(wc, bc, 768 + g * 128 + (F.tid & 15) * 8);
#pragma unroll 4
    for (int e = F.tid; e < 128 * 16; e += NTHR) { const int j = e >> 4, n8 = (e & 15) * 8; float o[8];
        conv8(PROJ, t0 + j, pos0 + j > 0, pos0 + j < len - 1, 768 + g * 128 + n8, W, o);
        const v4u pk = pack8(o);
        *(v4u*)((unsigned char*)Cl + (j * LDT + n8) * 2) = pk;
        *(v4u*)(CC + (size_t)(t0 + j) * 256 + g * 128 + n8) = pk; } }
    __syncthreads();
    {
        bf16x8 cf[4];
#pragma unroll
        for (int ks = 0; ks < 4; ++ks) cf[ks] = ld_frag16((const unsigned char*)Cl + ((16 * w + r) * LDT + 32 * ks + 8 * q) * 2);
        bf16* dst = CBM + ((size_t)(c * 2 + g) * 128 + 16 * w + r) * 128 + 4 * q;
#pragma unroll
        for (int jt = 0; jt < 8; ++jt) { f32x4 a = {0.f, 0.f, 0.f, 0.f};
#pragma unroll
            for (int ks = 0; ks < 4; ++ks) a = MFMA16(ld_frag16((const unsigned char*)Bl + ((16 * jt + r) * LDT + 32 * ks + 8 * q) * 2), cf[ks], a);
            v2u o; o.x = pk2(a[0], a[1]); o.y = pk2(a[2], a[3]); *(v2u*)(dst + 16 * jt) = o; }
    }
    __syncthreads();
    { const ConvW W = conv_w(wc, bc, g * 256 + (F.tid & 31) * 8);
#pragma unroll 4
    for (int e = F.tid; e < 128 * 32; e += NTHR) { const int j = e >> 5, p8 = (e & 31) * 8; float o[8];
        conv8(PROJ, t0 + j, pos0 + j > 0, pos0 + j < len - 1, g * 256 + p8, W, o);
#pragma unroll
        for (int i = 0; i < 8; ++i) XT4[(p8 + i) * LDT + j] = (bf16)f2bf1(o[i]); } }
    __syncthreads();
#pragma unroll 4
    for (int e = F.tid; e < 256 * 16; e += NTHR) { const int row = e >> 4, ch = (e & 15) * 8;
        *(v4u*)(XCT + ((size_t)(c * 8 + 4 * g) * 64 + row) * 128 + ch) = *(const v4u*)((const unsigned char*)XT4 + (row * LDT + ch) * 2); }
#pragma unroll 2
    for (int hd = 0; hd < 8; ++hd) {
        const int hh = hd >> 1, dir = hd & 1, h = 4 * g + hh;
        const float* dth = dtl + (dir * 8 + h) * 128; const float* cmh = cml + (dir * 8 + h) * 128;
        const float cend = dir == 0 ? cmh[127] : cmh[0];
        const bf16* XT = XT4 + hh * 64 * LDT;
        f32x4 acc[4];
#pragma unroll
        for (int pt = 0; pt < 4; ++pt) acc[pt] = (f32x4){0.f, 0.f, 0.f, 0.f};
#pragma unroll
        for (int ks = 0; ks < 4; ++ks) {
            const int j0 = 32 * ks + 8 * q;
            const v4u braw = *(const v4u*)((const unsigned char*)BT + ((16 * w + r) * LDT + j0) * 2); float bv[8]; unpack8(braw, bv);
            const f32x4 d0 = *(const f32x4*)(dth + j0), d1 = *(const f32x4*)(dth + j0 + 4), c0 = *(const f32x4*)(cmh + j0), c1 = *(const f32x4*)(cmh + j0 + 4);
#pragma unroll
            for (int i = 0; i < 4; ++i) { bv[i] *= d0[i] * __expf(cend - c0[i]); bv[4 + i] *= d1[i] * __expf(cend - c1[i]); }
            const bf16x8 af = __builtin_bit_cast(bf16x8, pack8(bv));
#pragma unroll
            for (int pt = 0; pt < 4; ++pt) { const bf16x8 bf = ld_frag16((const unsigned char*)XT + ((16 * pt + r) * LDT + j0) * 2); acc[pt] = MFMA16(af, bf, acc[pt]); }
        }
        bf16* dst = ST + ((size_t)(c * 8 + h) * 2 + dir) * 8192;
#pragma unroll
        for (int pt = 0; pt < 4; ++pt) { v2u o; o.x = pk2(acc[pt][0], acc[pt][1]); o.y = pk2(acc[pt][2], acc[pt][3]); *(v2u*)(dst + (16 * pt + r) * 128 + 16 * w + 4 * q) = o; }
        if (F.tid == 0) DEC[(c * 8 + h) * 2 + dir] = __expf(cend);
    }
}

__device__ __forceinline__ void gmlp_item(const Frame& F, int ei, int c, int g) {
    F.relane();
    const bf16* PROJ = WSP(bf16, WS_PROJ); bf16* YMIX = WSP(bf16, WS_YMIX);
    const int t0 = c * 128;
    float* rs = (float*)F.lds; bf16* Vt = (bf16*)(F.lds + 1024); bf16* Wl = (bf16*)(F.lds + 1024 + 34816);
    const float* gv = AIN(I_GV) + ei * 512;
    __syncthreads();
#pragma unroll 1
    for (int kb = 0; kb < 16; kb += 8) {
        v4u raw[8];
#pragma unroll
        for (int k = 0; k < 8; ++k) raw[k] = *(const v4u*)(PROJ + (size_t)(t0 + F.wave * 16 + kb + k) * EVEN_NP + 512 + 8 * F.lane);
#pragma unroll
        for (int k = 0; k < 8; ++k) { float x[8]; unpack8(raw[k], x); float s = 0.f;
#pragma unroll
            for (int i = 0; i < 8; ++i) { const float y = gelu_tanh(x[i]); s += y * y; }
            s = wave_sum(s); if (F.lane == 0) rs[F.wave * 16 + kb + k] = frsq(s * (1.f / 512.f) + EPS); }
    }
    { const float* ws_ = AIN(I_WSP) + ((size_t)ei * 4 + g) * 16384;
#pragma unroll
      for (int e = F.tid; e < 4096; e += NTHR) { const int i = e >> 5, j4 = (e & 31) * 4; const f32x4 v = *(const f32x4*)(ws_ + i * 128 + j4);
          v2u o; o.x = pk2(v.x, v.y); o.y = pk2(v.z, v.w); *(v2u*)((unsigned char*)Wl + (i * LDT + j4) * 2) = o; } }
    __syncthreads();
    { const int d8 = (F.tid & 15) * 8; v4u raw[4];
#pragma unroll
      for (int k = 0; k < 4; ++k) raw[k] = *(const v4u*)(PROJ + (size_t)(t0 + (F.tid >> 4) + 32 * k) * EVEN_NP + 512 + g * 128 + d8);
#pragma unroll
      for (int k = 0; k < 4; ++k) { const int j = (F.tid >> 4) + 32 * k; float x[8]; unpack8(raw[k], x); const float rj = rs[j];
#pragma unroll
          for (int i = 0; i < 8; ++i) Vt[(d8 + i) * LDT + j] = (bf16)f2bf1(gelu_tanh(x[i]) * rj * gv[g * 128 + d8 + i]); } }
    __syncthreads();
    const int r = F.lane & 15, q = F.lane >> 4, w = F.wave;
    bf16x8 af[4];
#pragma unroll
    for (int ks = 0; ks < 4; ++ks) af[ks] = ld_frag16((const unsigned char*)Vt + ((16 * w + r) * LDT + 32 * ks + 8 * q) * 2);
    const float* bs = AIN(I_BSP) + ((size_t)ei * 4 + g) * 128;
    v2u uraw[8];
#pragma unroll
    for (int it = 0; it < 8; ++it) uraw[it] = *(const v2u*)(PROJ + (size_t)(t0 + 16 * it + r) * EVEN_NP + g * 128 + 16 * w + 4 * q);
#pragma unroll
    for (int it = 0; it < 8; ++it) {
        f32x4 acc = {0.f, 0.f, 0.f, 0.f};
#pragma unroll
        for (int ks = 0; ks < 4; ++ks) acc = MFMA16(af[ks], ld_frag16((const unsigned char*)Wl + ((16 * it + r) * LDT + 32 * ks + 8 * q) * 2), acc);
        const int i = 16 * it + r, col = g * 128 + 16 * w + 4 * q; const float b = bs[i];
        const float u0 = gelu_tanh(bflo(uraw[it].x)), u1 = gelu_tanh(bfhi(uraw[it].x)), u2 = gelu_tanh(bflo(uraw[it].y)), u3 = gelu_tanh(bfhi(uraw[it].y));
        v2u o; o.x = pk2(u0 * (acc[0] + b), u1 * (acc[1] + b)); o.y = pk2(u2 * (acc[2] + b), u3 * (acc[3] + b));
        *(v2u*)(YMIX + (size_t)(t0 + i) * D + col) = o;
    }
}

__device__ __forceinline__ f32x4 ld_bf4(const bf16* p) { const v2u w = *(const v2u*)p; return (f32x4){bflo(w.x), bfhi(w.x), bflo(w.y), bfhi(w.y)}; }
__device__ __forceinline__ void ssd_scan_phase(const Frame& F, int ei) {
    F.relane();
    const bf16* ST = WSP(bf16, WS_ST); const float* DEC = WSP(float, WS_DEC); bf16* HIN = WSP(bf16, WS_HIN);
    const size_t gt = (size_t)F.bid * NTHR + F.tid, NT = (size_t)F.G * NTHR;
    constexpr size_t N_SMP = (size_t)2 * 8 * 2 * 2048, N_CTX = (size_t)32 * 8 * 2 * 2048;
    for (size_t it = gt; it < N_SMP + N_CTX; it += NT) {
        if (it < N_SMP) {
            const int e = (int)(it & 2047) * 4, dir = (int)(it >> 11) & 1, h = (int)(it >> 12) & 7, b = (int)(it >> 15);
            const int c0 = 64 + 8 * b;
            f32x4 st[8]; float dc[8];
#pragma unroll
            for (int k = 0; k < 8; ++k) { const int cc = dir == 0 ? c0 + k : c0 + 7 - k; st[k] = ld_bf4(ST + ((size_t)(cc * 8 + h) * 2 + dir) * 8192 + e); dc[k] = DEC[(cc * 8 + h) * 2 + dir]; }
            f32x4 v = *(const f32x4*)(AIN(I_SSD) + ((size_t)((b * 2 + ei) * 2 + dir) * 8 + h) * 8192 + e);
#pragma unroll
            for (int k = 0; k < 8; ++k) { const int cc = dir == 0 ? c0 + k : c0 + 7 - k;
                v2u o; o.x = pk2(v.x, v.y); o.y = pk2(v.z, v.w); *(v2u*)(HIN + ((size_t)(cc * 8 + h) * 2 + dir) * 8192 + e) = o;
                v = v * dc[k] + st[k]; }
        } else {
            const size_t i2 = it - N_SMP;
            const int e = (int)(i2 & 2047) * 4, dir = (int)(i2 >> 11) & 1, h = (int)(i2 >> 12) & 7, s = (int)(i2 >> 15);
            const int ca = dir == 0 ? 2 * s : 2 * s + 1, cb = dir == 0 ? 2 * s + 1 : 2 * s;
            const f32x4 sa = ld_bf4(ST + ((size_t)(ca * 8 + h) * 2 + dir) * 8192 + e), sb_ = ld_bf4(ST + ((size_t)(cb * 8 + h) * 2 + dir) * 8192 + e);
            const float db = DEC[(cb * 8 + h) * 2 + dir];
            *(f32x4*)(AOUT + OUT_SSD + ((size_t)((s * 2 + ei) * 2 + dir) * 8 + h) * 8192 + e) = sa * db + sb_;
        }
    }
}

__device__ __forceinline__ void ssd_out_item(const Frame& F, int ei, int c, int th) {
    F.relane();
    const bf16* PROJ = WSP(bf16, WS_PROJ); bf16* YMIX = WSP(bf16, WS_YMIX);
    const bf16* CC = WSP(bf16, WS_CC); const bf16* CBM = WSP(bf16, WS_CBM); const bf16* XCT = WSP(bf16, WS_XCT); const bf16* HIN = WSP(bf16, WS_HIN); const bf16* ST = WSP(bf16, WS_ST);
    const int t0 = c * 128;
    float* dtl = (float*)(F.lds + S2_DT); float* cml = (float*)(F.lds + S2_CUM); float* ssqx = (float*)(F.lds + S2_SSQ);
    const int r = F.lane & 15, q = F.lane >> 4, w = F.wave, it = w & 3, g = w >> 2;
    const int irow = 64 * th + 16 * it + r;
    const bool hzero[2] = {c < 64 && (c & 1) == 0, c < 64 && (c & 1) == 1};
    __syncthreads();
    ssd_tables(F, ei, t0, dtl, cml);
    v2u cbp[8]; bf16x8 cf[4];
    {
        const bf16* cbr = CBM + ((size_t)(c * 2 + g) * 128 + irow) * 128 + 4 * q;
#pragma unroll
        for (int jt = 0; jt < 8; ++jt) cbp[jt] = *(const v2u*)(cbr + 16 * jt);
#pragma unroll
        for (int kn = 0; kn < 4; ++kn) cf[kn] = *(const bf16x8*)(CC + (size_t)(t0 + irow) * 256 + g * 128 + 32 * kn + 8 * q);
    }
    float ssq = 0.f;
    v4u pre[12];
    const int goff = (F.tid >> 4) * 128 + (F.tid & 15) * 8, loff = ((F.tid >> 4) * LDT + (F.tid & 15) * 8) * 2;
#define E2_SRC(m_, hh_) ((m_) < 2 ? XCT + (size_t)(c * 8 + 4 * (m_) + (hh_)) * 8192 : \
        (c < 64 ? ST + ((size_t)((((m_) - 2) & 1) == 0 ? c - 1 : c + 1) * 8 + 4 * (((m_) - 2) >> 1) + (hh_)) * 16384 + (((m_) - 2) & 1) * 8192 \
                : HIN + ((size_t)c * 8 + 4 * (((m_) - 2) >> 1) + (hh_)) * 16384 + (((m_) - 2) & 1) * 8192))
#define E2_FETCH(hh_) do { _Pragma("unroll") for (int m = 0; m < 6; ++m) { if (m >= 2 && hzero[(m - 2) & 1]) continue; const bf16* sp = E2_SRC(m, hh_) + goff; \
            pre[2 * m] = *(const v4u*)sp; pre[2 * m + 1] = *(const v4u*)(sp + 32 * 128); } } while (0)
    E2_FETCH(0);
#pragma unroll 1
    for (int hh = 0; hh < 4; ++hh) {
        __syncthreads();
#pragma unroll
        for (int m = 0; m < 6; ++m) { if (m >= 2 && hzero[(m - 2) & 1]) continue;
            unsigned char* dp = F.lds + (m < 2 ? S2_XT + m * TILE64 : S2_H + (m - 2) * TILE64) + loff;
            *(v4u*)dp = pre[2 * m]; *(v4u*)(dp + 32 * LDT * 2) = pre[2 * m + 1]; }
        __syncthreads();
        if (hh < 3) E2_FETCH(hh + 1);
        v2u zr4[4];
#pragma unroll
        for (int pt = 0; pt < 4; ++pt) zr4[pt] = *(const v2u*)(PROJ + (size_t)(t0 + irow) * EVEN_NP + 1024 + (4 * g + hh) * 64 + 16 * pt + 4 * q);
        const int h = 4 * g + hh;
        const bf16* XT = (const bf16*)(F.lds + S2_XT + g * TILE64);
        f32x4 yacc[4];
#pragma unroll
        for (int pt = 0; pt < 4; ++pt) yacc[pt] = (f32x4){0.f, 0.f, 0.f, 0.f};
        const float* dt0 = dtl + h * 128; const float* cm0 = cml + h * 128; const float* dt1 = dtl + (8 + h) * 128; const float* cm1 = cml + (8 + h) * 128;
        const float ci0 = cm0[irow], ci1 = cm1[irow];
#pragma unroll
        for (int ks = 0; ks < 4; ++ks) {
            float sl0[8], sl1[8];
#pragma unroll
            for (int hf = 0; hf < 2; ++hf) {
                const int j0 = 32 * ks + 16 * hf + 4 * q; const v2u cw = cbp[2 * ks + hf];
                const f32x4 c0v = *(const f32x4*)(cm0 + j0), d0v = *(const f32x4*)(dt0 + j0), c1v = *(const f32x4*)(cm1 + j0), d1v = *(const f32x4*)(dt1 + j0);
                const float cbv[4] = {bflo(cw.x), bfhi(cw.x), bflo(cw.y), bfhi(cw.y)};
#pragma unroll
                for (int e = 0; e < 4; ++e) { const int j = j0 + e;
                    const float e0 = __expf(ci0 - c0v[e]) * d0v[e] * cbv[e], e1 = __expf(ci1 - c1v[e]) * d1v[e] * cbv[e];
                    sl0[4 * hf + e] = (j <= irow) ? e0 : 0.f; sl1[4 * hf + e] = (j >= irow) ? e1 : 0.f; }
            }
            const bf16x8 sf0 = __builtin_bit_cast(bf16x8, pack8(sl0)), sf1 = __builtin_bit_cast(bf16x8, pack8(sl1));
#pragma unroll
            for (int pt = 0; pt < 4; ++pt) { const unsigned char* xr = (const unsigned char*)XT + ((16 * pt + r) * LDT + 32 * ks + 4 * q) * 2;
                const bf16x8 xf = ld_frag8x2(xr, xr + 32);
                yacc[pt] = MFMA16(xf, sf0, yacc[pt]); yacc[pt] = MFMA16(xf, sf1, yacc[pt]); }
        }
#pragma unroll
        for (int dir = 0; dir < 2; ++dir) {
            if (hzero[dir]) continue;
            const unsigned char* Hl = F.lds + S2_H + (g * 2 + dir) * TILE64;
            const float ei_ = __expf(dir == 0 ? ci0 : ci1);
#pragma unroll
            for (int pt = 0; pt < 4; ++pt) { f32x4 t = {0.f, 0.f, 0.f, 0.f};
#pragma unroll
                for (int kn = 0; kn < 4; ++kn) t = MFMA16(ld_frag16(Hl + ((16 * pt + r) * LDT + 32 * kn + 8 * q) * 2), cf[kn], t);
                yacc[pt] += t * ei_; }
        }
        const float dsk = AIN(I_DSK)[ei * 16 + h] + AIN(I_DSK)[ei * 16 + 8 + h];
#pragma unroll
        for (int pt = 0; pt < 4; ++pt) {
            const int p0 = 16 * pt + 4 * q;
            const v2u zr = zr4[pt];
            const float z0 = bflo(zr.x), z1 = bfhi(zr.x), z2 = bflo(zr.y), z3 = bfhi(zr.y);
            float y0 = yacc[pt][0] + dsk * bf1(XT[(p0 + 0) * LDT + irow]), y1 = yacc[pt][1] + dsk * bf1(XT[(p0 + 1) * LDT + irow]),
                  y2 = yacc[pt][2] + dsk * bf1(XT[(p0 + 2) * LDT + irow]), y3 = yacc[pt][3] + dsk * bf1(XT[(p0 + 3) * LDT + irow]);
            y0 *= siluf_(z0); y1 *= siluf_(z1); y2 *= siluf_(z2); y3 *= siluf_(z3);
            ssq += (y0 * y0 + y1 * y1) + (y2 * y2 + y3 * y3);
            v2u o; o.x = pk2(y0, y1); o.y = pk2(y2, y3);
            *(v2u*)(YMIX + (size_t)(t0 + irow) * D + 512 + h * 64 + p0) = o;
        }
    }
#undef E2_FETCH
#undef E2_SRC
    ssq += xlane<16>(ssq); ssq = sum_x32(ssq);
    if (q == 0) ssqx[w * 16 + r] = ssq;
    __syncthreads();
    ssq += ssqx[(w ^ 4) * 16 + r];
    const float rstd = frsq(ssq * (1.f / 512.f) + EPS);
    const float* go = AIN(I_GSO) + ei * 512;
#pragma unroll 1
    for (int hh = 0; hh < 4; ++hh)
#pragma unroll
        for (int pt = 0; pt < 4; ++pt) {
            const int col = (4 * g + hh) * 64 + 16 * pt + 4 * q;
            v2u* p = (v2u*)(YMIX + (size_t)(t0 + irow) * D + 512 + col); const v2u v = *p; const f32x4 gg = *(const f32x4*)(go + col);
            v2u o; o.x = pk2(bflo(v.x) * rstd * gg.x, bfhi(v.x) * rstd * gg.y); o.y = pk2(bflo(v.y) * rstd * gg.z, bfhi(v.y) * rstd * gg.w);
            *p = o;
        }
}

__device__ __forceinline__ void even_phase1(const Frame& F, int ei) {
    if (F.G >= 256) {
        if (F.bid < 160) ssd_state_item(F, ei, F.bid >> 1, F.bid & 1);
        else for (int it = F.bid - 160; it < 192; it += F.G - 160) gmlp_item(F, ei, it >> 2, it & 3);
        return;
    }
    for (int it = F.bid; it < 160 + 320; it += F.G) {
        if (it < 160) ssd_state_item(F, ei, it >> 1, it & 1);
        else gmlp_item(F, ei, (it - 160) >> 2, (it - 160) & 3);
    }
}
__device__ __forceinline__ void even_phase2(const Frame& F, int ei) {
    if (F.G >= 256) {
        if (F.bid < 160) ssd_out_item(F, ei, F.bid >> 1, F.bid & 1);
        else for (int it = 192 + F.bid - 160; it < 320; it += F.G - 160) gmlp_item(F, ei, it >> 2, it & 3);
        return;
    }
    for (int it = F.bid; it < 160; it += F.G) ssd_out_item(F, ei, it >> 1, it & 1);
}
constexpr int CV_T = 43, CV_W = CV_T + 30, CV_ITEMS = 32 * 6 + 2 * 24;
__device__ __forceinline__ void conv_item(const Frame& F, int oi, int item) {
    F.relane();
    const bf16* PROJ = WSP(bf16, WS_PROJ); bf16* YMIX = WSP(bf16, WS_YMIX);
    int sbeg, slen, tile; if (item < 192) { sbeg = (item / 6) * 256; slen = 256; tile = item % 6; } else { const int i2 = item - 192; sbeg = TCTX + (i2 / 24) * 1024; slen = 1024; tile = i2 % 24; }
    const int send = sbeg + slen, t0 = sbeg + tile * CV_T, nt = (slen - tile * CV_T) < CV_T ? (slen - tile * CV_T) : CV_T;
    float* Dl = (float*)F.lds;
    const int c = F.tid;
    float glu[CV_W];
#pragma unroll
    for (int w0 = 0; w0 < CV_W; w0 += 8) {
        bf16 av[8], gv[8];
#pragma unroll
        for (int i = 0; i < 8; ++i) if (w0 + i < CV_W) { int t = t0 - 15 + w0 + i; t = t < sbeg ? sbeg : (t >= send ? send - 1 : t);
            av[i] = PROJ[(size_t)t * ODD_NP + 672 + c]; gv[i] = PROJ[(size_t)t * ODD_NP + 1184 + c]; }
#pragma unroll
        for (int i = 0; i < 8; ++i) if (w0 + i < CV_W) { const int t = t0 - 15 + w0 + i; const float v = bf1(av[i]) * sigmoidf_(bf1(gv[i])); glu[w0 + i] = (t >= sbeg && t < send) ? v : 0.f; }
    }
    float wk[31];
#pragma unroll
    for (int k = 0; k < 31; ++k) wk[k] = AIN(I_WDW)[((size_t)oi * 31 + k) * 512 + c];
    const float bd = AIN(I_BDW)[oi * 512 + c];
    __syncthreads();
#pragma unroll
    for (int tt = 0; tt < CV_T; ++tt) { float s = bd;
#pragma unroll
        for (int k = 0; k < 31; ++k) s += wk[k] * glu[tt + k];
        Dl[tt * 512 + c] = s; }
    __syncthreads();
    const float* gl = AIN(I_GLN) + oi * 512; const float* bl = AIN(I_BLN) + oi * 512;
    const f32x4 g0 = *(const f32x4*)(gl + 8 * F.lane), g1 = *(const f32x4*)(gl + 8 * F.lane + 4), b0 = *(const f32x4*)(bl + 8 * F.lane), b1 = *(const f32x4*)(bl + 8 * F.lane + 4);
#pragma unroll 1
    for (int tt = F.wave; tt < nt; tt += NWAVES) {
        const f32x4 v0 = *(const f32x4*)(Dl + tt * 512 + 8 * F.lane), v1 = *(const f32x4*)(Dl + tt * 512 + 8 * F.lane + 4);
        float s = (v0.x + v0.y) + (v0.z + v0.w) + (v1.x + v1.y) + (v1.z + v1.w);
        const float mean = wave_sum(s) * (1.f / 512.f);
        const f32x4 d0 = v0 - mean, d1 = v1 - mean;
        float s2 = (d0.x * d0.x + d0.y * d0.y) + (d0.z * d0.z + d0.w * d0.w) + (d1.x * d1.x + d1.y * d1.y) + (d1.z * d1.z + d1.w * d1.w);
        const float rstd = frsq(wave_sum(s2) * (1.f / 512.f) + EPS);
        float o[8];
#pragma unroll
        for (int i = 0; i < 4; ++i) { o[i] = siluf_(d0[i] * rstd * g0[i] + b0[i]); o[4 + i] = siluf_(d1[i] * rstd * g1[i] + b1[i]); }
        *(v4u*)(YMIX + (size_t)(t0 + tt) * D + 512 + 8 * F.lane) = pack8(o);
    }
}
__device__ __forceinline__ void odd_rows(const Frame& F, int oi) {
    F.relane();
    const bf16* PROJ = WSP(bf16, WS_PROJ);
    bf16* QA = WSP(bf16, WS_QA); bf16* CKVA = WSP(bf16, WS_CKVA); bf16* KR = WSP(bf16, WS_KR); const float* ROPE = WSP(float, WS_ROPE);
    const int gw = F.bid * NWAVES + F.wave, NGW = F.G * NWAVES, lane = F.lane;
    for (int row = T + gw; row < TP; row += NGW) {
        const int b = (row - T) >> 8, j = (row - T) & 255;
        const f32x4 v = *(const f32x4*)(AIN(I_CCKV) + ((size_t)(b * 2 + oi) * 256 + j) * 256 + 4 * lane);
        v2u o; o.x = pk2(v.x, v.y); o.y = pk2(v.z, v.w); *(v2u*)(CKVA + (size_t)row * 256 + 4 * lane) = o;
        if (lane < 32) KR[(size_t)row * 32 + lane] = (bf16)f2bf1(AIN(I_CKR)[((size_t)(b * 2 + oi) * 256 + j) * 32 + lane]);
    }
    const f32x4 gkv = *(const f32x4*)(AIN(I_GCKV) + oi * 256 + 4 * lane);
    float gq[6];
#pragma unroll
    for (int k = 0; k < 3; ++k) { gq[2 * k] = AIN(I_GCQ)[oi * 384 + 128 * k + 2 * lane]; gq[2 * k + 1] = AIN(I_GCQ)[oi * 384 + 128 * k + 2 * lane + 1]; }
    unsigned qw[3], nqw[3]; v2u kw, nkw; bf16 krw, nkrw;
    int row = gw;
    if (row < T) { const bf16* pr = PROJ + (size_t)row * ODD_NP;
#pragma unroll
        for (int k = 0; k < 3; ++k) nqw[k] = *(const unsigned*)(pr + 128 * k + 2 * lane);
        nkw = *(const v2u*)(pr + 384 + 4 * lane); nkrw = pr[640 + (lane & 31)]; }
#pragma unroll 1
    for (; row < T; row += NGW) {
#pragma unroll
        for (int k = 0; k < 3; ++k) qw[k] = nqw[k];
        kw = nkw; krw = nkrw;
        if (row + NGW < T) { const bf16* pr = PROJ + (size_t)(row + NGW) * ODD_NP;
#pragma unroll
            for (int k = 0; k < 3; ++k) nqw[k] = *(const unsigned*)(pr + 128 * k + 2 * lane);
            nkw = *(const v2u*)(pr + 384 + 4 * lane); nkrw = pr[640 + (lane & 31)]; }
        float qv[6]; float s = 0.f;
#pragma unroll
        for (int k = 0; k < 3; ++k) { qv[2 * k] = bflo(qw[k]); qv[2 * k + 1] = bfhi(qw[k]); s += qv[2 * k] * qv[2 * k] + qv[2 * k + 1] * qv[2 * k + 1]; }
        f32x4 kv = {bflo(kw.x), bfhi(kw.x), bflo(kw.y), bfhi(kw.y)};
        float s2 = (kv.x * kv.x + kv.y * kv.y) + (kv.z * kv.z + kv.w * kv.w);
        s += xlane<1>(s); s2 += xlane<1>(s2); s += xlane<2>(s); s2 += xlane<2>(s2); s += xlane<4>(s); s2 += xlane<4>(s2); s += xlane<8>(s); s2 += xlane<8>(s2); s += xlane<16>(s); s2 += xlane<16>(s2);
        s = sum_x32(s); s2 = sum_x32(s2);
        const float rq = frsq(s * (1.f / 384.f) + EPS), rk = frsq(s2 * (1.f / 256.f) + EPS);
#pragma unroll
        for (int k = 0; k < 3; ++k) *(unsigned*)(QA + (size_t)row * 384 + 128 * k + 2 * lane) = pk2(qv[2 * k] * rq * gq[2 * k], qv[2 * k + 1] * rq * gq[2 * k + 1]);
        kv = kv * rk * gkv;
        { v2u o; o.x = pk2(kv.x, kv.y); o.y = pk2(kv.z, kv.w); *(v2u*)(CKVA + (size_t)row * 256 + 4 * lane) = o; }
        float kr = bf1(krw);
        if (row < TCTX) {
            const int b = row >> 8, pos = row & 255;
            *(f32x4*)(AOUT + OUT_CKV + ((size_t)(b * 2 + oi) * 256 + pos) * 256 + 4 * lane) = kv;
            if (lane < 32) AOUT[OUT_KR + ((size_t)(b * 2 + oi) * 256 + pos) * 32 + lane] = kr;
        } else {
            const int pos = (row - TCTX) & 1023, e = lane & 31, ax = e >> 4, half = (e >> 3) & 1, f = e & 7;
            const float other = xlane<8>(kr);
            const float cs = ROPE[((pos * 2 + ax) * 8 + f) * 2], sn = ROPE[((pos * 2 + ax) * 8 + f) * 2 + 1];
            kr = half == 0 ? (kr * cs - other * sn) : (other * sn + kr * cs);
        }
        if (lane < 32) KR[(size_t)row * 32 + lane] = (bf16)f2bf1(kr);
    }
}
__device__ __forceinline__ void odd_phase1(const Frame& F, int oi) {
    for (int it = F.bid; it < CV_ITEMS; it += F.G) conv_item(F, oi, it);
    odd_rows(F, oi);
}

constexpr int AT_KROW = 208, AT_VROW = 272, AT_KBYTES = 128 * AT_KROW, AT_BUF = 45056;
struct AttnPre { v4u k[3]; v4u v[2]; };
__device__ __forceinline__ void attn_load_tile(const Frame& F, int h, int krow0, AttnPre& P) {
    const bf16* KN = WSP(bf16, WS_KN); const bf16* KR = WSP(bf16, WS_KR); const bf16* VT = WSP(bf16, WS_VT);
#pragma unroll
    for (int i = 0; i < 3; ++i) { const int e = F.tid + NTHR * i, key = e / 12, c = e % 12; const size_t kr = (size_t)(krow0 + key);
        P.k[i] = c < 8 ? *(const v4u*)(KN + kr * 512 + h * 64 + c * 8) : *(const v4u*)(KR + kr * 32 + (c - 8) * 8); }
#pragma unroll
    for (int i = 0; i < 2; ++i) { const int e = F.tid + NTHR * i, row = e >> 4, c = e & 15;
        P.v[i] = *(const v4u*)(VT + (size_t)(h * 64 + row) * TP + krow0 + c * 8); }
}
__device__ __forceinline__ void attn_store_tile(const Frame& F, unsigned char* buf, const AttnPre& P) {
#pragma unroll
    for (int i = 0; i < 3; ++i) { const int e = F.tid + NTHR * i, key = e / 12, c = e % 12; *(v4u*)(buf + key * AT_KROW + c * 16) = P.k[i]; }
#pragma unroll
    for (int i = 0; i < 2; ++i) { const int e = F.tid + NTHR * i, row = e >> 4, c = e & 15; *(v4u*)(buf + AT_KBYTES + row * AT_VROW + c * 16) = P.v[i]; }
}
__device__ __forceinline__ int attn_tile_row(bool is_smp, int sb, int i) {
    if (!is_smp) return sb * 256 + 128 * i;
    return i < 2 ? T + sb * 256 + 128 * i : TCTX + sb * 1024 + 128 * (i - 2);
}
__device__ __forceinline__ void attn_item(const Frame& F, int q0, int h, bool is_smp, int spos0, int sb) {
    F.relane();
    const bf16* Q = WSP(bf16, WS_Q); bf16* YMIX = WSP(bf16, WS_YMIX); const float* ROPE = WSP(float, WS_ROPE);
    const int r = F.lane & 15, g = F.lane >> 4, w = F.wave;
    const int tq = q0 + 16 * w + r;
    const int ntile = is_smp ? 10 : 2;
    AttnPre P;
    attn_load_tile(F, h, attn_tile_row(is_smp, sb, 0), P);
    bf16x8 qf[3];
#pragma unroll
    for (int ks = 0; ks < 3; ++ks) qf[ks] = *(const bf16x8*)(Q + (size_t)tq * 768 + h * 96 + 32 * ks + 8 * g);
    if (is_smp) {
        float x[8], o[8]; unpack8(__builtin_bit_cast(v4u, qf[2]), x);
        const int pos = spos0 + 16 * w + r, ax = g >> 1, half = g & 1;
        const float* rp = ROPE + ((size_t)(pos * 2 + ax) * 8) * 2;
#pragma unroll
        for (int j = 0; j < 8; ++j) { const float other = xlane<16>(x[j]); const float cs = rp[2 * j], sn = rp[2 * j + 1];
            o[j] = half == 0 ? (x[j] * cs - other * sn) : (other * sn + x[j] * cs); }
        qf[2] = __builtin_bit_cast(bf16x8, pack8(o));
    }
    const float csc = 0.10206207261596577f * 1.4426950408889634f;
    float m = -1e30f, l = 0.f;
    f32x4 oacc[4];
#pragma unroll
    for (int dt = 0; dt < 4; ++dt) oacc[dt] = (f32x4){0.f, 0.f, 0.f, 0.f};
    __syncthreads();
    attn_store_tile(F, F.lds, P);
    AttnPre P2;
    if (ntile > 1) attn_load_tile(F, h, attn_tile_row(is_smp, sb, 1), P);
    __syncthreads();
#define ATTN_COMPUTE(buf) do { \
        f32x4 sacc[8]; \
        _Pragma("unroll") \
        for (int st = 0; st < 8; ++st) { \
            const unsigned char* kp = buf + (16 * st + r) * AT_KROW + 16 * g; \
            f32x4 a = {0.f, 0.f, 0.f, 0.f}; \
            a = MFMA16(ld_frag16(kp), qf[0], a); a = MFMA16(ld_frag16(kp + 64), qf[1], a); a = MFMA16(ld_frag16(kp + 128), qf[2], a); \
            sacc[st] = a; \
        } \
        float mx = -1e30f; \
        _Pragma("unroll") \
        for (int st = 0; st < 8; ++st) mx = fmaxf(fmaxf(fmaxf(sacc[st][0], sacc[st][1]), fmaxf(sacc[st][2], sacc[st][3])), mx); \
        mx = fmaxf(mx, xlane<16>(mx)); mx = max_x32(mx); \
        const float mn = fmaxf(m, mx), alpha = __builtin_amdgcn_exp2f((m - mn) * csc); m = mn; \
        float ps = 0.f; float p[32]; \
        _Pragma("unroll") \
        for (int st = 0; st < 8; ++st) \
            _Pragma("unroll") \
            for (int j = 0; j < 4; ++j) { const float e = __builtin_amdgcn_exp2f((sacc[st][j] - mn) * csc); p[4 * st + j] = e; ps += e; } \
        l = l * alpha + ps; \
        _Pragma("unroll") \
        for (int dt = 0; dt < 4; ++dt) oacc[dt] *= alpha; \
        _Pragma("unroll") \
        for (int ks2 = 0; ks2 < 4; ++ks2) { \
            const bf16x8 pf = __builtin_bit_cast(bf16x8, pack8(p + 8 * ks2)); \
            _Pragma("unroll") \
            for (int dt = 0; dt < 4; ++dt) { \
                const unsigned char* vp = buf + AT_KBYTES + (16 * dt + r) * AT_VROW + (32 * ks2 + 4 * g) * 2; \
                oacc[dt] = MFMA16(ld_frag8x2(vp, vp + 32), pf, oacc[dt]); \
            } \
        } } while (0)
#pragma unroll 1
    for (int ti = 0; ti < ntile; ti += 2) {
        if (ti + 2 < ntile) attn_load_tile(F, h, attn_tile_row(is_smp, sb, ti + 2), P2);
        { const unsigned char* buf = F.lds; ATTN_COMPUTE(buf); }
        if (ti + 1 < ntile) attn_store_tile(F, F.lds + AT_BUF, P);
        __syncthreads();
        if (ti + 1 >= ntile) break;
        if (ti + 3 < ntile) attn_load_tile(F, h, attn_tile_row(is_smp, sb, ti + 3), P);
        { const unsigned char* buf = F.lds + AT_BUF; ATTN_COMPUTE(buf); }
        if (ti + 2 < ntile) attn_store_tile(F, F.lds, P2);
        __syncthreads();
    }
#undef ATTN_COMPUTE
    l += xlane<16>(l); l = sum_x32(l);
    const float inv = 1.0f / l;
#pragma unroll
    for (int dt = 0; dt < 4; ++dt) { v2u o; o.x = pk2(oacc[dt][0] * inv, oacc[dt][1] * inv); o.y = pk2(oacc[dt][2] * inv, oacc[dt][3] * inv);
        *(v2u*)(YMIX + (size_t)tq * D + h * 64 + 16 * dt + 4 * g) = o; }
}
__device__ __forceinline__ void odd_phase3(const Frame& F) {
    if (F.G >= 256) {
        if (F.bid < 128) {
            const int bh = F.bid & 15, qt = F.bid >> 4, b = bh >> 3, h = bh & 7;
            attn_item(F, TCTX + b * 1024 + qt * 128, h, true, qt * 128, b);
        } else {
            for (int p = F.bid - 128; p < 256; p += F.G - 128) { const int s = p >> 3, h = p & 7;
                attn_item(F, s * 256, h, false, 0, s); attn_item(F, s * 256 + 128, h, false, 0, s); }
        }
        return;
    }
    for (int it = F.bid; it < 640; it += F.G) {
        if (it < 128) { const int b = it >> 6, h = (it >> 3) & 7, qt = it & 7; attn_item(F, TCTX + b * 1024 + qt * 128, h, true, qt * 128, b); }
        else { const int i2 = it - 128, s = i2 >> 4, h = (i2 >> 1) & 7, qt = i2 & 1; attn_item(F, s * 256 + qt * 128, h, false, 0, s); }
    }
}
constexpr int PH_PER_LAYER = 9, PH_L0 = 2, N_PHASES = PH_L0 + 4 * PH_PER_LAYER + 1;
#ifndef MK_ONE_LAUNCH
#define MK_ONE_LAUNCH 1
#endif
#ifndef PROBE_REP
#define PROBE_REP 1
#define PROBE_SLOT -2
#endif

__global__ void __launch_bounds__(NTHR, 2) fwd_kernel(Args args) {
    extern __shared__ __attribute__((aligned(16))) unsigned char lds[];
    Frame F; F.lds = lds; F.tid = threadIdx.x; F.lane = F.tid & 63; F.wave = __builtin_amdgcn_readfirstlane(F.tid >> 6); F.bid = blockIdx.x; F.G = gridDim.x;
    const int wave_id = F.wave;
    { CArgsP ap = (CArgsP)__builtin_amdgcn_kernarg_segment_ptr(); asm volatile("" : "+s"(ap)); F.a = ap; F.ws = (GAS unsigned char*)ap->ws; }
    LAS unsigned char* ldsl = (LAS unsigned char*)lds;
    for (int u = F.tid; u < (LDS_BYTES - LDSCTL_OFF) / 4; u += NTHR) ((LAS unsigned*)(ldsl + LDSCTL_OFF))[u] = 0u;
    __syncthreads();
    XcdBarrier bar; bar.bar = (unsigned*)(GAS unsigned*)(F.ws + WS_CTL) + 1024; bar.x = 0; bar.st = nullptr;
    const bool multi = (args.ph_hi - args.ph_lo) > 1;
    if (multi) bar = xcd_barrier_post((unsigned*)(GAS unsigned*)(F.ws + WS_CTL) + 1024, (volatile LAS unsigned*)(ldsl + MISC_OFF) + 8);

#define FRESH_F() do { int wv_ = wave_id; asm volatile("" : "+s"(wv_)); int ln_; asm volatile("v_mbcnt_lo_u32_b32 %0, -1, 0\n\tv_mbcnt_hi_u32_b32 %0, -1, %0" : "=v"(ln_)); F.tid = wv_ * 64 + ln_; F.lane = ln_; F.wave = wv_; } while (0)
    int rep = 0;
    for (int ph = args.ph_lo; ph < args.ph_hi; ) {
        { CArgsP ap = (CArgsP)__builtin_amdgcn_kernarg_segment_ptr(); asm volatile("" : "+s"(ap)); F.a = ap; F.ws = (GAS unsigned char*)ap->ws;
          int bid_ = blockIdx.x; asm volatile("" : "+s"(bid_)); F.bid = bid_; }
        if (ph == 0) { FRESH_F(); p0_phase(F); }
        else if (ph == 1) { FRESH_F(); p1_copy_phase(F); norm0_phase(F); }
        else if (ph == N_PHASES - 1) { FRESH_F(); final_phase(F); }
        else {
            const int l = (ph - PH_L0) / PH_PER_LAYER, s = (ph - PH_L0) % PH_PER_LAYER, hi = l >> 1; const bool odd = l & 1;
            if (s == 0 || s == 7) {
                FRESH_F();
                const int f = s == 0 ? 0 : 1;
                pg8::Gemm g{(const bf16*)(const GAS bf16*)(F.ws + WS_XA), (const bf16*)(const GAS bf16*)(F.ws + WS_WGU + (size_t)(l * 2 + f) * SZ_WGU), T, 2 * DFF, D, D, D};
                pg8::StaticOrder S; S.init(T, 2 * DFF, F.G, F.bid);
                EpiSwiglu E{F.ws, (int)(((l * 3) + (f == 0 ? 0 : 2)) * 3 * BIAS_MS), (l == 0 && f == 0) ? 16 : 1};
                pg8::gemm_phase<EpiSwiglu, pg8::StaticOrder, true>(ldsl, F.tid, g, S, E);
            } else if (s == 1 || s == 8 || s == 6) {
                FRESH_F();
                const int f = s == 1 ? 0 : 1;
                const bool mix = s == 6, lastg = (s == 8 && l == 3);
                const bf16* gA = mix ? (const bf16*)(const GAS bf16*)(F.ws + WS_YMIX) : (const bf16*)(const GAS bf16*)(F.ws + WS_H);
                const bf16* gB = mix ? (const bf16*)(const GAS bf16*)(F.ws + (odd ? WS_WOO : WS_WOE) + (size_t)hi * SZ_WO) : (const bf16*)(const GAS bf16*)(F.ws + WS_WD + (size_t)(l * 2 + f) * SZ_WD);
                const int gK = mix ? D : DFF;
                const int gate_off = l * 3 * NMODV + (mix ? 5 : (f == 0 ? 2 : 8)) * 1024;
                const float coef = rep ? 0.f : (mix ? 1.0f : 0.5f);
                const int nl = (s == 8) ? l + 1 : l, ni = mix ? 2 : (f == 0 ? 1 : 0), sci = mix ? 7 : (f == 0 ? 4 : 1);
                const float* gn = AIN(I_GNORM) + (size_t)((lastg ? 0 : nl) * 3 + ni) * D;
                const int scn_off = (lastg ? 0 : nl) * 3 * NMODV + sci * 1024;
                pg8::Gemm g{gA, gB, T, D, gK, gK, gK};
                EpiResid E{F.ws, gn, gate_off, scn_off, coef};
                pg8::StaticOrder S; S.init(T, D, F.G, F.bid);
                pg8::gemm_phase<EpiResid, pg8::StaticOrder, true>(ldsl, F.tid, g, S, E);
                FRESH_F();
                if (F.bid >= 160 && rep == 0) {
#ifdef PROBE_BG
                    for (int pb = 0; pb < PROBE_BG - 1; ++pb) { background_work(F, l, s == 1 ? 0 : (s == 6 ? 1 : 2), F.bid - 160, F.G - 160); FRESH_F(); }
#endif
                    background_work(F, l, s == 1 ? 0 : (s == 6 ? 1 : 2), F.bid - 160, F.G - 160); }
            } else if (s == 2 || (s == 4 && odd)) {
                const int ng = s == 2 ? 1 : 3;
                for (int gi = 0; gi < ng; ++gi) {
                    FRESH_F();
                    const bool inproj = s == 2;
                    const int kind = inproj ? 0 : 1 + gi;
                    const size_t offA = kind == 0 ? WS_XA : (kind == 1 ? WS_QA : (kind == 2 ? WS_CKVA : WS_WKV + (size_t)hi * SZ_WKV + (size_t)512 * 256 * 2));
                    const size_t offB = kind == 0 ? (odd ? WS_WIO + (size_t)hi * SZ_WIO : WS_WIE + (size_t)hi * SZ_WIE) : (kind == 1 ? WS_WUQ + (size_t)hi * SZ_WUQ : (kind == 2 ? WS_WKV + (size_t)hi * SZ_WKV : WS_CKVA));
                    const size_t offO = kind == 0 ? WS_PROJ : (kind == 1 ? WS_Q : (kind == 2 ? WS_KN : WS_VT));
                    const int gM = kind == 3 ? 512 : (kind == 2 ? TP : T);
                    const int gN = kind == 0 ? (odd ? ODD_NP : EVEN_NP) : (kind == 1 ? 768 : (kind == 2 ? 512 : TP));
                    const int gK = kind == 0 ? D : (kind == 1 ? 384 : 256);
                    const int ldc = kind == 3 ? TP : gN;
                    const int off = kind == 2 ? 136 : (kind == 3 ? 52 : 0);
                    pg8::Gemm g{(const bf16*)(const GAS bf16*)(F.ws + offA), (const bf16*)(const GAS bf16*)(F.ws + offB), gM, gN, gK, gK, gK};
                    EpiStore E{F.ws, (unsigned)offO, ldc, inproj ? (int)((l * 3 + 1) * 3 * BIAS_MS) : -1};
                    pg8::StaticOrder S; S.init(gM, gN, F.G, (F.bid + off) % F.G);
                    pg8::gemm_phase<EpiStore, pg8::StaticOrder, true>(ldsl, F.tid, g, S, E);
                }
            } else if (s == 3) { if (!odd) { FRESH_F(); even_phase1(F, hi); } else { FRESH_F(); odd_phase1(F, hi); } }
            else if (s == 4) { FRESH_F(); ssd_scan_phase(F, hi); }
            else if (s == 5) { if (odd) { FRESH_F(); odd_phase3(F); } else { FRESH_F(); even_phase2(F, hi); } }
        }
        {
            const int slot = ph < PH_L0 ? 100 + ph : (ph == N_PHASES - 1 ? 102 : ((ph - PH_L0) % PH_PER_LAYER) + 20 * (((ph - PH_L0) / PH_PER_LAYER) & 1));
            const int reps = ((PROBE_SLOT == 200 && slot < 100) || slot == PROBE_SLOT || (PROBE_SLOT < 20 && slot == PROBE_SLOT + 20 && (PROBE_SLOT < 2 || PROBE_SLOT > 5))) ? PROBE_REP : 1;
            if (++rep >= reps) { rep = 0; ++ph; }
            if (ph < args.ph_hi) xcd_barrier(bar);
#if defined(PROBE_BAR)
            if (ph < args.ph_hi) { for (int pb_ = 1; pb_ < PROBE_BAR; ++pb_) xcd_barrier(bar); }
#endif
        }
    }
}

extern "C" void kernel_launch(void* const* d_in, const int* in_sizes, int n_in, void* d_out, int out_size, void* d_ws, size_t ws_size, hipStream_t stream) {
    static int grid = 0;
    if (grid == 0) {
        if (n_in != 34 || (size_t)out_size != OUT_END || ws_size < WS_END) { fprintf(stderr, "kernel_launch: unexpected problem: n_in %d out %d ws %zu (need %zu)\n", n_in, out_size, ws_size, (size_t)WS_END); grid = -1; return; }
        int dev = 0, cus = 0, per_cu = 0;
        if (hipGetDevice(&dev) != hipSuccess || hipDeviceGetAttribute(&cus, hipDeviceAttributeMultiprocessorCount, dev) != hipSuccess) { grid = -1; return; }
        if (hipFuncSetAttribute((const void*)fwd_kernel, hipFuncAttributeMaxDynamicSharedMemorySize, LDS_BYTES) != hipSuccess) { fprintf(stderr, "kernel_launch: hipFuncSetAttribute failed\n"); grid = -1; return; }
        if (hipOccupancyMaxActiveBlocksPerMultiprocessor(&per_cu, (const void*)fwd_kernel, NTHR, LDS_BYTES) != hipSuccess || per_cu < 1) { fprintf(stderr, "kernel_launch: occupancy query says %d blocks per CU\n", per_cu); per_cu = 1; }
        (void)hipGetLastError();
        grid = cus;
        if (grid < 256) fprintf(stderr, "kernel_launch: %d CUs (tuned for 256)\n", grid);
    }
    if (grid < 0) return;
    (void)hipMemsetAsync((char*)d_ws + WS_CTL, 0, CTL_ZERO_BYTES, stream);
    Args a{};
    for (int i = 0; i < 34; ++i) a.in[i] = (const float*)d_in[i];
    a.out = (float*)d_out; a.ws = (unsigned char*)d_ws;
#if MK_ONE_LAUNCH
    a.ph_lo = 0; a.ph_hi = N_PHASES; a.li = 0;
    hipLaunchKernelGGL(fwd_kernel, dim3(grid), dim3(NTHR), LDS_BYTES, stream, a);
#else
    int li = 0;
    for (int ph = 0; ph < N_PHASES; ++ph) {
        a.ph_lo = ph; a.ph_hi = ph + 1; a.li = li++;
        hipLaunchKernelGGL(fwd_kernel, dim3(grid), dim3(NTHR), LDS_BYTES, stream, a);
    }
#endif
}
```

```cpp
#include <hip/hip_runtime.h>
#include <cstdio>
#include <cstdint>
#ifndef GEMM_SP2
#define GEMM_SP2 1
#endif
namespace pg8 {
#define PG8_LAS __attribute__((address_space(3)))
typedef unsigned short bf16_t;
typedef short bf16x8 __attribute__((ext_vector_type(8)));
typedef float f32x4 __attribute__((ext_vector_type(4)));
typedef unsigned u32x4 __attribute__((ext_vector_type(4)));
typedef unsigned u32x2 __attribute__((ext_vector_type(2)));
constexpr int BM = 256, BK = 64, HALF = 128, HTB = HALF * BK * 2  , STAGE_BYTES = 8 * HTB, NXCD = 8, WGM = 8;

__host__ __device__ __forceinline__ int lds_byte(int r, int c) { const int st = (r >> 4) * 2 + (c >> 5), rr = r & 15, cc = c & 31, ob = rr * 64 + cc * 2; return st * 1024 + (ob ^ (((ob >> 9) & 1) << 5)); }
__host__ __device__ __forceinline__ void stage_rc(int b, int& R, int& C) { const int st = b / 1024, sb = b % 1024, swz = sb ^ (((sb >> 9) & 1) << 5); R = (st >> 1) * 16 + swz / 64; C = (st & 1) * 32 + (swz % 64) / 2; }
__host__ __device__ __forceinline__ int perm32(int rho) { const int n = rho >> 4, i = rho & 15; return 8 * (i >> 2) + 4 * n + (i & 3); }

struct Unit { int pm, pn; };
struct Gemm { const bf16_t* A; const bf16_t* Bt; int M, N, K, lda, ldb; };

struct StaticOrder {
    int nM, nN, nwg, G, c;
    __host__ __device__ void init(int M, int N, int G_, int c_, int bmr = BM) { nM = M / bmr; nN = N / BM; nwg = nM * nN; G = G_; c = c_; }
    __host__ __device__ bool next(int i, Unit& u) const {
        const long L = (long)i * G + c; if (L >= nwg) return false;
        int wgid = (int)L; { const int q = nwg / NXCD, r = nwg % NXCD, xcd = wgid % NXCD, off = wgid / NXCD; wgid = (xcd < r ? xcd * (q + 1) : r * (q + 1) + (xcd - r) * q) + off; }
        const int nig = WGM * nN, gid = wgid / nig, fm = gid * WGM, gsz = (nM - fm) < WGM ? (nM - fm) : WGM;
        u.pm = fm + ((wgid % nig) % gsz); u.pn = (wgid % nig) / gsz; return true;
    }
    __device__ __forceinline__ void a_ready(const Unit&) const {}
    __device__ __forceinline__ void done(const Unit&) const {}
};

__device__ __forceinline__ unsigned cvt_pk_bf16(float lo, float hi) { unsigned r; asm volatile("v_cvt_pk_bf16_f32 %0, %1, %2" : "=v"(r) : "v"(lo), "v"(hi)); return r; }

template <class Epi, class Sched, bool ALIGN_EPI, int MH1 = 4>
__device__ __forceinline__ void gemm_phase(PG8_LAS unsigned char* lds, const int tid, const Gemm g, const Sched& S, const Epi& E) {
    const int wid = __builtin_amdgcn_readfirstlane(tid >> 6), lane = tid & 63, wr = wid >> 2, wc = wid & 3, fr = lane & 15, fq = lane >> 4;
    static_assert(MH1 == 4 || MH1 == 1, "row tile");
    constexpr bool R160 = (MH1 == 1); constexpr int BMR = R160 ? 160 : 256;
    const int K = g.K, nt = K / BK;
    unsigned voffA[2], voffB[2], voffA1[2];
#pragma unroll
    for (int i = 0; i < 2; ++i) { int R, C; stage_rc(tid * 16 + i * 8192, R, C); const int Rb = Epi::PERM ? ((R & ~31) + perm32(R & 31)) : R;
        voffA[i] = (unsigned)(R * g.lda + C) * 2u; voffB[i] = (unsigned)(Rb * g.ldb + C) * 2u;
        int R1, C1; stage_rc(wid * 256 + (lane & 15) * 16 + i * 2048, R1, C1); voffA1[i] = (unsigned)(R1 * g.lda + C1) * 2u; }
    const size_t kstep = (size_t)(BK * 2);
    const size_t hstepA = (size_t)HALF * g.lda * 2, hstepB = (size_t)HALF * g.ldb * 2;
    const size_t tstepA = (size_t)BMR * g.lda * 2, tstepB = 2 * hstepB;
    const unsigned ldsw = (unsigned)wid * 1024u, ldsw1 = (unsigned)wid * 256u;
    const int aoff = lds_byte(wr * 64 + fr, fq * 8), boff = lds_byte(wc * 32 + fr, fq * 8), aoff1 = lds_byte(wr * 16 + fr, fq * 8);
#define PG8_SA(b, h) (((b) * 2 + (h)) * HTB)
#define PG8_SB(b, h) ((4 + (b) * 2 + (h)) * HTB)
#define PG8_STAGE(bufoff, gbase, voff) do { _Pragma("unroll") for (int _i = 0; _i < 2; ++_i) \
        __builtin_amdgcn_global_load_lds((const unsigned*)((const char*)(gbase) + (voff)[_i]), (PG8_LAS unsigned*)(lds + (bufoff) + ldsw + _i * 8192), 16, 0, 0); } while (0)
#define PG8_LDA_(dst, b, h) do { _Pragma("unroll") for (int m = 0; m < 4; ++m) _Pragma("unroll") for (int k = 0; k < 2; ++k) dst[m][k] = *(const PG8_LAS bf16x8*)(lds + PG8_SA(b, h) + aoff + m * 2048 + k * 1024); } while (0)
#define PG8_LDA(dst, b, h) do { if constexpr (R160 && (h) == 1) { _Pragma("unroll") for (int k = 0; k < 2; ++k) dst[0][k] = *(const PG8_LAS bf16x8*)(lds + PG8_SA(b, 1) + aoff1 + k * 1024); } else PG8_LDA_(dst, b, h); } while (0)
#define PG8_STAGE_A1(bufoff, gbase) do { if constexpr (R160) { if (lane < 16) { _Pragma("unroll") for (int _i = 0; _i < 2; ++_i) \
        __builtin_amdgcn_global_load_lds((const unsigned*)((const char*)(gbase) + voffA1[_i]), (PG8_LAS unsigned*)(lds + (bufoff) + ldsw1 + _i * 2048), 16, 0, 0); } } else PG8_STAGE(bufoff, gbase, voffA); } while (0)
#define PG8_LDB(dst, b, h) do { _Pragma("unroll") for (int n = 0; n < 2; ++n) _Pragma("unroll") for (int k = 0; k < 2; ++k) dst[n][k] = *(const PG8_LAS bf16x8*)(lds + PG8_SB(b, h) + boff + n * 2048 + k * 1024); } while (0)
#define PG8_MMA(ai, bj, At, Bt) do { __builtin_amdgcn_s_setprio(1); _Pragma("unroll") for (int m = 0; m < ((R160 && (ai) == 1) ? 1 : 4); ++m) _Pragma("unroll") for (int n = 0; n < 2; ++n) _Pragma("unroll") for (int k = 0; k < 2; ++k) \
        acc[ai][bj][m][n] = __builtin_amdgcn_mfma_f32_16x16x32_bf16(Bt[n][k], At[m][k], acc[ai][bj][m][n], 0, 0, 0); __builtin_amdgcn_s_setprio(0); } while (0)
#define PG8_WAIT_V(n) asm volatile("s_waitcnt vmcnt(" #n ")" ::: "memory")
#define PG8_WAIT_L(n) asm volatile("s_waitcnt lgkmcnt(" #n ")" ::: "memory")
#define PG8_BAR __builtin_amdgcn_s_barrier()
#define PG8_SCHED __builtin_amdgcn_sched_barrier(0)
    Unit cur, nxt; int ui = 0;
    if (!S.next(0, cur)) return;
    f32x4 acc[2][2][4][2];
#pragma unroll
    for (int a = 0; a < 2; ++a)
#pragma unroll
        for (int b = 0; b < 2; ++b)
#pragma unroll
            for (int m = 0; m < 4; ++m)
#pragma unroll
                for (int n = 0; n < 2; ++n) acc[a][b][m][n] = (f32x4){0.f, 0.f, 0.f, 0.f};
    bf16x8 At[4][2], B0[2][2], B1[2][2];
    const char* cA = (const char*)g.A + (size_t)cur.pm * tstepA; const char* cB = (const char*)g.Bt + (size_t)cur.pn * tstepB;
    S.a_ready(cur);
    E.prefetch_sync(cur, tid, lds, 0); E.prefetch_dma(cur, wid, lane, lds, 0);
#if GEMM_SP2
    PG8_STAGE(PG8_SB(0, 0), cB, voffB); PG8_STAGE(PG8_SB(0, 1), cB + hstepB, voffB); PG8_STAGE(PG8_SA(0, 0), cA, voffA); PG8_STAGE_A1(PG8_SA(0, 1), cA + hstepA);
    if (wr == 1) PG8_BAR;
    PG8_WAIT_V(2); PG8_BAR;
    PG8_STAGE(PG8_SB(1, 0), cB + kstep, voffB); PG8_STAGE(PG8_SA(1, 0), cA + kstep, voffA); PG8_STAGE(PG8_SB(1, 1), cB + hstepB + kstep, voffB);
    PG8_WAIT_V(6); PG8_BAR;
#else
    static_assert(!R160, "the 160-row unit exists for the SP2 schedule only");
    PG8_STAGE(PG8_SB(0, 0), cB, voffB); PG8_STAGE(PG8_SA(0, 0), cA, voffA); PG8_STAGE(PG8_SB(0, 1), cB + hstepB, voffB); PG8_STAGE(PG8_SA(0, 1), cA + hstepA, voffA);
    if (wr == 1) PG8_BAR;
    PG8_WAIT_V(4); PG8_BAR;
    PG8_STAGE(PG8_SB(1, 0), cB + kstep, voffB); PG8_STAGE(PG8_SA(1, 0), cA + kstep, voffA); PG8_STAGE(PG8_SB(1, 1), cB + hstepB + kstep, voffB);
    PG8_WAIT_V(6); PG8_BAR;
#endif
    for (;;) {
        const bool has_next = S.next(ui + 1, nxt);
        const char* nA = has_next ? (const char*)g.A + (size_t)nxt.pm * tstepA : cA; const char* nB = has_next ? (const char*)g.Bt + (size_t)nxt.pn * tstepB : cB;
        for (int t = 0; t < nt; t += 2) {
            const bool last = (t == nt - 2);
            const char* a1 = cA + (size_t)(t + 1) * kstep;
            const char* a2 = last ? nA : cA + (size_t)(t + 2) * kstep; const char* b2 = last ? nB : cB + (size_t)(t + 2) * kstep;
            const char* a3 = a2 + kstep; const char* b3 = b2 + kstep;
            if (last && has_next) { S.a_ready(nxt); E.prefetch_dma(nxt, wid, lane, lds, (ui + 1) & 1); }
#if GEMM_SP2
            PG8_LDB(B0, 0, 0); PG8_LDB(B1, 0, 1); PG8_SCHED; PG8_LDA(At, 0, 0); PG8_STAGE_A1(PG8_SA(1, 1), a1 + hstepA);
            PG8_WAIT_V(8); PG8_WAIT_L(0); PG8_BAR; PG8_MMA(0, 0, At, B0); PG8_MMA(0, 1, At, B1); PG8_BAR; PG8_SCHED;
            PG8_LDA(At, 0, 1); PG8_STAGE(PG8_SB(0, 0), b2, voffB); PG8_STAGE(PG8_SB(0, 1), b2 + hstepB, voffB); PG8_STAGE(PG8_SA(0, 0), a2, voffA);
            PG8_WAIT_V(8); PG8_WAIT_L(0); PG8_BAR; PG8_MMA(1, 0, At, B0); PG8_MMA(1, 1, At, B1); PG8_BAR; PG8_SCHED;
            PG8_LDB(B0, 1, 0); PG8_LDB(B1, 1, 1); PG8_SCHED; PG8_LDA(At, 1, 0); PG8_STAGE_A1(PG8_SA(0, 1), a2 + hstepA);
            PG8_WAIT_V(8); PG8_WAIT_L(0); PG8_BAR; PG8_MMA(0, 0, At, B0); PG8_MMA(0, 1, At, B1); PG8_BAR; PG8_SCHED;
            PG8_LDA(At, 1, 1); PG8_STAGE(PG8_SB(1, 0), b3, voffB); PG8_STAGE(PG8_SB(1, 1), b3 + hstepB, voffB); PG8_STAGE(PG8_SA(1, 0), a3, voffA);
            PG8_WAIT_V(8); PG8_WAIT_L(0); PG8_BAR; PG8_MMA(1, 0, At, B0); PG8_MMA(1, 1, At, B1); PG8_BAR; PG8_SCHED;
#else
            PG8_LDB(B0, 0, 0); PG8_SCHED; PG8_LDA(At, 0, 0); PG8_STAGE(PG8_SA(1, 1), a1 + hstepA, voffA);
            PG8_WAIT_L(8); PG8_BAR; PG8_WAIT_L(0); PG8_MMA(0, 0, At, B0); PG8_BAR; PG8_SCHED;
            PG8_LDB(B1, 0, 1); PG8_STAGE(PG8_SB(0, 0), b2, voffB);
            PG8_BAR; PG8_WAIT_L(0); PG8_MMA(0, 1, At, B1); PG8_BAR;
            PG8_LDA(At, 0, 1); PG8_STAGE(PG8_SA(0, 0), a2, voffA);
            PG8_BAR; PG8_WAIT_L(0); PG8_MMA(1, 0, At, B0); PG8_BAR; PG8_SCHED;
            PG8_STAGE(PG8_SB(0, 1), b2 + hstepB, voffB);
            PG8_WAIT_V(6); PG8_BAR; PG8_MMA(1, 1, At, B1); PG8_BAR;
            PG8_LDB(B0, 1, 0); PG8_SCHED; PG8_LDA(At, 1, 0); PG8_STAGE(PG8_SA(0, 1), a2 + hstepA, voffA);
            PG8_WAIT_L(8); PG8_BAR; PG8_WAIT_L(0); PG8_MMA(0, 0, At, B0); PG8_BAR; PG8_SCHED;
            PG8_LDB(B1, 1, 1); PG8_STAGE(PG8_SB(1, 0), b3, voffB);
            PG8_BAR; PG8_WAIT_L(0); PG8_MMA(0, 1, At, B1); PG8_BAR;
            PG8_LDA(At, 1, 1); PG8_STAGE(PG8_SA(1, 0), a3, voffA);
            PG8_BAR; PG8_WAIT_L(0); PG8_MMA(1, 0, At, B0); PG8_BAR; PG8_SCHED;
            PG8_STAGE(PG8_SB(1, 1), b3 + hstepB, voffB);
            PG8_WAIT_V(6); PG8_BAR; PG8_MMA(1, 1, At, B1); PG8_BAR;
#endif
        }
        if constexpr (ALIGN_EPI) { if (wr == 0) PG8_BAR; }
        E(acc, cur, wr, wc, fr, fq, lds, ui & 1);
#if defined(PROBE_EPI)
        if constexpr ((Epi::KIND & PROBE_EPI) != 0) { for (int er_ = 1; er_ < PROBE_EPI_REP; ++er_) E(acc, cur, wr, wc, fr, fq, lds, ui & 1); }
#endif
        if (!has_next) break;
#pragma unroll
        for (int a = 0; a < 2; ++a)
#pragma unroll
            for (int b = 0; b < 2; ++b)
#pragma unroll
                for (int m = 0; m < 4; ++m)
#pragma unroll
                    for (int n = 0; n < 2; ++n) acc[a][b][m][n] = (f32x4){0.f, 0.f, 0.f, 0.f};
        cur = nxt; cA = nA; cB = nB; ++ui;
        E.prefetch_sync(cur, tid, lds, ui & 1);
        if constexpr (ALIGN_EPI) { if (wr == 1) PG8_BAR; }
    }
    PG8_WAIT_V(0);
    if constexpr (!ALIGN_EPI) { if (wr == 0) PG8_BAR; }
    PG8_BAR;
#undef PG8_SA
#undef PG8_SB
#undef PG8_STAGE
#undef PG8_LDA
#undef PG8_LDA_
#undef PG8_STAGE_A1
#undef PG8_LDB
#undef PG8_MMA
#undef PG8_WAIT_V
#undef PG8_WAIT_L
#undef PG8_BAR
#undef PG8_SCHED
}
}
constexpr int NWAVES = 8, NTHR = 512;
constexpr int D = 1024, TCTX = 8192, TSMP = 2048, T = 10240, TP = T + 512;
constexpr int DFF = 2816, NMODV = 9 * 1024;
constexpr int EVEN_NP = 2816, ODD_NP = 1792;
constexpr float EPS = 1e-6f;
constexpr int NCHUNK = 80;

constexpr size_t MiB = 1u << 20;
constexpr size_t WS_CTL = 0, CTL_ZERO_BYTES = 64 * 1024;
constexpr size_t WS_MOD = 1 * MiB;
constexpr size_t WS_ROPE = WS_MOD + 512 * 1024;
constexpr size_t WS_DEC = WS_ROPE + 160 * 1024;
constexpr size_t WS_SSQ = WS_MOD + 768 * 1024;
constexpr size_t WS_BIAS = 2 * MiB;
constexpr size_t BIAS_LD = 5632, BIAS_MS = 16 * BIAS_LD;
constexpr size_t WS_BIASF = 15 * MiB;
constexpr size_t WS_WGU = 16 * MiB;
constexpr size_t SZ_WGU = (size_t)5632 * 1024 * 2;
constexpr size_t WS_WD = WS_WGU + 8 * SZ_WGU;
constexpr size_t SZ_WD = (size_t)1024 * 2816 * 2;
constexpr size_t WS_WIE = WS_WD + 8 * SZ_WD;
constexpr size_t SZ_WIE = (size_t)EVEN_NP * 1024 * 2;
constexpr size_t WS_WOE = WS_WIE + 2 * SZ_WIE;
constexpr size_t SZ_WO = (size_t)1024 * 1024 * 2;
constexpr size_t WS_WIO = WS_WOE + 2 * SZ_WO;
constexpr size_t SZ_WIO = (size_t)ODD_NP * 1024 * 2;
constexpr size_t WS_WOO = WS_WIO + 2 * SZ_WIO;
constexpr size_t WS_WUQ = WS_WOO + 2 * SZ_WO;
constexpr size_t SZ_WUQ = (size_t)768 * 384 * 2;
constexpr size_t WS_WKV = WS_WUQ + 2 * SZ_WUQ;
constexpr size_t SZ_WKV = (size_t)1024 * 256 * 2;
constexpr size_t WS_WEND = WS_WKV + 2 * SZ_WKV;
constexpr size_t WS_X = (WS_WEND + MiB - 1) / MiB * MiB;
constexpr size_t WS_XA = WS_X + (size_t)T * D * 4;
constexpr size_t WS_PROJ = WS_XA + (size_t)T * D * 2;
constexpr size_t WS_YMIX = WS_PROJ + (size_t)T * EVEN_NP * 2;
constexpr size_t WS_H = WS_YMIX + (size_t)T * D * 2;
constexpr size_t WS_ST = WS_H;
constexpr size_t WS_QA = WS_H;
constexpr size_t WS_CKVA = WS_QA + (size_t)T * 384 * 2;
constexpr size_t WS_KR = WS_CKVA + (size_t)TP * 256 * 2;
constexpr size_t WS_Q = WS_KR + (size_t)TP * 32 * 2;
constexpr size_t WS_KN = WS_Q + (size_t)T * 768 * 2;
constexpr size_t WS_VT = WS_KN + (size_t)TP * 512 * 2;
constexpr size_t WS_HEND = WS_H + (size_t)T * DFF * 2;
static_assert(WS_VT + (size_t)512 * TP * 2 <= WS_HEND, "odd-layer scratch fits the H overlay");
static_assert(WS_ST + (size_t)NCHUNK * 8 * 2 * 8192 * 4 <= WS_HEND, "chunk states fit the H overlay");
constexpr size_t WS_XCT = WS_HEND;
constexpr size_t WS_CC = WS_XCT + (size_t)NCHUNK * 8 * 8192 * 2;
constexpr size_t WS_CBM = WS_CC + (size_t)T * 256 * 2;
constexpr size_t WS_HIN = WS_CBM + (size_t)NCHUNK * 2 * 16384 * 2;
constexpr size_t WS_END = WS_HIN + (size_t)NCHUNK * 8 * 2 * 8192 * 2;

constexpr size_t OUT_Y = 0, OUT_SSD = (size_t)T * D, OUT_CKV = OUT_SSD + (size_t)32 * 2 * 2 * 8 * 64 * 128, OUT_KR = OUT_CKV + (size_t)32 * 2 * 256 * 256, OUT_END = OUT_KR + (size_t)32 * 2 * 256 * 32;

constexpr int RING_BYTES = 131072;
constexpr int LDSCTL_OFF = 144 * 1024 - 512, MISC_OFF = LDSCTL_OFF + 320;
constexpr int LDS_BYTES = 147456;

#define GAS __attribute__((address_space(1)))
#define LAS __attribute__((address_space(3)))
typedef unsigned short bf16;
typedef unsigned v4u __attribute__((ext_vector_type(4)));
typedef unsigned v2u __attribute__((ext_vector_type(2)));
typedef float f32x4 __attribute__((ext_vector_type(4)));
typedef short bf16x8 __attribute__((ext_vector_type(8)));
typedef GAS unsigned gu32;
#define RLX_AGENT __ATOMIC_RELAXED, __HIP_MEMORY_SCOPE_AGENT
__device__ __forceinline__ unsigned f2bf(float f) { unsigned u = __builtin_bit_cast(unsigned, f); return (u + 0x7fffu + ((u >> 16) & 1u)) >> 16; }
typedef float f32x2_t __attribute__((ext_vector_type(2)));
typedef __bf16 bf16x2_t __attribute__((ext_vector_type(2)));
__device__ __forceinline__ unsigned pk2(float lo, float hi) { const f32x2_t v = {lo, hi}; const bf16x2_t b = __builtin_convertvector(v, bf16x2_t); return __builtin_bit_cast(unsigned, b); }
__device__ __forceinline__ unsigned f2bf1(float f) { return pk2(f, 0.f) & 0xffffu; }
__device__ __forceinline__ float bflo(unsigned w) { return __builtin_bit_cast(float, w << 16); }
__device__ __forceinline__ float bfhi(unsigned w) { return __builtin_bit_cast(float, w & 0xffff0000u); }
__device__ __forceinline__ float bf1(bf16 h) { return __builtin_bit_cast(float, ((unsigned)h) << 16); }
__device__ __forceinline__ void unpack8(const v4u v, float* o) { o[0] = bflo(v.x); o[1] = bfhi(v.x); o[2] = bflo(v.y); o[3] = bfhi(v.y); o[4] = bflo(v.z); o[5] = bfhi(v.z); o[6] = bflo(v.w); o[7] = bfhi(v.w); }
__device__ __forceinline__ v4u pack8(const float* o) { v4u v; v.x = pk2(o[0], o[1]); v.y = pk2(o[2], o[3]); v.z = pk2(o[4], o[5]); v.w = pk2(o[6], o[7]); return v; }
template <int K> __device__ __forceinline__ float xlane(float v) { static_assert(K >= 1 && K < 32, "xor mask inside a 32-lane half");
    return __builtin_bit_cast(float, __builtin_amdgcn_ds_swizzle(__builtin_bit_cast(int, v), (K << 10) | 0x1F)); }
__device__ __forceinline__ float sum_x32(float v) { const unsigned u = __builtin_bit_cast(unsigned, v); const auto r = __builtin_amdgcn_permlane32_swap(u, u, false, false);
    return __builtin_bit_cast(float, (unsigned)r[0]) + __builtin_bit_cast(float, (unsigned)r[1]); }
__device__ __forceinline__ float max_x32(float v) { const unsigned u = __builtin_bit_cast(unsigned, v); const auto r = __builtin_amdgcn_permlane32_swap(u, u, false, false);
    return fmaxf(__builtin_bit_cast(float, (unsigned)r[0]), __builtin_bit_cast(float, (unsigned)r[1])); }
__device__ __forceinline__ float wave_sum(float v) {
    v += xlane<1>(v); v += xlane<2>(v); v += xlane<4>(v); v += xlane<8>(v); v += xlane<16>(v);
    return sum_x32(v);
}
__device__ __forceinline__ float frcp(float x) { return __builtin_amdgcn_rcpf(x); }
__device__ __forceinline__ float frsq(float x) { return __builtin_amdgcn_rsqf(x); }
__device__ __forceinline__ float sigmoidf_(float x) { return frcp(1.0f + __expf(-x)); }
__device__ __forceinline__ float siluf_(float x) { return x * frcp(1.0f + __expf(-x)); }
__device__ __forceinline__ float gelu_tanh(float x) { const float y = 0.7978845608028654f * (x + 0.044715f * x * x * x); const float t = 1.0f - 2.0f * frcp(1.0f + __expf(2.0f * y)); return 0.5f * x * (1.0f + t); }
__device__ __forceinline__ float softplusf_(float x) { const float e = __expf(x); return x > 20.f ? x : (e < 1e-3f ? e * (1.0f - 0.5f * e) : __logf(1.0f + e)); }
__device__ __forceinline__ int modrow_of_tile(int pm) { return pm < 32 ? 0 : 1 + ((pm - 32) >> 2); }
__device__ __forceinline__ int modrow_of_tok(int t) { return t < TCTX ? 0 : 1 + ((t - TCTX) >> 10); }

#define XB_TMO      128
#define XB_XCNT(j)  (256  + 64 * (j))
#define XB_XSUB(j)  (1280 + 64 * (j))
#define XB_XGEN(j)  (2304 + 64 * (j))
#define XB_TOP      3328
#define XB_TOPGEN   3392
#define XCD_BAR_WORDS 3456
#define XB_SPIN_CAP (1u << 22)
__device__ __forceinline__ unsigned xb_ld(unsigned* p)              { return __hip_atomic_load(p, __ATOMIC_RELAXED, __HIP_MEMORY_SCOPE_AGENT); }
__device__ __forceinline__ unsigned xb_add(unsigned* p, unsigned v) { return __hip_atomic_fetch_add(p, v, __ATOMIC_RELAXED, __HIP_MEMORY_SCOPE_AGENT); }
__device__ __forceinline__ unsigned xb_xcc_id() { return (unsigned)__builtin_amdgcn_s_getreg((3 << 11) | 20) & 0xFu; }
#define XB_SPIN(cond, bar) do { unsigned _sp = 0; while (cond) { __builtin_amdgcn_s_sleep(1); \
    if ((++_sp & 255u) == 0u) { if (xb_ld(&(bar)[XB_TMO])) break; if (_sp > XB_SPIN_CAP) { atomicAdd(&(bar)[XB_TMO], 1u); break; } } } } while (0)
struct XcdBarrier { unsigned* bar; unsigned x; volatile LAS unsigned* st; };
__device__ __forceinline__ XcdBarrier xcd_barrier_post(unsigned* bar, volatile LAS unsigned* st) {
    XcdBarrier b; b.bar = bar; b.x = xb_xcc_id(); b.st = st;
    if (threadIdx.x == 0) (void)xb_add(&bar[XB_XCNT(b.x)], 1u);
    return b;
}
__device__ __forceinline__ void xcd_barrier_complete(unsigned* bar, unsigned x, unsigned& nloc, unsigned& nx) {
    const unsigned G = gridDim.x * gridDim.y * gridDim.z;
    unsigned sum, cnt, mine, sp = 0u;
    for (;;) {
        sum = 0u; cnt = 0u; mine = 0u;
#pragma unroll
        for (unsigned j = 0; j < 16; ++j) { const unsigned c = xb_ld(&bar[XB_XCNT(j)]); sum += c; cnt += (c > 0u) ? 1u : 0u; mine = (j == x) ? c : mine; }
        if (sum == G) break;
        __builtin_amdgcn_s_sleep(1);
        if ((++sp & 255u) == 0u) { if (xb_ld(&bar[XB_TMO])) break; if (sp > XB_SPIN_CAP) { atomicAdd(&bar[XB_TMO], 1u); break; } }
    }
    nloc = mine > 0u ? mine : 1u; nx = cnt > 0u ? cnt : 1u;
}
__device__ __forceinline__ void xcd_barrier(const XcdBarrier& b) {
    asm volatile("s_waitcnt vmcnt(0)" ::: "memory");
    __syncthreads();
    if (threadIdx.x == 0) {
        unsigned* bar = b.bar;
        __builtin_amdgcn_s_waitcnt(0);
        unsigned nloc = b.st[0], nx = b.st[1];
        if (nloc == 0u) { xcd_barrier_complete(bar, b.x, nloc, nx); b.st[0] = nloc; b.st[1] = nx; }
        const unsigned k = b.st[2] + 1u; b.st[2] = k;
        const unsigned old = xb_add(&bar[XB_XSUB(b.x)], 1u);
        if (old + 1u == k * nloc) {
            __builtin_amdgcn_fence(__ATOMIC_RELEASE, "agent");
            asm volatile("s_waitcnt vmcnt(0)" ::: "memory");
            const unsigned og = xb_add(&bar[XB_TOP], 1u);
            if (og + 1u == k * nx) xb_add(&bar[XB_TOPGEN], 1u);
        }
        XB_SPIN(xb_ld(&bar[XB_TOPGEN]) < k, bar);
        __builtin_amdgcn_fence(__ATOMIC_ACQUIRE, "agent");
        asm volatile("s_waitcnt vmcnt(0)" ::: "memory");
    }
    __syncthreads();
}

struct Args { const float* in[34]; float* out; unsigned char* ws; int ph_lo, ph_hi, li, pad; };
typedef const __attribute__((address_space(4))) Args* CArgsP;
enum { I_XP = 0, I_XS, I_SSD, I_CCKV, I_CKR, I_C, I_CCTX, I_WMOD, I_BMOD, I_GNORM, I_WGU, I_WDN, I_WIE, I_WOE, I_WSP, I_BSP, I_GV, I_WCS, I_BCS, I_DTB, I_ALOG, I_DSK, I_GSO,
       I_WIO, I_WOO, I_GCQ, I_WUQ, I_GCKV, I_WUKV, I_WDW, I_BDW, I_GLN, I_BLN, I_GFIN };
using pg8::Unit;
constexpr int EP_PART = RING_BYTES, EP_S = RING_BYTES + 4096, EP_B = RING_BYTES + 4096 + 8192;
__device__ __forceinline__ void epi_prefetch_dma(GAS unsigned char* ws, int bias_off, const Unit& u, int wid, int lane, PG8_LAS unsigned char* ldsl, int par) {
    if (wid < 4) __builtin_amdgcn_global_load_lds((const GAS unsigned*)(ws + WS_SSQ + ((size_t)(u.pm * 256 + 64 * wid + lane) * 4) * 4), (PG8_LAS unsigned*)(ldsl + EP_S + par * 4096 + wid * 1024), 16, 0, 0);
    else if (wid == 4) __builtin_amdgcn_global_load_lds((const GAS unsigned*)(ws + WS_BIASF + ((size_t)bias_off / 16 + (size_t)modrow_of_tile(u.pm) * BIAS_LD + u.pn * 256 + 4 * lane) * 4), (PG8_LAS unsigned*)(ldsl + EP_B + par * 1024), 16, 0, 0);
}
__device__ __forceinline__ void epi_prefetch_sync16(GAS unsigned char* ws, int bias_off, const Unit& u, int tid, PG8_LAS unsigned char* ldsl, int par) {
    if (tid < 256) *(PG8_LAS pg8::f32x4*)(ldsl + EP_S + par * 4096 + tid * 16) = *(const GAS pg8::f32x4*)(ws + WS_SSQ + ((size_t)(u.pm * 256 + tid) * 4) * 4);
    else { const GAS float* bp = (const GAS float*)(ws + WS_BIAS) + (size_t)bias_off + (size_t)modrow_of_tile(u.pm) * BIAS_MS + u.pn * 256 + (tid - 256); float b = 0.f;
#pragma unroll
        for (int kb = 0; kb < 16; ++kb) b += bp[(size_t)kb * BIAS_LD];
        ((PG8_LAS float*)(ldsl + EP_B))[par * 256 + (tid - 256)] = b; }
}
__device__ __forceinline__ float epi_row_rstd(const PG8_LAS unsigned char* ldsl, int par, int rl) { const pg8::f32x4 s = *(const PG8_LAS pg8::f32x4*)(ldsl + EP_S + par * 4096 + rl * 16); return frsq(((s[0] + s[1]) + (s[2] + s[3])) * (1.f / D) + EPS); }
struct EpiSwiglu {
    static constexpr bool PERM = true; static constexpr int KIND = 1;
    GAS unsigned char* ws; int bias_off, nparts;
    __device__ __forceinline__ void prefetch_dma(const Unit& u, int wid, int lane, PG8_LAS unsigned char* ldsl, int par) const { if (nparts == 1) epi_prefetch_dma(ws, bias_off, u, wid, lane, ldsl, par); }
    __device__ __forceinline__ void prefetch_sync(const Unit& u, int tid, PG8_LAS unsigned char* ldsl, int par) const { if (nparts != 1) epi_prefetch_sync16(ws, bias_off, u, tid, ldsl, par); }
    __device__ __forceinline__ void operator()(const pg8::f32x4 (&acc)[2][2][4][2], const Unit& u, int wr, int wc, int fr, int fq, PG8_LAS unsigned char* ldsl, int par) const {
        bf16* H = (bf16*)(GAS bf16*)(ws + WS_H);
        const PG8_LAS float* bb = (const PG8_LAS float*)(ldsl + EP_B) + par * 256 + wc * 32 + 8 * fq;
        const int row0 = u.pm * 256 + wr * 64 + fr, col0 = u.pn * 128 + wc * 32 + 8 * fq;
        const pg8::f32x4 bg0 = *(const PG8_LAS pg8::f32x4*)bb, bg1 = *(const PG8_LAS pg8::f32x4*)(bb + 4), bu0 = *(const PG8_LAS pg8::f32x4*)(bb + 128), bu1 = *(const PG8_LAS pg8::f32x4*)(bb + 132);
#pragma unroll
        for (int ai = 0; ai < 2; ++ai)
#pragma unroll
            for (int m = 0; m < 4; ++m) {
                const int rl = ai * 128 + wr * 64 + m * 16 + fr;
                const float rs = epi_row_rstd(ldsl, par, rl);
                bf16* rowp = H + (size_t)(u.pm * 256 + rl) * DFF + col0;
                const pg8::f32x4 g0 = acc[ai][0][m][0] * rs + bg0, g1 = acc[ai][0][m][1] * rs + bg1, u0 = acc[ai][1][m][0] * rs + bu0, u1 = acc[ai][1][m][1] * rs + bu1;
                float gg[8], uu[8], e[8], o[8];
#pragma unroll
                for (int j = 0; j < 4; ++j) { gg[j] = g0[j]; gg[4 + j] = g1[j]; uu[j] = u0[j]; uu[4 + j] = u1[j]; }
#pragma unroll
                for (int j = 0; j < 8; ++j) e[j] = __builtin_amdgcn_exp2f(gg[j] * -1.4426950408889634f);
#pragma unroll
                for (int j = 0; j < 8; ++j) e[j] = __builtin_amdgcn_rcpf(1.0f + e[j]);
#pragma unroll
                for (int j = 0; j < 8; ++j) o[j] = (gg[j] * uu[j]) * e[j];
                pg8::u32x4 w; w.x = pg8::cvt_pk_bf16(o[0], o[1]); w.y = pg8::cvt_pk_bf16(o[2], o[3]); w.z = pg8::cvt_pk_bf16(o[4], o[5]); w.w = pg8::cvt_pk_bf16(o[6], o[7]);
                *(pg8::u32x4*)rowp = w;
            }
        (void)row0;
    }
};
struct EpiResid {
    static constexpr bool PERM = true; static constexpr int KIND = 4;
    GAS unsigned char* ws; const float* gn; int gate_off, scn_off; float coef;
    __device__ __forceinline__ void prefetch_dma(const Unit&, int, int, PG8_LAS unsigned char*, int) const {}
    __device__ __forceinline__ void prefetch_sync(const Unit&, int, PG8_LAS unsigned char*, int) const {}
    __device__ __forceinline__ void operator()(const pg8::f32x4 (&acc)[2][2][4][2], const Unit& u, int wr, int wc, int fr, int fq, PG8_LAS unsigned char* ldsl, int) const {
        bf16* X = (bf16*)(GAS bf16*)(ws + WS_X); const float* gate = (const float*)(const GAS float*)(ws + WS_MOD) + gate_off; const float* scn = (const float*)(const GAS float*)(ws + WS_MOD) + scn_off;
        bf16* XA = (bf16*)(GAS bf16*)(ws + WS_XA); float* SSQ = (float*)(GAS float*)(ws + WS_SSQ); PG8_LAS float* part = (PG8_LAS float*)(ldsl + EP_PART);
        const int row0 = u.pm * 256 + wr * 64 + fr, col0 = u.pn * 256 + wc * 32 + 8 * fq;
        const int mr = modrow_of_tile(u.pm);
        float ss[2][4];
#pragma unroll
        for (int ai = 0; ai < 2; ++ai)
#pragma unroll
            for (int m = 0; m < 4; ++m) ss[ai][m] = 0.f;
#pragma unroll
        for (int bj = 0; bj < 2; ++bj) {
            const int co = col0 + bj * 128;
            const float* gp = gate + (size_t)mr * NMODV + co; const float* sp = scn + (size_t)mr * NMODV + co;
            const pg8::f32x4 gv0 = *(const pg8::f32x4*)gp * coef, gv1 = *(const pg8::f32x4*)(gp + 4) * coef;
            const pg8::f32x4 gc0 = *(const pg8::f32x4*)(gn + co) * (*(const pg8::f32x4*)sp + 1.0f), gc1 = *(const pg8::f32x4*)(gn + co + 4) * (*(const pg8::f32x4*)(sp + 4) + 1.0f);
#pragma unroll
            for (int ai = 0; ai < 2; ++ai) {
                pg8::u32x4 xo[4];
#pragma unroll
                for (int m = 0; m < 4; ++m) xo[m] = *(const pg8::u32x4*)(X + (size_t)(row0 + ai * 128 + m * 16) * D + co);
#pragma unroll
                for (int m = 0; m < 4; ++m) {
                    const size_t off = (size_t)(row0 + ai * 128 + m * 16) * D + co;
                    const pg8::u32x4 xw = xo[m];
                    const pg8::f32x4 x0 = {bflo(xw.x), bfhi(xw.x), bflo(xw.y), bfhi(xw.y)}, x1 = {bflo(xw.z), bfhi(xw.z), bflo(xw.w), bfhi(xw.w)};
                    const pg8::f32x4 n0 = x0 + gv0 * acc[ai][bj][m][0], n1 = x1 + gv1 * acc[ai][bj][m][1];
                    ss[ai][m] += ((n0[0] * n0[0] + n0[1] * n0[1]) + (n0[2] * n0[2] + n0[3] * n0[3])) + ((n1[0] * n1[0] + n1[1] * n1[1]) + (n1[2] * n1[2] + n1[3] * n1[3]));
                    pg8::u32x4 w; w.x = pg8::cvt_pk_bf16(n0[0], n0[1]); w.y = pg8::cvt_pk_bf16(n0[2], n0[3]); w.z = pg8::cvt_pk_bf16(n1[0], n1[1]); w.w = pg8::cvt_pk_bf16(n1[2], n1[3]);
                    *(pg8::u32x4*)(X + off) = w;
                    const pg8::f32x4 a0 = n0 * gc0, a1 = n1 * gc1;
                    pg8::u32x4 v; v.x = pg8::cvt_pk_bf16(a0[0], a0[1]); v.y = pg8::cvt_pk_bf16(a0[2], a0[3]); v.z = pg8::cvt_pk_bf16(a1[0], a1[1]); v.w = pg8::cvt_pk_bf16(a1[2], a1[3]);
                    *(pg8::u32x4*)(XA + off) = v;
                }
            }
        }
#pragma unroll
        for (int ai = 0; ai < 2; ++ai)
#pragma unroll
            for (int m = 0; m < 4; ++m) { float s = ss[ai][m]; s += xlane<16>(s); s = sum_x32(s);
                if (fq == 0) part[wc * 256 + ai * 128 + wr * 64 + m * 16 + fr] = s; }
        asm volatile("s_waitcnt lgkmcnt(0)" ::: "memory"); __builtin_amdgcn_s_barrier(); asm volatile("" ::: "memory");
        const int t = (wr * 4 + wc) * 64 + fq * 16 + fr;
        if (t < 256) SSQ[(size_t)(u.pm * 256 + t) * 4 + u.pn] = (part[t] + part[256 + t]) + (part[512 + t] + part[768 + t]);
    }
};
struct EpiResid160 {
    static constexpr bool PERM = true; static constexpr int KIND = 4;
    GAS unsigned char* ws; const float* gn; int gate_off, scn_off; float coef;
    __device__ __forceinline__ void prefetch_dma(const Unit&, int, int, PG8_LAS unsigned char*, int) const {}
    __device__ __forceinline__ void prefetch_sync(const Unit&, int, PG8_LAS unsigned char*, int) const {}
    __device__ __forceinline__ void operator()(const pg8::f32x4 (&acc)[2][2][4][2], const Unit& u, int wr, int wc, int fr, int fq, PG8_LAS unsigned char* ldsl, int) const {
        bf16* X = (bf16*)(GAS bf16*)(ws + WS_X); const float* gate = (const float*)(const GAS float*)(ws + WS_MOD) + gate_off; const float* scn = (const float*)(const GAS float*)(ws + WS_MOD) + scn_off;
        bf16* XA = (bf16*)(GAS bf16*)(ws + WS_XA); float* SSQ = (float*)(GAS float*)(ws + WS_SSQ); PG8_LAS float* part = (PG8_LAS float*)(ldsl + EP_PART);
        const int rowbase = u.pm * 160, col0 = u.pn * 256 + wc * 32 + 8 * fq;
        const int mrA = modrow_of_tok(rowbase), mrB = modrow_of_tok(rowbase + 159);
        const int bnd = (mrA == mrB) ? (1 << 30) : (mrB == 1 ? TCTX : TCTX + 1024);
        float ss[5];
#pragma unroll
        for (int i = 0; i < 5; ++i) ss[i] = 0.f;
#pragma unroll
        for (int bj = 0; bj < 2; ++bj) {
            const int co = col0 + bj * 128;
            const float* gpA = gate + (size_t)mrA * NMODV + co; const float* spA = scn + (size_t)mrA * NMODV + co;
            const float* gpB = gate + (size_t)mrB * NMODV + co; const float* spB = scn + (size_t)mrB * NMODV + co;
            const pg8::f32x4 gn0 = *(const pg8::f32x4*)(gn + co), gn1 = *(const pg8::f32x4*)(gn + co + 4);
            const pg8::f32x4 gvA0 = *(const pg8::f32x4*)gpA * coef, gvA1 = *(const pg8::f32x4*)(gpA + 4) * coef, gvB0 = *(const pg8::f32x4*)gpB * coef, gvB1 = *(const pg8::f32x4*)(gpB + 4) * coef;
            const pg8::f32x4 gcA0 = gn0 * (*(const pg8::f32x4*)spA + 1.0f), gcA1 = gn1 * (*(const pg8::f32x4*)(spA + 4) + 1.0f), gcB0 = gn0 * (*(const pg8::f32x4*)spB + 1.0f), gcB1 = gn1 * (*(const pg8::f32x4*)(spB + 4) + 1.0f);
            pg8::u32x4 xo[5];
#pragma unroll
            for (int i = 0; i < 5; ++i) { const int rl = i < 4 ? wr * 64 + i * 16 + fr : 128 + wr * 16 + fr; xo[i] = *(const pg8::u32x4*)(X + (size_t)(rowbase + rl) * D + co); }
#pragma unroll
            for (int i = 0; i < 5; ++i) {
                const int rb = i < 4 ? wr * 64 + i * 16 : 128 + wr * 16;
                const bool hb = rowbase + rb >= bnd;
                const pg8::f32x4 gv0 = hb ? gvB0 : gvA0, gv1 = hb ? gvB1 : gvA1, gc0 = hb ? gcB0 : gcA0, gc1 = hb ? gcB1 : gcA1;
                const size_t off = (size_t)(rowbase + rb + fr) * D + co;
                const pg8::u32x4 xw = xo[i];
                const pg8::f32x4 c0 = i < 4 ? acc[0][bj][i & 3][0] : acc[1][bj][0][0], c1 = i < 4 ? acc[0][bj][i & 3][1] : acc[1][bj][0][1];
                const pg8::f32x4 x0 = {bflo(xw.x), bfhi(xw.x), bflo(xw.y), bfhi(xw.y)}, x1 = {bflo(xw.z), bfhi(xw.z), bflo(xw.w), bfhi(xw.w)};
                const pg8::f32x4 n0 = x0 + gv0 * c0, n1 = x1 + gv1 * c1;
                ss[i] += ((n0[0] * n0[0] + n0[1] * n0[1]) + (n0[2] * n0[2] + n0[3] * n0[3])) + ((n1[0] * n1[0] + n1[1] * n1[1]) + (n1[2] * n1[2] + n1[3] * n1[3]));
                pg8::u32x4 w; w.x = pg8::cvt_pk_bf16(n0[0], n0[1]); w.y = pg8::cvt_pk_bf16(n0[2], n0[3]); w.z = pg8::cvt_pk_bf16(n1[0], n1[1]); w.w = pg8::cvt_pk_bf16(n1[2], n1[3]);
                *(pg8::u32x4*)(X + off) = w;
                const pg8::f32x4 a0 = n0 * gc0, a1 = n1 * gc1;
                pg8::u32x4 v; v.x = pg8::cvt_pk_bf16(a0[0], a0[1]); v.y = pg8::cvt_pk_bf16(a0[2], a0[3]); v.z = pg8::cvt_pk_bf16(a1[0], a1[1]); v.w = pg8::cvt_pk_bf16(a1[2], a1[3]);
                *(pg8::u32x4*)(XA + off) = v;
            }
        }
#pragma unroll
        for (int i = 0; i < 5; ++i) { float s = ss[i]; s += xlane<16>(s); s = sum_x32(s);
            if (fq == 0) part[wc * 160 + (i < 4 ? wr * 64 + i * 16 + fr : 128 + wr * 16 + fr)] = s; }
        asm volatile("s_waitcnt lgkmcnt(0)" ::: "memory"); __builtin_amdgcn_s_barrier(); asm volatile("" ::: "memory");
        const int t = (wr * 4 + wc) * 64 + fq * 16 + fr;
        if (t < 160) SSQ[(size_t)(rowbase + t) * 4 + u.pn] = (part[t] + part[160 + t]) + (part[320 + t] + part[480 + t]);
    }
};
struct EpiStore {
    static constexpr bool PERM = true; static constexpr int KIND = 2;
    GAS unsigned char* ws; unsigned o_off; int ldc; int bias_off;
    __device__ __forceinline__ void prefetch_dma(const Unit& u, int wid, int lane, PG8_LAS unsigned char* ldsl, int par) const { if (bias_off >= 0) epi_prefetch_dma(ws, bias_off, u, wid, lane, ldsl, par); }
    __device__ __forceinline__ void prefetch_sync(const Unit&, int, PG8_LAS unsigned char*, int) const {}
    __device__ __forceinline__ void operator()(const pg8::f32x4 (&acc)[2][2][4][2], const Unit& u, int wr, int wc, int fr, int fq, PG8_LAS unsigned char* ldsl, int par) const {
        bf16* O = (bf16*)(GAS bf16*)(ws + o_off);
        const PG8_LAS float* bb = (const PG8_LAS float*)(ldsl + EP_B) + par * 256 + wc * 32 + 8 * fq;
        const int col0 = u.pn * 256 + wc * 32 + 8 * fq; const bool nrm = bias_off >= 0;
        pg8::f32x4 b[2][2];
#pragma unroll
        for (int bj = 0; bj < 2; ++bj)
#pragma unroll
            for (int n = 0; n < 2; ++n) { const pg8::f32x4 bv = *(const PG8_LAS pg8::f32x4*)(bb + bj * 128 + 4 * n); b[bj][n] = nrm ? bv : (pg8::f32x4){0.f, 0.f, 0.f, 0.f}; }
#pragma unroll
        for (int ai = 0; ai < 2; ++ai)
#pragma unroll
            for (int m = 0; m < 4; ++m) {
                const int rl = ai * 128 + wr * 64 + m * 16 + fr;
                const float rs0 = epi_row_rstd(ldsl, par, rl), rs = nrm ? rs0 : 1.0f;
                bf16* rowp = O + (size_t)(u.pm * 256 + rl) * ldc + col0;
#pragma unroll
                for (int bj = 0; bj < 2; ++bj) {
                    const pg8::f32x4 v0 = acc[ai][bj][m][0] * rs + b[bj][0], v1 = acc[ai][bj][m][1] * rs + b[bj][1];
                    pg8::u32x4 w; w.x = pg8::cvt_pk_bf16(v0[0], v0[1]); w.y = pg8::cvt_pk_bf16(v0[2], v0[3]); w.z = pg8::cvt_pk_bf16(v1[0], v1[1]); w.w = pg8::cvt_pk_bf16(v1[2], v1[3]);
                    *(pg8::u32x4*)(rowp + bj * 128) = w;
                }
            }
    }
};

struct Frame {
    unsigned char* lds;
    mutable int tid, lane; int wave, bid, G;
    __device__ __forceinline__ void relane() const { int ln; asm volatile("v_mbcnt_lo_u32_b32 %0, -1, 0\n\tv_mbcnt_hi_u32_b32 %0, -1, %0" : "=v"(ln)); lane = ln; tid = wave * 64 + ln; }
    CArgsP a;
    GAS unsigned char* ws;
};
#define WSP(type, off) ((type*)(GAS type*)(F.ws + (off)))
#define AIN(i) ((const float*)(const GAS float*)F.a->in[i])
#define AOUT ((float*)(GAS float*)F.a->out)

struct ConvD { const float* W; bf16* WT; const float* shift; float* bias_out; int N, ldt, k0, n0, dst; };
__device__ __forceinline__ void conv_load(const ConvD& d, int lane, f32x4 (&v)[8]) {
    const int n4 = (lane & 7) * 4; const bool ok4 = d.n0 + n4 < d.N;
#pragma unroll
    for (int i = 0; i < 8; ++i) { const int kk = 8 * i + (lane >> 3);
        v[i] = ok4 ? *(const f32x4*)(d.W + (size_t)(d.k0 + kk) * d.N + d.n0 + n4) : (f32x4){0.f, 0.f, 0.f, 0.f}; }
}
__device__ __forceinline__ void conv_proc(const ConvD& d, const f32x4 (&v)[8], float* scr, int lane) {
    const int n4 = (lane & 7) * 4;
#pragma unroll
    for (int i = 0; i < 8; ++i) { const int kk = 8 * i + (lane >> 3);
        scr[kk * 33 + n4] = v[i].x; scr[kk * 33 + n4 + 1] = v[i].y; scr[kk * 33 + n4 + 2] = v[i].z; scr[kk * 33 + n4 + 3] = v[i].w; }
    if (d.bias_out) {
#pragma unroll
        for (int m = 0; m < 3; ++m) scr[64 * 33 + m * 64 + lane] = d.shift[(size_t)m * NMODV + lane];
    }
    asm volatile("s_waitcnt lgkmcnt(0)" ::: "memory");
    const int c = lane & 7;
#pragma unroll
    for (int j = 0; j < 4; ++j) { const int nn = (lane >> 3) + 8 * j; const float* s = scr + (8 * c) * 33 + nn;
        v4u o; o.x = pk2(s[0 * 33], s[1 * 33]); o.y = pk2(s[2 * 33], s[3 * 33]); o.z = pk2(s[4 * 33], s[5 * 33]); o.w = pk2(s[6 * 33], s[7 * 33]);
        *(v4u*)(d.WT + (size_t)(d.dst + nn) * d.ldt + d.k0 + 8 * c) = o; }
    if (d.bias_out) {
        const int kh = lane >> 5, nl = lane & 31; float a0 = 0.f, a1 = 0.f, a2 = 0.f;
#pragma unroll 8
        for (int i = 0; i < 32; ++i) { const int kk = kh * 32 + i; const float wv = scr[kk * 33 + nl];
            a0 += wv * scr[64 * 33 + kk]; a1 += wv * scr[64 * 33 + 64 + kk]; a2 += wv * scr[64 * 33 + 128 + kk]; }
        a0 = sum_x32(a0); a1 = sum_x32(a1); a2 = sum_x32(a2);
        if (lane < 32) { float* bo = d.bias_out + (size_t)(d.k0 >> 6) * BIAS_LD + d.dst + nl; bo[0] = a0; bo[BIAS_MS] = a1; bo[2 * BIAS_MS] = a2; }
    }
    asm volatile("s_waitcnt lgkmcnt(0)" ::: "memory");
}
constexpr int CI_DN = 44 * 32, CI_OE = 16 * 32, CI_UQ = 6 * 24, CI_KV = 4 * 32, CI_GU = 16 * 176, CI_IE = 16 * 88, CI_IO = 16 * 56;
__host__ __device__ constexpr int conv_na(int l) { return 2 * CI_DN + CI_OE + ((l & 1) ? CI_UQ + CI_KV : 0); }
__host__ __device__ constexpr int conv_nb(int l) { return 2 * CI_GU + ((l & 1) ? CI_IO : CI_IE); }
__device__ __forceinline__ ConvD conv_desc_a(const Frame& F, int l, int it) {
    int r = it; const int hi = l >> 1;
    if (r < 2 * CI_DN) { const int w = l * 2 + r / CI_DN, q = r % CI_DN, kb = q / 32, nb = q % 32;
        return ConvD{AIN(I_WDN) + (size_t)w * DFF * 1024, WSP(bf16, WS_WD + w * SZ_WD), nullptr, nullptr, 1024, DFF, kb * 64, nb * 32, nb * 32}; } r -= 2 * CI_DN;
    if (r < CI_OE) { const int kb = r / 32, nb = r % 32;
        if (l & 1) return ConvD{AIN(I_WOO) + (size_t)hi * 1024 * 1024, WSP(bf16, WS_WOO + hi * SZ_WO), nullptr, nullptr, 1024, 1024, kb * 64, nb * 32, nb * 32};
        return ConvD{AIN(I_WOE) + (size_t)hi * 1024 * 1024, WSP(bf16, WS_WOE + hi * SZ_WO), nullptr, nullptr, 1024, 1024, kb * 64, nb * 32, nb * 32}; } r -= CI_OE;
    if (r < CI_UQ) { const int kb = r / 24, nb = r % 24;
        return ConvD{AIN(I_WUQ) + (size_t)hi * 384 * 768, WSP(bf16, WS_WUQ + hi * SZ_WUQ), nullptr, nullptr, 768, 384, kb * 64, nb * 32, nb * 32}; } r -= CI_UQ;
    { const int kb = r / 32, nb = r % 32, n0 = nb * 32, h = n0 >> 7, rr = n0 & 127;
        const int dst = (rr < 64 ? 0 : 512) + h * 64 + (rr & 63);
        return ConvD{AIN(I_WUKV) + (size_t)hi * 256 * 1024, WSP(bf16, WS_WKV + hi * SZ_WKV), nullptr, nullptr, 1024, 256, kb * 64, n0, dst}; }
}
__device__ __forceinline__ ConvD conv_desc_b(const Frame& F, int l, int it) {
    int r = it; const int hi = l >> 1; const float* MOD = WSP(float, WS_MOD) + (size_t)l * 3 * NMODV; float* BIAS = WSP(float, WS_BIAS) + (size_t)(l * 3) * 3 * BIAS_MS;
    if (r < 2 * CI_GU) { const int f = r / CI_GU, w = l * 2 + f, q = r % CI_GU, kb = q / 176, nb = q % 176, n0 = nb * 32;
        const int dst = (n0 < DFF) ? ((n0 >> 7) * 256 + (n0 & 127)) : (((n0 - DFF) >> 7) * 256 + 128 + ((n0 - DFF) & 127));
        return ConvD{AIN(I_WGU) + (size_t)w * 1024 * 5632, WSP(bf16, WS_WGU + w * SZ_WGU), MOD + (f == 0 ? 0 : 6) * 1024 + kb * 64, BIAS + (size_t)(f == 0 ? 0 : 2) * 3 * BIAS_MS, 5632, 1024, kb * 64, n0, dst}; } r -= 2 * CI_GU;
    if (l & 1) { const int kb = r / 56, nb = r % 56;
        return ConvD{AIN(I_WIO) + (size_t)hi * 1024 * 1696, WSP(bf16, WS_WIO + hi * SZ_WIO), MOD + 3 * 1024 + kb * 64, BIAS + (size_t)3 * BIAS_MS, 1696, 1024, kb * 64, nb * 32, nb * 32}; }
    { const int kb = r / 88, nb = r % 88;
        return ConvD{AIN(I_WIE) + (size_t)hi * 1024 * 2576, WSP(bf16, WS_WIE + hi * SZ_WIE), MOD + 3 * 1024 + kb * 64, BIAS + (size_t)3 * BIAS_MS, 2576, 1024, kb * 64, nb * 32, nb * 32}; }
}
template <bool LB> __device__ __forceinline__ void conv_run(const Frame& F, int l, int lo, int hi, int gw, int NGW, float* scr) {
    int it = lo + gw; if (it >= hi) return;
    ConvD d = LB ? conv_desc_b(F, l, it) : conv_desc_a(F, l, it);
    f32x4 v[8]; conv_load(d, F.lane, v);
    for (;;) {
        const int itn = it + NGW; const bool more = itn < hi;
        ConvD dn = d; f32x4 vn[8];
        if (more) { dn = LB ? conv_desc_b(F, l, itn) : conv_desc_a(F, l, itn); conv_load(dn, F.lane, vn); }
        conv_proc(d, v, scr, F.lane);
        if (!more) break;
        d = dn; it = itn;
#pragma unroll
        for (int i = 0; i < 8; ++i) v[i] = vn[i];
    }
}
template <int N4> __device__ __forceinline__ void mod_tile(const Frame& F, int l, int tile) {
    constexpr int KG = 504 / N4, NC = 4 * N4, NTW = KG * N4;
    float* sv = (float*)F.lds;
    float* red = (float*)(F.lds + 12288);
    __syncthreads();
    for (int i = F.tid; i < 3072; i += NTHR) { const int r = i >> 10, k = i & 1023; const float c = (r == 0) ? AIN(I_CCTX)[k] : AIN(I_C)[(r - 1) * 1024 + k]; sv[i] = siluf_(c); }
    __syncthreads();
    const int n0 = tile * NC, n4 = F.tid % N4, kg = F.tid / N4;
    if (F.tid < NTW) {
        f32x4 a0 = {0.f, 0.f, 0.f, 0.f}, a1 = a0, a2 = a0;
        const float* wp = AIN(I_WMOD) + (size_t)l * 1024 * NMODV + n0 + 4 * n4;
#pragma unroll 8
        for (int k = kg; k < 1024; k += KG) { const f32x4 w = *(const f32x4*)(wp + (size_t)k * NMODV); a0 += w * sv[k]; a1 += w * sv[1024 + k]; a2 += w * sv[2048 + k]; }
        *(f32x4*)(red + (kg * 3 + 0) * NC + 4 * n4) = a0; *(f32x4*)(red + (kg * 3 + 1) * NC + 4 * n4) = a1; *(f32x4*)(red + (kg * 3 + 2) * NC + 4 * n4) = a2;
    }
    __syncthreads();
    for (int o = F.tid; o < 3 * NC; o += NTHR) { const int r = o / NC, n = o % NC; float s = AIN(I_BMOD)[l * NMODV + n0 + n];
        for (int g = 0; g < KG; ++g) s += red[(g * 3 + r) * NC + n];
        WSP(float, WS_MOD)[(size_t)(l * 3 + r) * NMODV + n0 + n] = s; }
    __syncthreads();
}
__device__ __forceinline__ void bias_reduce(const Frame& F, int l, int kmask, int bgi, int nbg) {
    const float* BP = WSP(float, WS_BIAS); float* BF = WSP(float, WS_BIASF);
    const int gt = bgi * NTHR + F.tid, NT = nbg * NTHR;
    for (int i = gt; i < 3 * 3 * (int)BIAS_LD; i += NT) { const int kind = i / (3 * (int)BIAS_LD), rem = i % (3 * (int)BIAS_LD), m = rem / (int)BIAS_LD, n = rem % (int)BIAS_LD;
        if (!((kmask >> kind) & 1)) continue;
        const float* p = BP + ((size_t)(l * 3 + kind) * 3 + m) * BIAS_MS + n; float b = 0.f;
#pragma unroll
        for (int kb = 0; kb < 16; ++kb) b += p[(size_t)kb * BIAS_LD];
        BF[((size_t)(l * 3 + kind) * 3 + m) * BIAS_LD + n] = b; }
}
__device__ __forceinline__ void background_work(const Frame& F, int l, int win, int bgi, int nbg) {
    F.relane();
    if (nbg <= 0) return;
    if (win == 0) bias_reduce(F, l, 6, bgi, nbg);
    if (l >= 3) return;
    const int ln = l + 1;
    float* scr = (float*)(F.lds + F.wave * 16384);
    const int gw = bgi * NWAVES + F.wave, NGW = nbg * NWAVES;
    if (win == 0) {
        for (int t = bgi; t < 144; t += nbg) mod_tile<16>(F, ln, t);
        conv_run<false>(F, ln, 0, conv_na(ln), gw, NGW, scr);
    } else {
        conv_run<true>(F, ln, 0, conv_nb(ln), gw, NGW, scr);
    }
}
__device__ __forceinline__ void p0_phase(const Frame& F) {
    F.relane();
    for (int t = F.bid; t < 256; t += F.G) mod_tile<9>(F, 0, t);
    {
        float* scr = (float*)(F.lds + F.wave * 16384);
        const int gw = F.bid * NWAVES + F.wave, NGW = F.G * NWAVES;
        conv_run<false>(F, 0, 0, conv_na(0), gw, NGW, scr);
    }
    {
        const size_t gt = (size_t)F.bid * NTHR + F.tid, NT = (size_t)F.G * NTHR;
        for (size_t i = gt; i < 1024 * 16; i += NT) { const int pos = (int)(i >> 4), ax = (int)(i >> 3) & 1, f = (int)i & 7;
            const float freq = exp2f(-(float)f * (13.287712379549449f / 8.0f));
            const float ang = (float)(ax == 0 ? (pos >> 6) : (pos & 63)) * freq;
            float sn, cs; sincosf(ang, &sn, &cs);
            WSP(float, WS_ROPE)[2 * i] = cs; WSP(float, WS_ROPE)[2 * i + 1] = sn; }
    }
}
__device__ __forceinline__ void p1_copy_phase(const Frame& F) {
    F.relane();
    float* scr = (float*)(F.lds + F.wave * 16384);
    const int gw = F.bid * NWAVES + F.wave, NGW = F.G * NWAVES;
    conv_run<true>(F, 0, 0, conv_nb(0), gw, NGW, scr);
}

__device__ __forceinline__ void norm0_phase(const Frame& F) {
    F.relane();
    const int gw = F.bid * NWAVES + F.wave, NGW = F.G * NWAVES;
    bf16* X = WSP(bf16, WS_X); bf16* XA = WSP(bf16, WS_XA); float* SSQ = WSP(float, WS_SSQ);
    const float* g = AIN(I_GNORM); const float* scale = WSP(float, WS_MOD) + 1024;
    for (int row = gw; row < T; row += NGW) {
        const int r = modrow_of_tok(row);
        const f32x4* xr = (const f32x4*)(row < TCTX ? AIN(I_XP) + (size_t)row * D : AIN(I_XS) + (size_t)(row - TCTX) * D) + F.lane;
        f32x4 v[4]; float s = 0.f;
#pragma unroll
        for (int j = 0; j < 4; ++j) { v[j] = xr[64 * j]; s += (v[j].x * v[j].x + v[j].y * v[j].y) + (v[j].z * v[j].z + v[j].w * v[j].w); }
        s = wave_sum(s);
        if (F.lane == 0) *(f32x4*)(SSQ + (size_t)row * 4) = (f32x4){s, 0.f, 0.f, 0.f};
        unsigned long long* o8 = (unsigned long long*)(XA + (size_t)row * D) + F.lane;
        unsigned long long* xo = (unsigned long long*)(X + (size_t)row * D) + F.lane;
#pragma unroll
        for (int j = 0; j < 4; ++j) {
            const f32x4 gg = *((const f32x4*)g + F.lane + 64 * j), sc = *((const f32x4*)(scale + (size_t)r * NMODV) + F.lane + 64 * j);
            const f32x4 o = v[j] * gg * (sc + 1.0f);
            xo[64 * j] = (unsigned long long)pk2(v[j].x, v[j].y) | ((unsigned long long)pk2(v[j].z, v[j].w) << 32);
            o8[64 * j] = (unsigned long long)pk2(o.x, o.y) | ((unsigned long long)pk2(o.z, o.w) << 32);
        }
    }
}
__device__ __forceinline__ void final_phase(const Frame& F) {
    F.relane();
    const int gw = F.bid * NWAVES + F.wave, NGW = F.G * NWAVES;
    const bf16* X = WSP(bf16, WS_X); const float* g = AIN(I_GFIN); float* out = AOUT + OUT_Y;
    for (int row = gw; row < T; row += NGW) {
        const v2u* xr = (const v2u*)(X + (size_t)row * D) + F.lane;
        f32x4 v[4]; float s = 0.f;
#pragma unroll
        for (int j = 0; j < 4; ++j) { const v2u w = xr[64 * j]; v[j] = (f32x4){bflo(w.x), bfhi(w.x), bflo(w.y), bfhi(w.y)}; s += (v[j].x * v[j].x + v[j].y * v[j].y) + (v[j].z * v[j].z + v[j].w * v[j].w); }
        const float rstd = frsq(wave_sum(s) * (1.f / D) + EPS);
        f32x4* o = (f32x4*)(out + (size_t)row * D) + F.lane;
#pragma unroll
        for (int j = 0; j < 4; ++j) o[64 * j] = v[j] * rstd * *((const f32x4*)g + F.lane + 64 * j);
    }
}
constexpr int LDT = 136;
__device__ __forceinline__ bf16x8 ld_frag16(const unsigned char* p) { return *(const bf16x8*)p; }
__device__ __forceinline__ bf16x8 ld_frag8x2(const unsigned char* p0, const unsigned char* p1) {
    const v2u a = *(const v2u*)p0, b = *(const v2u*)p1; v4u v; v.x = a.x; v.y = a.y; v.z = b.x; v.w = b.y; return __builtin_bit_cast(bf16x8, v); }
#define MFMA16(a, b, c) __builtin_amdgcn_mfma_f32_16x16x32_bf16((a), (b), (c), 0, 0, 0)

__device__ __forceinline__ void chunk_info(int c, int& cfirst, int& clast, bool& is_ctx, int& sb) {
    if (c < 64) { cfirst = c & ~1; clast = cfirst + 1; is_ctx = true; sb = c >> 1; }
    else { cfirst = 64 + ((c - 64) & ~7); clast = cfirst + 7; is_ctx = false; sb = (c - 64) >> 3; }
}
struct ConvW { f32x4 w0a, w0b, w1a, w1b, w2a, w2b, ba, bb; };
__device__ __forceinline__ ConvW conv_w(const float* wc, const float* bc, int ch) {
    ConvW W; W.w0a = *(const f32x4*)(wc + ch); W.w0b = *(const f32x4*)(wc + ch + 4); W.w1a = *(const f32x4*)(wc + 1024 + ch); W.w1b = *(const f32x4*)(wc + 1024 + ch + 4);
    W.w2a = *(const f32x4*)(wc + 2048 + ch); W.w2b = *(const f32x4*)(wc + 2048 + ch + 4); W.ba = *(const f32x4*)(bc + ch); W.bb = *(const f32x4*)(bc + ch + 4); return W;
}
__device__ __forceinline__ void conv8(const bf16* PROJ, int t, bool has_prev, bool has_next, int ch, const ConvW& W, float* out) {
    const bf16* p = PROJ + (size_t)t * EVEN_NP + 1536 + ch;
    const v4u z = {0u, 0u, 0u, 0u};
    const v4u c0 = *(const v4u*)p, cm = has_prev ? *(const v4u*)(p - EVEN_NP) : z, cp = has_next ? *(const v4u*)(p + EVEN_NP) : z;
    float x0[8], xm[8], xp[8]; unpack8(c0, x0); unpack8(cm, xm); unpack8(cp, xp);
#pragma unroll
    for (int i = 0; i < 4; ++i) { out[i] = siluf_(W.ba[i] + W.w0a[i] * xm[i] + W.w1a[i] * x0[i] + W.w2a[i] * xp[i]); out[4 + i] = siluf_(W.bb[i] + W.w0b[i] * xm[4 + i] + W.w1b[i] * x0[4 + i] + W.w2b[i] * xp[4 + i]); }
}
__device__ __forceinline__ void ssd_tables(const Frame& F, int ei, int t0, float* dtl, float* cml) {
    const bf16* PROJ = WSP(bf16, WS_PROJ);
    if (F.tid < 256) { const int j = F.tid >> 1, dir = F.tid & 1;
        const v4u raw = *(const v4u*)(PROJ + (size_t)(t0 + j) * EVEN_NP + 2560 + 8 * dir); float x[8]; unpack8(raw, x);
#pragma unroll
        for (int h = 0; h < 8; ++h) dtl[(dir * 8 + h) * 128 + j] = softplusf_(x[h] + AIN(I_DTB)[ei * 16 + dir * 8 + h]); }
    __syncthreads();
#pragma unroll
    for (int k = 0; k < 2; ++k) {
        const int row = 2 * F.wave + k, rev = row >> 3;
        const float a = -__expf(AIN(I_ALOG)[ei * 16 + row]);
        const int i0 = rev ? 127 - 2 * F.lane : 2 * F.lane, i1 = rev ? 126 - 2 * F.lane : 2 * F.lane + 1;
        const float v0 = dtl[row * 128 + i0] * a, v1 = dtl[row * 128 + i1] * a;
        float x = v0 + v1;
#pragma unroll
        for (int d = 1; d < 64; d <<= 1) { const float t = __builtin_bit_cast(float, __builtin_amdgcn_ds_bpermute((F.lane - d) * 4, __builtin_bit_cast(int, x))); x += (F.lane >= d) ? t : 0.f; }
        const float ex = x - (v0 + v1);
        cml[row * 128 + i0] = ex + v0; cml[row * 128 + i1] = ex + (v0 + v1);
    }
    __syncthreads();
}
constexpr int TILE128 = 34816, TILE64 = 17408;
constexpr int S1_BT = 0, S1_B = TILE128, S1_C = 2 * TILE128, S1_XT = TILE128  , S1_DT = 3 * TILE128, S1_CUM = S1_DT + 8192;
constexpr int S2_XT = 0  , S2_H = 2 * TILE64  , S2_DT = 6 * TILE64, S2_CUM = S2_DT + 8192, S2_SSQ = S2_CUM + 8192;

__device__ __forceinline__ void ssd_state_item(const Frame& F, int ei, int c, int g) {
    F.relane();
    const bf16* PROJ = WSP(bf16, WS_PROJ);
    const float* wc = AIN(I_WCS) + (size_t)ei * 3 * 1024; const float* bc = AIN(I_BCS) + (size_t)ei * 1024;
    int cfirst, clast, sb; bool is_ctx; chunk_info(c, cfirst, clast, is_ctx, sb);
    const int t0 = c * 128, len = is_ctx ? 256 : 1024, pos0 = (c - cfirst) * 128;
    bf16* BT = (bf16*)(F.lds + S1_BT); bf16* Bl = (bf16*)(F.lds + S1_B); bf16* Cl = (bf16*)(F.lds + S1_C); bf16* XT4 = (bf16*)(F.lds + S1_XT);
    float* dtl = (float*)(F.lds + S1_DT); float* cml = (float*)(F.lds + S1_CUM);
    bf16* ST = WSP(bf16, WS_ST); float* DEC = WSP(float, WS_DEC);
    bf16* CC = WSP(bf16, WS_CC); bf16* CBM = WSP(bf16, WS_CBM); bf16* XCT = WSP(bf16, WS_XCT);
    const int r = F.lane & 15, q = F.lane >> 4, w = F.wave;
    __syncthreads();
    ssd_tables(F, ei, t0, dtl, cml);
    { const ConvW W = conv_w(wc, bc, 512 + g * 128 + (F.tid & 15) * 8);
#pragma unroll 4
    for (int e = F.tid; e < 128 * 16; e += NTHR) { const int j = e >> 4, n8 = (e & 15) * 8; float o[8];
        conv8(PROJ, t0 + j, pos0 + j > 0, pos0 + j < len - 1, 512 + g * 128 + n8, W, o);
        const v4u pk = pack8(o);
        *(v4u*)((unsigned char*)Bl + (j * LDT + n8) * 2) = pk;
#pragma unroll
        for (int i = 0; i < 8; ++i) BT[(n8 + i) * LDT + j] = (bf16)f2bf1(o[i]); } }
    { const ConvW W = conv_w(wc, bc, 768 + g * 128 + (F.tid & 15) * 8);
#pragma unroll 4
    for (int e = F.tid; e < 128 * 16; e += NTHR) { const int j = e >> 4, n8 = (e & 15) * 8; float o[8];
        conv8(PROJ, t0 + j, pos0 + j > 0, pos0 + j < len - 1, 768 + g * 128 + n8, W, o);
        const v4u pk = pack8(o);
        *(v4u*)((unsigned char*)Cl + (j * LDT + n8) * 2) = pk;
        *(v4u*)(CC + (size_t)(t0 + j) * 256 + g * 128 + n8) = pk; } }
    __syncthreads();
    {
        bf16x8 cf[4];
#pragma unroll
        for (int ks = 0; ks < 4; ++ks) cf[ks] = ld_frag16((const unsigned char*)Cl + ((16 * w + r) * LDT + 32 * ks + 8 * q) * 2);
        bf16* dst = CBM + ((size_t)(c * 2 + g) * 128 + 16 * w + r) * 128 + 4 * q;
#pragma unroll
        for (int jt = 0; jt < 8; ++jt) { f32x4 a = {0.f, 0.f, 0.f, 0.f};
#pragma unroll
            for (int ks = 0; ks < 4; ++ks) a = MFMA16(ld_frag16((const unsigned char*)Bl + ((16 * jt + r) * LDT + 32 * ks + 8 * q) * 2), cf[ks], a);
            v2u o; o.x = pk2(a[0], a[1]); o.y = pk2(a[2], a[3]); *(v2u*)(dst + 16 * jt) = o; }
    }
    __syncthreads();
    { const ConvW W = conv_w(wc, bc, g * 256 + (F.tid & 31) * 8);
#pragma unroll 4
    for (int e = F.tid; e < 128 * 32; e += NTHR) { const int j = e >> 5, p8 = (e & 31) * 8; float o[8];
        conv8(PROJ, t0 + j, pos0 + j > 0, pos0 + j < len - 1, g * 256 + p8, W, o);
#pragma unroll
        for (int i = 0; i < 8; ++i) XT4[(p8 + i) * LDT + j] = (bf16)f2bf1(o[i]); } }
    __syncthreads();
#pragma unroll 4
    for (int e = F.tid; e < 256 * 16; e += NTHR) { const int row = e >> 4, ch = (e & 15) * 8;
        *(v4u*)(XCT + ((size_t)(c * 8 + 4 * g) * 64 + row) * 128 + ch) = *(const v4u*)((const unsigned char*)XT4 + (row * LDT + ch) * 2); }
#pragma unroll 2
    for (int hd = 0; hd < 8; ++hd) {
        const int hh = hd >> 1, dir = hd & 1, h = 4 * g + hh;
        const float* dth = dtl + (dir * 8 + h) * 128; const float* cmh = cml + (dir * 8 + h) * 128;
        const float cend = dir == 0 ? cmh[127] : cmh[0];
        const bf16* XT = XT4 + hh * 64 * LDT;
        f32x4 acc[4];
#pragma unroll
        for (int pt = 0; pt < 4; ++pt) acc[pt] = (f32x4){0.f, 0.f, 0.f, 0.f};
#pragma unroll
        for (int ks = 0; ks < 4; ++ks) {
            const int j0 = 32 * ks + 8 * q;
            const v4u braw = *(const v4u*)((const unsigned char*)BT + ((16 * w + r) * LDT + j0) * 2); float bv[8]; unpack8(braw, bv);
            const f32x4 d0 = *(const f32x4*)(dth + j0), d1 = *(const f32x4*)(dth + j0 + 4), c0 = *(const f32x4*)(cmh + j0), c1 = *(const f32x4*)(cmh + j0 + 4);
#pragma unroll
            for (int i = 0; i < 4; ++i) { bv[i] *= d0[i] * __expf(cend - c0[i]); bv[4 + i] *= d1[i] * __expf(cend - c1[i]); }
            const bf16x8 af = __builtin_bit_cast(bf16x8, pack8(bv));
#pragma unroll
            for (int pt = 0; pt < 4; ++pt) { const bf16x8 bf = ld_frag16((const unsigned char*)XT + ((16 * pt + r) * LDT + j0) * 2); acc[pt] = MFMA16(af, bf, acc[pt]); }
        }
        bf16* dst = ST + ((size_t)(c * 8 + h) * 2 + dir) * 8192;
#pragma unroll
        for (int pt = 0; pt < 4; ++pt) { v2u o; o.x = pk2(acc[pt][0], acc[pt][1]); o.y = pk2(acc[pt][2], acc[pt][3]); *(v2u*)(dst + (16 * pt + r) * 128 + 16 * w + 4 * q) = o; }
        if (F.tid == 0) DEC[(c * 8 + h) * 2 + dir] = __expf(cend);
    }
}

__device__ __forceinline__ void gmlp_item(const Frame& F, int ei, int c, int g) {
    F.relane();
    const bf16* PROJ = WSP(bf16, WS_PROJ); bf16* YMIX = WSP(bf16, WS_YMIX);
    const int t0 = c * 128;
    float* rs = (float*)F.lds; bf16* Vt = (bf16*)(F.lds + 1024); bf16* Wl = (bf16*)(F.lds + 1024 + 34816);
    const float* gv = AIN(I_GV) + ei * 512;
    __syncthreads();
#pragma unroll 1
    for (int kb = 0; kb < 16; kb += 8) {
        v4u raw[8];
#pragma unroll
        for (int k = 0; k < 8; ++k) raw[k] = *(const v4u*)(PROJ + (size_t)(t0 + F.wave * 16 + kb + k) * EVEN_NP + 512 + 8 * F.lane);
#pragma unroll
        for (int k = 0; k < 8; ++k) { float x[8]; unpack8(raw[k], x); float s = 0.f;
#pragma unroll
            for (int i = 0; i < 8; ++i) { const float y = gelu_tanh(x[i]); s += y * y; }
            s = wave_sum(s); if (F.lane == 0) rs[F.wave * 16 + kb + k] = frsq(s * (1.f / 512.f) + EPS); }
    }
    { const float* ws_ = AIN(I_WSP) + ((size_t)ei * 4 + g) * 16384;
#pragma unroll
      for (int e = F.tid; e < 4096; e += NTHR) { const int i = e >> 5, j4 = (e & 31) * 4; const f32x4 v = *(const f32x4*)(ws_ + i * 128 + j4);
          v2u o; o.x = pk2(v.x, v.y); o.y = pk2(v.z, v.w); *(v2u*)((unsigned char*)Wl + (i * LDT + j4) * 2) = o; } }
    __syncthreads();
    { const int d8 = (F.tid & 15) * 8; v4u raw[4];
#pragma unroll
      for (int k = 0; k < 4; ++k) raw[k] = *(const v4u*)(PROJ + (size_t)(t0 + (F.tid >> 4) + 32 * k) * EVEN_NP + 512 + g * 128 + d8);
#pragma unroll
      for (int k = 0; k < 4; ++k) { const int j = (F.tid >> 4) + 32 * k; float x[8]; unpack8(raw[k], x); const float rj = rs[j];
#pragma unroll
          for (int i = 0; i < 8; ++i) Vt[(d8 + i) * LDT + j] = (bf16)f2bf1(gelu_tanh(x[i]) * rj * gv[g * 128 + d8 + i]); } }
    __syncthreads();
    const int r = F.lane & 15, q = F.lane >> 4, w = F.wave;
    bf16x8 af[4];
#pragma unroll
    for (int ks = 0; ks < 4; ++ks) af[ks] = ld_frag16((const unsigned char*)Vt + ((16 * w + r) * LDT + 32 * ks + 8 * q) * 2);
    const float* bs = AIN(I_BSP) + ((size_t)ei * 4 + g) * 128;
    v2u uraw[8];
#pragma unroll
    for (int it = 0; it < 8; ++it) uraw[it] = *(const v2u*)(PROJ + (size_t)(t0 + 16 * it + r) * EVEN_NP + g * 128 + 16 * w + 4 * q);
#pragma unroll
    for (int it = 0; it < 8; ++it) {
        f32x4 acc = {0.f, 0.f, 0.f, 0.f};
#pragma unroll
        for (int ks = 0; ks < 4; ++ks) acc = MFMA16(af[ks], ld_frag16((const unsigned char*)Wl + ((16 * it + r) * LDT + 32 * ks + 8 * q) * 2), acc);
        const int i = 16 * it + r, col = g * 128 + 16 * w + 4 * q; const float b = bs[i];
        const float u0 = gelu_tanh(bflo(uraw[it].x)), u1 = gelu_tanh(bfhi(uraw[it].x)), u2 = gelu_tanh(bflo(uraw[it].y)), u3 = gelu_tanh(bfhi(uraw[it].y));
        v2u o; o.x = pk2(u0 * (acc[0] + b), u1 * (acc[1] + b)); o.y = pk2(u2 * (acc[2] + b), u3 * (acc[3] + b));
        *(v2u*)(YMIX + (size_t)(t0 + i) * D + col) = o;
    }
}

__device__ __forceinline__ f32x4 ld_bf4(const bf16* p) { const v2u w = *(const v2u*)p; return (f32x4){bflo(w.x), bfhi(w.x), bflo(w.y), bfhi(w.y)}; }
__device__ __forceinline__ void ssd_scan_phase(const Frame& F, int ei) {
    F.relane();
    const bf16* ST = WSP(bf16, WS_ST); const float* DEC = WSP(float, WS_DEC); bf16* HIN = WSP(bf16, WS_HIN);
    const size_t gt = (size_t)F.bid * NTHR + F.tid, NT = (size_t)F.G * NTHR;
    constexpr size_t N_SMP = (size_t)2 * 8 * 2 * 2048, N_CTX = (size_t)32 * 8 * 2 * 2048;
    for (size_t it = gt; it < N_SMP + N_CTX; it += NT) {
        if (it < N_SMP) {
            const int e = (int)(it & 2047) * 4, dir = (int)(it >> 11) & 1, h = (int)(it >> 12) & 7, b = (int)(it >> 15);
            const int c0 = 64 + 8 * b;
            f32x4 st[8]; float dc[8];
#pragma unroll
            for (int k = 0; k < 8; ++k) { const int cc = dir == 0 ? c0 + k : c0 + 7 - k; st[k] = ld_bf4(ST + ((size_t)(cc * 8 + h) * 2 + dir) * 8192 + e); dc[k] = DEC[(cc * 8 + h) * 2 + dir]; }
            f32x4 v = *(const f32x4*)(AIN(I_SSD) + ((size_t)((b * 2 + ei) * 2 + dir) * 8 + h) * 8192 + e);
#pragma unroll
            for (int k = 0; k < 8; ++k) { const int cc = dir == 0 ? c0 + k : c0 + 7 - k;
                v2u o; o.x = pk2(v.x, v.y); o.y = pk2(v.z, v.w); *(v2u*)(HIN + ((size_t)(cc * 8 + h) * 2 + dir) * 8192 + e) = o;
                v = v * dc[k] + st[k]; }
        } else {
            const size_t i2 = it - N_SMP;
            const int e = (int)(i2 & 2047) * 4, dir = (int)(i2 >> 11) & 1, h = (int)(i2 >> 12) & 7, s = (int)(i2 >> 15);
            const int ca = dir == 0 ? 2 * s : 2 * s + 1, cb = dir == 0 ? 2 * s + 1 : 2 * s;
            const f32x4 sa = ld_bf4(ST + ((size_t)(ca * 8 + h) * 2 + dir) * 8192 + e), sb_ = ld_bf4(ST + ((size_t)(cb * 8 + h) * 2 + dir) * 8192 + e);
            const float db = DEC[(cb * 8 + h) * 2 + dir];
            *(f32x4*)(AOUT + OUT_SSD + ((size_t)((s * 2 + ei) * 2 + dir) * 8 + h) * 8192 + e) = sa * db + sb_;
        }
    }
}

__device__ __forceinline__ void ssd_out_item(const Frame& F, int ei, int c, int th) {
    F.relane();
    const bf16* PROJ = WSP(bf16, WS_PROJ); bf16* YMIX = WSP(bf16, WS_YMIX);
    const bf16* CC = WSP(bf16, WS_CC); const bf16* CBM = WSP(bf16, WS_CBM); const bf16* XCT = WSP(bf16, WS_XCT); const bf16* HIN = WSP(bf16, WS_HIN); const bf16* ST = WSP(bf16, WS_ST);
    const int t0 = c * 128;
    float* dtl = (float*)(F.lds + S2_DT); float* cml = (float*)(F.lds + S2_CUM); float* ssqx = (float*)(F.lds + S2_SSQ);
    const int r = F.lane & 15, q = F.lane >> 4, w = F.wave, it = w & 3, g = w >> 2;
    const int irow = 64 * th + 16 * it + r;
    const bool hzero[2] = {c < 64 && (c & 1) == 0, c < 64 && (c & 1) == 1};
    __syncthreads();
    ssd_tables(F, ei, t0, dtl, cml);
    v2u cbp[8]; bf16x8 cf[4];
    {
        const bf16* cbr = CBM + ((size_t)(c * 2 + g) * 128 + irow) * 128 + 4 * q;
#pragma unroll
        for (int jt = 0; jt < 8; ++jt) cbp[jt] = *(const v2u*)(cbr + 16 * jt);
#pragma unroll
        for (int kn = 0; kn < 4; ++kn) cf[kn] = *(const bf16x8*)(CC + (size_t)(t0 + irow) * 256 + g * 128 + 32 * kn + 8 * q);
    }
    float ssq = 0.f;
    v4u pre[12];
    const int goff = (F.tid >> 4) * 128 + (F.tid & 15) * 8, loff = ((F.tid >> 4) * LDT + (F.tid & 15) * 8) * 2;
#define E2_SRC(m_, hh_) ((m_) < 2 ? XCT + (size_t)(c * 8 + 4 * (m_) + (hh_)) * 8192 : \
        (c < 64 ? ST + ((size_t)((((m_) - 2) & 1) == 0 ? c - 1 : c + 1) * 8 + 4 * (((m_) - 2) >> 1) + (hh_)) * 16384 + (((m_) - 2) & 1) * 8192 \
                : HIN + ((size_t)c * 8 + 4 * (((m_) - 2) >> 1) + (hh_)) * 16384 + (((m_) - 2) & 1) * 8192))
#define E2_FETCH(hh_) do { _Pragma("unroll") for (int m = 0; m < 6; ++m) { if (m >= 2 && hzero[(m - 2) & 1]) continue; const bf16* sp = E2_SRC(m, hh_) + goff; \
            pre[2 * m] = *(const v4u*)sp; pre[2 * m + 1] = *(const v4u*)(sp + 32 * 128); } } while (0)
    E2_FETCH(0);
#pragma unroll 1
    for (int hh = 0; hh < 4; ++hh) {
        __syncthreads();
#pragma unroll
        for (int m = 0; m < 6; ++m) { if (m >= 2 && hzero[(m - 2) & 1]) continue;
            unsigned char* dp = F.lds + (m < 2 ? S2_XT + m * TILE64 : S2_H + (m - 2) * TILE64) + loff;
            *(v4u*)dp = pre[2 * m]; *(v4u*)(dp + 32 * LDT * 2) = pre[2 * m + 1]; }
        __syncthreads();
        if (hh < 3) E2_FETCH(hh + 1);
        v2u zr4[4];
#pragma unroll
        for (int pt = 0; pt < 4; ++pt) zr4[pt] = *(const v2u*)(PROJ + (size_t)(t0 + irow) * EVEN_NP + 1024 + (4 * g + hh) * 64 + 16 * pt + 4 * q);
        const int h = 4 * g + hh;
        const bf16* XT = (const bf16*)(F.lds + S2_XT + g * TILE64);
        f32x4 yacc[4];
#pragma unroll
        for (int pt = 0; pt < 4; ++pt) yacc[pt] = (f32x4){0.f, 0.f, 0.f, 0.f};
        const float* dt0 = dtl + h * 128; const float* cm0 = cml + h * 128; const float* dt1 = dtl + (8 + h) * 128; const float* cm1 = cml + (8 + h) * 128;
        const float ci0 = cm0[irow], ci1 = cm1[irow];
#pragma unroll
        for (int ks = 0; ks < 4; ++ks) {
            float sl0[8], sl1[8];
#pragma unroll
            for (int hf = 0; hf < 2; ++hf) {
                const int j0 = 32 * ks + 16 * hf + 4 * q; const v2u cw = cbp[2 * ks + hf];
                const f32x4 c0v = *(const f32x4*)(cm0 + j0), d0v = *(const f32x4*)(dt0 + j0), c1v = *(const f32x4*)(cm1 + j0), d1v = *(const f32x4*)(dt1 + j0);
                const float cbv[4] = {bflo(cw.x), bfhi(cw.x), bflo(cw.y), bfhi(cw.y)};
#pragma unroll
                for (int e = 0; e < 4; ++e) { const int j = j0 + e;
                    const float e0 = __expf(ci0 - c0v[e]) * d0v[e] * cbv[e], e1 = __expf(ci1 - c1v[e]) * d1v[e] * cbv[e];
                    sl0[4 * hf + e] = (j <= irow) ? e0 : 0.f; sl1[4 * hf + e] = (j >= irow) ? e1 : 0.f; }
            }
            const bf16x8 sf0 = __builtin_bit_cast(bf16x8, pack8(sl0)), sf1 = __builtin_bit_cast(bf16x8, pack8(sl1));
#pragma unroll
            for (int pt = 0; pt < 4; ++pt) { const unsigned char* xr = (const unsigned char*)XT + ((16 * pt + r) * LDT + 32 * ks + 4 * q) * 2;
                const bf16x8 xf = ld_frag8x2(xr, xr + 32);
                yacc[pt] = MFMA16(xf, sf0, yacc[pt]); yacc[pt] = MFMA16(xf, sf1, yacc[pt]); }
        }
#pragma unroll
        for (int dir = 0; dir < 2; ++dir) {
            if (hzero[dir]) continue;
            const unsigned char* Hl = F.lds + S2_H + (g * 2 + dir) * TILE64;
            const float ei_ = __expf(dir == 0 ? ci0 : ci1);
#pragma unroll
            for (int pt = 0; pt < 4; ++pt) { f32x4 t = {0.f, 0.f, 0.f, 0.f};
#pragma unroll
                for (int kn = 0; kn < 4; ++kn) t = MFMA16(ld_frag16(Hl + ((16 * pt + r) * LDT + 32 * kn + 8 * q) * 2), cf[kn], t);
                yacc[pt] += t * ei_; }
        }
        const float dsk = AIN(I_DSK)[ei * 16 + h] + AIN(I_DSK)[ei * 16 + 8 + h];
#pragma unroll
        for (int pt = 0; pt < 4; ++pt) {
            const int p0 = 16 * pt + 4 * q;
            const v2u zr = zr4[pt];
            const float z0 = bflo(zr.x), z1 = bfhi(zr.x), z2 = bflo(zr.y), z3 = bfhi(zr.y);
            float y0 = yacc[pt][0] + dsk * bf1(XT[(p0 + 0) * LDT + irow]), y1 = yacc[pt][1] + dsk * bf1(XT[(p0 + 1) * LDT + irow]),
                  y2 = yacc[pt][2] + dsk * bf1(XT[(p0 + 2) * LDT + irow]), y3 = yacc[pt][3] + dsk * bf1(XT[(p0 + 3) * LDT + irow]);
            y0 *= siluf_(z0); y1 *= siluf_(z1); y2 *= siluf_(z2); y3 *= siluf_(z3);
            ssq += (y0 * y0 + y1 * y1) + (y2 * y2 + y3 * y3);
            v2u o; o.x = pk2(y0, y1); o.y = pk2(y2, y3);
            *(v2u*)(YMIX + (size_t)(t0 + irow) * D + 512 + h * 64 + p0) = o;
        }
    }
#undef E2_FETCH
#undef E2_SRC
    ssq += xlane<16>(ssq); ssq = sum_x32(ssq);
    if (q == 0) ssqx[w * 16 + r] = ssq;
    __syncthreads();
    ssq += ssqx[(w ^ 4) * 16 + r];
    const float rstd = frsq(ssq * (1.f / 512.f) + EPS);
    const float* go = AIN(I_GSO) + ei * 512;
#pragma unroll 1
    for (int hh = 0; hh < 4; ++hh)
#pragma unroll
        for (int pt = 0; pt < 4; ++pt) {
            const int col = (4 * g + hh) * 64 + 16 * pt + 4 * q;
            v2u* p = (v2u*)(YMIX + (size_t)(t0 + irow) * D + 512 + col); const v2u v = *p; const f32x4 gg = *(const f32x4*)(go + col);
            v2u o; o.x = pk2(bflo(v.x) * rstd * gg.x, bfhi(v.x) * rstd * gg.y); o.y = pk2(bflo(v.y) * rstd * gg.z, bfhi(v.y) * rstd * gg.w);
            *p = o;
        }
}

__device__ __forceinline__ void even_phase1(const Frame& F, int ei) {
    if (F.G >= 256) {
        if (F.bid < 160) ssd_state_item(F, ei, F.bid >> 1, F.bid & 1);
        else for (int it = F.bid - 160; it < 192; it += F.G - 160) gmlp_item(F, ei, it >> 2, it & 3);
        return;
    }
    for (int it = F.bid; it < 160 + 320; it += F.G) {
        if (it < 160) ssd_state_item(F, ei, it >> 1, it & 1);
        else gmlp_item(F, ei, (it - 160) >> 2, (it - 160) & 3);
    }
}
__device__ __forceinline__ void even_phase2(const Frame& F, int ei) {
    if (F.G >= 256) {
        if (F.bid < 160) ssd_out_item(F, ei, F.bid >> 1, F.bid & 1);
        else for (int it = 192 + F.bid - 160; it < 320; it += F.G - 160) gmlp_item(F, ei, it >> 2, it & 3);
        return;
    }
    for (int it = F.bid; it < 160; it += F.G) ssd_out_item(F, ei, it >> 1, it & 1);
}
constexpr int CV_T = 43, CV_W = CV_T + 30, CV_ITEMS = 32 * 6 + 2 * 24;
__device__ __forceinline__ void conv_item(const Frame& F, int oi, int item) {
    F.relane();
    const bf16* PROJ = WSP(bf16, WS_PROJ); bf16* YMIX = WSP(bf16, WS_YMIX);
    int sbeg, slen, tile; if (item < 192) { sbeg = (item / 6) * 256; slen = 256; tile = item % 6; } else { const int i2 = item - 192; sbeg = TCTX + (i2 / 24) * 1024; slen = 1024; tile = i2 % 24; }
    const int send = sbeg + slen, t0 = sbeg + tile * CV_T, nt = (slen - tile * CV_T) < CV_T ? (slen - tile * CV_T) : CV_T;
    float* Dl = (float*)F.lds;
    const int c = F.tid;
    float glu[CV_W];
#pragma unroll
    for (int w0 = 0; w0 < CV_W; w0 += 8) {
        bf16 av[8], gv[8];
#pragma unroll
        for (int i = 0; i < 8; ++i) if (w0 + i < CV_W) { int t = t0 - 15 + w0 + i; t = t < sbeg ? sbeg : (t >= send ? send - 1 : t);
            av[i] = PROJ[(size_t)t * ODD_NP + 672 + c]; gv[i] = PROJ[(size_t)t * ODD_NP + 1184 + c]; }
#pragma unroll
        for (int i = 0; i < 8; ++i) if (w0 + i < CV_W) { const int t = t0 - 15 + w0 + i; const float v = bf1(av[i]) * sigmoidf_(bf1(gv[i])); glu[w0 + i] = (t >= sbeg && t < send) ? v : 0.f; }
    }
    float wk[31];
#pragma unroll
    for (int k = 0; k < 31; ++k) wk[k] = AIN(I_WDW)[((size_t)oi * 31 + k) * 512 + c];
    const float bd = AIN(I_BDW)[oi * 512 + c];
    __syncthreads();
#pragma unroll
    for (int tt = 0; tt < CV_T; ++tt) { float s = bd;
#pragma unroll
        for (int k = 0; k < 31; ++k) s += wk[k] * glu[tt + k];
        Dl[tt * 512 + c] = s; }
    __syncthreads();
    const float* gl = AIN(I_GLN) + oi * 512; const float* bl = AIN(I_BLN) + oi * 512;
    const f32x4 g0 = *(const f32x4*)(gl + 8 * F.lane), g1 = *(const f32x4*)(gl + 8 * F.lane + 4), b0 = *(const f32x4*)(bl + 8 * F.lane), b1 = *(const f32x4*)(bl + 8 * F.lane + 4);
#pragma unroll 1
    for (int tt = F.wave; tt < nt; tt += NWAVES) {
        const f32x4 v0 = *(const f32x4*)(Dl + tt * 512 + 8 * F.lane), v1 = *(const f32x4*)(Dl + tt * 512 + 8 * F.lane + 4);
        float s = (v0.x + v0.y) + (v0.z + v0.w) + (v1.x + v1.y) + (v1.z + v1.w);
        const float mean = wave_sum(s) * (1.f / 512.f);
        const f32x4 d0 = v0 - mean, d1 = v1 - mean;
        float s2 = (d0.x * d0.x + d0.y * d0.y) + (d0.z * d0.z + d0.w * d0.w) + (d1.x * d1.x + d1.y * d1.y) + (d1.z * d1.z + d1.w * d1.w);
        const float rstd = frsq(wave_sum(s2) * (1.f / 512.f) + EPS);
        float o[8];
#pragma unroll
        for (int i = 0; i < 4; ++i) { o[i] = siluf_(d0[i] * rstd * g0[i] + b0[i]); o[4 + i] = siluf_(d1[i] * rstd * g1[i] + b1[i]); }
        *(v4u*)(YMIX + (size_t)(t0 + tt) * D + 512 + 8 * F.lane) = pack8(o);
    }
}
__device__ __forceinline__ void odd_rows(const Frame& F, int oi) {
    F.relane();
    const bf16* PROJ = WSP(bf16, WS_PROJ);
    bf16* QA = WSP(bf16, WS_QA); bf16* CKVA = WSP(bf16, WS_CKVA); bf16* KR = WSP(bf16, WS_KR); const float* ROPE = WSP(float, WS_ROPE);
    const int gw = F.bid * NWAVES + F.wave, NGW = F.G * NWAVES, lane = F.lane;
    for (int row = T + gw; row < TP; row += NGW) {
        const int b = (row - T) >> 8, j = (row - T) & 255;
        const f32x4 v = *(const f32x4*)(AIN(I_CCKV) + ((size_t)(b * 2 + oi) * 256 + j) * 256 + 4 * lane);
        v2u o; o.x = pk2(v.x, v.y); o.y = pk2(v.z, v.w); *(v2u*)(CKVA + (size_t)row * 256 + 4 * lane) = o;
        if (lane < 32) KR[(size_t)row * 32 + lane] = (bf16)f2bf1(AIN(I_CKR)[((size_t)(b * 2 + oi) * 256 + j) * 32 + lane]);
    }
    const f32x4 gkv = *(const f32x4*)(AIN(I_GCKV) + oi * 256 + 4 * lane);
    float gq[6];
#pragma unroll
    for (int k = 0; k < 3; ++k) { gq[2 * k] = AIN(I_GCQ)[oi * 384 + 128 * k + 2 * lane]; gq[2 * k + 1] = AIN(I_GCQ)[oi * 384 + 128 * k + 2 * lane + 1]; }
    unsigned qw[3], nqw[3]; v2u kw, nkw; bf16 krw, nkrw;
    int row = gw;
    if (row < T) { const bf16* pr = PROJ + (size_t)row * ODD_NP;
#pragma unroll
        for (int k = 0; k < 3; ++k) nqw[k] = *(const unsigned*)(pr + 128 * k + 2 * lane);
        nkw = *(const v2u*)(pr + 384 + 4 * lane); nkrw = pr[640 + (lane & 31)]; }
#pragma unroll 1
    for (; row < T; row += NGW) {
#pragma unroll
        for (int k = 0; k < 3; ++k) qw[k] = nqw[k];
        kw = nkw; krw = nkrw;
        if (row + NGW < T) { const bf16* pr = PROJ + (size_t)(row + NGW) * ODD_NP;
#pragma unroll
            for (int k = 0; k < 3; ++k) nqw[k] = *(const unsigned*)(pr + 128 * k + 2 * lane);
            nkw = *(const v2u*)(pr + 384 + 4 * lane); nkrw = pr[640 + (lane & 31)]; }
        float qv[6]; float s = 0.f;
#pragma unroll
        for (int k = 0; k < 3; ++k) { qv[2 * k] = bflo(qw[k]); qv[2 * k + 1] = bfhi(qw[k]); s += qv[2 * k] * qv[2 * k] + qv[2 * k + 1] * qv[2 * k + 1]; }
        f32x4 kv = {bflo(kw.x), bfhi(kw.x), bflo(kw.y), bfhi(kw.y)};
        float s2 = (kv.x * kv.x + kv.y * kv.y) + (kv.z * kv.z + kv.w * kv.w);
        s += xlane<1>(s); s2 += xlane<1>(s2); s += xlane<2>(s); s2 += xlane<2>(s2); s += xlane<4>(s); s2 += xlane<4>(s2); s += xlane<8>(s); s2 += xlane<8>(s2); s += xlane<16>(s); s2 += xlane<16>(s2);
        s = sum_x32(s); s2 = sum_x32(s2);
        const float rq = frsq(s * (1.f / 384.f) + EPS), rk = frsq(s2 * (1.f / 256.f) + EPS);
#pragma unroll
        for (int k = 0; k < 3; ++k) *(unsigned*)(QA + (size_t)row * 384 + 128 * k + 2 * lane) = pk2(qv[2 * k] * rq * gq[2 * k], qv[2 * k + 1] * rq * gq[2 * k + 1]);
        kv = kv * rk * gkv;
        { v2u o; o.x = pk2(kv.x, kv.y); o.y = pk2(kv.z, kv.w); *(v2u*)(CKVA + (size_t)row * 256 + 4 * lane) = o; }
        float kr = bf1(krw);
        if (row < TCTX) {
            const int b = row >> 8, pos = row & 255;
            *(f32x4*)(AOUT + OUT_CKV + ((size_t)(b * 2 + oi) * 256 + pos) * 256 + 4 * lane) = kv;
            if (lane < 32) AOUT[OUT_KR + ((size_t)(b * 2 + oi) * 256 + pos) * 32 + lane] = kr;
        } else {
            const int pos = (row - TCTX) & 1023, e = lane & 31, ax = e >> 4, half = (e >> 3) & 1, f = e & 7;
            const float other = xlane<8>(kr);
            const float cs = ROPE[((pos * 2 + ax) * 8 + f) * 2], sn = ROPE[((pos * 2 + ax) * 8 + f) * 2 + 1];
            kr = half == 0 ? (kr * cs - other * sn) : (other * sn + kr * cs);
        }
        if (lane < 32) KR[(size_t)row * 32 + lane] = (bf16)f2bf1(kr);
    }
}
__device__ __forceinline__ void odd_phase1(const Frame& F, int oi) {
    for (int it = F.bid; it < CV_ITEMS; it += F.G) conv_item(F, oi, it);
    odd_rows(F, oi);
}

constexpr int AT_KROW = 208, AT_VROW = 272, AT_KBYTES = 128 * AT_KROW, AT_BUF = 45056;
struct AttnPre { v4u k[3]; v4u v[2]; };
__device__ __forceinline__ void attn_load_tile(const Frame& F, int h, int krow0, AttnPre& P) {
    const bf16* KN = WSP(bf16, WS_KN); const bf16* KR = WSP(bf16, WS_KR); const bf16* VT = WSP(bf16, WS_VT);
#pragma unroll
    for (int i = 0; i < 3; ++i) { const int e = F.tid + NTHR * i, key = e / 12, c = e % 12; const size_t kr = (size_t)(krow0 + key);
        P.k[i] = c < 8 ? *(const v4u*)(KN + kr * 512 + h * 64 + c * 8) : *(const v4u*)(KR + kr * 32 + (c - 8) * 8); }
#pragma unroll
    for (int i = 0; i < 2; ++i) { const int e = F.tid + NTHR * i, row = e >> 4, c = e & 15;
        P.v[i] = *(const v4u*)(VT + (size_t)(h * 64 + row) * TP + krow0 + c * 8); }
}
__device__ __forceinline__ void attn_store_tile(const Frame& F, unsigned char* buf, const AttnPre& P) {
#pragma unroll
    for (int i = 0; i < 3; ++i) { const int e = F.tid + NTHR * i, key = e / 12, c = e % 12; *(v4u*)(buf + key * AT_KROW + c * 16) = P.k[i]; }
#pragma unroll
    for (int i = 0; i < 2; ++i) { const int e = F.tid + NTHR * i, row = e >> 4, c = e & 15; *(v4u*)(buf + AT_KBYTES + row * AT_VROW + c * 16) = P.v[i]; }
}
__device__ __forceinline__ int attn_tile_row(bool is_smp, int sb, int i) {
    if (!is_smp) return sb * 256 + 128 * i;
    return i < 2 ? T + sb * 256 + 128 * i : TCTX + sb * 1024 + 128 * (i - 2);
}
__device__ __forceinline__ void attn_item(const Frame& F, int q0, int h, bool is_smp, int spos0, int sb) {
    F.relane();
    const bf16* Q = WSP(bf16, WS_Q); bf16* YMIX = WSP(bf16, WS_YMIX); const float* ROPE = WSP(float, WS_ROPE);
    const int r = F.lane & 15, g = F.lane >> 4, w = F.wave;
    const int tq = q0 + 16 * w + r;
    const int ntile = is_smp ? 10 : 2;
    AttnPre P;
    attn_load_tile(F, h, attn_tile_row(is_smp, sb, 0), P);
    bf16x8 qf[3];
#pragma unroll
    for (int ks = 0; ks < 3; ++ks) qf[ks] = *(const bf16x8*)(Q + (size_t)tq * 768 + h * 96 + 32 * ks + 8 * g);
    if (is_smp) {
        float x[8], o[8]; unpack8(__builtin_bit_cast(v4u, qf[2]), x);
        const int pos = spos0 + 16 * w + r, ax = g >> 1, half = g & 1;
        const float* rp = ROPE + ((size_t)(pos * 2 + ax) * 8) * 2;
#pragma unroll
        for (int j = 0; j < 8; ++j) { const float other = xlane<16>(x[j]); const float cs = rp[2 * j], sn = rp[2 * j + 1];
            o[j] = half == 0 ? (x[j] * cs - other * sn) : (other * sn + x[j] * cs); }
        qf[2] = __builtin_bit_cast(bf16x8, pack8(o));
    }
    const float csc = 0.10206207261596577f * 1.4426950408889634f;
    float m = -1e30f, l = 0.f;
    f32x4 oacc[4];
#pragma unroll
    for (int dt = 0; dt < 4; ++dt) oacc[dt] = (f32x4){0.f, 0.f, 0.f, 0.f};
    __syncthreads();
    attn_store_tile(F, F.lds, P);
    AttnPre P2;
    if (ntile > 1) attn_load_tile(F, h, attn_tile_row(is_smp, sb, 1), P);
    __syncthreads();
#define ATTN_COMPUTE(buf) do { \
        f32x4 sacc[8]; \
        _Pragma("unroll") \
        for (int st = 0; st < 8; ++st) { \
            const unsigned char* kp = buf + (16 * st + r) * AT_KROW + 16 * g; \
            f32x4 a = {0.f, 0.f, 0.f, 0.f}; \
            a = MFMA16(ld_frag16(kp), qf[0], a); a = MFMA16(ld_frag16(kp + 64), qf[1], a); a = MFMA16(ld_frag16(kp + 128), qf[2], a); \
            sacc[st] = a; \
        } \
        float mx = -1e30f; \
        _Pragma("unroll") \
        for (int st = 0; st < 8; ++st) mx = fmaxf(fmaxf(fmaxf(sacc[st][0], sacc[st][1]), fmaxf(sacc[st][2], sacc[st][3])), mx); \
        mx = fmaxf(mx, xlane<16>(mx)); mx = max_x32(mx); \
        const float mn = fmaxf(m, mx), alpha = __builtin_amdgcn_exp2f((m - mn) * csc); m = mn; \
        float ps = 0.f; float p[32]; \
        _Pragma("unroll") \
        for (int st = 0; st < 8; ++st) \
            _Pragma("unroll") \
            for (int j = 0; j < 4; ++j) { const float e = __builtin_amdgcn_exp2f((sacc[st][j] - mn) * csc); p[4 * st + j] = e; ps += e; } \
        l = l * alpha + ps; \
        _Pragma("unroll") \
        for (int dt = 0; dt < 4; ++dt) oacc[dt] *= alpha; \
        _Pragma("unroll") \
        for (int ks2 = 0; ks2 < 4; ++ks2) { \
            const bf16x8 pf = __builtin_bit_cast(bf16x8, pack8(p + 8 * ks2)); \
            _Pragma("unroll") \
            for (int dt = 0; dt < 4; ++dt) { \
                const unsigned char* vp = buf + AT_KBYTES + (16 * dt + r) * AT_VROW + (32 * ks2 + 4 * g) * 2; \
                oacc[dt] = MFMA16(ld_frag8x2(vp, vp + 32), pf, oacc[dt]); \
            } \
        } } while (0)
#pragma unroll 1
    for (int ti = 0; ti < ntile; ti += 2) {
        if (ti + 2 < ntile) attn_load_tile(F, h, attn_tile_row(is_smp, sb, ti + 2), P2);
        { const unsigned char* buf = F.lds; ATTN_COMPUTE(buf); }
        if (ti + 1 < ntile) attn_store_tile(F, F.lds + AT_BUF, P);
        __syncthreads();
        if (ti + 1 >= ntile) break;
        if (ti + 3 < ntile) attn_load_tile(F, h, attn_tile_row(is_smp, sb, ti + 3), P);
        { const unsigned char* buf = F.lds + AT_BUF; ATTN_COMPUTE(buf); }
        if (ti + 2 < ntile) attn_store_tile(F, F.lds, P2);
        __syncthreads();
    }
#undef ATTN_COMPUTE
    l += xlane<16>(l); l = sum_x32(l);
    const float inv = 1.0f / l;
#pragma unroll
    for (int dt = 0; dt < 4; ++dt) { v2u o; o.x = pk2(oacc[dt][0] * inv, oacc[dt][1] * inv); o.y = pk2(oacc[dt][2] * inv, oacc[dt][3] * inv);
        *(v2u*)(YMIX + (size_t)tq * D + h * 64 + 16 * dt + 4 * g) = o; }
}
__device__ __forceinline__ void odd_phase3(const Frame& F) {
    if (F.G >= 256) {
        if (F.bid < 128) {
            const int bh = F.bid & 15, qt = F.bid >> 4, b = bh >> 3, h = bh & 7;
            attn_item(F, TCTX + b * 1024 + qt * 128, h, true, qt * 128, b);
        } else {
            for (int p = F.bid - 128; p < 256; p += F.G - 128) { const int s = p >> 3, h = p & 7;
                attn_item(F, s * 256, h, false, 0, s); attn_item(F, s * 256 + 128, h, false, 0, s); }
        }
        return;
    }
    for (int it = F.bid; it < 640; it += F.G) {
        if (it < 128) { const int b = it >> 6, h = (it >> 3) & 7, qt = it & 7; attn_item(F, TCTX + b * 1024 + qt * 128, h, true, qt * 128, b); }
        else { const int i2 = it - 128, s = i2 >> 4, h = (i2 >> 1) & 7, qt = i2 & 1; attn_item(F, s * 256 + qt * 128, h, false, 0, s); }
    }
}
constexpr int PH_PER_LAYER = 9, PH_L0 = 2, N_PHASES = PH_L0 + 4 * PH_PER_LAYER + 1;
#ifndef MK_ONE_LAUNCH
#define MK_ONE_LAUNCH 1
#endif
#ifndef PROBE_REP
#define PROBE_REP 1
#define PROBE_SLOT -2
#endif

__global__ void __launch_bounds__(NTHR, 2) fwd_kernel(Args args) {
    extern __shared__ __attribute__((aligned(16))) unsigned char lds[];
    Frame F; F.lds = lds; F.tid = threadIdx.x; F.lane = F.tid & 63; F.wave = __builtin_amdgcn_readfirstlane(F.tid >> 6); F.bid = blockIdx.x; F.G = gridDim.x;
    const int wave_id = F.wave;
    { CArgsP ap = (CArgsP)__builtin_amdgcn_kernarg_segment_ptr(); asm volatile("" : "+s"(ap)); F.a = ap; F.ws = (GAS unsigned char*)ap->ws; }
    LAS unsigned char* ldsl = (LAS unsigned char*)lds;
    for (int u = F.tid; u < (LDS_BYTES - LDSCTL_OFF) / 4; u += NTHR) ((LAS unsigned*)(ldsl + LDSCTL_OFF))[u] = 0u;
    __syncthreads();
    XcdBarrier bar; bar.bar = (unsigned*)(GAS unsigned*)(F.ws + WS_CTL) + 1024; bar.x = 0; bar.st = nullptr;
    const bool multi = (args.ph_hi - args.ph_lo) > 1;
    if (multi) bar = xcd_barrier_post((unsigned*)(GAS unsigned*)(F.ws + WS_CTL) + 1024, (volatile LAS unsigned*)(ldsl + MISC_OFF) + 8);

#define FRESH_F() do { int wv_ = wave_id; asm volatile("" : "+s"(wv_)); int ln_; asm volatile("v_mbcnt_lo_u32_b32 %0, -1, 0\n\tv_mbcnt_hi_u32_b32 %0, -1, %0" : "=v"(ln_)); F.tid = wv_ * 64 + ln_; F.lane = ln_; F.wave = wv_; } while (0)
    int rep = 0;
    for (int ph = args.ph_lo; ph < args.ph_hi; ) {
        { CArgsP ap = (CArgsP)__builtin_amdgcn_kernarg_segment_ptr(); asm volatile("" : "+s"(ap)); F.a = ap; F.ws = (GAS unsigned char*)ap->ws;
          int bid_ = blockIdx.x; asm volatile("" : "+s"(bid_)); F.bid = bid_; }
        if (ph == 0) { FRESH_F(); p0_phase(F); }
        else if (ph == 1) { FRESH_F(); p1_copy_phase(F); norm0_phase(F); }
        else if (ph == N_PHASES - 1) { FRESH_F(); final_phase(F); }
        else {
            const int l = (ph - PH_L0) / PH_PER_LAYER, s = (ph - PH_L0) % PH_PER_LAYER, hi = l >> 1; const bool odd = l & 1;
            if (s == 0 || s == 7) {
                FRESH_F();
                const int f = s == 0 ? 0 : 1;
                pg8::Gemm g{(const bf16*)(const GAS bf16*)(F.ws + WS_XA), (const bf16*)(const GAS bf16*)(F.ws + WS_WGU + (size_t)(l * 2 + f) * SZ_WGU), T, 2 * DFF, D, D, D};
                pg8::StaticOrder S; S.init(T, 2 * DFF, F.G, F.bid);
                EpiSwiglu E{F.ws, (int)(((l * 3) + (f == 0 ? 0 : 2)) * 3 * BIAS_MS), (l == 0 && f == 0) ? 16 : 1};
                pg8::gemm_phase<EpiSwiglu, pg8::StaticOrder, true>(ldsl, F.tid, g, S, E);
                FRESH_F();
                { const int nfull = (40 * 22) % F.G, nbg = F.G - nfull, bgi = F.bid - nfull;
                  if (bgi >= 0 && rep == 0) {
#ifdef PROBE_BG
                    for (int pb = 0; pb < PROBE_BG - 1; ++pb) { background_work(F, l, f, bgi, nbg); FRESH_F(); }
#endif
                    background_work(F, l, f, bgi, nbg); } }
            } else if (s == 1 || s == 8 || s == 6) {
                FRESH_F();
                const int f = s == 1 ? 0 : 1;
                const bool mix = s == 6, lastg = (s == 8 && l == 3);
                const bf16* gA = mix ? (const bf16*)(const GAS bf16*)(F.ws + WS_YMIX) : (const bf16*)(const GAS bf16*)(F.ws + WS_H);
                const bf16* gB = mix ? (const bf16*)(const GAS bf16*)(F.ws + (odd ? WS_WOO : WS_WOE) + (size_t)hi * SZ_WO) : (const bf16*)(const GAS bf16*)(F.ws + WS_WD + (size_t)(l * 2 + f) * SZ_WD);
                const int gK = mix ? D : DFF;
                const int gate_off = l * 3 * NMODV + (mix ? 5 : (f == 0 ? 2 : 8)) * 1024;
                const float coef = rep ? 0.f : (mix ? 1.0f : 0.5f);
                const int nl = (s == 8) ? l + 1 : l, ni = mix ? 2 : (f == 0 ? 1 : 0), sci = mix ? 7 : (f == 0 ? 4 : 1);
                const float* gn = AIN(I_GNORM) + (size_t)((lastg ? 0 : nl) * 3 + ni) * D;
                const int scn_off = (lastg ? 0 : nl) * 3 * NMODV + sci * 1024;
                pg8::Gemm g{gA, gB, T, D, gK, gK, gK};
                EpiResid160 E{F.ws, gn, gate_off, scn_off, coef};
                pg8::StaticOrder S; S.init(T, D, F.G, F.bid, 160);
                pg8::gemm_phase<EpiResid160, pg8::StaticOrder, true, 1>(ldsl, F.tid, g, S, E);
                FRESH_F();
                if (s == 8 && l < 3 && rep == 0) bias_reduce(F, l + 1, 1, F.bid, F.G);
            } else if (s == 2 || (s == 4 && odd)) {
                const int ng = s == 2 ? 1 : 3;
                for (int gi = 0; gi < ng; ++gi) {
                    FRESH_F();
                    const bool inproj = s == 2;
                    const int kind = inproj ? 0 : 1 + gi;
                    const size_t offA = kind == 0 ? WS_XA : (kind == 1 ? WS_QA : (kind == 2 ? WS_CKVA : WS_WKV + (size_t)hi * SZ_WKV + (size_t)512 * 256 * 2));
                    const size_t offB = kind == 0 ? (odd ? WS_WIO + (size_t)hi * SZ_WIO : WS_WIE + (size_t)hi * SZ_WIE) : (kind == 1 ? WS_WUQ + (size_t)hi * SZ_WUQ : (kind == 2 ? WS_WKV + (size_t)hi * SZ_WKV : WS_CKVA));
                    const size_t offO = kind == 0 ? WS_PROJ : (kind == 1 ? WS_Q : (kind == 2 ? WS_KN : WS_VT));
                    const int gM = kind == 3 ? 512 : (kind == 2 ? TP : T);
                    const int gN = kind == 0 ? (odd ? ODD_NP : EVEN_NP) : (kind == 1 ? 768 : (kind == 2 ? 512 : TP));
                    const int gK = kind == 0 ? D : (kind == 1 ? 384 : 256);
                    const int ldc = kind == 3 ? TP : gN;
                    const int off = kind == 2 ? 136 : (kind == 3 ? 52 : 0);
                    pg8::Gemm g{(const bf16*)(const GAS bf16*)(F.ws + offA), (const bf16*)(const GAS bf16*)(F.ws + offB), gM, gN, gK, gK, gK};
                    EpiStore E{F.ws, (unsigned)offO, ldc, inproj ? (int)((l * 3 + 1) * 3 * BIAS_MS) : -1};
                    pg8::StaticOrder S; S.init(gM, gN, F.G, (F.bid + off) % F.G);
                    pg8::gemm_phase<EpiStore, pg8::StaticOrder, true>(ldsl, F.tid, g, S, E);
                }
            } else if (s == 3) { if (!odd) { FRESH_F(); even_phase1(F, hi); } else { FRESH_F(); odd_phase1(F, hi); } }
            else if (s == 4) { FRESH_F(); ssd_scan_phase(F, hi); }
            else if (s == 5) { if (odd) { FRESH_F(); odd_phase3(F); } else { FRESH_F(); even_phase2(F, hi); } }
        }
        {
            const int slot = ph < PH_L0 ? 100 + ph : (ph == N_PHASES - 1 ? 102 : ((ph - PH_L0) % PH_PER_LAYER) + 20 * (((ph - PH_L0) / PH_PER_LAYER) & 1));
            const int reps = ((PROBE_SLOT == 200 && slot < 100) || slot == PROBE_SLOT || (PROBE_SLOT < 20 && slot == PROBE_SLOT + 20 && (PROBE_SLOT < 2 || PROBE_SLOT > 5))) ? PROBE_REP : 1;
            if (++rep >= reps) { rep = 0; ++ph; }
            if (ph < args.ph_hi) xcd_barrier(bar);
#if defined(PROBE_BAR)
            if (ph < args.ph_hi) { for (int pb_ = 1; pb_ < PROBE_BAR; ++pb_) xcd_barrier(bar); }
#endif
        }
    }
}

extern "C" void kernel_launch(void* const* d_in, const int* in_sizes, int n_in, void* d_out, int out_size, void* d_ws, size_t ws_size, hipStream_t stream) {
    static int grid = 0;
    if (grid == 0) {
        if (n_in != 34 || (size_t)out_size != OUT_END || ws_size < WS_END) { fprintf(stderr, "kernel_launch: unexpected problem: n_in %d out %d ws %zu (need %zu)\n", n_in, out_size, ws_size, (size_t)WS_END); grid = -1; return; }
        int dev = 0, cus = 0, per_cu = 0;
        if (hipGetDevice(&dev) != hipSuccess || hipDeviceGetAttribute(&cus, hipDeviceAttributeMultiprocessorCount, dev) != hipSuccess) { grid = -1; return; }
        if (hipFuncSetAttribute((const void*)fwd_kernel, hipFuncAttributeMaxDynamicSharedMemorySize, LDS_BYTES) != hipSuccess) { fprintf(stderr, "kernel_launch: hipFuncSetAttribute failed\n"); grid = -1; return; }
        if (hipOccupancyMaxActiveBlocksPerMultiprocessor(&per_cu, (const void*)fwd_kernel, NTHR, LDS_BYTES) != hipSuccess || per_cu < 1) { fprintf(stderr, "kernel_launch: occupancy query says %d blocks per CU\n", per_cu); per_cu = 1; }
        (void)hipGetLastError();
        grid = cus;
        if (grid < 256) fprintf(stderr, "kernel_launch: %d CUs (tuned for 256)\n", grid);
    }
    if (grid < 0) return;
    (void)hipMemsetAsync((char*)d_ws + WS_CTL, 0, CTL_ZERO_BYTES, stream);
    Args a{};
    for (int i = 0; i < 34; ++i) a.in[i] = (const float*)d_in[i];
    a.out = (float*)d_out; a.ws = (unsigned char*)d_ws;
#if MK_ONE_LAUNCH
    a.ph_lo = 0; a.ph_hi = N_PHASES; a.li = 0;
    hipLaunchKernelGGL(fwd_kernel, dim3(grid), dim3(NTHR), LDS_BYTES, stream, a);
#else
    int li = 0;
    for (int ph = 0; ph < N_PHASES; ++ph) {
        a.ph_lo = ph; a.ph_hi = ph + 1; a.li = li++;
        hipLaunchKernelGGL(fwd_kernel, dim3(grid), dim3(NTHR), LDS_BYTES, stream, a);
    }
#endif
}
```

```cpp
#include <hip/hip_runtime.h>
#include <cstdio>
#include <cstdint>
#ifndef GEMM_SP2
#define GEMM_SP2 1
#endif
#ifndef PG8_AUXA
#define PG8_AUXA 0
#endif
#ifndef PG8_AUXB
#define PG8_AUXB 0
#endif
namespace pg8 {
#define PG8_LAS __attribute__((address_space(3)))
typedef unsigned short bf16_t;
typedef short bf16x8 __attribute__((ext_vector_type(8)));
typedef float f32x4 __attribute__((ext_vector_type(4)));
typedef unsigned u32x4 __attribute__((ext_vector_type(4)));
typedef unsigned u32x2 __attribute__((ext_vector_type(2)));
constexpr int BM = 256, BK = 64, HALF = 128, HTB = HALF * BK * 2  , STAGE_BYTES = 8 * HTB, NXCD = 8, WGM = 8;

__host__ __device__ __forceinline__ int lds_byte(int r, int c) { const int st = (r >> 4) * 2 + (c >> 5), rr = r & 15, cc = c & 31, ob = rr * 64 + cc * 2; return st * 1024 + (ob ^ (((ob >> 9) & 1) << 5)); }
__host__ __device__ __forceinline__ void stage_rc(int b, int& R, int& C) { const int st = b / 1024, sb = b % 1024, swz = sb ^ (((sb >> 9) & 1) << 5); R = (st >> 1) * 16 + swz / 64; C = (st & 1) * 32 + (swz % 64) / 2; }
__host__ __device__ __forceinline__ int perm32(int rho) { const int n = rho >> 4, i = rho & 15; return 8 * (i >> 2) + 4 * n + (i & 3); }

struct Unit { int pm, pn; };
struct Gemm { const bf16_t* A; const bf16_t* Bt; int M, N, K, lda, ldb; };

struct StaticOrder {
    int nM, nN, nwg, G, c;
    __host__ __device__ void init(int M, int N, int G_, int c_, int bmr = BM) { nM = M / bmr; nN = N / BM; nwg = nM * nN; G = G_; c = c_; }
    __host__ __device__ bool next(int i, Unit& u) const {
        const long L = (long)i * G + c; if (L >= nwg) return false;
        int wgid = (int)L; { const int q = nwg / NXCD, r = nwg % NXCD, xcd = wgid % NXCD, off = wgid / NXCD; wgid = (xcd < r ? xcd * (q + 1) : r * (q + 1) + (xcd - r) * q) + off; }
        const int nig = WGM * nN, gid = wgid / nig, fm = gid * WGM, gsz = (nM - fm) < WGM ? (nM - fm) : WGM;
        u.pm = fm + ((wgid % nig) % gsz); u.pn = (wgid % nig) / gsz; return true;
    }
    __device__ __forceinline__ void a_ready(const Unit&) const {}
    __device__ __forceinline__ void done(const Unit&) const {}
};

__device__ __forceinline__ unsigned cvt_pk_bf16(float lo, float hi) { unsigned r; asm volatile("v_cvt_pk_bf16_f32 %0, %1, %2" : "=v"(r) : "v"(lo), "v"(hi)); return r; }

template <class Epi, class Sched, bool ALIGN_EPI, int MH1 = 4>
__device__ __forceinline__ void gemm_phase(PG8_LAS unsigned char* lds, const int tid, const Gemm g, const Sched& S, const Epi& E) {
    const int wid = __builtin_amdgcn_readfirstlane(tid >> 6), lane = tid & 63, wr = wid >> 2, wc = wid & 3, fr = lane & 15, fq = lane >> 4;
    static_assert(MH1 == 4 || MH1 == 1, "row tile");
    constexpr bool R160 = (MH1 == 1); constexpr int BMR = R160 ? 160 : 256;
    const int K = g.K, nt = K / BK;
    unsigned voffA[2], voffB[2], voffA1[2];
#pragma unroll
    for (int i = 0; i < 2; ++i) { int R, C; stage_rc(tid * 16 + i * 8192, R, C); const int Rb = Epi::PERM ? ((R & ~31) + perm32(R & 31)) : R;
        voffA[i] = (unsigned)(R * g.lda + C) * 2u; voffB[i] = (unsigned)(Rb * g.ldb + C) * 2u;
        int R1, C1; stage_rc(wid * 256 + (lane & 15) * 16 + i * 2048, R1, C1); voffA1[i] = (unsigned)(R1 * g.lda + C1) * 2u; }
    const size_t kstep = (size_t)(BK * 2);
    const size_t hstepA = (size_t)HALF * g.lda * 2, hstepB = (size_t)HALF * g.ldb * 2;
    const size_t tstepA = (size_t)BMR * g.lda * 2, tstepB = 2 * hstepB;
    const unsigned ldsw = (unsigned)wid * 1024u, ldsw1 = (unsigned)wid * 256u;
    const int aoff = lds_byte(wr * 64 + fr, fq * 8), boff = lds_byte(wc * 32 + fr, fq * 8), aoff1 = lds_byte(wr * 16 + fr, fq * 8);
#define PG8_SA(b, h) (((b) * 2 + (h)) * HTB)
#define PG8_SB(b, h) ((4 + (b) * 2 + (h)) * HTB)
#define PG8_STAGE(bufoff, gbase, voff) do { _Pragma("unroll") for (int _i = 0; _i < 2; ++_i) \
        __builtin_amdgcn_global_load_lds((const unsigned*)((const char*)(gbase) + (voff)[_i]), (PG8_LAS unsigned*)(lds + (bufoff) + ldsw + _i * 8192), 16, 0, (&(voff)[0] == &voffB[0]) ? PG8_AUXB : PG8_AUXA); } while (0)
#define PG8_LDA_(dst, b, h) do { _Pragma("unroll") for (int m = 0; m < 4; ++m) _Pragma("unroll") for (int k = 0; k < 2; ++k) dst[m][k] = *(const PG8_LAS bf16x8*)(lds + PG8_SA(b, h) + aoff + m * 2048 + k * 1024); } while (0)
#define PG8_LDA(dst, b, h) do { if constexpr (R160 && (h) == 1) { _Pragma("unroll") for (int k = 0; k < 2; ++k) dst[0][k] = *(const PG8_LAS bf16x8*)(lds + PG8_SA(b, 1) + aoff1 + k * 1024); } else PG8_LDA_(dst, b, h); } while (0)
#define PG8_STAGE_A1(bufoff, gbase) do { if constexpr (R160) { if (lane < 16) { _Pragma("unroll") for (int _i = 0; _i < 2; ++_i) \
        __builtin_amdgcn_global_load_lds((const unsigned*)((const char*)(gbase) + voffA1[_i]), (PG8_LAS unsigned*)(lds + (bufoff) + ldsw1 + _i * 2048), 16, 0, 0); } } else PG8_STAGE(bufoff, gbase, voffA); } while (0)
#define PG8_LDB(dst, b, h) do { _Pragma("unroll") for (int n = 0; n < 2; ++n) _Pragma("unroll") for (int k = 0; k < 2; ++k) dst[n][k] = *(const PG8_LAS bf16x8*)(lds + PG8_SB(b, h) + boff + n * 2048 + k * 1024); } while (0)
#define PG8_MMA(ai, bj, At, Bt) do { __builtin_amdgcn_s_setprio(1); _Pragma("unroll") for (int m = 0; m < ((R160 && (ai) == 1) ? 1 : 4); ++m) _Pragma("unroll") for (int n = 0; n < 2; ++n) _Pragma("unroll") for (int k = 0; k < 2; ++k) \
        acc[ai][bj][m][n] = __builtin_amdgcn_mfma_f32_16x16x32_bf16(Bt[n][k], At[m][k], acc[ai][bj][m][n], 0, 0, 0); __builtin_amdgcn_s_setprio(0); } while (0)
#define PG8_WAIT_V(n) asm volatile("s_waitcnt vmcnt(" #n ")" ::: "memory")
#define PG8_WAIT_L(n) asm volatile("s_waitcnt lgkmcnt(" #n ")" ::: "memory")
#define PG8_BAR __builtin_amdgcn_s_barrier()
#define PG8_SCHED __builtin_amdgcn_sched_barrier(0)
    Unit cur, nxt; int ui = 0;
    if (!S.next(0, cur)) return;
    f32x4 acc[2][2][4][2];
#pragma unroll
    for (int a = 0; a < 2; ++a)
#pragma unroll
        for (int b = 0; b < 2; ++b)
#pragma unroll
            for (int m = 0; m < 4; ++m)
#pragma unroll
                for (int n = 0; n < 2; ++n) acc[a][b][m][n] = (f32x4){0.f, 0.f, 0.f, 0.f};
    bf16x8 At[4][2], B0[2][2], B1[2][2];
    const char* cA = (const char*)g.A + (size_t)cur.pm * tstepA; const char* cB = (const char*)g.Bt + (size_t)cur.pn * tstepB;
    S.a_ready(cur);
    E.prefetch_sync(cur, tid, lds, 0); E.prefetch_dma(cur, wid, lane, lds, 0);
    typename Epi::Pre pre;
    if constexpr (R160) { E.pre_dma(cur, wid, lane, lds); E.pre_x(pre, cur, wr, wc, fr, fq); }
#if GEMM_SP2
    PG8_STAGE(PG8_SB(0, 0), cB, voffB); PG8_STAGE(PG8_SB(0, 1), cB + hstepB, voffB); PG8_STAGE(PG8_SA(0, 0), cA, voffA); PG8_STAGE_A1(PG8_SA(0, 1), cA + hstepA);
    if (wr == 1) PG8_BAR;
    PG8_WAIT_V(2); PG8_BAR;
    PG8_STAGE(PG8_SB(1, 0), cB + kstep, voffB); PG8_STAGE(PG8_SA(1, 0), cA + kstep, voffA); PG8_STAGE(PG8_SB(1, 1), cB + hstepB + kstep, voffB);
    PG8_WAIT_V(6); PG8_BAR;
#else
    static_assert(!R160, "the 160-row unit exists for the SP2 schedule only");
    PG8_STAGE(PG8_SB(0, 0), cB, voffB); PG8_STAGE(PG8_SA(0, 0), cA, voffA); PG8_STAGE(PG8_SB(0, 1), cB + hstepB, voffB); PG8_STAGE(PG8_SA(0, 1), cA + hstepA, voffA);
    if (wr == 1) PG8_BAR;
    PG8_WAIT_V(4); PG8_BAR;
    PG8_STAGE(PG8_SB(1, 0), cB + kstep, voffB); PG8_STAGE(PG8_SA(1, 0), cA + kstep, voffA); PG8_STAGE(PG8_SB(1, 1), cB + hstepB + kstep, voffB);
    PG8_WAIT_V(6); PG8_BAR;
#endif
    for (;;) {
        const bool has_next = S.next(ui + 1, nxt);
        const char* nA = has_next ? (const char*)g.A + (size_t)nxt.pm * tstepA : cA; const char* nB = has_next ? (const char*)g.Bt + (size_t)nxt.pn * tstepB : cB;
        for (int t = 0; t < nt; t += 2) {
            const bool last = (t == nt - 2);
            const char* a1 = cA + (size_t)(t + 1) * kstep;
            const char* a2 = last ? nA : cA + (size_t)(t + 2) * kstep; const char* b2 = last ? nB : cB + (size_t)(t + 2) * kstep;
            const char* a3 = a2 + kstep; const char* b3 = b2 + kstep;
            if (last && has_next) { S.a_ready(nxt); E.prefetch_dma(nxt, wid, lane, lds, (ui + 1) & 1); }
#if GEMM_SP2
            PG8_LDB(B0, 0, 0); PG8_LDB(B1, 0, 1); PG8_SCHED; PG8_LDA(At, 0, 0); PG8_STAGE_A1(PG8_SA(1, 1), a1 + hstepA);
            PG8_WAIT_V(8); PG8_WAIT_L(0); PG8_BAR; PG8_MMA(0, 0, At, B0); PG8_MMA(0, 1, At, B1); PG8_BAR; PG8_SCHED;
            PG8_LDA(At, 0, 1); PG8_STAGE(PG8_SB(0, 0), b2, voffB); PG8_STAGE(PG8_SB(0, 1), b2 + hstepB, voffB); PG8_STAGE(PG8_SA(0, 0), a2, voffA);
            PG8_WAIT_V(8); PG8_WAIT_L(0); PG8_BAR; PG8_MMA(1, 0, At, B0); PG8_MMA(1, 1, At, B1); PG8_BAR; PG8_SCHED;
            PG8_LDB(B0, 1, 0); PG8_LDB(B1, 1, 1); PG8_SCHED; PG8_LDA(At, 1, 0); PG8_STAGE_A1(PG8_SA(0, 1), a2 + hstepA);
            PG8_WAIT_V(8); PG8_WAIT_L(0); PG8_BAR; PG8_MMA(0, 0, At, B0); PG8_MMA(0, 1, At, B1); PG8_BAR; PG8_SCHED;
            PG8_LDA(At, 1, 1); PG8_STAGE(PG8_SB(1, 0), b3, voffB); PG8_STAGE(PG8_SB(1, 1), b3 + hstepB, voffB); PG8_STAGE(PG8_SA(1, 0), a3, voffA);
            PG8_WAIT_V(8); PG8_WAIT_L(0); PG8_BAR; PG8_MMA(1, 0, At, B0); PG8_MMA(1, 1, At, B1); PG8_BAR; PG8_SCHED;
#else
            PG8_LDB(B0, 0, 0); PG8_SCHED; PG8_LDA(At, 0, 0); PG8_STAGE(PG8_SA(1, 1), a1 + hstepA, voffA);
            PG8_WAIT_L(8); PG8_BAR; PG8_WAIT_L(0); PG8_MMA(0, 0, At, B0); PG8_BAR; PG8_SCHED;
            PG8_LDB(B1, 0, 1); PG8_STAGE(PG8_SB(0, 0), b2, voffB);
            PG8_BAR; PG8_WAIT_L(0); PG8_MMA(0, 1, At, B1); PG8_BAR;
            PG8_LDA(At, 0, 1); PG8_STAGE(PG8_SA(0, 0), a2, voffA);
            PG8_BAR; PG8_WAIT_L(0); PG8_MMA(1, 0, At, B0); PG8_BAR; PG8_SCHED;
            PG8_STAGE(PG8_SB(0, 1), b2 + hstepB, voffB);
            PG8_WAIT_V(6); PG8_BAR; PG8_MMA(1, 1, At, B1); PG8_BAR;
            PG8_LDB(B0, 1, 0); PG8_SCHED; PG8_LDA(At, 1, 0); PG8_STAGE(PG8_SA(0, 1), a2 + hstepA, voffA);
            PG8_WAIT_L(8); PG8_BAR; PG8_WAIT_L(0); PG8_MMA(0, 0, At, B0); PG8_BAR; PG8_SCHED;
            PG8_LDB(B1, 1, 1); PG8_STAGE(PG8_SB(1, 0), b3, voffB);
            PG8_BAR; PG8_WAIT_L(0); PG8_MMA(0, 1, At, B1); PG8_BAR;
            PG8_LDA(At, 1, 1); PG8_STAGE(PG8_SA(1, 0), a3, voffA);
            PG8_BAR; PG8_WAIT_L(0); PG8_MMA(1, 0, At, B0); PG8_BAR; PG8_SCHED;
            PG8_STAGE(PG8_SB(1, 1), b3 + hstepB, voffB);
            PG8_WAIT_V(6); PG8_BAR; PG8_MMA(1, 1, At, B1); PG8_BAR;
#endif
        }
        if constexpr (ALIGN_EPI) { if (wr == 0) PG8_BAR; }
        if constexpr (R160) E(acc, cur, wr, wc, fr, fq, lds, pre); else E(acc, cur, wr, wc, fr, fq, lds, ui & 1);
#if defined(PROBE_EPI)
        if constexpr ((Epi::KIND & PROBE_EPI) != 0) { for (int er_ = 1; er_ < PROBE_EPI_REP; ++er_) { if constexpr (R160) E(acc, cur, wr, wc, fr, fq, lds, pre); else E(acc, cur, wr, wc, fr, fq, lds, ui & 1); } }
#endif
        if (!has_next) break;
#pragma unroll
        for (int a = 0; a < 2; ++a)
#pragma unroll
            for (int b = 0; b < 2; ++b)
#pragma unroll
                for (int m = 0; m < 4; ++m)
#pragma unroll
                    for (int n = 0; n < 2; ++n) acc[a][b][m][n] = (f32x4){0.f, 0.f, 0.f, 0.f};
        cur = nxt; cA = nA; cB = nB; ++ui;
        E.prefetch_sync(cur, tid, lds, ui & 1);
        if constexpr (R160) { PG8_BAR; E.pre_dma(cur, wid, lane, lds); E.pre_x(pre, cur, wr, wc, fr, fq); PG8_WAIT_V(0); }
        if constexpr (ALIGN_EPI) { if (wr == 1) PG8_BAR; }
    }
    PG8_WAIT_V(0);
    if constexpr (!ALIGN_EPI) { if (wr == 0) PG8_BAR; }
    PG8_BAR;
#undef PG8_SA
#undef PG8_SB
#undef PG8_STAGE
#undef PG8_LDA
#undef PG8_LDA_
#undef PG8_STAGE_A1
#undef PG8_LDB
#undef PG8_MMA
#undef PG8_WAIT_V
#undef PG8_WAIT_L
#undef PG8_BAR
#undef PG8_SCHED
}
}
constexpr int NWAVES = 8, NTHR = 512;
constexpr int D = 1024, TCTX = 8192, TSMP = 2048, T = 10240, TP = T + 512;
constexpr int DFF = 2816, NMODV = 9 * 1024;
constexpr int EVEN_NP = 2816, ODD_NP = 1792;
constexpr float EPS = 1e-6f;
constexpr int NCHUNK = 80;

constexpr size_t MiB = 1u << 20;
constexpr size_t WS_CTL = 0, CTL_ZERO_BYTES = 64 * 1024;
constexpr size_t WS_MOD = 1 * MiB;
constexpr size_t WS_ROPE = WS_MOD + 512 * 1024;
constexpr size_t WS_DEC = WS_ROPE + 160 * 1024;
constexpr size_t WS_SSQ = WS_MOD + 768 * 1024;
constexpr size_t WS_BIAS = 2 * MiB;
constexpr size_t BIAS_LD = 5632, BIAS_MS = 16 * BIAS_LD;
constexpr size_t WS_BIASF = 15 * MiB;
constexpr size_t WS_WGU = 16 * MiB;
constexpr size_t SZ_WGU = (size_t)5632 * 1024 * 2;
constexpr size_t WS_WD = WS_WGU + 8 * SZ_WGU;
constexpr size_t SZ_WD = (size_t)1024 * 2816 * 2;
constexpr size_t WS_WIE = WS_WD + 8 * SZ_WD;
constexpr size_t SZ_WIE = (size_t)EVEN_NP * 1024 * 2;
constexpr size_t WS_WOE = WS_WIE + 2 * SZ_WIE;
constexpr size_t SZ_WO = (size_t)1024 * 1024 * 2;
constexpr size_t WS_WIO = WS_WOE + 2 * SZ_WO;
constexpr size_t SZ_WIO = (size_t)ODD_NP * 1024 * 2;
constexpr size_t WS_WOO = WS_WIO + 2 * SZ_WIO;
constexpr size_t WS_WUQ = WS_WOO + 2 * SZ_WO;
constexpr size_t SZ_WUQ = (size_t)768 * 384 * 2;
constexpr size_t WS_WKV = WS_WUQ + 2 * SZ_WUQ;
constexpr size_t SZ_WKV = (size_t)1024 * 256 * 2;
constexpr size_t WS_WEND = WS_WKV + 2 * SZ_WKV;
constexpr size_t WS_X = (WS_WEND + MiB - 1) / MiB * MiB;
constexpr size_t WS_XA = WS_X + (size_t)T * D * 4;
constexpr size_t WS_PROJ = WS_XA + (size_t)T * D * 2;
constexpr size_t WS_YMIX = WS_PROJ + (size_t)T * EVEN_NP * 2;
constexpr size_t WS_H = WS_YMIX + (size_t)T * D * 2;
constexpr size_t WS_ST = WS_H;
constexpr size_t WS_QA = WS_H;
constexpr size_t WS_CKVA = WS_QA + (size_t)T * 384 * 2;
constexpr size_t WS_KR = WS_CKVA + (size_t)TP * 256 * 2;
constexpr size_t WS_Q = WS_KR + (size_t)TP * 32 * 2;
constexpr size_t WS_KN = WS_Q + (size_t)T * 768 * 2;
constexpr size_t WS_VT = WS_KN + (size_t)TP * 512 * 2;
constexpr size_t WS_HEND = WS_H + (size_t)T * DFF * 2;
static_assert(WS_VT + (size_t)512 * TP * 2 <= WS_HEND, "odd-layer scratch fits the H overlay");
static_assert(WS_ST + (size_t)NCHUNK * 8 * 2 * 8192 * 4 <= WS_HEND, "chunk states fit the H overlay");
constexpr size_t WS_XCT = WS_HEND;
constexpr size_t WS_CC = WS_XCT + (size_t)NCHUNK * 8 * 8192 * 2;
constexpr size_t WS_CBM = WS_CC + (size_t)T * 256 * 2;
constexpr size_t WS_HIN = WS_CBM + (size_t)NCHUNK * 2 * 16384 * 2;
constexpr size_t WS_END = WS_HIN + (size_t)NCHUNK * 8 * 2 * 8192 * 2;

constexpr size_t OUT_Y = 0, OUT_SSD = (size_t)T * D, OUT_CKV = OUT_SSD + (size_t)32 * 2 * 2 * 8 * 64 * 128, OUT_KR = OUT_CKV + (size_t)32 * 2 * 256 * 256, OUT_END = OUT_KR + (size_t)32 * 2 * 256 * 32;

constexpr int RING_BYTES = 131072;
constexpr int LDSCTL_OFF = 144 * 1024 - 512, MISC_OFF = LDSCTL_OFF + 320;
constexpr int LDS_BYTES = 147456;

#define GAS __attribute__((address_space(1)))
#define LAS __attribute__((address_space(3)))
typedef unsigned short bf16;
typedef unsigned v4u __attribute__((ext_vector_type(4)));
typedef unsigned v2u __attribute__((ext_vector_type(2)));
typedef float f32x4 __attribute__((ext_vector_type(4)));
typedef short bf16x8 __attribute__((ext_vector_type(8)));
typedef GAS unsigned gu32;
#define RLX_AGENT __ATOMIC_RELAXED, __HIP_MEMORY_SCOPE_AGENT
__device__ __forceinline__ unsigned f2bf(float f) { unsigned u = __builtin_bit_cast(unsigned, f); return (u + 0x7fffu + ((u >> 16) & 1u)) >> 16; }
typedef float f32x2_t __attribute__((ext_vector_type(2)));
typedef __bf16 bf16x2_t __attribute__((ext_vector_type(2)));
__device__ __forceinline__ unsigned pk2(float lo, float hi) { const f32x2_t v = {lo, hi}; const bf16x2_t b = __builtin_convertvector(v, bf16x2_t); return __builtin_bit_cast(unsigned, b); }
__device__ __forceinline__ unsigned f2bf1(float f) { return pk2(f, 0.f) & 0xffffu; }
__device__ __forceinline__ float bflo(unsigned w) { return __builtin_bit_cast(float, w << 16); }
__device__ __forceinline__ float bfhi(unsigned w) { return __builtin_bit_cast(float, w & 0xffff0000u); }
__device__ __forceinline__ float bf1(bf16 h) { return __builtin_bit_cast(float, ((unsigned)h) << 16); }
__device__ __forceinline__ void unpack8(const v4u v, float* o) { o[0] = bflo(v.x); o[1] = bfhi(v.x); o[2] = bflo(v.y); o[3] = bfhi(v.y); o[4] = bflo(v.z); o[5] = bfhi(v.z); o[6] = bflo(v.w); o[7] = bfhi(v.w); }
__device__ __forceinline__ v4u pack8(const float* o) { v4u v; v.x = pk2(o[0], o[1]); v.y = pk2(o[2], o[3]); v.z = pk2(o[4], o[5]); v.w = pk2(o[6], o[7]); return v; }
template <int K> __device__ __forceinline__ float xlane(float v) { static_assert(K >= 1 && K < 32, "xor mask inside a 32-lane half");
    return __builtin_bit_cast(float, __builtin_amdgcn_ds_swizzle(__builtin_bit_cast(int, v), (K << 10) | 0x1F)); }
__device__ __forceinline__ float sum_x32(float v) { const unsigned u = __builtin_bit_cast(unsigned, v); const auto r = __builtin_amdgcn_permlane32_swap(u, u, false, false);
    return __builtin_bit_cast(float, (unsigned)r[0]) + __builtin_bit_cast(float, (unsigned)r[1]); }
__device__ __forceinline__ float max_x32(float v) { const unsigned u = __builtin_bit_cast(unsigned, v); const auto r = __builtin_amdgcn_permlane32_swap(u, u, false, false);
    return fmaxf(__builtin_bit_cast(float, (unsigned)r[0]), __builtin_bit_cast(float, (unsigned)r[1])); }
__device__ __forceinline__ float wave_sum(float v) {
    v += xlane<1>(v); v += xlane<2>(v); v += xlane<4>(v); v += xlane<8>(v); v += xlane<16>(v);
    return sum_x32(v);
}
__device__ __forceinline__ float frcp(float x) { return __builtin_amdgcn_rcpf(x); }
__device__ __forceinline__ float frsq(float x) { return __builtin_amdgcn_rsqf(x); }
__device__ __forceinline__ float sigmoidf_(float x) { return frcp(1.0f + __expf(-x)); }
__device__ __forceinline__ float siluf_(float x) { return x * frcp(1.0f + __expf(-x)); }
__device__ __forceinline__ float gelu_tanh(float x) { const float y = 0.7978845608028654f * (x + 0.044715f * x * x * x); const float t = 1.0f - 2.0f * frcp(1.0f + __expf(2.0f * y)); return 0.5f * x * (1.0f + t); }
__device__ __forceinline__ float softplusf_(float x) { const float e = __expf(x); return x > 20.f ? x : (e < 1e-3f ? e * (1.0f - 0.5f * e) : __logf(1.0f + e)); }
__device__ __forceinline__ int modrow_of_tile(int pm) { return pm < 32 ? 0 : 1 + ((pm - 32) >> 2); }
__device__ __forceinline__ int modrow_of_tok(int t) { return t < TCTX ? 0 : 1 + ((t - TCTX) >> 10); }

#define XB_TMO      128
#define XB_XCNT(j)  (256  + 64 * (j))
#define XB_XSUB(j)  (1280 + 64 * (j))
#define XB_XGEN(j)  (2304 + 64 * (j))
#define XB_TOP      3328
#define XB_TOPGEN   3392
#define XCD_BAR_WORDS 3456
#define XB_SPIN_CAP (1u << 22)
__device__ __forceinline__ unsigned xb_ld(unsigned* p)              { return __hip_atomic_load(p, __ATOMIC_RELAXED, __HIP_MEMORY_SCOPE_AGENT); }
__device__ __forceinline__ unsigned xb_add(unsigned* p, unsigned v) { return __hip_atomic_fetch_add(p, v, __ATOMIC_RELAXED, __HIP_MEMORY_SCOPE_AGENT); }
__device__ __forceinline__ unsigned xb_xcc_id() { return (unsigned)__builtin_amdgcn_s_getreg((3 << 11) | 20) & 0xFu; }
#define XB_SPIN(cond, bar) do { unsigned _sp = 0; while (cond) { __builtin_amdgcn_s_sleep(1); \
    if ((++_sp & 255u) == 0u) { if (xb_ld(&(bar)[XB_TMO])) break; if (_sp > XB_SPIN_CAP) { atomicAdd(&(bar)[XB_TMO], 1u); break; } } } } while (0)
struct XcdBarrier { unsigned* bar; unsigned x; volatile LAS unsigned* st; };
__device__ __forceinline__ XcdBarrier xcd_barrier_post(unsigned* bar, volatile LAS unsigned* st) {
    XcdBarrier b; b.bar = bar; b.x = xb_xcc_id(); b.st = st;
    if (threadIdx.x == 0) (void)xb_add(&bar[XB_XCNT(b.x)], 1u);
    return b;
}
__device__ __forceinline__ void xcd_barrier_complete(unsigned* bar, unsigned x, unsigned& nloc, unsigned& nx) {
    const unsigned G = gridDim.x * gridDim.y * gridDim.z;
    unsigned sum, cnt, mine, sp = 0u;
    for (;;) {
        sum = 0u; cnt = 0u; mine = 0u;
#pragma unroll
        for (unsigned j = 0; j < 16; ++j) { const unsigned c = xb_ld(&bar[XB_XCNT(j)]); sum += c; cnt += (c > 0u) ? 1u : 0u; mine = (j == x) ? c : mine; }
        if (sum == G) break;
        __builtin_amdgcn_s_sleep(1);
        if ((++sp & 255u) == 0u) { if (xb_ld(&bar[XB_TMO])) break; if (sp > XB_SPIN_CAP) { atomicAdd(&bar[XB_TMO], 1u); break; } }
    }
    nloc = mine > 0u ? mine : 1u; nx = cnt > 0u ? cnt : 1u;
}
__device__ __forceinline__ void xcd_barrier(const XcdBarrier& b) {
    asm volatile("s_waitcnt vmcnt(0)" ::: "memory");
    __syncthreads();
    if (threadIdx.x == 0) {
        unsigned* bar = b.bar;
        __builtin_amdgcn_s_waitcnt(0);
        unsigned nloc = b.st[0], nx = b.st[1];
        if (nloc == 0u) { xcd_barrier_complete(bar, b.x, nloc, nx); b.st[0] = nloc; b.st[1] = nx; }
        const unsigned k = b.st[2] + 1u; b.st[2] = k;
        const unsigned old = xb_add(&bar[XB_XSUB(b.x)], 1u);
        if (old + 1u == k * nloc) {
            __builtin_amdgcn_fence(__ATOMIC_RELEASE, "agent");
            asm volatile("s_waitcnt vmcnt(0)" ::: "memory");
            const unsigned og = xb_add(&bar[XB_TOP], 1u);
            if (og + 1u == k * nx) xb_add(&bar[XB_TOPGEN], 1u);
        }
        XB_SPIN(xb_ld(&bar[XB_TOPGEN]) < k, bar);
        __builtin_amdgcn_fence(__ATOMIC_ACQUIRE, "agent");
        asm volatile("s_waitcnt vmcnt(0)" ::: "memory");
    }
    __syncthreads();
}

struct Args { const float* in[34]; float* out; unsigned char* ws; int ph_lo, ph_hi, li, pad; };
typedef const __attribute__((address_space(4))) Args* CArgsP;
enum { I_XP = 0, I_XS, I_SSD, I_CCKV, I_CKR, I_C, I_CCTX, I_WMOD, I_BMOD, I_GNORM, I_WGU, I_WDN, I_WIE, I_WOE, I_WSP, I_BSP, I_GV, I_WCS, I_BCS, I_DTB, I_ALOG, I_DSK, I_GSO,
       I_WIO, I_WOO, I_GCQ, I_WUQ, I_GCKV, I_WUKV, I_WDW, I_BDW, I_GLN, I_BLN, I_GFIN };
using pg8::Unit;
constexpr int EP_PART = RING_BYTES, EP_S = RING_BYTES + 4096, EP_B = RING_BYTES + 4096 + 8192;
__device__ __forceinline__ void epi_prefetch_dma(GAS unsigned char* ws, int bias_off, const Unit& u, int wid, int lane, PG8_LAS unsigned char* ldsl, int par) {
    if (wid < 4) __builtin_amdgcn_global_load_lds((const GAS unsigned*)(ws + WS_SSQ + ((size_t)(u.pm * 256 + 64 * wid + lane) * 4) * 4), (PG8_LAS unsigned*)(ldsl + EP_S + par * 4096 + wid * 1024), 16, 0, 0);
    else if (wid == 4) __builtin_amdgcn_global_load_lds((const GAS unsigned*)(ws + WS_BIASF + ((size_t)bias_off / 16 + (size_t)modrow_of_tile(u.pm) * BIAS_LD + u.pn * 256 + 4 * lane) * 4), (PG8_LAS unsigned*)(ldsl + EP_B + par * 1024), 16, 0, 0);
}
__device__ __forceinline__ void epi_prefetch_sync16(GAS unsigned char* ws, int bias_off, const Unit& u, int tid, PG8_LAS unsigned char* ldsl, int par) {
    if (tid < 256) *(PG8_LAS pg8::f32x4*)(ldsl + EP_S + par * 4096 + tid * 16) = *(const GAS pg8::f32x4*)(ws + WS_SSQ + ((size_t)(u.pm * 256 + tid) * 4) * 4);
    else { const GAS float* bp = (const GAS float*)(ws + WS_BIAS) + (size_t)bias_off + (size_t)modrow_of_tile(u.pm) * BIAS_MS + u.pn * 256 + (tid - 256); float b = 0.f;
#pragma unroll
        for (int kb = 0; kb < 16; ++kb) b += bp[(size_t)kb * BIAS_LD];
        ((PG8_LAS float*)(ldsl + EP_B))[par * 256 + (tid - 256)] = b; }
}
__device__ __forceinline__ float epi_row_rstd(const PG8_LAS unsigned char* ldsl, int par, int rl) { const pg8::f32x4 s = *(const PG8_LAS pg8::f32x4*)(ldsl + EP_S + par * 4096 + rl * 16); return frsq(((s[0] + s[1]) + (s[2] + s[3])) * (1.f / D) + EPS); }
struct EpiSwiglu {
    static constexpr bool PERM = true; static constexpr int KIND = 1; struct Pre {};
    GAS unsigned char* ws; int bias_off, nparts;
    __device__ __forceinline__ void prefetch_dma(const Unit& u, int wid, int lane, PG8_LAS unsigned char* ldsl, int par) const { if (nparts == 1) epi_prefetch_dma(ws, bias_off, u, wid, lane, ldsl, par); }
    __device__ __forceinline__ void prefetch_sync(const Unit& u, int tid, PG8_LAS unsigned char* ldsl, int par) const { if (nparts != 1) epi_prefetch_sync16(ws, bias_off, u, tid, ldsl, par); }
    __device__ __forceinline__ void operator()(const pg8::f32x4 (&acc)[2][2][4][2], const Unit& u, int wr, int wc, int fr, int fq, PG8_LAS unsigned char* ldsl, int par) const {
        bf16* H = (bf16*)(GAS bf16*)(ws + WS_H);
        const PG8_LAS float* bb = (const PG8_LAS float*)(ldsl + EP_B) + par * 256 + wc * 32 + 8 * fq;
        const int row0 = u.pm * 256 + wr * 64 + fr, col0 = u.pn * 128 + wc * 32 + 8 * fq;
        const pg8::f32x4 bg0 = *(const PG8_LAS pg8::f32x4*)bb, bg1 = *(const PG8_LAS pg8::f32x4*)(bb + 4), bu0 = *(const PG8_LAS pg8::f32x4*)(bb + 128), bu1 = *(const PG8_LAS pg8::f32x4*)(bb + 132);
#pragma unroll
        for (int ai = 0; ai < 2; ++ai)
#pragma unroll
            for (int m = 0; m < 4; ++m) {
                const int rl = ai * 128 + wr * 64 + m * 16 + fr;
                const float rs = epi_row_rstd(ldsl, par, rl);
                bf16* rowp = H + (size_t)(u.pm * 256 + rl) * DFF + col0;
                const pg8::f32x4 g0 = acc[ai][0][m][0] * rs + bg0, g1 = acc[ai][0][m][1] * rs + bg1, u0 = acc[ai][1][m][0] * rs + bu0, u1 = acc[ai][1][m][1] * rs + bu1;
                float gg[8], uu[8], e[8], o[8];
#pragma unroll
                for (int j = 0; j < 4; ++j) { gg[j] = g0[j]; gg[4 + j] = g1[j]; uu[j] = u0[j]; uu[4 + j] = u1[j]; }
#pragma unroll
                for (int j = 0; j < 8; ++j) e[j] = __builtin_amdgcn_exp2f(gg[j] * -1.4426950408889634f);
#pragma unroll
                for (int j = 0; j < 8; ++j) e[j] = __builtin_amdgcn_rcpf(1.0f + e[j]);
#pragma unroll
                for (int j = 0; j < 8; ++j) o[j] = (gg[j] * uu[j]) * e[j];
                pg8::u32x4 w; w.x = pg8::cvt_pk_bf16(o[0], o[1]); w.y = pg8::cvt_pk_bf16(o[2], o[3]); w.z = pg8::cvt_pk_bf16(o[4], o[5]); w.w = pg8::cvt_pk_bf16(o[6], o[7]);
                *(pg8::u32x4*)rowp = w;
            }
        (void)row0;
    }
};
struct EpiResid {
    static constexpr bool PERM = true; static constexpr int KIND = 4;
    GAS unsigned char* ws; const float* gn; int gate_off, scn_off; float coef;
    __device__ __forceinline__ void prefetch_dma(const Unit&, int, int, PG8_LAS unsigned char*, int) const {}
    __device__ __forceinline__ void prefetch_sync(const Unit&, int, PG8_LAS unsigned char*, int) const {}
    __device__ __forceinline__ void operator()(const pg8::f32x4 (&acc)[2][2][4][2], const Unit& u, int wr, int wc, int fr, int fq, PG8_LAS unsigned char* ldsl, int) const {
        bf16* X = (bf16*)(GAS bf16*)(ws + WS_X); const float* gate = (const float*)(const GAS float*)(ws + WS_MOD) + gate_off; const float* scn = (const float*)(const GAS float*)(ws + WS_MOD) + scn_off;
        bf16* XA = (bf16*)(GAS bf16*)(ws + WS_XA); float* SSQ = (float*)(GAS float*)(ws + WS_SSQ); PG8_LAS float* part = (PG8_LAS float*)(ldsl + EP_PART);
        const int row0 = u.pm * 256 + wr * 64 + fr, col0 = u.pn * 256 + wc * 32 + 8 * fq;
        const int mr = modrow_of_tile(u.pm);
        float ss[2][4];
#pragma unroll
        for (int ai = 0; ai < 2; ++ai)
#pragma unroll
            for (int m = 0; m < 4; ++m) ss[ai][m] = 0.f;
#pragma unroll
        for (int bj = 0; bj < 2; ++bj) {
            const int co = col0 + bj * 128;
            const float* gp = gate + (size_t)mr * NMODV + co; const float* sp = scn + (size_t)mr * NMODV + co;
            const pg8::f32x4 gv0 = *(const pg8::f32x4*)gp * coef, gv1 = *(const pg8::f32x4*)(gp + 4) * coef;
            const pg8::f32x4 gc0 = *(const pg8::f32x4*)(gn + co) * (*(const pg8::f32x4*)sp + 1.0f), gc1 = *(const pg8::f32x4*)(gn + co + 4) * (*(const pg8::f32x4*)(sp + 4) + 1.0f);
#pragma unroll
            for (int ai = 0; ai < 2; ++ai) {
                pg8::u32x4 xo[4];
#pragma unroll
                for (int m = 0; m < 4; ++m) xo[m] = *(const pg8::u32x4*)(X + (size_t)(row0 + ai * 128 + m * 16) * D + co);
#pragma unroll
                for (int m = 0; m < 4; ++m) {
                    const size_t off = (size_t)(row0 + ai * 128 + m * 16) * D + co;
                    const pg8::u32x4 xw = xo[m];
                    const pg8::f32x4 x0 = {bflo(xw.x), bfhi(xw.x), bflo(xw.y), bfhi(xw.y)}, x1 = {bflo(xw.z), bfhi(xw.z), bflo(xw.w), bfhi(xw.w)};
                    const pg8::f32x4 n0 = x0 + gv0 * acc[ai][bj][m][0], n1 = x1 + gv1 * acc[ai][bj][m][1];
                    ss[ai][m] += ((n0[0] * n0[0] + n0[1] * n0[1]) + (n0[2] * n0[2] + n0[3] * n0[3])) + ((n1[0] * n1[0] + n1[1] * n1[1]) + (n1[2] * n1[2] + n1[3] * n1[3]));
                    pg8::u32x4 w; w.x = pg8::cvt_pk_bf16(n0[0], n0[1]); w.y = pg8::cvt_pk_bf16(n0[2], n0[3]); w.z = pg8::cvt_pk_bf16(n1[0], n1[1]); w.w = pg8::cvt_pk_bf16(n1[2], n1[3]);
                    *(pg8::u32x4*)(X + off) = w;
                    const pg8::f32x4 a0 = n0 * gc0, a1 = n1 * gc1;
                    pg8::u32x4 v; v.x = pg8::cvt_pk_bf16(a0[0], a0[1]); v.y = pg8::cvt_pk_bf16(a0[2], a0[3]); v.z = pg8::cvt_pk_bf16(a1[0], a1[1]); v.w = pg8::cvt_pk_bf16(a1[2], a1[3]);
                    *(pg8::u32x4*)(XA + off) = v;
                }
            }
        }
#pragma unroll
        for (int ai = 0; ai < 2; ++ai)
#pragma unroll
            for (int m = 0; m < 4; ++m) { float s = ss[ai][m]; s += xlane<16>(s); s = sum_x32(s);
                if (fq == 0) part[wc * 256 + ai * 128 + wr * 64 + m * 16 + fr] = s; }
        asm volatile("s_waitcnt lgkmcnt(0)" ::: "memory"); __builtin_amdgcn_s_barrier(); asm volatile("" ::: "memory");
        const int t = (wr * 4 + wc) * 64 + fq * 16 + fr;
        if (t < 256) SSQ[(size_t)(u.pm * 256 + t) * 4 + u.pn] = (part[t] + part[256 + t]) + (part[512 + t] + part[768 + t]);
    }
};
struct EpiResid160 {
    static constexpr bool PERM = true; static constexpr int KIND = 4;
    GAS unsigned char* ws; const float* gn; int gate_off, scn_off; float coef;
    struct Pre { pg8::u32x4 xo[2][5]; };
    __device__ __forceinline__ void prefetch_dma(const Unit&, int, int, PG8_LAS unsigned char*, int) const {}
    __device__ __forceinline__ void prefetch_sync(const Unit&, int, PG8_LAS unsigned char*, int) const {}
    __device__ __forceinline__ void pre_dma(const Unit& u, int wid, int lane, PG8_LAS unsigned char* ldsl) const {
        const int rowbase = u.pm * 160, mrA = modrow_of_tok(rowbase), mrB = modrow_of_tok(rowbase + 159), col = u.pn * 256 + 4 * lane;
        if (wid < 5) {
            const int mr = wid >= 3 ? mrB : mrA;
            const GAS float* modp = (const GAS float*)(ws + WS_MOD) + (size_t)mr * NMODV + col;
            const GAS float* src = (wid == 2) ? (const GAS float*)gn + col : ((wid == 0 || wid == 3) ? modp + gate_off : modp + scn_off);
            __builtin_amdgcn_global_load_lds((const GAS unsigned*)src, (PG8_LAS unsigned*)(ldsl + EP_S + wid * 1024), 16, 0, 0);
        }
    }
    __device__ __forceinline__ void pre_x(Pre& pre, const Unit& u, int wr, int wc, int fr, int fq) const {
        const bf16* X = (const bf16*)(const GAS bf16*)(ws + WS_X);
        const int rowbase = u.pm * 160, col0 = u.pn * 256 + wc * 32 + 8 * fq;
#pragma unroll
        for (int bj = 0; bj < 2; ++bj)
#pragma unroll
            for (int i = 0; i < 5; ++i) { const int rl = i < 4 ? wr * 64 + i * 16 + fr : 128 + wr * 16 + fr; pre.xo[bj][i] = *(const pg8::u32x4*)(X + (size_t)(rowbase + rl) * D + col0 + bj * 128); }
    }
    __device__ __forceinline__ void operator()(const pg8::f32x4 (&acc)[2][2][4][2], const Unit& u, int wr, int wc, int fr, int fq, PG8_LAS unsigned char* ldsl, const Pre& pre) const {
        bf16* X = (bf16*)(GAS bf16*)(ws + WS_X);
        bf16* XA = (bf16*)(GAS bf16*)(ws + WS_XA); float* SSQ = (float*)(GAS float*)(ws + WS_SSQ); PG8_LAS float* part = (PG8_LAS float*)(ldsl + EP_PART);
        const PG8_LAS float* V = (const PG8_LAS float*)(ldsl + EP_S);
        const int rowbase = u.pm * 160, col0 = u.pn * 256 + wc * 32 + 8 * fq;
        const int mrA = modrow_of_tok(rowbase), mrB = modrow_of_tok(rowbase + 159);
        const int bnd = (mrA == mrB) ? (1 << 30) : (mrB == 1 ? TCTX : TCTX + 1024);
        float ss[5];
#pragma unroll
        for (int i = 0; i < 5; ++i) ss[i] = 0.f;
#pragma unroll
        for (int bj = 0; bj < 2; ++bj) {
            const int co = col0 + bj * 128, cl = wc * 32 + 8 * fq + bj * 128;
            const pg8::f32x4 gn0 = *(const PG8_LAS pg8::f32x4*)(V + 512 + cl), gn1 = *(const PG8_LAS pg8::f32x4*)(V + 512 + cl + 4);
            const pg8::f32x4 gvA0 = *(const PG8_LAS pg8::f32x4*)(V + cl) * coef, gvA1 = *(const PG8_LAS pg8::f32x4*)(V + cl + 4) * coef, gvB0 = *(const PG8_LAS pg8::f32x4*)(V + 768 + cl) * coef, gvB1 = *(const PG8_LAS pg8::f32x4*)(V + 768 + cl + 4) * coef;
            const pg8::f32x4 gcA0 = gn0 * (*(const PG8_LAS pg8::f32x4*)(V + 256 + cl) + 1.0f), gcA1 = gn1 * (*(const PG8_LAS pg8::f32x4*)(V + 256 + cl + 4) + 1.0f);
            const pg8::f32x4 gcB0 = gn0 * (*(const PG8_LAS pg8::f32x4*)(V + 1024 + cl) + 1.0f), gcB1 = gn1 * (*(const PG8_LAS pg8::f32x4*)(V + 1024 + cl + 4) + 1.0f);
#pragma unroll
            for (int i = 0; i < 5; ++i) {
                const int rb = i < 4 ? wr * 64 + i * 16 : 128 + wr * 16;
                const bool hb = rowbase + rb >= bnd;
                const pg8::f32x4 gv0 = hb ? gvB0 : gvA0, gv1 = hb ? gvB1 : gvA1, gc0 = hb ? gcB0 : gcA0, gc1 = hb ? gcB1 : gcA1;
                const size_t off = (size_t)(rowbase + rb + fr) * D + co;
                const pg8::u32x4 xw = pre.xo[bj][i];
                const pg8::f32x4 c0 = i < 4 ? acc[0][bj][i & 3][0] : acc[1][bj][0][0], c1 = i < 4 ? acc[0][bj][i & 3][1] : acc[1][bj][0][1];
                const pg8::f32x4 x0 = {bflo(xw.x), bfhi(xw.x), bflo(xw.y), bfhi(xw.y)}, x1 = {bflo(xw.z), bfhi(xw.z), bflo(xw.w), bfhi(xw.w)};
                const pg8::f32x4 n0 = x0 + gv0 * c0, n1 = x1 + gv1 * c1;
                ss[i] += ((n0[0] * n0[0] + n0[1] * n0[1]) + (n0[2] * n0[2] + n0[3] * n0[3])) + ((n1[0] * n1[0] + n1[1] * n1[1]) + (n1[2] * n1[2] + n1[3] * n1[3]));
                pg8::u32x4 w; w.x = pg8::cvt_pk_bf16(n0[0], n0[1]); w.y = pg8::cvt_pk_bf16(n0[2], n0[3]); w.z = pg8::cvt_pk_bf16(n1[0], n1[1]); w.w = pg8::cvt_pk_bf16(n1[2], n1[3]);
                *(pg8::u32x4*)(X + off) = w;
                const pg8::f32x4 a0 = n0 * gc0, a1 = n1 * gc1;
                pg8::u32x4 v; v.x = pg8::cvt_pk_bf16(a0[0], a0[1]); v.y = pg8::cvt_pk_bf16(a0[2], a0[3]); v.z = pg8::cvt_pk_bf16(a1[0], a1[1]); v.w = pg8::cvt_pk_bf16(a1[2], a1[3]);
                *(pg8::u32x4*)(XA + off) = v;
            }
        }
#pragma unroll
        for (int i = 0; i < 5; ++i) { float s = ss[i]; s += xlane<16>(s); s = sum_x32(s);
            if (fq == 0) part[wc * 160 + (i < 4 ? wr * 64 + i * 16 + fr : 128 + wr * 16 + fr)] = s; }
        asm volatile("s_waitcnt lgkmcnt(0)" ::: "memory"); __builtin_amdgcn_s_barrier(); asm volatile("" ::: "memory");
        const int t = (wr * 4 + wc) * 64 + fq * 16 + fr;
        if (t < 160) SSQ[(size_t)(rowbase + t) * 4 + u.pn] = (part[t] + part[160 + t]) + (part[320 + t] + part[480 + t]);
    }
};
struct EpiStore {
    static constexpr bool PERM = true; static constexpr int KIND = 2; struct Pre {};
    GAS unsigned char* ws; unsigned o_off; int ldc; int bias_off;
    __device__ __forceinline__ void prefetch_dma(const Unit& u, int wid, int lane, PG8_LAS unsigned char* ldsl, int par) const { if (bias_off >= 0) epi_prefetch_dma(ws, bias_off, u, wid, lane, ldsl, par); }
    __device__ __forceinline__ void prefetch_sync(const Unit&, int, PG8_LAS unsigned char*, int) const {}
    __device__ __forceinline__ void operator()(const pg8::f32x4 (&acc)[2][2][4][2], const Unit& u, int wr, int wc, int fr, int fq, PG8_LAS unsigned char* ldsl, int par) const {
        bf16* O = (bf16*)(GAS bf16*)(ws + o_off);
        const PG8_LAS float* bb = (const PG8_LAS float*)(ldsl + EP_B) + par * 256 + wc * 32 + 8 * fq;
        const int col0 = u.pn * 256 + wc * 32 + 8 * fq; const bool nrm = bias_off >= 0;
        pg8::f32x4 b[2][2];
#pragma unroll
        for (int bj = 0; bj < 2; ++bj)
#pragma unroll
            for (int n = 0; n < 2; ++n) { const pg8::f32x4 bv = *(const PG8_LAS pg8::f32x4*)(bb + bj * 128 + 4 * n); b[bj][n] = nrm ? bv : (pg8::f32x4){0.f, 0.f, 0.f, 0.f}; }
#pragma unroll
        for (int ai = 0; ai < 2; ++ai)
#pragma unroll
            for (int m = 0; m < 4; ++m) {
                const int rl = ai * 128 + wr * 64 + m * 16 + fr;
                const float rs0 = epi_row_rstd(ldsl, par, rl), rs = nrm ? rs0 : 1.0f;
                bf16* rowp = O + (size_t)(u.pm * 256 + rl) * ldc + col0;
#pragma unroll
                for (int bj = 0; bj < 2; ++bj) {
                    const pg8::f32x4 v0 = acc[ai][bj][m][0] * rs + b[bj][0], v1 = acc[ai][bj][m][1] * rs + b[bj][1];
                    pg8::u32x4 w; w.x = pg8::cvt_pk_bf16(v0[0], v0[1]); w.y = pg8::cvt_pk_bf16(v0[2], v0[3]); w.z = pg8::cvt_pk_bf16(v1[0], v1[1]); w.w = pg8::cvt_pk_bf16(v1[2], v1[3]);
                    *(pg8::u32x4*)(rowp + bj * 128) = w;
                }
            }
    }
};

struct Frame {
    unsigned char* lds;
    mutable int tid, lane; int wave, bid, G;
    __device__ __forceinline__ void relane() const { int ln; asm volatile("v_mbcnt_lo_u32_b32 %0, -1, 0\n\tv_mbcnt_hi_u32_b32 %0, -1, %0" : "=v"(ln)); lane = ln; tid = wave * 64 + ln; }
    CArgsP a;
    GAS unsigned char* ws;
};
#define WSP(type, off) ((type*)(GAS type*)(F.ws + (off)))
#define AIN(i) ((const float*)(const GAS float*)F.a->in[i])
#define AOUT ((float*)(GAS float*)F.a->out)

struct ConvD { const float* W; bf16* WT; const float* shift; float* bias_out; int N, ldt, k0, n0, dst; };
__device__ __forceinline__ void conv_load(const ConvD& d, int lane, f32x4 (&v)[8]) {
    const int n4 = (lane & 7) * 4; const bool ok4 = d.n0 + n4 < d.N;
#pragma unroll
    for (int i = 0; i < 8; ++i) { const int kk = 8 * i + (lane >> 3);
        v[i] = ok4 ? *(const f32x4*)(d.W + (size_t)(d.k0 + kk) * d.N + d.n0 + n4) : (f32x4){0.f, 0.f, 0.f, 0.f}; }
}
__device__ __forceinline__ void conv_proc(const ConvD& d, const f32x4 (&v)[8], float* scr, int lane) {
    const int n4 = (lane & 7) * 4;
#pragma unroll
    for (int i = 0; i < 8; ++i) { const int kk = 8 * i + (lane >> 3);
        scr[kk * 33 + n4] = v[i].x; scr[kk * 33 + n4 + 1] = v[i].y; scr[kk * 33 + n4 + 2] = v[i].z; scr[kk * 33 + n4 + 3] = v[i].w; }
    if (d.bias_out) {
#pragma unroll
        for (int m = 0; m < 3; ++m) scr[64 * 33 + m * 64 + lane] = d.shift[(size_t)m * NMODV + lane];
    }
    asm volatile("s_waitcnt lgkmcnt(0)" ::: "memory");
    const int c = lane & 7;
#pragma unroll
    for (int j = 0; j < 4; ++j) { const int nn = (lane >> 3) + 8 * j; const float* s = scr + (8 * c) * 33 + nn;
        v4u o; o.x = pk2(s[0 * 33], s[1 * 33]); o.y = pk2(s[2 * 33], s[3 * 33]); o.z = pk2(s[4 * 33], s[5 * 33]); o.w = pk2(s[6 * 33], s[7 * 33]);
        *(v4u*)(d.WT + (size_t)(d.dst + nn) * d.ldt + d.k0 + 8 * c) = o; }
    if (d.bias_out) {
        const int kh = lane >> 5, nl = lane & 31; float a0 = 0.f, a1 = 0.f, a2 = 0.f;
#pragma unroll 8
        for (int i = 0; i < 32; ++i) { const int kk = kh * 32 + i; const float wv = scr[kk * 33 + nl];
            a0 += wv * scr[64 * 33 + kk]; a1 += wv * scr[64 * 33 + 64 + kk]; a2 += wv * scr[64 * 33 + 128 + kk]; }
        a0 = sum_x32(a0); a1 = sum_x32(a1); a2 = sum_x32(a2);
        if (lane < 32) { float* bo = d.bias_out + (size_t)(d.k0 >> 6) * BIAS_LD + d.dst + nl; bo[0] = a0; bo[BIAS_MS] = a1; bo[2 * BIAS_MS] = a2; }
    }
    asm volatile("s_waitcnt lgkmcnt(0)" ::: "memory");
}
constexpr int CI_DN = 44 * 32, CI_OE = 16 * 32, CI_UQ = 6 * 24, CI_KV = 4 * 32, CI_GU = 16 * 176, CI_IE = 16 * 88, CI_IO = 16 * 56;
__host__ __device__ constexpr int conv_na(int l) { return 2 * CI_DN + CI_OE + ((l & 1) ? CI_UQ + CI_KV : 0); }
__host__ __device__ constexpr int conv_nb(int l) { return 2 * CI_GU + ((l & 1) ? CI_IO : CI_IE); }
__device__ __forceinline__ ConvD conv_desc_a(const Frame& F, int l, int it) {
    int r = it; const int hi = l >> 1;
    if (r < 2 * CI_DN) { const int w = l * 2 + r / CI_DN, q = r % CI_DN, kb = q / 32, nb = q % 32;
        return ConvD{AIN(I_WDN) + (size_t)w * DFF * 1024, WSP(bf16, WS_WD + w * SZ_WD), nullptr, nullptr, 1024, DFF, kb * 64, nb * 32, nb * 32}; } r -= 2 * CI_DN;
    if (r < CI_OE) { const int kb = r / 32, nb = r % 32;
        if (l & 1) return ConvD{AIN(I_WOO) + (size_t)hi * 1024 * 1024, WSP(bf16, WS_WOO + hi * SZ_WO), nullptr, nullptr, 1024, 1024, kb * 64, nb * 32, nb * 32};
        return ConvD{AIN(I_WOE) + (size_t)hi * 1024 * 1024, WSP(bf16, WS_WOE + hi * SZ_WO), nullptr, nullptr, 1024, 1024, kb * 64, nb * 32, nb * 32}; } r -= CI_OE;
    if (r < CI_UQ) { const int kb = r / 24, nb = r % 24;
        return ConvD{AIN(I_WUQ) + (size_t)hi * 384 * 768, WSP(bf16, WS_WUQ + hi * SZ_WUQ), nullptr, nullptr, 768, 384, kb * 64, nb * 32, nb * 32}; } r -= CI_UQ;
    { const int kb = r / 32, nb = r % 32, n0 = nb * 32, h = n0 >> 7, rr = n0 & 127;
        const int dst = (rr < 64 ? 0 : 512) + h * 64 + (rr & 63);
        return ConvD{AIN(I_WUKV) + (size_t)hi * 256 * 1024, WSP(bf16, WS_WKV + hi * SZ_WKV), nullptr, nullptr, 1024, 256, kb * 64, n0, dst}; }
}
__device__ __forceinline__ ConvD conv_desc_b(const Frame& F, int l, int it) {
    int r = it; const int hi = l >> 1; const float* MOD = WSP(float, WS_MOD) + (size_t)l * 3 * NMODV; float* BIAS = WSP(float, WS_BIAS) + (size_t)(l * 3) * 3 * BIAS_MS;
    if (r < 2 * CI_GU) { const int f = r / CI_GU, w = l * 2 + f, q = r % CI_GU, kb = q / 176, nb = q % 176, n0 = nb * 32;
        const int dst = (n0 < DFF) ? ((n0 >> 7) * 256 + (n0 & 127)) : (((n0 - DFF) >> 7) * 256 + 128 + ((n0 - DFF) & 127));
        return ConvD{AIN(I_WGU) + (size_t)w * 1024 * 5632, WSP(bf16, WS_WGU + w * SZ_WGU), MOD + (f == 0 ? 0 : 6) * 1024 + kb * 64, BIAS + (size_t)(f == 0 ? 0 : 2) * 3 * BIAS_MS, 5632, 1024, kb * 64, n0, dst}; } r -= 2 * CI_GU;
    if (l & 1) { const int kb = r / 56, nb = r % 56;
        return ConvD{AIN(I_WIO) + (size_t)hi * 1024 * 1696, WSP(bf16, WS_WIO + hi * SZ_WIO), MOD + 3 * 1024 + kb * 64, BIAS + (size_t)3 * BIAS_MS, 1696, 1024, kb * 64, nb * 32, nb * 32}; }
    { const int kb = r / 88, nb = r % 88;
        return ConvD{AIN(I_WIE) + (size_t)hi * 1024 * 2576, WSP(bf16, WS_WIE + hi * SZ_WIE), MOD + 3 * 1024 + kb * 64, BIAS + (size_t)3 * BIAS_MS, 2576, 1024, kb * 64, nb * 32, nb * 32}; }
}
template <bool LB> __device__ __forceinline__ void conv_run(const Frame& F, int l, int lo, int hi, int gw, int NGW, float* scr) {
    int it = lo + gw; if (it >= hi) return;
    ConvD d = LB ? conv_desc_b(F, l, it) : conv_desc_a(F, l, it);
    f32x4 v[8]; conv_load(d, F.lane, v);
    for (;;) {
        const int itn = it + NGW; const bool more = itn < hi;
        ConvD dn = d; f32x4 vn[8];
        if (more) { dn = LB ? conv_desc_b(F, l, itn) : conv_desc_a(F, l, itn); conv_load(dn, F.lane, vn); }
        conv_proc(d, v, scr, F.lane);
        if (!more) break;
        d = dn; it = itn;
#pragma unroll
        for (int i = 0; i < 8; ++i) v[i] = vn[i];
    }
}
template <int N4> __device__ __forceinline__ void mod_tile(const Frame& F, int l, int tile) {
    constexpr int KG = 504 / N4, NC = 4 * N4, NTW = KG * N4;
    float* sv = (float*)F.lds;
    float* red = (float*)(F.lds + 12288);
    __syncthreads();
    for (int i = F.tid; i < 3072; i += NTHR) { const int r = i >> 10, k = i & 1023; const float c = (r == 0) ? AIN(I_CCTX)[k] : AIN(I_C)[(r - 1) * 1024 + k]; sv[i] = siluf_(c); }
    __syncthreads();
    const int n0 = tile * NC, n4 = F.tid % N4, kg = F.tid / N4;
    if (F.tid < NTW) {
        f32x4 a0 = {0.f, 0.f, 0.f, 0.f}, a1 = a0, a2 = a0;
        const float* wp = AIN(I_WMOD) + (size_t)l * 1024 * NMODV + n0 + 4 * n4;
#pragma unroll 8
        for (int k = kg; k < 1024; k += KG) { const f32x4 w = *(const f32x4*)(wp + (size_t)k * NMODV); a0 += w * sv[k]; a1 += w * sv[1024 + k]; a2 += w * sv[2048 + k]; }
        *(f32x4*)(red + (kg * 3 + 0) * NC + 4 * n4) = a0; *(f32x4*)(red + (kg * 3 + 1) * NC + 4 * n4) = a1; *(f32x4*)(red + (kg * 3 + 2) * NC + 4 * n4) = a2;
    }
    __syncthreads();
    for (int o = F.tid; o < 3 * NC; o += NTHR) { const int r = o / NC, n = o % NC; float s = AIN(I_BMOD)[l * NMODV + n0 + n];
        for (int g = 0; g < KG; ++g) s += red[(g * 3 + r) * NC + n];
        WSP(float, WS_MOD)[(size_t)(l * 3 + r) * NMODV + n0 + n] = s; }
    __syncthreads();
}
__device__ __forceinline__ void bias_reduce(const Frame& F, int l, int kmask, int bgi, int nbg) {
    const float* BP = WSP(float, WS_BIAS); float* BF = WSP(float, WS_BIASF);
    const int gt = bgi * NTHR + F.tid, NT = nbg * NTHR;
    for (int i = gt; i < 3 * 3 * (int)BIAS_LD; i += NT) { const int kind = i / (3 * (int)BIAS_LD), rem = i % (3 * (int)BIAS_LD), m = rem / (int)BIAS_LD, n = rem % (int)BIAS_LD;
        if (!((kmask >> kind) & 1)) continue;
        const float* p = BP + ((size_t)(l * 3 + kind) * 3 + m) * BIAS_MS + n; float b = 0.f;
#pragma unroll
        for (int kb = 0; kb < 16; ++kb) b += p[(size_t)kb * BIAS_LD];
        BF[((size_t)(l * 3 + kind) * 3 + m) * BIAS_LD + n] = b; }
}
__device__ __forceinline__ void background_work(const Frame& F, int l, int win, int bgi, int nbg) {
    F.relane();
    if (nbg <= 0) return;
    if (win == 0) bias_reduce(F, l, 6, bgi, nbg);
    if (l >= 3) return;
    const int ln = l + 1;
    float* scr = (float*)(F.lds + F.wave * 16384);
    const int gw = bgi * NWAVES + F.wave, NGW = nbg * NWAVES;
    if (win == 0) {
        for (int t = bgi; t < 144; t += nbg) mod_tile<16>(F, ln, t);
        conv_run<false>(F, ln, 0, conv_na(ln), gw, NGW, scr);
    } else {
        conv_run<true>(F, ln, 0, conv_nb(ln), gw, NGW, scr);
    }
}
__device__ __forceinline__ void p0_phase(const Frame& F) {
    F.relane();
    for (int t = F.bid; t < 256; t += F.G) mod_tile<9>(F, 0, t);
    {
        float* scr = (float*)(F.lds + F.wave * 16384);
        const int gw = F.bid * NWAVES + F.wave, NGW = F.G * NWAVES;
        conv_run<false>(F, 0, 0, conv_na(0), gw, NGW, scr);
    }
    {
        const size_t gt = (size_t)F.bid * NTHR + F.tid, NT = (size_t)F.G * NTHR;
        for (size_t i = gt; i < 1024 * 16; i += NT) { const int pos = (int)(i >> 4), ax = (int)(i >> 3) & 1, f = (int)i & 7;
            const float freq = exp2f(-(float)f * (13.287712379549449f / 8.0f));
            const float ang = (float)(ax == 0 ? (pos >> 6) : (pos & 63)) * freq;
            float sn, cs; sincosf(ang, &sn, &cs);
            WSP(float, WS_ROPE)[2 * i] = cs; WSP(float, WS_ROPE)[2 * i + 1] = sn; }
    }
}
__device__ __forceinline__ void p1_copy_phase(const Frame& F) {
    F.relane();
    float* scr = (float*)(F.lds + F.wave * 16384);
    const int gw = F.bid * NWAVES + F.wave, NGW = F.G * NWAVES;
    conv_run<true>(F, 0, 0, conv_nb(0), gw, NGW, scr);
}

__device__ __forceinline__ void norm0_phase(const Frame& F) {
    F.relane();
    const int gw = F.bid * NWAVES + F.wave, NGW = F.G * NWAVES;
    bf16* X = WSP(bf16, WS_X); bf16* XA = WSP(bf16, WS_XA); float* SSQ = WSP(float, WS_SSQ);
    const float* g = AIN(I_GNORM); const float* scale = WSP(float, WS_MOD) + 1024;
    for (int row = gw; row < T; row += NGW) {
        const int r = modrow_of_tok(row);
        const f32x4* xr = (const f32x4*)(row < TCTX ? AIN(I_XP) + (size_t)row * D : AIN(I_XS) + (size_t)(row - TCTX) * D) + F.lane;
        f32x4 v[4]; float s = 0.f;
#pragma unroll
        for (int j = 0; j < 4; ++j) { v[j] = xr[64 * j]; s += (v[j].x * v[j].x + v[j].y * v[j].y) + (v[j].z * v[j].z + v[j].w * v[j].w); }
        s = wave_sum(s);
        if (F.lane == 0) *(f32x4*)(SSQ + (size_t)row * 4) = (f32x4){s, 0.f, 0.f, 0.f};
        unsigned long long* o8 = (unsigned long long*)(XA + (size_t)row * D) + F.lane;
        unsigned long long* xo = (unsigned long long*)(X + (size_t)row * D) + F.lane;
#pragma unroll
        for (int j = 0; j < 4; ++j) {
            const f32x4 gg = *((const f32x4*)g + F.lane + 64 * j), sc = *((const f32x4*)(scale + (size_t)r * NMODV) + F.lane + 64 * j);
            const f32x4 o = v[j] * gg * (sc + 1.0f);
            xo[64 * j] = (unsigned long long)pk2(v[j].x, v[j].y) | ((unsigned long long)pk2(v[j].z, v[j].w) << 32);
            o8[64 * j] = (unsigned long long)pk2(o.x, o.y) | ((unsigned long long)pk2(o.z, o.w) << 32);
        }
    }
}
__device__ __forceinline__ void final_phase(const Frame& F) {
    F.relane();
    const int gw = F.bid * NWAVES + F.wave, NGW = F.G * NWAVES;
    const bf16* X = WSP(bf16, WS_X); const float* g = AIN(I_GFIN); float* out = AOUT + OUT_Y;
    for (int row = gw; row < T; row += NGW) {
        const v2u* xr = (const v2u*)(X + (size_t)row * D) + F.lane;
        f32x4 v[4]; float s = 0.f;
#pragma unroll
        for (int j = 0; j < 4; ++j) { const v2u w = xr[64 * j]; v[j] = (f32x4){bflo(w.x), bfhi(w.x), bflo(w.y), bfhi(w.y)}; s += (v[j].x * v[j].x + v[j].y * v[j].y) + (v[j].z * v[j].z + v[j].w * v[j].w); }
        const float rstd = frsq(wave_sum(s) * (1.f / D) + EPS);
        f32x4* o = (f32x4*)(out + (size_t)row * D) + F.lane;
#pragma unroll
        for (int j = 0; j < 4; ++j) o[64 * j] = v[j] * rstd * *((const f32x4*)g + F.lane + 64 * j);
    }
}
constexpr int LDT = 136;
__device__ __forceinline__ bf16x8 ld_frag16(const unsigned char* p) { return *(const bf16x8*)p; }
__device__ __forceinline__ bf16x8 ld_frag8x2(const unsigned char* p0, const unsigned char* p1) {
    const v2u a = *(const v2u*)p0, b = *(const v2u*)p1; v4u v; v.x = a.x; v.y = a.y; v.z = b.x; v.w = b.y; return __builtin_bit_cast(bf16x8, v); }
#define MFMA16(a, b, c) __builtin_amdgcn_mfma_f32_16x16x32_bf16((a), (b), (c), 0, 0, 0)

__device__ __forceinline__ void chunk_info(int c, int& cfirst, int& clast, bool& is_ctx, int& sb) {
    if (c < 64) { cfirst = c & ~1; clast = cfirst + 1; is_ctx = true; sb = c >> 1; }
    else { cfirst = 64 + ((c - 64) & ~7); clast = cfirst + 7; is_ctx = false; sb = (c - 64) >> 3; }
}
struct ConvW { f32x4 w0a, w0b, w1a, w1b, w2a, w2b, ba, bb; };
__device__ __forceinline__ ConvW conv_w(const float* wc, const float* bc, int ch) {
    ConvW W; W.w0a = *(const f32x4*)(wc + ch); W.w0b = *(const f32x4*)(wc + ch + 4); W.w1a = *(const f32x4*)(wc + 1024 + ch); W.w1b = *(const f32x4*)(wc + 1024 + ch + 4);
    W.w2a = *(const f32x4*)(wc + 2048 + ch); W.w2b = *(const f32x4*)(wc + 2048 + ch + 4); W.ba = *(const f32x4*)(bc + ch); W.bb = *(const f32x4*)(bc + ch + 4); return W;
}
__device__ __forceinline__ void conv8(const bf16* PROJ, int t, bool has_prev, bool has_next, int ch, const ConvW& W, float* out) {
    const bf16* p = PROJ + (size_t)t * EVEN_NP + 1536 + ch;
    const v4u z = {0u, 0u, 0u, 0u};
    const v4u c0 = *(const v4u*)p, cm = has_prev ? *(const v4u*)(p - EVEN_NP) : z, cp = has_next ? *(const v4u*)(p + EVEN_NP) : z;
    float x0[8], xm[8], xp[8]; unpack8(c0, x0); unpack8(cm, xm); unpack8(cp, xp);
#pragma unroll
    for (int i = 0; i < 4; ++i) { out[i] = siluf_(W.ba[i] + W.w0a[i] * xm[i] + W.w1a[i] * x0[i] + W.w2a[i] * xp[i]); out[4 + i] = siluf_(W.bb[i] + W.w0b[i] * xm[4 + i] + W.w1b[i] * x0[4 + i] + W.w2b[i] * xp[4 + i]); }
}
__device__ __forceinline__ void ssd_tables(const Frame& F, int ei, int t0, float* dtl, float* cml) {
    const bf16* PROJ = WSP(bf16, WS_PROJ);
    if (F.tid < 256) { const int j = F.tid >> 1, dir = F.tid & 1;
        const v4u raw = *(const v4u*)(PROJ + (size_t)(t0 + j) * EVEN_NP + 2560 + 8 * dir); float x[8]; unpack8(raw, x);
#pragma unroll
        for (int h = 0; h < 8; ++h) dtl[(dir * 8 + h) * 128 + j] = softplusf_(x[h] + AIN(I_DTB)[ei * 16 + dir * 8 + h]); }
    __syncthreads();
#pragma unroll
    for (int k = 0; k < 2; ++k) {
        const int row = 2 * F.wave + k, rev = row >> 3;
        const float a = -__expf(AIN(I_ALOG)[ei * 16 + row]);
        const int i0 = rev ? 127 - 2 * F.lane : 2 * F.lane, i1 = rev ? 126 - 2 * F.lane : 2 * F.lane + 1;
        const float v0 = dtl[row * 128 + i0] * a, v1 = dtl[row * 128 + i1] * a;
        float x = v0 + v1;
#pragma unroll
        for (int d = 1; d < 64; d <<= 1) { const float t = __builtin_bit_cast(float, __builtin_amdgcn_ds_bpermute((F.lane - d) * 4, __builtin_bit_cast(int, x))); x += (F.lane >= d) ? t : 0.f; }
        const float ex = x - (v0 + v1);
        cml[row * 128 + i0] = ex + v0; cml[row * 128 + i1] = ex + (v0 + v1);
    }
    __syncthreads();
}
constexpr int TILE128 = 34816, TILE64 = 17408;
constexpr int S1_BT = 0, S1_B = TILE128, S1_C = 2 * TILE128, S1_XT = TILE128  , S1_DT = 3 * TILE128, S1_CUM = S1_DT + 8192;
constexpr int S2_XT = 0  , S2_H = 2 * TILE64  , S2_DT = 6 * TILE64, S2_CUM = S2_DT + 8192, S2_SSQ = S2_CUM + 8192;

__device__ __forceinline__ void ssd_state_item(const Frame& F, int ei, int c, int g) {
    F.relane();
    const bf16* PROJ = WSP(bf16, WS_PROJ);
    const float* wc = AIN(I_WCS) + (size_t)ei * 3 * 1024; const float* bc = AIN(I_BCS) + (size_t)ei * 1024;
    int cfirst, clast, sb; bool is_ctx; chunk_info(c, cfirst, clast, is_ctx, sb);
    const int t0 = c * 128, len = is_ctx ? 256 : 1024, pos0 = (c - cfirst) * 128;
    bf16* BT = (bf16*)(F.lds + S1_BT); bf16* Bl = (bf16*)(F.lds + S1_B); bf16* Cl = (bf16*)(F.lds + S1_C); bf16* XT4 = (bf16*)(F.lds + S1_XT);
    float* dtl = (float*)(F.lds + S1_DT); float* cml = (float*)(F.lds + S1_CUM);
    bf16* ST = WSP(bf16, WS_ST); float* DEC = WSP(float, WS_DEC);
    bf16* CC = WSP(bf16, WS_CC); bf16* CBM = WSP(bf16, WS_CBM); bf16* XCT = WSP(bf16, WS_XCT);
    const int r = F.lane & 15, q = F.lane >> 4, w = F.wave;
    __syncthreads();
    ssd_tables(F, ei, t0, dtl, cml);
    { const ConvW W = conv_w(wc, bc, 512 + g * 128 + (F.tid & 15) * 8);
#pragma unroll 4
    for (int e = F.tid; e < 128 * 16; e += NTHR) { const int j = e >> 4, n8 = (e & 15) * 8; float o[8];
        conv8(PROJ, t0 + j, pos0 + j > 0, pos0 + j < len - 1, 512 + g * 128 + n8, W, o);
        const v4u pk = pack8(o);
        *(v4u*)((unsigned char*)Bl + (j * LDT + n8) * 2) = pk;
#pragma unroll
        for (int i = 0; i < 8; ++i) BT[(n8 + i) * LDT + j] = (bf16)f2bf1(o[i]); } }
    { const ConvW W = conv_w(wc, bc, 768 + g * 128 + (F.tid & 15) * 8);
#pragma unroll 4
    for (int e = F.tid; e < 128 * 16; e += NTHR) { const int j = e >> 4, n8 = (e & 15) * 8; float o[8];
        conv8(PROJ, t0 + j, pos0 + j > 0, pos0 + j < len - 1, 768 + g * 128 + n8, W, o);
        const v4u pk = pack8(o);
        *(v4u*)((unsigned char*)Cl + (j * LDT + n8) * 2) = pk;
        *(v4u*)(CC + (size_t)(t0 + j) * 256 + g * 128 + n8) = pk; } }
    __syncthreads();
    {
        bf16x8 cf[4];
#pragma unroll
        for (int ks = 0; ks < 4; ++ks) cf[ks] = ld_frag16((const unsigned char*)Cl + ((16 * w + r) * LDT + 32 * ks + 8 * q) * 2);
        bf16* dst = CBM + ((size_t)(c * 2 + g) * 128 + 16 * w + r) * 128 + 4 * q;
#pragma unroll
        for (int jt = 0; jt < 8; ++jt) { f32x4 a = {0.f, 0.f, 0.f, 0.f};
#pragma unroll
            for (int ks = 0; ks < 4; ++ks) a = MFMA16(ld_frag16((const unsigned char*)Bl + ((16 * jt + r) * LDT + 32 * ks + 8 * q) * 2), cf[ks], a);
            v2u o; o.x = pk2(a[0], a[1]); o.y = pk2(a[2], a[3]); *(v2u*)(dst + 16 * jt) = o; }
    }
    __syncthreads();
    { const ConvW W = conv_w(wc, bc, g * 256 + (F.tid & 31) * 8);
#pragma unroll 4
    for (int e = F.tid; e < 128 * 32; e += NTHR) { const int j = e >> 5, p8 = (e & 31) * 8; float o[8];
        conv8(PROJ, t0 + j, pos0 + j > 0, pos0 + j < len - 1, g * 256 + p8, W, o);
#pragma unroll
        for (int i = 0; i < 8; ++i) XT4[(p8 + i) * LDT + j] = (bf16)f2bf1(o[i]); } }
    __syncthreads();
#pragma unroll 4
    for (int e = F.tid; e < 256 * 16; e += NTHR) { const int row = e >> 4, ch = (e & 15) * 8;
        *(v4u*)(XCT + ((size_t)(c * 8 + 4 * g) * 64 + row) * 128 + ch) = *(const v4u*)((const unsigned char*)XT4 + (row * LDT + ch) * 2); }
#pragma unroll 2
    for (int hd = 0; hd < 8; ++hd) {
        const int hh = hd >> 1, dir = hd & 1, h = 4 * g + hh;
        const float* dth = dtl + (dir * 8 + h) * 128; const float* cmh = cml + (dir * 8 + h) * 128;
        const float cend = dir == 0 ? cmh[127] : cmh[0];
        const bf16* XT = XT4 + hh * 64 * LDT;
        f32x4 acc[4];
#pragma unroll
        for (int pt = 0; pt < 4; ++pt) acc[pt] = (f32x4){0.f, 0.f, 0.f, 0.f};
#pragma unroll
        for (int ks = 0; ks < 4; ++ks) {
            const int j0 = 32 * ks + 8 * q;
            const v4u braw = *(const v4u*)((const unsigned char*)BT + ((16 * w + r) * LDT + j0) * 2); float bv[8]; unpack8(braw, bv);
            const f32x4 d0 = *(const f32x4*)(dth + j0), d1 = *(const f32x4*)(dth + j0 + 4), c0 = *(const f32x4*)(cmh + j0), c1 = *(const f32x4*)(cmh + j0 + 4);
#pragma unroll
            for (int i = 0; i < 4; ++i) { bv[i] *= d0[i] * __expf(cend - c0[i]); bv[4 + i] *= d1[i] * __expf(cend - c1[i]); }
            const bf16x8 af = __builtin_bit_cast(bf16x8, pack8(bv));
#pragma unroll
            for (int pt = 0; pt < 4; ++pt) { const bf16x8 bf = ld_frag16((const unsigned char*)XT + ((16 * pt + r) * LDT + j0) * 2); acc[pt] = MFMA16(af, bf, acc[pt]); }
        }
        bf16* dst = ST + ((size_t)(c * 8 + h) * 2 + dir) * 8192;
#pragma unroll
        for (int pt = 0; pt < 4; ++pt) { v2u o; o.x = pk2(acc[pt][0], acc[pt][1]); o.y = pk2(acc[pt][2], acc[pt][3]); *(v2u*)(dst + (16 * pt + r) * 128 + 16 * w + 4 * q) = o; }
        if (F.tid == 0) DEC[(c * 8 + h) * 2 + dir] = __expf(cend);
    }
}

__device__ __forceinline__ void gmlp_item(const Frame& F, int ei, int c, int g) {
    F.relane();
    const bf16* PROJ = WSP(bf16, WS_PROJ); bf16* YMIX = WSP(bf16, WS_YMIX);
    const int t0 = c * 128;
    float* rs = (float*)F.lds; bf16* Vt = (bf16*)(F.lds + 1024); bf16* Wl = (bf16*)(F.lds + 1024 + 34816);
    const float* gv = AIN(I_GV) + ei * 512;
    __syncthreads();
#pragma unroll 1
    for (int kb = 0; kb < 16; kb += 8) {
        v4u raw[8];
#pragma unroll
        for (int k = 0; k < 8; ++k) raw[k] = *(const v4u*)(PROJ + (size_t)(t0 + F.wave * 16 + kb + k) * EVEN_NP + 512 + 8 * F.lane);
#pragma unroll
        for (int k = 0; k < 8; ++k) { float x[8]; unpack8(raw[k], x); float s = 0.f;
#pragma unroll
            for (int i = 0; i < 8; ++i) { const float y = gelu_tanh(x[i]); s += y * y; }
            s = wave_sum(s); if (F.lane == 0) rs[F.wave * 16 + kb + k] = frsq(s * (1.f / 512.f) + EPS); }
    }
    { const float* ws_ = AIN(I_WSP) + ((size_t)ei * 4 + g) * 16384;
#pragma unroll
      for (int e = F.tid; e < 4096; e += NTHR) { const int i = e >> 5, j4 = (e & 31) * 4; const f32x4 v = *(const f32x4*)(ws_ + i * 128 + j4);
          v2u o; o.x = pk2(v.x, v.y); o.y = pk2(v.z, v.w); *(v2u*)((unsigned char*)Wl + (i * LDT + j4) * 2) = o; } }
    __syncthreads();
    { const int d8 = (F.tid & 15) * 8; v4u raw[4];
#pragma unroll
      for (int k = 0; k < 4; ++k) raw[k] = *(const v4u*)(PROJ + (size_t)(t0 + (F.tid >> 4) + 32 * k) * EVEN_NP + 512 + g * 128 + d8);
#pragma unroll
      for (int k = 0; k < 4; ++k) { const int j = (F.tid >> 4) + 32 * k; float x[8]; unpack8(raw[k], x); const float rj = rs[j];
#pragma unroll
          for (int i = 0; i < 8; ++i) Vt[(d8 + i) * LDT + j] = (bf16)f2bf1(gelu_tanh(x[i]) * rj * gv[g * 128 + d8 + i]); } }
    __syncthreads();
    const int r = F.lane & 15, q = F.lane >> 4, w = F.wave;
    bf16x8 af[4];
#pragma unroll
    for (int ks = 0; ks < 4; ++ks) af[ks] = ld_frag16((const unsigned char*)Vt + ((16 * w + r) * LDT + 32 * ks + 8 * q) * 2);
    const float* bs = AIN(I_BSP) + ((size_t)ei * 4 + g) * 128;
    v2u uraw[8];
#pragma unroll
    for (int it = 0; it < 8; ++it) uraw[it] = *(const v2u*)(PROJ + (size_t)(t0 + 16 * it + r) * EVEN_NP + g * 128 + 16 * w + 4 * q);
#pragma unroll
    for (int it = 0; it < 8; ++it) {
        f32x4 acc = {0.f, 0.f, 0.f, 0.f};
#pragma unroll
        for (int ks = 0; ks < 4; ++ks) acc = MFMA16(af[ks], ld_frag16((const unsigned char*)Wl + ((16 * it + r) * LDT + 32 * ks + 8 * q) * 2), acc);
        const int i = 16 * it + r, col = g * 128 + 16 * w + 4 * q; const float b = bs[i];
        const float u0 = gelu_tanh(bflo(uraw[it].x)), u1 = gelu_tanh(bfhi(uraw[it].x)), u2 = gelu_tanh(bflo(uraw[it].y)), u3 = gelu_tanh(bfhi(uraw[it].y));
        v2u o; o.x = pk2(u0 * (acc[0] + b), u1 * (acc[1] + b)); o.y = pk2(u2 * (acc[2] + b), u3 * (acc[3] + b));
        *(v2u*)(YMIX + (size_t)(t0 + i) * D + col) = o;
    }
}

__device__ __forceinline__ f32x4 ld_bf4(const bf16* p) { const v2u w = *(const v2u*)p; return (f32x4){bflo(w.x), bfhi(w.x), bflo(w.y), bfhi(w.y)}; }
__device__ __forceinline__ void ssd_scan_phase(const Frame& F, int ei) {
    F.relane();
    const bf16* ST = WSP(bf16, WS_ST); const float* DEC = WSP(float, WS_DEC); bf16* HIN = WSP(bf16, WS_HIN);
    const size_t gt = (size_t)F.bid * NTHR + F.tid, NT = (size_t)F.G * NTHR;
    constexpr size_t N_SMP = (size_t)2 * 8 * 2 * 2048, N_CTX = (size_t)32 * 8 * 2 * 2048;
    for (size_t it = gt; it < N_SMP + N_CTX; it += NT) {
        if (it < N_SMP) {
            const int e = (int)(it & 2047) * 4, dir = (int)(it >> 11) & 1, h = (int)(it >> 12) & 7, b = (int)(it >> 15);
            const int c0 = 64 + 8 * b;
            f32x4 st[8]; float dc[8];
#pragma unroll
            for (int k = 0; k < 8; ++k) { const int cc = dir == 0 ? c0 + k : c0 + 7 - k; st[k] = ld_bf4(ST + ((size_t)(cc * 8 + h) * 2 + dir) * 8192 + e); dc[k] = DEC[(cc * 8 + h) * 2 + dir]; }
            f32x4 v = *(const f32x4*)(AIN(I_SSD) + ((size_t)((b * 2 + ei) * 2 + dir) * 8 + h) * 8192 + e);
#pragma unroll
            for (int k = 0; k < 8; ++k) { const int cc = dir == 0 ? c0 + k : c0 + 7 - k;
                v2u o; o.x = pk2(v.x, v.y); o.y = pk2(v.z, v.w); *(v2u*)(HIN + ((size_t)(cc * 8 + h) * 2 + dir) * 8192 + e) = o;
                v = v * dc[k] + st[k]; }
        } else {
            const size_t i2 = it - N_SMP;
            const int e = (int)(i2 & 2047) * 4, dir = (int)(i2 >> 11) & 1, h = (int)(i2 >> 12) & 7, s = (int)(i2 >> 15);
            const int ca = dir == 0 ? 2 * s : 2 * s + 1, cb = dir == 0 ? 2 * s + 1 : 2 * s;
            const f32x4 sa = ld_bf4(ST + ((size_t)(ca * 8 + h) * 2 + dir) * 8192 + e), sb_ = ld_bf4(ST + ((size_t)(cb * 8 + h) * 2 + dir) * 8192 + e);
            const float db = DEC[(cb * 8 + h) * 2 + dir];
            *(f32x4*)(AOUT + OUT_SSD + ((size_t)((s * 2 + ei) * 2 + dir) * 8 + h) * 8192 + e) = sa * db + sb_;
        }
    }
}

__device__ __forceinline__ void ssd_out_item(const Frame& F, int ei, int c, int th) {
    F.relane();
    const bf16* PROJ = WSP(bf16, WS_PROJ); bf16* YMIX = WSP(bf16, WS_YMIX);
    const bf16* CC = WSP(bf16, WS_CC); const bf16* CBM = WSP(bf16, WS_CBM); const bf16* XCT = WSP(bf16, WS_XCT); const bf16* HIN = WSP(bf16, WS_HIN); const bf16* ST = WSP(bf16, WS_ST);
    const int t0 = c * 128;
    float* dtl = (float*)(F.lds + S2_DT); float* cml = (float*)(F.lds + S2_CUM); float* ssqx = (float*)(F.lds + S2_SSQ);
    const int r = F.lane & 15, q = F.lane >> 4, w = F.wave, it = w & 3, g = w >> 2;
    const int irow = 64 * th + 16 * it + r;
    const bool hzero[2] = {c < 64 && (c & 1) == 0, c < 64 && (c & 1) == 1};
    __syncthreads();
    ssd_tables(F, ei, t0, dtl, cml);
    v2u cbp[8]; bf16x8 cf[4];
    {
        const bf16* cbr = CBM + ((size_t)(c * 2 + g) * 128 + irow) * 128 + 4 * q;
#pragma unroll
        for (int jt = 0; jt < 8; ++jt) cbp[jt] = *(const v2u*)(cbr + 16 * jt);
#pragma unroll
        for (int kn = 0; kn < 4; ++kn) cf[kn] = *(const bf16x8*)(CC + (size_t)(t0 + irow) * 256 + g * 128 + 32 * kn + 8 * q);
    }
    float ssq = 0.f;
    v4u pre[12];
    const int goff = (F.tid >> 4) * 128 + (F.tid & 15) * 8, loff = ((F.tid >> 4) * LDT + (F.tid & 15) * 8) * 2;
#define E2_SRC(m_, hh_) ((m_) < 2 ? XCT + (size_t)(c * 8 + 4 * (m_) + (hh_)) * 8192 : \
        (c < 64 ? ST + ((size_t)((((m_) - 2) & 1) == 0 ? c - 1 : c + 1) * 8 + 4 * (((m_) - 2) >> 1) + (hh_)) * 16384 + (((m_) - 2) & 1) * 8192 \
                : HIN + ((size_t)c * 8 + 4 * (((m_) - 2) >> 1) + (hh_)) * 16384 + (((m_) - 2) & 1) * 8192))
#define E2_FETCH(hh_) do { _Pragma("unroll") for (int m = 0; m < 6; ++m) { if (m >= 2 && hzero[(m - 2) & 1]) continue; const bf16* sp = E2_SRC(m, hh_) + goff; \
            pre[2 * m] = *(const v4u*)sp; pre[2 * m + 1] = *(const v4u*)(sp + 32 * 128); } } while (0)
    E2_FETCH(0);
#pragma unroll 1
    for (int hh = 0; hh < 4; ++hh) {
        __syncthreads();
#pragma unroll
        for (int m = 0; m < 6; ++m) { if (m >= 2 && hzero[(m - 2) & 1]) continue;
            unsigned char* dp = F.lds + (m < 2 ? S2_XT + m * TILE64 : S2_H + (m - 2) * TILE64) + loff;
            *(v4u*)dp = pre[2 * m]; *(v4u*)(dp + 32 * LDT * 2) = pre[2 * m + 1]; }
        __syncthreads();
        if (hh < 3) E2_FETCH(hh + 1);
        v2u zr4[4];
#pragma unroll
        for (int pt = 0; pt < 4; ++pt) zr4[pt] = *(const v2u*)(PROJ + (size_t)(t0 + irow) * EVEN_NP + 1024 + (4 * g + hh) * 64 + 16 * pt + 4 * q);
        const int h = 4 * g + hh;
        const bf16* XT = (const bf16*)(F.lds + S2_XT + g * TILE64);
        f32x4 yacc[4];
#pragma unroll
        for (int pt = 0; pt < 4; ++pt) yacc[pt] = (f32x4){0.f, 0.f, 0.f, 0.f};
        const float* dt0 = dtl + h * 128; const float* cm0 = cml + h * 128; const float* dt1 = dtl + (8 + h) * 128; const float* cm1 = cml + (8 + h) * 128;
        const float ci0 = cm0[irow], ci1 = cm1[irow];
#pragma unroll
        for (int ks = 0; ks < 4; ++ks) {
            float sl0[8], sl1[8];
#pragma unroll
            for (int hf = 0; hf < 2; ++hf) {
                const int j0 = 32 * ks + 16 * hf + 4 * q; const v2u cw = cbp[2 * ks + hf];
                const f32x4 c0v = *(const f32x4*)(cm0 + j0), d0v = *(const f32x4*)(dt0 + j0), c1v = *(const f32x4*)(cm1 + j0), d1v = *(const f32x4*)(dt1 + j0);
                const float cbv[4] = {bflo(cw.x), bfhi(cw.x), bflo(cw.y), bfhi(cw.y)};
#pragma unroll
                for (int e = 0; e < 4; ++e) { const int j = j0 + e;
                    const float e0 = __expf(ci0 - c0v[e]) * d0v[e] * cbv[e], e1 = __expf(ci1 - c1v[e]) * d1v[e] * cbv[e];
                    sl0[4 * hf + e] = (j <= irow) ? e0 : 0.f; sl1[4 * hf + e] = (j >= irow) ? e1 : 0.f; }
            }
            const bf16x8 sf0 = __builtin_bit_cast(bf16x8, pack8(sl0)), sf1 = __builtin_bit_cast(bf16x8, pack8(sl1));
#pragma unroll
            for (int pt = 0; pt < 4; ++pt) { const unsigned char* xr = (const unsigned char*)XT + ((16 * pt + r) * LDT + 32 * ks + 4 * q) * 2;
                const bf16x8 xf = ld_frag8x2(xr, xr + 32);
                yacc[pt] = MFMA16(xf, sf0, yacc[pt]); yacc[pt] = MFMA16(xf, sf1, yacc[pt]); }
        }
#pragma unroll
        for (int dir = 0; dir < 2; ++dir) {
            if (hzero[dir]) continue;
            const unsigned char* Hl = F.lds + S2_H + (g * 2 + dir) * TILE64;
            const float ei_ = __expf(dir == 0 ? ci0 : ci1);
#pragma unroll
            for (int pt = 0; pt < 4; ++pt) { f32x4 t = {0.f, 0.f, 0.f, 0.f};
#pragma unroll
                for (int kn = 0; kn < 4; ++kn) t = MFMA16(ld_frag16(Hl + ((16 * pt + r) * LDT + 32 * kn + 8 * q) * 2), cf[kn], t);
                yacc[pt] += t * ei_; }
        }
        const float dsk = AIN(I_DSK)[ei * 16 + h] + AIN(I_DSK)[ei * 16 + 8 + h];
#pragma unroll
        for (int pt = 0; pt < 4; ++pt) {
            const int p0 = 16 * pt + 4 * q;
            const v2u zr = zr4[pt];
            const float z0 = bflo(zr.x), z1 = bfhi(zr.x), z2 = bflo(zr.y), z3 = bfhi(zr.y);
            float y0 = yacc[pt][0] + dsk * bf1(XT[(p0 + 0) * LDT + irow]), y1 = yacc[pt][1] + dsk * bf1(XT[(p0 + 1) * LDT + irow]),
                  y2 = yacc[pt][2] + dsk * bf1(XT[(p0 + 2) * LDT + irow]), y3 = yacc[pt][3] + dsk * bf1(XT[(p0 + 3) * LDT + irow]);
            y0 *= siluf_(z0); y1 *= siluf_(z1); y2 *= siluf_(z2); y3 *= siluf_(z3);
            ssq += (y0 * y0 + y1 * y1) + (y2 * y2 + y3 * y3);
            v2u o; o.x = pk2(y0, y1); o.y = pk2(y2, y3);
            *(v2u*)(YMIX + (size_t)(t0 + irow) * D + 512 + h * 64 + p0) = o;
        }
    }
#undef E2_FETCH
#undef E2_SRC
    ssq += xlane<16>(ssq); ssq = sum_x32(ssq);
    if (q == 0) ssqx[w * 16 + r] = ssq;
    __syncthreads();
    ssq += ssqx[(w ^ 4) * 16 + r];
    const float rstd = frsq(ssq * (1.f / 512.f) + EPS);
    const float* go = AIN(I_GSO) + ei * 512;
#pragma unroll 1
    for (int hh = 0; hh < 4; ++hh)
#pragma unroll
        for (int pt = 0; pt < 4; ++pt) {
            const int col = (4 * g + hh) * 64 + 16 * pt + 4 * q;
            v2u* p = (v2u*)(YMIX + (size_t)(t0 + irow) * D + 512 + col); const v2u v = *p; const f32x4 gg = *(const f32x4*)(go + col);
            v2u o; o.x = pk2(bflo(v.x) * rstd * gg.x, bfhi(v.x) * rstd * gg.y); o.y = pk2(bflo(v.y) * rstd * gg.z, bfhi(v.y) * rstd * gg.w);
            *p = o;
        }
}

__device__ __forceinline__ void even_phase1(const Frame& F, int ei) {
    if (F.G >= 256) {
        if (F.bid < 160) ssd_state_item(F, ei, F.bid >> 1, F.bid & 1);
        else for (int it = F.bid - 160; it < 192; it += F.G - 160) gmlp_item(F, ei, it >> 2, it & 3);
        return;
    }
    for (int it = F.bid; it < 160 + 320; it += F.G) {
        if (it < 160) ssd_state_item(F, ei, it >> 1, it & 1);
        else gmlp_item(F, ei, (it - 160) >> 2, (it - 160) & 3);
    }
}
__device__ __forceinline__ void even_phase2(const Frame& F, int ei) {
    if (F.G >= 256) {
        if (F.bid < 160) ssd_out_item(F, ei, F.bid >> 1, F.bid & 1);
        else for (int it = 192 + F.bid - 160; it < 320; it += F.G - 160) gmlp_item(F, ei, it >> 2, it & 3);
        return;
    }
    for (int it = F.bid; it < 160; it += F.G) ssd_out_item(F, ei, it >> 1, it & 1);
}
constexpr int CV_T = 43, CV_W = CV_T + 30, CV_ITEMS = 32 * 6 + 2 * 24;
__device__ __forceinline__ void conv_item(const Frame& F, int oi, int item) {
    F.relane();
    const bf16* PROJ = WSP(bf16, WS_PROJ); bf16* YMIX = WSP(bf16, WS_YMIX);
    int sbeg, slen, tile; if (item < 192) { sbeg = (item / 6) * 256; slen = 256; tile = item % 6; } else { const int i2 = item - 192; sbeg = TCTX + (i2 / 24) * 1024; slen = 1024; tile = i2 % 24; }
    const int send = sbeg + slen, t0 = sbeg + tile * CV_T, nt = (slen - tile * CV_T) < CV_T ? (slen - tile * CV_T) : CV_T;
    float* Dl = (float*)F.lds;
    const int c = F.tid;
    float glu[CV_W];
#pragma unroll
    for (int w0 = 0; w0 < CV_W; w0 += 8) {
        bf16 av[8], gv[8];
#pragma unroll
        for (int i = 0; i < 8; ++i) if (w0 + i < CV_W) { int t = t0 - 15 + w0 + i; t = t < sbeg ? sbeg : (t >= send ? send - 1 : t);
            av[i] = PROJ[(size_t)t * ODD_NP + 672 + c]; gv[i] = PROJ[(size_t)t * ODD_NP + 1184 + c]; }
#pragma unroll
        for (int i = 0; i < 8; ++i) if (w0 + i < CV_W) { const int t = t0 - 15 + w0 + i; const float v = bf1(av[i]) * sigmoidf_(bf1(gv[i])); glu[w0 + i] = (t >= sbeg && t < send) ? v : 0.f; }
    }
    float wk[31];
#pragma unroll
    for (int k = 0; k < 31; ++k) wk[k] = AIN(I_WDW)[((size_t)oi * 31 + k) * 512 + c];
    const float bd = AIN(I_BDW)[oi * 512 + c];
    __syncthreads();
#pragma unroll
    for (int tt = 0; tt < CV_T; ++tt) { float s = bd;
#pragma unroll
        for (int k = 0; k < 31; ++k) s += wk[k] * glu[tt + k];
        Dl[tt * 512 + c] = s; }
    __syncthreads();
    const float* gl = AIN(I_GLN) + oi * 512; const float* bl = AIN(I_BLN) + oi * 512;
    const f32x4 g0 = *(const f32x4*)(gl + 8 * F.lane), g1 = *(const f32x4*)(gl + 8 * F.lane + 4), b0 = *(const f32x4*)(bl + 8 * F.lane), b1 = *(const f32x4*)(bl + 8 * F.lane + 4);
#pragma unroll 1
    for (int tt = F.wave; tt < nt; tt += NWAVES) {
        const f32x4 v0 = *(const f32x4*)(Dl + tt * 512 + 8 * F.lane), v1 = *(const f32x4*)(Dl + tt * 512 + 8 * F.lane + 4);
        float s = (v0.x + v0.y) + (v0.z + v0.w) + (v1.x + v1.y) + (v1.z + v1.w);
        const float mean = wave_sum(s) * (1.f / 512.f);
        const f32x4 d0 = v0 - mean, d1 = v1 - mean;
        float s2 = (d0.x * d0.x + d0.y * d0.y) + (d0.z * d0.z + d0.w * d0.w) + (d1.x * d1.x + d1.y * d1.y) + (d1.z * d1.z + d1.w * d1.w);
        const float rstd = frsq(wave_sum(s2) * (1.f / 512.f) + EPS);
        float o[8];
#pragma unroll
        for (int i = 0; i < 4; ++i) { o[i] = siluf_(d0[i] * rstd * g0[i] + b0[i]); o[4 + i] = siluf_(d1[i] * rstd * g1[i] + b1[i]); }
        *(v4u*)(YMIX + (size_t)(t0 + tt) * D + 512 + 8 * F.lane) = pack8(o);
    }
}
__device__ __forceinline__ void odd_rows(const Frame& F, int oi) {
    F.relane();
    const bf16* PROJ = WSP(bf16, WS_PROJ);
    bf16* QA = WSP(bf16, WS_QA); bf16* CKVA = WSP(bf16, WS_CKVA); bf16* KR = WSP(bf16, WS_KR); const float* ROPE = WSP(float, WS_ROPE);
    const int gw = F.bid * NWAVES + F.wave, NGW = F.G * NWAVES, lane = F.lane;
    for (int row = T + gw; row < TP; row += NGW) {
        const int b = (row - T) >> 8, j = (row - T) & 255;
        const f32x4 v = *(const f32x4*)(AIN(I_CCKV) + ((size_t)(b * 2 + oi) * 256 + j) * 256 + 4 * lane);
        v2u o; o.x = pk2(v.x, v.y); o.y = pk2(v.z, v.w); *(v2u*)(CKVA + (size_t)row * 256 + 4 * lane) = o;
        if (lane < 32) KR[(size_t)row * 32 + lane] = (bf16)f2bf1(AIN(I_CKR)[((size_t)(b * 2 + oi) * 256 + j) * 32 + lane]);
    }
    const f32x4 gkv = *(const f32x4*)(AIN(I_GCKV) + oi * 256 + 4 * lane);
    float gq[6];
#pragma unroll
    for (int k = 0; k < 3; ++k) { gq[2 * k] = AIN(I_GCQ)[oi * 384 + 128 * k + 2 * lane]; gq[2 * k + 1] = AIN(I_GCQ)[oi * 384 + 128 * k + 2 * lane + 1]; }
    unsigned qw[3], nqw[3]; v2u kw, nkw; bf16 krw, nkrw;
    int row = gw;
    if (row < T) { const bf16* pr = PROJ + (size_t)row * ODD_NP;
#pragma unroll
        for (int k = 0; k < 3; ++k) nqw[k] = *(const unsigned*)(pr + 128 * k + 2 * lane);
        nkw = *(const v2u*)(pr + 384 + 4 * lane); nkrw = pr[640 + (lane & 31)]; }
#pragma unroll 1
    for (; row < T; row += NGW) {
#pragma unroll
        for (int k = 0; k < 3; ++k) qw[k] = nqw[k];
        kw = nkw; krw = nkrw;
        if (row + NGW < T) { const bf16* pr = PROJ + (size_t)(row + NGW) * ODD_NP;
#pragma unroll
            for (int k = 0; k < 3; ++k) nqw[k] = *(const unsigned*)(pr + 128 * k + 2 * lane);
            nkw = *(const v2u*)(pr + 384 + 4 * lane); nkrw = pr[640 + (lane & 31)]; }
        float qv[6]; float s = 0.f;
#pragma unroll
        for (int k = 0; k < 3; ++k) { qv[2 * k] = bflo(qw[k]); qv[2 * k + 1] = bfhi(qw[k]); s += qv[2 * k] * qv[2 * k] + qv[2 * k + 1] * qv[2 * k + 1]; }
        f32x4 kv = {bflo(kw.x), bfhi(kw.x), bflo(kw.y), bfhi(kw.y)};
        float s2 = (kv.x * kv.x + kv.y * kv.y) + (kv.z * kv.z + kv.w * kv.w);
        s += xlane<1>(s); s2 += xlane<1>(s2); s += xlane<2>(s); s2 += xlane<2>(s2); s += xlane<4>(s); s2 += xlane<4>(s2); s += xlane<8>(s); s2 += xlane<8>(s2); s += xlane<16>(s); s2 += xlane<16>(s2);
        s = sum_x32(s); s2 = sum_x32(s2);
        const float rq = frsq(s * (1.f / 384.f) + EPS), rk = frsq(s2 * (1.f / 256.f) + EPS);
#pragma unroll
        for (int k = 0; k < 3; ++k) *(unsigned*)(QA + (size_t)row * 384 + 128 * k + 2 * lane) = pk2(qv[2 * k] * rq * gq[2 * k], qv[2 * k + 1] * rq * gq[2 * k + 1]);
        kv = kv * rk * gkv;
        { v2u o; o.x = pk2(kv.x, kv.y); o.y = pk2(kv.z, kv.w); *(v2u*)(CKVA + (size_t)row * 256 + 4 * lane) = o; }
        float kr = bf1(krw);
        if (row < TCTX) {
            const int b = row >> 8, pos = row & 255;
            *(f32x4*)(AOUT + OUT_CKV + ((size_t)(b * 2 + oi) * 256 + pos) * 256 + 4 * lane) = kv;
            if (lane < 32) AOUT[OUT_KR + ((size_t)(b * 2 + oi) * 256 + pos) * 32 + lane] = kr;
        } else {
            const int pos = (row - TCTX) & 1023, e = lane & 31, ax = e >> 4, half = (e >> 3) & 1, f = e & 7;
            const float other = xlane<8>(kr);
            const float cs = ROPE[((pos * 2 + ax) * 8 + f) * 2], sn = ROPE[((pos * 2 + ax) * 8 + f) * 2 + 1];
            kr = half == 0 ? (kr * cs - other * sn) : (other * sn + kr * cs);
        }
        if (lane < 32) KR[(size_t)row * 32 + lane] = (bf16)f2bf1(kr);
    }
}
__device__ __forceinline__ void odd_phase1(const Frame& F, int oi) {
    for (int it = F.bid; it < CV_ITEMS; it += F.G) conv_item(F, oi, it);
    odd_rows(F, oi);
}

constexpr int AT_KROW = 208, AT_VROW = 272, AT_KBYTES = 128 * AT_KROW, AT_BUF = 45056;
struct AttnPre { v4u k[3]; v4u v[2]; };
__device__ __forceinline__ void attn_load_tile(const Frame& F, int h, int krow0, AttnPre& P) {
    const bf16* KN = WSP(bf16, WS_KN); const bf16* KR = WSP(bf16, WS_KR); const bf16* VT = WSP(bf16, WS_VT);
#pragma unroll
    for (int i = 0; i < 3; ++i) { const int e = F.tid + NTHR * i, key = e / 12, c = e % 12; const size_t kr = (size_t)(krow0 + key);
        P.k[i] = c < 8 ? *(const v4u*)(KN + kr * 512 + h * 64 + c * 8) : *(const v4u*)(KR + kr * 32 + (c - 8) * 8); }
#pragma unroll
    for (int i = 0; i < 2; ++i) { const int e = F.tid + NTHR * i, row = e >> 4, c = e & 15;
        P.v[i] = *(const v4u*)(VT + (size_t)(h * 64 + row) * TP + krow0 + c * 8); }
}
__device__ __forceinline__ void attn_store_tile(const Frame& F, unsigned char* buf, const AttnPre& P) {
#pragma unroll
    for (int i = 0; i < 3; ++i) { const int e = F.tid + NTHR * i, key = e / 12, c = e % 12; *(v4u*)(buf + key * AT_KROW + c * 16) = P.k[i]; }
#pragma unroll
    for (int i = 0; i < 2; ++i) { const int e = F.tid + NTHR * i, row = e >> 4, c = e & 15; *(v4u*)(buf + AT_KBYTES + row * AT_VROW + c * 16) = P.v[i]; }
}
__device__ __forceinline__ int attn_tile_row(bool is_smp, int sb, int i) {
    if (!is_smp) return sb * 256 + 128 * i;
    return i < 2 ? T + sb * 256 + 128 * i : TCTX + sb * 1024 + 128 * (i - 2);
}
__device__ __forceinline__ void attn_item(const Frame& F, int q0, int h, bool is_smp, int spos0, int sb) {
    F.relane();
    const bf16* Q = WSP(bf16, WS_Q); bf16* YMIX = WSP(bf16, WS_YMIX); const float* ROPE = WSP(float, WS_ROPE);
    const int r = F.lane & 15, g = F.lane >> 4, w = F.wave;
    const int tq = q0 + 16 * w + r;
    const int ntile = is_smp ? 10 : 2;
    AttnPre P;
    attn_load_tile(F, h, attn_tile_row(is_smp, sb, 0), P);
    bf16x8 qf[3];
#pragma unroll
    for (int ks = 0; ks < 3; ++ks) qf[ks] = *(const bf16x8*)(Q + (size_t)tq * 768 + h * 96 + 32 * ks + 8 * g);
    if (is_smp) {
        float x[8], o[8]; unpack8(__builtin_bit_cast(v4u, qf[2]), x);
        const int pos = spos0 + 16 * w + r, ax = g >> 1, half = g & 1;
        const float* rp = ROPE + ((size_t)(pos * 2 + ax) * 8) * 2;
#pragma unroll
        for (int j = 0; j < 8; ++j) { const float other = xlane<16>(x[j]); const float cs = rp[2 * j], sn = rp[2 * j + 1];
            o[j] = half == 0 ? (x[j] * cs - other * sn) : (other * sn + x[j] * cs); }
        qf[2] = __builtin_bit_cast(bf16x8, pack8(o));
    }
    const float csc = 0.10206207261596577f * 1.4426950408889634f;
    float m = -1e30f, l = 0.f;
    f32x4 oacc[4];
#pragma unroll
    for (int dt = 0; dt < 4; ++dt) oacc[dt] = (f32x4){0.f, 0.f, 0.f, 0.f};
    __syncthreads();
    attn_store_tile(F, F.lds, P);
    AttnPre P2;
    if (ntile > 1) attn_load_tile(F, h, attn_tile_row(is_smp, sb, 1), P);
    __syncthreads();
#define ATTN_COMPUTE(buf) do { \
        f32x4 sacc[8]; \
        _Pragma("unroll") \
        for (int st = 0; st < 8; ++st) { \
            const unsigned char* kp = buf + (16 * st + r) * AT_KROW + 16 * g; \
            f32x4 a = {0.f, 0.f, 0.f, 0.f}; \
            a = MFMA16(ld_frag16(kp), qf[0], a); a = MFMA16(ld_frag16(kp + 64), qf[1], a); a = MFMA16(ld_frag16(kp + 128), qf[2], a); \
            sacc[st] = a; \
        } \
        float mx = -1e30f; \
        _Pragma("unroll") \
        for (int st = 0; st < 8; ++st) mx = fmaxf(fmaxf(fmaxf(sacc[st][0], sacc[st][1]), fmaxf(sacc[st][2], sacc[st][3])), mx); \
        mx = fmaxf(mx, xlane<16>(mx)); mx = max_x32(mx); \
        const float mn = fmaxf(m, mx), alpha = __builtin_amdgcn_exp2f((m - mn) * csc); m = mn; \
        float ps = 0.f; float p[32]; \
        _Pragma("unroll") \
        for (int st = 0; st < 8; ++st) \
            _Pragma("unroll") \
            for (int j = 0; j < 4; ++j) { const float e = __builtin_amdgcn_exp2f((sacc[st][j] - mn) * csc); p[4 * st + j] = e; ps += e; } \
        l = l * alpha + ps; \
        _Pragma("unroll") \
        for (int dt = 0; dt < 4; ++dt) oacc[dt] *= alpha; \
        _Pragma("unroll") \
        for (int ks2 = 0; ks2 < 4; ++ks2) { \
            const bf16x8 pf = __builtin_bit_cast(bf16x8, pack8(p + 8 * ks2)); \
            _Pragma("unroll") \
            for (int dt = 0; dt < 4; ++dt) { \
                const unsigned char* vp = buf + AT_KBYTES + (16 * dt + r) * AT_VROW + (32 * ks2 + 4 * g) * 2; \
                oacc[dt] = MFMA16(ld_frag8x2(vp, vp + 32), pf, oacc[dt]); \
            } \
        } } while (0)
#pragma unroll 1
    for (int ti = 0; ti < ntile; ti += 2) {
        if (ti + 2 < ntile) attn_load_tile(F, h, attn_tile_row(is_smp, sb, ti + 2), P2);
        { const unsigned char* buf = F.lds; ATTN_COMPUTE(buf); }
        if (ti + 1 < ntile) attn_store_tile(F, F.lds + AT_BUF, P);
        __syncthreads();
        if (ti + 1 >= ntile) break;
        if (ti + 3 < ntile) attn_load_tile(F, h, attn_tile_row(is_smp, sb, ti + 3), P);
        { const unsigned char* buf = F.lds + AT_BUF; ATTN_COMPUTE(buf); }
        if (ti + 2 < ntile) attn_store_tile(F, F.lds, P2);
        __syncthreads();
    }
#undef ATTN_COMPUTE
    l += xlane<16>(l); l = sum_x32(l);
    const float inv = 1.0f / l;
#pragma unroll
    for (int dt = 0; dt < 4; ++dt) { v2u o; o.x = pk2(oacc[dt][0] * inv, oacc[dt][1] * inv); o.y = pk2(oacc[dt][2] * inv, oacc[dt][3] * inv);
        *(v2u*)(YMIX + (size_t)tq * D + h * 64 + 16 * dt + 4 * g) = o; }
}
__device__ __forceinline__ void odd_phase3(const Frame& F) {
    if (F.G >= 256) {
        if (F.bid < 128) {
            const int bh = F.bid & 15, qt = F.bid >> 4, b = bh >> 3, h = bh & 7;
            attn_item(F, TCTX + b * 1024 + qt * 128, h, true, qt * 128, b);
        } else {
            for (int p = F.bid - 128; p < 256; p += F.G - 128) { const int s = p >> 3, h = p & 7;
                attn_item(F, s * 256, h, false, 0, s); attn_item(F, s * 256 + 128, h, false, 0, s); }
        }
        return;
    }
    for (int it = F.bid; it < 640; it += F.G) {
        if (it < 128) { const int b = it >> 6, h = (it >> 3) & 7, qt = it & 7; attn_item(F, TCTX + b * 1024 + qt * 128, h, true, qt * 128, b); }
        else { const int i2 = it - 128, s = i2 >> 4, h = (i2 >> 1) & 7, qt = i2 & 1; attn_item(F, s * 256 + qt * 128, h, false, 0, s); }
    }
}
constexpr int PH_PER_LAYER = 9, PH_L0 = 2, N_PHASES = PH_L0 + 4 * PH_PER_LAYER + 1;
#ifndef MK_ONE_LAUNCH
#define MK_ONE_LAUNCH 1
#endif
#ifndef PROBE_REP
#define PROBE_REP 1
#define PROBE_SLOT -2
#endif

__global__ void __launch_bounds__(NTHR, 2) fwd_kernel(Args args) {
    extern __shared__ __attribute__((aligned(16))) unsigned char lds[];
    Frame F; F.lds = lds; F.tid = threadIdx.x; F.lane = F.tid & 63; F.wave = __builtin_amdgcn_readfirstlane(F.tid >> 6); F.bid = blockIdx.x; F.G = gridDim.x;
    const int wave_id = F.wave;
    { CArgsP ap = (CArgsP)__builtin_amdgcn_kernarg_segment_ptr(); asm volatile("" : "+s"(ap)); F.a = ap; F.ws = (GAS unsigned char*)ap->ws; }
    LAS unsigned char* ldsl = (LAS unsigned char*)lds;
    for (int u = F.tid; u < (LDS_BYTES - LDSCTL_OFF) / 4; u += NTHR) ((LAS unsigned*)(ldsl + LDSCTL_OFF))[u] = 0u;
    __syncthreads();
    XcdBarrier bar; bar.bar = (unsigned*)(GAS unsigned*)(F.ws + WS_CTL) + 1024; bar.x = 0; bar.st = nullptr;
    const bool multi = (args.ph_hi - args.ph_lo) > 1;
    if (multi) bar = xcd_barrier_post((unsigned*)(GAS unsigned*)(F.ws + WS_CTL) + 1024, (volatile LAS unsigned*)(ldsl + MISC_OFF) + 8);

#define FRESH_F() do { int wv_ = wave_id; asm volatile("" : "+s"(wv_)); int ln_; asm volatile("v_mbcnt_lo_u32_b32 %0, -1, 0\n\tv_mbcnt_hi_u32_b32 %0, -1, %0" : "=v"(ln_)); F.tid = wv_ * 64 + ln_; F.lane = ln_; F.wave = wv_; } while (0)
    int rep = 0;
    for (int ph = args.ph_lo; ph < args.ph_hi; ) {
        { CArgsP ap = (CArgsP)__builtin_amdgcn_kernarg_segment_ptr(); asm volatile("" : "+s"(ap)); F.a = ap; F.ws = (GAS unsigned char*)ap->ws;
          int bid_ = blockIdx.x; asm volatile("" : "+s"(bid_)); F.bid = bid_; }
        if (ph == 0) { FRESH_F(); p0_phase(F); }
        else if (ph == 1) { FRESH_F(); p1_copy_phase(F); norm0_phase(F); }
        else if (ph == N_PHASES - 1) { FRESH_F(); final_phase(F); }
        else {
            const int l = (ph - PH_L0) / PH_PER_LAYER, s = (ph - PH_L0) % PH_PER_LAYER, hi = l >> 1; const bool odd = l & 1;
            if (s == 0 || s == 7) {
                FRESH_F();
                const int f = s == 0 ? 0 : 1;
                pg8::Gemm g{(const bf16*)(const GAS bf16*)(F.ws + WS_XA), (const bf16*)(const GAS bf16*)(F.ws + WS_WGU + (size_t)(l * 2 + f) * SZ_WGU), T, 2 * DFF, D, D, D};
                pg8::StaticOrder S; S.init(T, 2 * DFF, F.G, F.bid);
                EpiSwiglu E{F.ws, (int)(((l * 3) + (f == 0 ? 0 : 2)) * 3 * BIAS_MS), (l == 0 && f == 0) ? 16 : 1};
                pg8::gemm_phase<EpiSwiglu, pg8::StaticOrder, true>(ldsl, F.tid, g, S, E);
                FRESH_F();
                { const int nfull = (40 * 22) % F.G, nbg = F.G - nfull, bgi = F.bid - nfull;
                  if (bgi >= 0 && rep == 0) {
#ifdef PROBE_BG
                    for (int pb = 0; pb < PROBE_BG - 1; ++pb) { background_work(F, l, f, bgi, nbg); FRESH_F(); }
#endif
                    background_work(F, l, f, bgi, nbg); } }
            } else if (s == 1 || s == 8 || s == 6) {
                FRESH_F();
                const int f = s == 1 ? 0 : 1;
                const bool mix = s == 6, lastg = (s == 8 && l == 3);
                const bf16* gA = mix ? (const bf16*)(const GAS bf16*)(F.ws + WS_YMIX) : (const bf16*)(const GAS bf16*)(F.ws + WS_H);
                const bf16* gB = mix ? (const bf16*)(const GAS bf16*)(F.ws + (odd ? WS_WOO : WS_WOE) + (size_t)hi * SZ_WO) : (const bf16*)(const GAS bf16*)(F.ws + WS_WD + (size_t)(l * 2 + f) * SZ_WD);
                const int gK = mix ? D : DFF;
                const int gate_off = l * 3 * NMODV + (mix ? 5 : (f == 0 ? 2 : 8)) * 1024;
                const float coef = rep ? 0.f : (mix ? 1.0f : 0.5f);
                const int nl = (s == 8) ? l + 1 : l, ni = mix ? 2 : (f == 0 ? 1 : 0), sci = mix ? 7 : (f == 0 ? 4 : 1);
                const float* gn = AIN(I_GNORM) + (size_t)((lastg ? 0 : nl) * 3 + ni) * D;
                const int scn_off = (lastg ? 0 : nl) * 3 * NMODV + sci * 1024;
                pg8::Gemm g{gA, gB, T, D, gK, gK, gK};
                EpiResid160 E{F.ws, gn, gate_off, scn_off, coef};
                pg8::StaticOrder S; S.init(T, D, F.G, F.bid, 160);
                pg8::gemm_phase<EpiResid160, pg8::StaticOrder, true, 1>(ldsl, F.tid, g, S, E);
                FRESH_F();
                if (s == 8 && l < 3 && rep == 0) bias_reduce(F, l + 1, 1, F.bid, F.G);
            } else if (s == 2 || (s == 4 && odd)) {
                const int ng = s == 2 ? 1 : 3;
                for (int gi = 0; gi < ng; ++gi) {
                    FRESH_F();
                    const bool inproj = s == 2;
                    const int kind = inproj ? 0 : 1 + gi;
                    const size_t offA = kind == 0 ? WS_XA : (kind == 1 ? WS_QA : (kind == 2 ? WS_CKVA : WS_WKV + (size_t)hi * SZ_WKV + (size_t)512 * 256 * 2));
                    const size_t offB = kind == 0 ? (odd ? WS_WIO + (size_t)hi * SZ_WIO : WS_WIE + (size_t)hi * SZ_WIE) : (kind == 1 ? WS_WUQ + (size_t)hi * SZ_WUQ : (kind == 2 ? WS_WKV + (size_t)hi * SZ_WKV : WS_CKVA));
                    const size_t offO = kind == 0 ? WS_PROJ : (kind == 1 ? WS_Q : (kind == 2 ? WS_KN : WS_VT));
                    const int gM = kind == 3 ? 512 : (kind == 2 ? TP : T);
                    const int gN = kind == 0 ? (odd ? ODD_NP : EVEN_NP) : (kind == 1 ? 768 : (kind == 2 ? 512 : TP));
                    const int gK = kind == 0 ? D : (kind == 1 ? 384 : 256);
                    const int ldc = kind == 3 ? TP : gN;
                    const int off = kind == 2 ? 136 : (kind == 3 ? 52 : 0);
                    pg8::Gemm g{(const bf16*)(const GAS bf16*)(F.ws + offA), (const bf16*)(const GAS bf16*)(F.ws + offB), gM, gN, gK, gK, gK};
                    EpiStore E{F.ws, (unsigned)offO, ldc, inproj ? (int)((l * 3 + 1) * 3 * BIAS_MS) : -1};
                    pg8::StaticOrder S; S.init(gM, gN, F.G, (F.bid + off) % F.G);
                    pg8::gemm_phase<EpiStore, pg8::StaticOrder, true>(ldsl, F.tid, g, S, E);
                }
            } else if (s == 3) { if (!odd) { FRESH_F(); even_phase1(F, hi); } else { FRESH_F(); odd_phase1(F, hi); } }
            else if (s == 4) { FRESH_F(); ssd_scan_phase(F, hi); }
            else if (s == 5) { if (odd) { FRESH_F(); odd_phase3(F); } else { FRESH_F(); even_phase2(F, hi); } }
        }
        {
            const int slot = ph < PH_L0 ? 100 + ph : (ph == N_PHASES - 1 ? 102 : ((ph - PH_L0) % PH_PER_LAYER) + 20 * (((ph - PH_L0) / PH_PER_LAYER) & 1));
            const int reps = ((PROBE_SLOT == 200 && slot < 100) || slot == PROBE_SLOT || (PROBE_SLOT < 20 && slot == PROBE_SLOT + 20 && (PROBE_SLOT < 2 || PROBE_SLOT > 5))) ? PROBE_REP : 1;
            if (++rep >= reps) { rep = 0; ++ph; }
            if (ph < args.ph_hi) xcd_barrier(bar);
#if defined(PROBE_BAR)
            if (ph < args.ph_hi) { for (int pb_ = 1; pb_ < PROBE_BAR; ++pb_) xcd_barrier(bar); }
#endif
        }
    }
}

extern "C" void kernel_launch(void* const* d_in, const int* in_sizes, int n_in, void* d_out, int out_size, void* d_ws, size_t ws_size, hipStream_t stream) {
    static int grid = 0;
    if (grid == 0) {
        if (n_in != 34 || (size_t)out_size != OUT_END || ws_size < WS_END) { fprintf(stderr, "kernel_launch: unexpected problem: n_in %d out %d ws %zu (need %zu)\n", n_in, out_size, ws_size, (size_t)WS_END); grid = -1; return; }
        int dev = 0, cus = 0, per_cu = 0;
        if (hipGetDevice(&dev) != hipSuccess || hipDeviceGetAttribute(&cus, hipDeviceAttributeMultiprocessorCount, dev) != hipSuccess) { grid = -1; return; }
        if (hipFuncSetAttribute((const void*)fwd_kernel, hipFuncAttributeMaxDynamicSharedMemorySize, LDS_BYTES) != hipSuccess) { fprintf(stderr, "kernel_launch: hipFuncSetAttribute failed\n"); grid = -1; return; }
        if (hipOccupancyMaxActiveBlocksPerMultiprocessor(&per_cu, (const void*)fwd_kernel, NTHR, LDS_BYTES) != hipSuccess || per_cu < 1) { fprintf(stderr, "kernel_launch: occupancy query says %d blocks per CU\n", per_cu); per_cu = 1; }
        (void)hipGetLastError();
        grid = cus;
        if (grid < 256) fprintf(stderr, "kernel_launch: %d CUs (tuned for 256)\n", grid);
    }
    if (grid < 0) return;
    (void)hipMemsetAsync((char*)d_ws + WS_CTL, 0, CTL_ZERO_BYTES, stream);
    Args a{};
    for (int i = 0; i < 34; ++i) a.in[i] = (const float*)d_in[i];
    a.out = (float*)d_out; a.ws = (unsigned char*)d_ws;
#if MK_ONE_LAUNCH
    a.ph_lo = 0; a.ph_hi = N_PHASES; a.li = 0;
    hipLaunchKernelGGL(fwd_kernel, dim3(grid), dim3(NTHR), LDS_BYTES, stream, a);
#else
    int li = 0;
    for (int ph = 0; ph < N_PHASES; ++ph) {
        a.ph_lo = ph; a.ph_hi = ph + 1; a.li = li++;
        hipLaunchKernelGGL(fwd_kernel, dim3(grid), dim3(NTHR), LDS_BYTES, stream, a);
    }
#endif
}
```

```cpp
#include <hip/hip_runtime.h>
#include <cstdio>
#include <cstdint>
#ifndef GEMM_SP2
#define GEMM_SP2 1
#endif
#ifndef PG8_AUXA
#define PG8_AUXA 0
#endif
#ifndef PG8_AUXB
#define PG8_AUXB 0
#endif
namespace pg8 {
#define PG8_LAS __attribute__((address_space(3)))
typedef unsigned short bf16_t;
typedef short bf16x8 __attribute__((ext_vector_type(8)));
typedef float f32x4 __attribute__((ext_vector_type(4)));
typedef unsigned u32x4 __attribute__((ext_vector_type(4)));
typedef unsigned u32x2 __attribute__((ext_vector_type(2)));
constexpr int BM = 256, BK = 64, HALF = 128, HTB = HALF * BK * 2  , STAGE_BYTES = 8 * HTB, NXCD = 8, WGM = 8;

__host__ __device__ __forceinline__ int lds_byte(int r, int c) { const int st = (r >> 4) * 2 + (c >> 5), rr = r & 15, cc = c & 31, ob = rr * 64 + cc * 2; return st * 1024 + (ob ^ (((ob >> 9) & 1) << 5)); }
__host__ __device__ __forceinline__ void stage_rc(int b, int& R, int& C) { const int st = b / 1024, sb = b % 1024, swz = sb ^ (((sb >> 9) & 1) << 5); R = (st >> 1) * 16 + swz / 64; C = (st & 1) * 32 + (swz % 64) / 2; }
__host__ __device__ __forceinline__ int perm32(int rho) { const int n = rho >> 4, i = rho & 15; return 8 * (i >> 2) + 4 * n + (i & 3); }

struct Unit { int pm, pn; };
struct Gemm { const bf16_t* A; const bf16_t* Bt; int M, N, K, lda, ldb; };

struct StaticOrder {
    int nM, nN, nwg, G, c;
    __host__ __device__ void init(int M, int N, int G_, int c_, int bmr = BM) { nM = M / bmr; nN = N / BM; nwg = nM * nN; G = G_; c = c_; }
    __host__ __device__ bool next(int i, Unit& u) const {
        const long L = (long)i * G + c; if (L >= nwg) return false;
        int wgid = (int)L; { const int q = nwg / NXCD, r = nwg % NXCD, xcd = wgid % NXCD, off = wgid / NXCD; wgid = (xcd < r ? xcd * (q + 1) : r * (q + 1) + (xcd - r) * q) + off; }
        const int nig = WGM * nN, gid = wgid / nig, fm = gid * WGM, gsz = (nM - fm) < WGM ? (nM - fm) : WGM;
        u.pm = fm + ((wgid % nig) % gsz); u.pn = (wgid % nig) / gsz; return true;
    }
    __device__ __forceinline__ void a_ready(const Unit&) const {}
    __device__ __forceinline__ void done(const Unit&) const {}
};

__device__ __forceinline__ unsigned cvt_pk_bf16(float lo, float hi) { unsigned r; asm volatile("v_cvt_pk_bf16_f32 %0, %1, %2" : "=v"(r) : "v"(lo), "v"(hi)); return r; }

template <class Epi, class Sched, bool ALIGN_EPI, int MH1 = 4>
__device__ __forceinline__ void gemm_phase(PG8_LAS unsigned char* lds, const int tid, const Gemm g, const Sched& S, const Epi& E) {
    const int wid = __builtin_amdgcn_readfirstlane(tid >> 6), lane = tid & 63, wr = wid >> 2, wc = wid & 3, fr = lane & 15, fq = lane >> 4;
    static_assert(MH1 == 4 || MH1 == 1, "row tile");
    constexpr bool R160 = (MH1 == 1); constexpr int BMR = R160 ? 160 : 256;
    const int K = g.K, nt = K / BK;
    unsigned voffA[2], voffB[2], voffA1[2];
#pragma unroll
    for (int i = 0; i < 2; ++i) { int R, C; stage_rc(tid * 16 + i * 8192, R, C); const int Rb = Epi::PERM ? ((R & ~31) + perm32(R & 31)) : R;
        voffA[i] = (unsigned)(R * g.lda + C) * 2u; voffB[i] = (unsigned)(Rb * g.ldb + C) * 2u;
        int R1, C1; stage_rc(wid * 256 + (lane & 15) * 16 + i * 2048, R1, C1); voffA1[i] = (unsigned)(R1 * g.lda + C1) * 2u; }
    const size_t kstep = (size_t)(BK * 2);
    const size_t hstepA = (size_t)HALF * g.lda * 2, hstepB = (size_t)HALF * g.ldb * 2;
    const size_t tstepA = (size_t)BMR * g.lda * 2, tstepB = 2 * hstepB;
    const unsigned ldsw = (unsigned)wid * 1024u, ldsw1 = (unsigned)wid * 256u;
    const int aoff = lds_byte(wr * 64 + fr, fq * 8), boff = lds_byte(wc * 32 + fr, fq * 8), aoff1 = lds_byte(wr * 16 + fr, fq * 8);
#define PG8_SA(b, h) (((b) * 2 + (h)) * HTB)
#define PG8_SB(b, h) ((4 + (b) * 2 + (h)) * HTB)
#define PG8_STAGE(bufoff, gbase, voff) do { _Pragma("unroll") for (int _i = 0; _i < 2; ++_i) \
        __builtin_amdgcn_global_load_lds((const unsigned*)((const char*)(gbase) + (voff)[_i]), (PG8_LAS unsigned*)(lds + (bufoff) + ldsw + _i * 8192), 16, 0, (&(voff)[0] == &voffB[0]) ? PG8_AUXB : PG8_AUXA); } while (0)
#define PG8_LDA_(dst, b, h) do { _Pragma("unroll") for (int m = 0; m < 4; ++m) _Pragma("unroll") for (int k = 0; k < 2; ++k) dst[m][k] = *(const PG8_LAS bf16x8*)(lds + PG8_SA(b, h) + aoff + m * 2048 + k * 1024); } while (0)
#define PG8_LDA(dst, b, h) do { if constexpr (R160 && (h) == 1) { _Pragma("unroll") for (int k = 0; k < 2; ++k) dst[0][k] = *(const PG8_LAS bf16x8*)(lds + PG8_SA(b, 1) + aoff1 + k * 1024); } else PG8_LDA_(dst, b, h); } while (0)
#define PG8_STAGE_A1(bufoff, gbase) do { if constexpr (R160) { if (lane < 16) { _Pragma("unroll") for (int _i = 0; _i < 2; ++_i) \
        __builtin_amdgcn_global_load_lds((const unsigned*)((const char*)(gbase) + voffA1[_i]), (PG8_LAS unsigned*)(lds + (bufoff) + ldsw1 + _i * 2048), 16, 0, 0); } } else PG8_STAGE(bufoff, gbase, voffA); } while (0)
#define PG8_LDB(dst, b, h) do { _Pragma("unroll") for (int n = 0; n < 2; ++n) _Pragma("unroll") for (int k = 0; k < 2; ++k) dst[n][k] = *(const PG8_LAS bf16x8*)(lds + PG8_SB(b, h) + boff + n * 2048 + k * 1024); } while (0)
#define PG8_MMA(ai, bj, At, Bt) do { __builtin_amdgcn_s_setprio(1); _Pragma("unroll") for (int m = 0; m < ((R160 && (ai) == 1) ? 1 : 4); ++m) _Pragma("unroll") for (int n = 0; n < 2; ++n) _Pragma("unroll") for (int k = 0; k < 2; ++k) \
        acc[ai][bj][m][n] = __builtin_amdgcn_mfma_f32_16x16x32_bf16(Bt[n][k], At[m][k], acc[ai][bj][m][n], 0, 0, 0); __builtin_amdgcn_s_setprio(0); } while (0)
#define PG8_WAIT_V(n) asm volatile("s_waitcnt vmcnt(" #n ")" ::: "memory")
#define PG8_WAIT_L(n) asm volatile("s_waitcnt lgkmcnt(" #n ")" ::: "memory")
#define PG8_BAR __builtin_amdgcn_s_barrier()
#define PG8_SCHED __builtin_amdgcn_sched_barrier(0)
    Unit cur, nxt; int ui = 0;
    if (!S.next(0, cur)) return;
    f32x4 acc[2][2][4][2];
#pragma unroll
    for (int a = 0; a < 2; ++a)
#pragma unroll
        for (int b = 0; b < 2; ++b)
#pragma unroll
            for (int m = 0; m < 4; ++m)
#pragma unroll
                for (int n = 0; n < 2; ++n) acc[a][b][m][n] = (f32x4){0.f, 0.f, 0.f, 0.f};
    bf16x8 At[4][2], B0[2][2], B1[2][2];
    const char* cA = (const char*)g.A + (size_t)cur.pm * tstepA; const char* cB = (const char*)g.Bt + (size_t)cur.pn * tstepB;
    S.a_ready(cur);
    E.prefetch_sync(cur, tid, lds, 0); E.prefetch_dma(cur, wid, lane, lds, 0);
    typename Epi::Pre pre;
    if constexpr (R160) { E.pre_dma(cur, wid, lane, lds); E.pre_x(pre, cur, wr, wc, fr, fq); }
#if GEMM_SP2
    PG8_STAGE(PG8_SB(0, 0), cB, voffB); PG8_STAGE(PG8_SB(0, 1), cB + hstepB, voffB); PG8_STAGE(PG8_SA(0, 0), cA, voffA); PG8_STAGE_A1(PG8_SA(0, 1), cA + hstepA);
    if (wr == 1) PG8_BAR;
    PG8_WAIT_V(2); PG8_BAR;
    PG8_STAGE(PG8_SB(1, 0), cB + kstep, voffB); PG8_STAGE(PG8_SA(1, 0), cA + kstep, voffA); PG8_STAGE(PG8_SB(1, 1), cB + hstepB + kstep, voffB);
    PG8_WAIT_V(6); PG8_BAR;
#else
    static_assert(!R160, "the 160-row unit exists for the SP2 schedule only");
    PG8_STAGE(PG8_SB(0, 0), cB, voffB); PG8_STAGE(PG8_SA(0, 0), cA, voffA); PG8_STAGE(PG8_SB(0, 1), cB + hstepB, voffB); PG8_STAGE(PG8_SA(0, 1), cA + hstepA, voffA);
    if (wr == 1) PG8_BAR;
    PG8_WAIT_V(4); PG8_BAR;
    PG8_STAGE(PG8_SB(1, 0), cB + kstep, voffB); PG8_STAGE(PG8_SA(1, 0), cA + kstep, voffA); PG8_STAGE(PG8_SB(1, 1), cB + hstepB + kstep, voffB);
    PG8_WAIT_V(6); PG8_BAR;
#endif
    for (;;) {
        const bool has_next = S.next(ui + 1, nxt);
        const char* nA = has_next ? (const char*)g.A + (size_t)nxt.pm * tstepA : cA; const char* nB = has_next ? (const char*)g.Bt + (size_t)nxt.pn * tstepB : cB;
        for (int t = 0; t < nt; t += 2) {
            const bool last = (t == nt - 2);
            const char* a1 = cA + (size_t)(t + 1) * kstep;
            const char* a2 = last ? nA : cA + (size_t)(t + 2) * kstep; const char* b2 = last ? nB : cB + (size_t)(t + 2) * kstep;
            const char* a3 = a2 + kstep; const char* b3 = b2 + kstep;
            if (last && has_next) { S.a_ready(nxt); E.prefetch_dma(nxt, wid, lane, lds, (ui + 1) & 1); }
#if GEMM_SP2
            PG8_LDB(B0, 0, 0); PG8_LDB(B1, 0, 1); PG8_SCHED; PG8_LDA(At, 0, 0); PG8_STAGE_A1(PG8_SA(1, 1), a1 + hstepA);
            PG8_WAIT_V(8); PG8_WAIT_L(0); PG8_BAR; PG8_MMA(0, 0, At, B0); PG8_MMA(0, 1, At, B1); PG8_BAR; PG8_SCHED;
            PG8_LDA(At, 0, 1); PG8_STAGE(PG8_SB(0, 0), b2, voffB); PG8_STAGE(PG8_SB(0, 1), b2 + hstepB, voffB); PG8_STAGE(PG8_SA(0, 0), a2, voffA);
            PG8_WAIT_V(8); PG8_WAIT_L(0); PG8_BAR; PG8_MMA(1, 0, At, B0); PG8_MMA(1, 1, At, B1); PG8_BAR; PG8_SCHED;
            PG8_LDB(B0, 1, 0); PG8_LDB(B1, 1, 1); PG8_SCHED; PG8_LDA(At, 1, 0); PG8_STAGE_A1(PG8_SA(0, 1), a2 + hstepA);
            PG8_WAIT_V(8); PG8_WAIT_L(0); PG8_BAR; PG8_MMA(0, 0, At, B0); PG8_MMA(0, 1, At, B1); PG8_BAR; PG8_SCHED;
            PG8_LDA(At, 1, 1); PG8_STAGE(PG8_SB(1, 0), b3, voffB); PG8_STAGE(PG8_SB(1, 1), b3 + hstepB, voffB); PG8_STAGE(PG8_SA(1, 0), a3, voffA);
            PG8_WAIT_V(8); PG8_WAIT_L(0); PG8_BAR; PG8_MMA(1, 0, At, B0); PG8_MMA(1, 1, At, B1); PG8_BAR; PG8_SCHED;
#else
            PG8_LDB(B0, 0, 0); PG8_SCHED; PG8_LDA(At, 0, 0); PG8_STAGE(PG8_SA(1, 1), a1 + hstepA, voffA);
            PG8_WAIT_L(8); PG8_BAR; PG8_WAIT_L(0); PG8_MMA(0, 0, At, B0); PG8_BAR; PG8_SCHED;
            PG8_LDB(B1, 0, 1); PG8_STAGE(PG8_SB(0, 0), b2, voffB);
            PG8_BAR; PG8_WAIT_L(0); PG8_MMA(0, 1, At, B1); PG8_BAR;
            PG8_LDA(At, 0, 1); PG8_STAGE(PG8_SA(0, 0), a2, voffA);
            PG8_BAR; PG8_WAIT_L(0); PG8_MMA(1, 0, At, B0); PG8_BAR; PG8_SCHED;
            PG8_STAGE(PG8_SB(0, 1), b2 + hstepB, voffB);
            PG8_WAIT_V(6); PG8_BAR; PG8_MMA(1, 1, At, B1); PG8_BAR;
            PG8_LDB(B0, 1, 0); PG8_SCHED; PG8_LDA(At, 1, 0); PG8_STAGE(PG8_SA(0, 1), a2 + hstepA, voffA);
            PG8_WAIT_L(8); PG8_BAR; PG8_WAIT_L(0); PG8_MMA(0, 0, At, B0); PG8_BAR; PG8_SCHED;
            PG8_LDB(B1, 1, 1); PG8_STAGE(PG8_SB(1, 0), b3, voffB);
            PG8_BAR; PG8_WAIT_L(0); PG8_MMA(0, 1, At, B1); PG8_BAR;
            PG8_LDA(At, 1, 1); PG8_STAGE(PG8_SA(1, 0), a3, voffA);
            PG8_BAR; PG8_WAIT_L(0); PG8_MMA(1, 0, At, B0); PG8_BAR; PG8_SCHED;
            PG8_STAGE(PG8_SB(1, 1), b3 + hstepB, voffB);
            PG8_WAIT_V(6); PG8_BAR; PG8_MMA(1, 1, At, B1); PG8_BAR;
#endif
        }
        if constexpr (ALIGN_EPI) { if (wr == 0) PG8_BAR; }
        if constexpr (R160) E(acc, cur, wr, wc, fr, fq, lds, pre); else E(acc, cur, wr, wc, fr, fq, lds, ui & 1);
#if defined(PROBE_EPI)
        if constexpr ((Epi::KIND & PROBE_EPI) != 0) { for (int er_ = 1; er_ < PROBE_EPI_REP; ++er_) { if constexpr (R160) E(acc, cur, wr, wc, fr, fq, lds, pre); else E(acc, cur, wr, wc, fr, fq, lds, ui & 1); } }
#endif
        if (!has_next) break;
#pragma unroll
        for (int a = 0; a < 2; ++a)
#pragma unroll
            for (int b = 0; b < 2; ++b)
#pragma unroll
                for (int m = 0; m < 4; ++m)
#pragma unroll
                    for (int n = 0; n < 2; ++n) acc[a][b][m][n] = (f32x4){0.f, 0.f, 0.f, 0.f};
        cur = nxt; cA = nA; cB = nB; ++ui;
        E.prefetch_sync(cur, tid, lds, ui & 1);
        if constexpr (R160) { PG8_BAR; E.pre_dma(cur, wid, lane, lds); E.pre_x(pre, cur, wr, wc, fr, fq); PG8_WAIT_V(0); }
        if constexpr (ALIGN_EPI) { if (wr == 1) PG8_BAR; }
    }
    PG8_WAIT_V(0);
    if constexpr (!ALIGN_EPI) { if (wr == 0) PG8_BAR; }
    PG8_BAR;
#undef PG8_SA
#undef PG8_SB
#undef PG8_STAGE
#undef PG8_LDA
#undef PG8_LDA_
#undef PG8_STAGE_A1
#undef PG8_LDB
#undef PG8_MMA
#undef PG8_WAIT_V
#undef PG8_WAIT_L
#undef PG8_BAR
#undef PG8_SCHED
}
}
constexpr int NWAVES = 8, NTHR = 512;
constexpr int D = 1024, TCTX = 8192, TSMP = 2048, T = 10240, TP = T + 512;
constexpr int DFF = 2816, NMODV = 9 * 1024;
constexpr int EVEN_NP = 2816, ODD_NP = 1792;
constexpr float EPS = 1e-6f;
constexpr int NCHUNK = 80;

constexpr size_t MiB = 1u << 20;
constexpr size_t WS_CTL = 0, CTL_ZERO_BYTES = 64 * 1024;
constexpr size_t WS_MOD = 1 * MiB;
constexpr size_t WS_ROPE = WS_MOD + 512 * 1024;
constexpr size_t WS_DEC = WS_ROPE + 160 * 1024;
constexpr size_t WS_SSQ = WS_MOD + 768 * 1024;
constexpr size_t WS_BIAS = 2 * MiB;
constexpr size_t BIAS_LD = 5632, BIAS_MS = 16 * BIAS_LD;
constexpr size_t WS_BIASF = 15 * MiB;
constexpr size_t WS_WGU = 16 * MiB;
constexpr size_t SZ_WGU = (size_t)5632 * 1024 * 2;
constexpr size_t WS_WD = WS_WGU + 8 * SZ_WGU;
constexpr size_t SZ_WD = (size_t)1024 * 2816 * 2;
constexpr size_t WS_WIE = WS_WD + 8 * SZ_WD;
constexpr size_t SZ_WIE = (size_t)EVEN_NP * 1024 * 2;
constexpr size_t WS_WOE = WS_WIE + 2 * SZ_WIE;
constexpr size_t SZ_WO = (size_t)1024 * 1024 * 2;
constexpr size_t WS_WIO = WS_WOE + 2 * SZ_WO;
constexpr size_t SZ_WIO = (size_t)ODD_NP * 1024 * 2;
constexpr size_t WS_WOO = WS_WIO + 2 * SZ_WIO;
constexpr size_t WS_WUQ = WS_WOO + 2 * SZ_WO;
constexpr size_t SZ_WUQ = (size_t)768 * 384 * 2;
constexpr size_t WS_WKV = WS_WUQ + 2 * SZ_WUQ;
constexpr size_t SZ_WKV = (size_t)1024 * 256 * 2;
constexpr size_t WS_WEND = WS_WKV + 2 * SZ_WKV;
constexpr size_t WS_X = (WS_WEND + MiB - 1) / MiB * MiB;
constexpr size_t WS_XA = WS_X + (size_t)T * D * 4;
constexpr size_t WS_PROJ = WS_XA + (size_t)T * D * 2;
constexpr size_t WS_YMIX = WS_PROJ + (size_t)T * EVEN_NP * 2;
constexpr size_t WS_H = WS_YMIX + (size_t)T * D * 2;
constexpr size_t WS_ST = WS_H;
constexpr size_t WS_QA = WS_H;
constexpr size_t WS_CKVA = WS_QA + (size_t)T * 384 * 2;
constexpr size_t WS_KR = WS_CKVA + (size_t)TP * 256 * 2;
constexpr size_t WS_Q = WS_KR + (size_t)TP * 32 * 2;
constexpr size_t WS_KN = WS_Q + (size_t)T * 768 * 2;
constexpr size_t WS_VT = WS_KN + (size_t)TP * 512 * 2;
constexpr size_t WS_HEND = WS_H + (size_t)T * DFF * 2;
static_assert(WS_VT + (size_t)512 * TP * 2 <= WS_HEND, "odd-layer scratch fits the H overlay");
static_assert(WS_ST + (size_t)NCHUNK * 8 * 2 * 8192 * 4 <= WS_HEND, "chunk states fit the H overlay");
constexpr size_t WS_XCT = WS_HEND;
constexpr size_t WS_CC = WS_XCT + (size_t)NCHUNK * 8 * 8192 * 2;
constexpr size_t WS_CBM = WS_CC + (size_t)T * 256 * 2;
constexpr size_t WS_HIN = WS_CBM + (size_t)NCHUNK * 2 * 16384 * 2;
constexpr size_t WS_END = WS_HIN + (size_t)NCHUNK * 8 * 2 * 8192 * 2;

constexpr size_t OUT_Y = 0, OUT_SSD = (size_t)T * D, OUT_CKV = OUT_SSD + (size_t)32 * 2 * 2 * 8 * 64 * 128, OUT_KR = OUT_CKV + (size_t)32 * 2 * 256 * 256, OUT_END = OUT_KR + (size_t)32 * 2 * 256 * 32;

constexpr int RING_BYTES = 131072;
constexpr int LDSCTL_OFF = 144 * 1024 - 512, MISC_OFF = LDSCTL_OFF + 320;
constexpr int LDS_BYTES = 147456;

#define GAS __attribute__((address_space(1)))
#define LAS __attribute__((address_space(3)))
typedef unsigned short bf16;
typedef unsigned v4u __attribute__((ext_vector_type(4)));
typedef unsigned v2u __attribute__((ext_vector_type(2)));
typedef float f32x4 __attribute__((ext_vector_type(4)));
typedef short bf16x8 __attribute__((ext_vector_type(8)));
typedef GAS unsigned gu32;
#define RLX_AGENT __ATOMIC_RELAXED, __HIP_MEMORY_SCOPE_AGENT
__device__ __forceinline__ unsigned f2bf(float f) { unsigned u = __builtin_bit_cast(unsigned, f); return (u + 0x7fffu + ((u >> 16) & 1u)) >> 16; }
typedef float f32x2_t __attribute__((ext_vector_type(2)));
typedef __bf16 bf16x2_t __attribute__((ext_vector_type(2)));
__device__ __forceinline__ unsigned pk2(float lo, float hi) { const f32x2_t v = {lo, hi}; const bf16x2_t b = __builtin_convertvector(v, bf16x2_t); return __builtin_bit_cast(unsigned, b); }
__device__ __forceinline__ unsigned f2bf1(float f) { return pk2(f, 0.f) & 0xffffu; }
__device__ __forceinline__ float bflo(unsigned w) { return __builtin_bit_cast(float, w << 16); }
__device__ __forceinline__ float bfhi(unsigned w) { return __builtin_bit_cast(float, w & 0xffff0000u); }
__device__ __forceinline__ float bf1(bf16 h) { return __builtin_bit_cast(float, ((unsigned)h) << 16); }
__device__ __forceinline__ void unpack8(const v4u v, float* o) { o[0] = bflo(v.x); o[1] = bfhi(v.x); o[2] = bflo(v.y); o[3] = bfhi(v.y); o[4] = bflo(v.z); o[5] = bfhi(v.z); o[6] = bflo(v.w); o[7] = bfhi(v.w); }
__device__ __forceinline__ v4u pack8(const float* o) { v4u v; v.x = pk2(o[0], o[1]); v.y = pk2(o[2], o[3]); v.z = pk2(o[4], o[5]); v.w = pk2(o[6], o[7]); return v; }
template <int K> __device__ __forceinline__ float xlane(float v) { static_assert(K >= 1 && K < 32, "xor mask inside a 32-lane half");
    return __builtin_bit_cast(float, __builtin_amdgcn_ds_swizzle(__builtin_bit_cast(int, v), (K << 10) | 0x1F)); }
__device__ __forceinline__ float sum_x32(float v) { const unsigned u = __builtin_bit_cast(unsigned, v); const auto r = __builtin_amdgcn_permlane32_swap(u, u, false, false);
    return __builtin_bit_cast(float, (unsigned)r[0]) + __builtin_bit_cast(float, (unsigned)r[1]); }
__device__ __forceinline__ float max_x32(float v) { const unsigned u = __builtin_bit_cast(unsigned, v); const auto r = __builtin_amdgcn_permlane32_swap(u, u, false, false);
    return fmaxf(__builtin_bit_cast(float, (unsigned)r[0]), __builtin_bit_cast(float, (unsigned)r[1])); }
__device__ __forceinline__ float wave_sum(float v) {
    v += xlane<1>(v); v += xlane<2>(v); v += xlane<4>(v); v += xlane<8>(v); v += xlane<16>(v);
    return sum_x32(v);
}
__device__ __forceinline__ float frcp(float x) { return __builtin_amdgcn_rcpf(x); }
__device__ __forceinline__ float frsq(float x) { return __builtin_amdgcn_rsqf(x); }
__device__ __forceinline__ float sigmoidf_(float x) { return frcp(1.0f + __expf(-x)); }
__device__ __forceinline__ float siluf_(float x) { return x * frcp(1.0f + __expf(-x)); }
__device__ __forceinline__ float gelu_tanh(float x) { const float y = 0.7978845608028654f * (x + 0.044715f * x * x * x); const float t = 1.0f - 2.0f * frcp(1.0f + __expf(2.0f * y)); return 0.5f * x * (1.0f + t); }
__device__ __forceinline__ float softplusf_(float x) { const float e = __expf(x); return x > 20.f ? x : (e < 1e-3f ? e * (1.0f - 0.5f * e) : __logf(1.0f + e)); }
__device__ __forceinline__ int modrow_of_tile(int pm) { return pm < 32 ? 0 : 1 + ((pm - 32) >> 2); }
__device__ __forceinline__ int modrow_of_tok(int t) { return t < TCTX ? 0 : 1 + ((t - TCTX) >> 10); }

#define XB_TMO      128
#define XB_XCNT(j)  (256  + 64 * (j))
#define XB_XSUB(j)  (1280 + 64 * (j))
#define XB_XGEN(j)  (2304 + 64 * (j))
#define XB_TOP      3328
#define XB_TOPGEN   3392
#define XCD_BAR_WORDS 3456
#define XB_SPIN_CAP (1u << 22)
__device__ __forceinline__ unsigned xb_ld(unsigned* p)              { return __hip_atomic_load(p, __ATOMIC_RELAXED, __HIP_MEMORY_SCOPE_AGENT); }
__device__ __forceinline__ unsigned xb_add(unsigned* p, unsigned v) { return __hip_atomic_fetch_add(p, v, __ATOMIC_RELAXED, __HIP_MEMORY_SCOPE_AGENT); }
__device__ __forceinline__ unsigned xb_xcc_id() { return (unsigned)__builtin_amdgcn_s_getreg((3 << 11) | 20) & 0xFu; }
#define XB_SPIN(cond, bar) do { unsigned _sp = 0; while (cond) { __builtin_amdgcn_s_sleep(1); \
    if ((++_sp & 255u) == 0u) { if (xb_ld(&(bar)[XB_TMO])) break; if (_sp > XB_SPIN_CAP) { atomicAdd(&(bar)[XB_TMO], 1u); break; } } } } while (0)
struct XcdBarrier { unsigned* bar; unsigned x; volatile LAS unsigned* st; };
__device__ __forceinline__ XcdBarrier xcd_barrier_post(unsigned* bar, volatile LAS unsigned* st) {
    XcdBarrier b; b.bar = bar; b.x = xb_xcc_id(); b.st = st;
    if (threadIdx.x == 0) (void)xb_add(&bar[XB_XCNT(b.x)], 1u);
    return b;
}
__device__ __forceinline__ void xcd_barrier_complete(unsigned* bar, unsigned x, unsigned& nloc, unsigned& nx) {
    const unsigned G = gridDim.x * gridDim.y * gridDim.z;
    unsigned sum, cnt, mine, sp = 0u;
    for (;;) {
        sum = 0u; cnt = 0u; mine = 0u;
#pragma unroll
        for (unsigned j = 0; j < 16; ++j) { const unsigned c = xb_ld(&bar[XB_XCNT(j)]); sum += c; cnt += (c > 0u) ? 1u : 0u; mine = (j == x) ? c : mine; }
        if (sum == G) break;
        __builtin_amdgcn_s_sleep(1);
        if ((++sp & 255u) == 0u) { if (xb_ld(&bar[XB_TMO])) break; if (sp > XB_SPIN_CAP) { atomicAdd(&bar[XB_TMO], 1u); break; } }
    }
    nloc = mine > 0u ? mine : 1u; nx = cnt > 0u ? cnt : 1u;
}
__device__ __forceinline__ void xcd_barrier(const XcdBarrier& b) {
    asm volatile("s_waitcnt vmcnt(0)" ::: "memory");
    __syncthreads();
    if (threadIdx.x == 0) {
        unsigned* bar = b.bar;
        __builtin_amdgcn_s_waitcnt(0);
        unsigned nloc = b.st[0], nx = b.st[1];
        if (nloc == 0u) { xcd_barrier_complete(bar, b.x, nloc, nx); b.st[0] = nloc; b.st[1] = nx; }
        const unsigned k = b.st[2] + 1u; b.st[2] = k;
        const unsigned old = xb_add(&bar[XB_XSUB(b.x)], 1u);
        if (old + 1u == k * nloc) {
            __builtin_amdgcn_fence(__ATOMIC_RELEASE, "agent");
            asm volatile("s_waitcnt vmcnt(0)" ::: "memory");
            const unsigned og = xb_add(&bar[XB_TOP], 1u);
            if (og + 1u == k * nx) xb_add(&bar[XB_TOPGEN], 1u);
        }
        XB_SPIN(xb_ld(&bar[XB_TOPGEN]) < k, bar);
        __builtin_amdgcn_fence(__ATOMIC_ACQUIRE, "agent");
        asm volatile("s_waitcnt vmcnt(0)" ::: "memory");
    }
    __syncthreads();
}

struct Args { const float* in[34]; float* out; unsigned char* ws; int ph_lo, ph_hi, li, pad; };
typedef const __attribute__((address_space(4))) Args* CArgsP;
enum { I_XP = 0, I_XS, I_SSD, I_CCKV, I_CKR, I_C, I_CCTX, I_WMOD, I_BMOD, I_GNORM, I_WGU, I_WDN, I_WIE, I_WOE, I_WSP, I_BSP, I_GV, I_WCS, I_BCS, I_DTB, I_ALOG, I_DSK, I_GSO,
       I_WIO, I_WOO, I_GCQ, I_WUQ, I_GCKV, I_WUKV, I_WDW, I_BDW, I_GLN, I_BLN, I_GFIN };
using pg8::Unit;
constexpr int EP_PART = RING_BYTES, EP_S = RING_BYTES + 4096, EP_B = RING_BYTES + 4096 + 8192;
__device__ __forceinline__ void epi_prefetch_dma(GAS unsigned char* ws, int bias_off, const Unit& u, int wid, int lane, PG8_LAS unsigned char* ldsl, int par) {
    if (wid < 4) __builtin_amdgcn_global_load_lds((const GAS unsigned*)(ws + WS_SSQ + ((size_t)(u.pm * 256 + 64 * wid + lane) * 4) * 4), (PG8_LAS unsigned*)(ldsl + EP_S + par * 4096 + wid * 1024), 16, 0, 0);
    else if (wid == 4) __builtin_amdgcn_global_load_lds((const GAS unsigned*)(ws + WS_BIASF + ((size_t)bias_off / 16 + (size_t)modrow_of_tile(u.pm) * BIAS_LD + u.pn * 256 + 4 * lane) * 4), (PG8_LAS unsigned*)(ldsl + EP_B + par * 1024), 16, 0, 0);
}
__device__ __forceinline__ void epi_prefetch_sync16(GAS unsigned char* ws, int bias_off, const Unit& u, int tid, PG8_LAS unsigned char* ldsl, int par) {
    if (tid < 256) *(PG8_LAS pg8::f32x4*)(ldsl + EP_S + par * 4096 + tid * 16) = *(const GAS pg8::f32x4*)(ws + WS_SSQ + ((size_t)(u.pm * 256 + tid) * 4) * 4);
    else { const GAS float* bp = (const GAS float*)(ws + WS_BIAS) + (size_t)bias_off + (size_t)modrow_of_tile(u.pm) * BIAS_MS + u.pn * 256 + (tid - 256); float b = 0.f;
#pragma unroll
        for (int kb = 0; kb < 16; ++kb) b += bp[(size_t)kb * BIAS_LD];
        ((PG8_LAS float*)(ldsl + EP_B))[par * 256 + (tid - 256)] = b; }
}
__device__ __forceinline__ float epi_row_rstd(const PG8_LAS unsigned char* ldsl, int par, int rl) { const pg8::f32x4 s = *(const PG8_LAS pg8::f32x4*)(ldsl + EP_S + par * 4096 + rl * 16); return frsq(((s[0] + s[1]) + (s[2] + s[3])) * (1.f / D) + EPS); }
struct EpiSwiglu {
    static constexpr bool PERM = true; static constexpr int KIND = 1; struct Pre {};
    GAS unsigned char* ws; int bias_off, nparts;
    __device__ __forceinline__ void prefetch_dma(const Unit& u, int wid, int lane, PG8_LAS unsigned char* ldsl, int par) const { if (nparts == 1) epi_prefetch_dma(ws, bias_off, u, wid, lane, ldsl, par); }
    __device__ __forceinline__ void prefetch_sync(const Unit& u, int tid, PG8_LAS unsigned char* ldsl, int par) const { if (nparts != 1) epi_prefetch_sync16(ws, bias_off, u, tid, ldsl, par); }
    __device__ __forceinline__ void operator()(const pg8::f32x4 (&acc)[2][2][4][2], const Unit& u, int wr, int wc, int fr, int fq, PG8_LAS unsigned char* ldsl, int par) const {
        bf16* H = (bf16*)(GAS bf16*)(ws + WS_H);
        const PG8_LAS float* bb = (const PG8_LAS float*)(ldsl + EP_B) + par * 256 + wc * 32 + 8 * fq;
        const int row0 = u.pm * 256 + wr * 64 + fr, col0 = u.pn * 128 + wc * 32 + 8 * fq;
        const pg8::f32x4 bg0 = *(const PG8_LAS pg8::f32x4*)bb, bg1 = *(const PG8_LAS pg8::f32x4*)(bb + 4), bu0 = *(const PG8_LAS pg8::f32x4*)(bb + 128), bu1 = *(const PG8_LAS pg8::f32x4*)(bb + 132);
#pragma unroll
        for (int ai = 0; ai < 2; ++ai)
#pragma unroll
            for (int m = 0; m < 4; ++m) {
                const int rl = ai * 128 + wr * 64 + m * 16 + fr;
                const float rs = epi_row_rstd(ldsl, par, rl);
                bf16* rowp = H + (size_t)(u.pm * 256 + rl) * DFF + col0;
                const pg8::f32x4 g0 = acc[ai][0][m][0] * rs + bg0, g1 = acc[ai][0][m][1] * rs + bg1, u0 = acc[ai][1][m][0] * rs + bu0, u1 = acc[ai][1][m][1] * rs + bu1;
                float gg[8], uu[8], e[8], o[8];
#pragma unroll
                for (int j = 0; j < 4; ++j) { gg[j] = g0[j]; gg[4 + j] = g1[j]; uu[j] = u0[j]; uu[4 + j] = u1[j]; }
#pragma unroll
                for (int j = 0; j < 8; ++j) e[j] = __builtin_amdgcn_exp2f(gg[j] * -1.4426950408889634f);
#pragma unroll
                for (int j = 0; j < 8; ++j) e[j] = __builtin_amdgcn_rcpf(1.0f + e[j]);
#pragma unroll
                for (int j = 0; j < 8; ++j) o[j] = (gg[j] * uu[j]) * e[j];
                pg8::u32x4 w; w.x = pg8::cvt_pk_bf16(o[0], o[1]); w.y = pg8::cvt_pk_bf16(o[2], o[3]); w.z = pg8::cvt_pk_bf16(o[4], o[5]); w.w = pg8::cvt_pk_bf16(o[6], o[7]);
                *(pg8::u32x4*)rowp = w;
            }
        (void)row0;
    }
};
struct EpiResid {
    static constexpr bool PERM = true; static constexpr int KIND = 4;
    GAS unsigned char* ws; const float* gn; int gate_off, scn_off; float coef;
    __device__ __forceinline__ void prefetch_dma(const Unit&, int, int, PG8_LAS unsigned char*, int) const {}
    __device__ __forceinline__ void prefetch_sync(const Unit&, int, PG8_LAS unsigned char*, int) const {}
    __device__ __forceinline__ void operator()(const pg8::f32x4 (&acc)[2][2][4][2], const Unit& u, int wr, int wc, int fr, int fq, PG8_LAS unsigned char* ldsl, int) const {
        bf16* X = (bf16*)(GAS bf16*)(ws + WS_X); const float* gate = (const float*)(const GAS float*)(ws + WS_MOD) + gate_off; const float* scn = (const float*)(const GAS float*)(ws + WS_MOD) + scn_off;
        bf16* XA = (bf16*)(GAS bf16*)(ws + WS_XA); float* SSQ = (float*)(GAS float*)(ws + WS_SSQ); PG8_LAS float* part = (PG8_LAS float*)(ldsl + EP_PART);
        const int row0 = u.pm * 256 + wr * 64 + fr, col0 = u.pn * 256 + wc * 32 + 8 * fq;
        const int mr = modrow_of_tile(u.pm);
        float ss[2][4];
#pragma unroll
        for (int ai = 0; ai < 2; ++ai)
#pragma unroll
            for (int m = 0; m < 4; ++m) ss[ai][m] = 0.f;
#pragma unroll
        for (int bj = 0; bj < 2; ++bj) {
            const int co = col0 + bj * 128;
            const float* gp = gate + (size_t)mr * NMODV + co; const float* sp = scn + (size_t)mr * NMODV + co;
            const pg8::f32x4 gv0 = *(const pg8::f32x4*)gp * coef, gv1 = *(const pg8::f32x4*)(gp + 4) * coef;
            const pg8::f32x4 gc0 = *(const pg8::f32x4*)(gn + co) * (*(const pg8::f32x4*)sp + 1.0f), gc1 = *(const pg8::f32x4*)(gn + co + 4) * (*(const pg8::f32x4*)(sp + 4) + 1.0f);
#pragma unroll
            for (int ai = 0; ai < 2; ++ai) {
                pg8::u32x4 xo[4];
#pragma unroll
                for (int m = 0; m < 4; ++m) xo[m] = *(const pg8::u32x4*)(X + (size_t)(row0 + ai * 128 + m * 16) * D + co);
#pragma unroll
                for (int m = 0; m < 4; ++m) {
                    const size_t off = (size_t)(row0 + ai * 128 + m * 16) * D + co;
                    const pg8::u32x4 xw = xo[m];
                    const pg8::f32x4 x0 = {bflo(xw.x), bfhi(xw.x), bflo(xw.y), bfhi(xw.y)}, x1 = {bflo(xw.z), bfhi(xw.z), bflo(xw.w), bfhi(xw.w)};
                    const pg8::f32x4 n0 = x0 + gv0 * acc[ai][bj][m][0], n1 = x1 + gv1 * acc[ai][bj][m][1];
                    ss[ai][m] += ((n0[0] * n0[0] + n0[1] * n0[1]) + (n0[2] * n0[2] + n0[3] * n0[3])) + ((n1[0] * n1[0] + n1[1] * n1[1]) + (n1[2] * n1[2] + n1[3] * n1[3]));
                    pg8::u32x4 w; w.x = pg8::cvt_pk_bf16(n0[0], n0[1]); w.y = pg8::cvt_pk_bf16(n0[2], n0[3]); w.z = pg8::cvt_pk_bf16(n1[0], n1[1]); w.w = pg8::cvt_pk_bf16(n1[2], n1[3]);
                    *(pg8::u32x4*)(X + off) = w;
                    const pg8::f32x4 a0 = n0 * gc0, a1 = n1 * gc1;
                    pg8::u32x4 v; v.x = pg8::cvt_pk_bf16(a0[0], a0[1]); v.y = pg8::cvt_pk_bf16(a0[2], a0[3]); v.z = pg8::cvt_pk_bf16(a1[0], a1[1]); v.w = pg8::cvt_pk_bf16(a1[2], a1[3]);
                    *(pg8::u32x4*)(XA + off) = v;
                }
            }
        }
#pragma unroll
        for (int ai = 0; ai < 2; ++ai)
#pragma unroll
            for (int m = 0; m < 4; ++m) { float s = ss[ai][m]; s += xlane<16>(s); s = sum_x32(s);
                if (fq == 0) part[wc * 256 + ai * 128 + wr * 64 + m * 16 + fr] = s; }
        asm volatile("s_waitcnt lgkmcnt(0)" ::: "memory"); __builtin_amdgcn_s_barrier(); asm volatile("" ::: "memory");
        const int t = (wr * 4 + wc) * 64 + fq * 16 + fr;
        if (t < 256) SSQ[(size_t)(u.pm * 256 + t) * 4 + u.pn] = (part[t] + part[256 + t]) + (part[512 + t] + part[768 + t]);
    }
};
struct EpiResid160 {
    static constexpr bool PERM = true; static constexpr int KIND = 4;
    GAS unsigned char* ws; const float* gn; int gate_off, scn_off; float coef;
    struct Pre { pg8::u32x4 xo[2][5]; };
    __device__ __forceinline__ void prefetch_dma(const Unit&, int, int, PG8_LAS unsigned char*, int) const {}
    __device__ __forceinline__ void prefetch_sync(const Unit&, int, PG8_LAS unsigned char*, int) const {}
    __device__ __forceinline__ void pre_dma(const Unit& u, int wid, int lane, PG8_LAS unsigned char* ldsl) const {
        const int rowbase = u.pm * 160, mrA = modrow_of_tok(rowbase), mrB = modrow_of_tok(rowbase + 159), col = u.pn * 256 + 4 * lane;
        if (wid < 5) {
            const int mr = wid >= 3 ? mrB : mrA;
            const GAS float* modp = (const GAS float*)(ws + WS_MOD) + (size_t)mr * NMODV + col;
            const GAS float* src = (wid == 2) ? (const GAS float*)gn + col : ((wid == 0 || wid == 3) ? modp + gate_off : modp + scn_off);
            __builtin_amdgcn_global_load_lds((const GAS unsigned*)src, (PG8_LAS unsigned*)(ldsl + EP_S + wid * 1024), 16, 0, 0);
        }
    }
    __device__ __forceinline__ void pre_x(Pre& pre, const Unit& u, int wr, int wc, int fr, int fq) const {
        const bf16* X = (const bf16*)(const GAS bf16*)(ws + WS_X);
        const int rowbase = u.pm * 160, col0 = u.pn * 256 + wc * 32 + 8 * fq;
#pragma unroll
        for (int bj = 0; bj < 2; ++bj)
#pragma unroll
            for (int i = 0; i < 5; ++i) { const int rl = i < 4 ? wr * 64 + i * 16 + fr : 128 + wr * 16 + fr; pre.xo[bj][i] = *(const pg8::u32x4*)(X + (size_t)(rowbase + rl) * D + col0 + bj * 128); }
    }
    __device__ __forceinline__ void operator()(const pg8::f32x4 (&acc)[2][2][4][2], const Unit& u, int wr, int wc, int fr, int fq, PG8_LAS unsigned char* ldsl, const Pre& pre) const {
        bf16* X = (bf16*)(GAS bf16*)(ws + WS_X);
        bf16* XA = (bf16*)(GAS bf16*)(ws + WS_XA); float* SSQ = (float*)(GAS float*)(ws + WS_SSQ); PG8_LAS float* part = (PG8_LAS float*)(ldsl + EP_PART);
        const PG8_LAS float* V = (const PG8_LAS float*)(ldsl + EP_S);
        const int rowbase = u.pm * 160, col0 = u.pn * 256 + wc * 32 + 8 * fq;
        const int mrA = modrow_of_tok(rowbase), mrB = modrow_of_tok(rowbase + 159);
        const int bnd = (mrA == mrB) ? (1 << 30) : (mrB == 1 ? TCTX : TCTX + 1024);
        float ss[5];
#pragma unroll
        for (int i = 0; i < 5; ++i) ss[i] = 0.f;
#pragma unroll
        for (int bj = 0; bj < 2; ++bj) {
            const int co = col0 + bj * 128, cl = wc * 32 + 8 * fq + bj * 128;
            const pg8::f32x4 gn0 = *(const PG8_LAS pg8::f32x4*)(V + 512 + cl), gn1 = *(const PG8_LAS pg8::f32x4*)(V + 512 + cl + 4);
            const pg8::f32x4 gvA0 = *(const PG8_LAS pg8::f32x4*)(V + cl) * coef, gvA1 = *(const PG8_LAS pg8::f32x4*)(V + cl + 4) * coef, gvB0 = *(const PG8_LAS pg8::f32x4*)(V + 768 + cl) * coef, gvB1 = *(const PG8_LAS pg8::f32x4*)(V + 768 + cl + 4) * coef;
            const pg8::f32x4 gcA0 = gn0 * (*(const PG8_LAS pg8::f32x4*)(V + 256 + cl) + 1.0f), gcA1 = gn1 * (*(const PG8_LAS pg8::f32x4*)(V + 256 + cl + 4) + 1.0f);
            const pg8::f32x4 gcB0 = gn0 * (*(const PG8_LAS pg8::f32x4*)(V + 1024 + cl) + 1.0f), gcB1 = gn1 * (*(const PG8_LAS pg8::f32x4*)(V + 1024 + cl + 4) + 1.0f);
#pragma unroll
            for (int i = 0; i < 5; ++i) {
                const int rb = i < 4 ? wr * 64 + i * 16 : 128 + wr * 16;
                const bool hb = rowbase + rb >= bnd;
                const pg8::f32x4 gv0 = hb ? gvB0 : gvA0, gv1 = hb ? gvB1 : gvA1, gc0 = hb ? gcB0 : gcA0, gc1 = hb ? gcB1 : gcA1;
                const size_t off = (size_t)(rowbase + rb + fr) * D + co;
                const pg8::u32x4 xw = pre.xo[bj][i];
                const pg8::f32x4 c0 = i < 4 ? acc[0][bj][i & 3][0] : acc[1][bj][0][0], c1 = i < 4 ? acc[0][bj][i & 3][1] : acc[1][bj][0][1];
                const pg8::f32x4 x0 = {bflo(xw.x), bfhi(xw.x), bflo(xw.y), bfhi(xw.y)}, x1 = {bflo(xw.z), bfhi(xw.z), bflo(xw.w), bfhi(xw.w)};
                const pg8::f32x4 n0 = x0 + gv0 * c0, n1 = x1 + gv1 * c1;
                ss[i] += ((n0[0] * n0[0] + n0[1] * n0[1]) + (n0[2] * n0[2] + n0[3] * n0[3])) + ((n1[0] * n1[0] + n1[1] * n1[1]) + (n1[2] * n1[2] + n1[3] * n1[3]));
                pg8::u32x4 w; w.x = pg8::cvt_pk_bf16(n0[0], n0[1]); w.y = pg8::cvt_pk_bf16(n0[2], n0[3]); w.z = pg8::cvt_pk_bf16(n1[0], n1[1]); w.w = pg8::cvt_pk_bf16(n1[2], n1[3]);
                *(pg8::u32x4*)(X + off) = w;
                const pg8::f32x4 a0 = n0 * gc0, a1 = n1 * gc1;
                pg8::u32x4 v; v.x = pg8::cvt_pk_bf16(a0[0], a0[1]); v.y = pg8::cvt_pk_bf16(a0[2], a0[3]); v.z = pg8::cvt_pk_bf16(a1[0], a1[1]); v.w = pg8::cvt_pk_bf16(a1[2], a1[3]);
                *(pg8::u32x4*)(XA + off) = v;
            }
        }
#pragma unroll
        for (int i = 0; i < 5; ++i) { float s = ss[i]; s += xlane<16>(s); s = sum_x32(s);
            if (fq == 0) part[wc * 160 + (i < 4 ? wr * 64 + i * 16 + fr : 128 + wr * 16 + fr)] = s; }
        asm volatile("s_waitcnt lgkmcnt(0)" ::: "memory"); __builtin_amdgcn_s_barrier(); asm volatile("" ::: "memory");
        const int t = (wr * 4 + wc) * 64 + fq * 16 + fr;
        if (t < 160) SSQ[(size_t)(rowbase + t) * 4 + u.pn] = (part[t] + part[160 + t]) + (part[320 + t] + part[480 + t]);
    }
};
struct EpiStore {
    static constexpr bool PERM = true; static constexpr int KIND = 2; struct Pre {};
    GAS unsigned char* ws; unsigned o_off; int ldc; int bias_off;
    __device__ __forceinline__ void prefetch_dma(const Unit& u, int wid, int lane, PG8_LAS unsigned char* ldsl, int par) const { if (bias_off >= 0) epi_prefetch_dma(ws, bias_off, u, wid, lane, ldsl, par); }
    __device__ __forceinline__ void prefetch_sync(const Unit&, int, PG8_LAS unsigned char*, int) const {}
    __device__ __forceinline__ void operator()(const pg8::f32x4 (&acc)[2][2][4][2], const Unit& u, int wr, int wc, int fr, int fq, PG8_LAS unsigned char* ldsl, int par) const {
        bf16* O = (bf16*)(GAS bf16*)(ws + o_off);
        const PG8_LAS float* bb = (const PG8_LAS float*)(ldsl + EP_B) + par * 256 + wc * 32 + 8 * fq;
        const int col0 = u.pn * 256 + wc * 32 + 8 * fq; const bool nrm = bias_off >= 0;
        pg8::f32x4 b[2][2];
#pragma unroll
        for (int bj = 0; bj < 2; ++bj)
#pragma unroll
            for (int n = 0; n < 2; ++n) { const pg8::f32x4 bv = *(const PG8_LAS pg8::f32x4*)(bb + bj * 128 + 4 * n); b[bj][n] = nrm ? bv : (pg8::f32x4){0.f, 0.f, 0.f, 0.f}; }
#pragma unroll
        for (int ai = 0; ai < 2; ++ai)
#pragma unroll
            for (int m = 0; m < 4; ++m) {
                const int rl = ai * 128 + wr * 64 + m * 16 + fr;
                const float rs0 = epi_row_rstd(ldsl, par, rl), rs = nrm ? rs0 : 1.0f;
                bf16* rowp = O + (size_t)(u.pm * 256 + rl) * ldc + col0;
#pragma unroll
                for (int bj = 0; bj < 2; ++bj) {
                    const pg8::f32x4 v0 = acc[ai][bj][m][0] * rs + b[bj][0], v1 = acc[ai][bj][m][1] * rs + b[bj][1];
                    pg8::u32x4 w; w.x = pg8::cvt_pk_bf16(v0[0], v0[1]); w.y = pg8::cvt_pk_bf16(v0[2], v0[3]); w.z = pg8::cvt_pk_bf16(v1[0], v1[1]); w.w = pg8::cvt_pk_bf16(v1[2], v1[3]);
                    *(pg8::u32x4*)(rowp + bj * 128) = w;
                }
            }
    }
};

struct Frame {
    unsigned char* lds;
    mutable int tid, lane; int wave, bid, G;
    __device__ __forceinline__ void relane() const { int ln; asm volatile("v_mbcnt_lo_u32_b32 %0, -1, 0\n\tv_mbcnt_hi_u32_b32 %0, -1, %0" : "=v"(ln)); lane = ln; tid = wave * 64 + ln; }
    CArgsP a;
    GAS unsigned char* ws;
};
#define WSP(type, off) ((type*)(GAS type*)(F.ws + (off)))
#define AIN(i) ((const float*)(const GAS float*)F.a->in[i])
#define AOUT ((float*)(GAS float*)F.a->out)

struct ConvD { const float* W; bf16* WT; const float* shift; float* bias_out; int N, ldt, k0, n0, dst; };
__device__ __forceinline__ void conv_load(const ConvD& d, int lane, f32x4 (&v)[8]) {
    const int n4 = (lane & 7) * 4; const bool ok4 = d.n0 + n4 < d.N;
#pragma unroll
    for (int i = 0; i < 8; ++i) { const int kk = 8 * i + (lane >> 3);
        v[i] = ok4 ? *(const f32x4*)(d.W + (size_t)(d.k0 + kk) * d.N + d.n0 + n4) : (f32x4){0.f, 0.f, 0.f, 0.f}; }
}
__device__ __forceinline__ void conv_proc(const ConvD& d, const f32x4 (&v)[8], float* scr, int lane) {
    const int n4 = (lane & 7) * 4;
#pragma unroll
    for (int i = 0; i < 8; ++i) { const int kk = 8 * i + (lane >> 3);
        scr[kk * 33 + n4] = v[i].x; scr[kk * 33 + n4 + 1] = v[i].y; scr[kk * 33 + n4 + 2] = v[i].z; scr[kk * 33 + n4 + 3] = v[i].w; }
    if (d.bias_out) {
#pragma unroll
        for (int m = 0; m < 3; ++m) scr[64 * 33 + m * 64 + lane] = d.shift[(size_t)m * NMODV + lane];
    }
    asm volatile("s_waitcnt lgkmcnt(0)" ::: "memory");
    const int c = lane & 7;
#pragma unroll
    for (int j = 0; j < 4; ++j) { const int nn = (lane >> 3) + 8 * j; const float* s = scr + (8 * c) * 33 + nn;
        v4u o; o.x = pk2(s[0 * 33], s[1 * 33]); o.y = pk2(s[2 * 33], s[3 * 33]); o.z = pk2(s[4 * 33], s[5 * 33]); o.w = pk2(s[6 * 33], s[7 * 33]);
        *(v4u*)(d.WT + (size_t)(d.dst + nn) * d.ldt + d.k0 + 8 * c) = o; }
    if (d.bias_out) {
        const int kh = lane >> 5, nl = lane & 31; float a0 = 0.f, a1 = 0.f, a2 = 0.f;
#pragma unroll 8
        for (int i = 0; i < 32; ++i) { const int kk = kh * 32 + i; const float wv = scr[kk * 33 + nl];
            a0 += wv * scr[64 * 33 + kk]; a1 += wv * scr[64 * 33 + 64 + kk]; a2 += wv * scr[64 * 33 + 128 + kk]; }
        a0 = sum_x32(a0); a1 = sum_x32(a1); a2 = sum_x32(a2);
        if (lane < 32) { float* bo = d.bias_out + (size_t)(d.k0 >> 6) * BIAS_LD + d.dst + nl; bo[0] = a0; bo[BIAS_MS] = a1; bo[2 * BIAS_MS] = a2; }
    }
    asm volatile("s_waitcnt lgkmcnt(0)" ::: "memory");
}
constexpr int CI_DN = 44 * 32, CI_OE = 16 * 32, CI_UQ = 6 * 24, CI_KV = 4 * 32, CI_GU = 16 * 176, CI_IE = 16 * 88, CI_IO = 16 * 56;
__host__ __device__ constexpr int conv_na(int l) { return 2 * CI_DN + CI_OE + ((l & 1) ? CI_UQ + CI_KV : 0); }
__host__ __device__ constexpr int conv_nb(int l) { return 2 * CI_GU + ((l & 1) ? CI_IO : CI_IE); }
__device__ __forceinline__ ConvD conv_desc_a(const Frame& F, int l, int it) {
    int r = it; const int hi = l >> 1;
    if (r < 2 * CI_DN) { const int w = l * 2 + r / CI_DN, q = r % CI_DN, kb = q / 32, nb = q % 32;
        return ConvD{AIN(I_WDN) + (size_t)w * DFF * 1024, WSP(bf16, WS_WD + w * SZ_WD), nullptr, nullptr, 1024, DFF, kb * 64, nb * 32, nb * 32}; } r -= 2 * CI_DN;
    if (r < CI_OE) { const int kb = r / 32, nb = r % 32;
        if (l & 1) return ConvD{AIN(I_WOO) + (size_t)hi * 1024 * 1024, WSP(bf16, WS_WOO + hi * SZ_WO), nullptr, nullptr, 1024, 1024, kb * 64, nb * 32, nb * 32};
        return ConvD{AIN(I_WOE) + (size_t)hi * 1024 * 1024, WSP(bf16, WS_WOE + hi * SZ_WO), nullptr, nullptr, 1024, 1024, kb * 64, nb * 32, nb * 32}; } r -= CI_OE;
    if (r < CI_UQ) { const int kb = r / 24, nb = r % 24;
        return ConvD{AIN(I_WUQ) + (size_t)hi * 384 * 768, WSP(bf16, WS_WUQ + hi * SZ_WUQ), nullptr, nullptr, 768, 384, kb * 64, nb * 32, nb * 32}; } r -= CI_UQ;
    { const int kb = r / 32, nb = r % 32, n0 = nb * 32, h = n0 >> 7, rr = n0 & 127;
        const int dst = (rr < 64 ? 0 : 512) + h * 64 + (rr & 63);
        return ConvD{AIN(I_WUKV) + (size_t)hi * 256 * 1024, WSP(bf16, WS_WKV + hi * SZ_WKV), nullptr, nullptr, 1024, 256, kb * 64, n0, dst}; }
}
__device__ __forceinline__ ConvD conv_desc_b(const Frame& F, int l, int it) {
    int r = it; const int hi = l >> 1; const float* MOD = WSP(float, WS_MOD) + (size_t)l * 3 * NMODV; float* BIAS = WSP(float, WS_BIAS) + (size_t)(l * 3) * 3 * BIAS_MS;
    if (r < 2 * CI_GU) { const int f = r / CI_GU, w = l * 2 + f, q = r % CI_GU, kb = q / 176, nb = q % 176, n0 = nb * 32;
        const int dst = (n0 < DFF) ? ((n0 >> 7) * 256 + (n0 & 127)) : (((n0 - DFF) >> 7) * 256 + 128 + ((n0 - DFF) & 127));
        return ConvD{AIN(I_WGU) + (size_t)w * 1024 * 5632, WSP(bf16, WS_WGU + w * SZ_WGU), MOD + (f == 0 ? 0 : 6) * 1024 + kb * 64, BIAS + (size_t)(f == 0 ? 0 : 2) * 3 * BIAS_MS, 5632, 1024, kb * 64, n0, dst}; } r -= 2 * CI_GU;
    if (l & 1) { const int kb = r / 56, nb = r % 56;
        return ConvD{AIN(I_WIO) + (size_t)hi * 1024 * 1696, WSP(bf16, WS_WIO + hi * SZ_WIO), MOD + 3 * 1024 + kb * 64, BIAS + (size_t)3 * BIAS_MS, 1696, 1024, kb * 64, nb * 32, nb * 32}; }
    { const int kb = r / 88, nb = r % 88;
        return ConvD{AIN(I_WIE) + (size_t)hi * 1024 * 2576, WSP(bf16, WS_WIE + hi * SZ_WIE), MOD + 3 * 1024 + kb * 64, BIAS + (size_t)3 * BIAS_MS, 2576, 1024, kb * 64, nb * 32, nb * 32}; }
}
template <bool LB> __device__ __forceinline__ void conv_run(const Frame& F, int l, int lo, int hi, int gw, int NGW, float* scr) {
    int it = lo + gw; if (it >= hi) return;
    ConvD d = LB ? conv_desc_b(F, l, it) : conv_desc_a(F, l, it);
    f32x4 v[8]; conv_load(d, F.lane, v);
    for (;;) {
        const int itn = it + NGW; const bool more = itn < hi;
        ConvD dn = d; f32x4 vn[8];
        if (more) { dn = LB ? conv_desc_b(F, l, itn) : conv_desc_a(F, l, itn); conv_load(dn, F.lane, vn); }
        conv_proc(d, v, scr, F.lane);
        if (!more) break;
        d = dn; it = itn;
#pragma unroll
        for (int i = 0; i < 8; ++i) v[i] = vn[i];
    }
}
template <int N4> __device__ __forceinline__ void mod_tile(const Frame& F, int l, int tile) {
    constexpr int KG = 504 / N4, NC = 4 * N4, NTW = KG * N4;
    float* sv = (float*)F.lds;
    float* red = (float*)(F.lds + 12288);
    __syncthreads();
    for (int i = F.tid; i < 3072; i += NTHR) { const int r = i >> 10, k = i & 1023; const float c = (r == 0) ? AIN(I_CCTX)[k] : AIN(I_C)[(r - 1) * 1024 + k]; sv[i] = siluf_(c); }
    __syncthreads();
    const int n0 = tile * NC, n4 = F.tid % N4, kg = F.tid / N4;
    if (F.tid < NTW) {
        f32x4 a0 = {0.f, 0.f, 0.f, 0.f}, a1 = a0, a2 = a0;
        const float* wp = AIN(I_WMOD) + (size_t)l * 1024 * NMODV + n0 + 4 * n4;
#pragma unroll 8
        for (int k = kg; k < 1024; k += KG) { const f32x4 w = *(const f32x4*)(wp + (size_t)k * NMODV); a0 += w * sv[k]; a1 += w * sv[1024 + k]; a2 += w * sv[2048 + k]; }
        *(f32x4*)(red + (kg * 3 + 0) * NC + 4 * n4) = a0; *(f32x4*)(red + (kg * 3 + 1) * NC + 4 * n4) = a1; *(f32x4*)(red + (kg * 3 + 2) * NC + 4 * n4) = a2;
    }
    __syncthreads();
    for (int o = F.tid; o < 3 * NC; o += NTHR) { const int r = o / NC, n = o % NC; float s = AIN(I_BMOD)[l * NMODV + n0 + n];
        for (int g = 0; g < KG; ++g) s += red[(g * 3 + r) * NC + n];
        WSP(float, WS_MOD)[(size_t)(l * 3 + r) * NMODV + n0 + n] = s; }
    __syncthreads();
}
__device__ __forceinline__ void bias_reduce(const Frame& F, int l, int kmask, int bgi, int nbg) {
    const float* BP = WSP(float, WS_BIAS); float* BF = WSP(float, WS_BIASF);
    const int gt = bgi * NTHR + F.tid, NT = nbg * NTHR;
    for (int i = gt; i < 3 * 3 * (int)BIAS_LD; i += NT) { const int kind = i / (3 * (int)BIAS_LD), rem = i % (3 * (int)BIAS_LD), m = rem / (int)BIAS_LD, n = rem % (int)BIAS_LD;
        if (!((kmask >> kind) & 1)) continue;
        const float* p = BP + ((size_t)(l * 3 + kind) * 3 + m) * BIAS_MS + n; float b = 0.f;
#pragma unroll
        for (int kb = 0; kb < 16; ++kb) b += p[(size_t)kb * BIAS_LD];
        BF[((size_t)(l * 3 + kind) * 3 + m) * BIAS_LD + n] = b; }
}
__device__ __forceinline__ void background_work(const Frame& F, int l, int win, int bgi, int nbg) {
    F.relane();
    if (nbg <= 0) return;
    if (win == 0) bias_reduce(F, l, 6, bgi, nbg);
    if (l >= 3) return;
    const int ln = l + 1;
    float* scr = (float*)(F.lds + F.wave * 16384);
    const int gw = bgi * NWAVES + F.wave, NGW = nbg * NWAVES;
    if (win == 0) {
        for (int t = bgi; t < 144; t += nbg) mod_tile<16>(F, ln, t);
        conv_run<false>(F, ln, 0, conv_na(ln), gw, NGW, scr);
    } else {
        conv_run<true>(F, ln, 0, conv_nb(ln), gw, NGW, scr);
    }
}
__device__ __forceinline__ void p0_phase(const Frame& F) {
    F.relane();
    for (int t = F.bid; t < 256; t += F.G) mod_tile<9>(F, 0, t);
    {
        float* scr = (float*)(F.lds + F.wave * 16384);
        const int gw = F.bid * NWAVES + F.wave, NGW = F.G * NWAVES;
        conv_run<false>(F, 0, 0, conv_na(0), gw, NGW, scr);
    }
    {
        const size_t gt = (size_t)F.bid * NTHR + F.tid, NT = (size_t)F.G * NTHR;
        for (size_t i = gt; i < 1024 * 16; i += NT) { const int pos = (int)(i >> 4), ax = (int)(i >> 3) & 1, f = (int)i & 7;
            const float freq = exp2f(-(float)f * (13.287712379549449f / 8.0f));
            const float ang = (float)(ax == 0 ? (pos >> 6) : (pos & 63)) * freq;
            float sn, cs; sincosf(ang, &sn, &cs);
            WSP(float, WS_ROPE)[2 * i] = cs; WSP(float, WS_ROPE)[2 * i + 1] = sn; }
    }
}
__device__ __forceinline__ void p1_copy_phase(const Frame& F) {
    F.relane();
    float* scr = (float*)(F.lds + F.wave * 16384);
    const int gw = F.bid * NWAVES + F.wave, NGW = F.G * NWAVES;
    conv_run<true>(F, 0, 0, conv_nb(0), gw, NGW, scr);
}

__device__ __forceinline__ void norm0_phase(const Frame& F) {
    F.relane();
    const int gw = F.bid * NWAVES + F.wave, NGW = F.G * NWAVES;
    bf16* X = WSP(bf16, WS_X); bf16* XA = WSP(bf16, WS_XA); float* SSQ = WSP(float, WS_SSQ);
    const float* g = AIN(I_GNORM); const float* scale = WSP(float, WS_MOD) + 1024;
    constexpr int RB = 5;
    for (int row0 = gw; row0 < T; row0 += RB * NGW) {
        f32x4 v[RB][4];
#pragma unroll
        for (int q = 0; q < RB; ++q) { const int row = row0 + q * NGW; if (row < T) {
            const f32x4* xr = (const f32x4*)(row < TCTX ? AIN(I_XP) + (size_t)row * D : AIN(I_XS) + (size_t)(row - TCTX) * D) + F.lane;
#pragma unroll
            for (int j = 0; j < 4; ++j) v[q][j] = xr[64 * j]; } }
#pragma unroll
        for (int q = 0; q < RB; ++q) { const int row = row0 + q * NGW; if (row < T) {
            const int r = modrow_of_tok(row);
            float s = 0.f;
#pragma unroll
            for (int j = 0; j < 4; ++j) s += (v[q][j].x * v[q][j].x + v[q][j].y * v[q][j].y) + (v[q][j].z * v[q][j].z + v[q][j].w * v[q][j].w);
            s = wave_sum(s);
            if (F.lane == 0) *(f32x4*)(SSQ + (size_t)row * 4) = (f32x4){s, 0.f, 0.f, 0.f};
            unsigned long long* o8 = (unsigned long long*)(XA + (size_t)row * D) + F.lane;
            unsigned long long* xo = (unsigned long long*)(X + (size_t)row * D) + F.lane;
#pragma unroll
            for (int j = 0; j < 4; ++j) {
                const f32x4 gg = *((const f32x4*)g + F.lane + 64 * j), sc = *((const f32x4*)(scale + (size_t)r * NMODV) + F.lane + 64 * j);
                const f32x4 o = v[q][j] * gg * (sc + 1.0f);
                xo[64 * j] = (unsigned long long)pk2(v[q][j].x, v[q][j].y) | ((unsigned long long)pk2(v[q][j].z, v[q][j].w) << 32);
                o8[64 * j] = (unsigned long long)pk2(o.x, o.y) | ((unsigned long long)pk2(o.z, o.w) << 32);
            } } }
    }
}
__device__ __forceinline__ void final_phase(const Frame& F) {
    F.relane();
    const int gw = F.bid * NWAVES + F.wave, NGW = F.G * NWAVES;
    const bf16* X = WSP(bf16, WS_X); const float* g = AIN(I_GFIN); float* out = AOUT + OUT_Y;
    constexpr int RB = 5;
    for (int row0 = gw; row0 < T; row0 += RB * NGW) {
        v2u w[RB][4];
#pragma unroll
        for (int q = 0; q < RB; ++q) { const int row = row0 + q * NGW; if (row < T) {
            const v2u* xr = (const v2u*)(X + (size_t)row * D) + F.lane;
#pragma unroll
            for (int j = 0; j < 4; ++j) w[q][j] = xr[64 * j]; } }
#pragma unroll
        for (int q = 0; q < RB; ++q) { const int row = row0 + q * NGW; if (row < T) {
            f32x4 v[4]; float s = 0.f;
#pragma unroll
            for (int j = 0; j < 4; ++j) { v[j] = (f32x4){bflo(w[q][j].x), bfhi(w[q][j].x), bflo(w[q][j].y), bfhi(w[q][j].y)}; s += (v[j].x * v[j].x + v[j].y * v[j].y) + (v[j].z * v[j].z + v[j].w * v[j].w); }
            const float rstd = frsq(wave_sum(s) * (1.f / D) + EPS);
            f32x4* o = (f32x4*)(out + (size_t)row * D) + F.lane;
#pragma unroll
            for (int j = 0; j < 4; ++j) o[64 * j] = v[j] * rstd * *((const f32x4*)g + F.lane + 64 * j);
        } }
    }
}
constexpr int LDT = 136;
__device__ __forceinline__ bf16x8 ld_frag16(const unsigned char* p) { return *(const bf16x8*)p; }
__device__ __forceinline__ bf16x8 ld_frag8x2(const unsigned char* p0, const unsigned char* p1) {
    const v2u a = *(const v2u*)p0, b = *(const v2u*)p1; v4u v; v.x = a.x; v.y = a.y; v.z = b.x; v.w = b.y; return __builtin_bit_cast(bf16x8, v); }
#define MFMA16(a, b, c) __builtin_amdgcn_mfma_f32_16x16x32_bf16((a), (b), (c), 0, 0, 0)

__device__ __forceinline__ void chunk_info(int c, int& cfirst, int& clast, bool& is_ctx, int& sb) {
    if (c < 64) { cfirst = c & ~1; clast = cfirst + 1; is_ctx = true; sb = c >> 1; }
    else { cfirst = 64 + ((c - 64) & ~7); clast = cfirst + 7; is_ctx = false; sb = (c - 64) >> 3; }
}
struct ConvW { f32x4 w0a, w0b, w1a, w1b, w2a, w2b, ba, bb; };
__device__ __forceinline__ ConvW conv_w(const float* wc, const float* bc, int ch) {
    ConvW W; W.w0a = *(const f32x4*)(wc + ch); W.w0b = *(const f32x4*)(wc + ch + 4); W.w1a = *(const f32x4*)(wc + 1024 + ch); W.w1b = *(const f32x4*)(wc + 1024 + ch + 4);
    W.w2a = *(const f32x4*)(wc + 2048 + ch); W.w2b = *(const f32x4*)(wc + 2048 + ch + 4); W.ba = *(const f32x4*)(bc + ch); W.bb = *(const f32x4*)(bc + ch + 4); return W;
}
__device__ __forceinline__ void conv8(const bf16* PROJ, int t, bool has_prev, bool has_next, int ch, const ConvW& W, float* out) {
    const bf16* p = PROJ + (size_t)t * EVEN_NP + 1536 + ch;
    const v4u z = {0u, 0u, 0u, 0u};
    const v4u c0 = *(const v4u*)p, cm = has_prev ? *(const v4u*)(p - EVEN_NP) : z, cp = has_next ? *(const v4u*)(p + EVEN_NP) : z;
    float x0[8], xm[8], xp[8]; unpack8(c0, x0); unpack8(cm, xm); unpack8(cp, xp);
#pragma unroll
    for (int i = 0; i < 4; ++i) { out[i] = siluf_(W.ba[i] + W.w0a[i] * xm[i] + W.w1a[i] * x0[i] + W.w2a[i] * xp[i]); out[4 + i] = siluf_(W.bb[i] + W.w0b[i] * xm[4 + i] + W.w1b[i] * x0[4 + i] + W.w2b[i] * xp[4 + i]); }
}
__device__ __forceinline__ void ssd_tables(const Frame& F, int ei, int t0, float* dtl, float* cml) {
    const bf16* PROJ = WSP(bf16, WS_PROJ);
    if (F.tid < 256) { const int j = F.tid >> 1, dir = F.tid & 1;
        const v4u raw = *(const v4u*)(PROJ + (size_t)(t0 + j) * EVEN_NP + 2560 + 8 * dir); float x[8]; unpack8(raw, x);
#pragma unroll
        for (int h = 0; h < 8; ++h) dtl[(dir * 8 + h) * 128 + j] = softplusf_(x[h] + AIN(I_DTB)[ei * 16 + dir * 8 + h]); }
    __syncthreads();
#pragma unroll
    for (int k = 0; k < 2; ++k) {
        const int row = 2 * F.wave + k, rev = row >> 3;
        const float a = -__expf(AIN(I_ALOG)[ei * 16 + row]);
        const int i0 = rev ? 127 - 2 * F.lane : 2 * F.lane, i1 = rev ? 126 - 2 * F.lane : 2 * F.lane + 1;
        const float v0 = dtl[row * 128 + i0] * a, v1 = dtl[row * 128 + i1] * a;
        float x = v0 + v1;
#pragma unroll
        for (int d = 1; d < 64; d <<= 1) { const float t = __builtin_bit_cast(float, __builtin_amdgcn_ds_bpermute((F.lane - d) * 4, __builtin_bit_cast(int, x))); x += (F.lane >= d) ? t : 0.f; }
        const float ex = x - (v0 + v1);
        cml[row * 128 + i0] = ex + v0; cml[row * 128 + i1] = ex + (v0 + v1);
    }
    __syncthreads();
}
constexpr int TILE128 = 34816, TILE64 = 17408;
constexpr int S1_BT = 0, S1_B = TILE128, S1_C = 2 * TILE128, S1_XT = TILE128  , S1_DT = 3 * TILE128, S1_CUM = S1_DT + 8192;
constexpr int S2_XT = 0  , S2_H = 2 * TILE64  , S2_DT = 6 * TILE64, S2_CUM = S2_DT + 8192, S2_SSQ = S2_CUM + 8192;

__device__ __forceinline__ void ssd_state_item(const Frame& F, int ei, int c, int g) {
    F.relane();
    const bf16* PROJ = WSP(bf16, WS_PROJ);
    const float* wc = AIN(I_WCS) + (size_t)ei * 3 * 1024; const float* bc = AIN(I_BCS) + (size_t)ei * 1024;
    int cfirst, clast, sb; bool is_ctx; chunk_info(c, cfirst, clast, is_ctx, sb);
    const int t0 = c * 128, len = is_ctx ? 256 : 1024, pos0 = (c - cfirst) * 128;
    bf16* BT = (bf16*)(F.lds + S1_BT); bf16* Bl = (bf16*)(F.lds + S1_B); bf16* Cl = (bf16*)(F.lds + S1_C); bf16* XT4 = (bf16*)(F.lds + S1_XT);
    float* dtl = (float*)(F.lds + S1_DT); float* cml = (float*)(F.lds + S1_CUM);
    bf16* ST = WSP(bf16, WS_ST); float* DEC = WSP(float, WS_DEC);
    bf16* CC = WSP(bf16, WS_CC); bf16* CBM = WSP(bf16, WS_CBM); bf16* XCT = WSP(bf16, WS_XCT);
    const int r = F.lane & 15, q = F.lane >> 4, w = F.wave;
    __syncthreads();
    ssd_tables(F, ei, t0, dtl, cml);
    { const ConvW W = conv_w(wc, bc, 512 + g * 128 + (F.tid & 15) * 8);
#pragma unroll 4
    for (int e = F.tid; e < 128 * 16; e += NTHR) { const int j = e >> 4, n8 = (e & 15) * 8; float o[8];
        conv8(PROJ, t0 + j, pos0 + j > 0, pos0 + j < len - 1, 512 + g * 128 + n8, W, o);
        const v4u pk = pack8(o);
        *(v4u*)((unsigned char*)Bl + (j * LDT + n8) * 2) = pk;
#pragma unroll
        for (int i = 0; i < 8; ++i) BT[(n8 + i) * LDT + j] = (bf16)f2bf1(o[i]); } }
    { const ConvW W = conv_w(wc, bc, 768 + g * 128 + (F.tid & 15) * 8);
#pragma unroll 4
    for (int e = F.tid; e < 128 * 16; e += NTHR) { const int j = e >> 4, n8 = (e & 15) * 8; float o[8];
        conv8(PROJ, t0 + j, pos0 + j > 0, pos0 + j < len - 1, 768 + g * 128 + n8, W, o);
        const v4u pk = pack8(o);
        *(v4u*)((unsigned char*)Cl + (j * LDT + n8) * 2) = pk;
        *(v4u*)(CC + (size_t)(t0 + j) * 256 + g * 128 + n8) = pk; } }
    __syncthreads();
    {
        bf16x8 cf[4];
#pragma unroll
        for (int ks = 0; ks < 4; ++ks) cf[ks] = ld_frag16((const unsigned char*)Cl + ((16 * w + r) * LDT + 32 * ks + 8 * q) * 2);
        bf16* dst = CBM + ((size_t)(c * 2 + g) * 128 + 16 * w + r) * 128 + 4 * q;
#pragma unroll
        for (int jt = 0; jt < 8; ++jt) { f32x4 a = {0.f, 0.f, 0.f, 0.f};
#pragma unroll
            for (int ks = 0; ks < 4; ++ks) a = MFMA16(ld_frag16((const unsigned char*)Bl + ((16 * jt + r) * LDT + 32 * ks + 8 * q) * 2), cf[ks], a);
            v2u o; o.x = pk2(a[0], a[1]); o.y = pk2(a[2], a[3]); *(v2u*)(dst + 16 * jt) = o; }
    }
    __syncthreads();
    { const ConvW W = conv_w(wc, bc, g * 256 + (F.tid & 31) * 8);
#pragma unroll 4
    for (int e = F.tid; e < 128 * 32; e += NTHR) { const int j = e >> 5, p8 = (e & 31) * 8; float o[8];
        conv8(PROJ, t0 + j, pos0 + j > 0, pos0 + j < len - 1, g * 256 + p8, W, o);
#pragma unroll
        for (int i = 0; i < 8; ++i) XT4[(p8 + i) * LDT + j] = (bf16)f2bf1(o[i]); } }
    __syncthreads();
#pragma unroll 4
    for (int e = F.tid; e < 256 * 16; e += NTHR) { const int row = e >> 4, ch = (e & 15) * 8;
        *(v4u*)(XCT + ((size_t)(c * 8 + 4 * g) * 64 + row) * 128 + ch) = *(const v4u*)((const unsigned char*)XT4 + (row * LDT + ch) * 2); }
#pragma unroll 2
    for (int hd = 0; hd < 8; ++hd) {
        const int hh = hd >> 1, dir = hd & 1, h = 4 * g + hh;
        const float* dth = dtl + (dir * 8 + h) * 128; const float* cmh = cml + (dir * 8 + h) * 128;
        const float cend = dir == 0 ? cmh[127] : cmh[0];
        const bf16* XT = XT4 + hh * 64 * LDT;
        f32x4 acc[4];
#pragma unroll
        for (int pt = 0; pt < 4; ++pt) acc[pt] = (f32x4){0.f, 0.f, 0.f, 0.f};
#pragma unroll
        for (int ks = 0; ks < 4; ++ks) {
            const int j0 = 32 * ks + 8 * q;
            const v4u braw = *(const v4u*)((const unsigned char*)BT + ((16 * w + r) * LDT + j0) * 2); float bv[8]; unpack8(braw, bv);
            const f32x4 d0 = *(const f32x4*)(dth + j0), d1 = *(const f32x4*)(dth + j0 + 4), c0 = *(const f32x4*)(cmh + j0), c1 = *(const f32x4*)(cmh + j0 + 4);
#pragma unroll
            for (int i = 0; i < 4; ++i) { bv[i] *= d0[i] * __expf(cend - c0[i]); bv[4 + i] *= d1[i] * __expf(cend - c1[i]); }
            const bf16x8 af = __builtin_bit_cast(bf16x8, pack8(bv));
#pragma unroll
            for (int pt = 0; pt < 4; ++pt) { const bf16x8 bf = ld_frag16((const unsigned char*)XT + ((16 * pt + r) * LDT + j0) * 2); acc[pt] = MFMA16(af, bf, acc[pt]); }
        }
        bf16* dst = ST + ((size_t)(c * 8 + h) * 2 + dir) * 8192;
#pragma unroll
        for (int pt = 0; pt < 4; ++pt) { v2u o; o.x = pk2(acc[pt][0], acc[pt][1]); o.y = pk2(acc[pt][2], acc[pt][3]); *(v2u*)(dst + (16 * pt + r) * 128 + 16 * w + 4 * q) = o; }
        if (F.tid == 0) DEC[(c * 8 + h) * 2 + dir] = __expf(cend);
    }
}

__device__ __forceinline__ void gmlp_item(const Frame& F, int ei, int c, int g) {
    F.relane();
    const bf16* PROJ = WSP(bf16, WS_PROJ); bf16* YMIX = WSP(bf16, WS_YMIX);
    const int t0 = c * 128;
    float* rs = (float*)F.lds; bf16* Vt = (bf16*)(F.lds + 1024); bf16* Wl = (bf16*)(F.lds + 1024 + 34816);
    const float* gv = AIN(I_GV) + ei * 512;
    __syncthreads();
#pragma unroll 1
    for (int kb = 0; kb < 16; kb += 8) {
        v4u raw[8];
#pragma unroll
        for (int k = 0; k < 8; ++k) raw[k] = *(const v4u*)(PROJ + (size_t)(t0 + F.wave * 16 + kb + k) * EVEN_NP + 512 + 8 * F.lane);
#pragma unroll
        for (int k = 0; k < 8; ++k) { float x[8]; unpack8(raw[k], x); float s = 0.f;
#pragma unroll
            for (int i = 0; i < 8; ++i) { const float y = gelu_tanh(x[i]); s += y * y; }
            s = wave_sum(s); if (F.lane == 0) rs[F.wave * 16 + kb + k] = frsq(s * (1.f / 512.f) + EPS); }
    }
    { const float* ws_ = AIN(I_WSP) + ((size_t)ei * 4 + g) * 16384;
#pragma unroll
      for (int e = F.tid; e < 4096; e += NTHR) { const int i = e >> 5, j4 = (e & 31) * 4; const f32x4 v = *(const f32x4*)(ws_ + i * 128 + j4);
          v2u o; o.x = pk2(v.x, v.y); o.y = pk2(v.z, v.w); *(v2u*)((unsigned char*)Wl + (i * LDT + j4) * 2) = o; } }
    __syncthreads();
    { const int d8 = (F.tid & 15) * 8; v4u raw[4];
#pragma unroll
      for (int k = 0; k < 4; ++k) raw[k] = *(const v4u*)(PROJ + (size_t)(t0 + (F.tid >> 4) + 32 * k) * EVEN_NP + 512 + g * 128 + d8);
#pragma unroll
      for (int k = 0; k < 4; ++k) { const int j = (F.tid >> 4) + 32 * k; float x[8]; unpack8(raw[k], x); const float rj = rs[j];
#pragma unroll
          for (int i = 0; i < 8; ++i) Vt[(d8 + i) * LDT + j] = (bf16)f2bf1(gelu_tanh(x[i]) * rj * gv[g * 128 + d8 + i]); } }
    __syncthreads();
    const int r = F.lane & 15, q = F.lane >> 4, w = F.wave;
    bf16x8 af[4];
#pragma unroll
    for (int ks = 0; ks < 4; ++ks) af[ks] = ld_frag16((const unsigned char*)Vt + ((16 * w + r) * LDT + 32 * ks + 8 * q) * 2);
    const float* bs = AIN(I_BSP) + ((size_t)ei * 4 + g) * 128;
    v2u uraw[8];
#pragma unroll
    for (int it = 0; it < 8; ++it) uraw[it] = *(const v2u*)(PROJ + (size_t)(t0 + 16 * it + r) * EVEN_NP + g * 128 + 16 * w + 4 * q);
#pragma unroll
    for (int it = 0; it < 8; ++it) {
        f32x4 acc = {0.f, 0.f, 0.f, 0.f};
#pragma unroll
        for (int ks = 0; ks < 4; ++ks) acc = MFMA16(af[ks], ld_frag16((const unsigned char*)Wl + ((16 * it + r) * LDT + 32 * ks + 8 * q) * 2), acc);
        const int i = 16 * it + r, col = g * 128 + 16 * w + 4 * q; const float b = bs[i];
        const float u0 = gelu_tanh(bflo(uraw[it].x)), u1 = gelu_tanh(bfhi(uraw[it].x)), u2 = gelu_tanh(bflo(uraw[it].y)), u3 = gelu_tanh(bfhi(uraw[it].y));
        v2u o; o.x = pk2(u0 * (acc[0] + b), u1 * (acc[1] + b)); o.y = pk2(u2 * (acc[2] + b), u3 * (acc[3] + b));
        *(v2u*)(YMIX + (size_t)(t0 + i) * D + col) = o;
    }
}

__device__ __forceinline__ f32x4 ld_bf4(const bf16* p) { const v2u w = *(const v2u*)p; return (f32x4){bflo(w.x), bfhi(w.x), bflo(w.y), bfhi(w.y)}; }
__device__ __forceinline__ void ssd_scan_phase(const Frame& F, int ei) {
    F.relane();
    const bf16* ST = WSP(bf16, WS_ST); const float* DEC = WSP(float, WS_DEC); bf16* HIN = WSP(bf16, WS_HIN);
    const size_t gt = (size_t)F.bid * NTHR + F.tid, NT = (size_t)F.G * NTHR;
    constexpr size_t N_SMP = (size_t)2 * 8 * 2 * 2048, N_CTX = (size_t)32 * 8 * 2 * 2048;
    for (size_t it = gt; it < N_SMP + N_CTX; it += NT) {
        if (it < N_SMP) {
            const int e = (int)(it & 2047) * 4, dir = (int)(it >> 11) & 1, h = (int)(it >> 12) & 7, b = (int)(it >> 15);
            const int c0 = 64 + 8 * b;
            f32x4 st[8]; float dc[8];
#pragma unroll
            for (int k = 0; k < 8; ++k) { const int cc = dir == 0 ? c0 + k : c0 + 7 - k; st[k] = ld_bf4(ST + ((size_t)(cc * 8 + h) * 2 + dir) * 8192 + e); dc[k] = DEC[(cc * 8 + h) * 2 + dir]; }
            f32x4 v = *(const f32x4*)(AIN(I_SSD) + ((size_t)((b * 2 + ei) * 2 + dir) * 8 + h) * 8192 + e);
#pragma unroll
            for (int k = 0; k < 8; ++k) { const int cc = dir == 0 ? c0 + k : c0 + 7 - k;
                v2u o; o.x = pk2(v.x, v.y); o.y = pk2(v.z, v.w); *(v2u*)(HIN + ((size_t)(cc * 8 + h) * 2 + dir) * 8192 + e) = o;
                v = v * dc[k] + st[k]; }
        } else {
            const size_t i2 = it - N_SMP;
            const int e = (int)(i2 & 2047) * 4, dir = (int)(i2 >> 11) & 1, h = (int)(i2 >> 12) & 7, s = (int)(i2 >> 15);
            const int ca = dir == 0 ? 2 * s : 2 * s + 1, cb = dir == 0 ? 2 * s + 1 : 2 * s;
            const f32x4 sa = ld_bf4(ST + ((size_t)(ca * 8 + h) * 2 + dir) * 8192 + e), sb_ = ld_bf4(ST + ((size_t)(cb * 8 + h) * 2 + dir) * 8192 + e);
            const float db = DEC[(cb * 8 + h) * 2 + dir];
            *(f32x4*)(AOUT + OUT_SSD + ((size_t)((s * 2 + ei) * 2 + dir) * 8 + h) * 8192 + e) = sa * db + sb_;
        }
    }
}

__device__ __forceinline__ void ssd_out_item(const Frame& F, int ei, int c, int th) {
    F.relane();
    const bf16* PROJ = WSP(bf16, WS_PROJ); bf16* YMIX = WSP(bf16, WS_YMIX);
    const bf16* CC = WSP(bf16, WS_CC); const bf16* CBM = WSP(bf16, WS_CBM); const bf16* XCT = WSP(bf16, WS_XCT); const bf16* HIN = WSP(bf16, WS_HIN); const bf16* ST = WSP(bf16, WS_ST);
    const int t0 = c * 128;
    float* dtl = (float*)(F.lds + S2_DT); float* cml = (float*)(F.lds + S2_CUM); float* ssqx = (float*)(F.lds + S2_SSQ);
    const int r = F.lane & 15, q = F.lane >> 4, w = F.wave, it = w & 3, g = w >> 2;
    const int irow = 64 * th + 16 * it + r;
    const bool hzero[2] = {c < 64 && (c & 1) == 0, c < 64 && (c & 1) == 1};
    __syncthreads();
    ssd_tables(F, ei, t0, dtl, cml);
    v2u cbp[8]; bf16x8 cf[4];
    {
        const bf16* cbr = CBM + ((size_t)(c * 2 + g) * 128 + irow) * 128 + 4 * q;
#pragma unroll
        for (int jt = 0; jt < 8; ++jt) cbp[jt] = *(const v2u*)(cbr + 16 * jt);
#pragma unroll
        for (int kn = 0; kn < 4; ++kn) cf[kn] = *(const bf16x8*)(CC + (size_t)(t0 + irow) * 256 + g * 128 + 32 * kn + 8 * q);
    }
    float ssq = 0.f;
    v4u pre[12];
    const int goff = (F.tid >> 4) * 128 + (F.tid & 15) * 8, loff = ((F.tid >> 4) * LDT + (F.tid & 15) * 8) * 2;
#define E2_SRC(m_, hh_) ((m_) < 2 ? XCT + (size_t)(c * 8 + 4 * (m_) + (hh_)) * 8192 : \
        (c < 64 ? ST + ((size_t)((((m_) - 2) & 1) == 0 ? c - 1 : c + 1) * 8 + 4 * (((m_) - 2) >> 1) + (hh_)) * 16384 + (((m_) - 2) & 1) * 8192 \
                : HIN + ((size_t)c * 8 + 4 * (((m_) - 2) >> 1) + (hh_)) * 16384 + (((m_) - 2) & 1) * 8192))
#define E2_FETCH(hh_) do { _Pragma("unroll") for (int m = 0; m < 6; ++m) { if (m >= 2 && hzero[(m - 2) & 1]) continue; const bf16* sp = E2_SRC(m, hh_) + goff; \
            pre[2 * m] = *(const v4u*)sp; pre[2 * m + 1] = *(const v4u*)(sp + 32 * 128); } } while (0)
    E2_FETCH(0);
#pragma unroll 1
    for (int hh = 0; hh < 4; ++hh) {
        __syncthreads();
#pragma unroll
        for (int m = 0; m < 6; ++m) { if (m >= 2 && hzero[(m - 2) & 1]) continue;
            unsigned char* dp = F.lds + (m < 2 ? S2_XT + m * TILE64 : S2_H + (m - 2) * TILE64) + loff;
            *(v4u*)dp = pre[2 * m]; *(v4u*)(dp + 32 * LDT * 2) = pre[2 * m + 1]; }
        __syncthreads();
        if (hh < 3) E2_FETCH(hh + 1);
        v2u zr4[4];
#pragma unroll
        for (int pt = 0; pt < 4; ++pt) zr4[pt] = *(const v2u*)(PROJ + (size_t)(t0 + irow) * EVEN_NP + 1024 + (4 * g + hh) * 64 + 16 * pt + 4 * q);
        const int h = 4 * g + hh;
        const bf16* XT = (const bf16*)(F.lds + S2_XT + g * TILE64);
        f32x4 yacc[4];
#pragma unroll
        for (int pt = 0; pt < 4; ++pt) yacc[pt] = (f32x4){0.f, 0.f, 0.f, 0.f};
        const float* dt0 = dtl + h * 128; const float* cm0 = cml + h * 128; const float* dt1 = dtl + (8 + h) * 128; const float* cm1 = cml + (8 + h) * 128;
        const float ci0 = cm0[irow], ci1 = cm1[irow];
#pragma unroll
        for (int ks = 0; ks < 4; ++ks) {
            float sl0[8], sl1[8];
#pragma unroll
            for (int hf = 0; hf < 2; ++hf) {
                const int j0 = 32 * ks + 16 * hf + 4 * q; const v2u cw = cbp[2 * ks + hf];
                const f32x4 c0v = *(const f32x4*)(cm0 + j0), d0v = *(const f32x4*)(dt0 + j0), c1v = *(const f32x4*)(cm1 + j0), d1v = *(const f32x4*)(dt1 + j0);
                const float cbv[4] = {bflo(cw.x), bfhi(cw.x), bflo(cw.y), bfhi(cw.y)};
#pragma unroll
                for (int e = 0; e < 4; ++e) { const int j = j0 + e;
                    const float e0 = __expf(ci0 - c0v[e]) * d0v[e] * cbv[e], e1 = __expf(ci1 - c1v[e]) * d1v[e] * cbv[e];
                    sl0[4 * hf + e] = (j <= irow) ? e0 : 0.f; sl1[4 * hf + e] = (j >= irow) ? e1 : 0.f; }
            }
            const bf16x8 sf0 = __builtin_bit_cast(bf16x8, pack8(sl0)), sf1 = __builtin_bit_cast(bf16x8, pack8(sl1));
#pragma unroll
            for (int pt = 0; pt < 4; ++pt) { const unsigned char* xr = (const unsigned char*)XT + ((16 * pt + r) * LDT + 32 * ks + 4 * q) * 2;
                const bf16x8 xf = ld_frag8x2(xr, xr + 32);
                yacc[pt] = MFMA16(xf, sf0, yacc[pt]); yacc[pt] = MFMA16(xf, sf1, yacc[pt]); }
        }
#pragma unroll
        for (int dir = 0; dir < 2; ++dir) {
            if (hzero[dir]) continue;
            const unsigned char* Hl = F.lds + S2_H + (g * 2 + dir) * TILE64;
            const float ei_ = __expf(dir == 0 ? ci0 : ci1);
#pragma unroll
            for (int pt = 0; pt < 4; ++pt) { f32x4 t = {0.f, 0.f, 0.f, 0.f};
#pragma unroll
                for (int kn = 0; kn < 4; ++kn) t = MFMA16(ld_frag16(Hl + ((16 * pt + r) * LDT + 32 * kn + 8 * q) * 2), cf[kn], t);
                yacc[pt] += t * ei_; }
        }
        const float dsk = AIN(I_DSK)[ei * 16 + h] + AIN(I_DSK)[ei * 16 + 8 + h];
#pragma unroll
        for (int pt = 0; pt < 4; ++pt) {
            const int p0 = 16 * pt + 4 * q;
            const v2u zr = zr4[pt];
            const float z0 = bflo(zr.x), z1 = bfhi(zr.x), z2 = bflo(zr.y), z3 = bfhi(zr.y);
            float y0 = yacc[pt][0] + dsk * bf1(XT[(p0 + 0) * LDT + irow]), y1 = yacc[pt][1] + dsk * bf1(XT[(p0 + 1) * LDT + irow]),
                  y2 = yacc[pt][2] + dsk * bf1(XT[(p0 + 2) * LDT + irow]), y3 = yacc[pt][3] + dsk * bf1(XT[(p0 + 3) * LDT + irow]);
            y0 *= siluf_(z0); y1 *= siluf_(z1); y2 *= siluf_(z2); y3 *= siluf_(z3);
            ssq += (y0 * y0 + y1 * y1) + (y2 * y2 + y3 * y3);
            v2u o; o.x = pk2(y0, y1); o.y = pk2(y2, y3);
            *(v2u*)(YMIX + (size_t)(t0 + irow) * D + 512 + h * 64 + p0) = o;
        }
    }
#undef E2_FETCH
#undef E2_SRC
    ssq += xlane<16>(ssq); ssq = sum_x32(ssq);
    if (q == 0) ssqx[w * 16 + r] = ssq;
    __syncthreads();
    ssq += ssqx[(w ^ 4) * 16 + r];
    const float rstd = frsq(ssq * (1.f / 512.f) + EPS);
    const float* go = AIN(I_GSO) + ei * 512;
#pragma unroll 1
    for (int hh = 0; hh < 4; ++hh)
#pragma unroll
        for (int pt = 0; pt < 4; ++pt) {
            const int col = (4 * g + hh) * 64 + 16 * pt + 4 * q;
            v2u* p = (v2u*)(YMIX + (size_t)(t0 + irow) * D + 512 + col); const v2u v = *p; const f32x4 gg = *(const f32x4*)(go + col);
            v2u o; o.x = pk2(bflo(v.x) * rstd * gg.x, bfhi(v.x) * rstd * gg.y); o.y = pk2(bflo(v.y) * rstd * gg.z, bfhi(v.y) * rstd * gg.w);
            *p = o;
        }
}

__device__ __forceinline__ void even_phase1(const Frame& F, int ei) {
    if (F.G >= 256) {
        if (F.bid < 160) ssd_state_item(F, ei, F.bid >> 1, F.bid & 1);
        else for (int it = F.bid - 160; it < 192; it += F.G - 160) gmlp_item(F, ei, it >> 2, it & 3);
        return;
    }
    for (int it = F.bid; it < 160 + 320; it += F.G) {
        if (it < 160) ssd_state_item(F, ei, it >> 1, it & 1);
        else gmlp_item(F, ei, (it - 160) >> 2, (it - 160) & 3);
    }
}
__device__ __forceinline__ void even_phase2(const Frame& F, int ei) {
    if (F.G >= 256) {
        if (F.bid < 160) ssd_out_item(F, ei, F.bid >> 1, F.bid & 1);
        else for (int it = 192 + F.bid - 160; it < 320; it += F.G - 160) gmlp_item(F, ei, it >> 2, it & 3);
        return;
    }
    for (int it = F.bid; it < 160; it += F.G) ssd_out_item(F, ei, it >> 1, it & 1);
}
constexpr int CV_T = 43, CV_W = CV_T + 30, CV_ITEMS = 32 * 6 + 2 * 24;
__device__ __forceinline__ void conv_item(const Frame& F, int oi, int item) {
    F.relane();
    const bf16* PROJ = WSP(bf16, WS_PROJ); bf16* YMIX = WSP(bf16, WS_YMIX);
    int sbeg, slen, tile; if (item < 192) { sbeg = (item / 6) * 256; slen = 256; tile = item % 6; } else { const int i2 = item - 192; sbeg = TCTX + (i2 / 24) * 1024; slen = 1024; tile = i2 % 24; }
    const int send = sbeg + slen, t0 = sbeg + tile * CV_T, nt = (slen - tile * CV_T) < CV_T ? (slen - tile * CV_T) : CV_T;
    float* Dl = (float*)F.lds;
    const int c = F.tid;
    float glu[CV_W];
#pragma unroll
    for (int w0 = 0; w0 < CV_W; w0 += 8) {
        bf16 av[8], gv[8];
#pragma unroll
        for (int i = 0; i < 8; ++i) if (w0 + i < CV_W) { int t = t0 - 15 + w0 + i; t = t < sbeg ? sbeg : (t >= send ? send - 1 : t);
            av[i] = PROJ[(size_t)t * ODD_NP + 672 + c]; gv[i] = PROJ[(size_t)t * ODD_NP + 1184 + c]; }
#pragma unroll
        for (int i = 0; i < 8; ++i) if (w0 + i < CV_W) { const int t = t0 - 15 + w0 + i; const float v = bf1(av[i]) * sigmoidf_(bf1(gv[i])); glu[w0 + i] = (t >= sbeg && t < send) ? v : 0.f; }
    }
    float wk[31];
#pragma unroll
    for (int k = 0; k < 31; ++k) wk[k] = AIN(I_WDW)[((size_t)oi * 31 + k) * 512 + c];
    const float bd = AIN(I_BDW)[oi * 512 + c];
    __syncthreads();
#pragma unroll
    for (int tt = 0; tt < CV_T; ++tt) { float s = bd;
#pragma unroll
        for (int k = 0; k < 31; ++k) s += wk[k] * glu[tt + k];
        Dl[tt * 512 + c] = s; }
    __syncthreads();
    const float* gl = AIN(I_GLN) + oi * 512; const float* bl = AIN(I_BLN) + oi * 512;
    const f32x4 g0 = *(const f32x4*)(gl + 8 * F.lane), g1 = *(const f32x4*)(gl + 8 * F.lane + 4), b0 = *(const f32x4*)(bl + 8 * F.lane), b1 = *(const f32x4*)(bl + 8 * F.lane + 4);
#pragma unroll 1
    for (int tt = F.wave; tt < nt; tt += NWAVES) {
        const f32x4 v0 = *(const f32x4*)(Dl + tt * 512 + 8 * F.lane), v1 = *(const f32x4*)(Dl + tt * 512 + 8 * F.lane + 4);
        float s = (v0.x + v0.y) + (v0.z + v0.w) + (v1.x + v1.y) + (v1.z + v1.w);
        const float mean = wave_sum(s) * (1.f / 512.f);
        const f32x4 d0 = v0 - mean, d1 = v1 - mean;
        float s2 = (d0.x * d0.x + d0.y * d0.y) + (d0.z * d0.z + d0.w * d0.w) + (d1.x * d1.x + d1.y * d1.y) + (d1.z * d1.z + d1.w * d1.w);
        const float rstd = frsq(wave_sum(s2) * (1.f / 512.f) + EPS);
        float o[8];
#pragma unroll
        for (int i = 0; i < 4; ++i) { o[i] = siluf_(d0[i] * rstd * g0[i] + b0[i]); o[4 + i] = siluf_(d1[i] * rstd * g1[i] + b1[i]); }
        *(v4u*)(YMIX + (size_t)(t0 + tt) * D + 512 + 8 * F.lane) = pack8(o);
    }
}
__device__ __forceinline__ void odd_rows(const Frame& F, int oi) {
    F.relane();
    const bf16* PROJ = WSP(bf16, WS_PROJ);
    bf16* QA = WSP(bf16, WS_QA); bf16* CKVA = WSP(bf16, WS_CKVA); bf16* KR = WSP(bf16, WS_KR); const float* ROPE = WSP(float, WS_ROPE);
    const int gw = F.bid * NWAVES + F.wave, NGW = F.G * NWAVES, lane = F.lane;
    for (int row = T + gw; row < TP; row += NGW) {
        const int b = (row - T) >> 8, j = (row - T) & 255;
        const f32x4 v = *(const f32x4*)(AIN(I_CCKV) + ((size_t)(b * 2 + oi) * 256 + j) * 256 + 4 * lane);
        v2u o; o.x = pk2(v.x, v.y); o.y = pk2(v.z, v.w); *(v2u*)(CKVA + (size_t)row * 256 + 4 * lane) = o;
        if (lane < 32) KR[(size_t)row * 32 + lane] = (bf16)f2bf1(AIN(I_CKR)[((size_t)(b * 2 + oi) * 256 + j) * 32 + lane]);
    }
    const f32x4 gkv = *(const f32x4*)(AIN(I_GCKV) + oi * 256 + 4 * lane);
    float gq[6];
#pragma unroll
    for (int k = 0; k < 3; ++k) { gq[2 * k] = AIN(I_GCQ)[oi * 384 + 128 * k + 2 * lane]; gq[2 * k + 1] = AIN(I_GCQ)[oi * 384 + 128 * k + 2 * lane + 1]; }
    unsigned qw[3], nqw[3]; v2u kw, nkw; bf16 krw, nkrw;
    int row = gw;
    if (row < T) { const bf16* pr = PROJ + (size_t)row * ODD_NP;
#pragma unroll
        for (int k = 0; k < 3; ++k) nqw[k] = *(const unsigned*)(pr + 128 * k + 2 * lane);
        nkw = *(const v2u*)(pr + 384 + 4 * lane); nkrw = pr[640 + (lane & 31)]; }
#pragma unroll 1
    for (; row < T; row += NGW) {
#pragma unroll
        for (int k = 0; k < 3; ++k) qw[k] = nqw[k];
        kw = nkw; krw = nkrw;
        if (row + NGW < T) { const bf16* pr = PROJ + (size_t)(row + NGW) * ODD_NP;
#pragma unroll
            for (int k = 0; k < 3; ++k) nqw[k] = *(const unsigned*)(pr + 128 * k + 2 * lane);
            nkw = *(const v2u*)(pr + 384 + 4 * lane); nkrw = pr[640 + (lane & 31)]; }
        float qv[6]; float s = 0.f;
#pragma unroll
        for (int k = 0; k < 3; ++k) { qv[2 * k] = bflo(qw[k]); qv[2 * k + 1] = bfhi(qw[k]); s += qv[2 * k] * qv[2 * k] + qv[2 * k + 1] * qv[2 * k + 1]; }
        f32x4 kv = {bflo(kw.x), bfhi(kw.x), bflo(kw.y), bfhi(kw.y)};
        float s2 = (kv.x * kv.x + kv.y * kv.y) + (kv.z * kv.z + kv.w * kv.w);
        s += xlane<1>(s); s2 += xlane<1>(s2); s += xlane<2>(s); s2 += xlane<2>(s2); s += xlane<4>(s); s2 += xlane<4>(s2); s += xlane<8>(s); s2 += xlane<8>(s2); s += xlane<16>(s); s2 += xlane<16>(s2);
        s = sum_x32(s); s2 = sum_x32(s2);
        const float rq = frsq(s * (1.f / 384.f) + EPS), rk = frsq(s2 * (1.f / 256.f) + EPS);
#pragma unroll
        for (int k = 0; k < 3; ++k) *(unsigned*)(QA + (size_t)row * 384 + 128 * k + 2 * lane) = pk2(qv[2 * k] * rq * gq[2 * k], qv[2 * k + 1] * rq * gq[2 * k + 1]);
        kv = kv * rk * gkv;
        { v2u o; o.x = pk2(kv.x, kv.y); o.y = pk2(kv.z, kv.w); *(v2u*)(CKVA + (size_t)row * 256 + 4 * lane) = o; }
        float kr = bf1(krw);
        if (row < TCTX) {
            const int b = row >> 8, pos = row & 255;
            *(f32x4*)(AOUT + OUT_CKV + ((size_t)(b * 2 + oi) * 256 + pos) * 256 + 4 * lane) = kv;
            if (lane < 32) AOUT[OUT_KR + ((size_t)(b * 2 + oi) * 256 + pos) * 32 + lane] = kr;
        } else {
            const int pos = (row - TCTX) & 1023, e = lane & 31, ax = e >> 4, half = (e >> 3) & 1, f = e & 7;
            const float other = xlane<8>(kr);
            const float cs = ROPE[((pos * 2 + ax) * 8 + f) * 2], sn = ROPE[((pos * 2 + ax) * 8 + f) * 2 + 1];
            kr = half == 0 ? (kr * cs - other * sn) : (other * sn + kr * cs);
        }
        if (lane < 32) KR[(size_t)row * 32 + lane] = (bf16)f2bf1(kr);
    }
}
__device__ __forceinline__ void odd_phase1(const Frame& F, int oi) {
    for (int it = F.bid; it < CV_ITEMS; it += F.G) conv_item(F, oi, it);
    odd_rows(F, oi);
}

constexpr int AT_KROW = 208, AT_VROW = 272, AT_KBYTES = 128 * AT_KROW, AT_BUF = 45056;
struct AttnPre { v4u k[3]; v4u v[2]; };
__device__ __forceinline__ void attn_load_tile(const Frame& F, int h, int krow0, AttnPre& P) {
    const bf16* KN = WSP(bf16, WS_KN); const bf16* KR = WSP(bf16, WS_KR); const bf16* VT = WSP(bf16, WS_VT);
#pragma unroll
    for (int i = 0; i < 3; ++i) { const int e = F.tid + NTHR * i, key = e / 12, c = e % 12; const size_t kr = (size_t)(krow0 + key);
        P.k[i] = c < 8 ? *(const v4u*)(KN + kr * 512 + h * 64 + c * 8) : *(const v4u*)(KR + kr * 32 + (c - 8) * 8); }
#pragma unroll
    for (int i = 0; i < 2; ++i) { const int e = F.tid + NTHR * i, row = e >> 4, c = e & 15;
        P.v[i] = *(const v4u*)(VT + (size_t)(h * 64 + row) * TP + krow0 + c * 8); }
}
__device__ __forceinline__ void attn_store_tile(const Frame& F, unsigned char* buf, const AttnPre& P) {
#pragma unroll
    for (int i = 0; i < 3; ++i) { const int e = F.tid + NTHR * i, key = e / 12, c = e % 12; *(v4u*)(buf + key * AT_KROW + c * 16) = P.k[i]; }
#pragma unroll
    for (int i = 0; i < 2; ++i) { const int e = F.tid + NTHR * i, row = e >> 4, c = e & 15; *(v4u*)(buf + AT_KBYTES + row * AT_VROW + c * 16) = P.v[i]; }
}
__device__ __forceinline__ int attn_tile_row(bool is_smp, int sb, int i) {
    if (!is_smp) return sb * 256 + 128 * i;
    return i < 2 ? T + sb * 256 + 128 * i : TCTX + sb * 1024 + 128 * (i - 2);
}
__device__ __forceinline__ void attn_item(const Frame& F, int q0, int h, bool is_smp, int spos0, int sb) {
    F.relane();
    const bf16* Q = WSP(bf16, WS_Q); bf16* YMIX = WSP(bf16, WS_YMIX); const float* ROPE = WSP(float, WS_ROPE);
    const int r = F.lane & 15, g = F.lane >> 4, w = F.wave;
    const int tq = q0 + 16 * w + r;
    const int ntile = is_smp ? 10 : 2;
    AttnPre P;
    attn_load_tile(F, h, attn_tile_row(is_smp, sb, 0), P);
    bf16x8 qf[3];
#pragma unroll
    for (int ks = 0; ks < 3; ++ks) qf[ks] = *(const bf16x8*)(Q + (size_t)tq * 768 + h * 96 + 32 * ks + 8 * g);
    if (is_smp) {
        float x[8], o[8]; unpack8(__builtin_bit_cast(v4u, qf[2]), x);
        const int pos = spos0 + 16 * w + r, ax = g >> 1, half = g & 1;
        const float* rp = ROPE + ((size_t)(pos * 2 + ax) * 8) * 2;
#pragma unroll
        for (int j = 0; j < 8; ++j) { const float other = xlane<16>(x[j]); const float cs = rp[2 * j], sn = rp[2 * j + 1];
            o[j] = half == 0 ? (x[j] * cs - other * sn) : (other * sn + x[j] * cs); }
        qf[2] = __builtin_bit_cast(bf16x8, pack8(o));
    }
    const float csc = 0.10206207261596577f * 1.4426950408889634f;
    float m = -1e30f, l = 0.f;
    f32x4 oacc[4];
#pragma unroll
    for (int dt = 0; dt < 4; ++dt) oacc[dt] = (f32x4){0.f, 0.f, 0.f, 0.f};
    __syncthreads();
    attn_store_tile(F, F.lds, P);
    AttnPre P2;
    if (ntile > 1) attn_load_tile(F, h, attn_tile_row(is_smp, sb, 1), P);
    __syncthreads();
#define ATTN_COMPUTE(buf) do { \
        f32x4 sacc[8]; \
        _Pragma("unroll") \
        for (int st = 0; st < 8; ++st) { \
            const unsigned char* kp = buf + (16 * st + r) * AT_KROW + 16 * g; \
            f32x4 a = {0.f, 0.f, 0.f, 0.f}; \
            a = MFMA16(ld_frag16(kp), qf[0], a); a = MFMA16(ld_frag16(kp + 64), qf[1], a); a = MFMA16(ld_frag16(kp + 128), qf[2], a); \
            sacc[st] = a; \
        } \
        float mx = -1e30f; \
        _Pragma("unroll") \
        for (int st = 0; st < 8; ++st) mx = fmaxf(fmaxf(fmaxf(sacc[st][0], sacc[st][1]), fmaxf(sacc[st][2], sacc[st][3])), mx); \
        mx = fmaxf(mx, xlane<16>(mx)); mx = max_x32(mx); \
        const float mn = fmaxf(m, mx), alpha = __builtin_amdgcn_exp2f((m - mn) * csc); m = mn; \
        float ps = 0.f; float p[32]; \
        _Pragma("unroll") \
        for (int st = 0; st < 8; ++st) \
            _Pragma("unroll") \
            for (int j = 0; j < 4; ++j) { const float e = __builtin_amdgcn_exp2f((sacc[st][j] - mn) * csc); p[4 * st + j] = e; ps += e; } \
        l = l * alpha + ps; \
        _Pragma("unroll") \
        for (int dt = 0; dt < 4; ++dt) oacc[dt] *= alpha; \
        _Pragma("unroll") \
        for (int ks2 = 0; ks2 < 4; ++ks2) { \
            const bf16x8 pf = __builtin_bit_cast(bf16x8, pack8(p + 8 * ks2)); \
            _Pragma("unroll") \
            for (int dt = 0; dt < 4; ++dt) { \
                const unsigned char* vp = buf + AT_KBYTES + (16 * dt + r) * AT_VROW + (32 * ks2 + 4 * g) * 2; \
                oacc[dt] = MFMA16(ld_frag8x2(vp, vp + 32), pf, oacc[dt]); \
            } \
        } } while (0)
#pragma unroll 1
    for (int ti = 0; ti < ntile; ti += 2) {
        if (ti + 2 < ntile) attn_load_tile(F, h, attn_tile_row(is_smp, sb, ti + 2), P2);
        { const unsigned char* buf = F.lds; ATTN_COMPUTE(buf); }
        if (ti + 1 < ntile) attn_store_tile(F, F.lds + AT_BUF, P);
        __syncthreads();
        if (ti + 1 >= ntile) break;
        if (ti + 3 < ntile) attn_load_tile(F, h, attn_tile_row(is_smp, sb, ti + 3), P);
        { const unsigned char* buf = F.lds + AT_BUF; ATTN_COMPUTE(buf); }
        if (ti + 2 < ntile) attn_store_tile(F, F.lds, P2);
        __syncthreads();
    }
#undef ATTN_COMPUTE
    l += xlane<16>(l); l = sum_x32(l);
    const float inv = 1.0f / l;
#pragma unroll
    for (int dt = 0; dt < 4; ++dt) { v2u o; o.x = pk2(oacc[dt][0] * inv, oacc[dt][1] * inv); o.y = pk2(oacc[dt][2] * inv, oacc[dt][3] * inv);
        *(v2u*)(YMIX + (size_t)tq * D + h * 64 + 16 * dt + 4 * g) = o; }
}
__device__ __forceinline__ void odd_phase3(const Frame& F) {
    if (F.G >= 256) {
        if (F.bid < 128) {
            const int bh = F.bid & 15, qt = F.bid >> 4, b = bh >> 3, h = bh & 7;
            attn_item(F, TCTX + b * 1024 + qt * 128, h, true, qt * 128, b);
        } else {
            for (int p = F.bid - 128; p < 256; p += F.G - 128) { const int s = p >> 3, h = p & 7;
                attn_item(F, s * 256, h, false, 0, s); attn_item(F, s * 256 + 128, h, false, 0, s); }
        }
        return;
    }
    for (int it = F.bid; it < 640; it += F.G) {
        if (it < 128) { const int b = it >> 6, h = (it >> 3) & 7, qt = it & 7; attn_item(F, TCTX + b * 1024 + qt * 128, h, true, qt * 128, b); }
        else { const int i2 = it - 128, s = i2 >> 4, h = (i2 >> 1) & 7, qt = i2 & 1; attn_item(F, s * 256 + qt * 128, h, false, 0, s); }
    }
}
constexpr int PH_PER_LAYER = 9, PH_L0 = 2, N_PHASES = PH_L0 + 4 * PH_PER_LAYER + 1;
#ifndef MK_ONE_LAUNCH
#define MK_ONE_LAUNCH 1
#endif
#ifndef PROBE_REP
#define PROBE_REP 1
#define PROBE_SLOT -2
#endif

__global__ void __launch_bounds__(NTHR, 2) fwd_kernel(Args args) {
    extern __shared__ __attribute__((aligned(16))) unsigned char lds[];
    Frame F; F.lds = lds; F.tid = threadIdx.x; F.lane = F.tid & 63; F.wave = __builtin_amdgcn_readfirstlane(F.tid >> 6); F.bid = blockIdx.x; F.G = gridDim.x;
    const int wave_id = F.wave;
    { CArgsP ap = (CArgsP)__builtin_amdgcn_kernarg_segment_ptr(); asm volatile("" : "+s"(ap)); F.a = ap; F.ws = (GAS unsigned char*)ap->ws; }
    LAS unsigned char* ldsl = (LAS unsigned char*)lds;
    for (int u = F.tid; u < (LDS_BYTES - LDSCTL_OFF) / 4; u += NTHR) ((LAS unsigned*)(ldsl + LDSCTL_OFF))[u] = 0u;
    __syncthreads();
    XcdBarrier bar; bar.bar = (unsigned*)(GAS unsigned*)(F.ws + WS_CTL) + 1024; bar.x = 0; bar.st = nullptr;
    const bool multi = (args.ph_hi - args.ph_lo) > 1;
    if (multi) bar = xcd_barrier_post((unsigned*)(GAS unsigned*)(F.ws + WS_CTL) + 1024, (volatile LAS unsigned*)(ldsl + MISC_OFF) + 8);

#define FRESH_F() do { int wv_ = wave_id; asm volatile("" : "+s"(wv_)); int ln_; asm volatile("v_mbcnt_lo_u32_b32 %0, -1, 0\n\tv_mbcnt_hi_u32_b32 %0, -1, %0" : "=v"(ln_)); F.tid = wv_ * 64 + ln_; F.lane = ln_; F.wave = wv_; } while (0)
    int rep = 0;
    for (int ph = args.ph_lo; ph < args.ph_hi; ) {
        { CArgsP ap = (CArgsP)__builtin_amdgcn_kernarg_segment_ptr(); asm volatile("" : "+s"(ap)); F.a = ap; F.ws = (GAS unsigned char*)ap->ws;
          int bid_ = blockIdx.x; asm volatile("" : "+s"(bid_)); F.bid = bid_; }
        if (ph == 0) { FRESH_F(); p0_phase(F); }
        else if (ph == 1) { FRESH_F(); p1_copy_phase(F); norm0_phase(F); }
        else if (ph == N_PHASES - 1) { FRESH_F(); final_phase(F); }
        else {
            const int l = (ph - PH_L0) / PH_PER_LAYER, s = (ph - PH_L0) % PH_PER_LAYER, hi = l >> 1; const bool odd = l & 1;
            if (s == 0 || s == 7) {
                FRESH_F();
                const int f = s == 0 ? 0 : 1;
                pg8::Gemm g{(const bf16*)(const GAS bf16*)(F.ws + WS_XA), (const bf16*)(const GAS bf16*)(F.ws + WS_WGU + (size_t)(l * 2 + f) * SZ_WGU), T, 2 * DFF, D, D, D};
                pg8::StaticOrder S; S.init(T, 2 * DFF, F.G, F.bid);
                EpiSwiglu E{F.ws, (int)(((l * 3) + (f == 0 ? 0 : 2)) * 3 * BIAS_MS), (l == 0 && f == 0) ? 16 : 1};
                pg8::gemm_phase<EpiSwiglu, pg8::StaticOrder, true>(ldsl, F.tid, g, S, E);
                FRESH_F();
                { const int nfull = (40 * 22) % F.G, nbg = F.G - nfull, bgi = F.bid - nfull;
                  if (bgi >= 0 && rep == 0) {
#ifdef PROBE_BG
                    for (int pb = 0; pb < PROBE_BG - 1; ++pb) { background_work(F, l, f, bgi, nbg); FRESH_F(); }
#endif
                    background_work(F, l, f, bgi, nbg); } }
            } else if (s == 1 || s == 8 || s == 6) {
                FRESH_F();
                const int f = s == 1 ? 0 : 1;
                const bool mix = s == 6, lastg = (s == 8 && l == 3);
                const bf16* gA = mix ? (const bf16*)(const GAS bf16*)(F.ws + WS_YMIX) : (const bf16*)(const GAS bf16*)(F.ws + WS_H);
                const bf16* gB = mix ? (const bf16*)(const GAS bf16*)(F.ws + (odd ? WS_WOO : WS_WOE) + (size_t)hi * SZ_WO) : (const bf16*)(const GAS bf16*)(F.ws + WS_WD + (size_t)(l * 2 + f) * SZ_WD);
                const int gK = mix ? D : DFF;
                const int gate_off = l * 3 * NMODV + (mix ? 5 : (f == 0 ? 2 : 8)) * 1024;
                const float coef = rep ? 0.f : (mix ? 1.0f : 0.5f);
                const int nl = (s == 8) ? l + 1 : l, ni = mix ? 2 : (f == 0 ? 1 : 0), sci = mix ? 7 : (f == 0 ? 4 : 1);
                const float* gn = AIN(I_GNORM) + (size_t)((lastg ? 0 : nl) * 3 + ni) * D;
                const int scn_off = (lastg ? 0 : nl) * 3 * NMODV + sci * 1024;
                pg8::Gemm g{gA, gB, T, D, gK, gK, gK};
                EpiResid160 E{F.ws, gn, gate_off, scn_off, coef};
                pg8::StaticOrder S; S.init(T, D, F.G, F.bid, 160);
                pg8::gemm_phase<EpiResid160, pg8::StaticOrder, true, 1>(ldsl, F.tid, g, S, E);
                FRESH_F();
                if (s == 8 && l < 3 && rep == 0) bias_reduce(F, l + 1, 1, F.bid, F.G);
            } else if (s == 2 || (s == 4 && odd)) {
                const int ng = s == 2 ? 1 : 3;
                for (int gi = 0; gi < ng; ++gi) {
                    FRESH_F();
                    const bool inproj = s == 2;
                    const int kind = inproj ? 0 : 1 + gi;
                    const size_t offA = kind == 0 ? WS_XA : (kind == 1 ? WS_QA : (kind == 2 ? WS_CKVA : WS_WKV + (size_t)hi * SZ_WKV + (size_t)512 * 256 * 2));
                    const size_t offB = kind == 0 ? (odd ? WS_WIO + (size_t)hi * SZ_WIO : WS_WIE + (size_t)hi * SZ_WIE) : (kind == 1 ? WS_WUQ + (size_t)hi * SZ_WUQ : (kind == 2 ? WS_WKV + (size_t)hi * SZ_WKV : WS_CKVA));
                    const size_t offO = kind == 0 ? WS_PROJ : (kind == 1 ? WS_Q : (kind == 2 ? WS_KN : WS_VT));
                    const int gM = kind == 3 ? 512 : (kind == 2 ? TP : T);
                    const int gN = kind == 0 ? (odd ? ODD_NP : EVEN_NP) : (kind == 1 ? 768 : (kind == 2 ? 512 : TP));
                    const int gK = kind == 0 ? D : (kind == 1 ? 384 : 256);
                    const int ldc = kind == 3 ? TP : gN;
                    const int off = kind == 2 ? 136 : (kind == 3 ? 52 : 0);
                    pg8::Gemm g{(const bf16*)(const GAS bf16*)(F.ws + offA), (const bf16*)(const GAS bf16*)(F.ws + offB), gM, gN, gK, gK, gK};
                    EpiStore E{F.ws, (unsigned)offO, ldc, inproj ? (int)((l * 3 + 1) * 3 * BIAS_MS) : -1};
                    pg8::StaticOrder S; S.init(gM, gN, F.G, (F.bid + off) % F.G);
                    pg8::gemm_phase<EpiStore, pg8::StaticOrder, true>(ldsl, F.tid, g, S, E);
                }
            } else if (s == 3) { if (!odd) { FRESH_F(); even_phase1(F, hi); } else { FRESH_F(); odd_phase1(F, hi); } }
            else if (s == 4) { FRESH_F(); ssd_scan_phase(F, hi); }
            else if (s == 5) { if (odd) { FRESH_F(); odd_phase3(F); } else { FRESH_F(); even_phase2(F, hi); } }
        }
        {
            const int slot = ph < PH_L0 ? 100 + ph : (ph == N_PHASES - 1 ? 102 : ((ph - PH_L0) % PH_PER_LAYER) + 20 * (((ph - PH_L0) / PH_PER_LAYER) & 1));
            const int reps = ((PROBE_SLOT == 200 && slot < 100) || slot == PROBE_SLOT || (PROBE_SLOT < 20 && slot == PROBE_SLOT + 20 && (PROBE_SLOT < 2 || PROBE_SLOT > 5))) ? PROBE_REP : 1;
            if (++rep >= reps) { rep = 0; ++ph; }
            if (ph < args.ph_hi) xcd_barrier(bar);
#if defined(PROBE_BAR)
            if (ph < args.ph_hi) { for (int pb_ = 1; pb_ < PROBE_BAR; ++pb_) xcd_barrier(bar); }
#endif
        }
    }
}

extern "C" void kernel_launch(void* const* d_in, const int* in_sizes, int n_in, void* d_out, int out_size, void* d_ws, size_t ws_size, hipStream_t stream) {
    static int grid = 0;
    if (grid == 0) {
        if (n_in != 34 || (size_t)out_size != OUT_END || ws_size < WS_END) { fprintf(stderr, "kernel_launch: unexpected problem: n_in %d out %d ws %zu (need %zu)\n", n_in, out_size, ws_size, (size_t)WS_END); grid = -1; return; }
        int dev = 0, cus = 0, per_cu = 0;
        if (hipGetDevice(&dev) != hipSuccess || hipDeviceGetAttribute(&cus, hipDeviceAttributeMultiprocessorCount, dev) != hipSuccess) { grid = -1; return; }
        if (hipFuncSetAttribute((const void*)fwd_kernel, hipFuncAttributeMaxDynamicSharedMemorySize, LDS_BYTES) != hipSuccess) { fprintf(stderr, "kernel_launch: hipFuncSetAttribute failed\n"); grid = -1; return; }
        if (hipOccupancyMaxActiveBlocksPerMultiprocessor(&per_cu, (const void*)fwd_kernel, NTHR, LDS_BYTES) != hipSuccess || per_cu < 1) { fprintf(stderr, "kernel_launch: occupancy query says %d blocks per CU\n", per_cu); per_cu = 1; }
        (void)hipGetLastError();
        grid = cus;
        if (grid < 256) fprintf(stderr, "kernel_launch: %d CUs (tuned for 256)\n", grid);
    }
    if (grid < 0) return;
    (void)hipMemsetAsync((char*)d_ws + WS_CTL, 0, CTL_ZERO_BYTES, stream);
    Args a{};
    for (int i = 0; i < 34; ++i) a.in[i] = (const float*)d_in[i];
    a.out = (float*)d_out; a.ws = (unsigned char*)d_ws;
#if MK_ONE_LAUNCH
    a.ph_lo = 0; a.ph_hi = N_PHASES; a.li = 0;
    hipLaunchKernelGGL(fwd_kernel, dim3(grid), dim3(NTHR), LDS_BYTES, stream, a);
#else
    int li = 0;
    for (int ph = 0; ph < N_PHASES; ++ph) {
        a.ph_lo = ph; a.ph_hi = ph + 1; a.li = li++;
        hipLaunchKernelGGL(fwd_kernel, dim3(grid), dim3(NTHR), LDS_BYTES, stream, a);
    }
#endif
}
```

```cpp
#include <hip/hip_runtime.h>
#include <cstdio>
#include <cstdint>
#ifndef GEMM_SP2
#define GEMM_SP2 1
#endif
#ifndef PG8_AUXA
#define PG8_AUXA 0
#endif
#ifndef PG8_AUXB
#define PG8_AUXB 0
#endif
namespace pg8 {
#define PG8_LAS __attribute__((address_space(3)))
typedef unsigned short bf16_t;
typedef short bf16x8 __attribute__((ext_vector_type(8)));
typedef float f32x4 __attribute__((ext_vector_type(4)));
typedef unsigned u32x4 __attribute__((ext_vector_type(4)));
typedef unsigned u32x2 __attribute__((ext_vector_type(2)));
constexpr int BM = 256, BK = 64, HALF = 128, HTB = HALF * BK * 2  , STAGE_BYTES = 8 * HTB, NXCD = 8, WGM = 8;

__host__ __device__ __forceinline__ int lds_byte(int r, int c) { const int st = (r >> 4) * 2 + (c >> 5), rr = r & 15, cc = c & 31, ob = rr * 64 + cc * 2; return st * 1024 + (ob ^ (((ob >> 9) & 1) << 5)); }
__host__ __device__ __forceinline__ void stage_rc(int b, int& R, int& C) { const int st = b / 1024, sb = b % 1024, swz = sb ^ (((sb >> 9) & 1) << 5); R = (st >> 1) * 16 + swz / 64; C = (st & 1) * 32 + (swz % 64) / 2; }
__host__ __device__ __forceinline__ int perm32(int rho) { const int n = rho >> 4, i = rho & 15; return 8 * (i >> 2) + 4 * n + (i & 3); }

typedef int i32x4 __attribute__((ext_vector_type(4)));
typedef int i32x8 __attribute__((ext_vector_type(8)));
__device__ __forceinline__ i32x8 cat8(bf16x8 lo, bf16x8 hi) { return __builtin_shufflevector(__builtin_bit_cast(i32x4, lo), __builtin_bit_cast(i32x4, hi), 0, 1, 2, 3, 4, 5, 6, 7); }
struct Unit { int pm, pn; };
struct Gemm { const bf16_t* A; const bf16_t* Bt; int M, N, K, lda, ldb; };

struct StaticOrder {
    int nM, nN, nwg, G, c;
    __host__ __device__ void init(int M, int N, int G_, int c_, int bmr = BM) { nM = M / bmr; nN = N / BM; nwg = nM * nN; G = G_; c = c_; }
    __host__ __device__ bool next(int i, Unit& u) const {
        const long L = (long)i * G + c; if (L >= nwg) return false;
        int wgid = (int)L; { const int q = nwg / NXCD, r = nwg % NXCD, xcd = wgid % NXCD, off = wgid / NXCD; wgid = (xcd < r ? xcd * (q + 1) : r * (q + 1) + (xcd - r) * q) + off; }
        const int nig = WGM * nN, gid = wgid / nig, fm = gid * WGM, gsz = (nM - fm) < WGM ? (nM - fm) : WGM;
        u.pm = fm + ((wgid % nig) % gsz); u.pn = (wgid % nig) / gsz; return true;
    }
    __device__ __forceinline__ void a_ready(const Unit&) const {}
    __device__ __forceinline__ void done(const Unit&) const {}
};

__device__ __forceinline__ unsigned cvt_pk_bf16(float lo, float hi) { unsigned r; asm volatile("v_cvt_pk_bf16_f32 %0, %1, %2" : "=v"(r) : "v"(lo), "v"(hi)); return r; }

template <class Epi, class Sched, bool ALIGN_EPI, int MH1 = 4, bool FP8 = false>
__device__ __forceinline__ void gemm_phase(PG8_LAS unsigned char* lds, const int tid, const Gemm g, const Sched& S, const Epi& E) {
    const int wid = __builtin_amdgcn_readfirstlane(tid >> 6), lane = tid & 63, wr = wid >> 2, wc = wid & 3, fr = lane & 15, fq = lane >> 4;
    static_assert(MH1 == 4 || MH1 == 1, "row tile");
    constexpr bool R160 = (MH1 == 1); constexpr int BMR = R160 ? 160 : 256;
    const int K = g.K, nt = K / BK;
    unsigned voffA[2], voffB[2], voffA1[2];
#pragma unroll
    for (int i = 0; i < 2; ++i) { int R, C; stage_rc(tid * 16 + i * 8192, R, C); const int Rb = Epi::PERM ? ((R & ~31) + perm32(R & 31)) : R;
        voffA[i] = (unsigned)(R * g.lda + C) * 2u; voffB[i] = (unsigned)(Rb * g.ldb + C) * 2u;
        int R1, C1; stage_rc(wid * 256 + (lane & 15) * 16 + i * 2048, R1, C1); voffA1[i] = (unsigned)(R1 * g.lda + C1) * 2u; }
    const unsigned kstep = (unsigned)(BK * 2);
    const unsigned hstepA = (unsigned)HALF * g.lda * 2, hstepB = (unsigned)HALF * g.ldb * 2;
    const unsigned tstepA = (unsigned)BMR * g.lda * 2, tstepB = 2 * hstepB;
    const __amdgpu_buffer_rsrc_t rsA = __builtin_amdgcn_make_buffer_rsrc((void*)g.A, 0, 0x7ffffff0, 0x00020000), rsB = __builtin_amdgcn_make_buffer_rsrc((void*)g.Bt, 0, 0x7ffffff0, 0x00020000);
    const unsigned ldsw = (unsigned)wid * 1024u, ldsw1 = (unsigned)wid * 256u;
    const unsigned r64A = 64u * g.lda * 2, r64B = 64u * g.ldb * 2, r16A = 16u * g.lda * 2;
    const int aoff = lds_byte(wr * 64 + fr, fq * 8), boff = lds_byte(wc * 32 + fr, fq * 8), aoff1 = lds_byte(wr * 16 + fr, fq * 8);
    int boffh = boff + 65536; asm volatile("" : "+v"(boffh));
#define PG8_SA(b, h) (((b) * 2 + (h)) * HTB)
#define PG8_SB(b, h) ((4 + (b) * 2 + (h)) * HTB)
#define PG8_STAGE(bufoff, gbase, voff) do { _Pragma("unroll") for (int _i = 0; _i < 2; ++_i) \
        __builtin_amdgcn_raw_ptr_buffer_load_lds((&(voff)[0] == &voffB[0]) ? rsB : rsA, (PG8_LAS void*)(lds + (bufoff) + ldsw + _i * 8192), 16, (int)(voff)[0], (int)((gbase) + _i * ((&(voff)[0] == &voffB[0]) ? r64B : r64A)), 0, 0); } while (0)
#define PG8_RD16(addr) (*(const PG8_LAS i32x4*)(lds + (addr)))
#define PG8_LDA_(dst, b, h) do { _Pragma("unroll") for (int m = 0; m < 4; ++m) { if constexpr (FP8) dst##8[m] = __builtin_shufflevector(PG8_RD16(PG8_SA(b, h) + aoff + m * 2048), PG8_RD16(PG8_SA(b, h) + aoff + m * 2048 + 1024), 0, 1, 2, 3, 4, 5, 6, 7); \
        else { _Pragma("unroll") for (int k = 0; k < 2; ++k) dst[m][k] = *(const PG8_LAS bf16x8*)(lds + PG8_SA(b, h) + aoff + m * 2048 + k * 1024); } } } while (0)
#define PG8_LDA(dst, b, h) do { if constexpr (R160 && (h) == 1) { if constexpr (FP8) dst##8[0] = __builtin_shufflevector(PG8_RD16(PG8_SA(b, 1) + aoff1), PG8_RD16(PG8_SA(b, 1) + aoff1 + 1024), 0, 1, 2, 3, 4, 5, 6, 7); \
        else { _Pragma("unroll") for (int k = 0; k < 2; ++k) dst[0][k] = *(const PG8_LAS bf16x8*)(lds + PG8_SA(b, 1) + aoff1 + k * 1024); } } else PG8_LDA_(dst, b, h); } while (0)
#define PG8_STAGE_A1(bufoff, gbase) do { if constexpr (R160) { if (lane < 16) { _Pragma("unroll") for (int _i = 0; _i < 2; ++_i) \
        __builtin_amdgcn_raw_ptr_buffer_load_lds(rsA, (PG8_LAS void*)(lds + (bufoff) + ldsw1 + _i * 2048), 16, (int)voffA1[0], (int)((gbase) + _i * r16A), 0, 0); } } else PG8_STAGE(bufoff, gbase, voffA); } while (0)
#define PG8_LDB(dst, b, h) do { _Pragma("unroll") for (int n = 0; n < 2; ++n) { if constexpr (FP8) dst##8[n] = __builtin_shufflevector(PG8_RD16(boffh + (PG8_SB(b, h) - 65536 + n * 2048)), PG8_RD16(boffh + (PG8_SB(b, h) - 65536 + n * 2048 + 1024)), 0, 1, 2, 3, 4, 5, 6, 7); \
        else { _Pragma("unroll") for (int k = 0; k < 2; ++k) dst[n][k] = *(const PG8_LAS bf16x8*)(lds + boffh + (PG8_SB(b, h) - 65536 + n * 2048 + k * 1024)); } } } while (0)
#define PG8_MMA(ai, bj, At, Bt) do { __builtin_amdgcn_s_setprio(1); _Pragma("unroll") for (int m = 0; m < ((R160 && (ai) == 1) ? 1 : 4); ++m) _Pragma("unroll") for (int n = 0; n < 2; ++n) { \
        if constexpr (FP8) { acc[ai][bj][m][n] = __builtin_amdgcn_mfma_scale_f32_16x16x128_f8f6f4(Bt##8[n], At##8[m], acc[ai][bj][m][n], 0, 0, 0, 0x7f7f7f7f, 0, 0x7f7f7f7f); } \
        else { _Pragma("unroll") for (int k = 0; k < 2; ++k) acc[ai][bj][m][n] = __builtin_amdgcn_mfma_f32_16x16x32_bf16(Bt[n][k], At[m][k], acc[ai][bj][m][n], 0, 0, 0); } } \
        __builtin_amdgcn_s_setprio(0); } while (0)
#define PG8_WAIT_V(n) asm volatile("s_waitcnt vmcnt(" #n ")" ::: "memory")
#define PG8_WAIT_L(n) asm volatile("s_waitcnt lgkmcnt(" #n ")" ::: "memory")
#define PG8_BAR __builtin_amdgcn_s_barrier()
#define PG8_SCHED __builtin_amdgcn_sched_barrier(0)
    Unit cur, nxt; int ui = 0;
    if (!S.next(0, cur)) return;
    f32x4 acc[2][2][4][2];
#pragma unroll
    for (int a = 0; a < 2; ++a)
#pragma unroll
        for (int b = 0; b < 2; ++b)
#pragma unroll
            for (int m = 0; m < 4; ++m)
#pragma unroll
                for (int n = 0; n < 2; ++n) acc[a][b][m][n] = (f32x4){0.f, 0.f, 0.f, 0.f};
    bf16x8 At[4][2], B0[2][2], B1[2][2];
    i32x8 At8[4], B08[2], B18[2];
    unsigned cA = (unsigned)cur.pm * tstepA, cB = (unsigned)cur.pn * tstepB;
    S.a_ready(cur);
    E.prefetch_sync(cur, tid, lds, 0); E.prefetch_dma(cur, wid, lane, lds, 0);
    typename Epi::Pre pre;
    if constexpr (R160) { E.pre_dma(cur, wid, lane, lds); E.pre_x(pre, cur, wr, wc, fr, fq); }
#if GEMM_SP2
    PG8_STAGE(PG8_SB(0, 0), cB, voffB); PG8_STAGE(PG8_SB(0, 1), cB + hstepB, voffB); PG8_STAGE(PG8_SA(0, 0), cA, voffA); PG8_STAGE_A1(PG8_SA(0, 1), cA + hstepA);
    if (wr == 1) PG8_BAR;
    PG8_WAIT_V(2); PG8_BAR;
    PG8_STAGE(PG8_SB(1, 0), cB + kstep, voffB); PG8_STAGE(PG8_SA(1, 0), cA + kstep, voffA); PG8_STAGE(PG8_SB(1, 1), cB + hstepB + kstep, voffB);
    PG8_WAIT_V(6); PG8_BAR;
#else
    static_assert(!R160, "the 160-row unit exists for the SP2 schedule only");
    PG8_STAGE(PG8_SB(0, 0), cB, voffB); PG8_STAGE(PG8_SA(0, 0), cA, voffA); PG8_STAGE(PG8_SB(0, 1), cB + hstepB, voffB); PG8_STAGE(PG8_SA(0, 1), cA + hstepA, voffA);
    if (wr == 1) PG8_BAR;
    PG8_WAIT_V(4); PG8_BAR;
    PG8_STAGE(PG8_SB(1, 0), cB + kstep, voffB); PG8_STAGE(PG8_SA(1, 0), cA + kstep, voffA); PG8_STAGE(PG8_SB(1, 1), cB + hstepB + kstep, voffB);
    PG8_WAIT_V(6); PG8_BAR;
#endif
    for (;;) {
        const bool has_next = S.next(ui + 1, nxt);
        const unsigned nA = has_next ? (unsigned)nxt.pm * tstepA : cA, nB = has_next ? (unsigned)nxt.pn * tstepB : cB;
#pragma unroll 1
        for (int t = 0; t < nt; t += 2) {
            const bool last = (t == nt - 2);
            const unsigned a1 = cA + (unsigned)(t + 1) * kstep;
            const unsigned a2 = last ? nA : cA + (unsigned)(t + 2) * kstep, b2 = last ? nB : cB + (unsigned)(t + 2) * kstep;
            const unsigned a3 = a2 + kstep, b3 = b2 + kstep;
            if (last && has_next) { S.a_ready(nxt); E.prefetch_dma(nxt, wid, lane, lds, (ui + 1) & 1); }
#if GEMM_SP2
            PG8_LDB(B0, 0, 0); PG8_LDB(B1, 0, 1); PG8_SCHED; PG8_LDA(At, 0, 0); PG8_STAGE_A1(PG8_SA(1, 1), a1 + hstepA);
            PG8_WAIT_V(8); PG8_WAIT_L(0); PG8_BAR; PG8_MMA(0, 0, At, B0); PG8_MMA(0, 1, At, B1); PG8_BAR; PG8_SCHED;
            PG8_LDA(At, 0, 1); PG8_STAGE(PG8_SB(0, 0), b2, voffB); PG8_STAGE(PG8_SB(0, 1), b2 + hstepB, voffB); PG8_STAGE(PG8_SA(0, 0), a2, voffA);
            PG8_WAIT_V(8); PG8_WAIT_L(0); PG8_BAR; PG8_MMA(1, 0, At, B0); PG8_MMA(1, 1, At, B1); PG8_BAR; PG8_SCHED;
            PG8_LDB(B0, 1, 0); PG8_LDB(B1, 1, 1); PG8_SCHED; PG8_LDA(At, 1, 0); PG8_STAGE_A1(PG8_SA(0, 1), a2 + hstepA);
            PG8_WAIT_V(8); PG8_WAIT_L(0); PG8_BAR; PG8_MMA(0, 0, At, B0); PG8_MMA(0, 1, At, B1); PG8_BAR; PG8_SCHED;
            PG8_LDA(At, 1, 1); PG8_STAGE(PG8_SB(1, 0), b3, voffB); PG8_STAGE(PG8_SB(1, 1), b3 + hstepB, voffB); PG8_STAGE(PG8_SA(1, 0), a3, voffA);
            PG8_WAIT_V(8); PG8_WAIT_L(0); PG8_BAR; PG8_MMA(1, 0, At, B0); PG8_MMA(1, 1, At, B1); PG8_BAR; PG8_SCHED;
#else
            PG8_LDB(B0, 0, 0); PG8_SCHED; PG8_LDA(At, 0, 0); PG8_STAGE(PG8_SA(1, 1), a1 + hstepA, voffA);
            PG8_WAIT_L(8); PG8_BAR; PG8_WAIT_L(0); PG8_MMA(0, 0, At, B0); PG8_BAR; PG8_SCHED;
            PG8_LDB(B1, 0, 1); PG8_STAGE(PG8_SB(0, 0), b2, voffB);
            PG8_BAR; PG8_WAIT_L(0); PG8_MMA(0, 1, At, B1); PG8_BAR;
            PG8_LDA(At, 0, 1); PG8_STAGE(PG8_SA(0, 0), a2, voffA);
            PG8_BAR; PG8_WAIT_L(0); PG8_MMA(1, 0, At, B0); PG8_BAR; PG8_SCHED;
            PG8_STAGE(PG8_SB(0, 1), b2 + hstepB, voffB);
            PG8_WAIT_V(6); PG8_BAR; PG8_MMA(1, 1, At, B1); PG8_BAR;
            PG8_LDB(B0, 1, 0); PG8_SCHED; PG8_LDA(At, 1, 0); PG8_STAGE(PG8_SA(0, 1), a2 + hstepA, voffA);
            PG8_WAIT_L(8); PG8_BAR; PG8_WAIT_L(0); PG8_MMA(0, 0, At, B0); PG8_BAR; PG8_SCHED;
            PG8_LDB(B1, 1, 1); PG8_STAGE(PG8_SB(1, 0), b3, voffB);
            PG8_BAR; PG8_WAIT_L(0); PG8_MMA(0, 1, At, B1); PG8_BAR;
            PG8_LDA(At, 1, 1); PG8_STAGE(PG8_SA(1, 0), a3, voffA);
            PG8_BAR; PG8_WAIT_L(0); PG8_MMA(1, 0, At, B0); PG8_BAR; PG8_SCHED;
            PG8_STAGE(PG8_SB(1, 1), b3 + hstepB, voffB);
            PG8_WAIT_V(6); PG8_BAR; PG8_MMA(1, 1, At, B1); PG8_BAR;
#endif
        }
        if constexpr (ALIGN_EPI) { if (wr == 0) PG8_BAR; }
        int fr_ = fr, fq_ = fq; asm volatile("" : "+v"(fr_), "+v"(fq_));
        if constexpr (R160) E(acc, cur, wr, wc, fr_, fq_, lds, pre); else E(acc, cur, wr, wc, fr_, fq_, lds, ui & 1);
#if defined(PROBE_EPI)
        if constexpr ((Epi::KIND & PROBE_EPI) != 0) { for (int er_ = 1; er_ < PROBE_EPI_REP; ++er_) { if constexpr (R160) E(acc, cur, wr, wc, fr, fq, lds, pre); else E(acc, cur, wr, wc, fr, fq, lds, ui & 1); } }
#endif
        if (!has_next) break;
#pragma unroll
        for (int a = 0; a < 2; ++a)
#pragma unroll
            for (int b = 0; b < 2; ++b)
#pragma unroll
                for (int m = 0; m < 4; ++m)
#pragma unroll
                    for (int n = 0; n < 2; ++n) acc[a][b][m][n] = (f32x4){0.f, 0.f, 0.f, 0.f};
        cur = nxt; cA = nA; cB = nB; ++ui;
        E.prefetch_sync(cur, tid, lds, ui & 1);
        if constexpr (R160) { PG8_BAR; E.pre_dma(cur, wid, lane, lds); E.pre_x(pre, cur, wr, wc, fr, fq); PG8_WAIT_V(0); }
        if constexpr (ALIGN_EPI) { if (wr == 1) PG8_BAR; }
    }
    PG8_WAIT_V(0);
    if constexpr (!ALIGN_EPI) { if (wr == 0) PG8_BAR; }
    PG8_BAR;
#undef PG8_SA
#undef PG8_SB
#undef PG8_STAGE
#undef PG8_LDA
#undef PG8_LDA_
#undef PG8_RD16
#undef PG8_STAGE_A1
#undef PG8_LDB
#undef PG8_MMA
#undef PG8_WAIT_V
#undef PG8_WAIT_L
#undef PG8_BAR
#undef PG8_SCHED
}
}
constexpr int NWAVES = 8, NTHR = 512;
constexpr int D = 1024, TCTX = 8192, TSMP = 2048, T = 10240, TP = T + 512;
constexpr int DFF = 2816, NMODV = 9 * 1024;
constexpr int EVEN_NP = 2816, ODD_NP = 1792;
constexpr float EPS = 1e-6f;
constexpr int NCHUNK = 80;

constexpr size_t MiB = 1u << 20;
constexpr size_t WS_CTL = 0, CTL_ZERO_BYTES = 64 * 1024;
constexpr size_t WS_MOD = 1 * MiB;
constexpr size_t WS_ROPE = WS_MOD + 512 * 1024;
constexpr size_t WS_DEC = WS_ROPE + 160 * 1024;
constexpr size_t WS_SSQ = WS_MOD + 768 * 1024;
constexpr size_t WS_BIAS = 2 * MiB;
constexpr size_t BIAS_LD = 5632, BIAS_MS = 16 * BIAS_LD;
constexpr size_t WS_BIASF = 15 * MiB;
constexpr size_t WS_WGU = 16 * MiB;
constexpr size_t SZ_WGU = (size_t)5632 * 1024 * 2;
constexpr size_t WS_WD = WS_WGU + 8 * SZ_WGU;
constexpr size_t SZ_WD = (size_t)1024 * 2816 * 2;
constexpr size_t WS_WIE = WS_WD + 8 * SZ_WD;
constexpr size_t SZ_WIE = (size_t)EVEN_NP * 1024 * 2;
constexpr size_t WS_WOE = WS_WIE + 2 * SZ_WIE;
constexpr size_t SZ_WO = (size_t)1024 * 1024 * 2;
constexpr size_t WS_WIO = WS_WOE + 2 * SZ_WO;
constexpr size_t SZ_WIO = (size_t)ODD_NP * 1024 * 2;
constexpr size_t WS_WOO = WS_WIO + 2 * SZ_WIO;
constexpr size_t WS_WUQ = WS_WOO + 2 * SZ_WO;
constexpr size_t SZ_WUQ = (size_t)768 * 384 * 2;
constexpr size_t WS_WKV = WS_WUQ + 2 * SZ_WUQ;
constexpr size_t SZ_WKV = (size_t)1024 * 256 * 2;
constexpr size_t WS_WEND = WS_WKV + 2 * SZ_WKV;
constexpr size_t WS_X = (WS_WEND + MiB - 1) / MiB * MiB;
constexpr size_t WS_XA = WS_X + (size_t)T * D * 4;
constexpr size_t WS_PROJ = WS_XA + (size_t)T * D * 2;
constexpr size_t WS_YMIX = WS_PROJ + (size_t)T * EVEN_NP * 2;
constexpr size_t WS_H = WS_YMIX + (size_t)T * D * 2;
constexpr size_t WS_ST = WS_H;
constexpr size_t WS_QA = WS_H;
constexpr size_t WS_CKVA = WS_QA + (size_t)T * 384 * 2;
constexpr size_t WS_KR = WS_CKVA + (size_t)TP * 256 * 2;
constexpr size_t WS_Q = WS_KR + (size_t)TP * 32 * 2;
constexpr size_t WS_KN = WS_Q + (size_t)T * 768 * 2;
constexpr size_t WS_VT = WS_KN + (size_t)TP * 512 * 2;
constexpr size_t WS_HEND = WS_H + (size_t)T * DFF * 2;
static_assert(WS_VT + (size_t)512 * TP * 2 <= WS_HEND, "odd-layer scratch fits the H overlay");
static_assert(WS_ST + (size_t)NCHUNK * 8 * 2 * 8192 * 4 <= WS_HEND, "chunk states fit the H overlay");
constexpr size_t WS_XCT = WS_HEND;
constexpr size_t WS_CC = WS_XCT + (size_t)NCHUNK * 8 * 8192 * 2;
constexpr size_t WS_CBM = WS_CC + (size_t)T * 256 * 2;
constexpr size_t WS_HIN = WS_CBM + (size_t)NCHUNK * 2 * 16384 * 2;
constexpr size_t WS_END = WS_HIN + (size_t)NCHUNK * 8 * 2 * 8192 * 2;

constexpr size_t OUT_Y = 0, OUT_SSD = (size_t)T * D, OUT_CKV = OUT_SSD + (size_t)32 * 2 * 2 * 8 * 64 * 128, OUT_KR = OUT_CKV + (size_t)32 * 2 * 256 * 256, OUT_END = OUT_KR + (size_t)32 * 2 * 256 * 32;

constexpr int RING_BYTES = 131072;
constexpr int LDSCTL_OFF = 144 * 1024 - 512, MISC_OFF = LDSCTL_OFF + 320;
constexpr int LDS_BYTES = 147456;

#define GAS __attribute__((address_space(1)))
#define LAS __attribute__((address_space(3)))
typedef unsigned short bf16;
typedef unsigned v4u __attribute__((ext_vector_type(4)));
typedef unsigned v2u __attribute__((ext_vector_type(2)));
typedef float f32x4 __attribute__((ext_vector_type(4)));
typedef short bf16x8 __attribute__((ext_vector_type(8)));
#define Z4() ({ float z_; asm volatile("v_mov_b32 %0, 0" : "=v"(z_)); (f32x4){z_, z_, z_, z_}; })
typedef GAS unsigned gu32;
#define RLX_AGENT __ATOMIC_RELAXED, __HIP_MEMORY_SCOPE_AGENT
__device__ __forceinline__ unsigned f2bf(float f) { unsigned u = __builtin_bit_cast(unsigned, f); return (u + 0x7fffu + ((u >> 16) & 1u)) >> 16; }
typedef float f32x2_t __attribute__((ext_vector_type(2)));
typedef __bf16 bf16x2_t __attribute__((ext_vector_type(2)));
__device__ __forceinline__ unsigned pk2(float lo, float hi) { const f32x2_t v = {lo, hi}; const bf16x2_t b = __builtin_convertvector(v, bf16x2_t); return __builtin_bit_cast(unsigned, b); }
__device__ __forceinline__ unsigned f2bf1(float f) { return pk2(f, 0.f) & 0xffffu; }
__device__ __forceinline__ float bflo(unsigned w) { return __builtin_bit_cast(float, w << 16); }
__device__ __forceinline__ float bfhi(unsigned w) { return __builtin_bit_cast(float, w & 0xffff0000u); }
__device__ __forceinline__ float bf1(bf16 h) { return __builtin_bit_cast(float, ((unsigned)h) << 16); }
__device__ __forceinline__ void unpack8(const v4u v, float* o) { o[0] = bflo(v.x); o[1] = bfhi(v.x); o[2] = bflo(v.y); o[3] = bfhi(v.y); o[4] = bflo(v.z); o[5] = bfhi(v.z); o[6] = bflo(v.w); o[7] = bfhi(v.w); }
__device__ __forceinline__ v4u pack8(const float* o) { v4u v; v.x = pk2(o[0], o[1]); v.y = pk2(o[2], o[3]); v.z = pk2(o[4], o[5]); v.w = pk2(o[6], o[7]); return v; }
template <int K> __device__ __forceinline__ float xlane(float v) { static_assert(K >= 1 && K < 32, "xor mask inside a 32-lane half");
    return __builtin_bit_cast(float, __builtin_amdgcn_ds_swizzle(__builtin_bit_cast(int, v), (K << 10) | 0x1F)); }
__device__ __forceinline__ float sum_x32(float v) { const unsigned u = __builtin_bit_cast(unsigned, v); const auto r = __builtin_amdgcn_permlane32_swap(u, u, false, false);
    return __builtin_bit_cast(float, (unsigned)r[0]) + __builtin_bit_cast(float, (unsigned)r[1]); }
__device__ __forceinline__ float max_x32(float v) { const unsigned u = __builtin_bit_cast(unsigned, v); const auto r = __builtin_amdgcn_permlane32_swap(u, u, false, false);
    return fmaxf(__builtin_bit_cast(float, (unsigned)r[0]), __builtin_bit_cast(float, (unsigned)r[1])); }
__device__ __forceinline__ float wave_sum(float v) {
    v += xlane<1>(v); v += xlane<2>(v); v += xlane<4>(v); v += xlane<8>(v); v += xlane<16>(v);
    return sum_x32(v);
}
__device__ __forceinline__ float frcp(float x) { return __builtin_amdgcn_rcpf(x); }
__device__ __forceinline__ float frsq(float x) { return __builtin_amdgcn_rsqf(x); }
__device__ __forceinline__ float sigmoidf_(float x) { return frcp(1.0f + __expf(-x)); }
__device__ __forceinline__ float siluf_(float x) { return x * frcp(1.0f + __expf(-x)); }
__device__ __forceinline__ float gelu_tanh(float x) { const float y = 0.7978845608028654f * (x + 0.044715f * x * x * x); const float t = 1.0f - 2.0f * frcp(1.0f + __expf(2.0f * y)); return 0.5f * x * (1.0f + t); }
__device__ __forceinline__ float softplusf_(float x) { const float e = __expf(x); return x > 20.f ? x : (e < 1e-3f ? e * (1.0f - 0.5f * e) : __logf(1.0f + e)); }
__device__ __forceinline__ int modrow_of_tile(int pm) { return pm < 32 ? 0 : 1 + ((pm - 32) >> 2); }
__device__ __forceinline__ int modrow_of_tok(int t) { return t < TCTX ? 0 : 1 + ((t - TCTX) >> 10); }

#define XB_TMO      128
#define XB_XCNT(j)  (256  + 64 * (j))
#define XB_XSUB(j)  (1280 + 64 * (j))
#define XB_XGEN(j)  (2304 + 64 * (j))
#define XB_TOP      3328
#define XB_TOPGEN   3392
#define XCD_BAR_WORDS 3456
#define XB_SPIN_CAP (1u << 22)
__device__ __forceinline__ unsigned xb_ld(unsigned* p)              { return __hip_atomic_load(p, __ATOMIC_RELAXED, __HIP_MEMORY_SCOPE_AGENT); }
__device__ __forceinline__ unsigned xb_add(unsigned* p, unsigned v) { return __hip_atomic_fetch_add(p, v, __ATOMIC_RELAXED, __HIP_MEMORY_SCOPE_AGENT); }
__device__ __forceinline__ unsigned xb_xcc_id() { return (unsigned)__builtin_amdgcn_s_getreg((3 << 11) | 20) & 0xFu; }
#define XB_SPIN(cond, bar) do { unsigned _sp = 0; while (cond) { __builtin_amdgcn_s_sleep(1); \
    if ((++_sp & 255u) == 0u) { if (xb_ld(&(bar)[XB_TMO])) break; if (_sp > XB_SPIN_CAP) { atomicAdd(&(bar)[XB_TMO], 1u); break; } } } } while (0)
struct XcdBarrier { unsigned* bar; unsigned x; volatile LAS unsigned* st; };
__device__ __forceinline__ XcdBarrier xcd_barrier_post(unsigned* bar, volatile LAS unsigned* st) {
    XcdBarrier b; b.bar = bar; b.x = xb_xcc_id(); b.st = st;
    if (threadIdx.x == 0) (void)xb_add(&bar[XB_XCNT(b.x)], 1u);
    return b;
}
__device__ __forceinline__ void xcd_barrier_complete(unsigned* bar, unsigned x, unsigned& nloc, unsigned& nx) {
    const unsigned G = gridDim.x * gridDim.y * gridDim.z;
    unsigned sum, cnt, mine, sp = 0u;
    for (;;) {
        sum = 0u; cnt = 0u; mine = 0u;
#pragma unroll
        for (unsigned j = 0; j < 16; ++j) { const unsigned c = xb_ld(&bar[XB_XCNT(j)]); sum += c; cnt += (c > 0u) ? 1u : 0u; mine = (j == x) ? c : mine; }
        if (sum == G) break;
        __builtin_amdgcn_s_sleep(1);
        if ((++sp & 255u) == 0u) { if (xb_ld(&bar[XB_TMO])) break; if (sp > XB_SPIN_CAP) { atomicAdd(&bar[XB_TMO], 1u); break; } }
    }
    nloc = mine > 0u ? mine : 1u; nx = cnt > 0u ? cnt : 1u;
}
__device__ __forceinline__ void xcd_barrier(const XcdBarrier& b) {
    asm volatile("s_waitcnt vmcnt(0)" ::: "memory");
    __syncthreads();
    if (threadIdx.x == 0) {
        unsigned* bar = b.bar;
        __builtin_amdgcn_s_waitcnt(0);
        unsigned nloc = b.st[0], nx = b.st[1];
        if (nloc == 0u) { xcd_barrier_complete(bar, b.x, nloc, nx); b.st[0] = nloc; b.st[1] = nx; }
        const unsigned k = b.st[2] + 1u; b.st[2] = k;
        const unsigned old = xb_add(&bar[XB_XSUB(b.x)], 1u);
        if (old + 1u == k * nloc) {
            __builtin_amdgcn_fence(__ATOMIC_RELEASE, "agent");
            asm volatile("s_waitcnt vmcnt(0)" ::: "memory");
            const unsigned og = xb_add(&bar[XB_TOP], 1u);
            if (og + 1u == k * nx) xb_add(&bar[XB_TOPGEN], 1u);
        }
        XB_SPIN(xb_ld(&bar[XB_TOPGEN]) < k, bar);
        __builtin_amdgcn_fence(__ATOMIC_ACQUIRE, "agent");
        asm volatile("s_waitcnt vmcnt(0)" ::: "memory");
    }
    __syncthreads();
}

struct Args { const float* in[34]; float* out; unsigned char* ws; int ph_lo, ph_hi, li, pad; };
typedef const __attribute__((address_space(4))) Args* CArgsP;
enum { I_XP = 0, I_XS, I_SSD, I_CCKV, I_CKR, I_C, I_CCTX, I_WMOD, I_BMOD, I_GNORM, I_WGU, I_WDN, I_WIE, I_WOE, I_WSP, I_BSP, I_GV, I_WCS, I_BCS, I_DTB, I_ALOG, I_DSK, I_GSO,
       I_WIO, I_WOO, I_GCQ, I_WUQ, I_GCKV, I_WUKV, I_WDW, I_BDW, I_GLN, I_BLN, I_GFIN };
constexpr int G1F8_L = 1;
constexpr float H8_SCALE = 4.0f, WD8_SCALE = 256.0f, XA8_SCALE = 4.0f, WGU8_SCALE = 256.0f;
__device__ __forceinline__ unsigned pk4_fp8(float a, float b, float c, float d, float sc) {
    a = __builtin_amdgcn_fmed3f(a * sc, -448.f, 448.f); b = __builtin_amdgcn_fmed3f(b * sc, -448.f, 448.f); c = __builtin_amdgcn_fmed3f(c * sc, -448.f, 448.f); d = __builtin_amdgcn_fmed3f(d * sc, -448.f, 448.f);
    int r = __builtin_amdgcn_cvt_pk_fp8_f32(a, b, 0, false); r = __builtin_amdgcn_cvt_pk_fp8_f32(c, d, r, true); return (unsigned)r; }
using pg8::Unit;
constexpr int EP_PART = RING_BYTES, EP_S = RING_BYTES + 4096, EP_B = RING_BYTES + 4096 + 8192;
__device__ __forceinline__ void epi_prefetch_dma(GAS unsigned char* ws, int bias_off, const Unit& u, int wid, int lane, PG8_LAS unsigned char* ldsl, int par) {
    const __amdgpu_buffer_rsrc_t rs = __builtin_amdgcn_make_buffer_rsrc((void*)ws, 0, 0x7ffffff0, 0x00020000);
    if (wid < 4) __builtin_amdgcn_raw_ptr_buffer_load_lds(rs, (PG8_LAS void*)(ldsl + EP_S + par * 4096 + wid * 1024), 16, lane * 16, (int)(WS_SSQ + (size_t)(u.pm * 256 + 64 * wid) * 16), 0, 0);
    else if (wid == 4) __builtin_amdgcn_raw_ptr_buffer_load_lds(rs, (PG8_LAS void*)(ldsl + EP_B + par * 1024), 16, lane * 16, (int)(WS_BIASF + ((size_t)bias_off / 16 + (size_t)modrow_of_tile(u.pm) * BIAS_LD + u.pn * 256) * 4), 0, 0);
}
__device__ __forceinline__ void epi_prefetch_sync16(GAS unsigned char* ws, int bias_off, const Unit& u, int tid, PG8_LAS unsigned char* ldsl, int par) {
    if (tid < 256) *(PG8_LAS pg8::f32x4*)(ldsl + EP_S + par * 4096 + tid * 16) = *(const GAS pg8::f32x4*)(ws + WS_SSQ + ((size_t)(u.pm * 256 + tid) * 4) * 4);
    else { const GAS float* bp = (const GAS float*)(ws + WS_BIAS) + (size_t)bias_off + (size_t)modrow_of_tile(u.pm) * BIAS_MS + u.pn * 256 + (tid - 256); float b = 0.f;
#pragma unroll
        for (int kb = 0; kb < 16; ++kb) b += bp[(size_t)kb * BIAS_LD];
        ((PG8_LAS float*)(ldsl + EP_B))[par * 256 + (tid - 256)] = b; }
}
__device__ __forceinline__ float epi_row_rstd(const PG8_LAS unsigned char* ldsl, int par, int rl) { const pg8::f32x4 s = *(const PG8_LAS pg8::f32x4*)(ldsl + EP_S + par * 4096 + rl * 16); return frsq(((s[0] + s[1]) + (s[2] + s[3])) * (1.f / D) + EPS); }
struct EpiSwiglu {
    static constexpr bool PERM = true; static constexpr int KIND = 1; struct Pre {};
    GAS unsigned char* ws; int bias_off, nparts; float inv_scale = 1.0f;
    __device__ __forceinline__ void prefetch_dma(const Unit& u, int wid, int lane, PG8_LAS unsigned char* ldsl, int par) const { if (nparts == 1) epi_prefetch_dma(ws, bias_off, u, wid, lane, ldsl, par); }
    __device__ __forceinline__ void prefetch_sync(const Unit& u, int tid, PG8_LAS unsigned char* ldsl, int par) const { if (nparts != 1) epi_prefetch_sync16(ws, bias_off, u, tid, ldsl, par); }
    __device__ __forceinline__ void operator()(const pg8::f32x4 (&acc)[2][2][4][2], const Unit& u, int wr, int wc, int fr, int fq, PG8_LAS unsigned char* ldsl, int par) const {
        unsigned char* H = (unsigned char*)(GAS unsigned char*)(ws + WS_H);
        const PG8_LAS float* bb = (const PG8_LAS float*)(ldsl + EP_B) + par * 256 + wc * 32 + 8 * fq;
        const int row0 = u.pm * 256 + wr * 64 + fr, col0 = u.pn * 128 + wc * 32 + 8 * fq;
        const pg8::f32x4 bg0 = *(const PG8_LAS pg8::f32x4*)bb, bg1 = *(const PG8_LAS pg8::f32x4*)(bb + 4), bu0 = *(const PG8_LAS pg8::f32x4*)(bb + 128), bu1 = *(const PG8_LAS pg8::f32x4*)(bb + 132);
#pragma unroll
        for (int ai = 0; ai < 2; ++ai)
#pragma unroll
            for (int m = 0; m < 4; ++m) {
                const int rl = ai * 128 + wr * 64 + m * 16 + fr;
                const float rs = epi_row_rstd(ldsl, par, rl) * inv_scale;
                unsigned char* rowp = H + (size_t)(u.pm * 256 + rl) * DFF + col0;
                const pg8::f32x4 g0 = acc[ai][0][m][0] * rs + bg0, g1 = acc[ai][0][m][1] * rs + bg1, u0 = acc[ai][1][m][0] * rs + bu0, u1 = acc[ai][1][m][1] * rs + bu1;
                float gg[8], uu[8], e[8], o[8];
#pragma unroll
                for (int j = 0; j < 4; ++j) { gg[j] = g0[j]; gg[4 + j] = g1[j]; uu[j] = u0[j]; uu[4 + j] = u1[j]; }
#pragma unroll
                for (int j = 0; j < 8; ++j) e[j] = __builtin_amdgcn_exp2f(gg[j] * -1.4426950408889634f);
#pragma unroll
                for (int j = 0; j < 8; ++j) e[j] = __builtin_amdgcn_rcpf(1.0f + e[j]);
#pragma unroll
                for (int j = 0; j < 8; ++j) o[j] = (gg[j] * uu[j]) * e[j];
                pg8::u32x2 w; w.x = pk4_fp8(o[0], o[1], o[2], o[3], H8_SCALE); w.y = pk4_fp8(o[4], o[5], o[6], o[7], H8_SCALE);
                *(pg8::u32x2*)rowp = w;
            }
        (void)row0;
    }
};
struct EpiResid {
    static constexpr bool PERM = true; static constexpr int KIND = 4;
    GAS unsigned char* ws; const float* gn; int gate_off, scn_off; float coef;
    __device__ __forceinline__ void prefetch_dma(const Unit&, int, int, PG8_LAS unsigned char*, int) const {}
    __device__ __forceinline__ void prefetch_sync(const Unit&, int, PG8_LAS unsigned char*, int) const {}
    __device__ __forceinline__ void operator()(const pg8::f32x4 (&acc)[2][2][4][2], const Unit& u, int wr, int wc, int fr, int fq, PG8_LAS unsigned char* ldsl, int) const {
        bf16* X = (bf16*)(GAS bf16*)(ws + WS_X); const float* gate = (const float*)(const GAS float*)(ws + WS_MOD) + gate_off; const float* scn = (const float*)(const GAS float*)(ws + WS_MOD) + scn_off;
        bf16* XA = (bf16*)(GAS bf16*)(ws + WS_XA); float* SSQ = (float*)(GAS float*)(ws + WS_SSQ); PG8_LAS float* part = (PG8_LAS float*)(ldsl + EP_PART);
        const int row0 = u.pm * 256 + wr * 64 + fr, col0 = u.pn * 256 + wc * 32 + 8 * fq;
        const int mr = modrow_of_tile(u.pm);
        float ss[2][4];
#pragma unroll
        for (int ai = 0; ai < 2; ++ai)
#pragma unroll
            for (int m = 0; m < 4; ++m) ss[ai][m] = 0.f;
#pragma unroll
        for (int bj = 0; bj < 2; ++bj) {
            const int co = col0 + bj * 128;
            const float* gp = gate + (size_t)mr * NMODV + co; const float* sp = scn + (size_t)mr * NMODV + co;
            const pg8::f32x4 gv0 = *(const pg8::f32x4*)gp * coef, gv1 = *(const pg8::f32x4*)(gp + 4) * coef;
            const pg8::f32x4 gc0 = *(const pg8::f32x4*)(gn + co) * (*(const pg8::f32x4*)sp + 1.0f), gc1 = *(const pg8::f32x4*)(gn + co + 4) * (*(const pg8::f32x4*)(sp + 4) + 1.0f);
#pragma unroll
            for (int ai = 0; ai < 2; ++ai) {
                pg8::u32x4 xo[4];
#pragma unroll
                for (int m = 0; m < 4; ++m) xo[m] = *(const pg8::u32x4*)(X + (size_t)(row0 + ai * 128 + m * 16) * D + co);
#pragma unroll
                for (int m = 0; m < 4; ++m) {
                    const size_t off = (size_t)(row0 + ai * 128 + m * 16) * D + co;
                    const pg8::u32x4 xw = xo[m];
                    const pg8::f32x4 x0 = {bflo(xw.x), bfhi(xw.x), bflo(xw.y), bfhi(xw.y)}, x1 = {bflo(xw.z), bfhi(xw.z), bflo(xw.w), bfhi(xw.w)};
                    const pg8::f32x4 n0 = x0 + gv0 * acc[ai][bj][m][0], n1 = x1 + gv1 * acc[ai][bj][m][1];
                    ss[ai][m] += ((n0[0] * n0[0] + n0[1] * n0[1]) + (n0[2] * n0[2] + n0[3] * n0[3])) + ((n1[0] * n1[0] + n1[1] * n1[1]) + (n1[2] * n1[2] + n1[3] * n1[3]));
                    pg8::u32x4 w; w.x = pg8::cvt_pk_bf16(n0[0], n0[1]); w.y = pg8::cvt_pk_bf16(n0[2], n0[3]); w.z = pg8::cvt_pk_bf16(n1[0], n1[1]); w.w = pg8::cvt_pk_bf16(n1[2], n1[3]);
                    *(pg8::u32x4*)(X + off) = w;
                    const pg8::f32x4 a0 = n0 * gc0, a1 = n1 * gc1;
                    pg8::u32x4 v; v.x = pg8::cvt_pk_bf16(a0[0], a0[1]); v.y = pg8::cvt_pk_bf16(a0[2], a0[3]); v.z = pg8::cvt_pk_bf16(a1[0], a1[1]); v.w = pg8::cvt_pk_bf16(a1[2], a1[3]);
                    *(pg8::u32x4*)(XA + off) = v;
                }
            }
        }
#pragma unroll
        for (int ai = 0; ai < 2; ++ai)
#pragma unroll
            for (int m = 0; m < 4; ++m) { float s = ss[ai][m]; s += xlane<16>(s); s = sum_x32(s);
                if (fq == 0) part[wc * 256 + ai * 128 + wr * 64 + m * 16 + fr] = s; }
        asm volatile("s_waitcnt lgkmcnt(0)" ::: "memory"); __builtin_amdgcn_s_barrier(); asm volatile("" ::: "memory");
        const int t = (wr * 4 + wc) * 64 + fq * 16 + fr;
        if (t < 256) SSQ[(size_t)(u.pm * 256 + t) * 4 + u.pn] = (part[t] + part[256 + t]) + (part[512 + t] + part[768 + t]);
    }
};
template <bool PREX, bool XA8 = false> struct EpiResid160T {
    static constexpr bool PERM = true; static constexpr int KIND = 4;
    GAS unsigned char* ws; const float* gn; int gate_off, scn_off; float coef; bool xa8rt = false;
    struct Pre { pg8::u32x4 xo[2][5]; };
    __device__ __forceinline__ void prefetch_dma(const Unit&, int, int, PG8_LAS unsigned char*, int) const {}
    __device__ __forceinline__ void prefetch_sync(const Unit&, int, PG8_LAS unsigned char*, int) const {}
    __device__ __forceinline__ void pre_dma(const Unit& u, int wid, int lane, PG8_LAS unsigned char* ldsl) const {
        const int rowbase = u.pm * 160, mrA = modrow_of_tok(rowbase), mrB = modrow_of_tok(rowbase + 159), col = u.pn * 256 + 4 * lane;
        if (wid < 5) {
            const int mr = wid >= 3 ? mrB : mrA;
            const GAS float* modp = (const GAS float*)(ws + WS_MOD) + (size_t)mr * NMODV + col;
            const GAS float* src = (wid == 2) ? (const GAS float*)gn + col : ((wid == 0 || wid == 3) ? modp + gate_off : modp + scn_off);
            __builtin_amdgcn_global_load_lds((const GAS unsigned*)src, (PG8_LAS unsigned*)(ldsl + EP_S + wid * 1024), 16, 0, 0);
        }
    }
    __device__ __forceinline__ void pre_x(Pre& pre, const Unit& u, int wr, int wc, int fr, int fq) const {
        if constexpr (!PREX) return;
        const bf16* X = (const bf16*)(const GAS bf16*)(ws + WS_X);
        const int rowbase = u.pm * 160, col0 = u.pn * 256 + wc * 32 + 8 * fq;
#pragma unroll
        for (int bj = 0; bj < 2; ++bj)
#pragma unroll
            for (int i = 0; i < 5; ++i) { const int rl = i < 4 ? wr * 64 + i * 16 + fr : 128 + wr * 16 + fr; pre.xo[bj][i] = *(const pg8::u32x4*)(X + (size_t)(rowbase + rl) * D + col0 + bj * 128); }
    }
    __device__ __forceinline__ void operator()(const pg8::f32x4 (&acc)[2][2][4][2], const Unit& u, int wr, int wc, int fr, int fq, PG8_LAS unsigned char* ldsl, const Pre& pre) const {
        bf16* X = (bf16*)(GAS bf16*)(ws + WS_X);
        bf16* XA = (bf16*)(GAS bf16*)(ws + WS_XA); float* SSQ = (float*)(GAS float*)(ws + WS_SSQ); PG8_LAS float* part = (PG8_LAS float*)(ldsl + EP_PART);
        const PG8_LAS float* V = (const PG8_LAS float*)(ldsl + EP_S);
        const int rowbase = u.pm * 160, col0 = u.pn * 256 + wc * 32 + 8 * fq;
        const int mrA = modrow_of_tok(rowbase), mrB = modrow_of_tok(rowbase + 159);
        const int bnd = (mrA == mrB) ? (1 << 30) : (mrB == 1 ? TCTX : TCTX + 1024);
        float ss[5];
#pragma unroll
        for (int i = 0; i < 5; ++i) ss[i] = 0.f;
#pragma unroll
        for (int bj = 0; bj < 2; ++bj) {
            const int co = col0 + bj * 128, cl = wc * 32 + 8 * fq + bj * 128;
            const pg8::f32x4 gn0 = *(const PG8_LAS pg8::f32x4*)(V + 512 + cl), gn1 = *(const PG8_LAS pg8::f32x4*)(V + 512 + cl + 4);
            const pg8::f32x4 gvA0 = *(const PG8_LAS pg8::f32x4*)(V + cl) * coef, gvA1 = *(const PG8_LAS pg8::f32x4*)(V + cl + 4) * coef, gvB0 = *(const PG8_LAS pg8::f32x4*)(V + 768 + cl) * coef, gvB1 = *(const PG8_LAS pg8::f32x4*)(V + 768 + cl + 4) * coef;
            const pg8::f32x4 gcA0 = gn0 * (*(const PG8_LAS pg8::f32x4*)(V + 256 + cl) + 1.0f), gcA1 = gn1 * (*(const PG8_LAS pg8::f32x4*)(V + 256 + cl + 4) + 1.0f);
            const pg8::f32x4 gcB0 = gn0 * (*(const PG8_LAS pg8::f32x4*)(V + 1024 + cl) + 1.0f), gcB1 = gn1 * (*(const PG8_LAS pg8::f32x4*)(V + 1024 + cl + 4) + 1.0f);
            pg8::u32x4 xo5[5];
#pragma unroll
            for (int i = 0; i < 5; ++i) { const int rl = i < 4 ? wr * 64 + i * 16 + fr : 128 + wr * 16 + fr;
                if constexpr (PREX) xo5[i] = pre.xo[bj][i]; else xo5[i] = *(const pg8::u32x4*)(X + (size_t)(rowbase + rl) * D + co); }
#pragma unroll
            for (int i = 0; i < 5; ++i) {
                const int rb = i < 4 ? wr * 64 + i * 16 : 128 + wr * 16;
                const bool hb = rowbase + rb >= bnd;
                const pg8::f32x4 gv0 = hb ? gvB0 : gvA0, gv1 = hb ? gvB1 : gvA1, gc0 = hb ? gcB0 : gcA0, gc1 = hb ? gcB1 : gcA1;
                const size_t off = (size_t)(rowbase + rb + fr) * D + co;
                const pg8::u32x4 xw = xo5[i];
                const pg8::f32x4 c0 = i < 4 ? acc[0][bj][i & 3][0] : acc[1][bj][0][0], c1 = i < 4 ? acc[0][bj][i & 3][1] : acc[1][bj][0][1];
                const pg8::f32x4 x0 = {bflo(xw.x), bfhi(xw.x), bflo(xw.y), bfhi(xw.y)}, x1 = {bflo(xw.z), bfhi(xw.z), bflo(xw.w), bfhi(xw.w)};
                const pg8::f32x4 n0 = x0 + gv0 * c0, n1 = x1 + gv1 * c1;
                ss[i] += ((n0[0] * n0[0] + n0[1] * n0[1]) + (n0[2] * n0[2] + n0[3] * n0[3])) + ((n1[0] * n1[0] + n1[1] * n1[1]) + (n1[2] * n1[2] + n1[3] * n1[3]));
                pg8::u32x4 w; w.x = pg8::cvt_pk_bf16(n0[0], n0[1]); w.y = pg8::cvt_pk_bf16(n0[2], n0[3]); w.z = pg8::cvt_pk_bf16(n1[0], n1[1]); w.w = pg8::cvt_pk_bf16(n1[2], n1[3]);
                *(pg8::u32x4*)(X + off) = w;
                const pg8::f32x4 a0 = n0 * gc0, a1 = n1 * gc1;
                if (XA8 || (!PREX && xa8rt)) { pg8::u32x2 v8; v8.x = pk4_fp8(a0[0], a0[1], a0[2], a0[3], XA8_SCALE); v8.y = pk4_fp8(a1[0], a1[1], a1[2], a1[3], XA8_SCALE); *(pg8::u32x2*)((unsigned char*)XA + off) = v8; }
                else { pg8::u32x4 v; v.x = pg8::cvt_pk_bf16(a0[0], a0[1]); v.y = pg8::cvt_pk_bf16(a0[2], a0[3]); v.z = pg8::cvt_pk_bf16(a1[0], a1[1]); v.w = pg8::cvt_pk_bf16(a1[2], a1[3]);
                    *(pg8::u32x4*)(XA + off) = v; }
            }
        }
#pragma unroll
        for (int i = 0; i < 5; ++i) { float s = ss[i]; s += xlane<16>(s); s = sum_x32(s);
            if (fq == 0) part[wc * 160 + (i < 4 ? wr * 64 + i * 16 + fr : 128 + wr * 16 + fr)] = s; }
        asm volatile("s_waitcnt lgkmcnt(0)" ::: "memory"); __builtin_amdgcn_s_barrier(); asm volatile("" ::: "memory");
        const int t = (wr * 4 + wc) * 64 + fq * 16 + fr;
        if (t < 160) SSQ[(size_t)(rowbase + t) * 4 + u.pn] = (part[t] + part[160 + t]) + (part[320 + t] + part[480 + t]);
    }
};
typedef EpiResid160T<true> EpiResid160;
typedef EpiResid160T<true, true> EpiResid160X8;
typedef EpiResid160T<false> EpiResid160L;
struct EpiStore {
    static constexpr bool PERM = true; static constexpr int KIND = 2; struct Pre {};
    GAS unsigned char* ws; unsigned o_off; int ldc; int bias_off;
    __device__ __forceinline__ void prefetch_dma(const Unit& u, int wid, int lane, PG8_LAS unsigned char* ldsl, int par) const { if (bias_off >= 0) epi_prefetch_dma(ws, bias_off, u, wid, lane, ldsl, par); }
    __device__ __forceinline__ void prefetch_sync(const Unit&, int, PG8_LAS unsigned char*, int) const {}
    __device__ __forceinline__ void operator()(const pg8::f32x4 (&acc)[2][2][4][2], const Unit& u, int wr, int wc, int fr, int fq, PG8_LAS unsigned char* ldsl, int par) const {
        bf16* O = (bf16*)(GAS bf16*)(ws + o_off);
        const PG8_LAS float* bb = (const PG8_LAS float*)(ldsl + EP_B) + par * 256 + wc * 32 + 8 * fq;
        const int col0 = u.pn * 256 + wc * 32 + 8 * fq; const bool nrm = bias_off >= 0;
        pg8::f32x4 b[2][2];
#pragma unroll
        for (int bj = 0; bj < 2; ++bj)
#pragma unroll
            for (int n = 0; n < 2; ++n) { const pg8::f32x4 bv = *(const PG8_LAS pg8::f32x4*)(bb + bj * 128 + 4 * n); b[bj][n] = nrm ? bv : (pg8::f32x4){0.f, 0.f, 0.f, 0.f}; }
#pragma unroll
        for (int ai = 0; ai < 2; ++ai)
#pragma unroll
            for (int m = 0; m < 4; ++m) {
                const int rl = ai * 128 + wr * 64 + m * 16 + fr;
                const float rs0 = epi_row_rstd(ldsl, par, rl), rs = nrm ? rs0 : 1.0f;
                bf16* rowp = O + (size_t)(u.pm * 256 + rl) * ldc + col0;
#pragma unroll
                for (int bj = 0; bj < 2; ++bj) {
                    const pg8::f32x4 v0 = acc[ai][bj][m][0] * rs + b[bj][0], v1 = acc[ai][bj][m][1] * rs + b[bj][1];
                    pg8::u32x4 w; w.x = pg8::cvt_pk_bf16(v0[0], v0[1]); w.y = pg8::cvt_pk_bf16(v0[2], v0[3]); w.z = pg8::cvt_pk_bf16(v1[0], v1[1]); w.w = pg8::cvt_pk_bf16(v1[2], v1[3]);
                    *(pg8::u32x4*)(rowp + bj * 128) = w;
                }
            }
    }
};

struct Frame {
    unsigned char* lds;
    mutable int tid, lane; int wave, bid, G;
    __device__ __forceinline__ void relane() const { int ln; asm volatile("v_mbcnt_lo_u32_b32 %0, -1, 0\n\tv_mbcnt_hi_u32_b32 %0, -1, %0" : "=v"(ln)); lane = ln; tid = wave * 64 + ln; }
    CArgsP a;
    GAS unsigned char* ws;
};
#define WSP(type, off) ((type*)(GAS type*)(F.ws + (off)))
#define AIN(i) ((const float*)(const GAS float*)F.a->in[i])
#define AOUT ((float*)(GAS float*)F.a->out)

struct ConvD { const float* W; bf16* WT; const float* shift; float* bias_out; int N, ldt, k0, n0, dst; float f8 = 0.f; };
__device__ __forceinline__ void conv_load(const ConvD& d, int lane, f32x4 (&v)[8]) {
    const int n4 = (lane & 7) * 4; const bool ok4 = d.n0 + n4 < d.N;
#pragma unroll
    for (int i = 0; i < 8; ++i) { const int kk = 8 * i + (lane >> 3);
        v[i] = ok4 ? *(const f32x4*)(d.W + (size_t)(d.k0 + kk) * d.N + d.n0 + n4) : (f32x4){0.f, 0.f, 0.f, 0.f}; }
}
__device__ __forceinline__ void conv_proc(const ConvD& d, const f32x4 (&v)[8], float* scr, int lane) {
    const int n4 = (lane & 7) * 4;
#pragma unroll
    for (int i = 0; i < 8; ++i) { const int kk = 8 * i + (lane >> 3);
        scr[kk * 33 + n4] = v[i].x; scr[kk * 33 + n4 + 1] = v[i].y; scr[kk * 33 + n4 + 2] = v[i].z; scr[kk * 33 + n4 + 3] = v[i].w; }
    if (d.bias_out) {
#pragma unroll
        for (int m = 0; m < 3; ++m) scr[64 * 33 + m * 64 + lane] = d.shift[(size_t)m * NMODV + lane];
    }
    asm volatile("s_waitcnt lgkmcnt(0)" ::: "memory");
    const int c = lane & 7;
#pragma unroll
    for (int j = 0; j < 4; ++j) { const int nn = (lane >> 3) + 8 * j; const float* s = scr + (8 * c) * 33 + nn;
        if (d.f8 != 0.f) { v2u o; o.x = pk4_fp8(s[0 * 33], s[1 * 33], s[2 * 33], s[3 * 33], d.f8); o.y = pk4_fp8(s[4 * 33], s[5 * 33], s[6 * 33], s[7 * 33], d.f8);
            *(v2u*)((unsigned char*)d.WT + (size_t)(d.dst + nn) * d.ldt + d.k0 + 8 * c) = o; }
        else { v4u o; o.x = pk2(s[0 * 33], s[1 * 33]); o.y = pk2(s[2 * 33], s[3 * 33]); o.z = pk2(s[4 * 33], s[5 * 33]); o.w = pk2(s[6 * 33], s[7 * 33]);
            *(v4u*)(d.WT + (size_t)(d.dst + nn) * d.ldt + d.k0 + 8 * c) = o; } }
    if (d.bias_out) {
        const int kq = lane >> 3;
        f32x4 pb[3];
#pragma unroll
        for (int m = 0; m < 3; ++m) { pb[m] = (f32x4){0.f, 0.f, 0.f, 0.f};
#pragma unroll
            for (int i = 0; i < 8; ++i) pb[m] += v[i] * scr[64 * 33 + m * 64 + 8 * i + kq]; }
#pragma unroll
        for (int m = 0; m < 3; ++m)
#pragma unroll
            for (int j = 0; j < 4; ++j) { float s = pb[m][j]; s += xlane<8>(s); s += xlane<16>(s); s = sum_x32(s); pb[m][j] = s; }
        if (lane < 8) { float* bo = d.bias_out + (size_t)(d.k0 >> 6) * BIAS_LD + d.dst + n4;
            *(f32x4*)bo = pb[0]; *(f32x4*)(bo + BIAS_MS) = pb[1]; *(f32x4*)(bo + 2 * BIAS_MS) = pb[2]; }
    }
    asm volatile("s_waitcnt lgkmcnt(0)" ::: "memory");
}
constexpr int CI_DN = 44 * 32, CI_OE = 16 * 32, CI_UQ = 6 * 24, CI_KV = 4 * 32, CI_GU = 16 * 176, CI_IE = 16 * 88, CI_IO = 16 * 56;
__host__ __device__ constexpr int conv_na(int l) { return 2 * CI_DN + CI_OE + ((l & 1) ? CI_UQ + CI_KV : 0); }
__host__ __device__ constexpr int conv_nb(int l) { return 2 * CI_GU + ((l & 1) ? CI_IO : CI_IE); }
__device__ __forceinline__ ConvD conv_desc_a(const Frame& F, int l, int it) {
    int r = it; const int hi = l >> 1;
    if (r < 2 * CI_DN) { const int w = l * 2 + r / CI_DN, q = r % CI_DN, kb = q / 32, nb = q % 32;
        return ConvD{AIN(I_WDN) + (size_t)w * DFF * 1024, WSP(bf16, WS_WD + w * SZ_WD), nullptr, nullptr, 1024, DFF, kb * 64, nb * 32, nb * 32, WD8_SCALE}; } r -= 2 * CI_DN;
    if (r < CI_OE) { const int kb = r / 32, nb = r % 32;
        if (l & 1) return ConvD{AIN(I_WOO) + (size_t)hi * 1024 * 1024, WSP(bf16, WS_WOO + hi * SZ_WO), nullptr, nullptr, 1024, 1024, kb * 64, nb * 32, nb * 32};
        return ConvD{AIN(I_WOE) + (size_t)hi * 1024 * 1024, WSP(bf16, WS_WOE + hi * SZ_WO), nullptr, nullptr, 1024, 1024, kb * 64, nb * 32, nb * 32}; } r -= CI_OE;
    if (r < CI_UQ) { const int kb = r / 24, nb = r % 24;
        return ConvD{AIN(I_WUQ) + (size_t)hi * 384 * 768, WSP(bf16, WS_WUQ + hi * SZ_WUQ), nullptr, nullptr, 768, 384, kb * 64, nb * 32, nb * 32}; } r -= CI_UQ;
    { const int kb = r / 32, nb = r % 32, n0 = nb * 32, h = n0 >> 7, rr = n0 & 127;
        const int dst = (rr < 64 ? 0 : 512) + h * 64 + (rr & 63);
        return ConvD{AIN(I_WUKV) + (size_t)hi * 256 * 1024, WSP(bf16, WS_WKV + hi * SZ_WKV), nullptr, nullptr, 1024, 256, kb * 64, n0, dst}; }
}
__device__ __forceinline__ ConvD conv_desc_b(const Frame& F, int l, int it) {
    int r = it; const int hi = l >> 1; const float* MOD = WSP(float, WS_MOD) + (size_t)l * 3 * NMODV; float* BIAS = WSP(float, WS_BIAS) + (size_t)(l * 3) * 3 * BIAS_MS;
    if (r < 2 * CI_GU) { const int f = r / CI_GU, w = l * 2 + f, q = r % CI_GU, kb = q / 176, nb = q % 176, n0 = nb * 32;
        const int dst = (n0 < DFF) ? ((n0 >> 7) * 256 + (n0 & 127)) : (((n0 - DFF) >> 7) * 256 + 128 + ((n0 - DFF) & 127));
        ConvD cd{AIN(I_WGU) + (size_t)w * 1024 * 5632, WSP(bf16, WS_WGU + w * SZ_WGU), MOD + (f == 0 ? 0 : 6) * 1024 + kb * 64, BIAS + (size_t)(f == 0 ? 0 : 2) * 3 * BIAS_MS, 5632, 1024, kb * 64, n0, dst};
        if (f == 1 || l >= G1F8_L) cd.f8 = WGU8_SCALE;
        return cd; } r -= 2 * CI_GU;
    if (l & 1) { const int kb = r / 56, nb = r % 56;
        return ConvD{AIN(I_WIO) + (size_t)hi * 1024 * 1696, WSP(bf16, WS_WIO + hi * SZ_WIO), MOD + 3 * 1024 + kb * 64, BIAS + (size_t)3 * BIAS_MS, 1696, 1024, kb * 64, nb * 32, nb * 32}; }
    { const int kb = r / 88, nb = r % 88;
        return ConvD{AIN(I_WIE) + (size_t)hi * 1024 * 2576, WSP(bf16, WS_WIE + hi * SZ_WIE), MOD + 3 * 1024 + kb * 64, BIAS + (size_t)3 * BIAS_MS, 2576, 1024, kb * 64, nb * 32, nb * 32}; }
}
template <bool LB> __device__ __forceinline__ void conv_run(const Frame& F, int l, int lo, int hi, int gw, int NGW, float* scr) {
    int it = lo + gw; if (it >= hi) return;
    ConvD d = LB ? conv_desc_b(F, l, it) : conv_desc_a(F, l, it);
    f32x4 v[8]; conv_load(d, F.lane, v);
    for (;;) {
        const int itn = it + NGW; const bool more = itn < hi;
        ConvD dn = d; f32x4 vn[8];
        if (more) { dn = LB ? conv_desc_b(F, l, itn) : conv_desc_a(F, l, itn); conv_load(dn, F.lane, vn); }
        conv_proc(d, v, scr, F.lane);
        if (!more) break;
        d = dn; it = itn;
#pragma unroll
        for (int i = 0; i < 8; ++i) v[i] = vn[i];
    }
}
template <int N4> __device__ __forceinline__ void mod_tile(const Frame& F, int l, int tile) {
    constexpr int KG = 504 / N4, NC = 4 * N4, NTW = KG * N4;
    float* sv = (float*)F.lds;
    float* red = (float*)(F.lds + 12288);
    __syncthreads();
    for (int i = F.tid; i < 3072; i += NTHR) { const int r = i >> 10, k = i & 1023; const float c = (r == 0) ? AIN(I_CCTX)[k] : AIN(I_C)[(r - 1) * 1024 + k]; sv[i] = siluf_(c); }
    __syncthreads();
    const int n0 = tile * NC, n4 = F.tid % N4, kg = F.tid / N4;
    if (F.tid < NTW) {
        f32x4 a0 = {0.f, 0.f, 0.f, 0.f}, a1 = a0, a2 = a0;
        const float* wp = AIN(I_WMOD) + (size_t)l * 1024 * NMODV + n0 + 4 * n4;
#pragma unroll 8
        for (int k = kg; k < 1024; k += KG) { const f32x4 w = *(const f32x4*)(wp + (size_t)k * NMODV); a0 += w * sv[k]; a1 += w * sv[1024 + k]; a2 += w * sv[2048 + k]; }
        *(f32x4*)(red + (kg * 3 + 0) * NC + 4 * n4) = a0; *(f32x4*)(red + (kg * 3 + 1) * NC + 4 * n4) = a1; *(f32x4*)(red + (kg * 3 + 2) * NC + 4 * n4) = a2;
    }
    __syncthreads();
    for (int o = F.tid; o < 3 * NC; o += NTHR) { const int r = o / NC, n = o % NC; float s = AIN(I_BMOD)[l * NMODV + n0 + n];
        for (int g = 0; g < KG; ++g) s += red[(g * 3 + r) * NC + n];
        WSP(float, WS_MOD)[(size_t)(l * 3 + r) * NMODV + n0 + n] = s; }
    __syncthreads();
}
__device__ __forceinline__ void bias_reduce(const Frame& F, int l, int kmask, int bgi, int nbg) {
    const float* BP = WSP(float, WS_BIAS); float* BF = WSP(float, WS_BIASF);
    const int gt = bgi * NTHR + F.tid, NT = nbg * NTHR;
    for (int i = gt; i < 3 * 3 * (int)BIAS_LD; i += NT) { const int kind = i / (3 * (int)BIAS_LD), rem = i % (3 * (int)BIAS_LD), m = rem / (int)BIAS_LD, n = rem % (int)BIAS_LD;
        if (!((kmask >> kind) & 1)) continue;
        const float* p = BP + ((size_t)(l * 3 + kind) * 3 + m) * BIAS_MS + n; float b = 0.f;
#pragma unroll
        for (int kb = 0; kb < 16; ++kb) b += p[(size_t)kb * BIAS_LD];
        BF[((size_t)(l * 3 + kind) * 3 + m) * BIAS_LD + n] = b; }
}
__device__ __forceinline__ void background_work(const Frame& F, int l, int win, int bgi, int nbg) {
    F.relane();
    if (nbg <= 0) return;
    if (win == 0 && l > 0) bias_reduce(F, l, 6, bgi, nbg);
    float* scr = (float*)(F.lds + F.wave * 16384);
    const int gw = bgi * NWAVES + F.wave, NGW = nbg * NWAVES;
    if (win == 0 && l == 0) conv_run<true>(F, 0, CI_GU, conv_nb(0), gw, NGW, scr);
    if (l >= 3) return;
    const int ln = l + 1;
    if (win == 0) {
        for (int t = bgi; t < 144; t += nbg) mod_tile<16>(F, ln, t);
    } else if (win == 2) {
        conv_run<false>(F, ln, 0, conv_na(ln), gw, NGW, scr);
    } else {
        conv_run<true>(F, ln, 0, conv_nb(ln), gw, NGW, scr);
    }
}
__device__ __forceinline__ void p0_phase(const Frame& F) {
    F.relane();
    for (int t = F.bid; t < 256; t += F.G) mod_tile<9>(F, 0, t);
    {
        float* scr = (float*)(F.lds + F.wave * 16384);
        const int gw = F.bid * NWAVES + F.wave, NGW = F.G * NWAVES;
        conv_run<false>(F, 0, 0, conv_na(0), gw, NGW, scr);
    }
    {
        const size_t gt = (size_t)F.bid * NTHR + F.tid, NT = (size_t)F.G * NTHR;
        for (size_t i = gt; i < 1024 * 16; i += NT) { const int pos = (int)(i >> 4), ax = (int)(i >> 3) & 1, f = (int)i & 7;
            const float freq = exp2f(-(float)f * (13.287712379549449f / 8.0f));
            const float ang = (float)(ax == 0 ? (pos >> 6) : (pos & 63)) * freq;
            float sn, cs; sincosf(ang, &sn, &cs);
            WSP(float, WS_ROPE)[2 * i] = cs; WSP(float, WS_ROPE)[2 * i + 1] = sn; }
    }
}
__device__ __forceinline__ void p1_copy_phase(const Frame& F) {
    F.relane();
    float* scr = (float*)(F.lds + F.wave * 16384);
    const int gw = F.bid * NWAVES + F.wave, NGW = F.G * NWAVES;
    conv_run<true>(F, 0, 0, CI_GU, gw, NGW, scr);
}

__device__ __forceinline__ void norm0_phase(const Frame& F) {
    F.relane();
    const int gw = F.bid * NWAVES + F.wave, NGW = F.G * NWAVES;
    bf16* X = WSP(bf16, WS_X); bf16* XA = WSP(bf16, WS_XA); float* SSQ = WSP(float, WS_SSQ);
    const float* g = AIN(I_GNORM); const float* scale = WSP(float, WS_MOD) + 1024;
    constexpr int RB = 5;
    for (int row0 = gw; row0 < T; row0 += RB * NGW) {
        f32x4 v[RB][4];
#pragma unroll
        for (int q = 0; q < RB; ++q) { const int row = row0 + q * NGW; if (row < T) {
            const f32x4* xr = (const f32x4*)(row < TCTX ? AIN(I_XP) + (size_t)row * D : AIN(I_XS) + (size_t)(row - TCTX) * D) + F.lane;
#pragma unroll
            for (int j = 0; j < 4; ++j) v[q][j] = xr[64 * j]; } }
#pragma unroll
        for (int q = 0; q < RB; ++q) { const int row = row0 + q * NGW; if (row < T) {
            const int r = modrow_of_tok(row);
            float s = 0.f;
#pragma unroll
            for (int j = 0; j < 4; ++j) s += (v[q][j].x * v[q][j].x + v[q][j].y * v[q][j].y) + (v[q][j].z * v[q][j].z + v[q][j].w * v[q][j].w);
            s = wave_sum(s);
            if (F.lane == 0) *(f32x4*)(SSQ + (size_t)row * 4) = (f32x4){s, 0.f, 0.f, 0.f};
            unsigned long long* o8 = (unsigned long long*)(XA + (size_t)row * D) + F.lane;
            unsigned long long* xo = (unsigned long long*)(X + (size_t)row * D) + F.lane;
#pragma unroll
            for (int j = 0; j < 4; ++j) {
                const f32x4 gg = *((const f32x4*)g + F.lane + 64 * j), sc = *((const f32x4*)(scale + (size_t)r * NMODV) + F.lane + 64 * j);
                const f32x4 o = v[q][j] * gg * (sc + 1.0f);
                xo[64 * j] = (unsigned long long)pk2(v[q][j].x, v[q][j].y) | ((unsigned long long)pk2(v[q][j].z, v[q][j].w) << 32);
                o8[64 * j] = (unsigned long long)pk2(o.x, o.y) | ((unsigned long long)pk2(o.z, o.w) << 32);
            } } }
    }
}
__device__ __forceinline__ void final_phase(const Frame& F) {
    F.relane();
    const int gw = F.bid * NWAVES + F.wave, NGW = F.G * NWAVES;
    const bf16* X = WSP(bf16, WS_X); const float* g = AIN(I_GFIN); float* out = AOUT + OUT_Y;
    constexpr int RB = 5;
    for (int row0 = gw; row0 < T; row0 += RB * NGW) {
        v2u w[RB][4];
#pragma unroll
        for (int q = 0; q < RB; ++q) { const int row = row0 + q * NGW; if (row < T) {
            const v2u* xr = (const v2u*)(X + (size_t)row * D) + F.lane;
#pragma unroll
            for (int j = 0; j < 4; ++j) w[q][j] = xr[64 * j]; } }
#pragma unroll
        for (int q = 0; q < RB; ++q) { const int row = row0 + q * NGW; if (row < T) {
            f32x4 v[4]; float s = 0.f;
#pragma unroll
            for (int j = 0; j < 4; ++j) { v[j] = (f32x4){bflo(w[q][j].x), bfhi(w[q][j].x), bflo(w[q][j].y), bfhi(w[q][j].y)}; s += (v[j].x * v[j].x + v[j].y * v[j].y) + (v[j].z * v[j].z + v[j].w * v[j].w); }
            const float rstd = frsq(wave_sum(s) * (1.f / D) + EPS);
            f32x4* o = (f32x4*)(out + (size_t)row * D) + F.lane;
#pragma unroll
            for (int j = 0; j < 4; ++j) o[64 * j] = v[j] * rstd * *((const f32x4*)g + F.lane + 64 * j);
        } }
    }
}
constexpr int LDT = 136;
__device__ __forceinline__ bf16x8 ld_frag16(const unsigned char* p) { return *(const bf16x8*)p; }
__device__ __forceinline__ bf16x8 ld_frag8x2(const unsigned char* p0, const unsigned char* p1) {
    const v2u a = *(const v2u*)p0, b = *(const v2u*)p1; v4u v; v.x = a.x; v.y = a.y; v.z = b.x; v.w = b.y; return __builtin_bit_cast(bf16x8, v); }
#define MFMA16(a, b, c) __builtin_amdgcn_mfma_f32_16x16x32_bf16((a), (b), (c), 0, 0, 0)

__device__ __forceinline__ void chunk_info(int c, int& cfirst, int& clast, bool& is_ctx, int& sb) {
    if (c < 64) { cfirst = c & ~1; clast = cfirst + 1; is_ctx = true; sb = c >> 1; }
    else { cfirst = 64 + ((c - 64) & ~7); clast = cfirst + 7; is_ctx = false; sb = (c - 64) >> 3; }
}
struct ConvW { f32x4 w0a, w0b, w1a, w1b, w2a, w2b, ba, bb; };
__device__ __forceinline__ ConvW conv_w(const float* wc, const float* bc, int ch) {
    ConvW W; W.w0a = *(const f32x4*)(wc + ch); W.w0b = *(const f32x4*)(wc + ch + 4); W.w1a = *(const f32x4*)(wc + 1024 + ch); W.w1b = *(const f32x4*)(wc + 1024 + ch + 4);
    W.w2a = *(const f32x4*)(wc + 2048 + ch); W.w2b = *(const f32x4*)(wc + 2048 + ch + 4); W.ba = *(const f32x4*)(bc + ch); W.bb = *(const f32x4*)(bc + ch + 4); return W;
}
__device__ __forceinline__ void conv8(const bf16* PROJ, int t, bool has_prev, bool has_next, int ch, const ConvW& W, float* out) {
    const bf16* p = PROJ + (size_t)t * EVEN_NP + 1536 + ch;
    const v4u z = {0u, 0u, 0u, 0u};
    const v4u c0 = *(const v4u*)p, cm = has_prev ? *(const v4u*)(p - EVEN_NP) : z, cp = has_next ? *(const v4u*)(p + EVEN_NP) : z;
    float x0[8], xm[8], xp[8]; unpack8(c0, x0); unpack8(cm, xm); unpack8(cp, xp);
#pragma unroll
    for (int i = 0; i < 4; ++i) { out[i] = siluf_(W.ba[i] + W.w0a[i] * xm[i] + W.w1a[i] * x0[i] + W.w2a[i] * xp[i]); out[4 + i] = siluf_(W.bb[i] + W.w0b[i] * xm[4 + i] + W.w1b[i] * x0[4 + i] + W.w2b[i] * xp[4 + i]); }
}
__device__ __forceinline__ void ssd_tables(const Frame& F, int ei, int t0, float* dtl, float* cml) {
    const bf16* PROJ = WSP(bf16, WS_PROJ);
    if (F.tid < 256) { const int j = F.tid >> 1, dir = F.tid & 1;
        const v4u raw = *(const v4u*)(PROJ + (size_t)(t0 + j) * EVEN_NP + 2560 + 8 * dir); float x[8]; unpack8(raw, x);
#pragma unroll
        for (int h = 0; h < 8; ++h) dtl[(dir * 8 + h) * 128 + j] = softplusf_(x[h] + AIN(I_DTB)[ei * 16 + dir * 8 + h]); }
    __syncthreads();
#pragma unroll
    for (int k = 0; k < 2; ++k) {
        const int row = 2 * F.wave + k, rev = row >> 3;
        const float a = -__expf(AIN(I_ALOG)[ei * 16 + row]);
        const int i0 = rev ? 127 - 2 * F.lane : 2 * F.lane, i1 = rev ? 126 - 2 * F.lane : 2 * F.lane + 1;
        const float v0 = dtl[row * 128 + i0] * a, v1 = dtl[row * 128 + i1] * a;
        float x = v0 + v1;
#pragma unroll
        for (int d = 1; d < 64; d <<= 1) { const float t = __builtin_bit_cast(float, __builtin_amdgcn_ds_bpermute((F.lane - d) * 4, __builtin_bit_cast(int, x))); x += (F.lane >= d) ? t : 0.f; }
        const float ex = x - (v0 + v1);
        cml[row * 128 + i0] = ex + v0; cml[row * 128 + i1] = ex + (v0 + v1);
    }
    __syncthreads();
}
constexpr int TILE128 = 34816, TILE64 = 17408;
constexpr int S1_BT = 0, S1_B = TILE128, S1_C = 2 * TILE128, S1_XT = TILE128  , S1_DT = 3 * TILE128, S1_CUM = S1_DT + 8192;
constexpr int S2_XT = 0  , S2_H = 2 * TILE64  , S2_DT = 6 * TILE64, S2_CUM = S2_DT + 8192, S2_SSQ = S2_CUM + 8192;

__device__ __forceinline__ void ssd_state_item(const Frame& F, int ei, int c, int g) {
    F.relane();
    const bf16* PROJ = WSP(bf16, WS_PROJ);
    const float* wc = AIN(I_WCS) + (size_t)ei * 3 * 1024; const float* bc = AIN(I_BCS) + (size_t)ei * 1024;
    int cfirst, clast, sb; bool is_ctx; chunk_info(c, cfirst, clast, is_ctx, sb);
    const int t0 = c * 128, len = is_ctx ? 256 : 1024, pos0 = (c - cfirst) * 128;
    bf16* BT = (bf16*)(F.lds + S1_BT); bf16* Bl = (bf16*)(F.lds + S1_B); bf16* Cl = (bf16*)(F.lds + S1_C); bf16* XT4 = (bf16*)(F.lds + S1_XT);
    float* dtl = (float*)(F.lds + S1_DT); float* cml = (float*)(F.lds + S1_CUM);
    bf16* ST = WSP(bf16, WS_ST); float* DEC = WSP(float, WS_DEC);
    bf16* CC = WSP(bf16, WS_CC); bf16* CBM = WSP(bf16, WS_CBM); bf16* XCT = WSP(bf16, WS_XCT);
    const int r = F.lane & 15, q = F.lane >> 4, w = F.wave;
    __syncthreads();
    ssd_tables(F, ei, t0, dtl, cml);
    { const ConvW W = conv_w(wc, bc, 512 + g * 128 + (F.tid & 15) * 8);
#pragma unroll 4
    for (int e = F.tid; e < 128 * 16; e += NTHR) { const int j = e >> 4, n8 = (e & 15) * 8; float o[8];
        conv8(PROJ, t0 + j, pos0 + j > 0, pos0 + j < len - 1, 512 + g * 128 + n8, W, o);
        const v4u pk = pack8(o);
        *(v4u*)((unsigned char*)Bl + (j * LDT + n8) * 2) = pk;
#pragma unroll
        for (int i = 0; i < 8; ++i) BT[(n8 + i) * LDT + j] = (bf16)f2bf1(o[i]); } }
    { const ConvW W = conv_w(wc, bc, 768 + g * 128 + (F.tid & 15) * 8);
#pragma unroll 4
    for (int e = F.tid; e < 128 * 16; e += NTHR) { const int j = e >> 4, n8 = (e & 15) * 8; float o[8];
        conv8(PROJ, t0 + j, pos0 + j > 0, pos0 + j < len - 1, 768 + g * 128 + n8, W, o);
        const v4u pk = pack8(o);
        *(v4u*)((unsigned char*)Cl + (j * LDT + n8) * 2) = pk;
        *(v4u*)(CC + (size_t)(t0 + j) * 256 + g * 128 + n8) = pk; } }
    __syncthreads();
    {
        bf16x8 cf[4];
#pragma unroll
        for (int ks = 0; ks < 4; ++ks) cf[ks] = ld_frag16((const unsigned char*)Cl + ((16 * w + r) * LDT + 32 * ks + 8 * q) * 2);
        bf16* dst = CBM + ((size_t)(c * 2 + g) * 128 + 16 * w + r) * 128 + 4 * q;
#pragma unroll
        for (int jt = 0; jt < 8; ++jt) { f32x4 a = Z4();
#pragma unroll
            for (int ks = 0; ks < 4; ++ks) a = MFMA16(ld_frag16((const unsigned char*)Bl + ((16 * jt + r) * LDT + 32 * ks + 8 * q) * 2), cf[ks], a);
            v2u o; o.x = pk2(a[0], a[1]); o.y = pk2(a[2], a[3]); *(v2u*)(dst + 16 * jt) = o; }
    }
    __syncthreads();
    { const ConvW W = conv_w(wc, bc, g * 256 + (F.tid & 31) * 8);
#pragma unroll 4
    for (int e = F.tid; e < 128 * 32; e += NTHR) { const int j = e >> 5, p8 = (e & 31) * 8; float o[8];
        conv8(PROJ, t0 + j, pos0 + j > 0, pos0 + j < len - 1, g * 256 + p8, W, o);
#pragma unroll
        for (int i = 0; i < 8; ++i) XT4[(p8 + i) * LDT + j] = (bf16)f2bf1(o[i]); } }
    __syncthreads();
#pragma unroll 4
    for (int e = F.tid; e < 256 * 16; e += NTHR) { const int row = e >> 4, ch = (e & 15) * 8;
        *(v4u*)(XCT + ((size_t)(c * 8 + 4 * g) * 64 + row) * 128 + ch) = *(const v4u*)((const unsigned char*)XT4 + (row * LDT + ch) * 2); }
#pragma unroll 2
    for (int hd = 0; hd < 8; ++hd) {
        const int hh = hd >> 1, dir = hd & 1, h = 4 * g + hh;
        const float* dth = dtl + (dir * 8 + h) * 128; const float* cmh = cml + (dir * 8 + h) * 128;
        const float cend = dir == 0 ? cmh[127] : cmh[0];
        const bf16* XT = XT4 + hh * 64 * LDT;
        f32x4 acc[4];
#pragma unroll
        for (int pt = 0; pt < 4; ++pt) acc[pt] = Z4();
#pragma unroll
        for (int ks = 0; ks < 4; ++ks) {
            const int j0 = 32 * ks + 8 * q;
            const v4u braw = *(const v4u*)((const unsigned char*)BT + ((16 * w + r) * LDT + j0) * 2); float bv[8]; unpack8(braw, bv);
            const f32x4 d0 = *(const f32x4*)(dth + j0), d1 = *(const f32x4*)(dth + j0 + 4), c0 = *(const f32x4*)(cmh + j0), c1 = *(const f32x4*)(cmh + j0 + 4);
#pragma unroll
            for (int i = 0; i < 4; ++i) { bv[i] *= d0[i] * __expf(cend - c0[i]); bv[4 + i] *= d1[i] * __expf(cend - c1[i]); }
            const bf16x8 af = __builtin_bit_cast(bf16x8, pack8(bv));
#pragma unroll
            for (int pt = 0; pt < 4; ++pt) { const bf16x8 bf = ld_frag16((const unsigned char*)XT + ((16 * pt + r) * LDT + j0) * 2); acc[pt] = MFMA16(af, bf, acc[pt]); }
        }
        bf16* dst = ST + ((size_t)(c * 8 + h) * 2 + dir) * 8192;
#pragma unroll
        for (int pt = 0; pt < 4; ++pt) { v2u o; o.x = pk2(acc[pt][0], acc[pt][1]); o.y = pk2(acc[pt][2], acc[pt][3]); *(v2u*)(dst + (16 * pt + r) * 128 + 16 * w + 4 * q) = o; }
        if (F.tid == 0) DEC[(c * 8 + h) * 2 + dir] = __expf(cend);
    }
}

__device__ __forceinline__ void gmlp_item(const Frame& F, int ei, int c, int g) {
    F.relane();
    const bf16* PROJ = WSP(bf16, WS_PROJ); bf16* YMIX = WSP(bf16, WS_YMIX);
    const int t0 = c * 128;
    float* rs = (float*)F.lds; bf16* Vt = (bf16*)(F.lds + 1024); bf16* Wl = (bf16*)(F.lds + 1024 + 34816);
    const float* gv = AIN(I_GV) + ei * 512;
    __syncthreads();
#pragma unroll 1
    for (int kb = 0; kb < 16; kb += 8) {
        v4u raw[8];
#pragma unroll
        for (int k = 0; k < 8; ++k) raw[k] = *(const v4u*)(PROJ + (size_t)(t0 + F.wave * 16 + kb + k) * EVEN_NP + 512 + 8 * F.lane);
#pragma unroll
        for (int k = 0; k < 8; ++k) { float x[8]; unpack8(raw[k], x); float s = 0.f;
#pragma unroll
            for (int i = 0; i < 8; ++i) { const float y = gelu_tanh(x[i]); s += y * y; }
            s = wave_sum(s); if (F.lane == 0) rs[F.wave * 16 + kb + k] = frsq(s * (1.f / 512.f) + EPS); }
    }
    { const float* ws_ = AIN(I_WSP) + ((size_t)ei * 4 + g) * 16384;
#pragma unroll
      for (int e = F.tid; e < 4096; e += NTHR) { const int i = e >> 5, j4 = (e & 31) * 4; const f32x4 v = *(const f32x4*)(ws_ + i * 128 + j4);
          v2u o; o.x = pk2(v.x, v.y); o.y = pk2(v.z, v.w); *(v2u*)((unsigned char*)Wl + (i * LDT + j4) * 2) = o; } }
    __syncthreads();
    { const int d8 = (F.tid & 15) * 8; v4u raw[4];
#pragma unroll
      for (int k = 0; k < 4; ++k) raw[k] = *(const v4u*)(PROJ + (size_t)(t0 + (F.tid >> 4) + 32 * k) * EVEN_NP + 512 + g * 128 + d8);
#pragma unroll
      for (int k = 0; k < 4; ++k) { const int j = (F.tid >> 4) + 32 * k; float x[8]; unpack8(raw[k], x); const float rj = rs[j];
#pragma unroll
          for (int i = 0; i < 8; ++i) Vt[(d8 + i) * LDT + j] = (bf16)f2bf1(gelu_tanh(x[i]) * rj * gv[g * 128 + d8 + i]); } }
    __syncthreads();
    const int r = F.lane & 15, q = F.lane >> 4, w = F.wave;
    bf16x8 af[4];
#pragma unroll
    for (int ks = 0; ks < 4; ++ks) af[ks] = ld_frag16((const unsigned char*)Vt + ((16 * w + r) * LDT + 32 * ks + 8 * q) * 2);
    const float* bs = AIN(I_BSP) + ((size_t)ei * 4 + g) * 128;
    v2u uraw[8];
#pragma unroll
    for (int it = 0; it < 8; ++it) uraw[it] = *(const v2u*)(PROJ + (size_t)(t0 + 16 * it + r) * EVEN_NP + g * 128 + 16 * w + 4 * q);
#pragma unroll
    for (int it = 0; it < 8; ++it) {
        f32x4 acc = Z4();
#pragma unroll
        for (int ks = 0; ks < 4; ++ks) acc = MFMA16(af[ks], ld_frag16((const unsigned char*)Wl + ((16 * it + r) * LDT + 32 * ks + 8 * q) * 2), acc);
        const int i = 16 * it + r, col = g * 128 + 16 * w + 4 * q; const float b = bs[i];
        const float u0 = gelu_tanh(bflo(uraw[it].x)), u1 = gelu_tanh(bfhi(uraw[it].x)), u2 = gelu_tanh(bflo(uraw[it].y)), u3 = gelu_tanh(bfhi(uraw[it].y));
        v2u o; o.x = pk2(u0 * (acc[0] + b), u1 * (acc[1] + b)); o.y = pk2(u2 * (acc[2] + b), u3 * (acc[3] + b));
        *(v2u*)(YMIX + (size_t)(t0 + i) * D + col) = o;
    }
}

__device__ __forceinline__ f32x4 ld_bf4(const bf16* p) { const v2u w = *(const v2u*)p; return (f32x4){bflo(w.x), bfhi(w.x), bflo(w.y), bfhi(w.y)}; }
__device__ __forceinline__ void ssd_scan_phase(const Frame& F, int ei) {
    F.relane();
    const bf16* ST = WSP(bf16, WS_ST); const float* DEC = WSP(float, WS_DEC); bf16* HIN = WSP(bf16, WS_HIN);
    const size_t gt = (size_t)F.bid * NTHR + F.tid, NT = (size_t)F.G * NTHR;
    constexpr size_t N_SMP = (size_t)2 * 8 * 2 * 2048;
    for (size_t it = gt; it < N_SMP; it += NT) {
        const int e = (int)(it & 2047) * 4, dir = (int)(it >> 11) & 1, h = (int)(it >> 12) & 7, b = (int)(it >> 15);
        const int c0 = 64 + 8 * b;
        f32x4 st[8]; float dc[8];
#pragma unroll
        for (int k = 0; k < 8; ++k) { const int cc = dir == 0 ? c0 + k : c0 + 7 - k; st[k] = ld_bf4(ST + ((size_t)(cc * 8 + h) * 2 + dir) * 8192 + e); dc[k] = DEC[(cc * 8 + h) * 2 + dir]; }
        f32x4 v = *(const f32x4*)(AIN(I_SSD) + ((size_t)((b * 2 + ei) * 2 + dir) * 8 + h) * 8192 + e);
#pragma unroll
        for (int k = 0; k < 8; ++k) { const int cc = dir == 0 ? c0 + k : c0 + 7 - k;
            v2u o; o.x = pk2(v.x, v.y); o.y = pk2(v.z, v.w); *(v2u*)(HIN + ((size_t)(cc * 8 + h) * 2 + dir) * 8192 + e) = o;
            v = v * dc[k] + st[k]; }
    }
}
__device__ __forceinline__ void ssd_ctx_final(const Frame& F, int ei, int bgi, int nbg) {
    F.relane();
    const bf16* ST = WSP(bf16, WS_ST); const float* DEC = WSP(float, WS_DEC);
    constexpr int N_CTX = 32 * 8 * 2 * 2048;
    const int gt = bgi * NTHR + F.tid, NT = nbg * NTHR;
    for (int i0 = gt; i0 < N_CTX; i0 += 8 * NT) {
        f32x4 sa[8], sb_[8]; float db[8];
#pragma unroll
        for (int q = 0; q < 8; ++q) { const int i2 = i0 + q * NT; if (i2 < N_CTX) {
            const int e = (i2 & 2047) * 4, dir = (i2 >> 11) & 1, h = (i2 >> 12) & 7, s = i2 >> 15;
            const int ca = dir == 0 ? 2 * s : 2 * s + 1, cb = dir == 0 ? 2 * s + 1 : 2 * s;
            sa[q] = ld_bf4(ST + ((size_t)(ca * 8 + h) * 2 + dir) * 8192 + e); sb_[q] = ld_bf4(ST + ((size_t)(cb * 8 + h) * 2 + dir) * 8192 + e);
            db[q] = DEC[(cb * 8 + h) * 2 + dir]; } }
#pragma unroll
        for (int q = 0; q < 8; ++q) { const int i2 = i0 + q * NT; if (i2 < N_CTX) {
            const int e = (i2 & 2047) * 4, dir = (i2 >> 11) & 1, h = (i2 >> 12) & 7, s = i2 >> 15;
            *(f32x4*)(AOUT + OUT_SSD + ((size_t)((s * 2 + ei) * 2 + dir) * 8 + h) * 8192 + e) = sa[q] * db[q] + sb_[q]; } }
    }
}

__device__ __forceinline__ void ssd_out_item(const Frame& F, int ei, int c, int th) {
    F.relane();
    const bf16* PROJ = WSP(bf16, WS_PROJ); bf16* YMIX = WSP(bf16, WS_YMIX);
    const bf16* CC = WSP(bf16, WS_CC); const bf16* CBM = WSP(bf16, WS_CBM); const bf16* XCT = WSP(bf16, WS_XCT); const bf16* HIN = WSP(bf16, WS_HIN); const bf16* ST = WSP(bf16, WS_ST);
    const int t0 = c * 128;
    float* dtl = (float*)(F.lds + S2_DT); float* cml = (float*)(F.lds + S2_CUM); float* ssqx = (float*)(F.lds + S2_SSQ);
    const int r = F.lane & 15, q = F.lane >> 4, w = F.wave, it = w & 3, g = w >> 2;
    const int irow = 64 * th + 16 * it + r;
    const bool hzero[2] = {c < 64 && (c & 1) == 0, c < 64 && (c & 1) == 1};
    __syncthreads();
    ssd_tables(F, ei, t0, dtl, cml);
    v2u cbp[8]; bf16x8 cf[4];
    {
        const bf16* cbr = CBM + ((size_t)(c * 2 + g) * 128 + irow) * 128 + 4 * q;
#pragma unroll
        for (int jt = 0; jt < 8; ++jt) cbp[jt] = *(const v2u*)(cbr + 16 * jt);
#pragma unroll
        for (int kn = 0; kn < 4; ++kn) cf[kn] = *(const bf16x8*)(CC + (size_t)(t0 + irow) * 256 + g * 128 + 32 * kn + 8 * q);
    }
    float ssq = 0.f;
    v4u pre[12];
    const int goff = (F.tid >> 4) * 128 + (F.tid & 15) * 8, loff = ((F.tid >> 4) * LDT + (F.tid & 15) * 8) * 2;
#define E2_SRC(m_, hh_) ((m_) < 2 ? XCT + (size_t)(c * 8 + 4 * (m_) + (hh_)) * 8192 : \
        (c < 64 ? ST + ((size_t)((((m_) - 2) & 1) == 0 ? c - 1 : c + 1) * 8 + 4 * (((m_) - 2) >> 1) + (hh_)) * 16384 + (((m_) - 2) & 1) * 8192 \
                : HIN + ((size_t)c * 8 + 4 * (((m_) - 2) >> 1) + (hh_)) * 16384 + (((m_) - 2) & 1) * 8192))
#define E2_FETCH(hh_) do { _Pragma("unroll") for (int m = 0; m < 6; ++m) { if (m >= 2 && hzero[(m - 2) & 1]) continue; const bf16* sp = E2_SRC(m, hh_) + goff; \
            pre[2 * m] = *(const v4u*)sp; pre[2 * m + 1] = *(const v4u*)(sp + 32 * 128); } } while (0)
    E2_FETCH(0);
#pragma unroll 1
    for (int hh = 0; hh < 4; ++hh) {
        __syncthreads();
#pragma unroll
        for (int m = 0; m < 6; ++m) { if (m >= 2 && hzero[(m - 2) & 1]) continue;
            unsigned char* dp = F.lds + (m < 2 ? S2_XT + m * TILE64 : S2_H + (m - 2) * TILE64) + loff;
            *(v4u*)dp = pre[2 * m]; *(v4u*)(dp + 32 * LDT * 2) = pre[2 * m + 1]; }
        __syncthreads();
        if (hh < 3) E2_FETCH(hh + 1);
        v2u zr4[4];
#pragma unroll
        for (int pt = 0; pt < 4; ++pt) zr4[pt] = *(const v2u*)(PROJ + (size_t)(t0 + irow) * EVEN_NP + 1024 + (4 * g + hh) * 64 + 16 * pt + 4 * q);
        const int h = 4 * g + hh;
        const bf16* XT = (const bf16*)(F.lds + S2_XT + g * TILE64);
        f32x4 yacc[4];
#pragma unroll
        for (int pt = 0; pt < 4; ++pt) yacc[pt] = Z4();
        const float* dt0 = dtl + h * 128; const float* cm0 = cml + h * 128; const float* dt1 = dtl + (8 + h) * 128; const float* cm1 = cml + (8 + h) * 128;
        const float ci0 = cm0[irow], ci1 = cm1[irow];
#pragma unroll
        for (int ks = 0; ks < 4; ++ks) {
            float sl0[8], sl1[8];
#pragma unroll
            for (int hf = 0; hf < 2; ++hf) {
                const int j0 = 32 * ks + 16 * hf + 4 * q; const v2u cw = cbp[2 * ks + hf];
                const f32x4 c0v = *(const f32x4*)(cm0 + j0), d0v = *(const f32x4*)(dt0 + j0), c1v = *(const f32x4*)(cm1 + j0), d1v = *(const f32x4*)(dt1 + j0);
                const float cbv[4] = {bflo(cw.x), bfhi(cw.x), bflo(cw.y), bfhi(cw.y)};
#pragma unroll
                for (int e = 0; e < 4; ++e) { const int j = j0 + e;
                    const float e0 = __expf(ci0 - c0v[e]) * d0v[e] * cbv[e], e1 = __expf(ci1 - c1v[e]) * d1v[e] * cbv[e];
                    sl0[4 * hf + e] = (j <= irow) ? e0 : 0.f; sl1[4 * hf + e] = (j >= irow) ? e1 : 0.f; }
            }
            const bf16x8 sf0 = __builtin_bit_cast(bf16x8, pack8(sl0)), sf1 = __builtin_bit_cast(bf16x8, pack8(sl1));
#pragma unroll
            for (int pt = 0; pt < 4; ++pt) { const unsigned char* xr = (const unsigned char*)XT + ((16 * pt + r) * LDT + 32 * ks + 4 * q) * 2;
                const bf16x8 xf = ld_frag8x2(xr, xr + 32);
                yacc[pt] = MFMA16(xf, sf0, yacc[pt]); yacc[pt] = MFMA16(xf, sf1, yacc[pt]); }
        }
#pragma unroll
        for (int dir = 0; dir < 2; ++dir) {
            if (hzero[dir]) continue;
            const unsigned char* Hl = F.lds + S2_H + (g * 2 + dir) * TILE64;
            const float ei_ = __expf(dir == 0 ? ci0 : ci1);
#pragma unroll
            for (int pt = 0; pt < 4; ++pt) { f32x4 t = Z4();
#pragma unroll
                for (int kn = 0; kn < 4; ++kn) t = MFMA16(ld_frag16(Hl + ((16 * pt + r) * LDT + 32 * kn + 8 * q) * 2), cf[kn], t);
                yacc[pt] += t * ei_; }
        }
        const float dsk = AIN(I_DSK)[ei * 16 + h] + AIN(I_DSK)[ei * 16 + 8 + h];
#pragma unroll
        for (int pt = 0; pt < 4; ++pt) {
            const int p0 = 16 * pt + 4 * q;
            const v2u zr = zr4[pt];
            const float z0 = bflo(zr.x), z1 = bfhi(zr.x), z2 = bflo(zr.y), z3 = bfhi(zr.y);
            float y0 = yacc[pt][0] + dsk * bf1(XT[(p0 + 0) * LDT + irow]), y1 = yacc[pt][1] + dsk * bf1(XT[(p0 + 1) * LDT + irow]),
                  y2 = yacc[pt][2] + dsk * bf1(XT[(p0 + 2) * LDT + irow]), y3 = yacc[pt][3] + dsk * bf1(XT[(p0 + 3) * LDT + irow]);
            y0 *= siluf_(z0); y1 *= siluf_(z1); y2 *= siluf_(z2); y3 *= siluf_(z3);
            ssq += (y0 * y0 + y1 * y1) + (y2 * y2 + y3 * y3);
            v2u o; o.x = pk2(y0, y1); o.y = pk2(y2, y3);
            *(v2u*)(YMIX + (size_t)(t0 + irow) * D + 512 + h * 64 + p0) = o;
        }
    }
#undef E2_FETCH
#undef E2_SRC
    ssq += xlane<16>(ssq); ssq = sum_x32(ssq);
    if (q == 0) ssqx[w * 16 + r] = ssq;
    __syncthreads();
    ssq += ssqx[(w ^ 4) * 16 + r];
    const float rstd = frsq(ssq * (1.f / 512.f) + EPS);
    const float* go = AIN(I_GSO) + ei * 512;
#pragma unroll 1
    for (int hh = 0; hh < 4; ++hh)
#pragma unroll
        for (int pt = 0; pt < 4; ++pt) {
            const int col = (4 * g + hh) * 64 + 16 * pt + 4 * q;
            v2u* p = (v2u*)(YMIX + (size_t)(t0 + irow) * D + 512 + col); const v2u v = *p; const f32x4 gg = *(const f32x4*)(go + col);
            v2u o; o.x = pk2(bflo(v.x) * rstd * gg.x, bfhi(v.x) * rstd * gg.y); o.y = pk2(bflo(v.y) * rstd * gg.z, bfhi(v.y) * rstd * gg.w);
            *p = o;
        }
}

__device__ __forceinline__ void even_phase1(const Frame& F, int ei) {
    if (F.G >= 256) {
        if (F.bid < 160) ssd_state_item(F, ei, F.bid >> 1, F.bid & 1);
        else for (int it = F.bid - 160; it < 192; it += F.G - 160) gmlp_item(F, ei, it >> 2, it & 3);
        return;
    }
    for (int it = F.bid; it < 160 + 320; it += F.G) {
        if (it < 160) ssd_state_item(F, ei, it >> 1, it & 1);
        else gmlp_item(F, ei, (it - 160) >> 2, (it - 160) & 3);
    }
}
__device__ __forceinline__ void even_phase2(const Frame& F, int ei) {
    if (F.G >= 256) {
        if (F.bid < 160) ssd_out_item(F, ei, F.bid >> 1, F.bid & 1);
        else { for (int it = 192 + F.bid - 160; it < 320; it += F.G - 160) gmlp_item(F, ei, it >> 2, it & 3);
               if (F.bid >= 192) ssd_ctx_final(F, ei, F.bid - 192, F.G - 192); }
        return;
    }
    for (int it = F.bid; it < 160; it += F.G) ssd_out_item(F, ei, it >> 1, it & 1);
    ssd_ctx_final(F, ei, F.bid, F.G);
}
constexpr int CV_T = 43, CV_W = CV_T + 30, CV_ITEMS = 32 * 6 + 2 * 24;
__device__ __forceinline__ void conv_item(const Frame& F, int oi, int item) {
    F.relane();
    const bf16* PROJ = WSP(bf16, WS_PROJ); bf16* YMIX = WSP(bf16, WS_YMIX);
    int sbeg, slen, tile; if (item < 192) { sbeg = (item / 6) * 256; slen = 256; tile = item % 6; } else { const int i2 = item - 192; sbeg = TCTX + (i2 / 24) * 1024; slen = 1024; tile = i2 % 24; }
    const int send = sbeg + slen, t0 = sbeg + tile * CV_T, nt = (slen - tile * CV_T) < CV_T ? (slen - tile * CV_T) : CV_T;
    float* Dl = (float*)F.lds;
    const int c = F.tid;
    float glu[CV_W];
#pragma unroll
    for (int w0 = 0; w0 < CV_W; w0 += 8) {
        bf16 av[8], gv[8];
#pragma unroll
        for (int i = 0; i < 8; ++i) if (w0 + i < CV_W) { int t = t0 - 15 + w0 + i; t = t < sbeg ? sbeg : (t >= send ? send - 1 : t);
            av[i] = PROJ[(size_t)t * ODD_NP + 672 + c]; gv[i] = PROJ[(size_t)t * ODD_NP + 1184 + c]; }
#pragma unroll
        for (int i = 0; i < 8; ++i) if (w0 + i < CV_W) { const int t = t0 - 15 + w0 + i; const float v = bf1(av[i]) * sigmoidf_(bf1(gv[i])); glu[w0 + i] = (t >= sbeg && t < send) ? v : 0.f; }
    }
    float wk[31];
#pragma unroll
    for (int k = 0; k < 31; ++k) wk[k] = AIN(I_WDW)[((size_t)oi * 31 + k) * 512 + c];
    const float bd = AIN(I_BDW)[oi * 512 + c];
    __syncthreads();
#pragma unroll
    for (int tt = 0; tt < CV_T; ++tt) { float s = bd;
#pragma unroll
        for (int k = 0; k < 31; ++k) s += wk[k] * glu[tt + k];
        Dl[tt * 512 + c] = s; }
    __syncthreads();
    const float* gl = AIN(I_GLN) + oi * 512; const float* bl = AIN(I_BLN) + oi * 512;
    const f32x4 g0 = *(const f32x4*)(gl + 8 * F.lane), g1 = *(const f32x4*)(gl + 8 * F.lane + 4), b0 = *(const f32x4*)(bl + 8 * F.lane), b1 = *(const f32x4*)(bl + 8 * F.lane + 4);
#pragma unroll 1
    for (int tt = F.wave; tt < nt; tt += NWAVES) {
        const f32x4 v0 = *(const f32x4*)(Dl + tt * 512 + 8 * F.lane), v1 = *(const f32x4*)(Dl + tt * 512 + 8 * F.lane + 4);
        float s = (v0.x + v0.y) + (v0.z + v0.w) + (v1.x + v1.y) + (v1.z + v1.w);
        const float mean = wave_sum(s) * (1.f / 512.f);
        const f32x4 d0 = v0 - mean, d1 = v1 - mean;
        float s2 = (d0.x * d0.x + d0.y * d0.y) + (d0.z * d0.z + d0.w * d0.w) + (d1.x * d1.x + d1.y * d1.y) + (d1.z * d1.z + d1.w * d1.w);
        const float rstd = frsq(wave_sum(s2) * (1.f / 512.f) + EPS);
        float o[8];
#pragma unroll
        for (int i = 0; i < 4; ++i) { o[i] = siluf_(d0[i] * rstd * g0[i] + b0[i]); o[4 + i] = siluf_(d1[i] * rstd * g1[i] + b1[i]); }
        *(v4u*)(YMIX + (size_t)(t0 + tt) * D + 512 + 8 * F.lane) = pack8(o);
    }
}
__device__ __forceinline__ void odd_rows(const Frame& F, int oi) {
    F.relane();
    const bf16* PROJ = WSP(bf16, WS_PROJ);
    bf16* QA = WSP(bf16, WS_QA); bf16* CKVA = WSP(bf16, WS_CKVA); bf16* KR = WSP(bf16, WS_KR); const float* ROPE = WSP(float, WS_ROPE);
    const int gw = F.bid * NWAVES + F.wave, NGW = F.G * NWAVES, lane = F.lane;
    for (int row = T + gw; row < TP; row += NGW) {
        const int b = (row - T) >> 8, j = (row - T) & 255;
        const f32x4 v = *(const f32x4*)(AIN(I_CCKV) + ((size_t)(b * 2 + oi) * 256 + j) * 256 + 4 * lane);
        v2u o; o.x = pk2(v.x, v.y); o.y = pk2(v.z, v.w); *(v2u*)(CKVA + (size_t)row * 256 + 4 * lane) = o;
        if (lane < 32) KR[(size_t)row * 32 + lane] = (bf16)f2bf1(AIN(I_CKR)[((size_t)(b * 2 + oi) * 256 + j) * 32 + lane]);
    }
    const f32x4 gkv = *(const f32x4*)(AIN(I_GCKV) + oi * 256 + 4 * lane);
    float gq[6];
#pragma unroll
    for (int k = 0; k < 3; ++k) { gq[2 * k] = AIN(I_GCQ)[oi * 384 + 128 * k + 2 * lane]; gq[2 * k + 1] = AIN(I_GCQ)[oi * 384 + 128 * k + 2 * lane + 1]; }
    unsigned qw[3], nqw[3]; v2u kw, nkw; bf16 krw, nkrw;
    int row = gw;
    if (row < T) { const bf16* pr = PROJ + (size_t)row * ODD_NP;
#pragma unroll
        for (int k = 0; k < 3; ++k) nqw[k] = *(const unsigned*)(pr + 128 * k + 2 * lane);
        nkw = *(const v2u*)(pr + 384 + 4 * lane); nkrw = pr[640 + (lane & 31)]; }
#pragma unroll 1
    for (; row < T; row += NGW) {
#pragma unroll
        for (int k = 0; k < 3; ++k) qw[k] = nqw[k];
        kw = nkw; krw = nkrw;
        if (row + NGW < T) { const bf16* pr = PROJ + (size_t)(row + NGW) * ODD_NP;
#pragma unroll
            for (int k = 0; k < 3; ++k) nqw[k] = *(const unsigned*)(pr + 128 * k + 2 * lane);
            nkw = *(const v2u*)(pr + 384 + 4 * lane); nkrw = pr[640 + (lane & 31)]; }
        float qv[6]; float s = 0.f;
#pragma unroll
        for (int k = 0; k < 3; ++k) { qv[2 * k] = bflo(qw[k]); qv[2 * k + 1] = bfhi(qw[k]); s += qv[2 * k] * qv[2 * k] + qv[2 * k + 1] * qv[2 * k + 1]; }
        f32x4 kv = {bflo(kw.x), bfhi(kw.x), bflo(kw.y), bfhi(kw.y)};
        float s2 = (kv.x * kv.x + kv.y * kv.y) + (kv.z * kv.z + kv.w * kv.w);
        s += xlane<1>(s); s2 += xlane<1>(s2); s += xlane<2>(s); s2 += xlane<2>(s2); s += xlane<4>(s); s2 += xlane<4>(s2); s += xlane<8>(s); s2 += xlane<8>(s2); s += xlane<16>(s); s2 += xlane<16>(s2);
        s = sum_x32(s); s2 = sum_x32(s2);
        const float rq = frsq(s * (1.f / 384.f) + EPS), rk = frsq(s2 * (1.f / 256.f) + EPS);
#pragma unroll
        for (int k = 0; k < 3; ++k) *(unsigned*)(QA + (size_t)row * 384 + 128 * k + 2 * lane) = pk2(qv[2 * k] * rq * gq[2 * k], qv[2 * k + 1] * rq * gq[2 * k + 1]);
        kv = kv * rk * gkv;
        { v2u o; o.x = pk2(kv.x, kv.y); o.y = pk2(kv.z, kv.w); *(v2u*)(CKVA + (size_t)row * 256 + 4 * lane) = o; }
        float kr = bf1(krw);
        if (row < TCTX) {
            const int b = row >> 8, pos = row & 255;
            *(f32x4*)(AOUT + OUT_CKV + ((size_t)(b * 2 + oi) * 256 + pos) * 256 + 4 * lane) = kv;
            if (lane < 32) AOUT[OUT_KR + ((size_t)(b * 2 + oi) * 256 + pos) * 32 + lane] = kr;
        } else {
            const int pos = (row - TCTX) & 1023, e = lane & 31, ax = e >> 4, half = (e >> 3) & 1, f = e & 7;
            const float other = xlane<8>(kr);
            const float cs = ROPE[((pos * 2 + ax) * 8 + f) * 2], sn = ROPE[((pos * 2 + ax) * 8 + f) * 2 + 1];
            kr = half == 0 ? (kr * cs - other * sn) : (other * sn + kr * cs);
        }
        if (lane < 32) KR[(size_t)row * 32 + lane] = (bf16)f2bf1(kr);
    }
}
__device__ __forceinline__ void odd_phase1(const Frame& F, int oi) {
    for (int it = F.bid; it < CV_ITEMS; it += F.G) conv_item(F, oi, it);
    odd_rows(F, oi);
}

constexpr int AT_KROW = 208, AT_VROW = 272, AT_KBYTES = 128 * AT_KROW, AT_BUF = 45056;
struct AttnPre { v4u k[3]; v4u v[2]; };
__device__ __forceinline__ void attn_load_tile(const Frame& F, int h, int krow0, AttnPre& P) {
    const bf16* KN = WSP(bf16, WS_KN); const bf16* KR = WSP(bf16, WS_KR); const bf16* VT = WSP(bf16, WS_VT);
#pragma unroll
    for (int i = 0; i < 3; ++i) { const int e = F.tid + NTHR * i, key = e / 12, c = e % 12; const size_t kr = (size_t)(krow0 + key);
        P.k[i] = c < 8 ? *(const v4u*)(KN + kr * 512 + h * 64 + c * 8) : *(const v4u*)(KR + kr * 32 + (c - 8) * 8); }
#pragma unroll
    for (int i = 0; i < 2; ++i) { const int e = F.tid + NTHR * i, row = e >> 4, c = e & 15;
        P.v[i] = *(const v4u*)(VT + (size_t)(h * 64 + row) * TP + krow0 + c * 8); }
}
__device__ __forceinline__ void attn_store_tile(const Frame& F, unsigned char* buf, const AttnPre& P) {
#pragma unroll
    for (int i = 0; i < 3; ++i) { const int e = F.tid + NTHR * i, key = e / 12, c = e % 12; *(v4u*)(buf + key * AT_KROW + c * 16) = P.k[i]; }
#pragma unroll
    for (int i = 0; i < 2; ++i) { const int e = F.tid + NTHR * i, row = e >> 4, c = e & 15; *(v4u*)(buf + AT_KBYTES + row * AT_VROW + c * 16) = P.v[i]; }
}
__device__ __forceinline__ int attn_tile_row(bool is_smp, int sb, int i) {
    if (!is_smp) return sb * 256 + 128 * i;
    return i < 2 ? T + sb * 256 + 128 * i : TCTX + sb * 1024 + 128 * (i - 2);
}
__device__ __forceinline__ void attn_item(const Frame& F, int q0, int h, bool is_smp, int spos0, int sb) {
    F.relane();
    const bf16* Q = WSP(bf16, WS_Q); bf16* YMIX = WSP(bf16, WS_YMIX); const float* ROPE = WSP(float, WS_ROPE);
    const int r = F.lane & 15, g = F.lane >> 4, w = F.wave;
    const int tq = q0 + 16 * w + r;
    const int ntile = is_smp ? 10 : 2;
    AttnPre P;
    attn_load_tile(F, h, attn_tile_row(is_smp, sb, 0), P);
    bf16x8 qf[3];
#pragma unroll
    for (int ks = 0; ks < 3; ++ks) qf[ks] = *(const bf16x8*)(Q + (size_t)tq * 768 + h * 96 + 32 * ks + 8 * g);
    if (is_smp) {
        float x[8], o[8]; unpack8(__builtin_bit_cast(v4u, qf[2]), x);
        const int pos = spos0 + 16 * w + r, ax = g >> 1, half = g & 1;
        const float* rp = ROPE + ((size_t)(pos * 2 + ax) * 8) * 2;
#pragma unroll
        for (int j = 0; j < 8; ++j) { const float other = xlane<16>(x[j]); const float cs = rp[2 * j], sn = rp[2 * j + 1];
            o[j] = half == 0 ? (x[j] * cs - other * sn) : (other * sn + x[j] * cs); }
        qf[2] = __builtin_bit_cast(bf16x8, pack8(o));
    }
    const float csc = 0.10206207261596577f * 1.4426950408889634f;
    float m = -1e30f, l = 0.f;
    f32x4 oacc[4];
#pragma unroll
    for (int dt = 0; dt < 4; ++dt) oacc[dt] = Z4();
    __syncthreads();
    attn_store_tile(F, F.lds, P);
    AttnPre P2;
    if (ntile > 1) attn_load_tile(F, h, attn_tile_row(is_smp, sb, 1), P);
    __syncthreads();
#define ATTN_COMPUTE(buf) do { \
        f32x4 sacc[8]; \
        _Pragma("unroll") \
        for (int st = 0; st < 8; ++st) { \
            const unsigned char* kp = buf + (16 * st + r) * AT_KROW + 16 * g; \
            f32x4 a = Z4(); \
            a = MFMA16(ld_frag16(kp), qf[0], a); a = MFMA16(ld_frag16(kp + 64), qf[1], a); a = MFMA16(ld_frag16(kp + 128), qf[2], a); \
            sacc[st] = a; \
        } \
        float mx = -1e30f; \
        _Pragma("unroll") \
        for (int st = 0; st < 8; ++st) mx = fmaxf(fmaxf(fmaxf(sacc[st][0], sacc[st][1]), fmaxf(sacc[st][2], sacc[st][3])), mx); \
        mx = fmaxf(mx, xlane<16>(mx)); mx = max_x32(mx); \
        const float mn = fmaxf(m, mx), alpha = __builtin_amdgcn_exp2f((m - mn) * csc); m = mn; \
        float ps = 0.f; float p[32]; \
        _Pragma("unroll") \
        for (int st = 0; st < 8; ++st) \
            _Pragma("unroll") \
            for (int j = 0; j < 4; ++j) { const float e = __builtin_amdgcn_exp2f((sacc[st][j] - mn) * csc); p[4 * st + j] = e; ps += e; } \
        l = l * alpha + ps; \
        _Pragma("unroll") \
        for (int dt = 0; dt < 4; ++dt) oacc[dt] *= alpha; \
        _Pragma("unroll") \
        for (int ks2 = 0; ks2 < 4; ++ks2) { \
            const bf16x8 pf = __builtin_bit_cast(bf16x8, pack8(p + 8 * ks2)); \
            _Pragma("unroll") \
            for (int dt = 0; dt < 4; ++dt) { \
                const unsigned char* vp = buf + AT_KBYTES + (16 * dt + r) * AT_VROW + (32 * ks2 + 4 * g) * 2; \
                oacc[dt] = MFMA16(ld_frag8x2(vp, vp + 32), pf, oacc[dt]); \
            } \
        } } while (0)
#pragma unroll 1
    for (int ti = 0; ti < ntile; ti += 2) {
        if (ti + 2 < ntile) attn_load_tile(F, h, attn_tile_row(is_smp, sb, ti + 2), P2);
        { const unsigned char* buf = F.lds; ATTN_COMPUTE(buf); }
        if (ti + 1 < ntile) attn_store_tile(F, F.lds + AT_BUF, P);
        __syncthreads();
        if (ti + 1 >= ntile) break;
        if (ti + 3 < ntile) attn_load_tile(F, h, attn_tile_row(is_smp, sb, ti + 3), P);
        { const unsigned char* buf = F.lds + AT_BUF; ATTN_COMPUTE(buf); }
        if (ti + 2 < ntile) attn_store_tile(F, F.lds, P2);
        __syncthreads();
    }
#undef ATTN_COMPUTE
    l += xlane<16>(l); l = sum_x32(l);
    const float inv = 1.0f / l;
#pragma unroll
    for (int dt = 0; dt < 4; ++dt) { v2u o; o.x = pk2(oacc[dt][0] * inv, oacc[dt][1] * inv); o.y = pk2(oacc[dt][2] * inv, oacc[dt][3] * inv);
        *(v2u*)(YMIX + (size_t)tq * D + h * 64 + 16 * dt + 4 * g) = o; }
}
__device__ __forceinline__ void odd_phase3(const Frame& F) {
    if (F.G >= 256) {
        if (F.bid < 128) {
            const int bh = F.bid & 15, qt = F.bid >> 4, b = bh >> 3, h = bh & 7;
            attn_item(F, TCTX + b * 1024 + qt * 128, h, true, qt * 128, b);
        } else {
            for (int p = F.bid - 128; p < 256; p += F.G - 128) { const int s = p >> 3, h = p & 7;
                attn_item(F, s * 256, h, false, 0, s); attn_item(F, s * 256 + 128, h, false, 0, s); }
        }
        return;
    }
    for (int it = F.bid; it < 640; it += F.G) {
        if (it < 128) { const int b = it >> 6, h = (it >> 3) & 7, qt = it & 7; attn_item(F, TCTX + b * 1024 + qt * 128, h, true, qt * 128, b); }
        else { const int i2 = it - 128, s = i2 >> 4, h = (i2 >> 1) & 7, qt = i2 & 1; attn_item(F, s * 256 + qt * 128, h, false, 0, s); }
    }
}
constexpr int PH_PER_LAYER = 9, PH_L0 = 2, N_PHASES = PH_L0 + 4 * PH_PER_LAYER + 1;
#ifndef MK_ONE_LAUNCH
#define MK_ONE_LAUNCH 1
#endif
#ifndef PROBE_REP
#define PROBE_REP 1
#define PROBE_SLOT -2
#endif

__global__ void __launch_bounds__(NTHR, 2) fwd_kernel(Args args) {
    extern __shared__ __attribute__((aligned(16))) unsigned char lds[];
    Frame F; F.lds = lds; F.tid = threadIdx.x; F.lane = F.tid & 63; F.wave = __builtin_amdgcn_readfirstlane(F.tid >> 6); F.bid = blockIdx.x; F.G = gridDim.x;
    const int wave_id = F.wave;
    { CArgsP ap = (CArgsP)__builtin_amdgcn_kernarg_segment_ptr(); asm volatile("" : "+s"(ap)); F.a = ap; F.ws = (GAS unsigned char*)ap->ws; }
    LAS unsigned char* ldsl = (LAS unsigned char*)lds;
    for (int u = F.tid; u < (LDS_BYTES - LDSCTL_OFF) / 4; u += NTHR) ((LAS unsigned*)(ldsl + LDSCTL_OFF))[u] = 0u;
    __syncthreads();
    XcdBarrier bar; bar.bar = (unsigned*)(GAS unsigned*)(F.ws + WS_CTL) + 1024; bar.x = 0; bar.st = nullptr;
    const bool multi = (args.ph_hi - args.ph_lo) > 1;
    if (multi) bar = xcd_barrier_post((unsigned*)(GAS unsigned*)(F.ws + WS_CTL) + 1024, (volatile LAS unsigned*)(ldsl + MISC_OFF) + 8);

#define FRESH_F() do { int wv_ = wave_id; asm volatile("" : "+s"(wv_)); int ln_; asm volatile("v_mbcnt_lo_u32_b32 %0, -1, 0\n\tv_mbcnt_hi_u32_b32 %0, -1, %0" : "=v"(ln_)); F.tid = wv_ * 64 + ln_; F.lane = ln_; F.wave = wv_; } while (0)
    int rep = 0;
    for (int ph = args.ph_lo; ph < args.ph_hi; ) {
        { CArgsP ap = (CArgsP)__builtin_amdgcn_kernarg_segment_ptr(); asm volatile("" : "+s"(ap)); F.a = ap; F.ws = (GAS unsigned char*)ap->ws;
          int bid_ = blockIdx.x; asm volatile("" : "+s"(bid_)); F.bid = bid_; }
        if (ph == 0) { FRESH_F(); p0_phase(F); }
        else if (ph == 1) { FRESH_F(); p1_copy_phase(F); norm0_phase(F); }
        else if (ph == N_PHASES - 1) { FRESH_F(); final_phase(F); }
        else {
            const int l = (ph - PH_L0) / PH_PER_LAYER, s = (ph - PH_L0) % PH_PER_LAYER, hi = l >> 1; const bool odd = l & 1;
            if (s == 0 && l < G1F8_L) {
                FRESH_F();
                pg8::Gemm g{(const bf16*)(const GAS bf16*)(F.ws + WS_XA), (const bf16*)(const GAS bf16*)(F.ws + WS_WGU + (size_t)(l * 2) * SZ_WGU), T, 2 * DFF, D, D, D};
                pg8::StaticOrder S; S.init(T, 2 * DFF, F.G, F.bid);
                EpiSwiglu E{F.ws, (int)((l * 3) * 3 * BIAS_MS), l == 0 ? 16 : 1};
                pg8::gemm_phase<EpiSwiglu, pg8::StaticOrder, true>(ldsl, F.tid, g, S, E);
                FRESH_F();
                { const int nfull = (40 * 22) % F.G, nbg = F.G - nfull, bgi = F.bid - nfull;
                  if (bgi >= 0 && rep == 0) {
#ifdef PROBE_BG
                    for (int pb = 0; pb < PROBE_BG - 1; ++pb) { background_work(F, l, 0, bgi, nbg); FRESH_F(); }
#endif
                    background_work(F, l, 0, bgi, nbg); } }
            } else if (s == 7 || s == 0) {
                FRESH_F();
                const int f = s == 7 ? 1 : 0;
                pg8::Gemm g8{(const bf16*)(const GAS bf16*)(F.ws + WS_XA), (const bf16*)(const GAS bf16*)(F.ws + WS_WGU + (size_t)(l * 2 + f) * SZ_WGU), T, 2 * DFF, D / 2, D / 2, D / 2};
                pg8::StaticOrder S; S.init(T, 2 * DFF, F.G, F.bid);
                EpiSwiglu E8{F.ws, (int)(((l * 3) + (f ? 2 : 0)) * 3 * BIAS_MS), 1, 1.0f / (XA8_SCALE * WGU8_SCALE)};
                pg8::gemm_phase<EpiSwiglu, pg8::StaticOrder, true, 4, true>(ldsl, F.tid, g8, S, E8);
                FRESH_F();
                { const int nfull = (40 * 22) % F.G, nbg = F.G - nfull, bgi = F.bid - nfull;
                  if (bgi >= 0 && rep == 0) {
#ifdef PROBE_BG
                    for (int pb = 0; pb < PROBE_BG - 1; ++pb) { background_work(F, l, f, bgi, nbg); FRESH_F(); }
#endif
                    background_work(F, l, f, bgi, nbg); } }
            } else if (s == 1 || s == 8 || s == 6) {
                FRESH_F();
                const int f = s == 1 ? 0 : 1;
                const bool mix = s == 6, lastg = (s == 8 && l == 3);
                const bf16* gA = mix ? (const bf16*)(const GAS bf16*)(F.ws + WS_YMIX) : (const bf16*)(const GAS bf16*)(F.ws + WS_H);
                const bf16* gB = mix ? (const bf16*)(const GAS bf16*)(F.ws + (odd ? WS_WOO : WS_WOE) + (size_t)hi * SZ_WO) : (const bf16*)(const GAS bf16*)(F.ws + WS_WD + (size_t)(l * 2 + f) * SZ_WD);
                const int gK = mix ? D : DFF;
                const int gate_off = l * 3 * NMODV + (mix ? 5 : (f == 0 ? 2 : 8)) * 1024;
                const float coef = rep ? 0.f : (mix ? 1.0f : 0.5f / (H8_SCALE * WD8_SCALE));
                const int nl = (s == 8) ? l + 1 : l, ni = mix ? 2 : (f == 0 ? 1 : 0), sci = mix ? 7 : (f == 0 ? 4 : 1);
                const float* gn = AIN(I_GNORM) + (size_t)((lastg ? 0 : nl) * 3 + ni) * D;
                const int scn_off = (lastg ? 0 : nl) * 3 * NMODV + sci * 1024;
                const int gK2 = mix ? gK : gK / 2;
                pg8::Gemm g{gA, gB, T, D, gK2, gK2, gK2};
                pg8::StaticOrder S; S.init(T, D, F.G, F.bid, 160);
                if (mix) { EpiResid160X8 EX{F.ws, gn, gate_off, scn_off, coef}; pg8::gemm_phase<EpiResid160X8, pg8::StaticOrder, true, 1, false>(ldsl, F.tid, g, S, EX); }
                else { EpiResid160L EL{F.ws, gn, gate_off, scn_off, coef, s == 8 && l + 1 >= G1F8_L && l < 3};
                       pg8::gemm_phase<EpiResid160L, pg8::StaticOrder, true, 1, true>(ldsl, F.tid, g, S, EL); }
                FRESH_F();
                if (s == 8 && l < 3 && rep == 0) bias_reduce(F, l + 1, 1, F.bid, F.G);
                if (s == 1 && l == 0 && rep == 0) bias_reduce(F, 0, 6, F.bid, F.G);
            } else if (s == 2 || (s == 4 && odd)) {
                const int ng = s == 2 ? 1 : 3;
                for (int gi = 0; gi < ng; ++gi) {
                    FRESH_F();
                    const bool inproj = s == 2;
                    const int kind = inproj ? 0 : 1 + gi;
                    const size_t offA = kind == 0 ? WS_XA : (kind == 1 ? WS_QA : (kind == 2 ? WS_CKVA : WS_WKV + (size_t)hi * SZ_WKV + (size_t)512 * 256 * 2));
                    const size_t offB = kind == 0 ? (odd ? WS_WIO + (size_t)hi * SZ_WIO : WS_WIE + (size_t)hi * SZ_WIE) : (kind == 1 ? WS_WUQ + (size_t)hi * SZ_WUQ : (kind == 2 ? WS_WKV + (size_t)hi * SZ_WKV : WS_CKVA));
                    const size_t offO = kind == 0 ? WS_PROJ : (kind == 1 ? WS_Q : (kind == 2 ? WS_KN : WS_VT));
                    const int gM = kind == 3 ? 512 : (kind == 2 ? TP : T);
                    const int gN = kind == 0 ? (odd ? ODD_NP : EVEN_NP) : (kind == 1 ? 768 : (kind == 2 ? 512 : TP));
                    const int gK = kind == 0 ? D : (kind == 1 ? 384 : 256);
                    const int ldc = kind == 3 ? TP : gN;
                    const int off = kind == 2 ? 136 : (kind == 3 ? 84 : 0);
                    pg8::Gemm g{(const bf16*)(const GAS bf16*)(F.ws + offA), (const bf16*)(const GAS bf16*)(F.ws + offB), gM, gN, gK, gK, gK};
                    EpiStore E{F.ws, (unsigned)offO, ldc, inproj ? (int)((l * 3 + 1) * 3 * BIAS_MS) : -1};
                    pg8::StaticOrder S; S.init(gM, gN, F.G, (F.bid + off) % F.G);
                    pg8::gemm_phase<EpiStore, pg8::StaticOrder, true>(ldsl, F.tid, g, S, E);
                }
                if (s == 2) {
                    FRESH_F();
                    const int nfull = (40 * ((odd ? ODD_NP : EVEN_NP) / 256)) % F.G, bgi = F.bid - nfull;
                    if (nfull != 0 && bgi >= 0 && rep == 0) background_work(F, l, 2, bgi, F.G - nfull);
                }
            } else if (s == 3) { if (!odd) { FRESH_F(); even_phase1(F, hi); } else { FRESH_F(); odd_phase1(F, hi); } }
            else if (s == 4) { FRESH_F(); ssd_scan_phase(F, hi); }
            else if (s == 5) { if (odd) { FRESH_F(); odd_phase3(F); } else { FRESH_F(); even_phase2(F, hi); } }
        }
        {
            const int slot = ph < PH_L0 ? 100 + ph : (ph == N_PHASES - 1 ? 102 : ((ph - PH_L0) % PH_PER_LAYER) + 20 * (((ph - PH_L0) / PH_PER_LAYER) & 1));
            const int reps = ((PROBE_SLOT == 200 && slot < 100) || slot == PROBE_SLOT || (PROBE_SLOT < 20 && slot == PROBE_SLOT + 20 && (PROBE_SLOT < 2 || PROBE_SLOT > 5))) ? PROBE_REP : 1;
            if (++rep >= reps) { rep = 0; ++ph; }
            if (ph < args.ph_hi) xcd_barrier(bar);
#if defined(PROBE_BAR)
            if (ph < args.ph_hi) { for (int pb_ = 1; pb_ < PROBE_BAR; ++pb_) xcd_barrier(bar); }
#endif
        }
    }
}

extern "C" void kernel_launch(void* const* d_in, const int* in_sizes, int n_in, void* d_out, int out_size, void* d_ws, size_t ws_size, hipStream_t stream) {
    static int grid = 0;
    if (grid == 0) {
        if (n_in != 34 || (size_t)out_size != OUT_END || ws_size < WS_END) { fprintf(stderr, "kernel_launch: unexpected problem: n_in %d out %d ws %zu (need %zu)\n", n_in, out_size, ws_size, (size_t)WS_END); grid = -1; return; }
        int dev = 0, cus = 0, per_cu = 0;
        if (hipGetDevice(&dev) != hipSuccess || hipDeviceGetAttribute(&cus, hipDeviceAttributeMultiprocessorCount, dev) != hipSuccess) { grid = -1; return; }
        if (hipFuncSetAttribute((const void*)fwd_kernel, hipFuncAttributeMaxDynamicSharedMemorySize, LDS_BYTES) != hipSuccess) { fprintf(stderr, "kernel_launch: hipFuncSetAttribute failed\n"); grid = -1; return; }
        if (hipOccupancyMaxActiveBlocksPerMultiprocessor(&per_cu, (const void*)fwd_kernel, NTHR, LDS_BYTES) != hipSuccess || per_cu < 1) { fprintf(stderr, "kernel_launch: occupancy query says %d blocks per CU\n", per_cu); per_cu = 1; }
        (void)hipGetLastError();
        grid = cus;
        if (grid < 256) fprintf(stderr, "kernel_launch: %d CUs (tuned for 256)\n", grid);
    }
    if (grid < 0) return;
    (void)hipMemsetAsync((char*)d_ws + WS_CTL, 0, CTL_ZERO_BYTES, stream);
    Args a{};
    for (int i = 0; i < 34; ++i) a.in[i] = (const float*)d_in[i];
    a.out = (float*)d_out; a.ws = (unsigned char*)d_ws;
#if MK_ONE_LAUNCH
    a.ph_lo = 0; a.ph_hi = N_PHASES; a.li = 0;
    hipLaunchKernelGGL(fwd_kernel, dim3(grid), dim3(NTHR), LDS_BYTES, stream, a);
#else
    int li = 0;
    for (int ph = 0; ph < N_PHASES; ++ph) {
        a.ph_lo = ph; a.ph_hi = ph + 1; a.li = li++;
        hipLaunchKernelGGL(fwd_kernel, dim3(grid), dim3(NTHR), LDS_BYTES, stream, a);
    }
#endif
}
```
